# Optimizing an MI355X kernel written in HIP

```python
import math
import jax, jax.numpy as jnp
from jax import lax
import numpy as np


D_MODEL = 2048
BATCH = 8
SEQ = 2048
DEPTH = 2

GRID_W = 64
CTX_LEN = 256
MIX_WIDTH = D_MODEL
ATT_WIDTH = MIX_WIDTH // 2
ATT_V_DIM = 128
ATT_QK_DIM = 64
ATT_HEADS = ATT_WIDTH // ATT_V_DIM
MLSTM_WIDTH = MIX_WIDTH - ATT_WIDTH
MLSTM_V_DIM = 256
MLSTM_QK_DIM = 128
MLSTM_HEADS = MLSTM_WIDTH // MLSTM_V_DIM
MLSTM_CHUNK = 64
CONV_WIDTH = 3
GATE_SOFTCAP = 15.0
ROPE_BASE = 10000.0
Q_BLOCK = 128
EPS = 1e-6

IN_SPLITS = (
    ATT_HEADS * 2 * ATT_QK_DIM,
    ATT_HEADS * 2 * ATT_QK_DIM,
    ATT_WIDTH,
    ATT_WIDTH,
    MLSTM_HEADS * MLSTM_QK_DIM,
    MLSTM_HEADS * MLSTM_QK_DIM,
    MLSTM_WIDTH,
    MLSTM_WIDTH,
    MLSTM_WIDTH,
    4 * MLSTM_HEADS,
)
IN_COLS = sum(IN_SPLITS)

kernel_name = 'hybrid_diffattn_mlstm_block'


def rms_norm(x, w):
    xf = x.astype(jnp.float32)
    y = xf * lax.rsqrt(jnp.mean(xf * xf, axis=-1, keepdims=True) + EPS)
    return (y * w.astype(jnp.float32)).astype(x.dtype)


def split_cols(p):
    idx = np.cumsum(IN_SPLITS)[:-1].tolist()
    return jnp.split(p, idx, axis=-1)


def axial_rope_tables(n_tokens):
    rows = n_tokens // GRID_W
    row = jnp.repeat(jnp.arange(rows), GRID_W).astype(jnp.float32)
    col = jnp.tile(jnp.arange(GRID_W), rows).astype(jnp.float32)
    n_freq = ATT_QK_DIM // 4
    inv = ROPE_BASE ** (-jnp.arange(n_freq, dtype=jnp.float32) / n_freq)
    ang = jnp.concatenate([row[:, None] * inv, col[:, None] * inv], axis=-1)
    return jnp.cos(ang), jnp.sin(ang)


def apply_rope(x, cos, sin):
    xf = x.astype(jnp.float32)
    x1, x2 = xf[..., 0::2], xf[..., 1::2]
    c = cos[:, None, None, :]
    s = sin[:, None, None, :]
    out = jnp.stack([x1 * c - x2 * s, x1 * s + x2 * c], axis=-1).reshape(x.shape)
    return out.astype(x.dtype)


def diff_softmax_mix(q, k, v, lam):
    s = jnp.einsum('bqhcd,bkhcd->bhcqk', q, k).astype(jnp.float32) * (ATT_QK_DIM ** -0.5)
    p = jax.nn.softmax(s, axis=-1)
    a = p[:, :, 0] - lam * p[:, :, 1]
    return jnp.einsum('bhqk,bkhe->bqhe', a.astype(v.dtype), v)


def diff_attention_branch(lat, ctx, lam_q1, lam_k1, lam_q2, lam_k2, subln_w, layer_idx, need_ctx_out):
    q, k, v, g = lat
    qc, kc, vc, gc = ctx
    B, T = q.shape[:2]
    f32 = jnp.float32
    lam_init = 0.8 - 0.6 * math.exp(-0.3 * layer_idx)
    lam = (jnp.exp(jnp.sum(lam_q1.astype(f32) * lam_k1.astype(f32)))
           - jnp.exp(jnp.sum(lam_q2.astype(f32) * lam_k2.astype(f32))) + lam_init)
    qk_heads = lambda t: t.reshape(t.shape[0], t.shape[1], ATT_HEADS, 2, ATT_QK_DIM)
    v_heads = lambda t: t.reshape(t.shape[0], t.shape[1], ATT_HEADS, ATT_V_DIM)
    cos, sin = axial_rope_tables(T)
    q = apply_rope(qk_heads(q), cos, sin)
    k = apply_rope(qk_heads(k), cos, sin)
    kc, vc = qk_heads(kc), v_heads(vc)
    k_all = jnp.concatenate([kc, k], axis=1)
    v_all = jnp.concatenate([vc, v_heads(v)], axis=1)
    n_blocks = T // Q_BLOCK
    q_blocks = jnp.swapaxes(q.reshape(B, n_blocks, Q_BLOCK, ATT_HEADS, 2, ATT_QK_DIM), 0, 1)
    o = lax.map(lambda qb: diff_softmax_mix(qb, k_all, v_all, lam), q_blocks)
    o = jnp.swapaxes(o, 0, 1).reshape(B, T, ATT_HEADS, ATT_V_DIM)

    def finish(o, gate):
        o = rms_norm(o, subln_w) * (1.0 - lam_init)
        return o.reshape(o.shape[0], o.shape[1], ATT_WIDTH) * jax.nn.silu(gate)

    y = finish(o, g)
    yc = finish(diff_softmax_mix(qk_heads(qc), kc, vc, lam), gc) if need_ctx_out else None
    return y, yc


def short_conv(x, w, b):
    pad = CONV_WIDTH // 2
    T = x.shape[1]
    xp = jnp.pad(x, ((0, 0), (pad, pad), (0, 0)))
    y = b
    for j in range(CONV_WIDTH):
        y = y + w[j] * xp[:, j:j + T]
    return y


def mlstm_chunkwise(q, k, v, ig, lf, state):
    B, H, T, _ = q.shape
    dv = v.shape[-1]
    nc = T // MLSTM_CHUNK

    def chunks(t):
        return jnp.moveaxis(t.reshape(B, H, nc, MLSTM_CHUNK, *t.shape[3:]), 2, 0)

    tril = jnp.tril(jnp.ones((MLSTM_CHUNK, MLSTM_CHUNK), dtype=bool))

    def step(carry, xs):
        C, n, m = carry
        qc, kc, vc, ic, fc = xs
        b = jnp.cumsum(fc, axis=-1)
        logw = jnp.where(tril, b[..., :, None] - b[..., None, :] + ic[..., None, :], -jnp.inf)
        inter = b + m[..., None]
        m_row = jnp.maximum(inter, jnp.max(logw, axis=-1))
        w = jnp.exp(logw - m_row[..., None])
        s = jnp.einsum('bhld,bhsd->bhls', qc, kc) * w
        sc = jnp.exp(inter - m_row)
        numer = sc[..., None] * jnp.einsum('bhld,bhde->bhle', qc, C) + jnp.einsum('bhls,bhse->bhle', s, vc)
        denom = sc * jnp.einsum('bhld,bhd->bhl', qc, n) + jnp.sum(s, axis=-1)
        h = numer / jnp.maximum(jnp.abs(denom), jnp.exp(-m_row))[..., None]
        b_last = b[..., -1]
        g = b_last[..., None] - b + ic
        m_new = jnp.maximum(b_last + m, jnp.max(g, axis=-1))
        wk = jnp.exp(g - m_new[..., None])
        decay = jnp.exp(b_last + m - m_new)
        C_new = decay[..., None, None] * C + jnp.einsum('bhsd,bhse->bhde', wk[..., None] * kc, vc)
        n_new = decay[..., None] * n + jnp.einsum('bhs,bhsd->bhd', wk, kc)
        return (C_new, n_new, m_new), h

    state, h = lax.scan(step, state, (chunks(q), chunks(k), chunks(v), chunks(ig), chunks(lf)))
    h = jnp.moveaxis(h, 0, 2).reshape(B, H, T, dv)
    return h, state


def mlstm_branch(lat, ctx, conv_w, conv_b, i_bias, f_bias, head_norm_w, need_ctx_out):
    f32 = jnp.float32

    def prep(q, k, v, gates):
        qk = jax.nn.silu(short_conv(jnp.concatenate([q, k], axis=-1), conv_w, conv_b))
        q, k = jnp.split(qk, 2, axis=-1)
        B, T = q.shape[:2]
        heads = lambda t, d: t.reshape(B, T, MLSTM_HEADS, d).transpose(0, 2, 1, 3).astype(f32)
        q = heads(q, MLSTM_QK_DIM)
        k = heads(k, MLSTM_QK_DIM) * (MLSTM_QK_DIM ** -0.5)
        v = heads(v, MLSTM_V_DIM)
        gp = gates.astype(f32).reshape(B, T, 2, 2, MLSTM_HEADS)
        cap = lambda t: GATE_SOFTCAP * jnp.tanh(t / GATE_SOFTCAP)
        ig = cap(gp[:, :, 0] + i_bias.astype(f32))
        lf = jax.nn.log_sigmoid(cap(gp[:, :, 1] + f_bias.astype(f32)))
        return q, k, v, ig.transpose(2, 0, 3, 1), lf.transpose(2, 0, 3, 1)

    ql, kl, vl, igl, lfl = prep(lat[0], lat[1], lat[2], lat[5])
    qc, kc, vc, igc, lfc = prep(ctx[0], ctx[1], ctx[2], ctx[5])
    B = ql.shape[0]
    h_lat, h_ctx = [], []
    for d in range(2):
        flip = (lambda t: jnp.flip(t, axis=2)) if d == 1 else (lambda t: t)
        state0 = (jnp.zeros((B, MLSTM_HEADS, MLSTM_QK_DIM, MLSTM_V_DIM), f32),
                  jnp.zeros((B, MLSTM_HEADS, MLSTM_QK_DIM), f32),
                  jnp.zeros((B, MLSTM_HEADS), f32))
        hc, state = mlstm_chunkwise(flip(qc), flip(kc), flip(vc), flip(igc[d]), flip(lfc[d]), state0)
        hl, _ = mlstm_chunkwise(flip(ql), flip(kl), flip(vl), flip(igl[d]), flip(lfl[d]), state)
        h_lat.append(flip(hl))
        h_ctx.append(flip(hc))

    def finish(h, o, g):
        Bh, H, T, dv = h.shape
        h = rms_norm(h.transpose(0, 2, 1, 3), head_norm_w.reshape(H, dv)).reshape(Bh, T, H * dv)
        return h.astype(o.dtype) * jax.nn.sigmoid(o) * jax.nn.silu(g)

    y = finish(h_lat[0] + h_lat[1], lat[3], lat[4])
    yc = finish(h_ctx[0] + h_ctx[1], ctx[3], ctx[4]) if need_ctx_out else None
    return y, yc


def hybrid_layer(x, xc, mod, mod_c, w_in, w_out, norm_pre, norm_post,
                 lam_q1, lam_k1, lam_q2, lam_k2, attn_subln,
                 conv_w, conv_b, i_bias, f_bias, mlstm_norm, layer_idx, need_ctx_out):
    shift, scale, gate = jnp.split(mod, 3, axis=-1)
    shift_c, scale_c, gate_c = jnp.split(mod_c, 3, axis=-1)
    h = rms_norm(x, norm_pre) * (1.0 + scale[:, None]) + shift[:, None]
    hc = rms_norm(xc, norm_pre) * (1.0 + scale_c) + shift_c
    pl = split_cols(h @ w_in)
    pc = split_cols(hc @ w_in)
    ya, yac = diff_attention_branch(pl[:4], pc[:4], lam_q1, lam_k1, lam_q2, lam_k2,
                                    attn_subln, layer_idx, need_ctx_out)
    ym, ymc = mlstm_branch(pl[4:], pc[4:], conv_w, conv_b, i_bias, f_bias, mlstm_norm, need_ctx_out)
    y = jnp.concatenate([ya, ym], axis=-1) @ w_out
    x = x + gate[:, None] * rms_norm(y, norm_post)
    if need_ctx_out:
        yc = jnp.concatenate([yac, ymc], axis=-1) @ w_out
        xc = xc + gate_c * rms_norm(yc, norm_post)
    return x, xc


def setup_inputs(seed: int = 0) -> dict:
    key = jax.random.key(seed)
    ks = jax.random.split(key, 20)
    f32 = jnp.float32
    nrm = lambda k, shape: jax.random.normal(k, shape, dtype=f32)
    return {
        'x': nrm(ks[0], (BATCH, SEQ, D_MODEL)),
        'c': nrm(ks[1], (BATCH, D_MODEL)),
        'ctx': nrm(ks[2], (BATCH, CTX_LEN, D_MODEL)),
        'c_ctx': nrm(ks[3], (D_MODEL,)),
        'w_ada': nrm(ks[4], (DEPTH, D_MODEL, 3 * D_MODEL)) * (0.5 * D_MODEL ** -0.5),
        'b_ada': nrm(ks[5], (DEPTH, 3 * D_MODEL)) * 0.02,
        'norm_pre': 1.0 + 0.05 * nrm(ks[6], (DEPTH, D_MODEL)),
        'norm_post': 1.0 + 0.05 * nrm(ks[7], (DEPTH, D_MODEL)),
        'w_in': nrm(ks[8], (DEPTH, D_MODEL, IN_COLS)) * (D_MODEL ** -0.5),
        'w_out': nrm(ks[9], (DEPTH, MIX_WIDTH, D_MODEL)) * (MIX_WIDTH ** -0.5),
        'lam_q1': 0.1 * nrm(ks[10], (DEPTH, ATT_QK_DIM)),
        'lam_k1': 0.1 * nrm(ks[11], (DEPTH, ATT_QK_DIM)),
        'lam_q2': 0.1 * nrm(ks[12], (DEPTH, ATT_QK_DIM)),
        'lam_k2': 0.1 * nrm(ks[13], (DEPTH, ATT_QK_DIM)),
        'attn_subln': 1.0 + 0.05 * nrm(ks[14], (DEPTH, ATT_V_DIM)),
        'conv_w': nrm(ks[15], (DEPTH, CONV_WIDTH, 2 * MLSTM_HEADS * MLSTM_QK_DIM)) * (CONV_WIDTH ** -0.5),
        'conv_b': 0.02 * nrm(ks[16], (DEPTH, 2 * MLSTM_HEADS * MLSTM_QK_DIM)),
        'i_bias': 0.1 * nrm(ks[17], (DEPTH, 2, MLSTM_HEADS)),
        'f_bias': jnp.linspace(3.0, 6.0, MLSTM_HEADS, dtype=f32) + 0.1 * nrm(ks[18], (DEPTH, 2, MLSTM_HEADS)),
        'mlstm_norm': 1.0 + 0.05 * nrm(ks[19], (DEPTH, MLSTM_WIDTH)),
    }


def reference(x, c, ctx, c_ctx, w_ada, b_ada, norm_pre, norm_post, w_in, w_out,
              lam_q1, lam_k1, lam_q2, lam_k2, attn_subln, conv_w, conv_b,
              i_bias, f_bias, mlstm_norm):
    xc = ctx
    sc = jax.nn.silu(c)
    sc_ctx = jax.nn.silu(c_ctx)
    for l in range(DEPTH):
        mod = sc @ w_ada[l] + b_ada[l]
        mod_c = sc_ctx @ w_ada[l] + b_ada[l]
        x, xc = hybrid_layer(x, xc, mod, mod_c, w_in[l], w_out[l], norm_pre[l], norm_post[l],
                             lam_q1[l], lam_k1[l], lam_q2[l], lam_k2[l], attn_subln[l],
                             conv_w[l], conv_b[l], i_bias[l], f_bias[l], mlstm_norm[l],
                             l, l < DEPTH - 1)
    return x
```

```cpp
#include <hip/hip_runtime.h>
#include <stdint.h>
#include <math.h>

#define DEVI __device__ __forceinline__
typedef unsigned short bf16_t;

constexpr int DM = 2048, NBATCH = 8, SEQ = 2048, CTXL = 256;
constexpr int NLAT = NBATCH * SEQ, NCTX = NBATCH * CTXL, NTOK = NLAT + NCTX;
constexpr int INC = 8208, NP = 8192, MODW = 6144;
constexpr int C_QA = 0, C_KA = 1024, C_VA = 2048, C_GA = 3072, C_QB = 4096, C_KB = 4608, C_VB = 5120, C_OB = 6144, C_GB = 7168;
constexpr float EPS = 1e-6f;

constexpr size_t MiB = (size_t)1 << 20;
constexpr size_t WS_CTL = 0, WS_MOD = 1 * MiB, WS_SC = WS_MOD + 512 * 1024, WS_ROPE = 2 * MiB, WS_GATES = 3 * MiB, WS_WOUT = 8 * MiB,
                 WS_WIN = 24 * MiB, WS_XC = 56 * MiB, WS_H = 72 * MiB, WS_HM = 144 * MiB, WS_P = 216 * MiB, WS_END = 504 * MiB;

DEVI float bf2f(bf16_t v) { return __uint_as_float(((unsigned)v) << 16); }
DEVI bf16_t f2bf(float f) { unsigned u = __float_as_uint(f); return (bf16_t)((u + 0x7fffu + ((u >> 16) & 1u)) >> 16); }
DEVI unsigned pk2(float lo, float hi) { return (unsigned)f2bf(lo) | ((unsigned)f2bf(hi) << 16); }
DEVI float wave_sum(float v) {
#pragma unroll
    for (int o = 32; o > 0; o >>= 1) v += __shfl_xor(v, o);
    return v;
}
DEVI float wave_max(float v) {
#pragma unroll
    for (int o = 32; o > 0; o >>= 1) v = fmaxf(v, __shfl_xor(v, o));
    return v;
}
DEVI float silu_f(float x) { return x / (1.f + expf(-x)); }
DEVI float sigmoid_f(float x) { return 1.f / (1.f + expf(-x)); }

__global__ void k_silu_c(const float* __restrict__ c, const float* __restrict__ c_ctx, float* __restrict__ SC) {
    int i = blockIdx.x * 256 + threadIdx.x;
    if (i < 9 * DM) { float v = (i < 8 * DM) ? c[i] : c_ctx[i - 8 * DM]; SC[i] = silu_f(v); }
}
__global__ __launch_bounds__(256) void k_mod(const float* __restrict__ SC, const float* __restrict__ w_ada, const float* __restrict__ b_ada, float* __restrict__ MOD) {
    int j = blockIdx.x * 256 + threadIdx.x;
    int l = j / MODW, jj = j % MODW;
    const float* w = w_ada + (size_t)l * DM * MODW + jj;
    float acc[9];
#pragma unroll
    for (int r = 0; r < 9; ++r) acc[r] = 0.f;
    for (int k = 0; k < DM; ++k) {
        float wv = w[(size_t)k * MODW];
#pragma unroll
        for (int r = 0; r < 9; ++r) acc[r] += SC[r * DM + k] * wv;
    }
#pragma unroll
    for (int r = 0; r < 9; ++r) MOD[(size_t)(l * 9 + r) * MODW + jj] = acc[r] + b_ada[l * MODW + jj];
}
__global__ void k_rope_table(float2* __restrict__ ROPE) {
    int i = blockIdx.x * 256 + threadIdx.x;
    if (i < 1024) { int pos = i >> 4, f = i & 15; float inv = powf(10000.f, -(float)f / 16.f); float ang = (float)pos * inv; ROPE[i] = make_float2(cosf(ang), sinf(ang)); }
}
DEVI void transpose_item(const float* __restrict__ W, int ldw, int K, int N, bf16_t* __restrict__ WT, float* scr, int item, int lane) {
    const int nblk = N / 32, kb = item / nblk, nb = item % nblk, k0 = 64 * kb, n0 = 32 * nb;
#pragma unroll 8
    for (int i = 0; i < 32; ++i) { const int kk = 2 * i + (lane >> 5); scr[kk * 33 + (lane & 31)] = W[(size_t)(k0 + kk) * ldw + n0 + (lane & 31)]; }
    asm volatile("s_waitcnt lgkmcnt(0)" ::: "memory");
    const int c = lane & 7;
#pragma unroll
    for (int j = 0; j < 4; ++j) {
        const int n = (lane >> 3) + 8 * j; const float* s = scr + (8 * c) * 33 + n;
        uint4 o; o.x = pk2(s[0 * 33], s[1 * 33]); o.y = pk2(s[2 * 33], s[3 * 33]); o.z = pk2(s[4 * 33], s[5 * 33]); o.w = pk2(s[6 * 33], s[7 * 33]);
        *(uint4*)(WT + (size_t)(n0 + n) * K + k0 + 8 * c) = o;
    }
    asm volatile("s_waitcnt lgkmcnt(0)" ::: "memory");
}
__global__ __launch_bounds__(256) void k_transpose(const float* __restrict__ W, int ldw, int K, int N, bf16_t* __restrict__ WT) {
    __shared__ float scr[4][64 * 33];
    const int wave = threadIdx.x >> 6, lane = threadIdx.x & 63;
    const int gw = blockIdx.x * 4 + wave, ngw = gridDim.x * 4;
    const int nitems = (K / 64) * (N / 32);
    for (int it = gw; it < nitems; it += ngw) transpose_item(W, ldw, K, N, WT, scr[wave], it, lane);
}

DEVI void norm_row(const float* __restrict__ xrow, int b, const float* __restrict__ mod_l, const float* __restrict__ npre, const float* __restrict__ wg,
                   bf16_t* __restrict__ hrow, float* __restrict__ grow, int lane) {
    float4 v[8]; float ss = 0.f;
#pragma unroll
    for (int j = 0; j < 8; ++j) { v[j] = ((const float4*)xrow)[lane + 64 * j]; ss += v[j].x * v[j].x + v[j].y * v[j].y + v[j].z * v[j].z + v[j].w * v[j].w; }
    ss = wave_sum(ss);
    const float rstd = rsqrtf(ss * (1.f / DM) + EPS);
    const float* shift = mod_l + (size_t)b * MODW; const float* scale = shift + DM;
    float g[16];
#pragma unroll
    for (int i = 0; i < 16; ++i) g[i] = 0.f;
#pragma unroll
    for (int j = 0; j < 8; ++j) {
        const int k0 = 4 * (lane + 64 * j);
        const float4 w = *(const float4*)(npre + k0), sh = *(const float4*)(shift + k0), sc = *(const float4*)(scale + k0);
        float h[4];
        h[0] = v[j].x * rstd * w.x * (1.f + sc.x) + sh.x; h[1] = v[j].y * rstd * w.y * (1.f + sc.y) + sh.y;
        h[2] = v[j].z * rstd * w.z * (1.f + sc.z) + sh.z; h[3] = v[j].w * rstd * w.w * (1.f + sc.w) + sh.w;
        uint2 o; o.x = pk2(h[0], h[1]); o.y = pk2(h[2], h[3]);
        *(uint2*)(hrow + k0) = o;
#pragma unroll
        for (int e = 0; e < 4; ++e) {
            const float4* wr = (const float4*)(wg + (size_t)(k0 + e) * INC);
#pragma unroll
            for (int q = 0; q < 4; ++q) { const float4 ww = wr[q]; g[4 * q] += h[e] * ww.x; g[4 * q + 1] += h[e] * ww.y; g[4 * q + 2] += h[e] * ww.z; g[4 * q + 3] += h[e] * ww.w; }
        }
        asm volatile("" ::: "memory");
    }
#pragma unroll
    for (int i = 0; i < 16; ++i) g[i] = wave_sum(g[i]);
    if (lane == 0) {
#pragma unroll
        for (int q = 0; q < 4; ++q) ((float4*)grow)[q] = make_float4(g[4 * q], g[4 * q + 1], g[4 * q + 2], g[4 * q + 3]);
    }
}
__global__ __launch_bounds__(256) void k_norm(const float* __restrict__ xlat, const float* __restrict__ xctx, const float* __restrict__ mod_l, const float* __restrict__ npre,
                                              const float* __restrict__ wg, bf16_t* __restrict__ H, float* __restrict__ GATES) {
    const int wave = threadIdx.x >> 6, lane = threadIdx.x & 63;
    const int gw = blockIdx.x * 4 + wave, ngw = gridDim.x * 4;
    for (int row = gw; row < NTOK; row += ngw) {
        const bool isl = row < NLAT;
        const float* xr = isl ? xlat + (size_t)row * DM : xctx + (size_t)(row - NLAT) * DM;
        const int b = isl ? row / SEQ : 8;
        norm_row(xr, b, mod_l, npre, wg, H + (size_t)row * DM, GATES + (size_t)row * 16, lane);
    }
}

__global__ __launch_bounds__(256) void k_gemm_naive(const bf16_t* __restrict__ A, const bf16_t* __restrict__ Bt, bf16_t* __restrict__ C, int M, int N, int K) {
    __shared__ float As[32][65], Bs[32][65];
    const int tx = threadIdx.x & 15, ty = threadIdx.x >> 4;
    const int m0 = blockIdx.y * 64, n0 = blockIdx.x * 64;
    float acc[4][4];
#pragma unroll
    for (int i = 0; i < 4; ++i)
#pragma unroll
        for (int j = 0; j < 4; ++j) acc[i][j] = 0.f;
    const int lr = threadIdx.x >> 2, lk = (threadIdx.x & 3) * 8;
    for (int k0 = 0; k0 < K; k0 += 32) {
        const uint4 av = *(const uint4*)(A + (size_t)(m0 + lr) * K + k0 + lk);
        const uint4 bv = *(const uint4*)(Bt + (size_t)(n0 + lr) * K + k0 + lk);
        const unsigned aw[4] = {av.x, av.y, av.z, av.w}, bw[4] = {bv.x, bv.y, bv.z, bv.w};
#pragma unroll
        for (int i = 0; i < 4; ++i) {
            As[lk + 2 * i][lr] = __uint_as_float(aw[i] << 16); As[lk + 2 * i + 1][lr] = __uint_as_float(aw[i] & 0xffff0000u);
            Bs[lk + 2 * i][lr] = __uint_as_float(bw[i] << 16); Bs[lk + 2 * i + 1][lr] = __uint_as_float(bw[i] & 0xffff0000u);
        }
        __syncthreads();
#pragma unroll 8
        for (int kk = 0; kk < 32; ++kk) {
            float a[4], b[4];
#pragma unroll
            for (int i = 0; i < 4; ++i) { a[i] = As[kk][ty * 4 + i]; b[i] = Bs[kk][tx * 4 + i]; }
#pragma unroll
            for (int i = 0; i < 4; ++i)
#pragma unroll
                for (int j = 0; j < 4; ++j) acc[i][j] += a[i] * b[j];
        }
        __syncthreads();
    }
#pragma unroll
    for (int i = 0; i < 4; ++i) {
        uint2 o; o.x = pk2(acc[i][0], acc[i][1]); o.y = pk2(acc[i][2], acc[i][3]);
        *(uint2*)(C + (size_t)(m0 + ty * 4 + i) * N + n0 + tx * 4) = o;
    }
}

__global__ __launch_bounds__(256) void k_rope_apply(bf16_t* __restrict__ P, const float2* __restrict__ ROPE) {
    const size_t total = (size_t)NLAT * 1024;
    for (size_t i = (size_t)blockIdx.x * 256 + threadIdx.x; i < total; i += (size_t)gridDim.x * 256) {
        const int row = (int)(i >> 10), p = (int)(i & 1023);
        const int t = row % SEQ;
        const int ip = p & 31;
        const int pos = (ip < 16) ? (t >> 6) : (t & 63);
        const float2 cs = ROPE[pos * 16 + (ip & 15)];
        unsigned* ptr = (unsigned*)(P + (size_t)row * NP + 2 * p);
        const unsigned w = *ptr;
        const float x1 = __uint_as_float(w << 16), x2 = __uint_as_float(w & 0xffff0000u);
        *ptr = pk2(x1 * cs.x - x2 * cs.y, x1 * cs.y + x2 * cs.x);
    }
}

template <bool CTXQ>
__global__ __launch_bounds__(128) void k_attn_naive(const bf16_t* __restrict__ P, bf16_t* __restrict__ Y, const float* __restrict__ lq1, const float* __restrict__ lk1,
                                                    const float* __restrict__ lq2, const float* __restrict__ lk2, const float* __restrict__ subln, float lam_init) {
    __shared__ float sb[2][2][2304];
    __shared__ float qb[2][128];
    const int w = threadIdx.x >> 6, lane = threadIdx.x & 63;
    const int t = blockIdx.x * 2 + w, hh = blockIdx.y, b = blockIdx.z;
    const int nkeys = CTXQ ? CTXL : (CTXL + SEQ);
    const size_t qrow = CTXQ ? (size_t)(NLAT + b * CTXL + t) : (size_t)(b * SEQ + t);
    const float lam = expf(wave_sum(lq1[lane] * lk1[lane])) - expf(wave_sum(lq2[lane] * lk2[lane])) + lam_init;
    qb[w][lane] = bf2f(P[qrow * NP + C_QA + hh * 128 + lane]);
    qb[w][64 + lane] = bf2f(P[qrow * NP + C_QA + hh * 128 + 64 + lane]);
    __syncthreads();
    float mx1 = -INFINITY, mx2 = -INFINITY;
    for (int j = lane; j < nkeys; j += 64) {
        const size_t kr = (j < CTXL) ? (size_t)(NLAT + b * CTXL + j) : (size_t)(b * SEQ + j - CTXL);
        const uint4* kp = (const uint4*)(P + kr * NP + C_KA + hh * 128);
        float s1 = 0.f, s2 = 0.f;
#pragma unroll
        for (int q = 0; q < 8; ++q) {
            const uint4 a = kp[q], c = kp[8 + q];
            const unsigned aw[4] = {a.x, a.y, a.z, a.w}, cw[4] = {c.x, c.y, c.z, c.w};
#pragma unroll
            for (int i = 0; i < 4; ++i) {
                s1 += qb[w][q * 8 + 2 * i] * __uint_as_float(aw[i] << 16) + qb[w][q * 8 + 2 * i + 1] * __uint_as_float(aw[i] & 0xffff0000u);
                s2 += qb[w][64 + q * 8 + 2 * i] * __uint_as_float(cw[i] << 16) + qb[w][64 + q * 8 + 2 * i + 1] * __uint_as_float(cw[i] & 0xffff0000u);
            }
        }
        s1 *= 0.125f; s2 *= 0.125f;
        sb[w][0][j] = s1; sb[w][1][j] = s2; mx1 = fmaxf(mx1, s1); mx2 = fmaxf(mx2, s2);
    }
    mx1 = wave_max(mx1); mx2 = wave_max(mx2);
    float l1 = 0.f, l2 = 0.f;
    for (int j = lane; j < nkeys; j += 64) {
        const float p1 = expf(sb[w][0][j] - mx1), p2 = expf(sb[w][1][j] - mx2);
        sb[w][0][j] = p1; sb[w][1][j] = p2; l1 += p1; l2 += p2;
    }
    l1 = wave_sum(l1); l2 = wave_sum(l2);
    const float r1 = 1.f / l1, r2 = lam / l2;
    for (int j = lane; j < nkeys; j += 64) sb[w][0][j] = sb[w][0][j] * r1 - sb[w][1][j] * r2;
    __syncthreads();
    float o0 = 0.f, o1 = 0.f;
    for (int j = 0; j < nkeys; ++j) {
        const size_t kr = (j < CTXL) ? (size_t)(NLAT + b * CTXL + j) : (size_t)(b * SEQ + j - CTXL);
        const unsigned vv = *(const unsigned*)(P + kr * NP + C_VA + hh * 128 + 2 * lane);
        const float a = sb[w][0][j];
        o0 += a * __uint_as_float(vv << 16); o1 += a * __uint_as_float(vv & 0xffff0000u);
    }
    const float ss = wave_sum(o0 * o0 + o1 * o1);
    const float r = rsqrtf(ss * (1.f / 128.f) + EPS) * (1.f - lam_init);
    const unsigned gg = *(const unsigned*)(P + qrow * NP + C_GA + hh * 128 + 2 * lane);
    const float g0 = __uint_as_float(gg << 16), g1 = __uint_as_float(gg & 0xffff0000u);
    const float y0 = o0 * r * subln[2 * lane] * silu_f(g0), y1 = o1 * r * subln[2 * lane + 1] * silu_f(g1);
    *(unsigned*)(Y + qrow * DM + hh * 128 + 2 * lane) = pk2(y0, y1);
}

constexpr int QS = 129;
constexpr int MLSTM_LDS_FLOATS = 2 * 64 * QS + 64 * 64 + 64 * 256 + 64 * 7 + 128 + 8;
__global__ __launch_bounds__(256) void k_mlstm_naive(const bf16_t* __restrict__ P, const float* __restrict__ GATES, bf16_t* __restrict__ HM, const float* __restrict__ conv_w,
                                                     const float* __restrict__ conv_b, const float* __restrict__ i_bias, const float* __restrict__ f_bias) {
    extern __shared__ float smem[];
    float* qs = smem; float* ks = qs + 64 * QS; float* S = ks + 64 * QS; float* vs = S + 64 * 64;
    float* bcum = vs + 64 * 256; float* ig = bcum + 64; float* lfv = ig + 64; float* mrow = lfv + 64; float* sc = mrow + 64; float* wk = sc + 64; float* den = wk + 64;
    float* nvec = den + 64; float* scal = nvec + 128;
    const int unit = blockIdx.x, dir = unit & 1, head = (unit >> 1) & 3, b = unit >> 3;
    const int tid = threadIdx.x;
    float C[128];
#pragma unroll
    for (int d = 0; d < 128; ++d) C[d] = 0.f;
    if (tid < 128) nvec[tid] = 0.f;
    float m = 0.f;
    const int ch = tid;
    const int cidx = (ch < 128) ? head * 128 + ch : 512 + head * 128 + (ch - 128);
    const int pcol = (ch < 128) ? C_QB + head * 128 + ch : C_KB + head * 128 + (ch - 128);
    const float cw0 = conv_w[cidx], cw1 = conv_w[1024 + cidx], cw2 = conv_w[2048 + cidx], cb = conv_b[cidx];
    __syncthreads();
    for (int c = 0; c < 36; ++c) {
        const bool isctx = c < 4; const int T = isctx ? CTXL : SEQ; const int cc = isctx ? c : c - 4;
        const int rowbase = isctx ? NLAT + b * CTXL : b * SEQ;
        const int tstart = dir ? (T - 1 - 64 * cc) : 64 * cc; const int tstep = dir ? -1 : 1;
        if (tid < 64) {
            const int t = tstart + tstep * tid; const size_t row = (size_t)(rowbase + t);
            const float gi = GATES[row * 16 + dir * 4 + head] + i_bias[dir * 4 + head];
            const float gf = GATES[row * 16 + 8 + dir * 4 + head] + f_bias[dir * 4 + head];
            const float igv = 15.f * tanhf(gi * (1.f / 15.f));
            const float fc = 15.f * tanhf(gf * (1.f / 15.f));
            ig[tid] = igv; lfv[tid] = fminf(fc, 0.f) - log1pf(expf(-fabsf(fc)));
        }
        for (int l = 0; l < 64; ++l) {
            const int t = tstart + tstep * l;
            const float x0 = (t > 0) ? bf2f(P[(size_t)(rowbase + t - 1) * NP + pcol]) : 0.f;
            const float x1 = bf2f(P[(size_t)(rowbase + t) * NP + pcol]);
            const float x2 = (t < T - 1) ? bf2f(P[(size_t)(rowbase + t + 1) * NP + pcol]) : 0.f;
            const float v = silu_f(cb + cw0 * x0 + cw1 * x1 + cw2 * x2);
            if (ch < 128) qs[l * QS + ch] = v; else ks[l * QS + ch - 128] = v * 0.08838834764831845f;
            vs[l * 256 + tid] = bf2f(P[(size_t)(rowbase + t) * NP + C_VB + head * 256 + tid]);
        }
        __syncthreads();
        if (tid == 0) { float a = 0.f; for (int l = 0; l < 64; ++l) { a += lfv[l]; bcum[l] = a; } }
        __syncthreads();
        if (tid < 64) {
            const float bl = bcum[tid]; float mx = bl + m;
            for (int s = 0; s <= tid; ++s) mx = fmaxf(mx, bl - bcum[s] + ig[s]);
            mrow[tid] = mx; sc[tid] = expf(bl + m - mx);
        }
        if (tid == 64) {
            const float blast = bcum[63]; float mn = blast + m;
            for (int s = 0; s < 64; ++s) mn = fmaxf(mn, blast - bcum[s] + ig[s]);
            scal[0] = mn; scal[1] = expf(blast + m - mn);
        }
        __syncthreads();
        const float m_new = scal[0], decay = scal[1];
        if (tid < 64) wk[tid] = expf(bcum[63] - bcum[tid] + ig[tid] - m_new);
        for (int idx = tid; idx < 4096; idx += 256) {
            const int l = idx >> 6, s = idx & 63; float val = 0.f;
            if (s <= l) { float dot = 0.f; for (int d = 0; d < 128; ++d) dot += qs[l * QS + d] * ks[s * QS + d]; val = dot * expf(bcum[l] - bcum[s] + ig[s] - mrow[l]); }
            S[idx] = val;
        }
        __syncthreads();
        if (tid < 64) {
            float dn = 0.f; for (int d = 0; d < 128; ++d) dn += qs[tid * QS + d] * nvec[d];
            dn *= sc[tid]; for (int s = 0; s < 64; ++s) dn += S[tid * 64 + s];
            den[tid] = fmaxf(fabsf(dn), expf(-mrow[tid]));
        }
        __syncthreads();
        for (int l = 0; l < 64; ++l) {
            float a = 0.f;
#pragma unroll
            for (int d = 0; d < 128; ++d) a += qs[l * QS + d] * C[d];
            a *= sc[l];
            for (int s = 0; s <= l; ++s) a += S[l * 64 + s] * vs[s * 256 + tid];
            const int t = tstart + tstep * l;
            HM[((size_t)dir * NTOK + rowbase + t) * 1024 + head * 256 + tid] = f2bf(a / den[l]);
        }
#pragma unroll
        for (int d = 0; d < 128; ++d) C[d] *= decay;
        for (int s = 0; s < 64; ++s) {
            const float wv = wk[s] * vs[s * 256 + tid];
#pragma unroll
            for (int d = 0; d < 128; ++d) C[d] += wv * ks[s * QS + d];
        }
        if (tid < 128) { float a = decay * nvec[tid]; for (int s = 0; s < 64; ++s) a += wk[s] * ks[s * QS + tid]; nvec[tid] = a; }
        m = m_new;
        __syncthreads();
    }
}

__global__ __launch_bounds__(256) void k_finish_mlstm(const bf16_t* __restrict__ P, const bf16_t* __restrict__ HM, const float* __restrict__ mnorm, bf16_t* __restrict__ Y) {
    const int wave = threadIdx.x >> 6, lane = threadIdx.x & 63;
    const int gw = blockIdx.x * 4 + wave, ngw = gridDim.x * 4;
    for (int row = gw; row < NTOK; row += ngw) {
#pragma unroll
        for (int head = 0; head < 4; ++head) {
            const int col = head * 256 + 4 * lane;
            const uint2 a = *(const uint2*)(HM + (size_t)row * 1024 + col), c = *(const uint2*)(HM + ((size_t)NTOK + row) * 1024 + col);
            float h[4];
            h[0] = __uint_as_float(a.x << 16) + __uint_as_float(c.x << 16); h[1] = __uint_as_float(a.x & 0xffff0000u) + __uint_as_float(c.x & 0xffff0000u);
            h[2] = __uint_as_float(a.y << 16) + __uint_as_float(c.y << 16); h[3] = __uint_as_float(a.y & 0xffff0000u) + __uint_as_float(c.y & 0xffff0000u);
            const float ss = wave_sum(h[0] * h[0] + h[1] * h[1] + h[2] * h[2] + h[3] * h[3]);
            const float r = rsqrtf(ss * (1.f / 256.f) + EPS);
            const uint2 ov = *(const uint2*)(P + (size_t)row * NP + C_OB + col), gv = *(const uint2*)(P + (size_t)row * NP + C_GB + col);
            const float o[4] = {__uint_as_float(ov.x << 16), __uint_as_float(ov.x & 0xffff0000u), __uint_as_float(ov.y << 16), __uint_as_float(ov.y & 0xffff0000u)};
            const float g[4] = {__uint_as_float(gv.x << 16), __uint_as_float(gv.x & 0xffff0000u), __uint_as_float(gv.y << 16), __uint_as_float(gv.y & 0xffff0000u)};
            const float4 w = *(const float4*)(mnorm + col);
            const float wv[4] = {w.x, w.y, w.z, w.w};
            float y[4];
#pragma unroll
            for (int e = 0; e < 4; ++e) y[e] = h[e] * r * wv[e] * sigmoid_f(o[e]) * silu_f(g[e]);
            uint2 out; out.x = pk2(y[0], y[1]); out.y = pk2(y[2], y[3]);
            *(uint2*)(Y + (size_t)row * DM + 1024 + col) = out;
        }
    }
}

__global__ __launch_bounds__(256) void k_post(const float* xlat, const float* xctx, const bf16_t* __restrict__ Y2, const float* __restrict__ mod_l,
                                              const float* __restrict__ npost, float* olat, float* octx, int nrows) {
    const int wave = threadIdx.x >> 6, lane = threadIdx.x & 63;
    const int gw = blockIdx.x * 4 + wave, ngw = gridDim.x * 4;
    for (int row = gw; row < nrows; row += ngw) {
        const bool isl = row < NLAT;
        const float* xr = isl ? xlat + (size_t)row * DM : xctx + (size_t)(row - NLAT) * DM;
        float* orow = isl ? olat + (size_t)row * DM : octx + (size_t)(row - NLAT) * DM;
        const int b = isl ? row / SEQ : 8;
        const float* gate = mod_l + (size_t)b * MODW + 2 * DM;
        float y[8][4]; float ss = 0.f;
#pragma unroll
        for (int j = 0; j < 8; ++j) {
            const uint2 a = *(const uint2*)(Y2 + (size_t)row * DM + 4 * (lane + 64 * j));
            y[j][0] = __uint_as_float(a.x << 16); y[j][1] = __uint_as_float(a.x & 0xffff0000u); y[j][2] = __uint_as_float(a.y << 16); y[j][3] = __uint_as_float(a.y & 0xffff0000u);
            ss += y[j][0] * y[j][0] + y[j][1] * y[j][1] + y[j][2] * y[j][2] + y[j][3] * y[j][3];
        }
        ss = wave_sum(ss);
        const float rstd = rsqrtf(ss * (1.f / DM) + EPS);
#pragma unroll
        for (int j = 0; j < 8; ++j) {
            const int k0 = 4 * (lane + 64 * j);
            const float4 xv = *(const float4*)(xr + k0), gt = *(const float4*)(gate + k0), w = *(const float4*)(npost + k0);
            float4 o;
            o.x = xv.x + gt.x * (y[j][0] * rstd * w.x); o.y = xv.y + gt.y * (y[j][1] * rstd * w.y);
            o.z = xv.z + gt.z * (y[j][2] * rstd * w.z); o.w = xv.w + gt.w * (y[j][3] * rstd * w.w);
            *(float4*)(orow + k0) = o;
        }
    }
}

extern "C" void kernel_launch(void* const* d_in, const int* in_sizes, int n_in, void* d_out, int out_size, void* d_ws, size_t ws_size, hipStream_t stream) {
    (void)in_sizes; (void)n_in; (void)out_size; (void)ws_size;
    const float* x = (const float*)d_in[0]; const float* c = (const float*)d_in[1]; const float* ctx = (const float*)d_in[2]; const float* c_ctx = (const float*)d_in[3];
    const float* w_ada = (const float*)d_in[4]; const float* b_ada = (const float*)d_in[5]; const float* norm_pre = (const float*)d_in[6]; const float* norm_post = (const float*)d_in[7];
    const float* w_in = (const float*)d_in[8]; const float* w_out = (const float*)d_in[9];
    const float* lq1 = (const float*)d_in[10]; const float* lk1 = (const float*)d_in[11]; const float* lq2 = (const float*)d_in[12]; const float* lk2 = (const float*)d_in[13];
    const float* subln = (const float*)d_in[14]; const float* conv_w = (const float*)d_in[15]; const float* conv_b = (const float*)d_in[16];
    const float* i_bias = (const float*)d_in[17]; const float* f_bias = (const float*)d_in[18]; const float* mnorm = (const float*)d_in[19];
    float* out = (float*)d_out; unsigned char* ws = (unsigned char*)d_ws;
    float* MOD = (float*)(ws + WS_MOD); float* SC = (float*)(ws + WS_SC); float2* ROPE = (float2*)(ws + WS_ROPE); float* GATES = (float*)(ws + WS_GATES);
    bf16_t* WOUT = (bf16_t*)(ws + WS_WOUT); bf16_t* WIN = (bf16_t*)(ws + WS_WIN); float* XC = (float*)(ws + WS_XC);
    bf16_t* H = (bf16_t*)(ws + WS_H); bf16_t* HM = (bf16_t*)(ws + WS_HM); bf16_t* P = (bf16_t*)(ws + WS_P);
    bf16_t* Y = H; bf16_t* Y2 = HM;

    const size_t mlstm_lds = (size_t)MLSTM_LDS_FLOATS * 4;
    (void)hipFuncSetAttribute((const void*)k_mlstm_naive, hipFuncAttributeMaxDynamicSharedMemorySize, (int)mlstm_lds);

    k_silu_c<<<(9 * DM + 255) / 256, 256, 0, stream>>>(c, c_ctx, SC);
    k_mod<<<2 * MODW / 256, 256, 0, stream>>>(SC, w_ada, b_ada, MOD);
    k_rope_table<<<4, 256, 0, stream>>>(ROPE);
    for (int l = 0; l < 2; ++l) k_transpose<<<1024, 256, 0, stream>>>(w_out + (size_t)l * DM * DM, DM, DM, DM, WOUT + (size_t)l * DM * DM);

    for (int l = 0; l < 2; ++l) {
        const float lam_init = (float)(0.8 - 0.6 * exp(-0.3 * (double)l));
        const float* mod_l = MOD + (size_t)l * 9 * MODW;
        const float* w_in_l = w_in + (size_t)l * DM * INC;
        k_transpose<<<2048, 256, 0, stream>>>(w_in_l, INC, DM, NP, WIN);
        k_norm<<<2048, 256, 0, stream>>>(l == 0 ? x : out, l == 0 ? ctx : XC, mod_l, norm_pre + l * DM, w_in_l + NP, H, GATES);
        k_gemm_naive<<<dim3(NP / 64, NTOK / 64), 256, 0, stream>>>(H, WIN, P, NTOK, NP, DM);
        k_rope_apply<<<4096, 256, 0, stream>>>(P, ROPE);
        k_attn_naive<false><<<dim3(SEQ / 2, 8, NBATCH), 128, 0, stream>>>(P, Y, lq1 + l * 64, lk1 + l * 64, lq2 + l * 64, lk2 + l * 64, subln + l * 128, lam_init);
        if (l == 0) k_attn_naive<true><<<dim3(CTXL / 2, 8, NBATCH), 128, 0, stream>>>(P, Y, lq1 + l * 64, lk1 + l * 64, lq2 + l * 64, lk2 + l * 64, subln + l * 128, lam_init);
        k_mlstm_naive<<<64, 256, mlstm_lds, stream>>>(P, GATES, HM, conv_w + (size_t)l * 3 * 1024, conv_b + l * 1024, i_bias + l * 8, f_bias + l * 8);
        k_finish_mlstm<<<2048, 256, 0, stream>>>(P, HM, mnorm + l * 1024, Y);
        k_gemm_naive<<<dim3(DM / 64, NTOK / 64), 256, 0, stream>>>(Y, WOUT + (size_t)l * DM * DM, Y2, NTOK, DM, DM);
        k_post<<<2048, 256, 0, stream>>>(l == 0 ? x : out, l == 0 ? ctx : XC, Y2, mod_l, norm_post + l * DM, out, XC, l == 0 ? NTOK : NLAT);
    }
}
```

```cpp
#include <hip/hip_runtime.h>
#include <stdint.h>
#include <math.h>

#define DEVI __device__ __forceinline__
typedef unsigned short bf16_t;

constexpr int DM = 2048, NBATCH = 8, SEQ = 2048, CTXL = 256;
constexpr int NLAT = NBATCH * SEQ, NCTX = NBATCH * CTXL, NTOK = NLAT + NCTX;
constexpr int INC = 8208, NP = 8192, MODW = 6144;
constexpr int C_QA = 0, C_KA = 1024, C_VA = 2048, C_GA = 3072, C_QB = 4096, C_KB = 4608, C_VB = 5120, C_OB = 6144, C_GB = 7168;
constexpr float EPS = 1e-6f;

constexpr size_t MiB = (size_t)1 << 20;
constexpr size_t WS_CTL = 0, WS_MOD = 1 * MiB, WS_SC = WS_MOD + 512 * 1024, WS_ROPE = 2 * MiB, WS_GATES = 3 * MiB, WS_WOUT = 8 * MiB,
                 WS_WIN = 24 * MiB, WS_XC = 56 * MiB, WS_H = 72 * MiB, WS_HM = 144 * MiB, WS_P = 216 * MiB, WS_END = 504 * MiB;

DEVI float bf2f(bf16_t v) { return __uint_as_float(((unsigned)v) << 16); }
DEVI bf16_t f2bf(float f) { unsigned u = __float_as_uint(f); return (bf16_t)((u + 0x7fffu + ((u >> 16) & 1u)) >> 16); }
DEVI unsigned pk2(float lo, float hi) { return (unsigned)f2bf(lo) | ((unsigned)f2bf(hi) << 16); }
DEVI float wave_sum(float v) {
#pragma unroll
    for (int o = 32; o > 0; o >>= 1) v += __shfl_xor(v, o);
    return v;
}
DEVI float wave_max(float v) {
#pragma unroll
    for (int o = 32; o > 0; o >>= 1) v = fmaxf(v, __shfl_xor(v, o));
    return v;
}
DEVI float silu_f(float x) { return x / (1.f + expf(-x)); }
DEVI float sigmoid_f(float x) { return 1.f / (1.f + expf(-x)); }

__global__ void k_silu_c(const float* __restrict__ c, const float* __restrict__ c_ctx, float* __restrict__ SC) {
    int i = blockIdx.x * 256 + threadIdx.x;
    if (i < 9 * DM) { float v = (i < 8 * DM) ? c[i] : c_ctx[i - 8 * DM]; SC[i] = silu_f(v); }
}
__global__ __launch_bounds__(256) void k_mod(const float* __restrict__ SC, const float* __restrict__ w_ada, const float* __restrict__ b_ada, float* __restrict__ MOD) {
    int j = blockIdx.x * 256 + threadIdx.x;
    int l = j / MODW, jj = j % MODW;
    const float* w = w_ada + (size_t)l * DM * MODW + jj;
    float acc[9];
#pragma unroll
    for (int r = 0; r < 9; ++r) acc[r] = 0.f;
    for (int k = 0; k < DM; ++k) {
        float wv = w[(size_t)k * MODW];
#pragma unroll
        for (int r = 0; r < 9; ++r) acc[r] += SC[r * DM + k] * wv;
    }
#pragma unroll
    for (int r = 0; r < 9; ++r) MOD[(size_t)(l * 9 + r) * MODW + jj] = acc[r] + b_ada[l * MODW + jj];
}
__global__ void k_rope_table(float2* __restrict__ ROPE) {
    int i = blockIdx.x * 256 + threadIdx.x;
    if (i < 1024) { int pos = i >> 4, f = i & 15; float inv = powf(10000.f, -(float)f / 16.f); float ang = (float)pos * inv; ROPE[i] = make_float2(cosf(ang), sinf(ang)); }
}
DEVI void transpose_item(const float* __restrict__ W, int ldw, int K, int N, bf16_t* __restrict__ WT, float* scr, int item, int lane) {
    const int nblk = N / 32, kb = item / nblk, nb = item % nblk, k0 = 64 * kb, n0 = 32 * nb;
#pragma unroll 8
    for (int i = 0; i < 32; ++i) { const int kk = 2 * i + (lane >> 5); scr[kk * 33 + (lane & 31)] = W[(size_t)(k0 + kk) * ldw + n0 + (lane & 31)]; }
    asm volatile("s_waitcnt lgkmcnt(0)" ::: "memory");
    const int c = lane & 7;
#pragma unroll
    for (int j = 0; j < 4; ++j) {
        const int n = (lane >> 3) + 8 * j; const float* s = scr + (8 * c) * 33 + n;
        uint4 o; o.x = pk2(s[0 * 33], s[1 * 33]); o.y = pk2(s[2 * 33], s[3 * 33]); o.z = pk2(s[4 * 33], s[5 * 33]); o.w = pk2(s[6 * 33], s[7 * 33]);
        *(uint4*)(WT + (size_t)(n0 + n) * K + k0 + 8 * c) = o;
    }
    asm volatile("s_waitcnt lgkmcnt(0)" ::: "memory");
}
__global__ __launch_bounds__(256) void k_transpose(const float* __restrict__ W, int ldw, int K, int N, bf16_t* __restrict__ WT) {
    __shared__ float scr[4][64 * 33];
    const int wave = threadIdx.x >> 6, lane = threadIdx.x & 63;
    const int gw = blockIdx.x * 4 + wave, ngw = gridDim.x * 4;
    const int nitems = (K / 64) * (N / 32);
    for (int it = gw; it < nitems; it += ngw) transpose_item(W, ldw, K, N, WT, scr[wave], it, lane);
}

DEVI void norm_row(const float* __restrict__ xrow, int b, const float* __restrict__ mod_l, const float* __restrict__ npre, const float* __restrict__ wg,
                   bf16_t* __restrict__ hrow, float* __restrict__ grow, int lane) {
    float4 v[8]; float ss = 0.f;
#pragma unroll
    for (int j = 0; j < 8; ++j) { v[j] = ((const float4*)xrow)[lane + 64 * j]; ss += v[j].x * v[j].x + v[j].y * v[j].y + v[j].z * v[j].z + v[j].w * v[j].w; }
    ss = wave_sum(ss);
    const float rstd = rsqrtf(ss * (1.f / DM) + EPS);
    const float* shift = mod_l + (size_t)b * MODW; const float* scale = shift + DM;
    float g[16];
#pragma unroll
    for (int i = 0; i < 16; ++i) g[i] = 0.f;
#pragma unroll
    for (int j = 0; j < 8; ++j) {
        const int k0 = 4 * (lane + 64 * j);
        const float4 w = *(const float4*)(npre + k0), sh = *(const float4*)(shift + k0), sc = *(const float4*)(scale + k0);
        float h[4];
        h[0] = v[j].x * rstd * w.x * (1.f + sc.x) + sh.x; h[1] = v[j].y * rstd * w.y * (1.f + sc.y) + sh.y;
        h[2] = v[j].z * rstd * w.z * (1.f + sc.z) + sh.z; h[3] = v[j].w * rstd * w.w * (1.f + sc.w) + sh.w;
        uint2 o; o.x = pk2(h[0], h[1]); o.y = pk2(h[2], h[3]);
        *(uint2*)(hrow + k0) = o;
#pragma unroll
        for (int e = 0; e < 4; ++e) {
            const float4* wr = (const float4*)(wg + (size_t)(k0 + e) * INC);
#pragma unroll
            for (int q = 0; q < 4; ++q) { const float4 ww = wr[q]; g[4 * q] += h[e] * ww.x; g[4 * q + 1] += h[e] * ww.y; g[4 * q + 2] += h[e] * ww.z; g[4 * q + 3] += h[e] * ww.w; }
        }
        asm volatile("" ::: "memory");
    }
#pragma unroll
    for (int i = 0; i < 16; ++i) g[i] = wave_sum(g[i]);
    if (lane == 0) {
#pragma unroll
        for (int q = 0; q < 4; ++q) ((float4*)grow)[q] = make_float4(g[4 * q], g[4 * q + 1], g[4 * q + 2], g[4 * q + 3]);
    }
}
__global__ __launch_bounds__(256) void k_norm(const float* __restrict__ xlat, const float* __restrict__ xctx, const float* __restrict__ mod_l, const float* __restrict__ npre,
                                              const float* __restrict__ wg, bf16_t* __restrict__ H, float* __restrict__ GATES) {
    const int wave = threadIdx.x >> 6, lane = threadIdx.x & 63;
    const int gw = blockIdx.x * 4 + wave, ngw = gridDim.x * 4;
    for (int row = gw; row < NTOK; row += ngw) {
        const bool isl = row < NLAT;
        const float* xr = isl ? xlat + (size_t)row * DM : xctx + (size_t)(row - NLAT) * DM;
        const int b = isl ? row / SEQ : 8;
        norm_row(xr, b, mod_l, npre, wg, H + (size_t)row * DM, GATES + (size_t)row * 16, lane);
    }
}

__global__ __launch_bounds__(256) void k_gemm_naive(const bf16_t* __restrict__ A, const bf16_t* __restrict__ Bt, bf16_t* __restrict__ C, int M, int N, int K) {
    __shared__ float As[32][65], Bs[32][65];
    const int tx = threadIdx.x & 15, ty = threadIdx.x >> 4;
    const int m0 = blockIdx.y * 64, n0 = blockIdx.x * 64;
    float acc[4][4];
#pragma unroll
    for (int i = 0; i < 4; ++i)
#pragma unroll
        for (int j = 0; j < 4; ++j) acc[i][j] = 0.f;
    const int lr = threadIdx.x >> 2, lk = (threadIdx.x & 3) * 8;
    for (int k0 = 0; k0 < K; k0 += 32) {
        const uint4 av = *(const uint4*)(A + (size_t)(m0 + lr) * K + k0 + lk);
        const uint4 bv = *(const uint4*)(Bt + (size_t)(n0 + lr) * K + k0 + lk);
        const unsigned aw[4] = {av.x, av.y, av.z, av.w}, bw[4] = {bv.x, bv.y, bv.z, bv.w};
#pragma unroll
        for (int i = 0; i < 4; ++i) {
            As[lk + 2 * i][lr] = __uint_as_float(aw[i] << 16); As[lk + 2 * i + 1][lr] = __uint_as_float(aw[i] & 0xffff0000u);
            Bs[lk + 2 * i][lr] = __uint_as_float(bw[i] << 16); Bs[lk + 2 * i + 1][lr] = __uint_as_float(bw[i] & 0xffff0000u);
        }
        __syncthreads();
#pragma unroll 8
        for (int kk = 0; kk < 32; ++kk) {
            float a[4], b[4];
#pragma unroll
            for (int i = 0; i < 4; ++i) { a[i] = As[kk][ty * 4 + i]; b[i] = Bs[kk][tx * 4 + i]; }
#pragma unroll
            for (int i = 0; i < 4; ++i)
#pragma unroll
                for (int j = 0; j < 4; ++j) acc[i][j] += a[i] * b[j];
        }
        __syncthreads();
    }
#pragma unroll
    for (int i = 0; i < 4; ++i) {
        uint2 o; o.x = pk2(acc[i][0], acc[i][1]); o.y = pk2(acc[i][2], acc[i][3]);
        *(uint2*)(C + (size_t)(m0 + ty * 4 + i) * N + n0 + tx * 4) = o;
    }
}

namespace pg8 {
#define PG8_LAS __attribute__((address_space(3)))
typedef unsigned short bf16_t;
typedef short bf16x8 __attribute__((ext_vector_type(8)));
typedef float f32x4 __attribute__((ext_vector_type(4)));
typedef unsigned u32x4 __attribute__((ext_vector_type(4)));
constexpr int BM = 256, BK = 64, HALF = 128, HTB = HALF * BK * 2  , STAGE_BYTES = 8 * HTB, NXCD = 8, WGM = 8;

__host__ __device__ __forceinline__ int lds_byte(int r, int c) { const int st = (r >> 4) * 2 + (c >> 5), rr = r & 15, cc = c & 31, ob = rr * 64 + cc * 2; return st * 1024 + (ob ^ (((ob >> 9) & 1) << 5)); }
__host__ __device__ __forceinline__ void stage_rc(int b, int& R, int& C) { const int st = b / 1024, sb = b % 1024, swz = sb ^ (((sb >> 9) & 1) << 5); R = (st >> 1) * 16 + swz / 64; C = (st & 1) * 32 + (swz % 64) / 2; }
__host__ __device__ __forceinline__ int perm32(int rho) { const int n = rho >> 4, i = rho & 15; return 8 * (i >> 2) + 4 * n + (i & 3); }

struct Unit { int pm, pn; };
struct Gemm { const bf16_t* A; const bf16_t* Bt; int M, N, K; };

struct StaticOrder {
    int nM, nN, nwg, G, c;
    __host__ __device__ void init(int M, int N, int G_, int c_) { nM = M / BM; nN = N / BM; nwg = nM * nN; G = G_; c = c_; }
    __host__ __device__ bool next(int i, Unit& u) const {
        const long L = (long)i * G + c; if (L >= nwg) return false;
        int wgid = (int)L; { const int q = nwg / NXCD, r = nwg % NXCD, xcd = wgid % NXCD, off = wgid / NXCD; wgid = (xcd < r ? xcd * (q + 1) : r * (q + 1) + (xcd - r) * q) + off; }
        const int nig = WGM * nN, gid = wgid / nig, fm = gid * WGM, gsz = (nM - fm) < WGM ? (nM - fm) : WGM;
        u.pm = fm + ((wgid % nig) % gsz); u.pn = (wgid % nig) / gsz; return true;
    }
    __device__ __forceinline__ void a_ready(const Unit&) const {}
    __device__ __forceinline__ void done(const Unit&) const {}
};

__device__ __forceinline__ unsigned cvt_pk_bf16(float lo, float hi) { unsigned r; asm volatile("v_cvt_pk_bf16_f32 %0, %1, %2" : "=v"(r) : "v"(lo), "v"(hi)); return r; }

struct EpiBf16 {
    static constexpr bool PERM = true, AFTER_DRAIN = false;
    bf16_t* O; int ldc;
    __device__ __forceinline__ void operator()(const f32x4 (&acc)[2][2][4][2], const Unit& u, int wr, int wc, int fr, int fq) const {
        const int row0 = u.pm * BM + wr * 64 + fr, col0 = u.pn * BM + wc * 32 + 8 * fq;
#pragma unroll
        for (int ai = 0; ai < 2; ++ai)
#pragma unroll
            for (int m = 0; m < 4; ++m) { bf16_t* rowp = O + (size_t)(row0 + ai * HALF + m * 16) * ldc + col0;
#pragma unroll
                for (int bj = 0; bj < 2; ++bj) { const f32x4 v0 = acc[ai][bj][m][0], v1 = acc[ai][bj][m][1];
                    u32x4 w; w.x = cvt_pk_bf16(v0[0], v0[1]); w.y = cvt_pk_bf16(v0[2], v0[3]); w.z = cvt_pk_bf16(v1[0], v1[1]); w.w = cvt_pk_bf16(v1[2], v1[3]);
                    *(u32x4*)(rowp + bj * HALF) = w; } }
    }
};
struct EpiInProj {
    static constexpr bool PERM = true, AFTER_DRAIN = false;
    bf16_t* O; int ldc; const float* rope;
    __device__ __forceinline__ void operator()(const f32x4 (&acc)[2][2][4][2], const Unit& u, int wr, int wc, int fr, int fq) const {
        const int row0 = u.pm * BM + wr * 64 + fr, col0 = u.pn * BM + wc * 32 + 8 * fq;
        const bool do_rope = (u.pn < 8) && (u.pm < 64);
#pragma unroll
        for (int ai = 0; ai < 2; ++ai)
#pragma unroll
            for (int m = 0; m < 4; ++m) { const int row = row0 + ai * HALF + m * 16; bf16_t* rowp = O + (size_t)row * ldc + col0;
                f32x4 cs01 = {1.f, 0.f, 1.f, 0.f}, cs23 = {1.f, 0.f, 1.f, 0.f};
                if (do_rope) { const int pos = (wc & 1) ? (row & 63) : ((row >> 6) & 31); const f32x4* rp = (const f32x4*)(rope + (size_t)(pos * 16 + 4 * fq) * 2); cs01 = rp[0]; cs23 = rp[1]; }
#pragma unroll
                for (int bj = 0; bj < 2; ++bj) { f32x4 v0 = acc[ai][bj][m][0], v1 = acc[ai][bj][m][1];
                    if (do_rope) {
                        const float a0 = v0[0] * cs01[0] - v0[1] * cs01[1], a1 = v0[0] * cs01[1] + v0[1] * cs01[0];
                        const float a2 = v0[2] * cs01[2] - v0[3] * cs01[3], a3 = v0[2] * cs01[3] + v0[3] * cs01[2];
                        const float b0 = v1[0] * cs23[0] - v1[1] * cs23[1], b1 = v1[0] * cs23[1] + v1[1] * cs23[0];
                        const float b2 = v1[2] * cs23[2] - v1[3] * cs23[3], b3 = v1[2] * cs23[3] + v1[3] * cs23[2];
                        v0 = (f32x4){a0, a1, a2, a3}; v1 = (f32x4){b0, b1, b2, b3};
                    }
                    u32x4 w; w.x = cvt_pk_bf16(v0[0], v0[1]); w.y = cvt_pk_bf16(v0[2], v0[3]); w.z = cvt_pk_bf16(v1[0], v1[1]); w.w = cvt_pk_bf16(v1[2], v1[3]);
                    *(u32x4*)(rowp + bj * HALF) = w; } }
    }
};

template <class Epi, class Sched, bool ALIGN_EPI = false, bool SP2 = false>
__device__ __forceinline__ void gemm_phase(PG8_LAS unsigned char* lds, const Gemm g, const Sched& S, const Epi& E) {
    const int tid = threadIdx.x, wid = __builtin_amdgcn_readfirstlane(tid >> 6), lane = tid & 63, wr = wid >> 2, wc = wid & 3, fr = lane & 15, fq = lane >> 4;
    const int K = g.K, nt = K / BK;
    unsigned voffA[2], voffB[2];
#pragma unroll
    for (int i = 0; i < 2; ++i) { int R, C; stage_rc(tid * 16 + i * 8192, R, C); const int Rb = Epi::PERM ? ((R & ~31) + perm32(R & 31)) : R;
        voffA[i] = (unsigned)(R * K + C) * 2u; voffB[i] = (unsigned)(Rb * K + C) * 2u; }
    const size_t kstep = (size_t)(BK * 2);
    const size_t hstep = (size_t)HALF * K * 2;
    const size_t tstep = 2 * hstep;
    const unsigned ldsw = (unsigned)wid * 1024u;
    const int aoff = lds_byte(wr * 64 + fr, fq * 8), boff = lds_byte(wc * 32 + fr, fq * 8);
#define PG8_SA(b, h) (((b) * 2 + (h)) * HTB)
#define PG8_SB(b, h) ((4 + (b) * 2 + (h)) * HTB)
#define PG8_STAGE(bufoff, gbase, voff) do { _Pragma("unroll") for (int _i = 0; _i < 2; ++_i) \
        __builtin_amdgcn_global_load_lds((const unsigned*)((const char*)(gbase) + (voff)[_i]), (PG8_LAS unsigned*)(lds + (bufoff) + ldsw + _i * 8192), 16, 0, 0); } while (0)
#define PG8_LDA(dst, b, h) do { _Pragma("unroll") for (int m = 0; m < 4; ++m) _Pragma("unroll") for (int k = 0; k < 2; ++k) dst[m][k] = *(const PG8_LAS bf16x8*)(lds + PG8_SA(b, h) + aoff + m * 2048 + k * 1024); } while (0)
#define PG8_LDB(dst, b, h) do { _Pragma("unroll") for (int n = 0; n < 2; ++n) _Pragma("unroll") for (int k = 0; k < 2; ++k) dst[n][k] = *(const PG8_LAS bf16x8*)(lds + PG8_SB(b, h) + boff + n * 2048 + k * 1024); } while (0)
#define PG8_MMA(ai, bj, At, Bt) do { __builtin_amdgcn_s_setprio(1); _Pragma("unroll") for (int m = 0; m < 4; ++m) _Pragma("unroll") for (int n = 0; n < 2; ++n) _Pragma("unroll") for (int k = 0; k < 2; ++k) \
        acc[ai][bj][m][n] = __builtin_amdgcn_mfma_f32_16x16x32_bf16(Bt[n][k], At[m][k], acc[ai][bj][m][n], 0, 0, 0); __builtin_amdgcn_s_setprio(0); } while (0)
#define PG8_WAIT_V(n) asm volatile("s_waitcnt vmcnt(" #n ")" ::: "memory")
#define PG8_WAIT_L(n) asm volatile("s_waitcnt lgkmcnt(" #n ")" ::: "memory")
#define PG8_BAR __builtin_amdgcn_s_barrier()
#define PG8_SCHED __builtin_amdgcn_sched_barrier(0)
    Unit cur, nxt; int ui = 0;
    if (!S.next(0, cur)) return;
    f32x4 acc[2][2][4][2];
#pragma unroll
    for (int a = 0; a < 2; ++a)
#pragma unroll
        for (int b = 0; b < 2; ++b)
#pragma unroll
            for (int m = 0; m < 4; ++m)
#pragma unroll
                for (int n = 0; n < 2; ++n) acc[a][b][m][n] = (f32x4){0.f, 0.f, 0.f, 0.f};
    bf16x8 At[4][2], B0[2][2], B1[2][2];
    const char* cA = (const char*)g.A + (size_t)cur.pm * tstep; const char* cB = (const char*)g.Bt + (size_t)cur.pn * tstep;
    S.a_ready(cur);
    if constexpr (SP2) {
        PG8_STAGE(PG8_SB(0, 0), cB, voffB); PG8_STAGE(PG8_SB(0, 1), cB + hstep, voffB); PG8_STAGE(PG8_SA(0, 0), cA, voffA); PG8_STAGE(PG8_SA(0, 1), cA + hstep, voffA);
        if (wr == 1) PG8_BAR;
        PG8_WAIT_V(2); PG8_BAR;
        PG8_STAGE(PG8_SB(1, 0), cB + kstep, voffB); PG8_STAGE(PG8_SA(1, 0), cA + kstep, voffA); PG8_STAGE(PG8_SB(1, 1), cB + hstep + kstep, voffB);
        PG8_WAIT_V(6); PG8_BAR;
    } else {
        PG8_STAGE(PG8_SB(0, 0), cB, voffB); PG8_STAGE(PG8_SA(0, 0), cA, voffA); PG8_STAGE(PG8_SB(0, 1), cB + hstep, voffB); PG8_STAGE(PG8_SA(0, 1), cA + hstep, voffA);
        if (wr == 1) PG8_BAR;
        PG8_WAIT_V(4); PG8_BAR;
        PG8_STAGE(PG8_SB(1, 0), cB + kstep, voffB); PG8_STAGE(PG8_SA(1, 0), cA + kstep, voffA); PG8_STAGE(PG8_SB(1, 1), cB + hstep + kstep, voffB);
        PG8_WAIT_V(6); PG8_BAR;
    }
    for (;;) {
        const bool has_next = S.next(ui + 1, nxt);
        const char* nA = has_next ? (const char*)g.A + (size_t)nxt.pm * tstep : cA; const char* nB = has_next ? (const char*)g.Bt + (size_t)nxt.pn * tstep : cB;
        for (int t = 0; t < nt; t += 2) {
            const bool last = (t == nt - 2);
            const char* a1 = cA + (size_t)(t + 1) * kstep;
            const char* a2 = last ? nA : cA + (size_t)(t + 2) * kstep; const char* b2 = last ? nB : cB + (size_t)(t + 2) * kstep;
            const char* a3 = a2 + kstep; const char* b3 = b2 + kstep;
            if (last && has_next) S.a_ready(nxt);
            if constexpr (SP2) {
            PG8_LDB(B0, 0, 0); PG8_LDB(B1, 0, 1); PG8_SCHED; PG8_LDA(At, 0, 0); PG8_STAGE(PG8_SA(1, 1), a1 + hstep, voffA);
            PG8_WAIT_V(8); PG8_WAIT_L(0); PG8_BAR; PG8_MMA(0, 0, At, B0); PG8_MMA(0, 1, At, B1); PG8_BAR; PG8_SCHED;
            PG8_LDA(At, 0, 1); PG8_STAGE(PG8_SB(0, 0), b2, voffB); PG8_STAGE(PG8_SB(0, 1), b2 + hstep, voffB); PG8_STAGE(PG8_SA(0, 0), a2, voffA);
            PG8_WAIT_V(8); PG8_WAIT_L(0); PG8_BAR; PG8_MMA(1, 0, At, B0); PG8_MMA(1, 1, At, B1); PG8_BAR; PG8_SCHED;
            PG8_LDB(B0, 1, 0); PG8_LDB(B1, 1, 1); PG8_SCHED; PG8_LDA(At, 1, 0); PG8_STAGE(PG8_SA(0, 1), a2 + hstep, voffA);
            PG8_WAIT_V(8); PG8_WAIT_L(0); PG8_BAR; PG8_MMA(0, 0, At, B0); PG8_MMA(0, 1, At, B1); PG8_BAR; PG8_SCHED;
            PG8_LDA(At, 1, 1); PG8_STAGE(PG8_SB(1, 0), b3, voffB); PG8_STAGE(PG8_SB(1, 1), b3 + hstep, voffB); PG8_STAGE(PG8_SA(1, 0), a3, voffA);
            PG8_WAIT_V(8); PG8_WAIT_L(0); PG8_BAR; PG8_MMA(1, 0, At, B0); PG8_MMA(1, 1, At, B1); PG8_BAR; PG8_SCHED;
            } else {
            PG8_LDB(B0, 0, 0); PG8_SCHED; PG8_LDA(At, 0, 0); PG8_STAGE(PG8_SA(1, 1), a1 + hstep, voffA);
            PG8_WAIT_L(8); PG8_BAR; PG8_WAIT_L(0); PG8_MMA(0, 0, At, B0); PG8_BAR; PG8_SCHED;
            PG8_LDB(B1, 0, 1); PG8_STAGE(PG8_SB(0, 0), b2, voffB);
            PG8_BAR; PG8_WAIT_L(0); PG8_MMA(0, 1, At, B1); PG8_BAR;
            PG8_LDA(At, 0, 1); PG8_STAGE(PG8_SA(0, 0), a2, voffA);
            PG8_BAR; PG8_WAIT_L(0); PG8_MMA(1, 0, At, B0); PG8_BAR; PG8_SCHED;
            PG8_STAGE(PG8_SB(0, 1), b2 + hstep, voffB);
            PG8_WAIT_V(6); PG8_BAR; PG8_MMA(1, 1, At, B1); PG8_BAR;
            PG8_LDB(B0, 1, 0); PG8_SCHED; PG8_LDA(At, 1, 0); PG8_STAGE(PG8_SA(0, 1), a2 + hstep, voffA);
            PG8_WAIT_L(8); PG8_BAR; PG8_WAIT_L(0); PG8_MMA(0, 0, At, B0); PG8_BAR; PG8_SCHED;
            PG8_LDB(B1, 1, 1); PG8_STAGE(PG8_SB(1, 0), b3, voffB);
            PG8_BAR; PG8_WAIT_L(0); PG8_MMA(0, 1, At, B1); PG8_BAR;
            PG8_LDA(At, 1, 1); PG8_STAGE(PG8_SA(1, 0), a3, voffA);
            PG8_BAR; PG8_WAIT_L(0); PG8_MMA(1, 0, At, B0); PG8_BAR; PG8_SCHED;
            PG8_STAGE(PG8_SB(1, 1), b3 + hstep, voffB);
            PG8_WAIT_V(6); PG8_BAR; PG8_MMA(1, 1, At, B1); PG8_BAR;
            }
        }
        if constexpr (ALIGN_EPI) { if (wr == 0) PG8_BAR; }
        if constexpr (!Epi::AFTER_DRAIN) { E(acc, cur, wr, wc, fr, fq); S.done(cur); }
        if (!has_next) break;
#pragma unroll
        for (int a = 0; a < 2; ++a)
#pragma unroll
            for (int b = 0; b < 2; ++b)
#pragma unroll
                for (int m = 0; m < 4; ++m)
#pragma unroll
                    for (int n = 0; n < 2; ++n) acc[a][b][m][n] = (f32x4){0.f, 0.f, 0.f, 0.f};
        cur = nxt; cA = nA; cB = nB; ++ui;
        if constexpr (ALIGN_EPI) { if (wr == 1) PG8_BAR; }
    }
    PG8_WAIT_V(0);
    if constexpr (!ALIGN_EPI) { if (wr == 0) PG8_BAR; }
    PG8_BAR;
    if constexpr (Epi::AFTER_DRAIN) { E.fused(acc, cur, wr, wc, fr, fq, lds, wid, lane); S.done(cur); }
#undef PG8_SA
#undef PG8_SB
#undef PG8_STAGE
#undef PG8_LDA
#undef PG8_LDB
#undef PG8_MMA
#undef PG8_WAIT_V
#undef PG8_WAIT_L
#undef PG8_BAR
#undef PG8_SCHED
}
}

constexpr int GEMM_LDS = pg8::STAGE_BYTES;
__global__ __launch_bounds__(512, 2) void k_gemm_inproj(const bf16_t* A, const bf16_t* Bt, bf16_t* P, const float* rope) {
    extern __shared__ __attribute__((aligned(16))) unsigned char lds_raw[];
    pg8::Gemm g{A, Bt, NTOK, NP, DM}; pg8::StaticOrder S; S.init(NTOK, NP, (int)gridDim.x, (int)blockIdx.x);
    pg8::EpiInProj E{P, NP, rope};
    pg8::gemm_phase<pg8::EpiInProj, pg8::StaticOrder, true, true>((PG8_LAS unsigned char*)lds_raw, g, S, E);
}
__global__ __launch_bounds__(512, 2) void k_gemm_outproj(const bf16_t* A, const bf16_t* Bt, bf16_t* C, int M) {
    extern __shared__ __attribute__((aligned(16))) unsigned char lds_raw[];
    pg8::Gemm g{A, Bt, M, DM, DM}; pg8::StaticOrder S; S.init(M, DM, (int)gridDim.x, (int)blockIdx.x);
    pg8::EpiBf16 E{C, DM};
    pg8::gemm_phase<pg8::EpiBf16, pg8::StaticOrder, true, true>((PG8_LAS unsigned char*)lds_raw, g, S, E);
}

__global__ __launch_bounds__(256) void k_rope_apply(bf16_t* __restrict__ P, const float2* __restrict__ ROPE) {
    const size_t total = (size_t)NLAT * 1024;
    for (size_t i = (size_t)blockIdx.x * 256 + threadIdx.x; i < total; i += (size_t)gridDim.x * 256) {
        const int row = (int)(i >> 10), p = (int)(i & 1023);
        const int t = row % SEQ;
        const int ip = p & 31;
        const int pos = (ip < 16) ? (t >> 6) : (t & 63);
        const float2 cs = ROPE[pos * 16 + (ip & 15)];
        unsigned* ptr = (unsigned*)(P + (size_t)row * NP + 2 * p);
        const unsigned w = *ptr;
        const float x1 = __uint_as_float(w << 16), x2 = __uint_as_float(w & 0xffff0000u);
        *ptr = pk2(x1 * cs.x - x2 * cs.y, x1 * cs.y + x2 * cs.x);
    }
}

template <bool CTXQ>
__global__ __launch_bounds__(128) void k_attn_naive(const bf16_t* __restrict__ P, bf16_t* __restrict__ Y, const float* __restrict__ lq1, const float* __restrict__ lk1,
                                                    const float* __restrict__ lq2, const float* __restrict__ lk2, const float* __restrict__ subln, float lam_init) {
    __shared__ float sb[2][2][2304];
    __shared__ float qb[2][128];
    const int w = threadIdx.x >> 6, lane = threadIdx.x & 63;
    const int t = blockIdx.x * 2 + w, hh = blockIdx.y, b = blockIdx.z;
    const int nkeys = CTXQ ? CTXL : (CTXL + SEQ);
    const size_t qrow = CTXQ ? (size_t)(NLAT + b * CTXL + t) : (size_t)(b * SEQ + t);
    const float lam = expf(wave_sum(lq1[lane] * lk1[lane])) - expf(wave_sum(lq2[lane] * lk2[lane])) + lam_init;
    qb[w][lane] = bf2f(P[qrow * NP + C_QA + hh * 128 + lane]);
    qb[w][64 + lane] = bf2f(P[qrow * NP + C_QA + hh * 128 + 64 + lane]);
    __syncthreads();
    float mx1 = -INFINITY, mx2 = -INFINITY;
    for (int j = lane; j < nkeys; j += 64) {
        const size_t kr = (j < CTXL) ? (size_t)(NLAT + b * CTXL + j) : (size_t)(b * SEQ + j - CTXL);
        const uint4* kp = (const uint4*)(P + kr * NP + C_KA + hh * 128);
        float s1 = 0.f, s2 = 0.f;
#pragma unroll
        for (int q = 0; q < 8; ++q) {
            const uint4 a = kp[q], c = kp[8 + q];
            const unsigned aw[4] = {a.x, a.y, a.z, a.w}, cw[4] = {c.x, c.y, c.z, c.w};
#pragma unroll
            for (int i = 0; i < 4; ++i) {
                s1 += qb[w][q * 8 + 2 * i] * __uint_as_float(aw[i] << 16) + qb[w][q * 8 + 2 * i + 1] * __uint_as_float(aw[i] & 0xffff0000u);
                s2 += qb[w][64 + q * 8 + 2 * i] * __uint_as_float(cw[i] << 16) + qb[w][64 + q * 8 + 2 * i + 1] * __uint_as_float(cw[i] & 0xffff0000u);
            }
        }
        s1 *= 0.125f; s2 *= 0.125f;
        sb[w][0][j] = s1; sb[w][1][j] = s2; mx1 = fmaxf(mx1, s1); mx2 = fmaxf(mx2, s2);
    }
    mx1 = wave_max(mx1); mx2 = wave_max(mx2);
    float l1 = 0.f, l2 = 0.f;
    for (int j = lane; j < nkeys; j += 64) {
        const float p1 = expf(sb[w][0][j] - mx1), p2 = expf(sb[w][1][j] - mx2);
        sb[w][0][j] = p1; sb[w][1][j] = p2; l1 += p1; l2 += p2;
    }
    l1 = wave_sum(l1); l2 = wave_sum(l2);
    const float r1 = 1.f / l1, r2 = lam / l2;
    for (int j = lane; j < nkeys; j += 64) sb[w][0][j] = sb[w][0][j] * r1 - sb[w][1][j] * r2;
    __syncthreads();
    float o0 = 0.f, o1 = 0.f;
    for (int j = 0; j < nkeys; ++j) {
        const size_t kr = (j < CTXL) ? (size_t)(NLAT + b * CTXL + j) : (size_t)(b * SEQ + j - CTXL);
        const unsigned vv = *(const unsigned*)(P + kr * NP + C_VA + hh * 128 + 2 * lane);
        const float a = sb[w][0][j];
        o0 += a * __uint_as_float(vv << 16); o1 += a * __uint_as_float(vv & 0xffff0000u);
    }
    const float ss = wave_sum(o0 * o0 + o1 * o1);
    const float r = rsqrtf(ss * (1.f / 128.f) + EPS) * (1.f - lam_init);
    const unsigned gg = *(const unsigned*)(P + qrow * NP + C_GA + hh * 128 + 2 * lane);
    const float g0 = __uint_as_float(gg << 16), g1 = __uint_as_float(gg & 0xffff0000u);
    const float y0 = o0 * r * subln[2 * lane] * silu_f(g0), y1 = o1 * r * subln[2 * lane + 1] * silu_f(g1);
    *(unsigned*)(Y + qrow * DM + hh * 128 + 2 * lane) = pk2(y0, y1);
}

constexpr int QS = 129;
constexpr int MLSTM_LDS_FLOATS = 2 * 64 * QS + 64 * 64 + 64 * 256 + 64 * 7 + 128 + 8;
__global__ __launch_bounds__(256) void k_mlstm_naive(const bf16_t* __restrict__ P, const float* __restrict__ GATES, bf16_t* __restrict__ HM, const float* __restrict__ conv_w,
                                                     const float* __restrict__ conv_b, const float* __restrict__ i_bias, const float* __restrict__ f_bias) {
    extern __shared__ float smem[];
    float* qs = smem; float* ks = qs + 64 * QS; float* S = ks + 64 * QS; float* vs = S + 64 * 64;
    float* bcum = vs + 64 * 256; float* ig = bcum + 64; float* lfv = ig + 64; float* mrow = lfv + 64; float* sc = mrow + 64; float* wk = sc + 64; float* den = wk + 64;
    float* nvec = den + 64; float* scal = nvec + 128;
    const int unit = blockIdx.x, dir = unit & 1, head = (unit >> 1) & 3, b = unit >> 3;
    const int tid = threadIdx.x;
    float C[128];
#pragma unroll
    for (int d = 0; d < 128; ++d) C[d] = 0.f;
    if (tid < 128) nvec[tid] = 0.f;
    float m = 0.f;
    const int ch = tid;
    const int cidx = (ch < 128) ? head * 128 + ch : 512 + head * 128 + (ch - 128);
    const int pcol = (ch < 128) ? C_QB + head * 128 + ch : C_KB + head * 128 + (ch - 128);
    const float cw0 = conv_w[cidx], cw1 = conv_w[1024 + cidx], cw2 = conv_w[2048 + cidx], cb = conv_b[cidx];
    __syncthreads();
    for (int c = 0; c < 36; ++c) {
        const bool isctx = c < 4; const int T = isctx ? CTXL : SEQ; const int cc = isctx ? c : c - 4;
        const int rowbase = isctx ? NLAT + b * CTXL : b * SEQ;
        const int tstart = dir ? (T - 1 - 64 * cc) : 64 * cc; const int tstep = dir ? -1 : 1;
        if (tid < 64) {
            const int t = tstart + tstep * tid; const size_t row = (size_t)(rowbase + t);
            const float gi = GATES[row * 16 + dir * 4 + head] + i_bias[dir * 4 + head];
            const float gf = GATES[row * 16 + 8 + dir * 4 + head] + f_bias[dir * 4 + head];
            const float igv = 15.f * tanhf(gi * (1.f / 15.f));
            const float fc = 15.f * tanhf(gf * (1.f / 15.f));
            ig[tid] = igv; lfv[tid] = fminf(fc, 0.f) - log1pf(expf(-fabsf(fc)));
        }
        for (int l = 0; l < 64; ++l) {
            const int t = tstart + tstep * l;
            const float x0 = (t > 0) ? bf2f(P[(size_t)(rowbase + t - 1) * NP + pcol]) : 0.f;
            const float x1 = bf2f(P[(size_t)(rowbase + t) * NP + pcol]);
            const float x2 = (t < T - 1) ? bf2f(P[(size_t)(rowbase + t + 1) * NP + pcol]) : 0.f;
            const float v = silu_f(cb + cw0 * x0 + cw1 * x1 + cw2 * x2);
            if (ch < 128) qs[l * QS + ch] = v; else ks[l * QS + ch - 128] = v * 0.08838834764831845f;
            vs[l * 256 + tid] = bf2f(P[(size_t)(rowbase + t) * NP + C_VB + head * 256 + tid]);
        }
        __syncthreads();
        if (tid == 0) { float a = 0.f; for (int l = 0; l < 64; ++l) { a += lfv[l]; bcum[l] = a; } }
        __syncthreads();
        if (tid < 64) {
            const float bl = bcum[tid]; float mx = bl + m;
            for (int s = 0; s <= tid; ++s) mx = fmaxf(mx, bl - bcum[s] + ig[s]);
            mrow[tid] = mx; sc[tid] = expf(bl + m - mx);
        }
        if (tid == 64) {
            const float blast = bcum[63]; float mn = blast + m;
            for (int s = 0; s < 64; ++s) mn = fmaxf(mn, blast - bcum[s] + ig[s]);
            scal[0] = mn; scal[1] = expf(blast + m - mn);
        }
        __syncthreads();
        const float m_new = scal[0], decay = scal[1];
        if (tid < 64) wk[tid] = expf(bcum[63] - bcum[tid] + ig[tid] - m_new);
        for (int idx = tid; idx < 4096; idx += 256) {
            const int l = idx >> 6, s = idx & 63; float val = 0.f;
            if (s <= l) { float dot = 0.f; for (int d = 0; d < 128; ++d) dot += qs[l * QS + d] * ks[s * QS + d]; val = dot * expf(bcum[l] - bcum[s] + ig[s] - mrow[l]); }
            S[idx] = val;
        }
        __syncthreads();
        if (tid < 64) {
            float dn = 0.f; for (int d = 0; d < 128; ++d) dn += qs[tid * QS + d] * nvec[d];
            dn *= sc[tid]; for (int s = 0; s < 64; ++s) dn += S[tid * 64 + s];
            den[tid] = fmaxf(fabsf(dn), expf(-mrow[tid]));
        }
        __syncthreads();
        for (int l = 0; l < 64; ++l) {
            float a = 0.f;
#pragma unroll
            for (int d = 0; d < 128; ++d) a += qs[l * QS + d] * C[d];
            a *= sc[l];
            for (int s = 0; s <= l; ++s) a += S[l * 64 + s] * vs[s * 256 + tid];
            const int t = tstart + tstep * l;
            HM[((size_t)dir * NTOK + rowbase + t) * 1024 + head * 256 + tid] = f2bf(a / den[l]);
        }
#pragma unroll
        for (int d = 0; d < 128; ++d) C[d] *= decay;
        for (int s = 0; s < 64; ++s) {
            const float wv = wk[s] * vs[s * 256 + tid];
#pragma unroll
            for (int d = 0; d < 128; ++d) C[d] += wv * ks[s * QS + d];
        }
        if (tid < 128) { float a = decay * nvec[tid]; for (int s = 0; s < 64; ++s) a += wk[s] * ks[s * QS + tid]; nvec[tid] = a; }
        m = m_new;
        __syncthreads();
    }
}

__global__ __launch_bounds__(256) void k_finish_mlstm(const bf16_t* __restrict__ P, const bf16_t* __restrict__ HM, const float* __restrict__ mnorm, bf16_t* __restrict__ Y) {
    const int wave = threadIdx.x >> 6, lane = threadIdx.x & 63;
    const int gw = blockIdx.x * 4 + wave, ngw = gridDim.x * 4;
    for (int row = gw; row < NTOK; row += ngw) {
#pragma unroll
        for (int head = 0; head < 4; ++head) {
            const int col = head * 256 + 4 * lane;
            const uint2 a = *(const uint2*)(HM + (size_t)row * 1024 + col), c = *(const uint2*)(HM + ((size_t)NTOK + row) * 1024 + col);
            float h[4];
            h[0] = __uint_as_float(a.x << 16) + __uint_as_float(c.x << 16); h[1] = __uint_as_float(a.x & 0xffff0000u) + __uint_as_float(c.x & 0xffff0000u);
            h[2] = __uint_as_float(a.y << 16) + __uint_as_float(c.y << 16); h[3] = __uint_as_float(a.y & 0xffff0000u) + __uint_as_float(c.y & 0xffff0000u);
            const float ss = wave_sum(h[0] * h[0] + h[1] * h[1] + h[2] * h[2] + h[3] * h[3]);
            const float r = rsqrtf(ss * (1.f / 256.f) + EPS);
            const uint2 ov = *(const uint2*)(P + (size_t)row * NP + C_OB + col), gv = *(const uint2*)(P + (size_t)row * NP + C_GB + col);
            const float o[4] = {__uint_as_float(ov.x << 16), __uint_as_float(ov.x & 0xffff0000u), __uint_as_float(ov.y << 16), __uint_as_float(ov.y & 0xffff0000u)};
            const float g[4] = {__uint_as_float(gv.x << 16), __uint_as_float(gv.x & 0xffff0000u), __uint_as_float(gv.y << 16), __uint_as_float(gv.y & 0xffff0000u)};
            const float4 w = *(const float4*)(mnorm + col);
            const float wv[4] = {w.x, w.y, w.z, w.w};
            float y[4];
#pragma unroll
            for (int e = 0; e < 4; ++e) y[e] = h[e] * r * wv[e] * sigmoid_f(o[e]) * silu_f(g[e]);
            uint2 out; out.x = pk2(y[0], y[1]); out.y = pk2(y[2], y[3]);
            *(uint2*)(Y + (size_t)row * DM + 1024 + col) = out;
        }
    }
}

__global__ __launch_bounds__(256) void k_post(const float* xlat, const float* xctx, const bf16_t* __restrict__ Y2, const float* __restrict__ mod_l,
                                              const float* __restrict__ npost, float* olat, float* octx, int nrows) {
    const int wave = threadIdx.x >> 6, lane = threadIdx.x & 63;
    const int gw = blockIdx.x * 4 + wave, ngw = gridDim.x * 4;
    for (int row = gw; row < nrows; row += ngw) {
        const bool isl = row < NLAT;
        const float* xr = isl ? xlat + (size_t)row * DM : xctx + (size_t)(row - NLAT) * DM;
        float* orow = isl ? olat + (size_t)row * DM : octx + (size_t)(row - NLAT) * DM;
        const int b = isl ? row / SEQ : 8;
        const float* gate = mod_l + (size_t)b * MODW + 2 * DM;
        float y[8][4]; float ss = 0.f;
#pragma unroll
        for (int j = 0; j < 8; ++j) {
            const uint2 a = *(const uint2*)(Y2 + (size_t)row * DM + 4 * (lane + 64 * j));
            y[j][0] = __uint_as_float(a.x << 16); y[j][1] = __uint_as_float(a.x & 0xffff0000u); y[j][2] = __uint_as_float(a.y << 16); y[j][3] = __uint_as_float(a.y & 0xffff0000u);
            ss += y[j][0] * y[j][0] + y[j][1] * y[j][1] + y[j][2] * y[j][2] + y[j][3] * y[j][3];
        }
        ss = wave_sum(ss);
        const float rstd = rsqrtf(ss * (1.f / DM) + EPS);
#pragma unroll
        for (int j = 0; j < 8; ++j) {
            const int k0 = 4 * (lane + 64 * j);
            const float4 xv = *(const float4*)(xr + k0), gt = *(const float4*)(gate + k0), w = *(const float4*)(npost + k0);
            float4 o;
            o.x = xv.x + gt.x * (y[j][0] * rstd * w.x); o.y = xv.y + gt.y * (y[j][1] * rstd * w.y);
            o.z = xv.z + gt.z * (y[j][2] * rstd * w.z); o.w = xv.w + gt.w * (y[j][3] * rstd * w.w);
            *(float4*)(orow + k0) = o;
        }
    }
}

extern "C" void kernel_launch(void* const* d_in, const int* in_sizes, int n_in, void* d_out, int out_size, void* d_ws, size_t ws_size, hipStream_t stream) {
    (void)in_sizes; (void)n_in; (void)out_size; (void)ws_size;
    const float* x = (const float*)d_in[0]; const float* c = (const float*)d_in[1]; const float* ctx = (const float*)d_in[2]; const float* c_ctx = (const float*)d_in[3];
    const float* w_ada = (const float*)d_in[4]; const float* b_ada = (const float*)d_in[5]; const float* norm_pre = (const float*)d_in[6]; const float* norm_post = (const float*)d_in[7];
    const float* w_in = (const float*)d_in[8]; const float* w_out = (const float*)d_in[9];
    const float* lq1 = (const float*)d_in[10]; const float* lk1 = (const float*)d_in[11]; const float* lq2 = (const float*)d_in[12]; const float* lk2 = (const float*)d_in[13];
    const float* subln = (const float*)d_in[14]; const float* conv_w = (const float*)d_in[15]; const float* conv_b = (const float*)d_in[16];
    const float* i_bias = (const float*)d_in[17]; const float* f_bias = (const float*)d_in[18]; const float* mnorm = (const float*)d_in[19];
    float* out = (float*)d_out; unsigned char* ws = (unsigned char*)d_ws;
    float* MOD = (float*)(ws + WS_MOD); float* SC = (float*)(ws + WS_SC); float2* ROPE = (float2*)(ws + WS_ROPE); float* GATES = (float*)(ws + WS_GATES);
    bf16_t* WOUT = (bf16_t*)(ws + WS_WOUT); bf16_t* WIN = (bf16_t*)(ws + WS_WIN); float* XC = (float*)(ws + WS_XC);
    bf16_t* H = (bf16_t*)(ws + WS_H); bf16_t* HM = (bf16_t*)(ws + WS_HM); bf16_t* P = (bf16_t*)(ws + WS_P);
    bf16_t* Y = H; bf16_t* Y2 = HM;

    const size_t mlstm_lds = (size_t)MLSTM_LDS_FLOATS * 4;
    (void)hipFuncSetAttribute((const void*)k_mlstm_naive, hipFuncAttributeMaxDynamicSharedMemorySize, (int)mlstm_lds);
    (void)hipFuncSetAttribute((const void*)k_gemm_inproj, hipFuncAttributeMaxDynamicSharedMemorySize, GEMM_LDS);
    (void)hipFuncSetAttribute((const void*)k_gemm_outproj, hipFuncAttributeMaxDynamicSharedMemorySize, GEMM_LDS);

    k_silu_c<<<(9 * DM + 255) / 256, 256, 0, stream>>>(c, c_ctx, SC);
    k_mod<<<2 * MODW / 256, 256, 0, stream>>>(SC, w_ada, b_ada, MOD);
    k_rope_table<<<4, 256, 0, stream>>>(ROPE);
    for (int l = 0; l < 2; ++l) k_transpose<<<1024, 256, 0, stream>>>(w_out + (size_t)l * DM * DM, DM, DM, DM, WOUT + (size_t)l * DM * DM);

    for (int l = 0; l < 2; ++l) {
        const float lam_init = (float)(0.8 - 0.6 * exp(-0.3 * (double)l));
        const float* mod_l = MOD + (size_t)l * 9 * MODW;
        const float* w_in_l = w_in + (size_t)l * DM * INC;
        k_transpose<<<2048, 256, 0, stream>>>(w_in_l, INC, DM, NP, WIN);
        k_norm<<<2048, 256, 0, stream>>>(l == 0 ? x : out, l == 0 ? ctx : XC, mod_l, norm_pre + l * DM, w_in_l + NP, H, GATES);
        k_gemm_inproj<<<256, 512, GEMM_LDS, stream>>>(H, WIN, P, (const float*)ROPE);
        k_attn_naive<false><<<dim3(SEQ / 2, 8, NBATCH), 128, 0, stream>>>(P, Y, lq1 + l * 64, lk1 + l * 64, lq2 + l * 64, lk2 + l * 64, subln + l * 128, lam_init);
        if (l == 0) k_attn_naive<true><<<dim3(CTXL / 2, 8, NBATCH), 128, 0, stream>>>(P, Y, lq1 + l * 64, lk1 + l * 64, lq2 + l * 64, lk2 + l * 64, subln + l * 128, lam_init);
        k_mlstm_naive<<<64, 256, mlstm_lds, stream>>>(P, GATES, HM, conv_w + (size_t)l * 3 * 1024, conv_b + l * 1024, i_bias + l * 8, f_bias + l * 8);
        k_finish_mlstm<<<2048, 256, 0, stream>>>(P, HM, mnorm + l * 1024, Y);
        k_gemm_outproj<<<256, 512, GEMM_LDS, stream>>>(Y, WOUT + (size_t)l * DM * DM, Y2, l == 0 ? NTOK : NLAT);
        k_post<<<2048, 256, 0, stream>>>(l == 0 ? x : out, l == 0 ? ctx : XC, Y2, mod_l, norm_post + l * DM, out, XC, l == 0 ? NTOK : NLAT);
    }
}
```

```cpp
#include <hip/hip_runtime.h>
#include <stdint.h>
#include <math.h>

#define DEVI __device__ __forceinline__
typedef unsigned short bf16_t;

constexpr int DM = 2048, NBATCH = 8, SEQ = 2048, CTXL = 256;
constexpr int NLAT = NBATCH * SEQ, NCTX = NBATCH * CTXL, NTOK = NLAT + NCTX;
constexpr int INC = 8208, NP = 8192, MODW = 6144;
constexpr int C_QA = 0, C_KA = 1024, C_VA = 2048, C_GA = 3072, C_QB = 4096, C_KB = 4608, C_VB = 5120, C_OB = 6144, C_GB = 7168;
constexpr float EPS = 1e-6f;

constexpr size_t MiB = (size_t)1 << 20;
constexpr size_t WS_CTL = 0, WS_MOD = 1 * MiB, WS_SC = WS_MOD + 512 * 1024, WS_ROPE = 2 * MiB, WS_GATES = 3 * MiB, WS_WOUT = 8 * MiB,
                 WS_WIN = 24 * MiB, WS_XC = 56 * MiB, WS_H = 72 * MiB, WS_HM = 144 * MiB, WS_P = 216 * MiB, WS_END = 504 * MiB;

DEVI float bf2f(bf16_t v) { return __uint_as_float(((unsigned)v) << 16); }
DEVI bf16_t f2bf(float f) { unsigned u = __float_as_uint(f); return (bf16_t)((u + 0x7fffu + ((u >> 16) & 1u)) >> 16); }
DEVI unsigned pk2(float lo, float hi) { return (unsigned)f2bf(lo) | ((unsigned)f2bf(hi) << 16); }
DEVI float wave_sum(float v) {
#pragma unroll
    for (int o = 32; o > 0; o >>= 1) v += __shfl_xor(v, o);
    return v;
}
DEVI float wave_max(float v) {
#pragma unroll
    for (int o = 32; o > 0; o >>= 1) v = fmaxf(v, __shfl_xor(v, o));
    return v;
}
DEVI float silu_f(float x) { return x / (1.f + expf(-x)); }
DEVI float sigmoid_f(float x) { return 1.f / (1.f + expf(-x)); }

__global__ void k_silu_c(const float* __restrict__ c, const float* __restrict__ c_ctx, float* __restrict__ SC) {
    int i = blockIdx.x * 256 + threadIdx.x;
    if (i < 9 * DM) { float v = (i < 8 * DM) ? c[i] : c_ctx[i - 8 * DM]; SC[i] = silu_f(v); }
}
__global__ __launch_bounds__(256) void k_mod(const float* __restrict__ SC, const float* __restrict__ w_ada, const float* __restrict__ b_ada, float* __restrict__ MOD) {
    int j = blockIdx.x * 256 + threadIdx.x;
    int l = j / MODW, jj = j % MODW;
    const float* w = w_ada + (size_t)l * DM * MODW + jj;
    float acc[9];
#pragma unroll
    for (int r = 0; r < 9; ++r) acc[r] = 0.f;
    for (int k = 0; k < DM; ++k) {
        float wv = w[(size_t)k * MODW];
#pragma unroll
        for (int r = 0; r < 9; ++r) acc[r] += SC[r * DM + k] * wv;
    }
#pragma unroll
    for (int r = 0; r < 9; ++r) MOD[(size_t)(l * 9 + r) * MODW + jj] = acc[r] + b_ada[l * MODW + jj];
}
__global__ void k_rope_table(float2* __restrict__ ROPE) {
    int i = blockIdx.x * 256 + threadIdx.x;
    if (i < 1024) { int pos = i >> 4, f = i & 15; float inv = powf(10000.f, -(float)f / 16.f); float ang = (float)pos * inv; ROPE[i] = make_float2(cosf(ang), sinf(ang)); }
}
DEVI void transpose_item(const float* __restrict__ W, int ldw, int K, int N, bf16_t* __restrict__ WT, float* scr, int item, int lane) {
    const int nblk = N / 32, kb = item / nblk, nb = item % nblk, k0 = 64 * kb, n0 = 32 * nb;
#pragma unroll 8
    for (int i = 0; i < 32; ++i) { const int kk = 2 * i + (lane >> 5); scr[kk * 33 + (lane & 31)] = W[(size_t)(k0 + kk) * ldw + n0 + (lane & 31)]; }
    asm volatile("s_waitcnt lgkmcnt(0)" ::: "memory");
    const int c = lane & 7;
#pragma unroll
    for (int j = 0; j < 4; ++j) {
        const int n = (lane >> 3) + 8 * j; const float* s = scr + (8 * c) * 33 + n;
        uint4 o; o.x = pk2(s[0 * 33], s[1 * 33]); o.y = pk2(s[2 * 33], s[3 * 33]); o.z = pk2(s[4 * 33], s[5 * 33]); o.w = pk2(s[6 * 33], s[7 * 33]);
        *(uint4*)(WT + (size_t)(n0 + n) * K + k0 + 8 * c) = o;
    }
    asm volatile("s_waitcnt lgkmcnt(0)" ::: "memory");
}
__global__ __launch_bounds__(256) void k_transpose(const float* __restrict__ W, int ldw, int K, int N, bf16_t* __restrict__ WT) {
    __shared__ float scr[4][64 * 33];
    const int wave = threadIdx.x >> 6, lane = threadIdx.x & 63;
    const int gw = blockIdx.x * 4 + wave, ngw = gridDim.x * 4;
    const int nitems = (K / 64) * (N / 32);
    for (int it = gw; it < nitems; it += ngw) transpose_item(W, ldw, K, N, WT, scr[wave], it, lane);
}

DEVI void norm_row(const float* __restrict__ xrow, int b, const float* __restrict__ mod_l, const float* __restrict__ npre, const float* __restrict__ wg,
                   bf16_t* __restrict__ hrow, float* __restrict__ grow, int lane) {
    float4 v[8]; float ss = 0.f;
#pragma unroll
    for (int j = 0; j < 8; ++j) { v[j] = ((const float4*)xrow)[lane + 64 * j]; ss += v[j].x * v[j].x + v[j].y * v[j].y + v[j].z * v[j].z + v[j].w * v[j].w; }
    ss = wave_sum(ss);
    const float rstd = rsqrtf(ss * (1.f / DM) + EPS);
    const float* shift = mod_l + (size_t)b * MODW; const float* scale = shift + DM;
    float g[16];
#pragma unroll
    for (int i = 0; i < 16; ++i) g[i] = 0.f;
#pragma unroll
    for (int j = 0; j < 8; ++j) {
        const int k0 = 4 * (lane + 64 * j);
        const float4 w = *(const float4*)(npre + k0), sh = *(const float4*)(shift + k0), sc = *(const float4*)(scale + k0);
        float h[4];
        h[0] = v[j].x * rstd * w.x * (1.f + sc.x) + sh.x; h[1] = v[j].y * rstd * w.y * (1.f + sc.y) + sh.y;
        h[2] = v[j].z * rstd * w.z * (1.f + sc.z) + sh.z; h[3] = v[j].w * rstd * w.w * (1.f + sc.w) + sh.w;
        uint2 o; o.x = pk2(h[0], h[1]); o.y = pk2(h[2], h[3]);
        *(uint2*)(hrow + k0) = o;
#pragma unroll
        for (int e = 0; e < 4; ++e) {
            const float4* wr = (const float4*)(wg + (size_t)(k0 + e) * INC);
#pragma unroll
            for (int q = 0; q < 4; ++q) { const float4 ww = wr[q]; g[4 * q] += h[e] * ww.x; g[4 * q + 1] += h[e] * ww.y; g[4 * q + 2] += h[e] * ww.z; g[4 * q + 3] += h[e] * ww.w; }
        }
        asm volatile("" ::: "memory");
    }
#pragma unroll
    for (int i = 0; i < 16; ++i) g[i] = wave_sum(g[i]);
    if (lane == 0) {
#pragma unroll
        for (int q = 0; q < 4; ++q) ((float4*)grow)[q] = make_float4(g[4 * q], g[4 * q + 1], g[4 * q + 2], g[4 * q + 3]);
    }
}
__global__ __launch_bounds__(256) void k_norm(const float* __restrict__ xlat, const float* __restrict__ xctx, const float* __restrict__ mod_l, const float* __restrict__ npre,
                                              const float* __restrict__ wg, bf16_t* __restrict__ H, float* __restrict__ GATES) {
    const int wave = threadIdx.x >> 6, lane = threadIdx.x & 63;
    const int gw = blockIdx.x * 4 + wave, ngw = gridDim.x * 4;
    for (int row = gw; row < NTOK; row += ngw) {
        const bool isl = row < NLAT;
        const float* xr = isl ? xlat + (size_t)row * DM : xctx + (size_t)(row - NLAT) * DM;
        const int b = isl ? row / SEQ : 8;
        norm_row(xr, b, mod_l, npre, wg, H + (size_t)row * DM, GATES + (size_t)row * 16, lane);
    }
}

__global__ __launch_bounds__(256) void k_gemm_naive(const bf16_t* __restrict__ A, const bf16_t* __restrict__ Bt, bf16_t* __restrict__ C, int M, int N, int K) {
    __shared__ float As[32][65], Bs[32][65];
    const int tx = threadIdx.x & 15, ty = threadIdx.x >> 4;
    const int m0 = blockIdx.y * 64, n0 = blockIdx.x * 64;
    float acc[4][4];
#pragma unroll
    for (int i = 0; i < 4; ++i)
#pragma unroll
        for (int j = 0; j < 4; ++j) acc[i][j] = 0.f;
    const int lr = threadIdx.x >> 2, lk = (threadIdx.x & 3) * 8;
    for (int k0 = 0; k0 < K; k0 += 32) {
        const uint4 av = *(const uint4*)(A + (size_t)(m0 + lr) * K + k0 + lk);
        const uint4 bv = *(const uint4*)(Bt + (size_t)(n0 + lr) * K + k0 + lk);
        const unsigned aw[4] = {av.x, av.y, av.z, av.w}, bw[4] = {bv.x, bv.y, bv.z, bv.w};
#pragma unroll
        for (int i = 0; i < 4; ++i) {
            As[lk + 2 * i][lr] = __uint_as_float(aw[i] << 16); As[lk + 2 * i + 1][lr] = __uint_as_float(aw[i] & 0xffff0000u);
            Bs[lk + 2 * i][lr] = __uint_as_float(bw[i] << 16); Bs[lk + 2 * i + 1][lr] = __uint_as_float(bw[i] & 0xffff0000u);
        }
        __syncthreads();
#pragma unroll 8
        for (int kk = 0; kk < 32; ++kk) {
            float a[4], b[4];
#pragma unroll
            for (int i = 0; i < 4; ++i) { a[i] = As[kk][ty * 4 + i]; b[i] = Bs[kk][tx * 4 + i]; }
#pragma unroll
            for (int i = 0; i < 4; ++i)
#pragma unroll
                for (int j = 0; j < 4; ++j) acc[i][j] += a[i] * b[j];
        }
        __syncthreads();
    }
#pragma unroll
    for (int i = 0; i < 4; ++i) {
        uint2 o; o.x = pk2(acc[i][0], acc[i][1]); o.y = pk2(acc[i][2], acc[i][3]);
        *(uint2*)(C + (size_t)(m0 + ty * 4 + i) * N + n0 + tx * 4) = o;
    }
}

namespace pg8 {
#define PG8_LAS __attribute__((address_space(3)))
typedef unsigned short bf16_t;
typedef short bf16x8 __attribute__((ext_vector_type(8)));
typedef float f32x4 __attribute__((ext_vector_type(4)));
typedef unsigned u32x4 __attribute__((ext_vector_type(4)));
constexpr int BM = 256, BK = 64, HALF = 128, HTB = HALF * BK * 2  , STAGE_BYTES = 8 * HTB, NXCD = 8, WGM = 8;

__host__ __device__ __forceinline__ int lds_byte(int r, int c) { const int st = (r >> 4) * 2 + (c >> 5), rr = r & 15, cc = c & 31, ob = rr * 64 + cc * 2; return st * 1024 + (ob ^ (((ob >> 9) & 1) << 5)); }
__host__ __device__ __forceinline__ void stage_rc(int b, int& R, int& C) { const int st = b / 1024, sb = b % 1024, swz = sb ^ (((sb >> 9) & 1) << 5); R = (st >> 1) * 16 + swz / 64; C = (st & 1) * 32 + (swz % 64) / 2; }
__host__ __device__ __forceinline__ int perm32(int rho) { const int n = rho >> 4, i = rho & 15; return 8 * (i >> 2) + 4 * n + (i & 3); }

struct Unit { int pm, pn; };
struct Gemm { const bf16_t* A; const bf16_t* Bt; int M, N, K; };

struct StaticOrder {
    int nM, nN, nwg, G, c;
    __host__ __device__ void init(int M, int N, int G_, int c_) { nM = M / BM; nN = N / BM; nwg = nM * nN; G = G_; c = c_; }
    __host__ __device__ bool next(int i, Unit& u) const {
        const long L = (long)i * G + c; if (L >= nwg) return false;
        int wgid = (int)L; { const int q = nwg / NXCD, r = nwg % NXCD, xcd = wgid % NXCD, off = wgid / NXCD; wgid = (xcd < r ? xcd * (q + 1) : r * (q + 1) + (xcd - r) * q) + off; }
        const int nig = WGM * nN, gid = wgid / nig, fm = gid * WGM, gsz = (nM - fm) < WGM ? (nM - fm) : WGM;
        u.pm = fm + ((wgid % nig) % gsz); u.pn = (wgid % nig) / gsz; return true;
    }
    __device__ __forceinline__ void a_ready(const Unit&) const {}
    __device__ __forceinline__ void done(const Unit&) const {}
};

__device__ __forceinline__ unsigned cvt_pk_bf16(float lo, float hi) { unsigned r; asm volatile("v_cvt_pk_bf16_f32 %0, %1, %2" : "=v"(r) : "v"(lo), "v"(hi)); return r; }

struct EpiBf16 {
    static constexpr bool PERM = true, AFTER_DRAIN = false;
    bf16_t* O; int ldc;
    __device__ __forceinline__ void operator()(const f32x4 (&acc)[2][2][4][2], const Unit& u, int wr, int wc, int fr, int fq) const {
        const int row0 = u.pm * BM + wr * 64 + fr, col0 = u.pn * BM + wc * 32 + 8 * fq;
#pragma unroll
        for (int ai = 0; ai < 2; ++ai)
#pragma unroll
            for (int m = 0; m < 4; ++m) { bf16_t* rowp = O + (size_t)(row0 + ai * HALF + m * 16) * ldc + col0;
#pragma unroll
                for (int bj = 0; bj < 2; ++bj) { const f32x4 v0 = acc[ai][bj][m][0], v1 = acc[ai][bj][m][1];
                    u32x4 w; w.x = cvt_pk_bf16(v0[0], v0[1]); w.y = cvt_pk_bf16(v0[2], v0[3]); w.z = cvt_pk_bf16(v1[0], v1[1]); w.w = cvt_pk_bf16(v1[2], v1[3]);
                    *(u32x4*)(rowp + bj * HALF) = w; } }
    }
};
struct EpiInProj {
    static constexpr bool PERM = true, AFTER_DRAIN = false;
    bf16_t* O; int ldc; const float* rope;
    __device__ __forceinline__ void operator()(const f32x4 (&acc)[2][2][4][2], const Unit& u, int wr, int wc, int fr, int fq) const {
        const int row0 = u.pm * BM + wr * 64 + fr, col0 = u.pn * BM + wc * 32 + 8 * fq;
        const bool do_rope = (u.pn < 8) && (u.pm < 64);
#pragma unroll
        for (int ai = 0; ai < 2; ++ai)
#pragma unroll
            for (int m = 0; m < 4; ++m) { const int row = row0 + ai * HALF + m * 16; bf16_t* rowp = O + (size_t)row * ldc + col0;
                f32x4 cs01 = {1.f, 0.f, 1.f, 0.f}, cs23 = {1.f, 0.f, 1.f, 0.f};
                if (do_rope) { const int pos = (wc & 1) ? (row & 63) : ((row >> 6) & 31); const f32x4* rp = (const f32x4*)(rope + (size_t)(pos * 16 + 4 * fq) * 2); cs01 = rp[0]; cs23 = rp[1]; }
#pragma unroll
                for (int bj = 0; bj < 2; ++bj) { f32x4 v0 = acc[ai][bj][m][0], v1 = acc[ai][bj][m][1];
                    if (do_rope) {
                        const float a0 = v0[0] * cs01[0] - v0[1] * cs01[1], a1 = v0[0] * cs01[1] + v0[1] * cs01[0];
                        const float a2 = v0[2] * cs01[2] - v0[3] * cs01[3], a3 = v0[2] * cs01[3] + v0[3] * cs01[2];
                        const float b0 = v1[0] * cs23[0] - v1[1] * cs23[1], b1 = v1[0] * cs23[1] + v1[1] * cs23[0];
                        const float b2 = v1[2] * cs23[2] - v1[3] * cs23[3], b3 = v1[2] * cs23[3] + v1[3] * cs23[2];
                        v0 = (f32x4){a0, a1, a2, a3}; v1 = (f32x4){b0, b1, b2, b3};
                    }
                    u32x4 w; w.x = cvt_pk_bf16(v0[0], v0[1]); w.y = cvt_pk_bf16(v0[2], v0[3]); w.z = cvt_pk_bf16(v1[0], v1[1]); w.w = cvt_pk_bf16(v1[2], v1[3]);
                    *(u32x4*)(rowp + bj * HALF) = w; } }
    }
};

template <class Epi, class Sched, bool ALIGN_EPI = false, bool SP2 = false>
__device__ __forceinline__ void gemm_phase(PG8_LAS unsigned char* lds, const Gemm g, const Sched& S, const Epi& E) {
    const int tid = threadIdx.x, wid = __builtin_amdgcn_readfirstlane(tid >> 6), lane = tid & 63, wr = wid >> 2, wc = wid & 3, fr = lane & 15, fq = lane >> 4;
    const int K = g.K, nt = K / BK;
    unsigned voffA[2], voffB[2];
#pragma unroll
    for (int i = 0; i < 2; ++i) { int R, C; stage_rc(tid * 16 + i * 8192, R, C); const int Rb = Epi::PERM ? ((R & ~31) + perm32(R & 31)) : R;
        voffA[i] = (unsigned)(R * K + C) * 2u; voffB[i] = (unsigned)(Rb * K + C) * 2u; }
    const size_t kstep = (size_t)(BK * 2);
    const size_t hstep = (size_t)HALF * K * 2;
    const size_t tstep = 2 * hstep;
    const unsigned ldsw = (unsigned)wid * 1024u;
    const int aoff = lds_byte(wr * 64 + fr, fq * 8), boff = lds_byte(wc * 32 + fr, fq * 8);
#define PG8_SA(b, h) (((b) * 2 + (h)) * HTB)
#define PG8_SB(b, h) ((4 + (b) * 2 + (h)) * HTB)
#define PG8_STAGE(bufoff, gbase, voff) do { _Pragma("unroll") for (int _i = 0; _i < 2; ++_i) \
        __builtin_amdgcn_global_load_lds((const unsigned*)((const char*)(gbase) + (voff)[_i]), (PG8_LAS unsigned*)(lds + (bufoff) + ldsw + _i * 8192), 16, 0, 0); } while (0)
#define PG8_LDA(dst, b, h) do { _Pragma("unroll") for (int m = 0; m < 4; ++m) _Pragma("unroll") for (int k = 0; k < 2; ++k) dst[m][k] = *(const PG8_LAS bf16x8*)(lds + PG8_SA(b, h) + aoff + m * 2048 + k * 1024); } while (0)
#define PG8_LDB(dst, b, h) do { _Pragma("unroll") for (int n = 0; n < 2; ++n) _Pragma("unroll") for (int k = 0; k < 2; ++k) dst[n][k] = *(const PG8_LAS bf16x8*)(lds + PG8_SB(b, h) + boff + n * 2048 + k * 1024); } while (0)
#define PG8_MMA(ai, bj, At, Bt) do { __builtin_amdgcn_s_setprio(1); _Pragma("unroll") for (int m = 0; m < 4; ++m) _Pragma("unroll") for (int n = 0; n < 2; ++n) _Pragma("unroll") for (int k = 0; k < 2; ++k) \
        acc[ai][bj][m][n] = __builtin_amdgcn_mfma_f32_16x16x32_bf16(Bt[n][k], At[m][k], acc[ai][bj][m][n], 0, 0, 0); __builtin_amdgcn_s_setprio(0); } while (0)
#define PG8_WAIT_V(n) asm volatile("s_waitcnt vmcnt(" #n ")" ::: "memory")
#define PG8_WAIT_L(n) asm volatile("s_waitcnt lgkmcnt(" #n ")" ::: "memory")
#define PG8_BAR __builtin_amdgcn_s_barrier()
#define PG8_SCHED __builtin_amdgcn_sched_barrier(0)
    Unit cur, nxt; int ui = 0;
    if (!S.next(0, cur)) return;
    f32x4 acc[2][2][4][2];
#pragma unroll
    for (int a = 0; a < 2; ++a)
#pragma unroll
        for (int b = 0; b < 2; ++b)
#pragma unroll
            for (int m = 0; m < 4; ++m)
#pragma unroll
                for (int n = 0; n < 2; ++n) acc[a][b][m][n] = (f32x4){0.f, 0.f, 0.f, 0.f};
    bf16x8 At[4][2], B0[2][2], B1[2][2];
    const char* cA = (const char*)g.A + (size_t)cur.pm * tstep; const char* cB = (const char*)g.Bt + (size_t)cur.pn * tstep;
    S.a_ready(cur);
    if constexpr (SP2) {
        PG8_STAGE(PG8_SB(0, 0), cB, voffB); PG8_STAGE(PG8_SB(0, 1), cB + hstep, voffB); PG8_STAGE(PG8_SA(0, 0), cA, voffA); PG8_STAGE(PG8_SA(0, 1), cA + hstep, voffA);
        if (wr == 1) PG8_BAR;
        PG8_WAIT_V(2); PG8_BAR;
        PG8_STAGE(PG8_SB(1, 0), cB + kstep, voffB); PG8_STAGE(PG8_SA(1, 0), cA + kstep, voffA); PG8_STAGE(PG8_SB(1, 1), cB + hstep + kstep, voffB);
        PG8_WAIT_V(6); PG8_BAR;
    } else {
        PG8_STAGE(PG8_SB(0, 0), cB, voffB); PG8_STAGE(PG8_SA(0, 0), cA, voffA); PG8_STAGE(PG8_SB(0, 1), cB + hstep, voffB); PG8_STAGE(PG8_SA(0, 1), cA + hstep, voffA);
        if (wr == 1) PG8_BAR;
        PG8_WAIT_V(4); PG8_BAR;
        PG8_STAGE(PG8_SB(1, 0), cB + kstep, voffB); PG8_STAGE(PG8_SA(1, 0), cA + kstep, voffA); PG8_STAGE(PG8_SB(1, 1), cB + hstep + kstep, voffB);
        PG8_WAIT_V(6); PG8_BAR;
    }
    for (;;) {
        const bool has_next = S.next(ui + 1, nxt);
        const char* nA = has_next ? (const char*)g.A + (size_t)nxt.pm * tstep : cA; const char* nB = has_next ? (const char*)g.Bt + (size_t)nxt.pn * tstep : cB;
        for (int t = 0; t < nt; t += 2) {
            const bool last = (t == nt - 2);
            const char* a1 = cA + (size_t)(t + 1) * kstep;
            const char* a2 = last ? nA : cA + (size_t)(t + 2) * kstep; const char* b2 = last ? nB : cB + (size_t)(t + 2) * kstep;
            const char* a3 = a2 + kstep; const char* b3 = b2 + kstep;
            if (last && has_next) S.a_ready(nxt);
            if constexpr (SP2) {
            PG8_LDB(B0, 0, 0); PG8_LDB(B1, 0, 1); PG8_SCHED; PG8_LDA(At, 0, 0); PG8_STAGE(PG8_SA(1, 1), a1 + hstep, voffA);
            PG8_WAIT_V(8); PG8_WAIT_L(0); PG8_BAR; PG8_MMA(0, 0, At, B0); PG8_MMA(0, 1, At, B1); PG8_BAR; PG8_SCHED;
            PG8_LDA(At, 0, 1); PG8_STAGE(PG8_SB(0, 0), b2, voffB); PG8_STAGE(PG8_SB(0, 1), b2 + hstep, voffB); PG8_STAGE(PG8_SA(0, 0), a2, voffA);
            PG8_WAIT_V(8); PG8_WAIT_L(0); PG8_BAR; PG8_MMA(1, 0, At, B0); PG8_MMA(1, 1, At, B1); PG8_BAR; PG8_SCHED;
            PG8_LDB(B0, 1, 0); PG8_LDB(B1, 1, 1); PG8_SCHED; PG8_LDA(At, 1, 0); PG8_STAGE(PG8_SA(0, 1), a2 + hstep, voffA);
            PG8_WAIT_V(8); PG8_WAIT_L(0); PG8_BAR; PG8_MMA(0, 0, At, B0); PG8_MMA(0, 1, At, B1); PG8_BAR; PG8_SCHED;
            PG8_LDA(At, 1, 1); PG8_STAGE(PG8_SB(1, 0), b3, voffB); PG8_STAGE(PG8_SB(1, 1), b3 + hstep, voffB); PG8_STAGE(PG8_SA(1, 0), a3, voffA);
            PG8_WAIT_V(8); PG8_WAIT_L(0); PG8_BAR; PG8_MMA(1, 0, At, B0); PG8_MMA(1, 1, At, B1); PG8_BAR; PG8_SCHED;
            } else {
            PG8_LDB(B0, 0, 0); PG8_SCHED; PG8_LDA(At, 0, 0); PG8_STAGE(PG8_SA(1, 1), a1 + hstep, voffA);
            PG8_WAIT_L(8); PG8_BAR; PG8_WAIT_L(0); PG8_MMA(0, 0, At, B0); PG8_BAR; PG8_SCHED;
            PG8_LDB(B1, 0, 1); PG8_STAGE(PG8_SB(0, 0), b2, voffB);
            PG8_BAR; PG8_WAIT_L(0); PG8_MMA(0, 1, At, B1); PG8_BAR;
            PG8_LDA(At, 0, 1); PG8_STAGE(PG8_SA(0, 0), a2, voffA);
            PG8_BAR; PG8_WAIT_L(0); PG8_MMA(1, 0, At, B0); PG8_BAR; PG8_SCHED;
            PG8_STAGE(PG8_SB(0, 1), b2 + hstep, voffB);
            PG8_WAIT_V(6); PG8_BAR; PG8_MMA(1, 1, At, B1); PG8_BAR;
            PG8_LDB(B0, 1, 0); PG8_SCHED; PG8_LDA(At, 1, 0); PG8_STAGE(PG8_SA(0, 1), a2 + hstep, voffA);
            PG8_WAIT_L(8); PG8_BAR; PG8_WAIT_L(0); PG8_MMA(0, 0, At, B0); PG8_BAR; PG8_SCHED;
            PG8_LDB(B1, 1, 1); PG8_STAGE(PG8_SB(1, 0), b3, voffB);
            PG8_BAR; PG8_WAIT_L(0); PG8_MMA(0, 1, At, B1); PG8_BAR;
            PG8_LDA(At, 1, 1); PG8_STAGE(PG8_SA(1, 0), a3, voffA);
            PG8_BAR; PG8_WAIT_L(0); PG8_MMA(1, 0, At, B0); PG8_BAR; PG8_SCHED;
            PG8_STAGE(PG8_SB(1, 1), b3 + hstep, voffB);
            PG8_WAIT_V(6); PG8_BAR; PG8_MMA(1, 1, At, B1); PG8_BAR;
            }
        }
        if constexpr (ALIGN_EPI) { if (wr == 0) PG8_BAR; }
        if constexpr (!Epi::AFTER_DRAIN) { E(acc, cur, wr, wc, fr, fq); S.done(cur); }
        if (!has_next) break;
#pragma unroll
        for (int a = 0; a < 2; ++a)
#pragma unroll
            for (int b = 0; b < 2; ++b)
#pragma unroll
                for (int m = 0; m < 4; ++m)
#pragma unroll
                    for (int n = 0; n < 2; ++n) acc[a][b][m][n] = (f32x4){0.f, 0.f, 0.f, 0.f};
        cur = nxt; cA = nA; cB = nB; ++ui;
        if constexpr (ALIGN_EPI) { if (wr == 1) PG8_BAR; }
    }
    PG8_WAIT_V(0);
    if constexpr (!ALIGN_EPI) { if (wr == 0) PG8_BAR; }
    PG8_BAR;
    if constexpr (Epi::AFTER_DRAIN) { E.fused(acc, cur, wr, wc, fr, fq, lds, wid, lane); S.done(cur); }
#undef PG8_SA
#undef PG8_SB
#undef PG8_STAGE
#undef PG8_LDA
#undef PG8_LDB
#undef PG8_MMA
#undef PG8_WAIT_V
#undef PG8_WAIT_L
#undef PG8_BAR
#undef PG8_SCHED
}
}

constexpr int GEMM_LDS = pg8::STAGE_BYTES;
__global__ __launch_bounds__(512, 2) void k_gemm_inproj(const bf16_t* A, const bf16_t* Bt, bf16_t* P, const float* rope) {
    extern __shared__ __attribute__((aligned(16))) unsigned char lds_raw[];
    pg8::Gemm g{A, Bt, NTOK, NP, DM}; pg8::StaticOrder S; S.init(NTOK, NP, (int)gridDim.x, (int)blockIdx.x);
    pg8::EpiInProj E{P, NP, rope};
    pg8::gemm_phase<pg8::EpiInProj, pg8::StaticOrder, true, true>((PG8_LAS unsigned char*)lds_raw, g, S, E);
}
__global__ __launch_bounds__(512, 2) void k_gemm_outproj(const bf16_t* A, const bf16_t* Bt, bf16_t* C, int M) {
    extern __shared__ __attribute__((aligned(16))) unsigned char lds_raw[];
    pg8::Gemm g{A, Bt, M, DM, DM}; pg8::StaticOrder S; S.init(M, DM, (int)gridDim.x, (int)blockIdx.x);
    pg8::EpiBf16 E{C, DM};
    pg8::gemm_phase<pg8::EpiBf16, pg8::StaticOrder, true, true>((PG8_LAS unsigned char*)lds_raw, g, S, E);
}

__global__ __launch_bounds__(256) void k_rope_apply(bf16_t* __restrict__ P, const float2* __restrict__ ROPE) {
    const size_t total = (size_t)NLAT * 1024;
    for (size_t i = (size_t)blockIdx.x * 256 + threadIdx.x; i < total; i += (size_t)gridDim.x * 256) {
        const int row = (int)(i >> 10), p = (int)(i & 1023);
        const int t = row % SEQ;
        const int ip = p & 31;
        const int pos = (ip < 16) ? (t >> 6) : (t & 63);
        const float2 cs = ROPE[pos * 16 + (ip & 15)];
        unsigned* ptr = (unsigned*)(P + (size_t)row * NP + 2 * p);
        const unsigned w = *ptr;
        const float x1 = __uint_as_float(w << 16), x2 = __uint_as_float(w & 0xffff0000u);
        *ptr = pk2(x1 * cs.x - x2 * cs.y, x1 * cs.y + x2 * cs.x);
    }
}

template <bool CTXQ>
__global__ __launch_bounds__(128) void k_attn_naive(const bf16_t* __restrict__ P, bf16_t* __restrict__ Y, const float* __restrict__ lq1, const float* __restrict__ lk1,
                                                    const float* __restrict__ lq2, const float* __restrict__ lk2, const float* __restrict__ subln, float lam_init) {
    __shared__ float sb[2][2][2304];
    __shared__ float qb[2][128];
    const int w = threadIdx.x >> 6, lane = threadIdx.x & 63;
    const int t = blockIdx.x * 2 + w, hh = blockIdx.y, b = blockIdx.z;
    const int nkeys = CTXQ ? CTXL : (CTXL + SEQ);
    const size_t qrow = CTXQ ? (size_t)(NLAT + b * CTXL + t) : (size_t)(b * SEQ + t);
    const float lam = expf(wave_sum(lq1[lane] * lk1[lane])) - expf(wave_sum(lq2[lane] * lk2[lane])) + lam_init;
    qb[w][lane] = bf2f(P[qrow * NP + C_QA + hh * 128 + lane]);
    qb[w][64 + lane] = bf2f(P[qrow * NP + C_QA + hh * 128 + 64 + lane]);
    __syncthreads();
    float mx1 = -INFINITY, mx2 = -INFINITY;
    for (int j = lane; j < nkeys; j += 64) {
        const size_t kr = (j < CTXL) ? (size_t)(NLAT + b * CTXL + j) : (size_t)(b * SEQ + j - CTXL);
        const uint4* kp = (const uint4*)(P + kr * NP + C_KA + hh * 128);
        float s1 = 0.f, s2 = 0.f;
#pragma unroll
        for (int q = 0; q < 8; ++q) {
            const uint4 a = kp[q], c = kp[8 + q];
            const unsigned aw[4] = {a.x, a.y, a.z, a.w}, cw[4] = {c.x, c.y, c.z, c.w};
#pragma unroll
            for (int i = 0; i < 4; ++i) {
                s1 += qb[w][q * 8 + 2 * i] * __uint_as_float(aw[i] << 16) + qb[w][q * 8 + 2 * i + 1] * __uint_as_float(aw[i] & 0xffff0000u);
                s2 += qb[w][64 + q * 8 + 2 * i] * __uint_as_float(cw[i] << 16) + qb[w][64 + q * 8 + 2 * i + 1] * __uint_as_float(cw[i] & 0xffff0000u);
            }
        }
        s1 *= 0.125f; s2 *= 0.125f;
        sb[w][0][j] = s1; sb[w][1][j] = s2; mx1 = fmaxf(mx1, s1); mx2 = fmaxf(mx2, s2);
    }
    mx1 = wave_max(mx1); mx2 = wave_max(mx2);
    float l1 = 0.f, l2 = 0.f;
    for (int j = lane; j < nkeys; j += 64) {
        const float p1 = expf(sb[w][0][j] - mx1), p2 = expf(sb[w][1][j] - mx2);
        sb[w][0][j] = p1; sb[w][1][j] = p2; l1 += p1; l2 += p2;
    }
    l1 = wave_sum(l1); l2 = wave_sum(l2);
    const float r1 = 1.f / l1, r2 = lam / l2;
    for (int j = lane; j < nkeys; j += 64) sb[w][0][j] = sb[w][0][j] * r1 - sb[w][1][j] * r2;
    __syncthreads();
    float o0 = 0.f, o1 = 0.f;
    for (int j = 0; j < nkeys; ++j) {
        const size_t kr = (j < CTXL) ? (size_t)(NLAT + b * CTXL + j) : (size_t)(b * SEQ + j - CTXL);
        const unsigned vv = *(const unsigned*)(P + kr * NP + C_VA + hh * 128 + 2 * lane);
        const float a = sb[w][0][j];
        o0 += a * __uint_as_float(vv << 16); o1 += a * __uint_as_float(vv & 0xffff0000u);
    }
    const float ss = wave_sum(o0 * o0 + o1 * o1);
    const float r = rsqrtf(ss * (1.f / 128.f) + EPS) * (1.f - lam_init);
    const unsigned gg = *(const unsigned*)(P + qrow * NP + C_GA + hh * 128 + 2 * lane);
    const float g0 = __uint_as_float(gg << 16), g1 = __uint_as_float(gg & 0xffff0000u);
    const float y0 = o0 * r * subln[2 * lane] * silu_f(g0), y1 = o1 * r * subln[2 * lane + 1] * silu_f(g1);
    *(unsigned*)(Y + qrow * DM + hh * 128 + 2 * lane) = pk2(y0, y1);
}


namespace att {
using bf16x8 = __attribute__((ext_vector_type(8))) short;
using s16x4  = __attribute__((ext_vector_type(4))) short;
using f32x16 = __attribute__((ext_vector_type(16))) float;
using u32x4  = __attribute__((ext_vector_type(4))) unsigned;
constexpr int NW = 8, QBLK = 32, KVBLK = 64, QROWS = 128;
constexpr float SCALE = 0.125f, THR = 6.f;
constexpr int SHM_V = KVBLK * 128 * 2, SHM_K = KVBLK * 128 * 2, SHM_ATTN = 2 * SHM_V + 2 * SHM_K + NW * 64 * 4;
#define KSWZ(row, colB) ((row) * 256 + ((colB) ^ (((row) & 7) << 4)))
#define SBAR() __builtin_amdgcn_sched_barrier(0)
__device__ __forceinline__ int crow(int r, int hi) { return (r & 3) + 8 * (r >> 2) + 4 * hi; }
__device__ __forceinline__ unsigned cvtpk(float lo, float hi) { unsigned r; asm volatile("v_cvt_pk_bf16_f32 %0, %1, %2" : "=v"(r) : "v"(lo), "v"(hi)); return r; }
__device__ __forceinline__ void partialSM(f32x16& p0, f32x16& p1, float& m_reg, float& mn, float& alpha) {
  constexpr float C = SCALE * 1.4426950408889634f;
  float pmax = p0[0];
#pragma unroll
  for (int r = 1; r < 16; ++r) pmax = fmaxf(pmax, p0[r]);
#pragma unroll
  for (int r = 0; r < 16; ++r) pmax = fmaxf(pmax, p1[r]);
  { auto rr = __builtin_amdgcn_permlane32_swap(__float_as_uint(pmax), __float_as_uint(pmax), false, false);
    pmax = fmaxf(__uint_as_float(rr[0]), __uint_as_float(rr[1])); }
  if (__builtin_expect(__all(pmax - m_reg <= THR / SCALE), 1)) { mn = m_reg; alpha = 1.f; }
  else { mn = fmaxf(m_reg, pmax); alpha = __builtin_amdgcn_exp2f((m_reg - mn) * C); m_reg = mn; }
  const float mnC = -mn * C;
#pragma unroll
  for (int r = 0; r < 16; ++r) p0[r] = fmaf(p0[r], C, mnC);
#pragma unroll
  for (int r = 0; r < 16; ++r) p1[r] = fmaf(p1[r], C, mnC);
#pragma unroll
  for (int r = 0; r < 16; ++r) p0[r] = __builtin_amdgcn_exp2f(p0[r]);
}
__device__ __forceinline__ void finishSM(f32x16& p0, f32x16& p1, float alpha, float& l_reg, bf16x8& pa0, bf16x8& pa1, bf16x8& pa2, bf16x8& pa3) {
#pragma unroll
  for (int r = 0; r < 16; ++r) p1[r] = __builtin_amdgcn_exp2f(p1[r]);
  float ps = 0;
#pragma unroll
  for (int r = 0; r < 16; ++r) ps += p0[r];
#pragma unroll
  for (int r = 0; r < 16; ++r) ps += p1[r];
  { auto rr = __builtin_amdgcn_permlane32_swap(__float_as_uint(ps), __float_as_uint(ps), false, false);
    ps = __uint_as_float(rr[0]) + __uint_as_float(rr[1]); }
  l_reg = l_reg * alpha + ps;
#define PK4(P, BASE, OUT) do { unsigned a0 = cvtpk(P[BASE + 0], P[BASE + 1]), a1 = cvtpk(P[BASE + 2], P[BASE + 3]);   \
    unsigned b0 = cvtpk(P[BASE + 4], P[BASE + 5]), b1 = cvtpk(P[BASE + 6], P[BASE + 7]);                              \
    auto r0 = __builtin_amdgcn_permlane32_swap(a0, b0, false, false); auto r1 = __builtin_amdgcn_permlane32_swap(a1, b1, false, false); \
    u32x4 w = {r0[0], r1[0], r0[1], r1[1]}; OUT = *reinterpret_cast<bf16x8*>(&w); } while (0)
  PK4(p0, 0, pa0); PK4(p0, 8, pa1); PK4(p1, 0, pa2); PK4(p1, 8, pa3);
#undef PK4
}
__device__ __forceinline__ void qkt(f32x16& p0, f32x16& p1, const char* Ks, const bf16x8* qr, int r32, int hi, int sub) {
  p0 = f32x16{}; p1 = f32x16{};
#pragma unroll
  for (int d0 = 0; d0 < 4; ++d0) { const int cb = (sub * 64 + d0 * 16 + hi * 8) * 2;
    const bf16x8 b0 = *reinterpret_cast<const bf16x8*>(Ks + KSWZ(r32, cb));
    const bf16x8 b1 = *reinterpret_cast<const bf16x8*>(Ks + KSWZ(32 + r32, cb));
    p0 = __builtin_amdgcn_mfma_f32_32x32x16_bf16(b0, qr[d0], p0, 0, 0, 0);
    p1 = __builtin_amdgcn_mfma_f32_32x32x16_bf16(b1, qr[d0], p1, 0, 0, 0); }
}
__device__ __forceinline__ int v_st(int k, int c) { const int kk = (k & ~0xC) | ((k & 4) << 1) | ((k & 8) >> 1); return ((kk >> 3) * 4 + (c >> 5)) * 512 + ((kk & 7) * 32 + (c & 31)) * 2; }
__device__ __forceinline__ int v_rd_base(int lane) { return ((lane & 3) << 3) | (((lane >> 2) & 3) << 6) | (((lane >> 4) & 1) << 5) | (((lane >> 5) & 1) << 8); }
constexpr int v_rd_off(int d0, int ks, int half) { return d0 * 512 + ks * 4096 + half * 2048; }
template <int OFF> __device__ __forceinline__ s16x4 tr_read(int vb) {
  s16x4 r; asm volatile("ds_read_b64_tr_b16 %0, %1 offset:%2" : "=&v"(r) : "v"(vb), "i"(OFF) : "memory"); return r;
}
template <int D0> __device__ __forceinline__ void pv_one(f32x16& od, int vb, bf16x8 pa0, bf16x8 pa1, bf16x8 pa2, bf16x8 pa3) {
  const s16x4 l0 = tr_read<v_rd_off(D0, 0, 0)>(vb), h0 = tr_read<v_rd_off(D0, 0, 1)>(vb), l1 = tr_read<v_rd_off(D0, 1, 0)>(vb), h1 = tr_read<v_rd_off(D0, 1, 1)>(vb);
  const s16x4 l2 = tr_read<v_rd_off(D0, 2, 0)>(vb), h2 = tr_read<v_rd_off(D0, 2, 1)>(vb), l3 = tr_read<v_rd_off(D0, 3, 0)>(vb), h3 = tr_read<v_rd_off(D0, 3, 1)>(vb);
  asm volatile("s_waitcnt lgkmcnt(0)" ::: "memory"); SBAR();
#define PK(L, H) (bf16x8){L[0], L[1], L[2], L[3], H[0], H[1], H[2], H[3]}
  od = __builtin_amdgcn_mfma_f32_32x32x16_bf16(pa0, PK(l0, h0), od, 0, 0, 0);
  od = __builtin_amdgcn_mfma_f32_32x32x16_bf16(pa1, PK(l1, h1), od, 0, 0, 0);
  od = __builtin_amdgcn_mfma_f32_32x32x16_bf16(pa2, PK(l2, h2), od, 0, 0, 0);
  od = __builtin_amdgcn_mfma_f32_32x32x16_bf16(pa3, PK(l3, h3), od, 0, 0, 0);
#undef PK
}
__device__ __forceinline__ void pv_d0(f32x16* o, int vb, bf16x8 pa0, bf16x8 pa1, bf16x8 pa2, bf16x8 pa3) {
  pv_one<0>(o[0], vb, pa0, pa1, pa2, pa3); pv_one<1>(o[1], vb, pa0, pa1, pa2, pa3); pv_one<2>(o[2], vb, pa0, pa1, pa2, pa3); pv_one<3>(o[3], vb, pa0, pa1, pa2, pa3);
}
__device__ __forceinline__ long ktile_row(int b, int t) { return t < 4 ? (long)(NLAT + b * CTXL + 64 * t) : (long)(b * SEQ + 64 * (t - 4)); }

__device__ __forceinline__ void attn_unit(const bf16_t* __restrict__ Pm, bf16_t* __restrict__ Y, long qrow0, int b, int hh, int NT, float lam, float lam_init,
                                          const float* __restrict__ subln, char* lds) {
  const int tid = threadIdx.x, wid = tid >> 6, lane = tid & 63, r32 = lane & 31, hi = lane >> 5;
  const int sub = wid & 1, pr = wid >> 1;
  char* V_lds = lds; char* K_lds = lds + 2 * SHM_V;
  float* ws = (float*)(lds + 2 * SHM_V + 2 * SHM_K) + wid * 64; float* li_l = ws; float* al_l = ws + 32;
  float m_reg = -1e30f, l_reg = 0; f32x16 o[4] = {}; bf16x8 qr[4];
  const bf16_t* Qw = Pm + (qrow0 + pr * QBLK + r32) * NP + C_QA + hh * 128 + sub * 64 + hi * 8;
#pragma unroll
  for (int d0 = 0; d0 < 4; ++d0) qr[d0] = *reinterpret_cast<const bf16x8*>(Qw + d0 * 16);
  const int sr = tid >> 4, sc = (tid & 15) * 8, vst0 = v_st(sr, sc), vst1 = v_st(32 + sr, sc);
  const int vb0 = (int)(uintptr_t)V_lds + v_rd_base(lane);
  const bf16_t* Kcol = Pm + C_KA + hh * 128 + sc; const bf16_t* Vcol = Pm + C_VA + hh * 128 + sc;
  struct { bf16x8 vs0, vs1, ks0, ks1; } sr_[2];
#define SLOAD(i, t) do { const long r0_ = ktile_row(b, (t)) + sr; \
    sr_[i].vs0 = *reinterpret_cast<const bf16x8*>(Vcol + r0_ * NP); sr_[i].vs1 = *reinterpret_cast<const bf16x8*>(Vcol + (r0_ + 32) * NP); \
    sr_[i].ks0 = *reinterpret_cast<const bf16x8*>(Kcol + r0_ * NP); sr_[i].ks1 = *reinterpret_cast<const bf16x8*>(Kcol + (r0_ + 32) * NP); } while (0)
#define SWRITE(bb, i) do { *(bf16x8*)(V_lds + (bb) * SHM_V + vst0) = sr_[i].vs0; *(bf16x8*)(V_lds + (bb) * SHM_V + vst1) = sr_[i].vs1; const int kc = sc * 2; \
    *(bf16x8*)(K_lds + (bb) * SHM_K + KSWZ(sr, kc)) = sr_[i].ks0; *(bf16x8*)(K_lds + (bb) * SHM_K + KSWZ(32 + sr, kc)) = sr_[i].ks1; } while (0)
#define SWAIT() asm volatile("s_waitcnt vmcnt(4)" ::: "memory")
#define RESC(a) do { if (__any((a) < 1.f)) { if (hi == 0) al_l[r32] = (a); asm volatile("s_waitcnt lgkmcnt(0)" ::: "memory"); \
    _Pragma("unroll") for (int d = 0; d < 4; ++d) _Pragma("unroll") for (int r = 0; r < 16; ++r) o[d][r] *= al_l[crow(r, hi)]; } } while (0)
  f32x16 pA0, pA1, pB0, pB1; float mnA, mnB, alA, alB; bf16x8 pa0, pa1, pa2, pa3;
  constexpr int SE = 0, SO = 1;
  SLOAD(SE, 0); asm volatile("s_waitcnt vmcnt(0)" ::: "memory"); SWRITE(0, SE); __syncthreads();
  qkt(pA0, pA1, K_lds, qr, r32, hi, sub); partialSM(pA0, pA1, m_reg, mnA, alA);
  SLOAD(SO, 1); if (2 < NT) SLOAD(SE, 2);
  SWAIT(); SWRITE(1, SO); __syncthreads();
  for (int j = 1; j + 1 < NT; j += 2) {
    SBAR(); qkt(pB0, pB1, K_lds + SHM_K, qr, r32, hi, sub);
    finishSM(pA0, pA1, alA, l_reg, pa0, pa1, pa2, pa3); SBAR();
    SLOAD(SO, j + 2); SBAR();
    pv_d0(o, vb0, pa0, pa1, pa2, pa3); partialSM(pB0, pB1, m_reg, mnB, alB);
    __syncthreads(); SWAIT(); SWRITE(0, SE);
    RESC(alB); __syncthreads();
    SBAR(); qkt(pA0, pA1, K_lds, qr, r32, hi, sub);
    finishSM(pB0, pB1, alB, l_reg, pa0, pa1, pa2, pa3); SBAR();
    if (j + 3 < NT) SLOAD(SE, j + 3); SBAR();
    pv_d0(o, vb0 + SHM_V, pa0, pa1, pa2, pa3); partialSM(pA0, pA1, m_reg, mnA, alA);
    __syncthreads(); SWAIT(); SWRITE(1, SO);
    RESC(alA); __syncthreads();
  }
  SBAR(); qkt(pB0, pB1, K_lds + SHM_K, qr, r32, hi, sub);
  finishSM(pA0, pA1, alA, l_reg, pa0, pa1, pa2, pa3); SBAR();
  pv_d0(o, vb0, pa0, pa1, pa2, pa3); partialSM(pB0, pB1, m_reg, mnB, alB);
  __syncthreads(); RESC(alB);
  finishSM(pB0, pB1, alB, l_reg, pa0, pa1, pa2, pa3); SBAR();
  pv_d0(o, vb0 + SHM_V, pa0, pa1, pa2, pa3);
  if (hi == 0) li_l[r32] = l_reg; asm volatile("s_waitcnt lgkmcnt(0)" ::: "memory");
  const float fac = sub ? lam : 1.f;
#pragma unroll
  for (int r = 0; r < 16; ++r) { const float rl = fac * __builtin_amdgcn_rcpf(li_l[crow(r, hi)]);
#pragma unroll
    for (int d0 = 0; d0 < 4; ++d0) o[d0][r] *= rl; }
  __syncthreads();
  float* XB = (float*)lds + pr * 4096;
  if (sub == 1) {
#pragma unroll
    for (int d0 = 0; d0 < 4; ++d0)
#pragma unroll
      for (int r = 0; r < 16; ++r) XB[(d0 * 16 + r) * 64 + lane] = o[d0][r];
  }
  __syncthreads();
  if (sub == 0) {
    float ss[16];
#pragma unroll
    for (int r = 0; r < 16; ++r) { float a = 0.f;
#pragma unroll
      for (int d0 = 0; d0 < 4; ++d0) { o[d0][r] -= XB[(d0 * 16 + r) * 64 + lane]; a += o[d0][r] * o[d0][r]; }
      ss[r] = a; }
#pragma unroll
    for (int r = 0; r < 16; ++r) {
#pragma unroll
      for (int off = 1; off < 32; off <<= 1) ss[r] += __shfl_xor(ss[r], off);
      ss[r] = rsqrtf(ss[r] * (1.f / 128.f) + EPS) * (1.f - lam_init);
    }
    float sw[4];
#pragma unroll
    for (int d0 = 0; d0 < 4; ++d0) sw[d0] = subln[d0 * 32 + r32];
#pragma unroll
    for (int r = 0; r < 16; ++r) { const long row = qrow0 + pr * QBLK + crow(r, hi);
      const bf16_t* gp = Pm + row * NP + C_GA + hh * 128 + r32; bf16_t* yp = Y + row * DM + hh * 128 + r32;
#pragma unroll
      for (int d0 = 0; d0 < 4; ++d0) { const float g = bf2f(gp[d0 * 32]); yp[d0 * 32] = f2bf(o[d0][r] * ss[r] * sw[d0] * (g / (1.f + __expf(-g)))); } }
  }
  __syncthreads();
#undef SLOAD
#undef SWRITE
#undef SWAIT
#undef RESC
}
__device__ __forceinline__ void attn_phase(const bf16_t* __restrict__ Pm, bf16_t* __restrict__ Y, const float* lq1, const float* lk1, const float* lq2, const float* lk2,
                                           const float* __restrict__ subln, float lam_init, bool ctx_out, char* lds) {
  const int lane = threadIdx.x & 63;
  const float lam = expf(wave_sum(lq1[lane] * lk1[lane])) - expf(wave_sum(lq2[lane] * lk2[lane])) + lam_init;
  const int G = gridDim.x, bx = blockIdx.x; const int vcu = (G % 8 == 0) ? (bx % 8) * (G / 8) + bx / 8 : bx;
  const int nunits = 1024 + (ctx_out ? 128 : 0);
  for (int u = vcu; u < nunits; u += G) {
    if (u < 1024) { const int bh = u >> 4, qb = u & 15, b = bh >> 3, hh = bh & 7; attn_unit(Pm, Y, (long)b * SEQ + qb * QROWS, b, hh, 36, lam, lam_init, subln, lds); }
    else { const int v = u - 1024, bh = v >> 1, qb = v & 1, b = bh >> 3, hh = bh & 7; attn_unit(Pm, Y, (long)NLAT + b * CTXL + qb * QROWS, b, hh, 4, lam, lam_init, subln, lds); }
  }
}
#undef KSWZ
#undef SBAR
}
__global__ __launch_bounds__(512, 2) void k_attn_fast(const bf16_t* Pm, bf16_t* Y, const float* lq1, const float* lk1, const float* lq2, const float* lk2, const float* subln, float lam_init, int ctx_out) {
    extern __shared__ __attribute__((aligned(16))) unsigned char lds_raw[];
    att::attn_phase(Pm, Y, lq1, lk1, lq2, lk2, subln, lam_init, ctx_out != 0, (char*)lds_raw);
}

constexpr int QS = 129;
constexpr int MLSTM_LDS_FLOATS = 2 * 64 * QS + 64 * 64 + 64 * 256 + 64 * 7 + 128 + 8;
__global__ __launch_bounds__(256) void k_mlstm_naive(const bf16_t* __restrict__ P, const float* __restrict__ GATES, bf16_t* __restrict__ HM, const float* __restrict__ conv_w,
                                                     const float* __restrict__ conv_b, const float* __restrict__ i_bias, const float* __restrict__ f_bias) {
    extern __shared__ float smem[];
    float* qs = smem; float* ks = qs + 64 * QS; float* S = ks + 64 * QS; float* vs = S + 64 * 64;
    float* bcum = vs + 64 * 256; float* ig = bcum + 64; float* lfv = ig + 64; float* mrow = lfv + 64; float* sc = mrow + 64; float* wk = sc + 64; float* den = wk + 64;
    float* nvec = den + 64; float* scal = nvec + 128;
    const int unit = blockIdx.x, dir = unit & 1, head = (unit >> 1) & 3, b = unit >> 3;
    const int tid = threadIdx.x;
    float C[128];
#pragma unroll
    for (int d = 0; d < 128; ++d) C[d] = 0.f;
    if (tid < 128) nvec[tid] = 0.f;
    float m = 0.f;
    const int ch = tid;
    const int cidx = (ch < 128) ? head * 128 + ch : 512 + head * 128 + (ch - 128);
    const int pcol = (ch < 128) ? C_QB + head * 128 + ch : C_KB + head * 128 + (ch - 128);
    const float cw0 = conv_w[cidx], cw1 = conv_w[1024 + cidx], cw2 = conv_w[2048 + cidx], cb = conv_b[cidx];
    __syncthreads();
    for (int c = 0; c < 36; ++c) {
        const bool isctx = c < 4; const int T = isctx ? CTXL : SEQ; const int cc = isctx ? c : c - 4;
        const int rowbase = isctx ? NLAT + b * CTXL : b * SEQ;
        const int tstart = dir ? (T - 1 - 64 * cc) : 64 * cc; const int tstep = dir ? -1 : 1;
        if (tid < 64) {
            const int t = tstart + tstep * tid; const size_t row = (size_t)(rowbase + t);
            const float gi = GATES[row * 16 + dir * 4 + head] + i_bias[dir * 4 + head];
            const float gf = GATES[row * 16 + 8 + dir * 4 + head] + f_bias[dir * 4 + head];
            const float igv = 15.f * tanhf(gi * (1.f / 15.f));
            const float fc = 15.f * tanhf(gf * (1.f / 15.f));
            ig[tid] = igv; lfv[tid] = fminf(fc, 0.f) - log1pf(expf(-fabsf(fc)));
        }
        for (int l = 0; l < 64; ++l) {
            const int t = tstart + tstep * l;
            const float x0 = (t > 0) ? bf2f(P[(size_t)(rowbase + t - 1) * NP + pcol]) : 0.f;
            const float x1 = bf2f(P[(size_t)(rowbase + t) * NP + pcol]);
            const float x2 = (t < T - 1) ? bf2f(P[(size_t)(rowbase + t + 1) * NP + pcol]) : 0.f;
            const float v = silu_f(cb + cw0 * x0 + cw1 * x1 + cw2 * x2);
            if (ch < 128) qs[l * QS + ch] = v; else ks[l * QS + ch - 128] = v * 0.08838834764831845f;
            vs[l * 256 + tid] = bf2f(P[(size_t)(rowbase + t) * NP + C_VB + head * 256 + tid]);
        }
        __syncthreads();
        if (tid == 0) { float a = 0.f; for (int l = 0; l < 64; ++l) { a += lfv[l]; bcum[l] = a; } }
        __syncthreads();
        if (tid < 64) {
            const float bl = bcum[tid]; float mx = bl + m;
            for (int s = 0; s <= tid; ++s) mx = fmaxf(mx, bl - bcum[s] + ig[s]);
            mrow[tid] = mx; sc[tid] = expf(bl + m - mx);
        }
        if (tid == 64) {
            const float blast = bcum[63]; float mn = blast + m;
            for (int s = 0; s < 64; ++s) mn = fmaxf(mn, blast - bcum[s] + ig[s]);
            scal[0] = mn; scal[1] = expf(blast + m - mn);
        }
        __syncthreads();
        const float m_new = scal[0], decay = scal[1];
        if (tid < 64) wk[tid] = expf(bcum[63] - bcum[tid] + ig[tid] - m_new);
        for (int idx = tid; idx < 4096; idx += 256) {
            const int l = idx >> 6, s = idx & 63; float val = 0.f;
            if (s <= l) { float dot = 0.f; for (int d = 0; d < 128; ++d) dot += qs[l * QS + d] * ks[s * QS + d]; val = dot * expf(bcum[l] - bcum[s] + ig[s] - mrow[l]); }
            S[idx] = val;
        }
        __syncthreads();
        if (tid < 64) {
            float dn = 0.f; for (int d = 0; d < 128; ++d) dn += qs[tid * QS + d] * nvec[d];
            dn *= sc[tid]; for (int s = 0; s < 64; ++s) dn += S[tid * 64 + s];
            den[tid] = fmaxf(fabsf(dn), expf(-mrow[tid]));
        }
        __syncthreads();
        for (int l = 0; l < 64; ++l) {
            float a = 0.f;
#pragma unroll
            for (int d = 0; d < 128; ++d) a += qs[l * QS + d] * C[d];
            a *= sc[l];
            for (int s = 0; s <= l; ++s) a += S[l * 64 + s] * vs[s * 256 + tid];
            const int t = tstart + tstep * l;
            HM[((size_t)dir * NTOK + rowbase + t) * 1024 + head * 256 + tid] = f2bf(a / den[l]);
        }
#pragma unroll
        for (int d = 0; d < 128; ++d) C[d] *= decay;
        for (int s = 0; s < 64; ++s) {
            const float wv = wk[s] * vs[s * 256 + tid];
#pragma unroll
            for (int d = 0; d < 128; ++d) C[d] += wv * ks[s * QS + d];
        }
        if (tid < 128) { float a = decay * nvec[tid]; for (int s = 0; s < 64; ++s) a += wk[s] * ks[s * QS + tid]; nvec[tid] = a; }
        m = m_new;
        __syncthreads();
    }
}

__global__ __launch_bounds__(256) void k_finish_mlstm(const bf16_t* __restrict__ P, const bf16_t* __restrict__ HM, const float* __restrict__ mnorm, bf16_t* __restrict__ Y) {
    const int wave = threadIdx.x >> 6, lane = threadIdx.x & 63;
    const int gw = blockIdx.x * 4 + wave, ngw = gridDim.x * 4;
    for (int row = gw; row < NTOK; row += ngw) {
#pragma unroll
        for (int head = 0; head < 4; ++head) {
            const int col = head * 256 + 4 * lane;
            const uint2 a = *(const uint2*)(HM + (size_t)row * 1024 + col), c = *(const uint2*)(HM + ((size_t)NTOK + row) * 1024 + col);
            float h[4];
            h[0] = __uint_as_float(a.x << 16) + __uint_as_float(c.x << 16); h[1] = __uint_as_float(a.x & 0xffff0000u) + __uint_as_float(c.x & 0xffff0000u);
            h[2] = __uint_as_float(a.y << 16) + __uint_as_float(c.y << 16); h[3] = __uint_as_float(a.y & 0xffff0000u) + __uint_as_float(c.y & 0xffff0000u);
            const float ss = wave_sum(h[0] * h[0] + h[1] * h[1] + h[2] * h[2] + h[3] * h[3]);
            const float r = rsqrtf(ss * (1.f / 256.f) + EPS);
            const uint2 ov = *(const uint2*)(P + (size_t)row * NP + C_OB + col), gv = *(const uint2*)(P + (size_t)row * NP + C_GB + col);
            const float o[4] = {__uint_as_float(ov.x << 16), __uint_as_float(ov.x & 0xffff0000u), __uint_as_float(ov.y << 16), __uint_as_float(ov.y & 0xffff0000u)};
            const float g[4] = {__uint_as_float(gv.x << 16), __uint_as_float(gv.x & 0xffff0000u), __uint_as_float(gv.y << 16), __uint_as_float(gv.y & 0xffff0000u)};
            const float4 w = *(const float4*)(mnorm + col);
            const float wv[4] = {w.x, w.y, w.z, w.w};
            float y[4];
#pragma unroll
            for (int e = 0; e < 4; ++e) y[e] = h[e] * r * wv[e] * sigmoid_f(o[e]) * silu_f(g[e]);
            uint2 out; out.x = pk2(y[0], y[1]); out.y = pk2(y[2], y[3]);
            *(uint2*)(Y + (size_t)row * DM + 1024 + col) = out;
        }
    }
}

__global__ __launch_bounds__(256) void k_post(const float* xlat, const float* xctx, const bf16_t* __restrict__ Y2, const float* __restrict__ mod_l,
                                              const float* __restrict__ npost, float* olat, float* octx, int nrows) {
    const int wave = threadIdx.x >> 6, lane = threadIdx.x & 63;
    const int gw = blockIdx.x * 4 + wave, ngw = gridDim.x * 4;
    for (int row = gw; row < nrows; row += ngw) {
        const bool isl = row < NLAT;
        const float* xr = isl ? xlat + (size_t)row * DM : xctx + (size_t)(row - NLAT) * DM;
        float* orow = isl ? olat + (size_t)row * DM : octx + (size_t)(row - NLAT) * DM;
        const int b = isl ? row / SEQ : 8;
        const float* gate = mod_l + (size_t)b * MODW + 2 * DM;
        float y[8][4]; float ss = 0.f;
#pragma unroll
        for (int j = 0; j < 8; ++j) {
            const uint2 a = *(const uint2*)(Y2 + (size_t)row * DM + 4 * (lane + 64 * j));
            y[j][0] = __uint_as_float(a.x << 16); y[j][1] = __uint_as_float(a.x & 0xffff0000u); y[j][2] = __uint_as_float(a.y << 16); y[j][3] = __uint_as_float(a.y & 0xffff0000u);
            ss += y[j][0] * y[j][0] + y[j][1] * y[j][1] + y[j][2] * y[j][2] + y[j][3] * y[j][3];
        }
        ss = wave_sum(ss);
        const float rstd = rsqrtf(ss * (1.f / DM) + EPS);
#pragma unroll
        for (int j = 0; j < 8; ++j) {
            const int k0 = 4 * (lane + 64 * j);
            const float4 xv = *(const float4*)(xr + k0), gt = *(const float4*)(gate + k0), w = *(const float4*)(npost + k0);
            float4 o;
            o.x = xv.x + gt.x * (y[j][0] * rstd * w.x); o.y = xv.y + gt.y * (y[j][1] * rstd * w.y);
            o.z = xv.z + gt.z * (y[j][2] * rstd * w.z); o.w = xv.w + gt.w * (y[j][3] * rstd * w.w);
            *(float4*)(orow + k0) = o;
        }
    }
}

extern "C" void kernel_launch(void* const* d_in, const int* in_sizes, int n_in, void* d_out, int out_size, void* d_ws, size_t ws_size, hipStream_t stream) {
    (void)in_sizes; (void)n_in; (void)out_size; (void)ws_size;
    const float* x = (const float*)d_in[0]; const float* c = (const float*)d_in[1]; const float* ctx = (const float*)d_in[2]; const float* c_ctx = (const float*)d_in[3];
    const float* w_ada = (const float*)d_in[4]; const float* b_ada = (const float*)d_in[5]; const float* norm_pre = (const float*)d_in[6]; const float* norm_post = (const float*)d_in[7];
    const float* w_in = (const float*)d_in[8]; const float* w_out = (const float*)d_in[9];
    const float* lq1 = (const float*)d_in[10]; const float* lk1 = (const float*)d_in[11]; const float* lq2 = (const float*)d_in[12]; const float* lk2 = (const float*)d_in[13];
    const float* subln = (const float*)d_in[14]; const float* conv_w = (const float*)d_in[15]; const float* conv_b = (const float*)d_in[16];
    const float* i_bias = (const float*)d_in[17]; const float* f_bias = (const float*)d_in[18]; const float* mnorm = (const float*)d_in[19];
    float* out = (float*)d_out; unsigned char* ws = (unsigned char*)d_ws;
    float* MOD = (float*)(ws + WS_MOD); float* SC = (float*)(ws + WS_SC); float2* ROPE = (float2*)(ws + WS_ROPE); float* GATES = (float*)(ws + WS_GATES);
    bf16_t* WOUT = (bf16_t*)(ws + WS_WOUT); bf16_t* WIN = (bf16_t*)(ws + WS_WIN); float* XC = (float*)(ws + WS_XC);
    bf16_t* H = (bf16_t*)(ws + WS_H); bf16_t* HM = (bf16_t*)(ws + WS_HM); bf16_t* P = (bf16_t*)(ws + WS_P);
    bf16_t* Y = H; bf16_t* Y2 = HM;

    const size_t mlstm_lds = (size_t)MLSTM_LDS_FLOATS * 4;
    (void)hipFuncSetAttribute((const void*)k_mlstm_naive, hipFuncAttributeMaxDynamicSharedMemorySize, (int)mlstm_lds);
    (void)hipFuncSetAttribute((const void*)k_attn_fast, hipFuncAttributeMaxDynamicSharedMemorySize, att::SHM_ATTN);
    (void)hipFuncSetAttribute((const void*)k_gemm_inproj, hipFuncAttributeMaxDynamicSharedMemorySize, GEMM_LDS);
    (void)hipFuncSetAttribute((const void*)k_gemm_outproj, hipFuncAttributeMaxDynamicSharedMemorySize, GEMM_LDS);

    k_silu_c<<<(9 * DM + 255) / 256, 256, 0, stream>>>(c, c_ctx, SC);
    k_mod<<<2 * MODW / 256, 256, 0, stream>>>(SC, w_ada, b_ada, MOD);
    k_rope_table<<<4, 256, 0, stream>>>(ROPE);
    for (int l = 0; l < 2; ++l) k_transpose<<<1024, 256, 0, stream>>>(w_out + (size_t)l * DM * DM, DM, DM, DM, WOUT + (size_t)l * DM * DM);

    for (int l = 0; l < 2; ++l) {
        const float lam_init = (float)(0.8 - 0.6 * exp(-0.3 * (double)l));
        const float* mod_l = MOD + (size_t)l * 9 * MODW;
        const float* w_in_l = w_in + (size_t)l * DM * INC;
        k_transpose<<<2048, 256, 0, stream>>>(w_in_l, INC, DM, NP, WIN);
        k_norm<<<2048, 256, 0, stream>>>(l == 0 ? x : out, l == 0 ? ctx : XC, mod_l, norm_pre + l * DM, w_in_l + NP, H, GATES);
        k_gemm_inproj<<<256, 512, GEMM_LDS, stream>>>(H, WIN, P, (const float*)ROPE);
        k_attn_fast<<<256, 512, att::SHM_ATTN, stream>>>(P, Y, lq1 + l * 64, lk1 + l * 64, lq2 + l * 64, lk2 + l * 64, subln + l * 128, lam_init, l == 0 ? 1 : 0);
        k_mlstm_naive<<<64, 256, mlstm_lds, stream>>>(P, GATES, HM, conv_w + (size_t)l * 3 * 1024, conv_b + l * 1024, i_bias + l * 8, f_bias + l * 8);
        k_finish_mlstm<<<2048, 256, 0, stream>>>(P, HM, mnorm + l * 1024, Y);
        k_gemm_outproj<<<256, 512, GEMM_LDS, stream>>>(Y, WOUT + (size_t)l * DM * DM, Y2, l == 0 ? NTOK : NLAT);
        k_post<<<2048, 256, 0, stream>>>(l == 0 ? x : out, l == 0 ? ctx : XC, Y2, mod_l, norm_post + l * DM, out, XC, l == 0 ? NTOK : NLAT);
    }
}
```

```cpp
#include <hip/hip_runtime.h>
#include <stdint.h>
#include <math.h>

#define DEVI __device__ __forceinline__
typedef unsigned short bf16_t;

constexpr int DM = 2048, NBATCH = 8, SEQ = 2048, CTXL = 256;
constexpr int NLAT = NBATCH * SEQ, NCTX = NBATCH * CTXL, NTOK = NLAT + NCTX;
constexpr int INC = 8208, NP = 8192, MODW = 6144;
constexpr int C_QA = 0, C_KA = 1024, C_VA = 2048, C_GA = 3072, C_QB = 4096, C_KB = 4608, C_VB = 5120, C_OB = 6144, C_GB = 7168;
constexpr float EPS = 1e-6f;

constexpr size_t MiB = (size_t)1 << 20;
constexpr size_t WS_CTL = 0, WS_MOD = 1 * MiB, WS_SC = WS_MOD + 512 * 1024, WS_ROPE = 2 * MiB, WS_GATES = 3 * MiB, WS_WOUT = 8 * MiB,
                 WS_WIN = 24 * MiB, WS_XC = 56 * MiB, WS_H = 72 * MiB, WS_HM = 144 * MiB, WS_P = 216 * MiB, WS_END = 504 * MiB;

DEVI float bf2f(bf16_t v) { return __uint_as_float(((unsigned)v) << 16); }
DEVI bf16_t f2bf(float f) { unsigned u = __float_as_uint(f); return (bf16_t)((u + 0x7fffu + ((u >> 16) & 1u)) >> 16); }
DEVI unsigned pk2(float lo, float hi) { return (unsigned)f2bf(lo) | ((unsigned)f2bf(hi) << 16); }
DEVI float wave_sum(float v) {
#pragma unroll
    for (int o = 32; o > 0; o >>= 1) v += __shfl_xor(v, o);
    return v;
}
DEVI float wave_max(float v) {
#pragma unroll
    for (int o = 32; o > 0; o >>= 1) v = fmaxf(v, __shfl_xor(v, o));
    return v;
}
DEVI float silu_f(float x) { return x / (1.f + expf(-x)); }
DEVI float sigmoid_f(float x) { return 1.f / (1.f + expf(-x)); }

__global__ void k_silu_c(const float* __restrict__ c, const float* __restrict__ c_ctx, float* __restrict__ SC) {
    int i = blockIdx.x * 256 + threadIdx.x;
    if (i < 9 * DM) { float v = (i < 8 * DM) ? c[i] : c_ctx[i - 8 * DM]; SC[i] = silu_f(v); }
}
__global__ __launch_bounds__(256) void k_mod(const float* __restrict__ SC, const float* __restrict__ w_ada, const float* __restrict__ b_ada, float* __restrict__ MOD) {
    int j = blockIdx.x * 256 + threadIdx.x;
    int l = j / MODW, jj = j % MODW;
    const float* w = w_ada + (size_t)l * DM * MODW + jj;
    float acc[9];
#pragma unroll
    for (int r = 0; r < 9; ++r) acc[r] = 0.f;
    for (int k = 0; k < DM; ++k) {
        float wv = w[(size_t)k * MODW];
#pragma unroll
        for (int r = 0; r < 9; ++r) acc[r] += SC[r * DM + k] * wv;
    }
#pragma unroll
    for (int r = 0; r < 9; ++r) MOD[(size_t)(l * 9 + r) * MODW + jj] = acc[r] + b_ada[l * MODW + jj];
}
__global__ void k_rope_table(float2* __restrict__ ROPE) {
    int i = blockIdx.x * 256 + threadIdx.x;
    if (i < 1024) { int pos = i >> 4, f = i & 15; float inv = powf(10000.f, -(float)f / 16.f); float ang = (float)pos * inv; ROPE[i] = make_float2(cosf(ang), sinf(ang)); }
}
DEVI void transpose_item(const float* __restrict__ W, int ldw, int K, int N, bf16_t* __restrict__ WT, float* scr, int item, int lane) {
    const int nblk = N / 32, kb = item / nblk, nb = item % nblk, k0 = 64 * kb, n0 = 32 * nb;
#pragma unroll 8
    for (int i = 0; i < 32; ++i) { const int kk = 2 * i + (lane >> 5); scr[kk * 33 + (lane & 31)] = W[(size_t)(k0 + kk) * ldw + n0 + (lane & 31)]; }
    asm volatile("s_waitcnt lgkmcnt(0)" ::: "memory");
    const int c = lane & 7;
#pragma unroll
    for (int j = 0; j < 4; ++j) {
        const int n = (lane >> 3) + 8 * j; const float* s = scr + (8 * c) * 33 + n;
        uint4 o; o.x = pk2(s[0 * 33], s[1 * 33]); o.y = pk2(s[2 * 33], s[3 * 33]); o.z = pk2(s[4 * 33], s[5 * 33]); o.w = pk2(s[6 * 33], s[7 * 33]);
        *(uint4*)(WT + (size_t)(n0 + n) * K + k0 + 8 * c) = o;
    }
    asm volatile("s_waitcnt lgkmcnt(0)" ::: "memory");
}
__global__ __launch_bounds__(256) void k_transpose(const float* __restrict__ W, int ldw, int K, int N, bf16_t* __restrict__ WT) {
    __shared__ float scr[4][64 * 33];
    const int wave = threadIdx.x >> 6, lane = threadIdx.x & 63;
    const int gw = blockIdx.x * 4 + wave, ngw = gridDim.x * 4;
    const int nitems = (K / 64) * (N / 32);
    for (int it = gw; it < nitems; it += ngw) transpose_item(W, ldw, K, N, WT, scr[wave], it, lane);
}

DEVI void norm_row(const float* __restrict__ xrow, int b, const float* __restrict__ mod_l, const float* __restrict__ npre, const float* __restrict__ wg,
                   bf16_t* __restrict__ hrow, float* __restrict__ grow, int lane) {
    float4 v[8]; float ss = 0.f;
#pragma unroll
    for (int j = 0; j < 8; ++j) { v[j] = ((const float4*)xrow)[lane + 64 * j]; ss += v[j].x * v[j].x + v[j].y * v[j].y + v[j].z * v[j].z + v[j].w * v[j].w; }
    ss = wave_sum(ss);
    const float rstd = rsqrtf(ss * (1.f / DM) + EPS);
    const float* shift = mod_l + (size_t)b * MODW; const float* scale = shift + DM;
    float g[16];
#pragma unroll
    for (int i = 0; i < 16; ++i) g[i] = 0.f;
#pragma unroll
    for (int j = 0; j < 8; ++j) {
        const int k0 = 4 * (lane + 64 * j);
        const float4 w = *(const float4*)(npre + k0), sh = *(const float4*)(shift + k0), sc = *(const float4*)(scale + k0);
        float h[4];
        h[0] = v[j].x * rstd * w.x * (1.f + sc.x) + sh.x; h[1] = v[j].y * rstd * w.y * (1.f + sc.y) + sh.y;
        h[2] = v[j].z * rstd * w.z * (1.f + sc.z) + sh.z; h[3] = v[j].w * rstd * w.w * (1.f + sc.w) + sh.w;
        uint2 o; o.x = pk2(h[0], h[1]); o.y = pk2(h[2], h[3]);
        *(uint2*)(hrow + k0) = o;
#pragma unroll
        for (int e = 0; e < 4; ++e) {
            const float4* wr = (const float4*)(wg + (size_t)(k0 + e) * INC);
#pragma unroll
            for (int q = 0; q < 4; ++q) { const float4 ww = wr[q]; g[4 * q] += h[e] * ww.x; g[4 * q + 1] += h[e] * ww.y; g[4 * q + 2] += h[e] * ww.z; g[4 * q + 3] += h[e] * ww.w; }
        }
        asm volatile("" ::: "memory");
    }
#pragma unroll
    for (int i = 0; i < 16; ++i) g[i] = wave_sum(g[i]);
    if (lane == 0) {
#pragma unroll
        for (int q = 0; q < 4; ++q) ((float4*)grow)[q] = make_float4(g[4 * q], g[4 * q + 1], g[4 * q + 2], g[4 * q + 3]);
    }
}
__global__ __launch_bounds__(256) void k_norm(const float* __restrict__ xlat, const float* __restrict__ xctx, const float* __restrict__ mod_l, const float* __restrict__ npre,
                                              const float* __restrict__ wg, bf16_t* __restrict__ H, float* __restrict__ GATES) {
    const int wave = threadIdx.x >> 6, lane = threadIdx.x & 63;
    const int gw = blockIdx.x * 4 + wave, ngw = gridDim.x * 4;
    for (int row = gw; row < NTOK; row += ngw) {
        const bool isl = row < NLAT;
        const float* xr = isl ? xlat + (size_t)row * DM : xctx + (size_t)(row - NLAT) * DM;
        const int b = isl ? row / SEQ : 8;
        norm_row(xr, b, mod_l, npre, wg, H + (size_t)row * DM, GATES + (size_t)row * 16, lane);
    }
}

__global__ __launch_bounds__(256) void k_gemm_naive(const bf16_t* __restrict__ A, const bf16_t* __restrict__ Bt, bf16_t* __restrict__ C, int M, int N, int K) {
    __shared__ float As[32][65], Bs[32][65];
    const int tx = threadIdx.x & 15, ty = threadIdx.x >> 4;
    const int m0 = blockIdx.y * 64, n0 = blockIdx.x * 64;
    float acc[4][4];
#pragma unroll
    for (int i = 0; i < 4; ++i)
#pragma unroll
        for (int j = 0; j < 4; ++j) acc[i][j] = 0.f;
    const int lr = threadIdx.x >> 2, lk = (threadIdx.x & 3) * 8;
    for (int k0 = 0; k0 < K; k0 += 32) {
        const uint4 av = *(const uint4*)(A + (size_t)(m0 + lr) * K + k0 + lk);
        const uint4 bv = *(const uint4*)(Bt + (size_t)(n0 + lr) * K + k0 + lk);
        const unsigned aw[4] = {av.x, av.y, av.z, av.w}, bw[4] = {bv.x, bv.y, bv.z, bv.w};
#pragma unroll
        for (int i = 0; i < 4; ++i) {
            As[lk + 2 * i][lr] = __uint_as_float(aw[i] << 16); As[lk + 2 * i + 1][lr] = __uint_as_float(aw[i] & 0xffff0000u);
            Bs[lk + 2 * i][lr] = __uint_as_float(bw[i] << 16); Bs[lk + 2 * i + 1][lr] = __uint_as_float(bw[i] & 0xffff0000u);
        }
        __syncthreads();
#pragma unroll 8
        for (int kk = 0; kk < 32; ++kk) {
            float a[4], b[4];
#pragma unroll
            for (int i = 0; i < 4; ++i) { a[i] = As[kk][ty * 4 + i]; b[i] = Bs[kk][tx * 4 + i]; }
#pragma unroll
            for (int i = 0; i < 4; ++i)
#pragma unroll
                for (int j = 0; j < 4; ++j) acc[i][j] += a[i] * b[j];
        }
        __syncthreads();
    }
#pragma unroll
    for (int i = 0; i < 4; ++i) {
        uint2 o; o.x = pk2(acc[i][0], acc[i][1]); o.y = pk2(acc[i][2], acc[i][3]);
        *(uint2*)(C + (size_t)(m0 + ty * 4 + i) * N + n0 + tx * 4) = o;
    }
}

namespace pg8 {
#define PG8_LAS __attribute__((address_space(3)))
typedef unsigned short bf16_t;
typedef short bf16x8 __attribute__((ext_vector_type(8)));
typedef float f32x4 __attribute__((ext_vector_type(4)));
typedef unsigned u32x4 __attribute__((ext_vector_type(4)));
constexpr int BM = 256, BK = 64, HALF = 128, HTB = HALF * BK * 2  , STAGE_BYTES = 8 * HTB, NXCD = 8, WGM = 8;

__host__ __device__ __forceinline__ int lds_byte(int r, int c) { const int st = (r >> 4) * 2 + (c >> 5), rr = r & 15, cc = c & 31, ob = rr * 64 + cc * 2; return st * 1024 + (ob ^ (((ob >> 9) & 1) << 5)); }
__host__ __device__ __forceinline__ void stage_rc(int b, int& R, int& C) { const int st = b / 1024, sb = b % 1024, swz = sb ^ (((sb >> 9) & 1) << 5); R = (st >> 1) * 16 + swz / 64; C = (st & 1) * 32 + (swz % 64) / 2; }
__host__ __device__ __forceinline__ int perm32(int rho) { const int n = rho >> 4, i = rho & 15; return 8 * (i >> 2) + 4 * n + (i & 3); }

struct Unit { int pm, pn; };
struct Gemm { const bf16_t* A; const bf16_t* Bt; int M, N, K; };

struct StaticOrder {
    int nM, nN, nwg, G, c;
    __host__ __device__ void init(int M, int N, int G_, int c_) { nM = M / BM; nN = N / BM; nwg = nM * nN; G = G_; c = c_; }
    __host__ __device__ bool next(int i, Unit& u) const {
        const long L = (long)i * G + c; if (L >= nwg) return false;
        int wgid = (int)L; { const int q = nwg / NXCD, r = nwg % NXCD, xcd = wgid % NXCD, off = wgid / NXCD; wgid = (xcd < r ? xcd * (q + 1) : r * (q + 1) + (xcd - r) * q) + off; }
        const int nig = WGM * nN, gid = wgid / nig, fm = gid * WGM, gsz = (nM - fm) < WGM ? (nM - fm) : WGM;
        u.pm = fm + ((wgid % nig) % gsz); u.pn = (wgid % nig) / gsz; return true;
    }
    __device__ __forceinline__ void a_ready(const Unit&) const {}
    __device__ __forceinline__ void done(const Unit&) const {}
};

__device__ __forceinline__ unsigned cvt_pk_bf16(float lo, float hi) { unsigned r; asm volatile("v_cvt_pk_bf16_f32 %0, %1, %2" : "=v"(r) : "v"(lo), "v"(hi)); return r; }

struct EpiBf16 {
    static constexpr bool PERM = true, AFTER_DRAIN = false;
    bf16_t* O; int ldc;
    __device__ __forceinline__ void operator()(const f32x4 (&acc)[2][2][4][2], const Unit& u, int wr, int wc, int fr, int fq) const {
        const int row0 = u.pm * BM + wr * 64 + fr, col0 = u.pn * BM + wc * 32 + 8 * fq;
#pragma unroll
        for (int ai = 0; ai < 2; ++ai)
#pragma unroll
            for (int m = 0; m < 4; ++m) { bf16_t* rowp = O + (size_t)(row0 + ai * HALF + m * 16) * ldc + col0;
#pragma unroll
                for (int bj = 0; bj < 2; ++bj) { const f32x4 v0 = acc[ai][bj][m][0], v1 = acc[ai][bj][m][1];
                    u32x4 w; w.x = cvt_pk_bf16(v0[0], v0[1]); w.y = cvt_pk_bf16(v0[2], v0[3]); w.z = cvt_pk_bf16(v1[0], v1[1]); w.w = cvt_pk_bf16(v1[2], v1[3]);
                    *(u32x4*)(rowp + bj * HALF) = w; } }
    }
};
struct EpiInProj {
    static constexpr bool PERM = true, AFTER_DRAIN = false;
    bf16_t* O; int ldc; const float* rope;
    __device__ __forceinline__ void operator()(const f32x4 (&acc)[2][2][4][2], const Unit& u, int wr, int wc, int fr, int fq) const {
        const int row0 = u.pm * BM + wr * 64 + fr, col0 = u.pn * BM + wc * 32 + 8 * fq;
        const bool do_rope = (u.pn < 8) && (u.pm < 64);
#pragma unroll
        for (int ai = 0; ai < 2; ++ai)
#pragma unroll
            for (int m = 0; m < 4; ++m) { const int row = row0 + ai * HALF + m * 16; bf16_t* rowp = O + (size_t)row * ldc + col0;
                f32x4 cs01 = {1.f, 0.f, 1.f, 0.f}, cs23 = {1.f, 0.f, 1.f, 0.f};
                if (do_rope) { const int pos = (wc & 1) ? (row & 63) : ((row >> 6) & 31); const f32x4* rp = (const f32x4*)(rope + (size_t)(pos * 16 + 4 * fq) * 2); cs01 = rp[0]; cs23 = rp[1]; }
#pragma unroll
                for (int bj = 0; bj < 2; ++bj) { f32x4 v0 = acc[ai][bj][m][0], v1 = acc[ai][bj][m][1];
                    if (do_rope) {
                        const float a0 = v0[0] * cs01[0] - v0[1] * cs01[1], a1 = v0[0] * cs01[1] + v0[1] * cs01[0];
                        const float a2 = v0[2] * cs01[2] - v0[3] * cs01[3], a3 = v0[2] * cs01[3] + v0[3] * cs01[2];
                        const float b0 = v1[0] * cs23[0] - v1[1] * cs23[1], b1 = v1[0] * cs23[1] + v1[1] * cs23[0];
                        const float b2 = v1[2] * cs23[2] - v1[3] * cs23[3], b3 = v1[2] * cs23[3] + v1[3] * cs23[2];
                        v0 = (f32x4){a0, a1, a2, a3}; v1 = (f32x4){b0, b1, b2, b3};
                    }
                    u32x4 w; w.x = cvt_pk_bf16(v0[0], v0[1]); w.y = cvt_pk_bf16(v0[2], v0[3]); w.z = cvt_pk_bf16(v1[0], v1[1]); w.w = cvt_pk_bf16(v1[2], v1[3]);
                    *(u32x4*)(rowp + bj * HALF) = w; } }
    }
};

template <class Epi, class Sched, bool ALIGN_EPI = false, bool SP2 = false>
__device__ __forceinline__ void gemm_phase(PG8_LAS unsigned char* lds, const Gemm g, const Sched& S, const Epi& E) {
    const int tid = threadIdx.x, wid = __builtin_amdgcn_readfirstlane(tid >> 6), lane = tid & 63, wr = wid >> 2, wc = wid & 3, fr = lane & 15, fq = lane >> 4;
    const int K = g.K, nt = K / BK;
    unsigned voffA[2], voffB[2];
#pragma unroll
    for (int i = 0; i < 2; ++i) { int R, C; stage_rc(tid * 16 + i * 8192, R, C); const int Rb = Epi::PERM ? ((R & ~31) + perm32(R & 31)) : R;
        voffA[i] = (unsigned)(R * K + C) * 2u; voffB[i] = (unsigned)(Rb * K + C) * 2u; }
    const size_t kstep = (size_t)(BK * 2);
    const size_t hstep = (size_t)HALF * K * 2;
    const size_t tstep = 2 * hstep;
    const unsigned ldsw = (unsigned)wid * 1024u;
    const int aoff = lds_byte(wr * 64 + fr, fq * 8), boff = lds_byte(wc * 32 + fr, fq * 8);
#define PG8_SA(b, h) (((b) * 2 + (h)) * HTB)
#define PG8_SB(b, h) ((4 + (b) * 2 + (h)) * HTB)
#define PG8_STAGE(bufoff, gbase, voff) do { _Pragma("unroll") for (int _i = 0; _i < 2; ++_i) \
        __builtin_amdgcn_global_load_lds((const unsigned*)((const char*)(gbase) + (voff)[_i]), (PG8_LAS unsigned*)(lds + (bufoff) + ldsw + _i * 8192), 16, 0, 0); } while (0)
#define PG8_LDA(dst, b, h) do { _Pragma("unroll") for (int m = 0; m < 4; ++m) _Pragma("unroll") for (int k = 0; k < 2; ++k) dst[m][k] = *(const PG8_LAS bf16x8*)(lds + PG8_SA(b, h) + aoff + m * 2048 + k * 1024); } while (0)
#define PG8_LDB(dst, b, h) do { _Pragma("unroll") for (int n = 0; n < 2; ++n) _Pragma("unroll") for (int k = 0; k < 2; ++k) dst[n][k] = *(const PG8_LAS bf16x8*)(lds + PG8_SB(b, h) + boff + n * 2048 + k * 1024); } while (0)
#define PG8_MMA(ai, bj, At, Bt) do { __builtin_amdgcn_s_setprio(1); _Pragma("unroll") for (int m = 0; m < 4; ++m) _Pragma("unroll") for (int n = 0; n < 2; ++n) _Pragma("unroll") for (int k = 0; k < 2; ++k) \
        acc[ai][bj][m][n] = __builtin_amdgcn_mfma_f32_16x16x32_bf16(Bt[n][k], At[m][k], acc[ai][bj][m][n], 0, 0, 0); __builtin_amdgcn_s_setprio(0); } while (0)
#define PG8_WAIT_V(n) asm volatile("s_waitcnt vmcnt(" #n ")" ::: "memory")
#define PG8_WAIT_L(n) asm volatile("s_waitcnt lgkmcnt(" #n ")" ::: "memory")
#define PG8_BAR __builtin_amdgcn_s_barrier()
#define PG8_SCHED __builtin_amdgcn_sched_barrier(0)
    Unit cur, nxt; int ui = 0;
    if (!S.next(0, cur)) return;
    f32x4 acc[2][2][4][2];
#pragma unroll
    for (int a = 0; a < 2; ++a)
#pragma unroll
        for (int b = 0; b < 2; ++b)
#pragma unroll
            for (int m = 0; m < 4; ++m)
#pragma unroll
                for (int n = 0; n < 2; ++n) acc[a][b][m][n] = (f32x4){0.f, 0.f, 0.f, 0.f};
    bf16x8 At[4][2], B0[2][2], B1[2][2];
    const char* cA = (const char*)g.A + (size_t)cur.pm * tstep; const char* cB = (const char*)g.Bt + (size_t)cur.pn * tstep;
    S.a_ready(cur);
    if constexpr (SP2) {
        PG8_STAGE(PG8_SB(0, 0), cB, voffB); PG8_STAGE(PG8_SB(0, 1), cB + hstep, voffB); PG8_STAGE(PG8_SA(0, 0), cA, voffA); PG8_STAGE(PG8_SA(0, 1), cA + hstep, voffA);
        if (wr == 1) PG8_BAR;
        PG8_WAIT_V(2); PG8_BAR;
        PG8_STAGE(PG8_SB(1, 0), cB + kstep, voffB); PG8_STAGE(PG8_SA(1, 0), cA + kstep, voffA); PG8_STAGE(PG8_SB(1, 1), cB + hstep + kstep, voffB);
        PG8_WAIT_V(6); PG8_BAR;
    } else {
        PG8_STAGE(PG8_SB(0, 0), cB, voffB); PG8_STAGE(PG8_SA(0, 0), cA, voffA); PG8_STAGE(PG8_SB(0, 1), cB + hstep, voffB); PG8_STAGE(PG8_SA(0, 1), cA + hstep, voffA);
        if (wr == 1) PG8_BAR;
        PG8_WAIT_V(4); PG8_BAR;
        PG8_STAGE(PG8_SB(1, 0), cB + kstep, voffB); PG8_STAGE(PG8_SA(1, 0), cA + kstep, voffA); PG8_STAGE(PG8_SB(1, 1), cB + hstep + kstep, voffB);
        PG8_WAIT_V(6); PG8_BAR;
    }
    for (;;) {
        const bool has_next = S.next(ui + 1, nxt);
        const char* nA = has_next ? (const char*)g.A + (size_t)nxt.pm * tstep : cA; const char* nB = has_next ? (const char*)g.Bt + (size_t)nxt.pn * tstep : cB;
        for (int t = 0; t < nt; t += 2) {
            const bool last = (t == nt - 2);
            const char* a1 = cA + (size_t)(t + 1) * kstep;
            const char* a2 = last ? nA : cA + (size_t)(t + 2) * kstep; const char* b2 = last ? nB : cB + (size_t)(t + 2) * kstep;
            const char* a3 = a2 + kstep; const char* b3 = b2 + kstep;
            if (last && has_next) S.a_ready(nxt);
            if constexpr (SP2) {
            PG8_LDB(B0, 0, 0); PG8_LDB(B1, 0, 1); PG8_SCHED; PG8_LDA(At, 0, 0); PG8_STAGE(PG8_SA(1, 1), a1 + hstep, voffA);
            PG8_WAIT_V(8); PG8_WAIT_L(0); PG8_BAR; PG8_MMA(0, 0, At, B0); PG8_MMA(0, 1, At, B1); PG8_BAR; PG8_SCHED;
            PG8_LDA(At, 0, 1); PG8_STAGE(PG8_SB(0, 0), b2, voffB); PG8_STAGE(PG8_SB(0, 1), b2 + hstep, voffB); PG8_STAGE(PG8_SA(0, 0), a2, voffA);
            PG8_WAIT_V(8); PG8_WAIT_L(0); PG8_BAR; PG8_MMA(1, 0, At, B0); PG8_MMA(1, 1, At, B1); PG8_BAR; PG8_SCHED;
            PG8_LDB(B0, 1, 0); PG8_LDB(B1, 1, 1); PG8_SCHED; PG8_LDA(At, 1, 0); PG8_STAGE(PG8_SA(0, 1), a2 + hstep, voffA);
            PG8_WAIT_V(8); PG8_WAIT_L(0); PG8_BAR; PG8_MMA(0, 0, At, B0); PG8_MMA(0, 1, At, B1); PG8_BAR; PG8_SCHED;
            PG8_LDA(At, 1, 1); PG8_STAGE(PG8_SB(1, 0), b3, voffB); PG8_STAGE(PG8_SB(1, 1), b3 + hstep, voffB); PG8_STAGE(PG8_SA(1, 0), a3, voffA);
            PG8_WAIT_V(8); PG8_WAIT_L(0); PG8_BAR; PG8_MMA(1, 0, At, B0); PG8_MMA(1, 1, At, B1); PG8_BAR; PG8_SCHED;
            } else {
            PG8_LDB(B0, 0, 0); PG8_SCHED; PG8_LDA(At, 0, 0); PG8_STAGE(PG8_SA(1, 1), a1 + hstep, voffA);
            PG8_WAIT_L(8); PG8_BAR; PG8_WAIT_L(0); PG8_MMA(0, 0, At, B0); PG8_BAR; PG8_SCHED;
            PG8_LDB(B1, 0, 1); PG8_STAGE(PG8_SB(0, 0), b2, voffB);
            PG8_BAR; PG8_WAIT_L(0); PG8_MMA(0, 1, At, B1); PG8_BAR;
            PG8_LDA(At, 0, 1); PG8_STAGE(PG8_SA(0, 0), a2, voffA);
            PG8_BAR; PG8_WAIT_L(0); PG8_MMA(1, 0, At, B0); PG8_BAR; PG8_SCHED;
            PG8_STAGE(PG8_SB(0, 1), b2 + hstep, voffB);
            PG8_WAIT_V(6); PG8_BAR; PG8_MMA(1, 1, At, B1); PG8_BAR;
            PG8_LDB(B0, 1, 0); PG8_SCHED; PG8_LDA(At, 1, 0); PG8_STAGE(PG8_SA(0, 1), a2 + hstep, voffA);
            PG8_WAIT_L(8); PG8_BAR; PG8_WAIT_L(0); PG8_MMA(0, 0, At, B0); PG8_BAR; PG8_SCHED;
            PG8_LDB(B1, 1, 1); PG8_STAGE(PG8_SB(1, 0), b3, voffB);
            PG8_BAR; PG8_WAIT_L(0); PG8_MMA(0, 1, At, B1); PG8_BAR;
            PG8_LDA(At, 1, 1); PG8_STAGE(PG8_SA(1, 0), a3, voffA);
            PG8_BAR; PG8_WAIT_L(0); PG8_MMA(1, 0, At, B0); PG8_BAR; PG8_SCHED;
            PG8_STAGE(PG8_SB(1, 1), b3 + hstep, voffB);
            PG8_WAIT_V(6); PG8_BAR; PG8_MMA(1, 1, At, B1); PG8_BAR;
            }
        }
        if constexpr (ALIGN_EPI) { if (wr == 0) PG8_BAR; }
        if constexpr (!Epi::AFTER_DRAIN) { E(acc, cur, wr, wc, fr, fq); S.done(cur); }
        if (!has_next) break;
#pragma unroll
        for (int a = 0; a < 2; ++a)
#pragma unroll
            for (int b = 0; b < 2; ++b)
#pragma unroll
                for (int m = 0; m < 4; ++m)
#pragma unroll
                    for (int n = 0; n < 2; ++n) acc[a][b][m][n] = (f32x4){0.f, 0.f, 0.f, 0.f};
        cur = nxt; cA = nA; cB = nB; ++ui;
        if constexpr (ALIGN_EPI) { if (wr == 1) PG8_BAR; }
    }
    PG8_WAIT_V(0);
    if constexpr (!ALIGN_EPI) { if (wr == 0) PG8_BAR; }
    PG8_BAR;
    if constexpr (Epi::AFTER_DRAIN) { E.fused(acc, cur, wr, wc, fr, fq, lds, wid, lane); S.done(cur); }
#undef PG8_SA
#undef PG8_SB
#undef PG8_STAGE
#undef PG8_LDA
#undef PG8_LDB
#undef PG8_MMA
#undef PG8_WAIT_V
#undef PG8_WAIT_L
#undef PG8_BAR
#undef PG8_SCHED
}
}

constexpr int GEMM_LDS = pg8::STAGE_BYTES;
__global__ __launch_bounds__(512, 2) void k_gemm_inproj(const bf16_t* A, const bf16_t* Bt, bf16_t* P, const float* rope) {
    extern __shared__ __attribute__((aligned(16))) unsigned char lds_raw[];
    pg8::Gemm g{A, Bt, NTOK, NP, DM}; pg8::StaticOrder S; S.init(NTOK, NP, (int)gridDim.x, (int)blockIdx.x);
    pg8::EpiInProj E{P, NP, rope};
    pg8::gemm_phase<pg8::EpiInProj, pg8::StaticOrder, true, true>((PG8_LAS unsigned char*)lds_raw, g, S, E);
}
__global__ __launch_bounds__(512, 2) void k_gemm_outproj(const bf16_t* A, const bf16_t* Bt, bf16_t* C, int M) {
    extern __shared__ __attribute__((aligned(16))) unsigned char lds_raw[];
    pg8::Gemm g{A, Bt, M, DM, DM}; pg8::StaticOrder S; S.init(M, DM, (int)gridDim.x, (int)blockIdx.x);
    pg8::EpiBf16 E{C, DM};
    pg8::gemm_phase<pg8::EpiBf16, pg8::StaticOrder, true, true>((PG8_LAS unsigned char*)lds_raw, g, S, E);
}

__global__ __launch_bounds__(256) void k_rope_apply(bf16_t* __restrict__ P, const float2* __restrict__ ROPE) {
    const size_t total = (size_t)NLAT * 1024;
    for (size_t i = (size_t)blockIdx.x * 256 + threadIdx.x; i < total; i += (size_t)gridDim.x * 256) {
        const int row = (int)(i >> 10), p = (int)(i & 1023);
        const int t = row % SEQ;
        const int ip = p & 31;
        const int pos = (ip < 16) ? (t >> 6) : (t & 63);
        const float2 cs = ROPE[pos * 16 + (ip & 15)];
        unsigned* ptr = (unsigned*)(P + (size_t)row * NP + 2 * p);
        const unsigned w = *ptr;
        const float x1 = __uint_as_float(w << 16), x2 = __uint_as_float(w & 0xffff0000u);
        *ptr = pk2(x1 * cs.x - x2 * cs.y, x1 * cs.y + x2 * cs.x);
    }
}

template <bool CTXQ>
__global__ __launch_bounds__(128) void k_attn_naive(const bf16_t* __restrict__ P, bf16_t* __restrict__ Y, const float* __restrict__ lq1, const float* __restrict__ lk1,
                                                    const float* __restrict__ lq2, const float* __restrict__ lk2, const float* __restrict__ subln, float lam_init) {
    __shared__ float sb[2][2][2304];
    __shared__ float qb[2][128];
    const int w = threadIdx.x >> 6, lane = threadIdx.x & 63;
    const int t = blockIdx.x * 2 + w, hh = blockIdx.y, b = blockIdx.z;
    const int nkeys = CTXQ ? CTXL : (CTXL + SEQ);
    const size_t qrow = CTXQ ? (size_t)(NLAT + b * CTXL + t) : (size_t)(b * SEQ + t);
    const float lam = expf(wave_sum(lq1[lane] * lk1[lane])) - expf(wave_sum(lq2[lane] * lk2[lane])) + lam_init;
    qb[w][lane] = bf2f(P[qrow * NP + C_QA + hh * 128 + lane]);
    qb[w][64 + lane] = bf2f(P[qrow * NP + C_QA + hh * 128 + 64 + lane]);
    __syncthreads();
    float mx1 = -INFINITY, mx2 = -INFINITY;
    for (int j = lane; j < nkeys; j += 64) {
        const size_t kr = (j < CTXL) ? (size_t)(NLAT + b * CTXL + j) : (size_t)(b * SEQ + j - CTXL);
        const uint4* kp = (const uint4*)(P + kr * NP + C_KA + hh * 128);
        float s1 = 0.f, s2 = 0.f;
#pragma unroll
        for (int q = 0; q < 8; ++q) {
            const uint4 a = kp[q], c = kp[8 + q];
            const unsigned aw[4] = {a.x, a.y, a.z, a.w}, cw[4] = {c.x, c.y, c.z, c.w};
#pragma unroll
            for (int i = 0; i < 4; ++i) {
                s1 += qb[w][q * 8 + 2 * i] * __uint_as_float(aw[i] << 16) + qb[w][q * 8 + 2 * i + 1] * __uint_as_float(aw[i] & 0xffff0000u);
                s2 += qb[w][64 + q * 8 + 2 * i] * __uint_as_float(cw[i] << 16) + qb[w][64 + q * 8 + 2 * i + 1] * __uint_as_float(cw[i] & 0xffff0000u);
            }
        }
        s1 *= 0.125f; s2 *= 0.125f;
        sb[w][0][j] = s1; sb[w][1][j] = s2; mx1 = fmaxf(mx1, s1); mx2 = fmaxf(mx2, s2);
    }
    mx1 = wave_max(mx1); mx2 = wave_max(mx2);
    float l1 = 0.f, l2 = 0.f;
    for (int j = lane; j < nkeys; j += 64) {
        const float p1 = expf(sb[w][0][j] - mx1), p2 = expf(sb[w][1][j] - mx2);
        sb[w][0][j] = p1; sb[w][1][j] = p2; l1 += p1; l2 += p2;
    }
    l1 = wave_sum(l1); l2 = wave_sum(l2);
    const float r1 = 1.f / l1, r2 = lam / l2;
    for (int j = lane; j < nkeys; j += 64) sb[w][0][j] = sb[w][0][j] * r1 - sb[w][1][j] * r2;
    __syncthreads();
    float o0 = 0.f, o1 = 0.f;
    for (int j = 0; j < nkeys; ++j) {
        const size_t kr = (j < CTXL) ? (size_t)(NLAT + b * CTXL + j) : (size_t)(b * SEQ + j - CTXL);
        const unsigned vv = *(const unsigned*)(P + kr * NP + C_VA + hh * 128 + 2 * lane);
        const float a = sb[w][0][j];
        o0 += a * __uint_as_float(vv << 16); o1 += a * __uint_as_float(vv & 0xffff0000u);
    }
    const float ss = wave_sum(o0 * o0 + o1 * o1);
    const float r = rsqrtf(ss * (1.f / 128.f) + EPS) * (1.f - lam_init);
    const unsigned gg = *(const unsigned*)(P + qrow * NP + C_GA + hh * 128 + 2 * lane);
    const float g0 = __uint_as_float(gg << 16), g1 = __uint_as_float(gg & 0xffff0000u);
    const float y0 = o0 * r * subln[2 * lane] * silu_f(g0), y1 = o1 * r * subln[2 * lane + 1] * silu_f(g1);
    *(unsigned*)(Y + qrow * DM + hh * 128 + 2 * lane) = pk2(y0, y1);
}


namespace att {
using bf16x8 = __attribute__((ext_vector_type(8))) short;
using s16x4  = __attribute__((ext_vector_type(4))) short;
using f32x16 = __attribute__((ext_vector_type(16))) float;
using u32x4  = __attribute__((ext_vector_type(4))) unsigned;
constexpr int NW = 8, QBLK = 32, KVBLK = 64, QROWS = 128;
constexpr float SCALE = 0.125f, THR = 6.f;
constexpr int SHM_V = KVBLK * 128 * 2, SHM_K = KVBLK * 128 * 2, SHM_ATTN = 2 * SHM_V + 2 * SHM_K + NW * 64 * 4;
#define KSWZ(row, colB) ((row) * 256 + ((colB) ^ (((row) & 7) << 4)))
#define SBAR() __builtin_amdgcn_sched_barrier(0)
__device__ __forceinline__ int crow(int r, int hi) { return (r & 3) + 8 * (r >> 2) + 4 * hi; }
__device__ __forceinline__ unsigned cvtpk(float lo, float hi) { unsigned r; asm volatile("v_cvt_pk_bf16_f32 %0, %1, %2" : "=v"(r) : "v"(lo), "v"(hi)); return r; }
__device__ __forceinline__ void partialSM(f32x16& p0, f32x16& p1, float& m_reg, float& mn, float& alpha) {
  constexpr float C = SCALE * 1.4426950408889634f;
  float pmax = p0[0];
#pragma unroll
  for (int r = 1; r < 16; ++r) pmax = fmaxf(pmax, p0[r]);
#pragma unroll
  for (int r = 0; r < 16; ++r) pmax = fmaxf(pmax, p1[r]);
  { auto rr = __builtin_amdgcn_permlane32_swap(__float_as_uint(pmax), __float_as_uint(pmax), false, false);
    pmax = fmaxf(__uint_as_float(rr[0]), __uint_as_float(rr[1])); }
  if (__builtin_expect(__all(pmax - m_reg <= THR / SCALE), 1)) { mn = m_reg; alpha = 1.f; }
  else { mn = fmaxf(m_reg, pmax); alpha = __builtin_amdgcn_exp2f((m_reg - mn) * C); m_reg = mn; }
  const float mnC = -mn * C;
#pragma unroll
  for (int r = 0; r < 16; ++r) p0[r] = fmaf(p0[r], C, mnC);
#pragma unroll
  for (int r = 0; r < 16; ++r) p1[r] = fmaf(p1[r], C, mnC);
#pragma unroll
  for (int r = 0; r < 16; ++r) p0[r] = __builtin_amdgcn_exp2f(p0[r]);
}
__device__ __forceinline__ void finishSM(f32x16& p0, f32x16& p1, float alpha, float& l_reg, bf16x8& pa0, bf16x8& pa1, bf16x8& pa2, bf16x8& pa3) {
#pragma unroll
  for (int r = 0; r < 16; ++r) p1[r] = __builtin_amdgcn_exp2f(p1[r]);
  float ps = 0;
#pragma unroll
  for (int r = 0; r < 16; ++r) ps += p0[r];
#pragma unroll
  for (int r = 0; r < 16; ++r) ps += p1[r];
  { auto rr = __builtin_amdgcn_permlane32_swap(__float_as_uint(ps), __float_as_uint(ps), false, false);
    ps = __uint_as_float(rr[0]) + __uint_as_float(rr[1]); }
  l_reg = l_reg * alpha + ps;
#define PK4(P, BASE, OUT) do { unsigned a0 = cvtpk(P[BASE + 0], P[BASE + 1]), a1 = cvtpk(P[BASE + 2], P[BASE + 3]);   \
    unsigned b0 = cvtpk(P[BASE + 4], P[BASE + 5]), b1 = cvtpk(P[BASE + 6], P[BASE + 7]);                              \
    auto r0 = __builtin_amdgcn_permlane32_swap(a0, b0, false, false); auto r1 = __builtin_amdgcn_permlane32_swap(a1, b1, false, false); \
    u32x4 w = {r0[0], r1[0], r0[1], r1[1]}; OUT = *reinterpret_cast<bf16x8*>(&w); } while (0)
  PK4(p0, 0, pa0); PK4(p0, 8, pa1); PK4(p1, 0, pa2); PK4(p1, 8, pa3);
#undef PK4
}
__device__ __forceinline__ void qkt(f32x16& p0, f32x16& p1, const char* Ks, const bf16x8* qr, int r32, int hi, int sub) {
  p0 = f32x16{}; p1 = f32x16{};
#pragma unroll
  for (int d0 = 0; d0 < 4; ++d0) { const int cb = (sub * 64 + d0 * 16 + hi * 8) * 2;
    const bf16x8 b0 = *reinterpret_cast<const bf16x8*>(Ks + KSWZ(r32, cb));
    const bf16x8 b1 = *reinterpret_cast<const bf16x8*>(Ks + KSWZ(32 + r32, cb));
    p0 = __builtin_amdgcn_mfma_f32_32x32x16_bf16(b0, qr[d0], p0, 0, 0, 0);
    p1 = __builtin_amdgcn_mfma_f32_32x32x16_bf16(b1, qr[d0], p1, 0, 0, 0); }
}
__device__ __forceinline__ int v_st(int k, int c) { const int kk = (k & ~0xC) | ((k & 4) << 1) | ((k & 8) >> 1); return ((kk >> 3) * 4 + (c >> 5)) * 512 + ((kk & 7) * 32 + (c & 31)) * 2; }
__device__ __forceinline__ int v_rd_base(int lane) { return ((lane & 3) << 3) | (((lane >> 2) & 3) << 6) | (((lane >> 4) & 1) << 5) | (((lane >> 5) & 1) << 8); }
constexpr int v_rd_off(int d0, int ks, int half) { return d0 * 512 + ks * 4096 + half * 2048; }
template <int OFF> __device__ __forceinline__ s16x4 tr_read(int vb) {
  s16x4 r; asm volatile("ds_read_b64_tr_b16 %0, %1 offset:%2" : "=&v"(r) : "v"(vb), "i"(OFF) : "memory"); return r;
}
template <int D0> __device__ __forceinline__ void pv_one(f32x16& od, int vb, bf16x8 pa0, bf16x8 pa1, bf16x8 pa2, bf16x8 pa3) {
  const s16x4 l0 = tr_read<v_rd_off(D0, 0, 0)>(vb), h0 = tr_read<v_rd_off(D0, 0, 1)>(vb), l1 = tr_read<v_rd_off(D0, 1, 0)>(vb), h1 = tr_read<v_rd_off(D0, 1, 1)>(vb);
  const s16x4 l2 = tr_read<v_rd_off(D0, 2, 0)>(vb), h2 = tr_read<v_rd_off(D0, 2, 1)>(vb), l3 = tr_read<v_rd_off(D0, 3, 0)>(vb), h3 = tr_read<v_rd_off(D0, 3, 1)>(vb);
  asm volatile("s_waitcnt lgkmcnt(0)" ::: "memory"); SBAR();
#define PK(L, H) (bf16x8){L[0], L[1], L[2], L[3], H[0], H[1], H[2], H[3]}
  od = __builtin_amdgcn_mfma_f32_32x32x16_bf16(pa0, PK(l0, h0), od, 0, 0, 0);
  od = __builtin_amdgcn_mfma_f32_32x32x16_bf16(pa1, PK(l1, h1), od, 0, 0, 0);
  od = __builtin_amdgcn_mfma_f32_32x32x16_bf16(pa2, PK(l2, h2), od, 0, 0, 0);
  od = __builtin_amdgcn_mfma_f32_32x32x16_bf16(pa3, PK(l3, h3), od, 0, 0, 0);
#undef PK
}
__device__ __forceinline__ void pv_d0(f32x16* o, int vb, bf16x8 pa0, bf16x8 pa1, bf16x8 pa2, bf16x8 pa3) {
  pv_one<0>(o[0], vb, pa0, pa1, pa2, pa3); pv_one<1>(o[1], vb, pa0, pa1, pa2, pa3); pv_one<2>(o[2], vb, pa0, pa1, pa2, pa3); pv_one<3>(o[3], vb, pa0, pa1, pa2, pa3);
}
__device__ __forceinline__ long ktile_row(int b, int t) { return t < 4 ? (long)(NLAT + b * CTXL + 64 * t) : (long)(b * SEQ + 64 * (t - 4)); }

__device__ __forceinline__ void attn_unit(const bf16_t* __restrict__ Pm, bf16_t* __restrict__ Y, long qrow0, int b, int hh, int NT, float lam, float lam_init,
                                          const float* __restrict__ subln, char* lds) {
  const int tid = threadIdx.x, wid = tid >> 6, lane = tid & 63, r32 = lane & 31, hi = lane >> 5;
  const int sub = wid & 1, pr = wid >> 1;
  char* V_lds = lds; char* K_lds = lds + 2 * SHM_V;
  float* ws = (float*)(lds + 2 * SHM_V + 2 * SHM_K) + wid * 64; float* li_l = ws; float* al_l = ws + 32;
  float m_reg = -1e30f, l_reg = 0; f32x16 o[4] = {}; bf16x8 qr[4];
  const bf16_t* Qw = Pm + (qrow0 + pr * QBLK + r32) * NP + C_QA + hh * 128 + sub * 64 + hi * 8;
#pragma unroll
  for (int d0 = 0; d0 < 4; ++d0) qr[d0] = *reinterpret_cast<const bf16x8*>(Qw + d0 * 16);
  const int sr = tid >> 4, sc = (tid & 15) * 8, vst0 = v_st(sr, sc), vst1 = v_st(32 + sr, sc);
  const int vb0 = (int)(uintptr_t)V_lds + v_rd_base(lane);
  const bf16_t* Kcol = Pm + C_KA + hh * 128 + sc; const bf16_t* Vcol = Pm + C_VA + hh * 128 + sc;
  struct { bf16x8 vs0, vs1, ks0, ks1; } sr_[2];
#define SLOAD(i, t) do { const long r0_ = ktile_row(b, (t)) + sr; \
    sr_[i].vs0 = *reinterpret_cast<const bf16x8*>(Vcol + r0_ * NP); sr_[i].vs1 = *reinterpret_cast<const bf16x8*>(Vcol + (r0_ + 32) * NP); \
    sr_[i].ks0 = *reinterpret_cast<const bf16x8*>(Kcol + r0_ * NP); sr_[i].ks1 = *reinterpret_cast<const bf16x8*>(Kcol + (r0_ + 32) * NP); } while (0)
#define SWRITE(bb, i) do { *(bf16x8*)(V_lds + (bb) * SHM_V + vst0) = sr_[i].vs0; *(bf16x8*)(V_lds + (bb) * SHM_V + vst1) = sr_[i].vs1; const int kc = sc * 2; \
    *(bf16x8*)(K_lds + (bb) * SHM_K + KSWZ(sr, kc)) = sr_[i].ks0; *(bf16x8*)(K_lds + (bb) * SHM_K + KSWZ(32 + sr, kc)) = sr_[i].ks1; } while (0)
#define SWAIT() asm volatile("s_waitcnt vmcnt(4)" ::: "memory")
#define RESC(a) do { if (__any((a) < 1.f)) { if (hi == 0) al_l[r32] = (a); asm volatile("s_waitcnt lgkmcnt(0)" ::: "memory"); \
    _Pragma("unroll") for (int d = 0; d < 4; ++d) _Pragma("unroll") for (int r = 0; r < 16; ++r) o[d][r] *= al_l[crow(r, hi)]; } } while (0)
  f32x16 pA0, pA1, pB0, pB1; float mnA, mnB, alA, alB; bf16x8 pa0, pa1, pa2, pa3;
  constexpr int SE = 0, SO = 1;
  SLOAD(SE, 0); asm volatile("s_waitcnt vmcnt(0)" ::: "memory"); SWRITE(0, SE); __syncthreads();
  qkt(pA0, pA1, K_lds, qr, r32, hi, sub); partialSM(pA0, pA1, m_reg, mnA, alA);
  SLOAD(SO, 1); if (2 < NT) SLOAD(SE, 2);
  SWAIT(); SWRITE(1, SO); __syncthreads();
  for (int j = 1; j + 1 < NT; j += 2) {
    SBAR(); qkt(pB0, pB1, K_lds + SHM_K, qr, r32, hi, sub);
    finishSM(pA0, pA1, alA, l_reg, pa0, pa1, pa2, pa3); SBAR();
    SLOAD(SO, j + 2); SBAR();
    pv_d0(o, vb0, pa0, pa1, pa2, pa3); partialSM(pB0, pB1, m_reg, mnB, alB);
    __syncthreads(); SWAIT(); SWRITE(0, SE);
    RESC(alB); __syncthreads();
    SBAR(); qkt(pA0, pA1, K_lds, qr, r32, hi, sub);
    finishSM(pB0, pB1, alB, l_reg, pa0, pa1, pa2, pa3); SBAR();
    if (j + 3 < NT) SLOAD(SE, j + 3); SBAR();
    pv_d0(o, vb0 + SHM_V, pa0, pa1, pa2, pa3); partialSM(pA0, pA1, m_reg, mnA, alA);
    __syncthreads(); SWAIT(); SWRITE(1, SO);
    RESC(alA); __syncthreads();
  }
  SBAR(); qkt(pB0, pB1, K_lds + SHM_K, qr, r32, hi, sub);
  finishSM(pA0, pA1, alA, l_reg, pa0, pa1, pa2, pa3); SBAR();
  pv_d0(o, vb0, pa0, pa1, pa2, pa3); partialSM(pB0, pB1, m_reg, mnB, alB);
  __syncthreads(); RESC(alB);
  finishSM(pB0, pB1, alB, l_reg, pa0, pa1, pa2, pa3); SBAR();
  pv_d0(o, vb0 + SHM_V, pa0, pa1, pa2, pa3);
  if (hi == 0) li_l[r32] = l_reg; asm volatile("s_waitcnt lgkmcnt(0)" ::: "memory");
  const float fac = sub ? lam : 1.f;
#pragma unroll
  for (int r = 0; r < 16; ++r) { const float rl = fac * __builtin_amdgcn_rcpf(li_l[crow(r, hi)]);
#pragma unroll
    for (int d0 = 0; d0 < 4; ++d0) o[d0][r] *= rl; }
  __syncthreads();
  float* XB = (float*)lds + pr * 4096;
  if (sub == 1) {
#pragma unroll
    for (int d0 = 0; d0 < 4; ++d0)
#pragma unroll
      for (int r = 0; r < 16; ++r) XB[(d0 * 16 + r) * 64 + lane] = o[d0][r];
  }
  __syncthreads();
  if (sub == 0) {
    float ss[16];
#pragma unroll
    for (int r = 0; r < 16; ++r) { float a = 0.f;
#pragma unroll
      for (int d0 = 0; d0 < 4; ++d0) { o[d0][r] -= XB[(d0 * 16 + r) * 64 + lane]; a += o[d0][r] * o[d0][r]; }
      ss[r] = a; }
#pragma unroll
    for (int r = 0; r < 16; ++r) {
#pragma unroll
      for (int off = 1; off < 32; off <<= 1) ss[r] += __shfl_xor(ss[r], off);
      ss[r] = rsqrtf(ss[r] * (1.f / 128.f) + EPS) * (1.f - lam_init);
    }
    float sw[4];
#pragma unroll
    for (int d0 = 0; d0 < 4; ++d0) sw[d0] = subln[d0 * 32 + r32];
#pragma unroll
    for (int r = 0; r < 16; ++r) { const long row = qrow0 + pr * QBLK + crow(r, hi);
      const bf16_t* gp = Pm + row * NP + C_GA + hh * 128 + r32; bf16_t* yp = Y + row * DM + hh * 128 + r32;
#pragma unroll
      for (int d0 = 0; d0 < 4; ++d0) { const float g = bf2f(gp[d0 * 32]); yp[d0 * 32] = f2bf(o[d0][r] * ss[r] * sw[d0] * (g / (1.f + __expf(-g)))); } }
  }
  __syncthreads();
#undef SLOAD
#undef SWRITE
#undef SWAIT
#undef RESC
}
__device__ __forceinline__ void attn_phase(const bf16_t* __restrict__ Pm, bf16_t* __restrict__ Y, const float* lq1, const float* lk1, const float* lq2, const float* lk2,
                                           const float* __restrict__ subln, float lam_init, bool ctx_out, char* lds) {
  const int lane = threadIdx.x & 63;
  const float lam = expf(wave_sum(lq1[lane] * lk1[lane])) - expf(wave_sum(lq2[lane] * lk2[lane])) + lam_init;
  const int G = gridDim.x, bx = blockIdx.x; const int vcu = (G % 8 == 0) ? (bx % 8) * (G / 8) + bx / 8 : bx;
  const int nunits = 1024 + (ctx_out ? 128 : 0);
  for (int u = vcu; u < nunits; u += G) {
    if (u < 1024) { const int bh = u >> 4, qb = u & 15, b = bh >> 3, hh = bh & 7; attn_unit(Pm, Y, (long)b * SEQ + qb * QROWS, b, hh, 36, lam, lam_init, subln, lds); }
    else { const int v = u - 1024, bh = v >> 1, qb = v & 1, b = bh >> 3, hh = bh & 7; attn_unit(Pm, Y, (long)NLAT + b * CTXL + qb * QROWS, b, hh, 4, lam, lam_init, subln, lds); }
  }
}
#undef KSWZ
#undef SBAR
}
__global__ __launch_bounds__(512, 2) void k_attn_fast(const bf16_t* Pm, bf16_t* Y, const float* lq1, const float* lk1, const float* lq2, const float* lk2, const float* subln, float lam_init, int ctx_out) {
    extern __shared__ __attribute__((aligned(16))) unsigned char lds_raw[];
    att::attn_phase(Pm, Y, lq1, lk1, lq2, lk2, subln, lam_init, ctx_out != 0, (char*)lds_raw);
}

constexpr int QS = 129;
constexpr int MLSTM_LDS_FLOATS = 2 * 64 * QS + 64 * 64 + 64 * 256 + 64 * 7 + 128 + 8;
__global__ __launch_bounds__(256) void k_mlstm_naive(const bf16_t* __restrict__ P, const float* __restrict__ GATES, bf16_t* __restrict__ HM, const float* __restrict__ conv_w,
                                                     const float* __restrict__ conv_b, const float* __restrict__ i_bias, const float* __restrict__ f_bias) {
    extern __shared__ float smem[];
    float* qs = smem; float* ks = qs + 64 * QS; float* S = ks + 64 * QS; float* vs = S + 64 * 64;
    float* bcum = vs + 64 * 256; float* ig = bcum + 64; float* lfv = ig + 64; float* mrow = lfv + 64; float* sc = mrow + 64; float* wk = sc + 64; float* den = wk + 64;
    float* nvec = den + 64; float* scal = nvec + 128;
    const int unit = blockIdx.x, dir = unit & 1, head = (unit >> 1) & 3, b = unit >> 3;
    const int tid = threadIdx.x;
    float C[128];
#pragma unroll
    for (int d = 0; d < 128; ++d) C[d] = 0.f;
    if (tid < 128) nvec[tid] = 0.f;
    float m = 0.f;
    const int ch = tid;
    const int cidx = (ch < 128) ? head * 128 + ch : 512 + head * 128 + (ch - 128);
    const int pcol = (ch < 128) ? C_QB + head * 128 + ch : C_KB + head * 128 + (ch - 128);
    const float cw0 = conv_w[cidx], cw1 = conv_w[1024 + cidx], cw2 = conv_w[2048 + cidx], cb = conv_b[cidx];
    __syncthreads();
    for (int c = 0; c < 36; ++c) {
        const bool isctx = c < 4; const int T = isctx ? CTXL : SEQ; const int cc = isctx ? c : c - 4;
        const int rowbase = isctx ? NLAT + b * CTXL : b * SEQ;
        const int tstart = dir ? (T - 1 - 64 * cc) : 64 * cc; const int tstep = dir ? -1 : 1;
        if (tid < 64) {
            const int t = tstart + tstep * tid; const size_t row = (size_t)(rowbase + t);
            const float gi = GATES[row * 16 + dir * 4 + head] + i_bias[dir * 4 + head];
            const float gf = GATES[row * 16 + 8 + dir * 4 + head] + f_bias[dir * 4 + head];
            const float igv = 15.f * tanhf(gi * (1.f / 15.f));
            const float fc = 15.f * tanhf(gf * (1.f / 15.f));
            ig[tid] = igv; lfv[tid] = fminf(fc, 0.f) - log1pf(expf(-fabsf(fc)));
        }
        for (int l = 0; l < 64; ++l) {
            const int t = tstart + tstep * l;
            const float x0 = (t > 0) ? bf2f(P[(size_t)(rowbase + t - 1) * NP + pcol]) : 0.f;
            const float x1 = bf2f(P[(size_t)(rowbase + t) * NP + pcol]);
            const float x2 = (t < T - 1) ? bf2f(P[(size_t)(rowbase + t + 1) * NP + pcol]) : 0.f;
            const float v = silu_f(cb + cw0 * x0 + cw1 * x1 + cw2 * x2);
            if (ch < 128) qs[l * QS + ch] = v; else ks[l * QS + ch - 128] = v * 0.08838834764831845f;
            vs[l * 256 + tid] = bf2f(P[(size_t)(rowbase + t) * NP + C_VB + head * 256 + tid]);
        }
        __syncthreads();
        if (tid == 0) { float a = 0.f; for (int l = 0; l < 64; ++l) { a += lfv[l]; bcum[l] = a; } }
        __syncthreads();
        if (tid < 64) {
            const float bl = bcum[tid]; float mx = bl + m;
            for (int s = 0; s <= tid; ++s) mx = fmaxf(mx, bl - bcum[s] + ig[s]);
            mrow[tid] = mx; sc[tid] = expf(bl + m - mx);
        }
        if (tid == 64) {
            const float blast = bcum[63]; float mn = blast + m;
            for (int s = 0; s < 64; ++s) mn = fmaxf(mn, blast - bcum[s] + ig[s]);
            scal[0] = mn; scal[1] = expf(blast + m - mn);
        }
        __syncthreads();
        const float m_new = scal[0], decay = scal[1];
        if (tid < 64) wk[tid] = expf(bcum[63] - bcum[tid] + ig[tid] - m_new);
        for (int idx = tid; idx < 4096; idx += 256) {
            const int l = idx >> 6, s = idx & 63; float val = 0.f;
            if (s <= l) { float dot = 0.f; for (int d = 0; d < 128; ++d) dot += qs[l * QS + d] * ks[s * QS + d]; val = dot * expf(bcum[l] - bcum[s] + ig[s] - mrow[l]); }
            S[idx] = val;
        }
        __syncthreads();
        if (tid < 64) {
            float dn = 0.f; for (int d = 0; d < 128; ++d) dn += qs[tid * QS + d] * nvec[d];
            dn *= sc[tid]; for (int s = 0; s < 64; ++s) dn += S[tid * 64 + s];
            den[tid] = fmaxf(fabsf(dn), expf(-mrow[tid]));
        }
        __syncthreads();
        for (int l = 0; l < 64; ++l) {
            float a = 0.f;
#pragma unroll
            for (int d = 0; d < 128; ++d) a += qs[l * QS + d] * C[d];
            a *= sc[l];
            for (int s = 0; s <= l; ++s) a += S[l * 64 + s] * vs[s * 256 + tid];
            const int t = tstart + tstep * l;
            HM[((size_t)dir * NTOK + rowbase + t) * 1024 + head * 256 + tid] = f2bf(a / den[l]);
        }
#pragma unroll
        for (int d = 0; d < 128; ++d) C[d] *= decay;
        for (int s = 0; s < 64; ++s) {
            const float wv = wk[s] * vs[s * 256 + tid];
#pragma unroll
            for (int d = 0; d < 128; ++d) C[d] += wv * ks[s * QS + d];
        }
        if (tid < 128) { float a = decay * nvec[tid]; for (int s = 0; s < 64; ++s) a += wk[s] * ks[s * QS + tid]; nvec[tid] = a; }
        m = m_new;
        __syncthreads();
    }
}


namespace mls {
using bf16x8 = __attribute__((ext_vector_type(8))) short;
using f32x4  = __attribute__((ext_vector_type(4))) float;
constexpr int QSTRB = 272, SSTRB = 144;
constexpr int NPOS = 2304;
constexpr int L_BC = 0, L_IG = L_BC + NPOS * 4, L_Q = L_IG + NPOS * 4, L_K = L_Q + 64 * QSTRB, L_KW = L_K + 64 * QSTRB, L_VT = L_KW + 128 * SSTRB,
              L_S = L_VT + 64 * SSTRB, L_CT = L_S + 64 * SSTRB, L_SM = L_CT + 2 * 64 * QSTRB, L_END = L_SM + 2560;
static_assert(L_END <= 131072 && (L_Q % 16) == 0 && (L_K % 16) == 0 && (L_KW % 16) == 0 && (L_VT % 16) == 0 && (L_S % 16) == 0 && (L_CT % 16) == 0 && (L_SM % 16) == 0, "mlstm LDS map");
__device__ __forceinline__ f32x4 mfma16(bf16x8 a, bf16x8 b, f32x4 c) { return __builtin_amdgcn_mfma_f32_16x16x32_bf16(a, b, c, 0, 0, 0); }
__device__ __forceinline__ float bfw(unsigned w, int odd) { return odd ? __uint_as_float(w & 0xffff0000u) : __uint_as_float(w << 16); }

__device__ __forceinline__ void mlstm_unit(const bf16_t* __restrict__ Pm, const float* __restrict__ GATES, bf16_t* __restrict__ HM, const float* __restrict__ conv_w,
                                           const float* __restrict__ conv_b, const float* __restrict__ i_bias, const float* __restrict__ f_bias,
                                           int b, int head, int dir, int es, char* lds) {
  const int tid = threadIdx.x, wid = tid >> 6, lane = tid & 63, lr = lane & 15, kg = lane >> 4;
  float* Bc = (float*)(lds + L_BC); float* Ig = (float*)(lds + L_IG);
  char* q_lds = lds + L_Q; char* k_lds = lds + L_K; char* kw_lds = lds + L_KW; char* vt_lds = lds + L_VT; char* s_lds = lds + L_S; char* ct_lds = lds + L_CT;
  float* bl = (float*)(lds + L_SM); float* bsp = bl + 64; float* av = bsp + 64; float* rs = av + 64; float* qn = rs + 256; float* nvec = qn + 64;
  for (int p = tid; p < NPOS; p += 512) {
    const int c = p >> 6, l = p & 63; const bool isctx = c < 4; const int T = isctx ? CTXL : SEQ, cc = isctx ? c : c - 4;
    const long rowbase = isctx ? (long)(NLAT + b * CTXL) : (long)b * SEQ;
    const int t = dir ? (T - 1 - 64 * cc - l) : (64 * cc + l);
    const float* gr = GATES + (rowbase + t) * 16;
    const float gi = gr[dir * 4 + head] + i_bias[dir * 4 + head], gf = gr[8 + dir * 4 + head] + f_bias[dir * 4 + head];
    Ig[p] = 15.f * tanhf(gi * (1.f / 15.f));
    const float fc = 15.f * tanhf(gf * (1.f / 15.f));
    Bc[p] = fminf(fc, 0.f) - log1pf(expf(-fabsf(fc)));
  }
  for (int i = tid; i < 64 * QSTRB / 4; i += 512) ((unsigned*)ct_lds)[i] = 0u;
  if (tid < 128) nvec[tid] = 0.f;
  __syncthreads();
  if (wid == 0) {
    float run = 0.f;
    for (int k = 0; k < 36; ++k) { run += Bc[36 * lane + k]; Bc[36 * lane + k] = run; }
    float x = run;
#pragma unroll
    for (int off = 1; off < 64; off <<= 1) { const float y = __shfl_up(x, off); if (lane >= off) x += y; }
    const float offs = x - run;
    for (int k = 0; k < 36; ++k) Bc[36 * lane + k] += offs;
  }
  __syncthreads();
  const int chg = tid & 31, rg = tid >> 5; const bool isk = chg >= 16; const int ch8 = (chg & 15) * 8;
  const int pcol = (isk ? C_KB : C_QB) + head * 128 + ch8, cidx = (isk ? 512 : 0) + head * 128 + ch8;
  float cw0[8], cw1[8], cw2[8], cbv[8];
#pragma unroll
  for (int i = 0; i < 8; ++i) { cw0[i] = conv_w[cidx + i]; cw1[i] = conv_w[1024 + cidx + i]; cw2[i] = conv_w[2048 + cidx + i]; cbv[i] = conv_b[cidx + i]; }
  const int veg = tid & 15, vrg = tid >> 4;
  f32x4 Cacc[4];
#pragma unroll
  for (int e = 0; e < 4; ++e) Cacc[e] = (f32x4){0.f, 0.f, 0.f, 0.f};
  for (int c = 0; c < 36; ++c) {
    const bool isctx = c < 4; const int T = isctx ? CTXL : SEQ, cc = isctx ? c : c - 4;
    const long rowbase = isctx ? (long)(NLAT + b * CTXL) : (long)b * SEQ;
    const int t0 = dir ? (T - 64 * (cc + 1)) : 64 * cc, p0 = 64 * c;
    char* ct_cur = ct_lds + (c & 1) * 64 * QSTRB; char* ct_nxt = ct_lds + ((c + 1) & 1) * 64 * QSTRB;
    uint4 raw[6];
#pragma unroll
    for (int r = 0; r < 6; ++r) { const int t = t0 + 4 * rg - 1 + r; raw[r] = (t >= 0 && t < T) ? *(const uint4*)(Pm + (rowbase + t) * NP + pcol) : make_uint4(0u, 0u, 0u, 0u); }
    uint2 vr[4];
    if (tid < 256) {
#pragma unroll
      for (int jj = 0; jj < 4; ++jj) vr[jj] = *(const uint2*)(Pm + (rowbase + t0 + 4 * vrg + jj) * NP + C_VB + head * 256 + es * 64 + 4 * veg);
    }
    const float Bend = Bc[p0 + 63], Bprev = p0 ? Bc[p0 - 1] : 0.f;
    const float gamma = expf(Bend - Bprev);
    if (tid < 64) { const float blv = Bc[p0 + tid] - Bprev; bl[tid] = blv; bsp[tid] = blv - Ig[p0 + tid]; av[tid] = expf(blv); }
    {
      float kw[4][8];
#pragma unroll
      for (int jj = 0; jj < 4; ++jj) {
        const int l = dir ? 63 - (4 * rg + jj) : 4 * rg + jj;
        const unsigned* x0 = (const unsigned*)&raw[jj]; const unsigned* x1 = (const unsigned*)&raw[jj + 1]; const unsigned* x2 = (const unsigned*)&raw[jj + 2];
        float o[8];
#pragma unroll
        for (int i = 0; i < 8; ++i) { const float z = cbv[i] + cw0[i] * bfw(x0[i >> 1], i & 1) + cw1[i] * bfw(x1[i >> 1], i & 1) + cw2[i] * bfw(x2[i >> 1], i & 1);
          o[i] = z / (1.f + __expf(-z)); }
        if (isk) {
          const float wk = expf(Bend - Bc[p0 + l] + Ig[p0 + l]);
#pragma unroll
          for (int i = 0; i < 8; ++i) { o[i] *= 0.08838834764831845f; kw[jj][i] = o[i] * wk; }
        }
        uint4 w; w.x = pk2(o[0], o[1]); w.y = pk2(o[2], o[3]); w.z = pk2(o[4], o[5]); w.w = pk2(o[6], o[7]);
        *(uint4*)((isk ? k_lds : q_lds) + l * QSTRB + ch8 * 2) = w;
      }
      if (isk) {
        const int lb = dir ? 60 - 4 * rg : 4 * rg;
#pragma unroll
        for (int i = 0; i < 8; ++i) { uint2 w;
          if (dir) { w.x = pk2(kw[3][i], kw[2][i]); w.y = pk2(kw[1][i], kw[0][i]); } else { w.x = pk2(kw[0][i], kw[1][i]); w.y = pk2(kw[2][i], kw[3][i]); }
          *(uint2*)(kw_lds + (ch8 + i) * SSTRB + lb * 2) = w; }
      }
    }
    if (tid < 256) {
      const int lb = dir ? 60 - 4 * vrg : 4 * vrg;
      const unsigned vw[4][2] = {{vr[0].x, vr[0].y}, {vr[1].x, vr[1].y}, {vr[2].x, vr[2].y}, {vr[3].x, vr[3].y}};
#pragma unroll
      for (int e = 0; e < 4; ++e) { unsigned short h4[4];
#pragma unroll
        for (int jj = 0; jj < 4; ++jj) { const unsigned wd = vw[jj][e >> 1]; h4[jj] = (unsigned short)((e & 1) ? (wd >> 16) : (wd & 0xffffu)); }
        uint2 w;
        if (dir) { w.x = (unsigned)h4[3] | ((unsigned)h4[2] << 16); w.y = (unsigned)h4[1] | ((unsigned)h4[0] << 16); }
        else { w.x = (unsigned)h4[0] | ((unsigned)h4[1] << 16); w.y = (unsigned)h4[2] | ((unsigned)h4[3] << 16); }
        *(uint2*)(vt_lds + (4 * veg + e) * SSTRB + lb * 2) = w; }
    }
    __syncthreads();
    {
      const int lblk = wid >> 1;
#pragma unroll
      for (int u2 = 0; u2 < 2; ++u2) {
        const int sblk = 2 * (wid & 1) + u2;
        if (sblk <= lblk) {
          f32x4 acc = {0.f, 0.f, 0.f, 0.f};
#pragma unroll
          for (int ks = 0; ks < 4; ++ks) {
            const bf16x8 ka = *(const bf16x8*)(k_lds + (sblk * 16 + lr) * QSTRB + (ks * 32 + 8 * kg) * 2);
            const bf16x8 qb = *(const bf16x8*)(q_lds + (lblk * 16 + lr) * QSTRB + (ks * 32 + 8 * kg) * 2);
            acc = mfma16(ka, qb, acc);
          }
          const int l = lblk * 16 + lr; const float blv = bl[l];
          float v4[4]; float sum = 0.f;
#pragma unroll
          for (int r = 0; r < 4; ++r) { const int sidx = sblk * 16 + 4 * kg + r; const float w = (sidx <= l) ? expf(blv - bsp[sidx]) : 0.f; v4[r] = acc[r] * w; sum += v4[r]; }
          uint2 w; w.x = pk2(v4[0], v4[1]); w.y = pk2(v4[2], v4[3]);
          *(uint2*)(s_lds + l * SSTRB + (sblk * 16 + 4 * kg) * 2) = w;
          sum += __shfl_xor(sum, 16); sum += __shfl_xor(sum, 32);
          if (kg == 0) rs[sblk * 64 + l] = sum;
        } else if ((lblk == 0 && sblk == 1) || (lblk == 2 && sblk == 3)) {
          *(uint2*)(s_lds + (lblk * 16 + lr) * SSTRB + (sblk * 16 + 4 * kg) * 2) = make_uint2(0u, 0u);
        }
      }
      { const int l = tid >> 3, part = tid & 7; float a = 0.f;
        const unsigned* qp = (const unsigned*)(q_lds + l * QSTRB + part * 32);
#pragma unroll
        for (int i = 0; i < 8; ++i) { const unsigned wd = qp[i]; a += __uint_as_float(wd << 16) * nvec[part * 16 + 2 * i] + __uint_as_float(wd & 0xffff0000u) * nvec[part * 16 + 2 * i + 1]; }
        a += __shfl_xor(a, 1); a += __shfl_xor(a, 2); a += __shfl_xor(a, 4);
        if (part == 0) qn[l] = a; }
    }
    __syncthreads();
    {
      const int lblk = wid >> 1;
      float arow[4], dinv[4];
#pragma unroll
      for (int r = 0; r < 4; ++r) { const int l = lblk * 16 + 4 * kg + r; float d = av[l] * qn[l];
        for (int sb = 0; sb <= lblk; ++sb) d += rs[sb * 64 + l];
        arow[r] = av[l]; dinv[r] = 1.f / fmaxf(fabsf(d), 1.f); }
      bf16x8 qa[4];
#pragma unroll
      for (int ks = 0; ks < 4; ++ks) qa[ks] = *(const bf16x8*)(q_lds + (lblk * 16 + lr) * QSTRB + (ks * 32 + 8 * kg) * 2);
      const bf16x8 sa0 = *(const bf16x8*)(s_lds + (lblk * 16 + lr) * SSTRB + (8 * kg) * 2);
      bf16x8 sa1 = sa0; if (lblk >= 2) sa1 = *(const bf16x8*)(s_lds + (lblk * 16 + lr) * SSTRB + (32 + 8 * kg) * 2);
#pragma unroll
      for (int u2 = 0; u2 < 2; ++u2) {
        const int eblk = 2 * (wid & 1) + u2;
        f32x4 acc1 = {0.f, 0.f, 0.f, 0.f}, acc2 = {0.f, 0.f, 0.f, 0.f};
#pragma unroll
        for (int ks = 0; ks < 4; ++ks) { const bf16x8 cb = *(const bf16x8*)(ct_cur + (eblk * 16 + lr) * QSTRB + (ks * 32 + 8 * kg) * 2); acc1 = mfma16(qa[ks], cb, acc1); }
        { const bf16x8 vb = *(const bf16x8*)(vt_lds + (eblk * 16 + lr) * SSTRB + (8 * kg) * 2); acc2 = mfma16(sa0, vb, acc2); }
        if (lblk >= 2) { const bf16x8 vb = *(const bf16x8*)(vt_lds + (eblk * 16 + lr) * SSTRB + (32 + 8 * kg) * 2); acc2 = mfma16(sa1, vb, acc2); }
#pragma unroll
        for (int r = 0; r < 4; ++r) { const int l = lblk * 16 + 4 * kg + r; const int t = dir ? (t0 + 63 - l) : (t0 + l);
          const float hv = (arow[r] * acc1[r] + acc2[r]) * dinv[r];
          HM[((size_t)dir * NTOK + rowbase + t) * 1024 + head * 256 + es * 64 + eblk * 16 + lr] = f2bf(hv); }
      }
    }
    {
      const int dblk = wid;
      const bf16x8 ka0 = *(const bf16x8*)(kw_lds + (dblk * 16 + lr) * SSTRB + (8 * kg) * 2), ka1 = *(const bf16x8*)(kw_lds + (dblk * 16 + lr) * SSTRB + (32 + 8 * kg) * 2);
#pragma unroll
      for (int eblk = 0; eblk < 4; ++eblk) {
        const bf16x8 vb0 = *(const bf16x8*)(vt_lds + (eblk * 16 + lr) * SSTRB + (8 * kg) * 2), vb1 = *(const bf16x8*)(vt_lds + (eblk * 16 + lr) * SSTRB + (32 + 8 * kg) * 2);
        f32x4 cc_ = Cacc[eblk] * gamma;
        cc_ = mfma16(ka0, vb0, cc_); cc_ = mfma16(ka1, vb1, cc_);
        Cacc[eblk] = cc_;
        uint2 w; w.x = pk2(cc_[0], cc_[1]); w.y = pk2(cc_[2], cc_[3]);
        *(uint2*)(ct_nxt + (eblk * 16 + lr) * QSTRB + (dblk * 16 + 4 * kg) * 2) = w;
      }
      if (tid < 128) { float a = gamma * nvec[tid]; const unsigned* kp = (const unsigned*)(kw_lds + tid * SSTRB);
#pragma unroll
        for (int i = 0; i < 32; ++i) { const unsigned wd = kp[i]; a += __uint_as_float(wd << 16) + __uint_as_float(wd & 0xffff0000u); }
        nvec[tid] = a; }
    }
    __syncthreads();
  }
}
__device__ __forceinline__ void mlstm_phase(const bf16_t* __restrict__ Pm, const float* __restrict__ GATES, bf16_t* __restrict__ HM, const float* __restrict__ conv_w,
                                            const float* __restrict__ conv_b, const float* __restrict__ i_bias, const float* __restrict__ f_bias, char* lds) {
  const int G = gridDim.x, bx = blockIdx.x; const int vcu = (G % 8 == 0) ? (bx % 8) * (G / 8) + bx / 8 : bx;
  for (int u = vcu; u < 256; u += G) { const int es = u & 3, dir = (u >> 2) & 1, head = (u >> 3) & 3, b = u >> 5; mlstm_unit(Pm, GATES, HM, conv_w, conv_b, i_bias, f_bias, b, head, dir, es, lds); }
}
}
__global__ __launch_bounds__(512, 2) void k_mlstm_fast(const bf16_t* Pm, const float* GATES, bf16_t* HM, const float* conv_w, const float* conv_b, const float* i_bias, const float* f_bias) {
    extern __shared__ __attribute__((aligned(16))) unsigned char lds_raw[];
    mls::mlstm_phase(Pm, GATES, HM, conv_w, conv_b, i_bias, f_bias, (char*)lds_raw);
}

__global__ __launch_bounds__(256) void k_finish_mlstm(const bf16_t* __restrict__ P, const bf16_t* __restrict__ HM, const float* __restrict__ mnorm, bf16_t* __restrict__ Y) {
    const int wave = threadIdx.x >> 6, lane = threadIdx.x & 63;
    const int gw = blockIdx.x * 4 + wave, ngw = gridDim.x * 4;
    for (int row = gw; row < NTOK; row += ngw) {
#pragma unroll
        for (int head = 0; head < 4; ++head) {
            const int col = head * 256 + 4 * lane;
            const uint2 a = *(const uint2*)(HM + (size_t)row * 1024 + col), c = *(const uint2*)(HM + ((size_t)NTOK + row) * 1024 + col);
            float h[4];
            h[0] = __uint_as_float(a.x << 16) + __uint_as_float(c.x << 16); h[1] = __uint_as_float(a.x & 0xffff0000u) + __uint_as_float(c.x & 0xffff0000u);
            h[2] = __uint_as_float(a.y << 16) + __uint_as_float(c.y << 16); h[3] = __uint_as_float(a.y & 0xffff0000u) + __uint_as_float(c.y & 0xffff0000u);
            const float ss = wave_sum(h[0] * h[0] + h[1] * h[1] + h[2] * h[2] + h[3] * h[3]);
            const float r = rsqrtf(ss * (1.f / 256.f) + EPS);
            const uint2 ov = *(const uint2*)(P + (size_t)row * NP + C_OB + col), gv = *(const uint2*)(P + (size_t)row * NP + C_GB + col);
            const float o[4] = {__uint_as_float(ov.x << 16), __uint_as_float(ov.x & 0xffff0000u), __uint_as_float(ov.y << 16), __uint_as_float(ov.y & 0xffff0000u)};
            const float g[4] = {__uint_as_float(gv.x << 16), __uint_as_float(gv.x & 0xffff0000u), __uint_as_float(gv.y << 16), __uint_as_float(gv.y & 0xffff0000u)};
            const float4 w = *(const float4*)(mnorm + col);
            const float wv[4] = {w.x, w.y, w.z, w.w};
            float y[4];
#pragma unroll
            for (int e = 0; e < 4; ++e) y[e] = h[e] * r * wv[e] * sigmoid_f(o[e]) * silu_f(g[e]);
            uint2 out; out.x = pk2(y[0], y[1]); out.y = pk2(y[2], y[3]);
            *(uint2*)(Y + (size_t)row * DM + 1024 + col) = out;
        }
    }
}

__global__ __launch_bounds__(256) void k_post(const float* xlat, const float* xctx, const bf16_t* __restrict__ Y2, const float* __restrict__ mod_l,
                                              const float* __restrict__ npost, float* olat, float* octx, int nrows) {
    const int wave = threadIdx.x >> 6, lane = threadIdx.x & 63;
    const int gw = blockIdx.x * 4 + wave, ngw = gridDim.x * 4;
    for (int row = gw; row < nrows; row += ngw) {
        const bool isl = row < NLAT;
        const float* xr = isl ? xlat + (size_t)row * DM : xctx + (size_t)(row - NLAT) * DM;
        float* orow = isl ? olat + (size_t)row * DM : octx + (size_t)(row - NLAT) * DM;
        const int b = isl ? row / SEQ : 8;
        const float* gate = mod_l + (size_t)b * MODW + 2 * DM;
        float y[8][4]; float ss = 0.f;
#pragma unroll
        for (int j = 0; j < 8; ++j) {
            const uint2 a = *(const uint2*)(Y2 + (size_t)row * DM + 4 * (lane + 64 * j));
            y[j][0] = __uint_as_float(a.x << 16); y[j][1] = __uint_as_float(a.x & 0xffff0000u); y[j][2] = __uint_as_float(a.y << 16); y[j][3] = __uint_as_float(a.y & 0xffff0000u);
            ss += y[j][0] * y[j][0] + y[j][1] * y[j][1] + y[j][2] * y[j][2] + y[j][3] * y[j][3];
        }
        ss = wave_sum(ss);
        const float rstd = rsqrtf(ss * (1.f / DM) + EPS);
#pragma unroll
        for (int j = 0; j < 8; ++j) {
            const int k0 = 4 * (lane + 64 * j);
            const float4 xv = *(const float4*)(xr + k0), gt = *(const float4*)(gate + k0), w = *(const float4*)(npost + k0);
            float4 o;
            o.x = xv.x + gt.x * (y[j][0] * rstd * w.x); o.y = xv.y + gt.y * (y[j][1] * rstd * w.y);
            o.z = xv.z + gt.z * (y[j][2] * rstd * w.z); o.w = xv.w + gt.w * (y[j][3] * rstd * w.w);
            *(float4*)(orow + k0) = o;
        }
    }
}

extern "C" void kernel_launch(void* const* d_in, const int* in_sizes, int n_in, void* d_out, int out_size, void* d_ws, size_t ws_size, hipStream_t stream) {
    (void)in_sizes; (void)n_in; (void)out_size; (void)ws_size;
    const float* x = (const float*)d_in[0]; const float* c = (const float*)d_in[1]; const float* ctx = (const float*)d_in[2]; const float* c_ctx = (const float*)d_in[3];
    const float* w_ada = (const float*)d_in[4]; const float* b_ada = (const float*)d_in[5]; const float* norm_pre = (const float*)d_in[6]; const float* norm_post = (const float*)d_in[7];
    const float* w_in = (const float*)d_in[8]; const float* w_out = (const float*)d_in[9];
    const float* lq1 = (const float*)d_in[10]; const float* lk1 = (const float*)d_in[11]; const float* lq2 = (const float*)d_in[12]; const float* lk2 = (const float*)d_in[13];
    const float* subln = (const float*)d_in[14]; const float* conv_w = (const float*)d_in[15]; const float* conv_b = (const float*)d_in[16];
    const float* i_bias = (const float*)d_in[17]; const float* f_bias = (const float*)d_in[18]; const float* mnorm = (const float*)d_in[19];
    float* out = (float*)d_out; unsigned char* ws = (unsigned char*)d_ws;
    float* MOD = (float*)(ws + WS_MOD); float* SC = (float*)(ws + WS_SC); float2* ROPE = (float2*)(ws + WS_ROPE); float* GATES = (float*)(ws + WS_GATES);
    bf16_t* WOUT = (bf16_t*)(ws + WS_WOUT); bf16_t* WIN = (bf16_t*)(ws + WS_WIN); float* XC = (float*)(ws + WS_XC);
    bf16_t* H = (bf16_t*)(ws + WS_H); bf16_t* HM = (bf16_t*)(ws + WS_HM); bf16_t* P = (bf16_t*)(ws + WS_P);
    bf16_t* Y = H; bf16_t* Y2 = HM;

    const size_t mlstm_lds = (size_t)MLSTM_LDS_FLOATS * 4;
    (void)hipFuncSetAttribute((const void*)k_mlstm_naive, hipFuncAttributeMaxDynamicSharedMemorySize, (int)mlstm_lds);
    (void)hipFuncSetAttribute((const void*)k_mlstm_fast, hipFuncAttributeMaxDynamicSharedMemorySize, mls::L_END);
    (void)hipFuncSetAttribute((const void*)k_attn_fast, hipFuncAttributeMaxDynamicSharedMemorySize, att::SHM_ATTN);
    (void)hipFuncSetAttribute((const void*)k_gemm_inproj, hipFuncAttributeMaxDynamicSharedMemorySize, GEMM_LDS);
    (void)hipFuncSetAttribute((const void*)k_gemm_outproj, hipFuncAttributeMaxDynamicSharedMemorySize, GEMM_LDS);

    k_silu_c<<<(9 * DM + 255) / 256, 256, 0, stream>>>(c, c_ctx, SC);
    k_mod<<<2 * MODW / 256, 256, 0, stream>>>(SC, w_ada, b_ada, MOD);
    k_rope_table<<<4, 256, 0, stream>>>(ROPE);
    for (int l = 0; l < 2; ++l) k_transpose<<<1024, 256, 0, stream>>>(w_out + (size_t)l * DM * DM, DM, DM, DM, WOUT + (size_t)l * DM * DM);

    for (int l = 0; l < 2; ++l) {
        const float lam_init = (float)(0.8 - 0.6 * exp(-0.3 * (double)l));
        const float* mod_l = MOD + (size_t)l * 9 * MODW;
        const float* w_in_l = w_in + (size_t)l * DM * INC;
        k_transpose<<<2048, 256, 0, stream>>>(w_in_l, INC, DM, NP, WIN);
        k_norm<<<2048, 256, 0, stream>>>(l == 0 ? x : out, l == 0 ? ctx : XC, mod_l, norm_pre + l * DM, w_in_l + NP, H, GATES);
        k_gemm_inproj<<<256, 512, GEMM_LDS, stream>>>(H, WIN, P, (const float*)ROPE);
        k_attn_fast<<<256, 512, att::SHM_ATTN, stream>>>(P, Y, lq1 + l * 64, lk1 + l * 64, lq2 + l * 64, lk2 + l * 64, subln + l * 128, lam_init, l == 0 ? 1 : 0);
        k_mlstm_fast<<<256, 512, mls::L_END, stream>>>(P, GATES, HM, conv_w + (size_t)l * 3 * 1024, conv_b + l * 1024, i_bias + l * 8, f_bias + l * 8);
        k_finish_mlstm<<<2048, 256, 0, stream>>>(P, HM, mnorm + l * 1024, Y);
        k_gemm_outproj<<<256, 512, GEMM_LDS, stream>>>(Y, WOUT + (size_t)l * DM * DM, Y2, l == 0 ? NTOK : NLAT);
        k_post<<<2048, 256, 0, stream>>>(l == 0 ? x : out, l == 0 ? ctx : XC, Y2, mod_l, norm_post + l * DM, out, XC, l == 0 ? NTOK : NLAT);
    }
}
```

```cpp
#include <hip/hip_runtime.h>
#include <hip/hip_cooperative_groups.h>
#include <stdint.h>
#include <math.h>

#define DEVI __device__ __forceinline__
typedef unsigned short bf16_t;

constexpr int DM = 2048, NBATCH = 8, SEQ = 2048, CTXL = 256;
constexpr int NLAT = NBATCH * SEQ, NCTX = NBATCH * CTXL, NTOK = NLAT + NCTX;
constexpr int INC = 8208, NP = 8192, MODW = 6144;
constexpr int C_QA = 0, C_KA = 1024, C_VA = 2048, C_GA = 3072, C_QB = 4096, C_KB = 4608, C_VB = 5120, C_OB = 6144, C_GB = 7168;
constexpr float EPS = 1e-6f;

constexpr size_t MiB = (size_t)1 << 20;
constexpr size_t WS_CTL = 0, WS_MOD = 1 * MiB, WS_SC = WS_MOD + 512 * 1024, WS_ROPE = 2 * MiB, WS_GATES = 3 * MiB, WS_WOUT = 8 * MiB,
                 WS_WIN = 24 * MiB, WS_XC = 56 * MiB, WS_H = 72 * MiB, WS_HM = 144 * MiB, WS_P = 216 * MiB, WS_END = 504 * MiB;

DEVI int opaque_tid() { int t = threadIdx.x; asm volatile("" : "+v"(t)); return t; }
DEVI float bf2f(bf16_t v) { return __uint_as_float(((unsigned)v) << 16); }
DEVI bf16_t f2bf(float f) { unsigned u = __float_as_uint(f); return (bf16_t)((u + 0x7fffu + ((u >> 16) & 1u)) >> 16); }
DEVI unsigned pk2(float lo, float hi) { return (unsigned)f2bf(lo) | ((unsigned)f2bf(hi) << 16); }
DEVI float wave_sum(float v) {
#pragma unroll
    for (int o = 32; o > 0; o >>= 1) v += __shfl_xor(v, o);
    return v;
}
DEVI float wave_max(float v) {
#pragma unroll
    for (int o = 32; o > 0; o >>= 1) v = fmaxf(v, __shfl_xor(v, o));
    return v;
}
DEVI float silu_f(float x) { return x / (1.f + expf(-x)); }
DEVI float sigmoid_f(float x) { return 1.f / (1.f + expf(-x)); }


DEVI void transpose_item(const float* __restrict__ W, int ldw, int K, int N, bf16_t* __restrict__ WT, float* scr, int item, int lane) {
    const int nblk = N / 32, kb = item / nblk, nb = item % nblk, k0 = 64 * kb, n0 = 32 * nb;
#pragma unroll 8
    for (int i = 0; i < 32; ++i) { const int kk = 2 * i + (lane >> 5); scr[kk * 33 + (lane & 31)] = W[(size_t)(k0 + kk) * ldw + n0 + (lane & 31)]; }
    asm volatile("s_waitcnt lgkmcnt(0)" ::: "memory");
    const int c = lane & 7;
#pragma unroll
    for (int j = 0; j < 4; ++j) {
        const int n = (lane >> 3) + 8 * j; const float* s = scr + (8 * c) * 33 + n;
        uint4 o; o.x = pk2(s[0 * 33], s[1 * 33]); o.y = pk2(s[2 * 33], s[3 * 33]); o.z = pk2(s[4 * 33], s[5 * 33]); o.w = pk2(s[6 * 33], s[7 * 33]);
        *(uint4*)(WT + (size_t)(n0 + n) * K + k0 + 8 * c) = o;
    }
    asm volatile("s_waitcnt lgkmcnt(0)" ::: "memory");
}

namespace pg8 {
#define PG8_LAS __attribute__((address_space(3)))
typedef unsigned short bf16_t;
typedef short bf16x8 __attribute__((ext_vector_type(8)));
typedef float f32x4 __attribute__((ext_vector_type(4)));
typedef unsigned u32x4 __attribute__((ext_vector_type(4)));
constexpr int BM = 256, BK = 64, HALF = 128, HTB = HALF * BK * 2  , STAGE_BYTES = 8 * HTB, NXCD = 8, WGM = 8;

__host__ __device__ __forceinline__ int lds_byte(int r, int c) { const int st = (r >> 4) * 2 + (c >> 5), rr = r & 15, cc = c & 31, ob = rr * 64 + cc * 2; return st * 1024 + (ob ^ (((ob >> 9) & 1) << 5)); }
__host__ __device__ __forceinline__ void stage_rc(int b, int& R, int& C) { const int st = b / 1024, sb = b % 1024, swz = sb ^ (((sb >> 9) & 1) << 5); R = (st >> 1) * 16 + swz / 64; C = (st & 1) * 32 + (swz % 64) / 2; }
__host__ __device__ __forceinline__ int perm32(int rho) { const int n = rho >> 4, i = rho & 15; return 8 * (i >> 2) + 4 * n + (i & 3); }

struct Unit { int pm, pn; };
struct Gemm { const bf16_t* A; const bf16_t* Bt; int M, N, K; };

struct StaticOrder {
    int nM, nN, nwg, G, c;
    __host__ __device__ void init(int M, int N, int G_, int c_) { nM = M / BM; nN = N / BM; nwg = nM * nN; G = G_; c = c_; }
    __host__ __device__ bool next(int i, Unit& u) const {
        const long L = (long)i * G + c; if (L >= nwg) return false;
        int wgid = (int)L; { const int q = nwg / NXCD, r = nwg % NXCD, xcd = wgid % NXCD, off = wgid / NXCD; wgid = (xcd < r ? xcd * (q + 1) : r * (q + 1) + (xcd - r) * q) + off; }
        const int nig = WGM * nN, gid = wgid / nig, fm = gid * WGM, gsz = (nM - fm) < WGM ? (nM - fm) : WGM;
        u.pm = fm + ((wgid % nig) % gsz); u.pn = (wgid % nig) / gsz; return true;
    }
    __device__ __forceinline__ void a_ready(const Unit&) const {}
    __device__ __forceinline__ void done(const Unit&) const {}
};

__device__ __forceinline__ unsigned cvt_pk_bf16(float lo, float hi) { unsigned r; asm volatile("v_cvt_pk_bf16_f32 %0, %1, %2" : "=v"(r) : "v"(lo), "v"(hi)); return r; }

struct EpiBf16 {
    static constexpr bool PERM = true, AFTER_DRAIN = false;
    bf16_t* O; int ldc;
    __device__ __forceinline__ void operator()(const f32x4 (&acc)[2][2][4][2], const Unit& u, int wr, int wc, int fr, int fq) const {
        const int row0 = u.pm * BM + wr * 64 + fr, col0 = u.pn * BM + wc * 32 + 8 * fq;
#pragma unroll
        for (int ai = 0; ai < 2; ++ai)
#pragma unroll
            for (int m = 0; m < 4; ++m) { bf16_t* rowp = O + (size_t)(row0 + ai * HALF + m * 16) * ldc + col0;
#pragma unroll
                for (int bj = 0; bj < 2; ++bj) { const f32x4 v0 = acc[ai][bj][m][0], v1 = acc[ai][bj][m][1];
                    u32x4 w; w.x = cvt_pk_bf16(v0[0], v0[1]); w.y = cvt_pk_bf16(v0[2], v0[3]); w.z = cvt_pk_bf16(v1[0], v1[1]); w.w = cvt_pk_bf16(v1[2], v1[3]);
                    *(u32x4*)(rowp + bj * HALF) = w; } }
    }
};
struct EpiInProj {
    static constexpr bool PERM = true, AFTER_DRAIN = false;
    bf16_t* O; int ldc; const float* rope;
    __device__ __forceinline__ void operator()(const f32x4 (&acc)[2][2][4][2], const Unit& u, int wr, int wc, int fr, int fq) const {
        const int row0 = u.pm * BM + wr * 64 + fr, col0 = u.pn * BM + wc * 32 + 8 * fq;
        const bool do_rope = (u.pn < 8) && (u.pm < 64);
#pragma unroll
        for (int ai = 0; ai < 2; ++ai)
#pragma unroll
            for (int m = 0; m < 4; ++m) { const int row = row0 + ai * HALF + m * 16; bf16_t* rowp = O + (size_t)row * ldc + col0;
                f32x4 cs01 = {1.f, 0.f, 1.f, 0.f}, cs23 = {1.f, 0.f, 1.f, 0.f};
                if (do_rope) { const int pos = (wc & 1) ? (row & 63) : ((row >> 6) & 31); const f32x4* rp = (const f32x4*)(rope + (size_t)(pos * 16 + 4 * fq) * 2); cs01 = rp[0]; cs23 = rp[1]; }
#pragma unroll
                for (int bj = 0; bj < 2; ++bj) { f32x4 v0 = acc[ai][bj][m][0], v1 = acc[ai][bj][m][1];
                    if (do_rope) {
                        const float a0 = v0[0] * cs01[0] - v0[1] * cs01[1], a1 = v0[0] * cs01[1] + v0[1] * cs01[0];
                        const float a2 = v0[2] * cs01[2] - v0[3] * cs01[3], a3 = v0[2] * cs01[3] + v0[3] * cs01[2];
                        const float b0 = v1[0] * cs23[0] - v1[1] * cs23[1], b1 = v1[0] * cs23[1] + v1[1] * cs23[0];
                        const float b2 = v1[2] * cs23[2] - v1[3] * cs23[3], b3 = v1[2] * cs23[3] + v1[3] * cs23[2];
                        v0 = (f32x4){a0, a1, a2, a3}; v1 = (f32x4){b0, b1, b2, b3};
                    }
                    u32x4 w; w.x = cvt_pk_bf16(v0[0], v0[1]); w.y = cvt_pk_bf16(v0[2], v0[3]); w.z = cvt_pk_bf16(v1[0], v1[1]); w.w = cvt_pk_bf16(v1[2], v1[3]);
                    *(u32x4*)(rowp + bj * HALF) = w; } }
    }
};

template <class Epi, class Sched, bool ALIGN_EPI = false, bool SP2 = false>
__device__ __forceinline__ void gemm_phase(PG8_LAS unsigned char* lds, const Gemm g, const Sched& S, const Epi& E) {
    const int tid = opaque_tid(), wid = __builtin_amdgcn_readfirstlane(tid >> 6), lane = tid & 63, wr = wid >> 2, wc = wid & 3, fr = lane & 15, fq = lane >> 4;
    const int K = g.K, nt = K / BK;
    unsigned voffA[2], voffB[2];
#pragma unroll
    for (int i = 0; i < 2; ++i) { int R, C; stage_rc(tid * 16 + i * 8192, R, C); const int Rb = Epi::PERM ? ((R & ~31) + perm32(R & 31)) : R;
        voffA[i] = (unsigned)(R * K + C) * 2u; voffB[i] = (unsigned)(Rb * K + C) * 2u; }
    const size_t kstep = (size_t)(BK * 2);
    const size_t hstep = (size_t)HALF * K * 2;
    const size_t tstep = 2 * hstep;
    const unsigned ldsw = (unsigned)wid * 1024u;
    const int aoff = lds_byte(wr * 64 + fr, fq * 8), boff = lds_byte(wc * 32 + fr, fq * 8);
#define PG8_SA(b, h) (((b) * 2 + (h)) * HTB)
#define PG8_SB(b, h) ((4 + (b) * 2 + (h)) * HTB)
#define PG8_STAGE(bufoff, gbase, voff) do { _Pragma("unroll") for (int _i = 0; _i < 2; ++_i) \
        __builtin_amdgcn_global_load_lds((const unsigned*)((const char*)(gbase) + (voff)[_i]), (PG8_LAS unsigned*)(lds + (bufoff) + ldsw + _i * 8192), 16, 0, 0); } while (0)
#define PG8_LDA(dst, b, h) do { _Pragma("unroll") for (int m = 0; m < 4; ++m) _Pragma("unroll") for (int k = 0; k < 2; ++k) dst[m][k] = *(const PG8_LAS bf16x8*)(lds + PG8_SA(b, h) + aoff + m * 2048 + k * 1024); } while (0)
#define PG8_LDB(dst, b, h) do { _Pragma("unroll") for (int n = 0; n < 2; ++n) _Pragma("unroll") for (int k = 0; k < 2; ++k) dst[n][k] = *(const PG8_LAS bf16x8*)(lds + PG8_SB(b, h) + boff + n * 2048 + k * 1024); } while (0)
#define PG8_MMA(ai, bj, At, Bt) do { __builtin_amdgcn_s_setprio(1); _Pragma("unroll") for (int m = 0; m < 4; ++m) _Pragma("unroll") for (int n = 0; n < 2; ++n) _Pragma("unroll") for (int k = 0; k < 2; ++k) \
        acc[ai][bj][m][n] = __builtin_amdgcn_mfma_f32_16x16x32_bf16(Bt[n][k], At[m][k], acc[ai][bj][m][n], 0, 0, 0); __builtin_amdgcn_s_setprio(0); } while (0)
#define PG8_WAIT_V(n) asm volatile("s_waitcnt vmcnt(" #n ")" ::: "memory")
#define PG8_WAIT_L(n) asm volatile("s_waitcnt lgkmcnt(" #n ")" ::: "memory")
#define PG8_BAR __builtin_amdgcn_s_barrier()
#define PG8_SCHED __builtin_amdgcn_sched_barrier(0)
    Unit cur, nxt; int ui = 0;
    if (!S.next(0, cur)) return;
    f32x4 acc[2][2][4][2];
#pragma unroll
    for (int a = 0; a < 2; ++a)
#pragma unroll
        for (int b = 0; b < 2; ++b)
#pragma unroll
            for (int m = 0; m < 4; ++m)
#pragma unroll
                for (int n = 0; n < 2; ++n) acc[a][b][m][n] = (f32x4){0.f, 0.f, 0.f, 0.f};
    bf16x8 At[4][2], B0[2][2], B1[2][2];
    const char* cA = (const char*)g.A + (size_t)cur.pm * tstep; const char* cB = (const char*)g.Bt + (size_t)cur.pn * tstep;
    S.a_ready(cur);
    if constexpr (SP2) {
        PG8_STAGE(PG8_SB(0, 0), cB, voffB); PG8_STAGE(PG8_SB(0, 1), cB + hstep, voffB); PG8_STAGE(PG8_SA(0, 0), cA, voffA); PG8_STAGE(PG8_SA(0, 1), cA + hstep, voffA);
        if (wr == 1) PG8_BAR;
        PG8_WAIT_V(2); PG8_BAR;
        PG8_STAGE(PG8_SB(1, 0), cB + kstep, voffB); PG8_STAGE(PG8_SA(1, 0), cA + kstep, voffA); PG8_STAGE(PG8_SB(1, 1), cB + hstep + kstep, voffB);
        PG8_WAIT_V(6); PG8_BAR;
    } else {
        PG8_STAGE(PG8_SB(0, 0), cB, voffB); PG8_STAGE(PG8_SA(0, 0), cA, voffA); PG8_STAGE(PG8_SB(0, 1), cB + hstep, voffB); PG8_STAGE(PG8_SA(0, 1), cA + hstep, voffA);
        if (wr == 1) PG8_BAR;
        PG8_WAIT_V(4); PG8_BAR;
        PG8_STAGE(PG8_SB(1, 0), cB + kstep, voffB); PG8_STAGE(PG8_SA(1, 0), cA + kstep, voffA); PG8_STAGE(PG8_SB(1, 1), cB + hstep + kstep, voffB);
        PG8_WAIT_V(6); PG8_BAR;
    }
    for (;;) {
        const bool has_next = S.next(ui + 1, nxt);
        const char* nA = has_next ? (const char*)g.A + (size_t)nxt.pm * tstep : cA; const char* nB = has_next ? (const char*)g.Bt + (size_t)nxt.pn * tstep : cB;
        for (int t = 0; t < nt; t += 2) {
            const bool last = (t == nt - 2);
            const char* a1 = cA + (size_t)(t + 1) * kstep;
            const char* a2 = last ? nA : cA + (size_t)(t + 2) * kstep; const char* b2 = last ? nB : cB + (size_t)(t + 2) * kstep;
            const char* a3 = a2 + kstep; const char* b3 = b2 + kstep;
            if (last && has_next) S.a_ready(nxt);
            if constexpr (SP2) {
            PG8_LDB(B0, 0, 0); PG8_LDB(B1, 0, 1); PG8_SCHED; PG8_LDA(At, 0, 0); PG8_STAGE(PG8_SA(1, 1), a1 + hstep, voffA);
            PG8_WAIT_V(8); PG8_WAIT_L(0); PG8_BAR; PG8_MMA(0, 0, At, B0); PG8_MMA(0, 1, At, B1); PG8_BAR; PG8_SCHED;
            PG8_LDA(At, 0, 1); PG8_STAGE(PG8_SB(0, 0), b2, voffB); PG8_STAGE(PG8_SB(0, 1), b2 + hstep, voffB); PG8_STAGE(PG8_SA(0, 0), a2, voffA);
            PG8_WAIT_V(8); PG8_WAIT_L(0); PG8_BAR; PG8_MMA(1, 0, At, B0); PG8_MMA(1, 1, At, B1); PG8_BAR; PG8_SCHED;
            PG8_LDB(B0, 1, 0); PG8_LDB(B1, 1, 1); PG8_SCHED; PG8_LDA(At, 1, 0); PG8_STAGE(PG8_SA(0, 1), a2 + hstep, voffA);
            PG8_WAIT_V(8); PG8_WAIT_L(0); PG8_BAR; PG8_MMA(0, 0, At, B0); PG8_MMA(0, 1, At, B1); PG8_BAR; PG8_SCHED;
            PG8_LDA(At, 1, 1); PG8_STAGE(PG8_SB(1, 0), b3, voffB); PG8_STAGE(PG8_SB(1, 1), b3 + hstep, voffB); PG8_STAGE(PG8_SA(1, 0), a3, voffA);
            PG8_WAIT_V(8); PG8_WAIT_L(0); PG8_BAR; PG8_MMA(1, 0, At, B0); PG8_MMA(1, 1, At, B1); PG8_BAR; PG8_SCHED;
            } else {
            PG8_LDB(B0, 0, 0); PG8_SCHED; PG8_LDA(At, 0, 0); PG8_STAGE(PG8_SA(1, 1), a1 + hstep, voffA);
            PG8_WAIT_L(8); PG8_BAR; PG8_WAIT_L(0); PG8_MMA(0, 0, At, B0); PG8_BAR; PG8_SCHED;
            PG8_LDB(B1, 0, 1); PG8_STAGE(PG8_SB(0, 0), b2, voffB);
            PG8_BAR; PG8_WAIT_L(0); PG8_MMA(0, 1, At, B1); PG8_BAR;
            PG8_LDA(At, 0, 1); PG8_STAGE(PG8_SA(0, 0), a2, voffA);
            PG8_BAR; PG8_WAIT_L(0); PG8_MMA(1, 0, At, B0); PG8_BAR; PG8_SCHED;
            PG8_STAGE(PG8_SB(0, 1), b2 + hstep, voffB);
            PG8_WAIT_V(6); PG8_BAR; PG8_MMA(1, 1, At, B1); PG8_BAR;
            PG8_LDB(B0, 1, 0); PG8_SCHED; PG8_LDA(At, 1, 0); PG8_STAGE(PG8_SA(0, 1), a2 + hstep, voffA);
            PG8_WAIT_L(8); PG8_BAR; PG8_WAIT_L(0); PG8_MMA(0, 0, At, B0); PG8_BAR; PG8_SCHED;
            PG8_LDB(B1, 1, 1); PG8_STAGE(PG8_SB(1, 0), b3, voffB);
            PG8_BAR; PG8_WAIT_L(0); PG8_MMA(0, 1, At, B1); PG8_BAR;
            PG8_LDA(At, 1, 1); PG8_STAGE(PG8_SA(1, 0), a3, voffA);
            PG8_BAR; PG8_WAIT_L(0); PG8_MMA(1, 0, At, B0); PG8_BAR; PG8_SCHED;
            PG8_STAGE(PG8_SB(1, 1), b3 + hstep, voffB);
            PG8_WAIT_V(6); PG8_BAR; PG8_MMA(1, 1, At, B1); PG8_BAR;
            }
        }
        if constexpr (ALIGN_EPI) { if (wr == 0) PG8_BAR; }
        if constexpr (!Epi::AFTER_DRAIN) { E(acc, cur, wr, wc, fr, fq); S.done(cur); }
        if (!has_next) break;
#pragma unroll
        for (int a = 0; a < 2; ++a)
#pragma unroll
            for (int b = 0; b < 2; ++b)
#pragma unroll
                for (int m = 0; m < 4; ++m)
#pragma unroll
                    for (int n = 0; n < 2; ++n) acc[a][b][m][n] = (f32x4){0.f, 0.f, 0.f, 0.f};
        cur = nxt; cA = nA; cB = nB; ++ui;
        if constexpr (ALIGN_EPI) { if (wr == 1) PG8_BAR; }
    }
    PG8_WAIT_V(0);
    if constexpr (!ALIGN_EPI) { if (wr == 0) PG8_BAR; }
    PG8_BAR;
    if constexpr (Epi::AFTER_DRAIN) { E.fused(acc, cur, wr, wc, fr, fq, lds, wid, lane); S.done(cur); }
#undef PG8_SA
#undef PG8_SB
#undef PG8_STAGE
#undef PG8_LDA
#undef PG8_LDB
#undef PG8_MMA
#undef PG8_WAIT_V
#undef PG8_WAIT_L
#undef PG8_BAR
#undef PG8_SCHED
}
}

namespace att {
using bf16x8 = __attribute__((ext_vector_type(8))) short;
using s16x4  = __attribute__((ext_vector_type(4))) short;
using f32x16 = __attribute__((ext_vector_type(16))) float;
using u32x4  = __attribute__((ext_vector_type(4))) unsigned;
constexpr int NW = 8, QBLK = 32, KVBLK = 64, QROWS = 128;
constexpr float SCALE = 0.125f, THR = 6.f;
constexpr int SHM_V = KVBLK * 128 * 2, SHM_K = KVBLK * 128 * 2, SHM_ATTN = 2 * SHM_V + 2 * SHM_K + NW * 64 * 4;
#define KSWZ(row, colB) ((row) * 256 + ((colB) ^ (((row) & 7) << 4)))
#define SBAR() __builtin_amdgcn_sched_barrier(0)
__device__ __forceinline__ int crow(int r, int hi) { return (r & 3) + 8 * (r >> 2) + 4 * hi; }
__device__ __forceinline__ unsigned cvtpk(float lo, float hi) { unsigned r; asm volatile("v_cvt_pk_bf16_f32 %0, %1, %2" : "=v"(r) : "v"(lo), "v"(hi)); return r; }
__device__ __forceinline__ void partialSM(f32x16& p0, f32x16& p1, float& m_reg, float& mn, float& alpha) {
  constexpr float C = SCALE * 1.4426950408889634f;
  float pmax = p0[0];
#pragma unroll
  for (int r = 1; r < 16; ++r) pmax = fmaxf(pmax, p0[r]);
#pragma unroll
  for (int r = 0; r < 16; ++r) pmax = fmaxf(pmax, p1[r]);
  { auto rr = __builtin_amdgcn_permlane32_swap(__float_as_uint(pmax), __float_as_uint(pmax), false, false);
    pmax = fmaxf(__uint_as_float(rr[0]), __uint_as_float(rr[1])); }
  if (__builtin_expect(__all(pmax - m_reg <= THR / SCALE), 1)) { mn = m_reg; alpha = 1.f; }
  else { mn = fmaxf(m_reg, pmax); alpha = __builtin_amdgcn_exp2f((m_reg - mn) * C); m_reg = mn; }
  const float mnC = -mn * C;
#pragma unroll
  for (int r = 0; r < 16; ++r) p0[r] = fmaf(p0[r], C, mnC);
#pragma unroll
  for (int r = 0; r < 16; ++r) p1[r] = fmaf(p1[r], C, mnC);
#pragma unroll
  for (int r = 0; r < 16; ++r) p0[r] = __builtin_amdgcn_exp2f(p0[r]);
}
__device__ __forceinline__ void finishSM(f32x16& p0, f32x16& p1, float alpha, float& l_reg, bf16x8& pa0, bf16x8& pa1, bf16x8& pa2, bf16x8& pa3) {
#pragma unroll
  for (int r = 0; r < 16; ++r) p1[r] = __builtin_amdgcn_exp2f(p1[r]);
  float ps = 0;
#pragma unroll
  for (int r = 0; r < 16; ++r) ps += p0[r];
#pragma unroll
  for (int r = 0; r < 16; ++r) ps += p1[r];
  { auto rr = __builtin_amdgcn_permlane32_swap(__float_as_uint(ps), __float_as_uint(ps), false, false);
    ps = __uint_as_float(rr[0]) + __uint_as_float(rr[1]); }
  l_reg = l_reg * alpha + ps;
#define PK4(P, BASE, OUT) do { unsigned a0 = cvtpk(P[BASE + 0], P[BASE + 1]), a1 = cvtpk(P[BASE + 2], P[BASE + 3]);   \
    unsigned b0 = cvtpk(P[BASE + 4], P[BASE + 5]), b1 = cvtpk(P[BASE + 6], P[BASE + 7]);                              \
    auto r0 = __builtin_amdgcn_permlane32_swap(a0, b0, false, false); auto r1 = __builtin_amdgcn_permlane32_swap(a1, b1, false, false); \
    u32x4 w = {r0[0], r1[0], r0[1], r1[1]}; OUT = *reinterpret_cast<bf16x8*>(&w); } while (0)
  PK4(p0, 0, pa0); PK4(p0, 8, pa1); PK4(p1, 0, pa2); PK4(p1, 8, pa3);
#undef PK4
}
__device__ __forceinline__ void qkt(f32x16& p0, f32x16& p1, const char* Ks, const bf16x8* qr, int r32, int hi, int sub) {
  p0 = f32x16{}; p1 = f32x16{};
#pragma unroll
  for (int d0 = 0; d0 < 4; ++d0) { const int cb = (sub * 64 + d0 * 16 + hi * 8) * 2;
    const bf16x8 b0 = *reinterpret_cast<const bf16x8*>(Ks + KSWZ(r32, cb));
    const bf16x8 b1 = *reinterpret_cast<const bf16x8*>(Ks + KSWZ(32 + r32, cb));
    p0 = __builtin_amdgcn_mfma_f32_32x32x16_bf16(b0, qr[d0], p0, 0, 0, 0);
    p1 = __builtin_amdgcn_mfma_f32_32x32x16_bf16(b1, qr[d0], p1, 0, 0, 0); }
}
__device__ __forceinline__ int v_st(int k, int c) { const int kk = (k & ~0xC) | ((k & 4) << 1) | ((k & 8) >> 1); return ((kk >> 3) * 4 + (c >> 5)) * 512 + ((kk & 7) * 32 + (c & 31)) * 2; }
__device__ __forceinline__ int v_rd_base(int lane) { return ((lane & 3) << 3) | (((lane >> 2) & 3) << 6) | (((lane >> 4) & 1) << 5) | (((lane >> 5) & 1) << 8); }
constexpr int v_rd_off(int d0, int ks, int half) { return d0 * 512 + ks * 4096 + half * 2048; }
template <int OFF> __device__ __forceinline__ s16x4 tr_read(int vb) {
  s16x4 r; asm volatile("ds_read_b64_tr_b16 %0, %1 offset:%2" : "=&v"(r) : "v"(vb), "i"(OFF) : "memory"); return r;
}
template <int D0> __device__ __forceinline__ void pv_one(f32x16& od, int vb, bf16x8 pa0, bf16x8 pa1, bf16x8 pa2, bf16x8 pa3) {
  const s16x4 l0 = tr_read<v_rd_off(D0, 0, 0)>(vb), h0 = tr_read<v_rd_off(D0, 0, 1)>(vb), l1 = tr_read<v_rd_off(D0, 1, 0)>(vb), h1 = tr_read<v_rd_off(D0, 1, 1)>(vb);
  const s16x4 l2 = tr_read<v_rd_off(D0, 2, 0)>(vb), h2 = tr_read<v_rd_off(D0, 2, 1)>(vb), l3 = tr_read<v_rd_off(D0, 3, 0)>(vb), h3 = tr_read<v_rd_off(D0, 3, 1)>(vb);
  asm volatile("s_waitcnt lgkmcnt(0)" ::: "memory"); SBAR();
#define PK(L, H) (bf16x8){L[0], L[1], L[2], L[3], H[0], H[1], H[2], H[3]}
  od = __builtin_amdgcn_mfma_f32_32x32x16_bf16(pa0, PK(l0, h0), od, 0, 0, 0);
  od = __builtin_amdgcn_mfma_f32_32x32x16_bf16(pa1, PK(l1, h1), od, 0, 0, 0);
  od = __builtin_amdgcn_mfma_f32_32x32x16_bf16(pa2, PK(l2, h2), od, 0, 0, 0);
  od = __builtin_amdgcn_mfma_f32_32x32x16_bf16(pa3, PK(l3, h3), od, 0, 0, 0);
#undef PK
}
__device__ __forceinline__ void pv_d0(f32x16* o, int vb, bf16x8 pa0, bf16x8 pa1, bf16x8 pa2, bf16x8 pa3) {
  pv_one<0>(o[0], vb, pa0, pa1, pa2, pa3); pv_one<1>(o[1], vb, pa0, pa1, pa2, pa3); pv_one<2>(o[2], vb, pa0, pa1, pa2, pa3); pv_one<3>(o[3], vb, pa0, pa1, pa2, pa3);
}
__device__ __forceinline__ long ktile_row(int b, int t) { return t < 4 ? (long)(NLAT + b * CTXL + 64 * t) : (long)(b * SEQ + 64 * (t - 4)); }

__device__ __forceinline__ void attn_unit(const bf16_t* __restrict__ Pm, bf16_t* __restrict__ Y, long qrow0, int b, int hh, int NT, float lam, float lam_init,
                                          const float* __restrict__ subln, char* lds) {
  const int tid = opaque_tid(), wid = tid >> 6, lane = tid & 63, r32 = lane & 31, hi = lane >> 5;
  const int sub = wid & 1, pr = wid >> 1;
  char* V_lds = lds; char* K_lds = lds + 2 * SHM_V;
  float* ws = (float*)(lds + 2 * SHM_V + 2 * SHM_K) + wid * 64; float* li_l = ws; float* al_l = ws + 32;
  float m_reg = -1e30f, l_reg = 0; f32x16 o[4] = {}; bf16x8 qr[4];
  const bf16_t* Qw = Pm + (qrow0 + pr * QBLK + r32) * NP + C_QA + hh * 128 + sub * 64 + hi * 8;
#pragma unroll
  for (int d0 = 0; d0 < 4; ++d0) qr[d0] = *reinterpret_cast<const bf16x8*>(Qw + d0 * 16);
  const int sr = tid >> 4, sc = (tid & 15) * 8, vst0 = v_st(sr, sc), vst1 = v_st(32 + sr, sc);
  const int vb0 = (int)(uintptr_t)V_lds + v_rd_base(lane);
  const bf16_t* Kcol = Pm + C_KA + hh * 128 + sc; const bf16_t* Vcol = Pm + C_VA + hh * 128 + sc;
  struct { bf16x8 vs0, vs1, ks0, ks1; } sr_[2];
#define SLOAD(i, t) do { const long r0_ = ktile_row(b, (t)) + sr; \
    sr_[i].vs0 = *reinterpret_cast<const bf16x8*>(Vcol + r0_ * NP); sr_[i].vs1 = *reinterpret_cast<const bf16x8*>(Vcol + (r0_ + 32) * NP); \
    sr_[i].ks0 = *reinterpret_cast<const bf16x8*>(Kcol + r0_ * NP); sr_[i].ks1 = *reinterpret_cast<const bf16x8*>(Kcol + (r0_ + 32) * NP); } while (0)
#define SWRITE(bb, i) do { *(bf16x8*)(V_lds + (bb) * SHM_V + vst0) = sr_[i].vs0; *(bf16x8*)(V_lds + (bb) * SHM_V + vst1) = sr_[i].vs1; const int kc = sc * 2; \
    *(bf16x8*)(K_lds + (bb) * SHM_K + KSWZ(sr, kc)) = sr_[i].ks0; *(bf16x8*)(K_lds + (bb) * SHM_K + KSWZ(32 + sr, kc)) = sr_[i].ks1; } while (0)
#define SWAIT() asm volatile("s_waitcnt vmcnt(4)" ::: "memory")
#define RESC(a) do { if (__any((a) < 1.f)) { if (hi == 0) al_l[r32] = (a); asm volatile("s_waitcnt lgkmcnt(0)" ::: "memory"); \
    _Pragma("unroll") for (int d = 0; d < 4; ++d) _Pragma("unroll") for (int r = 0; r < 16; ++r) o[d][r] *= al_l[crow(r, hi)]; } } while (0)
  f32x16 pA0, pA1, pB0, pB1; float mnA, mnB, alA, alB; bf16x8 pa0, pa1, pa2, pa3;
  constexpr int SE = 0, SO = 1;
  SLOAD(SE, 0); asm volatile("s_waitcnt vmcnt(0)" ::: "memory"); SWRITE(0, SE); __syncthreads();
  qkt(pA0, pA1, K_lds, qr, r32, hi, sub); partialSM(pA0, pA1, m_reg, mnA, alA);
  SLOAD(SO, 1); if (2 < NT) SLOAD(SE, 2);
  SWAIT(); SWRITE(1, SO); __syncthreads();
  for (int j = 1; j + 1 < NT; j += 2) {
    SBAR(); qkt(pB0, pB1, K_lds + SHM_K, qr, r32, hi, sub);
    finishSM(pA0, pA1, alA, l_reg, pa0, pa1, pa2, pa3); SBAR();
    SLOAD(SO, j + 2); SBAR();
    pv_d0(o, vb0, pa0, pa1, pa2, pa3); partialSM(pB0, pB1, m_reg, mnB, alB);
    __syncthreads(); SWAIT(); SWRITE(0, SE);
    RESC(alB); __syncthreads();
    SBAR(); qkt(pA0, pA1, K_lds, qr, r32, hi, sub);
    finishSM(pB0, pB1, alB, l_reg, pa0, pa1, pa2, pa3); SBAR();
    if (j + 3 < NT) SLOAD(SE, j + 3); SBAR();
    pv_d0(o, vb0 + SHM_V, pa0, pa1, pa2, pa3); partialSM(pA0, pA1, m_reg, mnA, alA);
    __syncthreads(); SWAIT(); SWRITE(1, SO);
    RESC(alA); __syncthreads();
  }
  SBAR(); qkt(pB0, pB1, K_lds + SHM_K, qr, r32, hi, sub);
  finishSM(pA0, pA1, alA, l_reg, pa0, pa1, pa2, pa3); SBAR();
  pv_d0(o, vb0, pa0, pa1, pa2, pa3); partialSM(pB0, pB1, m_reg, mnB, alB);
  __syncthreads(); RESC(alB);
  finishSM(pB0, pB1, alB, l_reg, pa0, pa1, pa2, pa3); SBAR();
  pv_d0(o, vb0 + SHM_V, pa0, pa1, pa2, pa3);
  if (hi == 0) li_l[r32] = l_reg; asm volatile("s_waitcnt lgkmcnt(0)" ::: "memory");
  const float fac = sub ? lam : 1.f;
#pragma unroll
  for (int r = 0; r < 16; ++r) { const float rl = fac * __builtin_amdgcn_rcpf(li_l[crow(r, hi)]);
#pragma unroll
    for (int d0 = 0; d0 < 4; ++d0) o[d0][r] *= rl; }
  __syncthreads();
  float* XB = (float*)lds + pr * 4096;
  if (sub == 1) {
#pragma unroll
    for (int d0 = 0; d0 < 4; ++d0)
#pragma unroll
      for (int r = 0; r < 16; ++r) XB[(d0 * 16 + r) * 64 + lane] = o[d0][r];
  }
  __syncthreads();
  if (sub == 0) {
    float ss[16];
#pragma unroll
    for (int r = 0; r < 16; ++r) { float a = 0.f;
#pragma unroll
      for (int d0 = 0; d0 < 4; ++d0) { o[d0][r] -= XB[(d0 * 16 + r) * 64 + lane]; a += o[d0][r] * o[d0][r]; }
      ss[r] = a; }
#pragma unroll
    for (int r = 0; r < 16; ++r) {
#pragma unroll
      for (int off = 1; off < 32; off <<= 1) ss[r] += __shfl_xor(ss[r], off);
      ss[r] = rsqrtf(ss[r] * (1.f / 128.f) + EPS) * (1.f - lam_init);
    }
    float sw[4];
#pragma unroll
    for (int d0 = 0; d0 < 4; ++d0) sw[d0] = subln[d0 * 32 + r32];
#pragma unroll
    for (int r = 0; r < 16; ++r) { const long row = qrow0 + pr * QBLK + crow(r, hi);
      const bf16_t* gp = Pm + row * NP + C_GA + hh * 128 + r32; bf16_t* yp = Y + row * DM + hh * 128 + r32;
#pragma unroll
      for (int d0 = 0; d0 < 4; ++d0) { const float g = bf2f(gp[d0 * 32]); yp[d0 * 32] = f2bf(o[d0][r] * ss[r] * sw[d0] * (g / (1.f + __expf(-g)))); } }
  }
  __syncthreads();
#undef SLOAD
#undef SWRITE
#undef SWAIT
#undef RESC
}
__device__ __forceinline__ void attn_phase(const bf16_t* __restrict__ Pm, bf16_t* __restrict__ Y, const float* lq1, const float* lk1, const float* lq2, const float* lk2,
                                           const float* __restrict__ subln, float lam_init, bool ctx_out, char* lds) {
  const int lane = opaque_tid() & 63;
  const float lam = expf(wave_sum(lq1[lane] * lk1[lane])) - expf(wave_sum(lq2[lane] * lk2[lane])) + lam_init;
  const int G = gridDim.x, bx = blockIdx.x; const int vcu = (G % 8 == 0) ? (bx % 8) * (G / 8) + bx / 8 : bx;
  const int nunits = 1024 + (ctx_out ? 128 : 0);
  for (int u = vcu; u < nunits; u += G) {
    if (u < 1024) { const int bh = u >> 4, qb = u & 15, b = bh >> 3, hh = bh & 7; attn_unit(Pm, Y, (long)b * SEQ + qb * QROWS, b, hh, 36, lam, lam_init, subln, lds); }
    else { const int v = u - 1024, bh = v >> 1, qb = v & 1, b = bh >> 3, hh = bh & 7; attn_unit(Pm, Y, (long)NLAT + b * CTXL + qb * QROWS, b, hh, 4, lam, lam_init, subln, lds); }
  }
}
#undef KSWZ
#undef SBAR
}

namespace mls {
using bf16x8 = __attribute__((ext_vector_type(8))) short;
using f32x4  = __attribute__((ext_vector_type(4))) float;
constexpr int QSTRB = 272, SSTRB = 144;
constexpr int NPOS = 2304;
constexpr int L_BC = 0, L_IG = L_BC + NPOS * 4, L_Q = L_IG + NPOS * 4, L_K = L_Q + 64 * QSTRB, L_KW = L_K + 64 * QSTRB, L_VT = L_KW + 128 * SSTRB,
              L_S = L_VT + 64 * SSTRB, L_CT = L_S + 64 * SSTRB, L_SM = L_CT + 2 * 64 * QSTRB, L_END = L_SM + 2560;
static_assert(L_END <= 131072 && (L_Q % 16) == 0 && (L_K % 16) == 0 && (L_KW % 16) == 0 && (L_VT % 16) == 0 && (L_S % 16) == 0 && (L_CT % 16) == 0 && (L_SM % 16) == 0, "mlstm LDS map");
__device__ __forceinline__ f32x4 mfma16(bf16x8 a, bf16x8 b, f32x4 c) { return __builtin_amdgcn_mfma_f32_16x16x32_bf16(a, b, c, 0, 0, 0); }
__device__ __forceinline__ float bfw(unsigned w, int odd) { return odd ? __uint_as_float(w & 0xffff0000u) : __uint_as_float(w << 16); }

__device__ __forceinline__ void mlstm_unit(const bf16_t* __restrict__ Pm, const float* __restrict__ GATES, bf16_t* __restrict__ HM, const float* __restrict__ conv_w,
                                           const float* __restrict__ conv_b, const float* __restrict__ i_bias, const float* __restrict__ f_bias,
                                           int b, int head, int dir, int es, char* lds) {
  const int tid = opaque_tid(), wid = tid >> 6, lane = tid & 63, lr = lane & 15, kg = lane >> 4;
  float* Bc = (float*)(lds + L_BC); float* Ig = (float*)(lds + L_IG);
  char* q_lds = lds + L_Q; char* k_lds = lds + L_K; char* kw_lds = lds + L_KW; char* vt_lds = lds + L_VT; char* s_lds = lds + L_S; char* ct_lds = lds + L_CT;
  float* bl = (float*)(lds + L_SM); float* bsp = bl + 64; float* av = bsp + 64; float* rs = av + 64; float* qn = rs + 256; float* nvec = qn + 64;
  for (int p = tid; p < NPOS; p += 512) {
    const int c = p >> 6, l = p & 63; const bool isctx = c < 4; const int T = isctx ? CTXL : SEQ, cc = isctx ? c : c - 4;
    const long rowbase = isctx ? (long)(NLAT + b * CTXL) : (long)b * SEQ;
    const int t = dir ? (T - 1 - 64 * cc - l) : (64 * cc + l);
    const float* gr = GATES + (rowbase + t) * 16;
    const float gi = gr[dir * 4 + head] + i_bias[dir * 4 + head], gf = gr[8 + dir * 4 + head] + f_bias[dir * 4 + head];
    Ig[p] = 15.f * tanhf(gi * (1.f / 15.f));
    const float fc = 15.f * tanhf(gf * (1.f / 15.f));
    Bc[p] = fminf(fc, 0.f) - log1pf(expf(-fabsf(fc)));
  }
  for (int i = tid; i < 64 * QSTRB / 4; i += 512) ((unsigned*)ct_lds)[i] = 0u;
  if (tid < 128) nvec[tid] = 0.f;
  __syncthreads();
  if (wid == 0) {
    float run = 0.f;
    for (int k = 0; k < 36; ++k) { run += Bc[36 * lane + k]; Bc[36 * lane + k] = run; }
    float x = run;
#pragma unroll
    for (int off = 1; off < 64; off <<= 1) { const float y = __shfl_up(x, off); if (lane >= off) x += y; }
    const float offs = x - run;
    for (int k = 0; k < 36; ++k) Bc[36 * lane + k] += offs;
  }
  __syncthreads();
  const int chg = tid & 31, rg = tid >> 5; const bool isk = chg >= 16; const int ch8 = (chg & 15) * 8;
  const int pcol = (isk ? C_KB : C_QB) + head * 128 + ch8, cidx = (isk ? 512 : 0) + head * 128 + ch8;
  float cw0[8], cw1[8], cw2[8], cbv[8];
#pragma unroll
  for (int i = 0; i < 8; ++i) { cw0[i] = conv_w[cidx + i]; cw1[i] = conv_w[1024 + cidx + i]; cw2[i] = conv_w[2048 + cidx + i]; cbv[i] = conv_b[cidx + i]; }
  const int veg = tid & 15, vrg = tid >> 4;
  f32x4 Cacc[4];
#pragma unroll
  for (int e = 0; e < 4; ++e) Cacc[e] = (f32x4){0.f, 0.f, 0.f, 0.f};
  for (int c = 0; c < 36; ++c) {
    const bool isctx = c < 4; const int T = isctx ? CTXL : SEQ, cc = isctx ? c : c - 4;
    const long rowbase = isctx ? (long)(NLAT + b * CTXL) : (long)b * SEQ;
    const int t0 = dir ? (T - 64 * (cc + 1)) : 64 * cc, p0 = 64 * c;
    char* ct_cur = ct_lds + (c & 1) * 64 * QSTRB; char* ct_nxt = ct_lds + ((c + 1) & 1) * 64 * QSTRB;
    uint4 raw[6];
#pragma unroll
    for (int r = 0; r < 6; ++r) { const int t = t0 + 4 * rg - 1 + r; raw[r] = (t >= 0 && t < T) ? *(const uint4*)(Pm + (rowbase + t) * NP + pcol) : make_uint4(0u, 0u, 0u, 0u); }
    uint2 vr[4];
    if (tid < 256) {
#pragma unroll
      for (int jj = 0; jj < 4; ++jj) vr[jj] = *(const uint2*)(Pm + (rowbase + t0 + 4 * vrg + jj) * NP + C_VB + head * 256 + es * 64 + 4 * veg);
    }
    const float Bend = Bc[p0 + 63], Bprev = p0 ? Bc[p0 - 1] : 0.f;
    const float gamma = expf(Bend - Bprev);
    if (tid < 64) { const float blv = Bc[p0 + tid] - Bprev; bl[tid] = blv; bsp[tid] = blv - Ig[p0 + tid]; av[tid] = expf(blv); }
    {
      float kw[4][8];
#pragma unroll
      for (int jj = 0; jj < 4; ++jj) {
        const int l = dir ? 63 - (4 * rg + jj) : 4 * rg + jj;
        const unsigned* x0 = (const unsigned*)&raw[jj]; const unsigned* x1 = (const unsigned*)&raw[jj + 1]; const unsigned* x2 = (const unsigned*)&raw[jj + 2];
        float o[8];
#pragma unroll
        for (int i = 0; i < 8; ++i) { const float z = cbv[i] + cw0[i] * bfw(x0[i >> 1], i & 1) + cw1[i] * bfw(x1[i >> 1], i & 1) + cw2[i] * bfw(x2[i >> 1], i & 1);
          o[i] = z / (1.f + __expf(-z)); }
        if (isk) {
          const float wk = expf(Bend - Bc[p0 + l] + Ig[p0 + l]);
#pragma unroll
          for (int i = 0; i < 8; ++i) { o[i] *= 0.08838834764831845f; kw[jj][i] = o[i] * wk; }
        }
        uint4 w; w.x = pk2(o[0], o[1]); w.y = pk2(o[2], o[3]); w.z = pk2(o[4], o[5]); w.w = pk2(o[6], o[7]);
        *(uint4*)((isk ? k_lds : q_lds) + l * QSTRB + ch8 * 2) = w;
      }
      if (isk) {
        const int lb = dir ? 60 - 4 * rg : 4 * rg;
#pragma unroll
        for (int i = 0; i < 8; ++i) { uint2 w;
          if (dir) { w.x = pk2(kw[3][i], kw[2][i]); w.y = pk2(kw[1][i], kw[0][i]); } else { w.x = pk2(kw[0][i], kw[1][i]); w.y = pk2(kw[2][i], kw[3][i]); }
          *(uint2*)(kw_lds + (ch8 + i) * SSTRB + lb * 2) = w; }
      }
    }
    if (tid < 256) {
      const int lb = dir ? 60 - 4 * vrg : 4 * vrg;
      const unsigned vw[4][2] = {{vr[0].x, vr[0].y}, {vr[1].x, vr[1].y}, {vr[2].x, vr[2].y}, {vr[3].x, vr[3].y}};
#pragma unroll
      for (int e = 0; e < 4; ++e) { unsigned short h4[4];
#pragma unroll
        for (int jj = 0; jj < 4; ++jj) { const unsigned wd = vw[jj][e >> 1]; h4[jj] = (unsigned short)((e & 1) ? (wd >> 16) : (wd & 0xffffu)); }
        uint2 w;
        if (dir) { w.x = (unsigned)h4[3] | ((unsigned)h4[2] << 16); w.y = (unsigned)h4[1] | ((unsigned)h4[0] << 16); }
        else { w.x = (unsigned)h4[0] | ((unsigned)h4[1] << 16); w.y = (unsigned)h4[2] | ((unsigned)h4[3] << 16); }
        *(uint2*)(vt_lds + (4 * veg + e) * SSTRB + lb * 2) = w; }
    }
    __syncthreads();
    {
      const int lblk = wid >> 1;
#pragma unroll
      for (int u2 = 0; u2 < 2; ++u2) {
        const int sblk = 2 * (wid & 1) + u2;
        if (sblk <= lblk) {
          f32x4 acc = {0.f, 0.f, 0.f, 0.f};
#pragma unroll
          for (int ks = 0; ks < 4; ++ks) {
            const bf16x8 ka = *(const bf16x8*)(k_lds + (sblk * 16 + lr) * QSTRB + (ks * 32 + 8 * kg) * 2);
            const bf16x8 qb = *(const bf16x8*)(q_lds + (lblk * 16 + lr) * QSTRB + (ks * 32 + 8 * kg) * 2);
            acc = mfma16(ka, qb, acc);
          }
          const int l = lblk * 16 + lr; const float blv = bl[l];
          float v4[4]; float sum = 0.f;
#pragma unroll
          for (int r = 0; r < 4; ++r) { const int sidx = sblk * 16 + 4 * kg + r; const float w = (sidx <= l) ? expf(blv - bsp[sidx]) : 0.f; v4[r] = acc[r] * w; sum += v4[r]; }
          uint2 w; w.x = pk2(v4[0], v4[1]); w.y = pk2(v4[2], v4[3]);
          *(uint2*)(s_lds + l * SSTRB + (sblk * 16 + 4 * kg) * 2) = w;
          sum += __shfl_xor(sum, 16); sum += __shfl_xor(sum, 32);
          if (kg == 0) rs[sblk * 64 + l] = sum;
        } else if ((lblk == 0 && sblk == 1) || (lblk == 2 && sblk == 3)) {
          *(uint2*)(s_lds + (lblk * 16 + lr) * SSTRB + (sblk * 16 + 4 * kg) * 2) = make_uint2(0u, 0u);
        }
      }
      { const int l = tid >> 3, part = tid & 7; float a = 0.f;
        const unsigned* qp = (const unsigned*)(q_lds + l * QSTRB + part * 32);
#pragma unroll
        for (int i = 0; i < 8; ++i) { const unsigned wd = qp[i]; a += __uint_as_float(wd << 16) * nvec[part * 16 + 2 * i] + __uint_as_float(wd & 0xffff0000u) * nvec[part * 16 + 2 * i + 1]; }
        a += __shfl_xor(a, 1); a += __shfl_xor(a, 2); a += __shfl_xor(a, 4);
        if (part == 0) qn[l] = a; }
    }
    __syncthreads();
    {
      const int lblk = wid >> 1;
      float arow[4], dinv[4];
#pragma unroll
      for (int r = 0; r < 4; ++r) { const int l = lblk * 16 + 4 * kg + r; float d = av[l] * qn[l];
        for (int sb = 0; sb <= lblk; ++sb) d += rs[sb * 64 + l];
        arow[r] = av[l]; dinv[r] = 1.f / fmaxf(fabsf(d), 1.f); }
      bf16x8 qa[4];
#pragma unroll
      for (int ks = 0; ks < 4; ++ks) qa[ks] = *(const bf16x8*)(q_lds + (lblk * 16 + lr) * QSTRB + (ks * 32 + 8 * kg) * 2);
      const bf16x8 sa0 = *(const bf16x8*)(s_lds + (lblk * 16 + lr) * SSTRB + (8 * kg) * 2);
      bf16x8 sa1 = sa0; if (lblk >= 2) sa1 = *(const bf16x8*)(s_lds + (lblk * 16 + lr) * SSTRB + (32 + 8 * kg) * 2);
#pragma unroll
      for (int u2 = 0; u2 < 2; ++u2) {
        const int eblk = 2 * (wid & 1) + u2;
        f32x4 acc1 = {0.f, 0.f, 0.f, 0.f}, acc2 = {0.f, 0.f, 0.f, 0.f};
#pragma unroll
        for (int ks = 0; ks < 4; ++ks) { const bf16x8 cb = *(const bf16x8*)(ct_cur + (eblk * 16 + lr) * QSTRB + (ks * 32 + 8 * kg) * 2); acc1 = mfma16(qa[ks], cb, acc1); }
        { const bf16x8 vb = *(const bf16x8*)(vt_lds + (eblk * 16 + lr) * SSTRB + (8 * kg) * 2); acc2 = mfma16(sa0, vb, acc2); }
        if (lblk >= 2) { const bf16x8 vb = *(const bf16x8*)(vt_lds + (eblk * 16 + lr) * SSTRB + (32 + 8 * kg) * 2); acc2 = mfma16(sa1, vb, acc2); }
#pragma unroll
        for (int r = 0; r < 4; ++r) { const int l = lblk * 16 + 4 * kg + r; const int t = dir ? (t0 + 63 - l) : (t0 + l);
          const float hv = (arow[r] * acc1[r] + acc2[r]) * dinv[r];
          HM[((size_t)dir * NTOK + rowbase + t) * 1024 + head * 256 + es * 64 + eblk * 16 + lr] = f2bf(hv); }
      }
    }
    {
      const int dblk = wid;
      const bf16x8 ka0 = *(const bf16x8*)(kw_lds + (dblk * 16 + lr) * SSTRB + (8 * kg) * 2), ka1 = *(const bf16x8*)(kw_lds + (dblk * 16 + lr) * SSTRB + (32 + 8 * kg) * 2);
#pragma unroll
      for (int eblk = 0; eblk < 4; ++eblk) {
        const bf16x8 vb0 = *(const bf16x8*)(vt_lds + (eblk * 16 + lr) * SSTRB + (8 * kg) * 2), vb1 = *(const bf16x8*)(vt_lds + (eblk * 16 + lr) * SSTRB + (32 + 8 * kg) * 2);
        f32x4 cc_ = Cacc[eblk] * gamma;
        cc_ = mfma16(ka0, vb0, cc_); cc_ = mfma16(ka1, vb1, cc_);
        Cacc[eblk] = cc_;
        uint2 w; w.x = pk2(cc_[0], cc_[1]); w.y = pk2(cc_[2], cc_[3]);
        *(uint2*)(ct_nxt + (eblk * 16 + lr) * QSTRB + (dblk * 16 + 4 * kg) * 2) = w;
      }
      if (tid < 128) { float a = gamma * nvec[tid]; const unsigned* kp = (const unsigned*)(kw_lds + tid * SSTRB);
#pragma unroll
        for (int i = 0; i < 32; ++i) { const unsigned wd = kp[i]; a += __uint_as_float(wd << 16) + __uint_as_float(wd & 0xffff0000u); }
        nvec[tid] = a; }
    }
    __syncthreads();
  }
}
__device__ __forceinline__ void mlstm_phase(const bf16_t* __restrict__ Pm, const float* __restrict__ GATES, bf16_t* __restrict__ HM, const float* __restrict__ conv_w,
                                            const float* __restrict__ conv_b, const float* __restrict__ i_bias, const float* __restrict__ f_bias, char* lds) {
  const int G = gridDim.x, bx = blockIdx.x; const int vcu = (G % 8 == 0) ? (bx % 8) * (G / 8) + bx / 8 : bx;
  for (int u = vcu; u < 256; u += G) { const int es = u & 3, dir = (u >> 2) & 1, head = (u >> 3) & 3, b = u >> 5; mlstm_unit(Pm, GATES, HM, conv_w, conv_b, i_bias, f_bias, b, head, dir, es, lds); }
}
}

DEVI void mod_unit(int unit, const float* __restrict__ c, const float* __restrict__ c_ctx, const float* __restrict__ w_ada, const float* __restrict__ b_ada, float* __restrict__ MOD, float* ldsf) {
    const int tid = opaque_tid(), ci = tid & 63, kgp = tid >> 6;
    const int l = unit / 96, cb = unit % 96;
    float* sc = ldsf; float* red = ldsf + 9 * DM;
    for (int i = tid; i < 9 * DM; i += 512) { const float v = (i < 8 * DM) ? c[i] : c_ctx[i - 8 * DM]; sc[i] = silu_f(v); }
    __syncthreads();
    float acc[9];
#pragma unroll
    for (int r = 0; r < 9; ++r) acc[r] = 0.f;
    const float* w = w_ada + (size_t)l * DM * MODW + cb * 64 + ci;
#pragma unroll 8
    for (int k = kgp * 256; k < kgp * 256 + 256; ++k) {
        const float wv = w[(size_t)k * MODW];
#pragma unroll
        for (int r = 0; r < 9; ++r) acc[r] += sc[r * DM + k] * wv;
    }
#pragma unroll
    for (int r = 0; r < 9; ++r) red[(kgp * 9 + r) * 64 + ci] = acc[r];
    __syncthreads();
    for (int idx = tid; idx < 9 * 64; idx += 512) {
        const int r = idx >> 6, cc = idx & 63; float s = 0.f;
#pragma unroll
        for (int g = 0; g < 8; ++g) s += red[(g * 9 + r) * 64 + cc];
        MOD[(size_t)(l * 9 + r) * MODW + cb * 64 + cc] = s + b_ada[l * MODW + cb * 64 + cc];
    }
    __syncthreads();
}
DEVI void transpose_items(const float* __restrict__ W, int ldw, int K, int N, bf16_t* __restrict__ WT, float* scr, int gw, int ngw, int lane) {
    const int nitems = (K / 64) * (N / 32);
    for (int it = gw; it < nitems; it += ngw) transpose_item(W, ldw, K, N, WT, scr, it, lane);
}
DEVI void finish_row(const bf16_t* __restrict__ P, const bf16_t* __restrict__ HM, const float* __restrict__ mnorm, bf16_t* __restrict__ Y, int row, int lane) {
#pragma unroll
    for (int head = 0; head < 4; ++head) {
        const int col = head * 256 + 4 * lane;
        const uint2 a = *(const uint2*)(HM + (size_t)row * 1024 + col), c = *(const uint2*)(HM + ((size_t)NTOK + row) * 1024 + col);
        float h[4];
        h[0] = __uint_as_float(a.x << 16) + __uint_as_float(c.x << 16); h[1] = __uint_as_float(a.x & 0xffff0000u) + __uint_as_float(c.x & 0xffff0000u);
        h[2] = __uint_as_float(a.y << 16) + __uint_as_float(c.y << 16); h[3] = __uint_as_float(a.y & 0xffff0000u) + __uint_as_float(c.y & 0xffff0000u);
        const float ss = wave_sum(h[0] * h[0] + h[1] * h[1] + h[2] * h[2] + h[3] * h[3]);
        const float r = rsqrtf(ss * (1.f / 256.f) + EPS);
        const uint2 ov = *(const uint2*)(P + (size_t)row * NP + C_OB + col), gv = *(const uint2*)(P + (size_t)row * NP + C_GB + col);
        const float o[4] = {__uint_as_float(ov.x << 16), __uint_as_float(ov.x & 0xffff0000u), __uint_as_float(ov.y << 16), __uint_as_float(ov.y & 0xffff0000u)};
        const float g[4] = {__uint_as_float(gv.x << 16), __uint_as_float(gv.x & 0xffff0000u), __uint_as_float(gv.y << 16), __uint_as_float(gv.y & 0xffff0000u)};
        const float4 w = *(const float4*)(mnorm + col);
        const float wv[4] = {w.x, w.y, w.z, w.w};
        float y[4];
#pragma unroll
        for (int e = 0; e < 4; ++e) y[e] = h[e] * r * wv[e] * sigmoid_f(o[e]) * silu_f(g[e]);
        uint2 out; out.x = pk2(y[0], y[1]); out.y = pk2(y[2], y[3]);
        *(uint2*)(Y + (size_t)row * DM + 1024 + col) = out;
    }
}
DEVI void load_row(const float* __restrict__ xr, float4 (&v)[8], int lane) {
#pragma unroll
    for (int j = 0; j < 8; ++j) v[j] = ((const float4*)xr)[lane + 64 * j];
}
DEVI void post_regs(float4 (&v)[8], const bf16_t* __restrict__ y2row, const float* __restrict__ gate, const float* __restrict__ npost, float* __restrict__ orow, int lane) {
    uint2 yv[8]; float ss = 0.f;
#pragma unroll
    for (int j = 0; j < 8; ++j) {
        yv[j] = *(const uint2*)(y2row + 4 * (lane + 64 * j));
        const float y0 = __uint_as_float(yv[j].x << 16), y1 = __uint_as_float(yv[j].x & 0xffff0000u), y2 = __uint_as_float(yv[j].y << 16), y3 = __uint_as_float(yv[j].y & 0xffff0000u);
        ss += y0 * y0 + y1 * y1 + y2 * y2 + y3 * y3;
    }
    ss = wave_sum(ss);
    const float rstd = rsqrtf(ss * (1.f / DM) + EPS);
#pragma unroll
    for (int j = 0; j < 8; ++j) {
        const int k0 = 4 * (lane + 64 * j);
        const float4 gt = *(const float4*)(gate + k0), w = *(const float4*)(npost + k0);
        const float y0 = __uint_as_float(yv[j].x << 16), y1 = __uint_as_float(yv[j].x & 0xffff0000u), y2 = __uint_as_float(yv[j].y << 16), y3 = __uint_as_float(yv[j].y & 0xffff0000u);
        v[j].x += gt.x * (y0 * rstd * w.x); v[j].y += gt.y * (y1 * rstd * w.y); v[j].z += gt.z * (y2 * rstd * w.z); v[j].w += gt.w * (y3 * rstd * w.w);
        *(float4*)(orow + k0) = v[j];
        asm volatile("" ::: "memory");
    }
}
DEVI void norm_regs(const float4 (&v)[8], const float* __restrict__ shift, const float* __restrict__ scale, const float* __restrict__ npre, bf16_t* __restrict__ hrow, char* trow, int lane) {
    float ss = 0.f;
#pragma unroll
    for (int j = 0; j < 8; ++j) ss += v[j].x * v[j].x + v[j].y * v[j].y + v[j].z * v[j].z + v[j].w * v[j].w;
    ss = wave_sum(ss);
    const float rstd = rsqrtf(ss * (1.f / DM) + EPS);
#pragma unroll
    for (int j = 0; j < 8; ++j) {
        const int k0 = 4 * (lane + 64 * j);
        const float4 w = *(const float4*)(npre + k0), sh = *(const float4*)(shift + k0), sc = *(const float4*)(scale + k0);
        uint2 o;
        o.x = pk2(v[j].x * rstd * w.x * (1.f + sc.x) + sh.x, v[j].y * rstd * w.y * (1.f + sc.y) + sh.y);
        o.y = pk2(v[j].z * rstd * w.z * (1.f + sc.z) + sh.z, v[j].w * rstd * w.w * (1.f + sc.w) + sh.w);
        *(uint2*)(hrow + k0) = o; *(uint2*)(trow + k0 * 2) = o;
        asm volatile("" ::: "memory");
    }
}
constexpr int NT_ROWB = (DM + 8) * 2;
template <bool POST>
DEVI void norm_phase(const float* __restrict__ xlat, const float* __restrict__ xctx, const bf16_t* __restrict__ Y2, const float* __restrict__ mod_post, const float* __restrict__ npost,
                     float* olat, float* octx, const float* __restrict__ mod_n, const float* __restrict__ npre, const float* __restrict__ wg, bf16_t* __restrict__ H,
                     float* __restrict__ GATES, char* lds) {
    typedef short bf16x8 __attribute__((ext_vector_type(8))); typedef float f32x4 __attribute__((ext_vector_type(4)));
    const int tid = opaque_tid(), lane = tid & 63, wave = tid >> 6, lr = lane & 15, kgp = lane >> 4;
    char* tile = lds; float* red = (float*)(lds + 8 * NT_ROWB);
    bf16x8 bfrag[8];
    {
        const float* wp = wg + (size_t)(wave * 256 + 8 * kgp) * INC + lr;
#pragma unroll
        for (int ks = 0; ks < 8; ++ks) {
            unsigned w4[4];
#pragma unroll
            for (int q = 0; q < 4; ++q) { w4[q] = pk2(wp[0], wp[INC]); wp += 2 * INC; asm volatile("" : "+v"(wp)); }
            wp += (size_t)24 * INC; asm volatile("" : "+v"(wp));
            bfrag[ks] = __builtin_bit_cast(bf16x8, make_uint4(w4[0], w4[1], w4[2], w4[3]));
        }
    }
    for (int grp = blockIdx.x; grp < NTOK / 8; grp += gridDim.x) {
        const int row = grp * 8 + wave; const bool isl = row < NLAT; const int b = isl ? row / SEQ : 8;
        {
            float4 v[8];
            load_row(isl ? xlat + (size_t)row * DM : xctx + (size_t)(row - NLAT) * DM, v, lane);
            if (POST) post_regs(v, Y2 + (size_t)row * DM, mod_post + (size_t)b * MODW + 2 * DM, npost, isl ? olat + (size_t)row * DM : octx + (size_t)(row - NLAT) * DM, lane);
            norm_regs(v, mod_n + (size_t)b * MODW, mod_n + (size_t)b * MODW + DM, npre, H + (size_t)row * DM, tile + wave * NT_ROWB, lane);
        }
        __syncthreads();
        f32x4 acc = {0.f, 0.f, 0.f, 0.f};
#pragma unroll
        for (int ks = 0; ks < 8; ++ks) {
            bf16x8 af = {0, 0, 0, 0, 0, 0, 0, 0};
            if (lr < 8) af = *(const bf16x8*)(tile + lr * NT_ROWB + (wave * 256 + ks * 32 + 8 * kgp) * 2);
            acc = __builtin_amdgcn_mfma_f32_16x16x32_bf16(af, bfrag[ks], acc, 0, 0, 0);
        }
        if (kgp < 2) {
#pragma unroll
            for (int r = 0; r < 4; ++r) red[(wave * 8 + 4 * kgp + r) * 16 + lr] = acc[r];
        }
        __syncthreads();
        if (tid < 128) { const int rr = tid >> 4, cc = tid & 15; float sum = 0.f;
#pragma unroll
            for (int w8 = 0; w8 < 8; ++w8) sum += red[(w8 * 8 + rr) * 16 + cc];
            GATES[(size_t)(grp * 8 + rr) * 16 + cc] = sum; }
    }
    __syncthreads();
}

namespace cg = cooperative_groups;
constexpr int MEGA_LDS = 131072;
struct MegaArgs { const float* in[20]; float* out; unsigned char* ws; };
__global__ __launch_bounds__(512, 2) void mega_fwd(MegaArgs a) {
    extern __shared__ __attribute__((aligned(16))) unsigned char lds[];
    cg::grid_group grid = cg::this_grid();
    const int G = gridDim.x;
#define PHASE_IDS const int tid = opaque_tid(), lane = tid & 63, wave = tid >> 6, gw = blockIdx.x * 8 + wave, ngw = G * 8; (void)tid; (void)lane; (void)gw; (void)ngw; float* scr = (float*)lds + wave * (64 * 33); (void)scr
    const float* x = a.in[0]; const float* c = a.in[1]; const float* ctx = a.in[2]; const float* c_ctx = a.in[3];
    const float* w_ada = a.in[4]; const float* b_ada = a.in[5]; const float* norm_pre = a.in[6]; const float* norm_post = a.in[7];
    const float* w_in = a.in[8]; const float* w_out = a.in[9];
    float* out = a.out; unsigned char* ws = a.ws;
    float* MOD = (float*)(ws + WS_MOD); float* ROPE = (float*)(ws + WS_ROPE); float* GATES = (float*)(ws + WS_GATES);
    bf16_t* WOUT = (bf16_t*)(ws + WS_WOUT); bf16_t* WIN = (bf16_t*)(ws + WS_WIN); float* XC = (float*)(ws + WS_XC);
    bf16_t* H = (bf16_t*)(ws + WS_H); bf16_t* HM = (bf16_t*)(ws + WS_HM); bf16_t* P = (bf16_t*)(ws + WS_P);
    bf16_t* Y = H; bf16_t* Y2 = HM;

    { PHASE_IDS;
    for (int u = blockIdx.x; u < 192; u += G) mod_unit(u, c, c_ctx, w_ada, b_ada, MOD, (float*)lds);
    for (int i = blockIdx.x * 512 + tid; i < 1024; i += G * 512) { const int pos = i >> 4, f = i & 15; const float inv = powf(10000.f, -(float)f / 16.f); const float ang = (float)pos * inv;
        ROPE[2 * i] = cosf(ang); ROPE[2 * i + 1] = sinf(ang); }
    transpose_items(w_in, INC, DM, NP, WIN, scr, gw, ngw, lane);
    transpose_items(w_out, DM, DM, DM, WOUT, scr, gw, ngw, lane);
    transpose_items(w_out + (size_t)DM * DM, DM, DM, DM, WOUT + (size_t)DM * DM, scr, gw, ngw, lane); }
    grid.sync();
    norm_phase<false>(x, ctx, nullptr, nullptr, nullptr, nullptr, nullptr, MOD, norm_pre, w_in + NP, H, GATES, (char*)lds);
    grid.sync();
    for (int l = 0; l < 2; ++l) {
        const float lam_init = l == 0 ? 0.2f : 0.35550906759f;
        const float* mod_l = MOD + (size_t)l * 9 * MODW;
        { pg8::Gemm g{H, WIN, NTOK, NP, DM}; pg8::StaticOrder S; S.init(NTOK, NP, G, (int)blockIdx.x); pg8::EpiInProj E{P, NP, ROPE};
          pg8::gemm_phase<pg8::EpiInProj, pg8::StaticOrder, true, true>((PG8_LAS unsigned char*)lds, g, S, E); }
        grid.sync();
        mls::mlstm_phase(P, GATES, HM, a.in[15] + (size_t)l * 3 * 1024, a.in[16] + l * 1024, a.in[17] + l * 8, a.in[18] + l * 8, (char*)lds);
        att::attn_phase(P, Y, a.in[10] + l * 64, a.in[11] + l * 64, a.in[12] + l * 64, a.in[13] + l * 64, a.in[14] + l * 128, lam_init, l == 0, (char*)lds);
        grid.sync();
        { PHASE_IDS; const int nrows = l == 0 ? NTOK : NLAT; for (int row = gw; row < nrows; row += ngw) finish_row(P, HM, a.in[19] + l * 1024, Y, row, lane); }
        grid.sync();
        { const int M = l == 0 ? NTOK : NLAT; pg8::Gemm g{Y, WOUT + (size_t)l * DM * DM, M, DM, DM}; pg8::StaticOrder S; S.init(M, DM, G, (int)blockIdx.x); pg8::EpiBf16 E{Y2, DM};
          pg8::gemm_phase<pg8::EpiBf16, pg8::StaticOrder, true, true>((PG8_LAS unsigned char*)lds, g, S, E); }
        if (l == 0) { PHASE_IDS;
            const int nbusy = (NTOK / 256) * (DM / 256) - 2 * G;
            if (nbusy >= 0 && nbusy < G) { if ((int)blockIdx.x >= nbusy) transpose_items(w_in + (size_t)DM * INC, INC, DM, NP, WIN, scr, ((int)blockIdx.x - nbusy) * 8 + wave, (G - nbusy) * 8, lane); }
            else transpose_items(w_in + (size_t)DM * INC, INC, DM, NP, WIN, scr, gw, ngw, lane);
        }
        grid.sync();
        if (l == 0) {
            norm_phase<true>(x, ctx, Y2, mod_l, norm_post, out, XC, MOD + (size_t)9 * MODW, norm_pre + DM, w_in + (size_t)DM * INC + NP, H, GATES, (char*)lds);
            grid.sync();
        } else { PHASE_IDS;
            for (int row = gw; row < NLAT; row += ngw) {
                float4 v[8];
                load_row(out + (size_t)row * DM, v, lane);
                post_regs(v, Y2 + (size_t)row * DM, mod_l + (size_t)(row / SEQ) * MODW + 2 * DM, norm_post + DM, out + (size_t)row * DM, lane);
            }
        }
    }
}

extern "C" void kernel_launch(void* const* d_in, const int* in_sizes, int n_in, void* d_out, int out_size, void* d_ws, size_t ws_size, hipStream_t stream) {
    (void)in_sizes; (void)n_in; (void)out_size; (void)ws_size;
    static int grid_blocks = 0;
    if (!grid_blocks) {
        int dev = 0, cus = 0, per_cu = 0;
        (void)hipGetDevice(&dev);
        (void)hipDeviceGetAttribute(&cus, hipDeviceAttributeMultiprocessorCount, dev);
        (void)hipFuncSetAttribute((const void*)mega_fwd, hipFuncAttributeMaxDynamicSharedMemorySize, MEGA_LDS);
        (void)hipOccupancyMaxActiveBlocksPerMultiprocessor(&per_cu, (const void*)mega_fwd, 512, MEGA_LDS);
        if (per_cu < 1) per_cu = 1;
        if (per_cu > 1) per_cu = 1;
        grid_blocks = cus * per_cu;
    }
    MegaArgs a{};
    for (int i = 0; i < 20; ++i) a.in[i] = (const float*)d_in[i];
    a.out = (float*)d_out; a.ws = (unsigned char*)d_ws;
    void* args[] = {&a};
    (void)hipLaunchCooperativeKernel((const void*)mega_fwd, dim3(grid_blocks), dim3(512), args, (size_t)MEGA_LDS, stream);
}
```

```cpp
#include <hip/hip_runtime.h>
#include <hip/hip_cooperative_groups.h>
#include <stdint.h>
#include <math.h>

#define DEVI __device__ __forceinline__
typedef unsigned short bf16_t;

constexpr int DM = 2048, NBATCH = 8, SEQ = 2048, CTXL = 256;
constexpr int NLAT = NBATCH * SEQ, NCTX = NBATCH * CTXL, NTOK = NLAT + NCTX;
constexpr int INC = 8208, NP = 8192, MODW = 6144;
constexpr int C_QA = 0, C_KA = 1024, C_VA = 2048, C_GA = 3072, C_QB = 4096, C_KB = 4608, C_VB = 5120, C_OB = 6144, C_GB = 7168;
constexpr float EPS = 1e-6f;

constexpr size_t MiB = (size_t)1 << 20;
constexpr size_t WS_CTL = 0, WS_MOD = 1 * MiB, WS_SC = WS_MOD + 512 * 1024, WS_ROPE = 2 * MiB, WS_GATES = 3 * MiB, WS_WOUT = 8 * MiB,
                 WS_WIN = 24 * MiB, WS_XC = 56 * MiB, WS_H = 72 * MiB, WS_HM = 144 * MiB, WS_P = 216 * MiB, WS_END = 504 * MiB;

DEVI int opaque_tid() { int t = threadIdx.x; asm volatile("" : "+v"(t)); return t; }
DEVI float bf2f(bf16_t v) { return __uint_as_float(((unsigned)v) << 16); }
DEVI bf16_t f2bf(float f) { unsigned u = __float_as_uint(f); return (bf16_t)((u + 0x7fffu + ((u >> 16) & 1u)) >> 16); }
DEVI unsigned pk2(float lo, float hi) { return (unsigned)f2bf(lo) | ((unsigned)f2bf(hi) << 16); }
DEVI float wave_sum(float v) {
#pragma unroll
    for (int o = 32; o > 0; o >>= 1) v += __shfl_xor(v, o);
    return v;
}
DEVI float wave_max(float v) {
#pragma unroll
    for (int o = 32; o > 0; o >>= 1) v = fmaxf(v, __shfl_xor(v, o));
    return v;
}
DEVI float silu_f(float x) { return x / (1.f + expf(-x)); }
DEVI float sigmoid_f(float x) { return 1.f / (1.f + expf(-x)); }


DEVI void transpose_item(const float* __restrict__ W, int ldw, int K, int N, bf16_t* __restrict__ WT, float* scr, int item, int lane) {
    const int nblk = N / 32, kb = item / nblk, nb = item % nblk, k0 = 64 * kb, n0 = 32 * nb;
#pragma unroll 8
    for (int i = 0; i < 32; ++i) { const int kk = 2 * i + (lane >> 5); scr[kk * 33 + (lane & 31)] = W[(size_t)(k0 + kk) * ldw + n0 + (lane & 31)]; }
    asm volatile("s_waitcnt lgkmcnt(0)" ::: "memory");
    const int c = lane & 7;
#pragma unroll
    for (int j = 0; j < 4; ++j) {
        const int n = (lane >> 3) + 8 * j; const float* s = scr + (8 * c) * 33 + n;
        uint4 o; o.x = pk2(s[0 * 33], s[1 * 33]); o.y = pk2(s[2 * 33], s[3 * 33]); o.z = pk2(s[4 * 33], s[5 * 33]); o.w = pk2(s[6 * 33], s[7 * 33]);
        *(uint4*)(WT + (size_t)(n0 + n) * K + k0 + 8 * c) = o;
    }
    asm volatile("s_waitcnt lgkmcnt(0)" ::: "memory");
}

namespace pg8 {
#define PG8_LAS __attribute__((address_space(3)))
typedef unsigned short bf16_t;
typedef short bf16x8 __attribute__((ext_vector_type(8)));
typedef float f32x4 __attribute__((ext_vector_type(4)));
typedef unsigned u32x4 __attribute__((ext_vector_type(4)));
constexpr int BM = 256, BK = 64, HALF = 128, HTB = HALF * BK * 2  , STAGE_BYTES = 8 * HTB, NXCD = 8, WGM = 8;

__host__ __device__ __forceinline__ int lds_byte(int r, int c) { const int st = (r >> 4) * 2 + (c >> 5), rr = r & 15, cc = c & 31, ob = rr * 64 + cc * 2; return st * 1024 + (ob ^ (((ob >> 9) & 1) << 5)); }
__host__ __device__ __forceinline__ void stage_rc(int b, int& R, int& C) { const int st = b / 1024, sb = b % 1024, swz = sb ^ (((sb >> 9) & 1) << 5); R = (st >> 1) * 16 + swz / 64; C = (st & 1) * 32 + (swz % 64) / 2; }
__host__ __device__ __forceinline__ int perm32(int rho) { const int n = rho >> 4, i = rho & 15; return 8 * (i >> 2) + 4 * n + (i & 3); }

struct Unit { int pm, pn; };
struct Gemm { const bf16_t* A; const bf16_t* Bt; int M, N, K; };

struct StaticOrder {
    int nM, nN, nwg, G, c;
    __host__ __device__ void init(int M, int N, int G_, int c_) { nM = M / BM; nN = N / BM; nwg = nM * nN; G = G_; c = c_; }
    __host__ __device__ bool next(int i, Unit& u) const {
        const long L = (long)i * G + c; if (L >= nwg) return false;
        int wgid = (int)L; { const int q = nwg / NXCD, r = nwg % NXCD, xcd = wgid % NXCD, off = wgid / NXCD; wgid = (xcd < r ? xcd * (q + 1) : r * (q + 1) + (xcd - r) * q) + off; }
        const int nig = WGM * nN, gid = wgid / nig, fm = gid * WGM, gsz = (nM - fm) < WGM ? (nM - fm) : WGM;
        u.pm = fm + ((wgid % nig) % gsz); u.pn = (wgid % nig) / gsz; return true;
    }
    __device__ __forceinline__ void a_ready(const Unit&) const {}
    __device__ __forceinline__ void done(const Unit&) const {}
};

__device__ __forceinline__ unsigned cvt_pk_bf16(float lo, float hi) { unsigned r; asm volatile("v_cvt_pk_bf16_f32 %0, %1, %2" : "=v"(r) : "v"(lo), "v"(hi)); return r; }

struct EpiBf16 {
    static constexpr bool PERM = true, AFTER_DRAIN = false;
    bf16_t* O; int ldc;
    __device__ __forceinline__ void operator()(const f32x4 (&acc)[2][2][4][2], const Unit& u, int wr, int wc, int fr, int fq) const {
        const int row0 = u.pm * BM + wr * 64 + fr, col0 = u.pn * BM + wc * 32 + 8 * fq;
#pragma unroll
        for (int ai = 0; ai < 2; ++ai)
#pragma unroll
            for (int m = 0; m < 4; ++m) { bf16_t* rowp = O + (size_t)(row0 + ai * HALF + m * 16) * ldc + col0;
#pragma unroll
                for (int bj = 0; bj < 2; ++bj) { const f32x4 v0 = acc[ai][bj][m][0], v1 = acc[ai][bj][m][1];
                    u32x4 w; w.x = cvt_pk_bf16(v0[0], v0[1]); w.y = cvt_pk_bf16(v0[2], v0[3]); w.z = cvt_pk_bf16(v1[0], v1[1]); w.w = cvt_pk_bf16(v1[2], v1[3]);
                    *(u32x4*)(rowp + bj * HALF) = w; } }
    }
};
struct EpiInProj {
    static constexpr bool PERM = true, AFTER_DRAIN = false;
    bf16_t* O; int ldc; const float* rope;
    __device__ __forceinline__ void operator()(const f32x4 (&acc)[2][2][4][2], const Unit& u, int wr, int wc, int fr, int fq) const {
        const int row0 = u.pm * BM + wr * 64 + fr, col0 = u.pn * BM + wc * 32 + 8 * fq;
        const bool do_rope = (u.pn < 8) && (u.pm < 64);
#pragma unroll
        for (int ai = 0; ai < 2; ++ai)
#pragma unroll
            for (int m = 0; m < 4; ++m) { const int row = row0 + ai * HALF + m * 16; bf16_t* rowp = O + (size_t)row * ldc + col0;
                f32x4 cs01 = {1.f, 0.f, 1.f, 0.f}, cs23 = {1.f, 0.f, 1.f, 0.f};
                if (do_rope) { const int pos = (wc & 1) ? (row & 63) : ((row >> 6) & 31); const f32x4* rp = (const f32x4*)(rope + (size_t)(pos * 16 + 4 * fq) * 2); cs01 = rp[0]; cs23 = rp[1]; }
#pragma unroll
                for (int bj = 0; bj < 2; ++bj) { f32x4 v0 = acc[ai][bj][m][0], v1 = acc[ai][bj][m][1];
                    if (do_rope) {
                        const float a0 = v0[0] * cs01[0] - v0[1] * cs01[1], a1 = v0[0] * cs01[1] + v0[1] * cs01[0];
                        const float a2 = v0[2] * cs01[2] - v0[3] * cs01[3], a3 = v0[2] * cs01[3] + v0[3] * cs01[2];
                        const float b0 = v1[0] * cs23[0] - v1[1] * cs23[1], b1 = v1[0] * cs23[1] + v1[1] * cs23[0];
                        const float b2 = v1[2] * cs23[2] - v1[3] * cs23[3], b3 = v1[2] * cs23[3] + v1[3] * cs23[2];
                        v0 = (f32x4){a0, a1, a2, a3}; v1 = (f32x4){b0, b1, b2, b3};
                    }
                    u32x4 w; w.x = cvt_pk_bf16(v0[0], v0[1]); w.y = cvt_pk_bf16(v0[2], v0[3]); w.z = cvt_pk_bf16(v1[0], v1[1]); w.w = cvt_pk_bf16(v1[2], v1[3]);
                    *(u32x4*)(rowp + bj * HALF) = w; } }
    }
};

template <class Epi, class Sched, bool ALIGN_EPI = false, bool SP2 = false>
__device__ __forceinline__ void gemm_phase(PG8_LAS unsigned char* lds, const Gemm g, const Sched& S, const Epi& E) {
    const int tid = opaque_tid(), wid = __builtin_amdgcn_readfirstlane(tid >> 6), lane = tid & 63, wr = wid >> 2, wc = wid & 3, fr = lane & 15, fq = lane >> 4;
    const int K = g.K, nt = K / BK;
    unsigned voffA[2], voffB[2];
#pragma unroll
    for (int i = 0; i < 2; ++i) { int R, C; stage_rc(tid * 16 + i * 8192, R, C); const int Rb = Epi::PERM ? ((R & ~31) + perm32(R & 31)) : R;
        voffA[i] = (unsigned)(R * K + C) * 2u; voffB[i] = (unsigned)(Rb * K + C) * 2u; }
    const size_t kstep = (size_t)(BK * 2);
    const size_t hstep = (size_t)HALF * K * 2;
    const size_t tstep = 2 * hstep;
    const unsigned ldsw = (unsigned)wid * 1024u;
    const int aoff = lds_byte(wr * 64 + fr, fq * 8), boff = lds_byte(wc * 32 + fr, fq * 8);
#define PG8_SA(b, h) (((b) * 2 + (h)) * HTB)
#define PG8_SB(b, h) ((4 + (b) * 2 + (h)) * HTB)
#define PG8_STAGE(bufoff, gbase, voff) do { _Pragma("unroll") for (int _i = 0; _i < 2; ++_i) \
        __builtin_amdgcn_global_load_lds((const unsigned*)((const char*)(gbase) + (voff)[_i]), (PG8_LAS unsigned*)(lds + (bufoff) + ldsw + _i * 8192), 16, 0, 0); } while (0)
#define PG8_LDA(dst, b, h) do { _Pragma("unroll") for (int m = 0; m < 4; ++m) _Pragma("unroll") for (int k = 0; k < 2; ++k) dst[m][k] = *(const PG8_LAS bf16x8*)(lds + PG8_SA(b, h) + aoff + m * 2048 + k * 1024); } while (0)
#define PG8_LDB(dst, b, h) do { _Pragma("unroll") for (int n = 0; n < 2; ++n) _Pragma("unroll") for (int k = 0; k < 2; ++k) dst[n][k] = *(const PG8_LAS bf16x8*)(lds + PG8_SB(b, h) + boff + n * 2048 + k * 1024); } while (0)
#define PG8_MMA(ai, bj, At, Bt) do { __builtin_amdgcn_s_setprio(1); _Pragma("unroll") for (int m = 0; m < 4; ++m) _Pragma("unroll") for (int n = 0; n < 2; ++n) _Pragma("unroll") for (int k = 0; k < 2; ++k) \
        acc[ai][bj][m][n] = __builtin_amdgcn_mfma_f32_16x16x32_bf16(Bt[n][k], At[m][k], acc[ai][bj][m][n], 0, 0, 0); __builtin_amdgcn_s_setprio(0); } while (0)
#define PG8_WAIT_V(n) asm volatile("s_waitcnt vmcnt(" #n ")" ::: "memory")
#define PG8_WAIT_L(n) asm volatile("s_waitcnt lgkmcnt(" #n ")" ::: "memory")
#define PG8_BAR __builtin_amdgcn_s_barrier()
#define PG8_SCHED __builtin_amdgcn_sched_barrier(0)
    Unit cur, nxt; int ui = 0;
    if (!S.next(0, cur)) return;
    f32x4 acc[2][2][4][2];
#pragma unroll
    for (int a = 0; a < 2; ++a)
#pragma unroll
        for (int b = 0; b < 2; ++b)
#pragma unroll
            for (int m = 0; m < 4; ++m)
#pragma unroll
                for (int n = 0; n < 2; ++n) acc[a][b][m][n] = (f32x4){0.f, 0.f, 0.f, 0.f};
    bf16x8 At[4][2], B0[2][2], B1[2][2];
    const char* cA = (const char*)g.A + (size_t)cur.pm * tstep; const char* cB = (const char*)g.Bt + (size_t)cur.pn * tstep;
    S.a_ready(cur);
    if constexpr (SP2) {
        PG8_STAGE(PG8_SB(0, 0), cB, voffB); PG8_STAGE(PG8_SB(0, 1), cB + hstep, voffB); PG8_STAGE(PG8_SA(0, 0), cA, voffA); PG8_STAGE(PG8_SA(0, 1), cA + hstep, voffA);
        if (wr == 1) PG8_BAR;
        PG8_WAIT_V(2); PG8_BAR;
        PG8_STAGE(PG8_SB(1, 0), cB + kstep, voffB); PG8_STAGE(PG8_SA(1, 0), cA + kstep, voffA); PG8_STAGE(PG8_SB(1, 1), cB + hstep + kstep, voffB);
        PG8_WAIT_V(6); PG8_BAR;
    } else {
        PG8_STAGE(PG8_SB(0, 0), cB, voffB); PG8_STAGE(PG8_SA(0, 0), cA, voffA); PG8_STAGE(PG8_SB(0, 1), cB + hstep, voffB); PG8_STAGE(PG8_SA(0, 1), cA + hstep, voffA);
        if (wr == 1) PG8_BAR;
        PG8_WAIT_V(4); PG8_BAR;
        PG8_STAGE(PG8_SB(1, 0), cB + kstep, voffB); PG8_STAGE(PG8_SA(1, 0), cA + kstep, voffA); PG8_STAGE(PG8_SB(1, 1), cB + hstep + kstep, voffB);
        PG8_WAIT_V(6); PG8_BAR;
    }
    for (;;) {
        const bool has_next = S.next(ui + 1, nxt);
        const char* nA = has_next ? (const char*)g.A + (size_t)nxt.pm * tstep : cA; const char* nB = has_next ? (const char*)g.Bt + (size_t)nxt.pn * tstep : cB;
        for (int t = 0; t < nt; t += 2) {
            const bool last = (t == nt - 2);
            const char* a1 = cA + (size_t)(t + 1) * kstep;
            const char* a2 = last ? nA : cA + (size_t)(t + 2) * kstep; const char* b2 = last ? nB : cB + (size_t)(t + 2) * kstep;
            const char* a3 = a2 + kstep; const char* b3 = b2 + kstep;
            if (last && has_next) S.a_ready(nxt);
            if constexpr (SP2) {
            PG8_LDB(B0, 0, 0); PG8_LDB(B1, 0, 1); PG8_SCHED; PG8_LDA(At, 0, 0); PG8_STAGE(PG8_SA(1, 1), a1 + hstep, voffA);
            PG8_WAIT_V(8); PG8_WAIT_L(0); PG8_BAR; PG8_MMA(0, 0, At, B0); PG8_MMA(0, 1, At, B1); PG8_BAR; PG8_SCHED;
            PG8_LDA(At, 0, 1); PG8_STAGE(PG8_SB(0, 0), b2, voffB); PG8_STAGE(PG8_SB(0, 1), b2 + hstep, voffB); PG8_STAGE(PG8_SA(0, 0), a2, voffA);
            PG8_WAIT_V(8); PG8_WAIT_L(0); PG8_BAR; PG8_MMA(1, 0, At, B0); PG8_MMA(1, 1, At, B1); PG8_BAR; PG8_SCHED;
            PG8_LDB(B0, 1, 0); PG8_LDB(B1, 1, 1); PG8_SCHED; PG8_LDA(At, 1, 0); PG8_STAGE(PG8_SA(0, 1), a2 + hstep, voffA);
            PG8_WAIT_V(8); PG8_WAIT_L(0); PG8_BAR; PG8_MMA(0, 0, At, B0); PG8_MMA(0, 1, At, B1); PG8_BAR; PG8_SCHED;
            PG8_LDA(At, 1, 1); PG8_STAGE(PG8_SB(1, 0), b3, voffB); PG8_STAGE(PG8_SB(1, 1), b3 + hstep, voffB); PG8_STAGE(PG8_SA(1, 0), a3, voffA);
            PG8_WAIT_V(8); PG8_WAIT_L(0); PG8_BAR; PG8_MMA(1, 0, At, B0); PG8_MMA(1, 1, At, B1); PG8_BAR; PG8_SCHED;
            } else {
            PG8_LDB(B0, 0, 0); PG8_SCHED; PG8_LDA(At, 0, 0); PG8_STAGE(PG8_SA(1, 1), a1 + hstep, voffA);
            PG8_WAIT_L(8); PG8_BAR; PG8_WAIT_L(0); PG8_MMA(0, 0, At, B0); PG8_BAR; PG8_SCHED;
            PG8_LDB(B1, 0, 1); PG8_STAGE(PG8_SB(0, 0), b2, voffB);
            PG8_BAR; PG8_WAIT_L(0); PG8_MMA(0, 1, At, B1); PG8_BAR;
            PG8_LDA(At, 0, 1); PG8_STAGE(PG8_SA(0, 0), a2, voffA);
            PG8_BAR; PG8_WAIT_L(0); PG8_MMA(1, 0, At, B0); PG8_BAR; PG8_SCHED;
            PG8_STAGE(PG8_SB(0, 1), b2 + hstep, voffB);
            PG8_WAIT_V(6); PG8_BAR; PG8_MMA(1, 1, At, B1); PG8_BAR;
            PG8_LDB(B0, 1, 0); PG8_SCHED; PG8_LDA(At, 1, 0); PG8_STAGE(PG8_SA(0, 1), a2 + hstep, voffA);
            PG8_WAIT_L(8); PG8_BAR; PG8_WAIT_L(0); PG8_MMA(0, 0, At, B0); PG8_BAR; PG8_SCHED;
            PG8_LDB(B1, 1, 1); PG8_STAGE(PG8_SB(1, 0), b3, voffB);
            PG8_BAR; PG8_WAIT_L(0); PG8_MMA(0, 1, At, B1); PG8_BAR;
            PG8_LDA(At, 1, 1); PG8_STAGE(PG8_SA(1, 0), a3, voffA);
            PG8_BAR; PG8_WAIT_L(0); PG8_MMA(1, 0, At, B0); PG8_BAR; PG8_SCHED;
            PG8_STAGE(PG8_SB(1, 1), b3 + hstep, voffB);
            PG8_WAIT_V(6); PG8_BAR; PG8_MMA(1, 1, At, B1); PG8_BAR;
            }
        }
        if constexpr (ALIGN_EPI) { if (wr == 0) PG8_BAR; }
        if constexpr (!Epi::AFTER_DRAIN) { E(acc, cur, wr, wc, fr, fq); S.done(cur); }
        if (!has_next) break;
#pragma unroll
        for (int a = 0; a < 2; ++a)
#pragma unroll
            for (int b = 0; b < 2; ++b)
#pragma unroll
                for (int m = 0; m < 4; ++m)
#pragma unroll
                    for (int n = 0; n < 2; ++n) acc[a][b][m][n] = (f32x4){0.f, 0.f, 0.f, 0.f};
        cur = nxt; cA = nA; cB = nB; ++ui;
        if constexpr (ALIGN_EPI) { if (wr == 1) PG8_BAR; }
    }
    PG8_WAIT_V(0);
    if constexpr (!ALIGN_EPI) { if (wr == 0) PG8_BAR; }
    PG8_BAR;
    if constexpr (Epi::AFTER_DRAIN) { E.fused(acc, cur, wr, wc, fr, fq, lds, wid, lane); S.done(cur); }
#undef PG8_SA
#undef PG8_SB
#undef PG8_STAGE
#undef PG8_LDA
#undef PG8_LDB
#undef PG8_MMA
#undef PG8_WAIT_V
#undef PG8_WAIT_L
#undef PG8_BAR
#undef PG8_SCHED
}
}

namespace att {
using bf16x8 = __attribute__((ext_vector_type(8))) short;
using s16x4  = __attribute__((ext_vector_type(4))) short;
using f32x16 = __attribute__((ext_vector_type(16))) float;
using u32x4  = __attribute__((ext_vector_type(4))) unsigned;
constexpr int NW = 8, QBLK = 32, KVBLK = 64, QROWS = 128;
constexpr float SCALE = 0.125f, THR = 6.f;
constexpr int SHM_V = KVBLK * 128 * 2, SHM_K = KVBLK * 128 * 2, SHM_ATTN = 2 * SHM_V + 2 * SHM_K + NW * 64 * 4;
#define KSWZ(row, colB) ((row) * 256 + ((colB) ^ (((row) & 7) << 4)))
#define SBAR() __builtin_amdgcn_sched_barrier(0)
__device__ __forceinline__ int crow(int r, int hi) { return (r & 3) + 8 * (r >> 2) + 4 * hi; }
__device__ __forceinline__ unsigned cvtpk(float lo, float hi) { unsigned r; asm volatile("v_cvt_pk_bf16_f32 %0, %1, %2" : "=v"(r) : "v"(lo), "v"(hi)); return r; }
__device__ __forceinline__ void partialSM(f32x16& p0, f32x16& p1, float& m_reg, float& mn, float& alpha) {
  constexpr float C = SCALE * 1.4426950408889634f;
  float pmax = p0[0];
#pragma unroll
  for (int r = 1; r < 16; ++r) pmax = fmaxf(pmax, p0[r]);
#pragma unroll
  for (int r = 0; r < 16; ++r) pmax = fmaxf(pmax, p1[r]);
  { auto rr = __builtin_amdgcn_permlane32_swap(__float_as_uint(pmax), __float_as_uint(pmax), false, false);
    pmax = fmaxf(__uint_as_float(rr[0]), __uint_as_float(rr[1])); }
  if (__builtin_expect(__all(pmax - m_reg <= THR / SCALE), 1)) { mn = m_reg; alpha = 1.f; }
  else { mn = fmaxf(m_reg, pmax); alpha = __builtin_amdgcn_exp2f((m_reg - mn) * C); m_reg = mn; }
  const float mnC = -mn * C;
#pragma unroll
  for (int r = 0; r < 16; ++r) p0[r] = fmaf(p0[r], C, mnC);
#pragma unroll
  for (int r = 0; r < 16; ++r) p1[r] = fmaf(p1[r], C, mnC);
#pragma unroll
  for (int r = 0; r < 16; ++r) p0[r] = __builtin_amdgcn_exp2f(p0[r]);
}
__device__ __forceinline__ void finishSM(f32x16& p0, f32x16& p1, float alpha, float& l_reg, bf16x8& pa0, bf16x8& pa1, bf16x8& pa2, bf16x8& pa3) {
#pragma unroll
  for (int r = 0; r < 16; ++r) p1[r] = __builtin_amdgcn_exp2f(p1[r]);
  float ps = 0;
#pragma unroll
  for (int r = 0; r < 16; ++r) ps += p0[r];
#pragma unroll
  for (int r = 0; r < 16; ++r) ps += p1[r];
  { auto rr = __builtin_amdgcn_permlane32_swap(__float_as_uint(ps), __float_as_uint(ps), false, false);
    ps = __uint_as_float(rr[0]) + __uint_as_float(rr[1]); }
  l_reg = l_reg * alpha + ps;
#define PK4(P, BASE, OUT) do { unsigned a0 = cvtpk(P[BASE + 0], P[BASE + 1]), a1 = cvtpk(P[BASE + 2], P[BASE + 3]);   \
    unsigned b0 = cvtpk(P[BASE + 4], P[BASE + 5]), b1 = cvtpk(P[BASE + 6], P[BASE + 7]);                              \
    auto r0 = __builtin_amdgcn_permlane32_swap(a0, b0, false, false); auto r1 = __builtin_amdgcn_permlane32_swap(a1, b1, false, false); \
    u32x4 w = {r0[0], r1[0], r0[1], r1[1]}; OUT = *reinterpret_cast<bf16x8*>(&w); } while (0)
  PK4(p0, 0, pa0); PK4(p0, 8, pa1); PK4(p1, 0, pa2); PK4(p1, 8, pa3);
#undef PK4
}
__device__ __forceinline__ void qkt(f32x16& p0, f32x16& p1, const char* Ks, const bf16x8* qr, int r32, int hi, int sub) {
  p0 = f32x16{}; p1 = f32x16{};
#pragma unroll
  for (int d0 = 0; d0 < 4; ++d0) { const int cb = (sub * 64 + d0 * 16 + hi * 8) * 2;
    const bf16x8 b0 = *reinterpret_cast<const bf16x8*>(Ks + KSWZ(r32, cb));
    const bf16x8 b1 = *reinterpret_cast<const bf16x8*>(Ks + KSWZ(32 + r32, cb));
    p0 = __builtin_amdgcn_mfma_f32_32x32x16_bf16(b0, qr[d0], p0, 0, 0, 0);
    p1 = __builtin_amdgcn_mfma_f32_32x32x16_bf16(b1, qr[d0], p1, 0, 0, 0); }
}
__device__ __forceinline__ int v_st(int k, int c) { const int kk = (k & ~0xC) | ((k & 4) << 1) | ((k & 8) >> 1); return ((kk >> 3) * 4 + (c >> 5)) * 512 + ((kk & 7) * 32 + (c & 31)) * 2; }
__device__ __forceinline__ int v_rd_base(int lane) { return ((lane & 3) << 3) | (((lane >> 2) & 3) << 6) | (((lane >> 4) & 1) << 5) | (((lane >> 5) & 1) << 8); }
constexpr int v_rd_off(int d0, int ks, int half) { return d0 * 512 + ks * 4096 + half * 2048; }
template <int OFF> __device__ __forceinline__ s16x4 tr_read(int vb) {
  s16x4 r; asm volatile("ds_read_b64_tr_b16 %0, %1 offset:%2" : "=&v"(r) : "v"(vb), "i"(OFF) : "memory"); return r;
}
template <int D0> __device__ __forceinline__ void pv_one(f32x16& od, int vb, bf16x8 pa0, bf16x8 pa1, bf16x8 pa2, bf16x8 pa3) {
  const s16x4 l0 = tr_read<v_rd_off(D0, 0, 0)>(vb), h0 = tr_read<v_rd_off(D0, 0, 1)>(vb), l1 = tr_read<v_rd_off(D0, 1, 0)>(vb), h1 = tr_read<v_rd_off(D0, 1, 1)>(vb);
  const s16x4 l2 = tr_read<v_rd_off(D0, 2, 0)>(vb), h2 = tr_read<v_rd_off(D0, 2, 1)>(vb), l3 = tr_read<v_rd_off(D0, 3, 0)>(vb), h3 = tr_read<v_rd_off(D0, 3, 1)>(vb);
  asm volatile("s_waitcnt lgkmcnt(0)" ::: "memory"); SBAR();
#define PK(L, H) (bf16x8){L[0], L[1], L[2], L[3], H[0], H[1], H[2], H[3]}
  od = __builtin_amdgcn_mfma_f32_32x32x16_bf16(pa0, PK(l0, h0), od, 0, 0, 0);
  od = __builtin_amdgcn_mfma_f32_32x32x16_bf16(pa1, PK(l1, h1), od, 0, 0, 0);
  od = __builtin_amdgcn_mfma_f32_32x32x16_bf16(pa2, PK(l2, h2), od, 0, 0, 0);
  od = __builtin_amdgcn_mfma_f32_32x32x16_bf16(pa3, PK(l3, h3), od, 0, 0, 0);
#undef PK
}
__device__ __forceinline__ void pv_d0(f32x16* o, int vb, bf16x8 pa0, bf16x8 pa1, bf16x8 pa2, bf16x8 pa3) {
  pv_one<0>(o[0], vb, pa0, pa1, pa2, pa3); pv_one<1>(o[1], vb, pa0, pa1, pa2, pa3); pv_one<2>(o[2], vb, pa0, pa1, pa2, pa3); pv_one<3>(o[3], vb, pa0, pa1, pa2, pa3);
}
__device__ __forceinline__ long ktile_row(int b, int t) { return t < 4 ? (long)(NLAT + b * CTXL + 64 * t) : (long)(b * SEQ + 64 * (t - 4)); }

__device__ __forceinline__ void attn_unit(const bf16_t* __restrict__ Pm, bf16_t* __restrict__ Y, long qrow0, int b, int hh, int NT, float lam, float lam_init,
                                          const float* __restrict__ subln, char* lds) {
  const int tid = opaque_tid(), wid = tid >> 6, lane = tid & 63, r32 = lane & 31, hi = lane >> 5;
  const int sub = wid & 1, pr = wid >> 1;
  char* V_lds = lds; char* K_lds = lds + 2 * SHM_V;
  float* ws = (float*)(lds + 2 * SHM_V + 2 * SHM_K) + wid * 64; float* li_l = ws; float* al_l = ws + 32;
  float m_reg = -1e30f, l_reg = 0; f32x16 o[4] = {}; bf16x8 qr[4];
  const bf16_t* Qw = Pm + (qrow0 + pr * QBLK + r32) * NP + C_QA + hh * 128 + sub * 64 + hi * 8;
#pragma unroll
  for (int d0 = 0; d0 < 4; ++d0) qr[d0] = *reinterpret_cast<const bf16x8*>(Qw + d0 * 16);
  const int sr = tid >> 4, sc = (tid & 15) * 8, vst0 = v_st(sr, sc), vst1 = v_st(32 + sr, sc);
  const int vb0 = (int)(uintptr_t)V_lds + v_rd_base(lane);
  const bf16_t* Kcol = Pm + C_KA + hh * 128 + sc; const bf16_t* Vcol = Pm + C_VA + hh * 128 + sc;
  struct { bf16x8 vs0, vs1, ks0, ks1; } sr_[2];
#define SLOAD(i, t) do { const long r0_ = ktile_row(b, (t)) + sr; \
    sr_[i].vs0 = *reinterpret_cast<const bf16x8*>(Vcol + r0_ * NP); sr_[i].vs1 = *reinterpret_cast<const bf16x8*>(Vcol + (r0_ + 32) * NP); \
    sr_[i].ks0 = *reinterpret_cast<const bf16x8*>(Kcol + r0_ * NP); sr_[i].ks1 = *reinterpret_cast<const bf16x8*>(Kcol + (r0_ + 32) * NP); } while (0)
#define SWRITE(bb, i) do { *(bf16x8*)(V_lds + (bb) * SHM_V + vst0) = sr_[i].vs0; *(bf16x8*)(V_lds + (bb) * SHM_V + vst1) = sr_[i].vs1; const int kc = sc * 2; \
    *(bf16x8*)(K_lds + (bb) * SHM_K + KSWZ(sr, kc)) = sr_[i].ks0; *(bf16x8*)(K_lds + (bb) * SHM_K + KSWZ(32 + sr, kc)) = sr_[i].ks1; } while (0)
#define SWAIT() asm volatile("s_waitcnt vmcnt(4)" ::: "memory")
#define RESC(a) do { if (__any((a) < 1.f)) { if (hi == 0) al_l[r32] = (a); asm volatile("s_waitcnt lgkmcnt(0)" ::: "memory"); \
    _Pragma("unroll") for (int d = 0; d < 4; ++d) _Pragma("unroll") for (int r = 0; r < 16; ++r) o[d][r] *= al_l[crow(r, hi)]; } } while (0)
  f32x16 pA0, pA1, pB0, pB1; float mnA, mnB, alA, alB; bf16x8 pa0, pa1, pa2, pa3;
  constexpr int SE = 0, SO = 1;
  SLOAD(SE, 0); asm volatile("s_waitcnt vmcnt(0)" ::: "memory"); SWRITE(0, SE); __syncthreads();
  qkt(pA0, pA1, K_lds, qr, r32, hi, sub); partialSM(pA0, pA1, m_reg, mnA, alA);
  SLOAD(SO, 1); if (2 < NT) SLOAD(SE, 2);
  SWAIT(); SWRITE(1, SO); __syncthreads();
  for (int j = 1; j + 1 < NT; j += 2) {
    SBAR(); qkt(pB0, pB1, K_lds + SHM_K, qr, r32, hi, sub);
    finishSM(pA0, pA1, alA, l_reg, pa0, pa1, pa2, pa3); SBAR();
    SLOAD(SO, j + 2); SBAR();
    pv_d0(o, vb0, pa0, pa1, pa2, pa3); partialSM(pB0, pB1, m_reg, mnB, alB);
    __syncthreads(); SWAIT(); SWRITE(0, SE);
    RESC(alB); __syncthreads();
    SBAR(); qkt(pA0, pA1, K_lds, qr, r32, hi, sub);
    finishSM(pB0, pB1, alB, l_reg, pa0, pa1, pa2, pa3); SBAR();
    if (j + 3 < NT) SLOAD(SE, j + 3); SBAR();
    pv_d0(o, vb0 + SHM_V, pa0, pa1, pa2, pa3); partialSM(pA0, pA1, m_reg, mnA, alA);
    __syncthreads(); SWAIT(); SWRITE(1, SO);
    RESC(alA); __syncthreads();
  }
  SBAR(); qkt(pB0, pB1, K_lds + SHM_K, qr, r32, hi, sub);
  finishSM(pA0, pA1, alA, l_reg, pa0, pa1, pa2, pa3); SBAR();
  pv_d0(o, vb0, pa0, pa1, pa2, pa3); partialSM(pB0, pB1, m_reg, mnB, alB);
  __syncthreads(); RESC(alB);
  finishSM(pB0, pB1, alB, l_reg, pa0, pa1, pa2, pa3); SBAR();
  pv_d0(o, vb0 + SHM_V, pa0, pa1, pa2, pa3);
  if (hi == 0) li_l[r32] = l_reg; asm volatile("s_waitcnt lgkmcnt(0)" ::: "memory");
  const float fac = sub ? lam : 1.f;
#pragma unroll
  for (int r = 0; r < 16; ++r) { const float rl = fac * __builtin_amdgcn_rcpf(li_l[crow(r, hi)]);
#pragma unroll
    for (int d0 = 0; d0 < 4; ++d0) o[d0][r] *= rl; }
  __syncthreads();
  float* XB = (float*)lds + pr * 4096;
  if (sub == 1) {
#pragma unroll
    for (int d0 = 0; d0 < 4; ++d0)
#pragma unroll
      for (int r = 0; r < 16; ++r) XB[(d0 * 16 + r) * 64 + lane] = o[d0][r];
  }
  __syncthreads();
  if (sub == 0) {
    float ss[16];
#pragma unroll
    for (int r = 0; r < 16; ++r) { float a = 0.f;
#pragma unroll
      for (int d0 = 0; d0 < 4; ++d0) { o[d0][r] -= XB[(d0 * 16 + r) * 64 + lane]; a += o[d0][r] * o[d0][r]; }
      ss[r] = a; }
#pragma unroll
    for (int r = 0; r < 16; ++r) {
#pragma unroll
      for (int off = 1; off < 32; off <<= 1) ss[r] += __shfl_xor(ss[r], off);
      ss[r] = rsqrtf(ss[r] * (1.f / 128.f) + EPS) * (1.f - lam_init);
    }
    float sw[4];
#pragma unroll
    for (int d0 = 0; d0 < 4; ++d0) sw[d0] = subln[d0 * 32 + r32];
#pragma unroll
    for (int r = 0; r < 16; ++r) { const long row = qrow0 + pr * QBLK + crow(r, hi);
      const bf16_t* gp = Pm + row * NP + C_GA + hh * 128 + r32; bf16_t* yp = Y + row * DM + hh * 128 + r32;
#pragma unroll
      for (int d0 = 0; d0 < 4; ++d0) { const float g = bf2f(gp[d0 * 32]); yp[d0 * 32] = f2bf(o[d0][r] * ss[r] * sw[d0] * (g / (1.f + __expf(-g)))); } }
  }
  __syncthreads();
#undef SLOAD
#undef SWRITE
#undef SWAIT
#undef RESC
}
__device__ __forceinline__ void attn_phase(const bf16_t* __restrict__ Pm, bf16_t* __restrict__ Y, const float* lq1, const float* lk1, const float* lq2, const float* lk2,
                                           const float* __restrict__ subln, float lam_init, bool ctx_out, char* lds) {
  const int lane = opaque_tid() & 63;
  const float lam = expf(wave_sum(lq1[lane] * lk1[lane])) - expf(wave_sum(lq2[lane] * lk2[lane])) + lam_init;
  const int G = gridDim.x, bx = blockIdx.x; const int vcu = (G % 8 == 0) ? (bx % 8) * (G / 8) + bx / 8 : bx;
  const int nunits = 1024 + (ctx_out ? 128 : 0);
  for (int u = vcu; u < nunits; u += G) {
    if (u < 1024) { const int bh = u >> 4, qb = u & 15, b = bh >> 3, hh = bh & 7; attn_unit(Pm, Y, (long)b * SEQ + qb * QROWS, b, hh, 36, lam, lam_init, subln, lds); }
    else { const int v = u - 1024, bh = v >> 1, qb = v & 1, b = bh >> 3, hh = bh & 7; attn_unit(Pm, Y, (long)NLAT + b * CTXL + qb * QROWS, b, hh, 4, lam, lam_init, subln, lds); }
  }
}
#undef KSWZ
#undef SBAR
}

namespace mls {
using bf16x8 = __attribute__((ext_vector_type(8))) short;
using f32x4  = __attribute__((ext_vector_type(4))) float;
constexpr int QSTRB = 272, SSTRB = 144;
constexpr int NPOS = 2304;
constexpr int L_BC = 0, L_IG = L_BC + NPOS * 4, L_Q = L_IG + NPOS * 4, L_K = L_Q + 64 * QSTRB, L_KW = L_K + 64 * QSTRB, L_VT = L_KW + 128 * SSTRB,
              L_S = L_VT + 64 * SSTRB, L_CT = L_S + 64 * SSTRB, L_SM = L_CT + 2 * 64 * QSTRB, L_END = L_SM + 2560;
static_assert(L_END <= 131072 && (L_Q % 16) == 0 && (L_K % 16) == 0 && (L_KW % 16) == 0 && (L_VT % 16) == 0 && (L_S % 16) == 0 && (L_CT % 16) == 0 && (L_SM % 16) == 0, "mlstm LDS map");
__device__ __forceinline__ f32x4 mfma16(bf16x8 a, bf16x8 b, f32x4 c) { return __builtin_amdgcn_mfma_f32_16x16x32_bf16(a, b, c, 0, 0, 0); }
__device__ __forceinline__ float bfw(unsigned w, int odd) { return odd ? __uint_as_float(w & 0xffff0000u) : __uint_as_float(w << 16); }

__device__ __forceinline__ void mlstm_unit(const bf16_t* __restrict__ Pm, const float* __restrict__ GATES, bf16_t* __restrict__ HM, const float* __restrict__ conv_w,
                                           const float* __restrict__ conv_b, const float* __restrict__ i_bias, const float* __restrict__ f_bias,
                                           int b, int head, int dir, int es, char* lds) {
  const int tid = opaque_tid(), wid = tid >> 6, lane = tid & 63, lr = lane & 15, kg = lane >> 4;
  float* Bc = (float*)(lds + L_BC); float* Ig = (float*)(lds + L_IG);
  char* q_lds = lds + L_Q; char* k_lds = lds + L_K; char* kw_lds = lds + L_KW; char* vt_lds = lds + L_VT; char* s_lds = lds + L_S; char* ct_lds = lds + L_CT;
  float* bl = (float*)(lds + L_SM); float* bsp = bl + 64; float* av = bsp + 64; float* rs = av + 64; float* qn = rs + 256; float* nvec = qn + 64;
  for (int p = tid; p < NPOS; p += 512) {
    const int c = p >> 6, l = p & 63; const bool isctx = c < 4; const int T = isctx ? CTXL : SEQ, cc = isctx ? c : c - 4;
    const long rowbase = isctx ? (long)(NLAT + b * CTXL) : (long)b * SEQ;
    const int t = dir ? (T - 1 - 64 * cc - l) : (64 * cc + l);
    const float* gr = GATES + (rowbase + t) * 16;
    const float gi = gr[dir * 4 + head] + i_bias[dir * 4 + head], gf = gr[8 + dir * 4 + head] + f_bias[dir * 4 + head];
    Ig[p] = 15.f * tanhf(gi * (1.f / 15.f));
    const float fc = 15.f * tanhf(gf * (1.f / 15.f));
    Bc[p] = fminf(fc, 0.f) - log1pf(expf(-fabsf(fc)));
  }
  for (int i = tid; i < 64 * QSTRB / 4; i += 512) ((unsigned*)ct_lds)[i] = 0u;
  if (tid < 128) nvec[tid] = 0.f;
  __syncthreads();
  if (wid == 0) {
    float run = 0.f;
    for (int k = 0; k < 36; ++k) { run += Bc[36 * lane + k]; Bc[36 * lane + k] = run; }
    float x = run;
#pragma unroll
    for (int off = 1; off < 64; off <<= 1) { const float y = __shfl_up(x, off); if (lane >= off) x += y; }
    const float offs = x - run;
    for (int k = 0; k < 36; ++k) Bc[36 * lane + k] += offs;
  }
  __syncthreads();
  const int chg = tid & 31, rg = tid >> 5; const bool isk = chg >= 16; const int ch8 = (chg & 15) * 8;
  const int pcol = (isk ? C_KB : C_QB) + head * 128 + ch8, cidx = (isk ? 512 : 0) + head * 128 + ch8;
  float cw0[8], cw1[8], cw2[8], cbv[8];
#pragma unroll
  for (int i = 0; i < 8; ++i) { cw0[i] = conv_w[cidx + i]; cw1[i] = conv_w[1024 + cidx + i]; cw2[i] = conv_w[2048 + cidx + i]; cbv[i] = conv_b[cidx + i]; }
  const int veg = tid & 15, vrg = tid >> 4;
  f32x4 Cacc[4];
#pragma unroll
  for (int e = 0; e < 4; ++e) Cacc[e] = (f32x4){0.f, 0.f, 0.f, 0.f};
  for (int c = 0; c < 36; ++c) {
    const bool isctx = c < 4; const int T = isctx ? CTXL : SEQ, cc = isctx ? c : c - 4;
    const long rowbase = isctx ? (long)(NLAT + b * CTXL) : (long)b * SEQ;
    const int t0 = dir ? (T - 64 * (cc + 1)) : 64 * cc, p0 = 64 * c;
    char* ct_cur = ct_lds + (c & 1) * 64 * QSTRB; char* ct_nxt = ct_lds + ((c + 1) & 1) * 64 * QSTRB;
    uint4 raw[6];
#pragma unroll
    for (int r = 0; r < 6; ++r) { const int t = t0 + 4 * rg - 1 + r; raw[r] = (t >= 0 && t < T) ? *(const uint4*)(Pm + (rowbase + t) * NP + pcol) : make_uint4(0u, 0u, 0u, 0u); }
    uint2 vr[4];
    if (tid < 256) {
#pragma unroll
      for (int jj = 0; jj < 4; ++jj) vr[jj] = *(const uint2*)(Pm + (rowbase + t0 + 4 * vrg + jj) * NP + C_VB + head * 256 + es * 64 + 4 * veg);
    }
    const float Bend = Bc[p0 + 63], Bprev = p0 ? Bc[p0 - 1] : 0.f;
    const float gamma = expf(Bend - Bprev);
    if (tid < 64) { const float blv = Bc[p0 + tid] - Bprev; bl[tid] = blv; bsp[tid] = blv - Ig[p0 + tid]; av[tid] = expf(blv); }
    {
      float kw[4][8];
#pragma unroll
      for (int jj = 0; jj < 4; ++jj) {
        const int l = dir ? 63 - (4 * rg + jj) : 4 * rg + jj;
        const unsigned* x0 = (const unsigned*)&raw[jj]; const unsigned* x1 = (const unsigned*)&raw[jj + 1]; const unsigned* x2 = (const unsigned*)&raw[jj + 2];
        float o[8];
#pragma unroll
        for (int i = 0; i < 8; ++i) { const float z = cbv[i] + cw0[i] * bfw(x0[i >> 1], i & 1) + cw1[i] * bfw(x1[i >> 1], i & 1) + cw2[i] * bfw(x2[i >> 1], i & 1);
          o[i] = z / (1.f + __expf(-z)); }
        if (isk) {
          const float wk = expf(Bend - Bc[p0 + l] + Ig[p0 + l]);
#pragma unroll
          for (int i = 0; i < 8; ++i) { o[i] *= 0.08838834764831845f; kw[jj][i] = o[i] * wk; }
        }
        uint4 w; w.x = pk2(o[0], o[1]); w.y = pk2(o[2], o[3]); w.z = pk2(o[4], o[5]); w.w = pk2(o[6], o[7]);
        *(uint4*)((isk ? k_lds : q_lds) + l * QSTRB + ch8 * 2) = w;
      }
      if (isk) {
        const int lb = dir ? 60 - 4 * rg : 4 * rg;
#pragma unroll
        for (int i = 0; i < 8; ++i) { uint2 w;
          if (dir) { w.x = pk2(kw[3][i], kw[2][i]); w.y = pk2(kw[1][i], kw[0][i]); } else { w.x = pk2(kw[0][i], kw[1][i]); w.y = pk2(kw[2][i], kw[3][i]); }
          *(uint2*)(kw_lds + (ch8 + i) * SSTRB + lb * 2) = w; }
      }
    }
    if (tid < 256) {
      const int lb = dir ? 60 - 4 * vrg : 4 * vrg;
      const unsigned vw[4][2] = {{vr[0].x, vr[0].y}, {vr[1].x, vr[1].y}, {vr[2].x, vr[2].y}, {vr[3].x, vr[3].y}};
#pragma unroll
      for (int e = 0; e < 4; ++e) { unsigned short h4[4];
#pragma unroll
        for (int jj = 0; jj < 4; ++jj) { const unsigned wd = vw[jj][e >> 1]; h4[jj] = (unsigned short)((e & 1) ? (wd >> 16) : (wd & 0xffffu)); }
        uint2 w;
        if (dir) { w.x = (unsigned)h4[3] | ((unsigned)h4[2] << 16); w.y = (unsigned)h4[1] | ((unsigned)h4[0] << 16); }
        else { w.x = (unsigned)h4[0] | ((unsigned)h4[1] << 16); w.y = (unsigned)h4[2] | ((unsigned)h4[3] << 16); }
        *(uint2*)(vt_lds + (4 * veg + e) * SSTRB + lb * 2) = w; }
    }
    __syncthreads();
    {
      const int lblk = wid >> 1;
#pragma unroll
      for (int u2 = 0; u2 < 2; ++u2) {
        const int sblk = 2 * (wid & 1) + u2;
        if (sblk <= lblk) {
          f32x4 acc = {0.f, 0.f, 0.f, 0.f};
#pragma unroll
          for (int ks = 0; ks < 4; ++ks) {
            const bf16x8 ka = *(const bf16x8*)(k_lds + (sblk * 16 + lr) * QSTRB + (ks * 32 + 8 * kg) * 2);
            const bf16x8 qb = *(const bf16x8*)(q_lds + (lblk * 16 + lr) * QSTRB + (ks * 32 + 8 * kg) * 2);
            acc = mfma16(ka, qb, acc);
          }
          const int l = lblk * 16 + lr; const float blv = bl[l];
          float v4[4]; float sum = 0.f;
#pragma unroll
          for (int r = 0; r < 4; ++r) { const int sidx = sblk * 16 + 4 * kg + r; const float w = (sidx <= l) ? expf(blv - bsp[sidx]) : 0.f; v4[r] = acc[r] * w; sum += v4[r]; }
          uint2 w; w.x = pk2(v4[0], v4[1]); w.y = pk2(v4[2], v4[3]);
          *(uint2*)(s_lds + l * SSTRB + (sblk * 16 + 4 * kg) * 2) = w;
          sum += __shfl_xor(sum, 16); sum += __shfl_xor(sum, 32);
          if (kg == 0) rs[sblk * 64 + l] = sum;
        } else if ((lblk == 0 && sblk == 1) || (lblk == 2 && sblk == 3)) {
          *(uint2*)(s_lds + (lblk * 16 + lr) * SSTRB + (sblk * 16 + 4 * kg) * 2) = make_uint2(0u, 0u);
        }
      }
      { const int l = tid >> 3, part = tid & 7; float a = 0.f;
        const unsigned* qp = (const unsigned*)(q_lds + l * QSTRB + part * 32);
#pragma unroll
        for (int i = 0; i < 8; ++i) { const unsigned wd = qp[i]; a += __uint_as_float(wd << 16) * nvec[part * 16 + 2 * i] + __uint_as_float(wd & 0xffff0000u) * nvec[part * 16 + 2 * i + 1]; }
        a += __shfl_xor(a, 1); a += __shfl_xor(a, 2); a += __shfl_xor(a, 4);
        if (part == 0) qn[l] = a; }
    }
    __syncthreads();
    {
      const int lblk = wid >> 1;
      float arow[4], dinv[4];
#pragma unroll
      for (int r = 0; r < 4; ++r) { const int l = lblk * 16 + 4 * kg + r; float d = av[l] * qn[l];
        for (int sb = 0; sb <= lblk; ++sb) d += rs[sb * 64 + l];
        arow[r] = av[l]; dinv[r] = 1.f / fmaxf(fabsf(d), 1.f); }
      bf16x8 qa[4];
#pragma unroll
      for (int ks = 0; ks < 4; ++ks) qa[ks] = *(const bf16x8*)(q_lds + (lblk * 16 + lr) * QSTRB + (ks * 32 + 8 * kg) * 2);
      const bf16x8 sa0 = *(const bf16x8*)(s_lds + (lblk * 16 + lr) * SSTRB + (8 * kg) * 2);
      bf16x8 sa1 = sa0; if (lblk >= 2) sa1 = *(const bf16x8*)(s_lds + (lblk * 16 + lr) * SSTRB + (32 + 8 * kg) * 2);
#pragma unroll
      for (int u2 = 0; u2 < 2; ++u2) {
        const int eblk = 2 * (wid & 1) + u2;
        f32x4 acc1 = {0.f, 0.f, 0.f, 0.f}, acc2 = {0.f, 0.f, 0.f, 0.f};
#pragma unroll
        for (int ks = 0; ks < 4; ++ks) { const bf16x8 cb = *(const bf16x8*)(ct_cur + (eblk * 16 + lr) * QSTRB + (ks * 32 + 8 * kg) * 2); acc1 = mfma16(qa[ks], cb, acc1); }
        { const bf16x8 vb = *(const bf16x8*)(vt_lds + (eblk * 16 + lr) * SSTRB + (8 * kg) * 2); acc2 = mfma16(sa0, vb, acc2); }
        if (lblk >= 2) { const bf16x8 vb = *(const bf16x8*)(vt_lds + (eblk * 16 + lr) * SSTRB + (32 + 8 * kg) * 2); acc2 = mfma16(sa1, vb, acc2); }
#pragma unroll
        for (int r = 0; r < 4; ++r) { const int l = lblk * 16 + 4 * kg + r; const int t = dir ? (t0 + 63 - l) : (t0 + l);
          const float hv = (arow[r] * acc1[r] + acc2[r]) * dinv[r];
          HM[((size_t)dir * NTOK + rowbase + t) * 1024 + head * 256 + es * 64 + eblk * 16 + lr] = f2bf(hv); }
      }
    }
    {
      const int dblk = wid;
      const bf16x8 ka0 = *(const bf16x8*)(kw_lds + (dblk * 16 + lr) * SSTRB + (8 * kg) * 2), ka1 = *(const bf16x8*)(kw_lds + (dblk * 16 + lr) * SSTRB + (32 + 8 * kg) * 2);
#pragma unroll
      for (int eblk = 0; eblk < 4; ++eblk) {
        const bf16x8 vb0 = *(const bf16x8*)(vt_lds + (eblk * 16 + lr) * SSTRB + (8 * kg) * 2), vb1 = *(const bf16x8*)(vt_lds + (eblk * 16 + lr) * SSTRB + (32 + 8 * kg) * 2);
        f32x4 cc_ = Cacc[eblk] * gamma;
        cc_ = mfma16(ka0, vb0, cc_); cc_ = mfma16(ka1, vb1, cc_);
        Cacc[eblk] = cc_;
        uint2 w; w.x = pk2(cc_[0], cc_[1]); w.y = pk2(cc_[2], cc_[3]);
        *(uint2*)(ct_nxt + (eblk * 16 + lr) * QSTRB + (dblk * 16 + 4 * kg) * 2) = w;
      }
      if (tid < 128) { float a = gamma * nvec[tid]; const unsigned* kp = (const unsigned*)(kw_lds + tid * SSTRB);
#pragma unroll
        for (int i = 0; i < 32; ++i) { const unsigned wd = kp[i]; a += __uint_as_float(wd << 16) + __uint_as_float(wd & 0xffff0000u); }
        nvec[tid] = a; }
    }
    __syncthreads();
  }
}
__device__ __forceinline__ void mlstm_phase(const bf16_t* __restrict__ Pm, const float* __restrict__ GATES, bf16_t* __restrict__ HM, const float* __restrict__ conv_w,
                                            const float* __restrict__ conv_b, const float* __restrict__ i_bias, const float* __restrict__ f_bias, char* lds) {
  const int G = gridDim.x, bx = blockIdx.x; const int vcu = (G % 8 == 0) ? (bx % 8) * (G / 8) + bx / 8 : bx;
  for (int u = vcu; u < 256; u += G) { const int es = u & 3, dir = (u >> 2) & 1, head = (u >> 3) & 3, b = u >> 5; mlstm_unit(Pm, GATES, HM, conv_w, conv_b, i_bias, f_bias, b, head, dir, es, lds); }
}
}

DEVI void mod_unit(int unit, const float* __restrict__ c, const float* __restrict__ c_ctx, const float* __restrict__ w_ada, const float* __restrict__ b_ada, float* __restrict__ MOD, float* ldsf) {
    const int tid = opaque_tid(), ci = tid & 63, kgp = tid >> 6;
    const int l = unit / 96, cb = unit % 96;
    float* sc = ldsf; float* red = ldsf + 9 * DM;
    for (int i = tid; i < 9 * DM; i += 512) { const float v = (i < 8 * DM) ? c[i] : c_ctx[i - 8 * DM]; sc[i] = silu_f(v); }
    __syncthreads();
    float acc[9];
#pragma unroll
    for (int r = 0; r < 9; ++r) acc[r] = 0.f;
    const float* w = w_ada + (size_t)l * DM * MODW + cb * 64 + ci;
#pragma unroll 8
    for (int k = kgp * 256; k < kgp * 256 + 256; ++k) {
        const float wv = w[(size_t)k * MODW];
#pragma unroll
        for (int r = 0; r < 9; ++r) acc[r] += sc[r * DM + k] * wv;
    }
#pragma unroll
    for (int r = 0; r < 9; ++r) red[(kgp * 9 + r) * 64 + ci] = acc[r];
    __syncthreads();
    for (int idx = tid; idx < 9 * 64; idx += 512) {
        const int r = idx >> 6, cc = idx & 63; float s = 0.f;
#pragma unroll
        for (int g = 0; g < 8; ++g) s += red[(g * 9 + r) * 64 + cc];
        MOD[(size_t)(l * 9 + r) * MODW + cb * 64 + cc] = s + b_ada[l * MODW + cb * 64 + cc];
    }
    __syncthreads();
}
DEVI void transpose_items(const float* __restrict__ W, int ldw, int K, int N, bf16_t* __restrict__ WT, float* scr, int gw, int ngw, int lane) {
    const int nitems = (K / 64) * (N / 32);
    for (int it = gw; it < nitems; it += ngw) transpose_item(W, ldw, K, N, WT, scr, it, lane);
}
DEVI void finish_row(const bf16_t* __restrict__ P, const bf16_t* __restrict__ HM, const float* __restrict__ mnorm, bf16_t* __restrict__ Y, int row, int lane) {
#pragma unroll
    for (int head = 0; head < 4; ++head) {
        const int col = head * 256 + 4 * lane;
        const uint2 a = *(const uint2*)(HM + (size_t)row * 1024 + col), c = *(const uint2*)(HM + ((size_t)NTOK + row) * 1024 + col);
        float h[4];
        h[0] = __uint_as_float(a.x << 16) + __uint_as_float(c.x << 16); h[1] = __uint_as_float(a.x & 0xffff0000u) + __uint_as_float(c.x & 0xffff0000u);
        h[2] = __uint_as_float(a.y << 16) + __uint_as_float(c.y << 16); h[3] = __uint_as_float(a.y & 0xffff0000u) + __uint_as_float(c.y & 0xffff0000u);
        const float ss = wave_sum(h[0] * h[0] + h[1] * h[1] + h[2] * h[2] + h[3] * h[3]);
        const float r = rsqrtf(ss * (1.f / 256.f) + EPS);
        const uint2 ov = *(const uint2*)(P + (size_t)row * NP + C_OB + col), gv = *(const uint2*)(P + (size_t)row * NP + C_GB + col);
        const float o[4] = {__uint_as_float(ov.x << 16), __uint_as_float(ov.x & 0xffff0000u), __uint_as_float(ov.y << 16), __uint_as_float(ov.y & 0xffff0000u)};
        const float g[4] = {__uint_as_float(gv.x << 16), __uint_as_float(gv.x & 0xffff0000u), __uint_as_float(gv.y << 16), __uint_as_float(gv.y & 0xffff0000u)};
        const float4 w = *(const float4*)(mnorm + col);
        const float wv[4] = {w.x, w.y, w.z, w.w};
        float y[4];
#pragma unroll
        for (int e = 0; e < 4; ++e) y[e] = h[e] * r * wv[e] * sigmoid_f(o[e]) * silu_f(g[e]);
        uint2 out; out.x = pk2(y[0], y[1]); out.y = pk2(y[2], y[3]);
        *(uint2*)(Y + (size_t)row * DM + 1024 + col) = out;
    }
}
DEVI void load_row(const float* __restrict__ xr, float4 (&v)[8], int lane) {
#pragma unroll
    for (int j = 0; j < 8; ++j) v[j] = ((const float4*)xr)[lane + 64 * j];
}
DEVI void post_regs(float4 (&v)[8], const bf16_t* __restrict__ y2row, const float* __restrict__ gate, const float* __restrict__ npost, float* __restrict__ orow, int lane) {
    uint2 yv[8]; float ss = 0.f;
#pragma unroll
    for (int j = 0; j < 8; ++j) {
        yv[j] = *(const uint2*)(y2row + 4 * (lane + 64 * j));
        const float y0 = __uint_as_float(yv[j].x << 16), y1 = __uint_as_float(yv[j].x & 0xffff0000u), y2 = __uint_as_float(yv[j].y << 16), y3 = __uint_as_float(yv[j].y & 0xffff0000u);
        ss += y0 * y0 + y1 * y1 + y2 * y2 + y3 * y3;
    }
    ss = wave_sum(ss);
    const float rstd = rsqrtf(ss * (1.f / DM) + EPS);
#pragma unroll
    for (int j = 0; j < 8; ++j) {
        const int k0 = 4 * (lane + 64 * j);
        const float4 gt = *(const float4*)(gate + k0), w = *(const float4*)(npost + k0);
        const float y0 = __uint_as_float(yv[j].x << 16), y1 = __uint_as_float(yv[j].x & 0xffff0000u), y2 = __uint_as_float(yv[j].y << 16), y3 = __uint_as_float(yv[j].y & 0xffff0000u);
        v[j].x += gt.x * (y0 * rstd * w.x); v[j].y += gt.y * (y1 * rstd * w.y); v[j].z += gt.z * (y2 * rstd * w.z); v[j].w += gt.w * (y3 * rstd * w.w);
        *(float4*)(orow + k0) = v[j];
        asm volatile("" ::: "memory");
    }
}
DEVI void norm_regs(const float4 (&v)[8], const float* __restrict__ shift, const float* __restrict__ scale, const float* __restrict__ npre, bf16_t* __restrict__ hrow, char* trow, int lane) {
    float ss = 0.f;
#pragma unroll
    for (int j = 0; j < 8; ++j) ss += v[j].x * v[j].x + v[j].y * v[j].y + v[j].z * v[j].z + v[j].w * v[j].w;
    ss = wave_sum(ss);
    const float rstd = rsqrtf(ss * (1.f / DM) + EPS);
#pragma unroll
    for (int j = 0; j < 8; ++j) {
        const int k0 = 4 * (lane + 64 * j);
        const float4 w = *(const float4*)(npre + k0), sh = *(const float4*)(shift + k0), sc = *(const float4*)(scale + k0);
        uint2 o;
        o.x = pk2(v[j].x * rstd * w.x * (1.f + sc.x) + sh.x, v[j].y * rstd * w.y * (1.f + sc.y) + sh.y);
        o.y = pk2(v[j].z * rstd * w.z * (1.f + sc.z) + sh.z, v[j].w * rstd * w.w * (1.f + sc.w) + sh.w);
        *(uint2*)(hrow + k0) = o; *(uint2*)(trow + k0 * 2) = o;
        asm volatile("" ::: "memory");
    }
}
constexpr int NT_ROWB = (DM + 8) * 2;
template <bool POST>
DEVI void norm_phase(const float* __restrict__ xlat, const float* __restrict__ xctx, const bf16_t* __restrict__ Y2, const float* __restrict__ mod_post, const float* __restrict__ npost,
                     float* olat, float* octx, const float* __restrict__ mod_n, const float* __restrict__ npre, const float* __restrict__ wg, bf16_t* __restrict__ H,
                     float* __restrict__ GATES, char* lds) {
    typedef short bf16x8 __attribute__((ext_vector_type(8))); typedef float f32x4 __attribute__((ext_vector_type(4)));
    const int tid = opaque_tid(), lane = tid & 63, wave = tid >> 6, lr = lane & 15, kgp = lane >> 4;
    char* tile = lds; float* red = (float*)(lds + 8 * NT_ROWB);
    bf16x8 bfrag[8];
    {
        const float* wp = wg + (size_t)(wave * 256 + 8 * kgp) * INC + lr;
#pragma unroll
        for (int ks = 0; ks < 8; ++ks) {
            unsigned w4[4];
#pragma unroll
            for (int q = 0; q < 4; ++q) { w4[q] = pk2(wp[0], wp[INC]); wp += 2 * INC; asm volatile("" : "+v"(wp)); }
            wp += (size_t)24 * INC; asm volatile("" : "+v"(wp));
            bfrag[ks] = __builtin_bit_cast(bf16x8, make_uint4(w4[0], w4[1], w4[2], w4[3]));
        }
    }
    for (int grp = blockIdx.x; grp < NTOK / 8; grp += gridDim.x) {
        const int row = grp * 8 + wave; const bool isl = row < NLAT; const int b = isl ? row / SEQ : 8;
        {
            float4 v[8];
            load_row(isl ? xlat + (size_t)row * DM : xctx + (size_t)(row - NLAT) * DM, v, lane);
            if (POST) post_regs(v, Y2 + (size_t)row * DM, mod_post + (size_t)b * MODW + 2 * DM, npost, isl ? olat + (size_t)row * DM : octx + (size_t)(row - NLAT) * DM, lane);
            norm_regs(v, mod_n + (size_t)b * MODW, mod_n + (size_t)b * MODW + DM, npre, H + (size_t)row * DM, tile + wave * NT_ROWB, lane);
        }
        __syncthreads();
        f32x4 acc = {0.f, 0.f, 0.f, 0.f};
#pragma unroll
        for (int ks = 0; ks < 8; ++ks) {
            bf16x8 af = {0, 0, 0, 0, 0, 0, 0, 0};
            if (lr < 8) af = *(const bf16x8*)(tile + lr * NT_ROWB + (wave * 256 + ks * 32 + 8 * kgp) * 2);
            acc = __builtin_amdgcn_mfma_f32_16x16x32_bf16(af, bfrag[ks], acc, 0, 0, 0);
        }
        if (kgp < 2) {
#pragma unroll
            for (int r = 0; r < 4; ++r) red[(wave * 8 + 4 * kgp + r) * 16 + lr] = acc[r];
        }
        __syncthreads();
        if (tid < 128) { const int rr = tid >> 4, cc = tid & 15; float sum = 0.f;
#pragma unroll
            for (int w8 = 0; w8 < 8; ++w8) sum += red[(w8 * 8 + rr) * 16 + cc];
            GATES[(size_t)(grp * 8 + rr) * 16 + cc] = sum; }
    }
    __syncthreads();
}

#define XB_TMO      128
#define XB_XCNT(j)  (256  + 64 * (j))
#define XB_XSUB(j)  (1280 + 64 * (j))
#define XB_XGEN(j)  (2304 + 64 * (j))
#define XB_TOP      3328
#define XB_TOPGEN   3392
#define XCD_BAR_WORDS 3456
#define XB_SPIN_CAP (1u << 18)

__device__ __forceinline__ unsigned xb_ld(unsigned* p)              { return __hip_atomic_load(p, __ATOMIC_RELAXED, __HIP_MEMORY_SCOPE_AGENT); }
__device__ __forceinline__ unsigned xb_add(unsigned* p, unsigned v) { return __hip_atomic_fetch_add(p, v, __ATOMIC_RELAXED, __HIP_MEMORY_SCOPE_AGENT); }
__device__ __forceinline__ unsigned xb_xcc_id() { return (unsigned)__builtin_amdgcn_s_getreg((3 << 11) | 20) & 0xFu; }
#define XB_SPIN(cond, bar) do { unsigned _sp = 0; while (cond) { __builtin_amdgcn_s_sleep(1); \
    if ((++_sp & 255u) == 0u) { if (xb_ld(&(bar)[XB_TMO])) break; if (_sp > XB_SPIN_CAP) { atomicAdd(&(bar)[XB_TMO], 1u); break; } } } } while (0)

struct XcdBarrier {
    unsigned* bar; unsigned x;
    volatile __attribute__((address_space(3))) unsigned* st;
};

__device__ __forceinline__ XcdBarrier xcd_barrier_post(unsigned* bar, volatile __attribute__((address_space(3))) unsigned* st) {
    XcdBarrier b; b.bar = bar; b.x = xb_xcc_id(); b.st = st;
    if (threadIdx.x == 0) (void)xb_add(&bar[XB_XCNT(b.x)], 1u);
    return b;
}
__device__ __forceinline__ void xcd_barrier_complete(unsigned* bar, unsigned x, unsigned& nloc, unsigned& nx) {
    const unsigned G = gridDim.x * gridDim.y * gridDim.z;
    unsigned sum, cnt, mine, sp = 0u;
    for (;;) {
        sum = 0u; cnt = 0u; mine = 0u;
#pragma unroll
        for (unsigned j = 0; j < 16; ++j) { const unsigned c = xb_ld(&bar[XB_XCNT(j)]); sum += c; cnt += (c > 0u) ? 1u : 0u; mine = (j == x) ? c : mine; }
        if (sum == G) break;
        __builtin_amdgcn_s_sleep(1);
        if ((++sp & 255u) == 0u) { if (xb_ld(&bar[XB_TMO])) break; if (sp > XB_SPIN_CAP) { atomicAdd(&bar[XB_TMO], 1u); break; } }
    }
    nloc = mine > 0u ? mine : 1u; nx = cnt > 0u ? cnt : 1u;
}

__device__ __forceinline__ void xcd_barrier(const XcdBarrier& b) {
    asm volatile("s_waitcnt vmcnt(0)" ::: "memory");
    __syncthreads();
    if (threadIdx.x == 0) {
        unsigned* bar = b.bar;
        __builtin_amdgcn_s_waitcnt(0);
        unsigned nloc = b.st[0], nx = b.st[1];
        if (nloc == 0u) { xcd_barrier_complete(bar, b.x, nloc, nx); b.st[0] = nloc; b.st[1] = nx; }
        const unsigned old = xb_add(&bar[XB_XSUB(b.x)], 1u);
        const unsigned gen = old / nloc;
        if (old + 1u == (gen + 1u) * nloc) {
            __builtin_amdgcn_fence(__ATOMIC_RELEASE, "agent");
            asm volatile("s_waitcnt vmcnt(0)" ::: "memory");
            const unsigned og = xb_add(&bar[XB_TOP], 1u);
            const unsigned tg = og / nx;
            if (og + 1u == (tg + 1u) * nx) xb_add(&bar[XB_TOPGEN], 1u);
            else XB_SPIN(xb_ld(&bar[XB_TOPGEN]) == tg, bar);
            __builtin_amdgcn_fence(__ATOMIC_ACQUIRE, "agent");
            xb_add(&bar[XB_XGEN(b.x)], 1u);
            asm volatile("s_waitcnt vmcnt(0)" ::: "memory");
        } else {
            XB_SPIN(xb_ld(&bar[XB_XGEN(b.x)]) == gen, bar);
            __builtin_amdgcn_fence(__ATOMIC_ACQUIRE, "agent");
            asm volatile("s_waitcnt vmcnt(0)" ::: "memory");
        }
    }
    __syncthreads();
}

namespace cg = cooperative_groups;
constexpr int MEGA_LDS = 131072 + 256;
struct MegaArgs { const float* in[20]; float* out; unsigned char* ws; };
__global__ __launch_bounds__(512, 2) void mega_fwd(MegaArgs a) {
    extern __shared__ __attribute__((aligned(16))) unsigned char lds[];
    cg::grid_group grid = cg::this_grid();
    volatile __attribute__((address_space(3))) unsigned* MISC = (volatile __attribute__((address_space(3))) unsigned*)((__attribute__((address_space(3))) unsigned char*)lds + 131072);
    if (threadIdx.x < 64) MISC[threadIdx.x] = 0u;
    __syncthreads();
    const XcdBarrier bar = xcd_barrier_post((unsigned*)(a.ws + WS_CTL) + 4096, MISC + 8);
    const int G = gridDim.x;
#define PHASE_IDS const int tid = opaque_tid(), lane = tid & 63, wave = tid >> 6, gw = blockIdx.x * 8 + wave, ngw = G * 8; (void)tid; (void)lane; (void)gw; (void)ngw; float* scr = (float*)lds + wave * (64 * 33); (void)scr
    const float* x = a.in[0]; const float* c = a.in[1]; const float* ctx = a.in[2]; const float* c_ctx = a.in[3];
    const float* w_ada = a.in[4]; const float* b_ada = a.in[5]; const float* norm_pre = a.in[6]; const float* norm_post = a.in[7];
    const float* w_in = a.in[8]; const float* w_out = a.in[9];
    float* out = a.out; unsigned char* ws = a.ws;
    float* MOD = (float*)(ws + WS_MOD); float* ROPE = (float*)(ws + WS_ROPE); float* GATES = (float*)(ws + WS_GATES);
    bf16_t* WOUT = (bf16_t*)(ws + WS_WOUT); bf16_t* WIN = (bf16_t*)(ws + WS_WIN); float* XC = (float*)(ws + WS_XC);
    bf16_t* H = (bf16_t*)(ws + WS_H); bf16_t* HM = (bf16_t*)(ws + WS_HM); bf16_t* P = (bf16_t*)(ws + WS_P);
    bf16_t* Y = H; bf16_t* Y2 = HM;

    { PHASE_IDS;
    for (int u = blockIdx.x; u < 192; u += G) mod_unit(u, c, c_ctx, w_ada, b_ada, MOD, (float*)lds);
    for (int i = blockIdx.x * 512 + tid; i < 1024; i += G * 512) { const int pos = i >> 4, f = i & 15; const float inv = powf(10000.f, -(float)f / 16.f); const float ang = (float)pos * inv;
        ROPE[2 * i] = cosf(ang); ROPE[2 * i + 1] = sinf(ang); }
    transpose_items(w_in, INC, DM, NP, WIN, scr, gw, ngw, lane);
    transpose_items(w_out, DM, DM, DM, WOUT, scr, gw, ngw, lane);
    transpose_items(w_out + (size_t)DM * DM, DM, DM, DM, WOUT + (size_t)DM * DM, scr, gw, ngw, lane); }
    grid.sync();
    norm_phase<false>(x, ctx, nullptr, nullptr, nullptr, nullptr, nullptr, MOD, norm_pre, w_in + NP, H, GATES, (char*)lds);
    xcd_barrier(bar);
    for (int l = 0; l < 2; ++l) {
        const float lam_init = l == 0 ? 0.2f : 0.35550906759f;
        const float* mod_l = MOD + (size_t)l * 9 * MODW;
        { pg8::Gemm g{H, WIN, NTOK, NP, DM}; pg8::StaticOrder S; S.init(NTOK, NP, G, (int)blockIdx.x); pg8::EpiInProj E{P, NP, ROPE};
          pg8::gemm_phase<pg8::EpiInProj, pg8::StaticOrder, true, true>((PG8_LAS unsigned char*)lds, g, S, E); }
        xcd_barrier(bar);
        mls::mlstm_phase(P, GATES, HM, a.in[15] + (size_t)l * 3 * 1024, a.in[16] + l * 1024, a.in[17] + l * 8, a.in[18] + l * 8, (char*)lds);
        att::attn_phase(P, Y, a.in[10] + l * 64, a.in[11] + l * 64, a.in[12] + l * 64, a.in[13] + l * 64, a.in[14] + l * 128, lam_init, l == 0, (char*)lds);
        xcd_barrier(bar);
        { PHASE_IDS; const int nrows = l == 0 ? NTOK : NLAT; for (int row = gw; row < nrows; row += ngw) finish_row(P, HM, a.in[19] + l * 1024, Y, row, lane); }
        xcd_barrier(bar);
        { const int M = l == 0 ? NTOK : NLAT; pg8::Gemm g{Y, WOUT + (size_t)l * DM * DM, M, DM, DM}; pg8::StaticOrder S; S.init(M, DM, G, (int)blockIdx.x); pg8::EpiBf16 E{Y2, DM};
          pg8::gemm_phase<pg8::EpiBf16, pg8::StaticOrder, true, true>((PG8_LAS unsigned char*)lds, g, S, E); }
        if (l == 0) { PHASE_IDS;
            const int nbusy = (NTOK / 256) * (DM / 256) - 2 * G;
            if (nbusy >= 0 && nbusy < G) { if ((int)blockIdx.x >= nbusy) transpose_items(w_in + (size_t)DM * INC, INC, DM, NP, WIN, scr, ((int)blockIdx.x - nbusy) * 8 + wave, (G - nbusy) * 8, lane); }
            else transpose_items(w_in + (size_t)DM * INC, INC, DM, NP, WIN, scr, gw, ngw, lane);
        }
        xcd_barrier(bar);
        if (l == 0) {
            norm_phase<true>(x, ctx, Y2, mod_l, norm_post, out, XC, MOD + (size_t)9 * MODW, norm_pre + DM, w_in + (size_t)DM * INC + NP, H, GATES, (char*)lds);
            xcd_barrier(bar);
        } else { PHASE_IDS;
            for (int row = gw; row < NLAT; row += ngw) {
                float4 v[8];
                load_row(out + (size_t)row * DM, v, lane);
                post_regs(v, Y2 + (size_t)row * DM, mod_l + (size_t)(row / SEQ) * MODW + 2 * DM, norm_post + DM, out + (size_t)row * DM, lane);
            }
        }
    }
}

extern "C" void kernel_launch(void* const* d_in, const int* in_sizes, int n_in, void* d_out, int out_size, void* d_ws, size_t ws_size, hipStream_t stream) {
    (void)in_sizes; (void)n_in; (void)out_size; (void)ws_size;
    static int grid_blocks = 0;
    if (!grid_blocks) {
        int dev = 0, cus = 0, per_cu = 0;
        (void)hipGetDevice(&dev);
        (void)hipDeviceGetAttribute(&cus, hipDeviceAttributeMultiprocessorCount, dev);
        (void)hipFuncSetAttribute((const void*)mega_fwd, hipFuncAttributeMaxDynamicSharedMemorySize, MEGA_LDS);
        (void)hipOccupancyMaxActiveBlocksPerMultiprocessor(&per_cu, (const void*)mega_fwd, 512, MEGA_LDS);
        if (per_cu < 1) per_cu = 1;
        if (per_cu > 1) per_cu = 1;
        grid_blocks = cus * per_cu;
    }
    (void)hipMemsetAsync((char*)d_ws + WS_CTL, 0, 65536, stream);
    MegaArgs a{};
    for (int i = 0; i < 20; ++i) a.in[i] = (const float*)d_in[i];
    a.out = (float*)d_out; a.ws = (unsigned char*)d_ws;
    void* args[] = {&a};
    (void)hipLaunchCooperativeKernel((const void*)mega_fwd, dim3(grid_blocks), dim3(512), args, (size_t)MEGA_LDS, stream);
}
```

```cpp
#include <hip/hip_runtime.h>
#include <hip/hip_cooperative_groups.h>
#include <stdint.h>
#include <math.h>

#define DEVI __device__ __forceinline__
typedef unsigned short bf16_t;

constexpr int DM = 2048, NBATCH = 8, SEQ = 2048, CTXL = 256;
constexpr int NLAT = NBATCH * SEQ, NCTX = NBATCH * CTXL, NTOK = NLAT + NCTX;
constexpr int INC = 8208, NP = 8192, MODW = 6144;
constexpr int C_QA = 0, C_KA = 1024, C_VA = 2048, C_GA = 3072, C_QB = 4096, C_KB = 4608, C_VB = 5120, C_OB = 6144, C_GB = 7168;
constexpr float EPS = 1e-6f;

constexpr size_t MiB = (size_t)1 << 20;
constexpr size_t WS_CTL = 0, WS_MOD = 1 * MiB, WS_SC = WS_MOD + 512 * 1024, WS_ROPE = 2 * MiB, WS_GATES = 3 * MiB, WS_WOUT = 8 * MiB,
                 WS_WIN = 24 * MiB, WS_XC = 56 * MiB, WS_H = 72 * MiB, WS_HM = 144 * MiB, WS_P = 216 * MiB, WS_END = 504 * MiB;

DEVI int opaque_tid() { int t = threadIdx.x; asm volatile("" : "+v"(t)); return t; }
DEVI float bf2f(bf16_t v) { return __uint_as_float(((unsigned)v) << 16); }
DEVI bf16_t f2bf(float f) { unsigned u = __float_as_uint(f); return (bf16_t)((u + 0x7fffu + ((u >> 16) & 1u)) >> 16); }
DEVI unsigned pk2(float lo, float hi) { return (unsigned)f2bf(lo) | ((unsigned)f2bf(hi) << 16); }
DEVI float wave_sum(float v) {
#pragma unroll
    for (int o = 32; o > 0; o >>= 1) v += __shfl_xor(v, o);
    return v;
}
DEVI float wave_max(float v) {
#pragma unroll
    for (int o = 32; o > 0; o >>= 1) v = fmaxf(v, __shfl_xor(v, o));
    return v;
}
DEVI float silu_f(float x) { return x / (1.f + expf(-x)); }
DEVI float sigmoid_f(float x) { return 1.f / (1.f + expf(-x)); }


DEVI void transpose_item(const float* __restrict__ W, int ldw, int K, int N, bf16_t* __restrict__ WT, float* scr, int item, int lane) {
    const int nblk = N / 32, kb = item / nblk, nb = item % nblk, k0 = 64 * kb, n0 = 32 * nb;
#pragma unroll 8
    for (int i = 0; i < 32; ++i) { const int kk = 2 * i + (lane >> 5); scr[kk * 33 + (lane & 31)] = W[(size_t)(k0 + kk) * ldw + n0 + (lane & 31)]; }
    asm volatile("s_waitcnt lgkmcnt(0)" ::: "memory");
    const int c = lane & 7;
#pragma unroll
    for (int j = 0; j < 4; ++j) {
        const int n = (lane >> 3) + 8 * j; const float* s = scr + (8 * c) * 33 + n;
        uint4 o; o.x = pk2(s[0 * 33], s[1 * 33]); o.y = pk2(s[2 * 33], s[3 * 33]); o.z = pk2(s[4 * 33], s[5 * 33]); o.w = pk2(s[6 * 33], s[7 * 33]);
        *(uint4*)(WT + (size_t)(n0 + n) * K + k0 + 8 * c) = o;
    }
    asm volatile("s_waitcnt lgkmcnt(0)" ::: "memory");
}

namespace pg8 {
#define PG8_LAS __attribute__((address_space(3)))
typedef unsigned short bf16_t;
typedef short bf16x8 __attribute__((ext_vector_type(8)));
typedef float f32x4 __attribute__((ext_vector_type(4)));
typedef unsigned u32x4 __attribute__((ext_vector_type(4)));
constexpr int BM = 256, BK = 64, HALF = 128, HTB = HALF * BK * 2  , STAGE_BYTES = 8 * HTB, NXCD = 8, WGM = 8;

__host__ __device__ __forceinline__ int lds_byte(int r, int c) { const int st = (r >> 4) * 2 + (c >> 5), rr = r & 15, cc = c & 31, ob = rr * 64 + cc * 2; return st * 1024 + (ob ^ (((ob >> 9) & 1) << 5)); }
__host__ __device__ __forceinline__ void stage_rc(int b, int& R, int& C) { const int st = b / 1024, sb = b % 1024, swz = sb ^ (((sb >> 9) & 1) << 5); R = (st >> 1) * 16 + swz / 64; C = (st & 1) * 32 + (swz % 64) / 2; }
__host__ __device__ __forceinline__ int perm32(int rho) { const int n = rho >> 4, i = rho & 15; return 8 * (i >> 2) + 4 * n + (i & 3); }

struct Unit { int pm, pn; };
struct Gemm { const bf16_t* A; const bf16_t* Bt; int M, N, K; };

struct StaticOrder {
    int nM, nN, nwg, G, c;
    __host__ __device__ void init(int M, int N, int G_, int c_) { nM = M / BM; nN = N / BM; nwg = nM * nN; G = G_; c = c_; }
    __host__ __device__ bool next(int i, Unit& u) const {
        const long L = (long)i * G + c; if (L >= nwg) return false;
        int wgid = (int)L; { const int q = nwg / NXCD, r = nwg % NXCD, xcd = wgid % NXCD, off = wgid / NXCD; wgid = (xcd < r ? xcd * (q + 1) : r * (q + 1) + (xcd - r) * q) + off; }
        const int nig = WGM * nN, gid = wgid / nig, fm = gid * WGM, gsz = (nM - fm) < WGM ? (nM - fm) : WGM;
        u.pm = fm + ((wgid % nig) % gsz); u.pn = (wgid % nig) / gsz; return true;
    }
    __device__ __forceinline__ void a_ready(const Unit&) const {}
    __device__ __forceinline__ void done(const Unit&) const {}
};

__device__ __forceinline__ unsigned cvt_pk_bf16(float lo, float hi) { unsigned r; asm volatile("v_cvt_pk_bf16_f32 %0, %1, %2" : "=v"(r) : "v"(lo), "v"(hi)); return r; }

struct EpiBf16 {
    static constexpr bool PERM = true, AFTER_DRAIN = false;
    bf16_t* O; int ldc;
    __device__ __forceinline__ void operator()(const f32x4 (&acc)[2][2][4][2], const Unit& u, int wr, int wc, int fr, int fq) const {
        const int row0 = u.pm * BM + wr * 64 + fr, col0 = u.pn * BM + wc * 32 + 8 * fq;
#pragma unroll
        for (int ai = 0; ai < 2; ++ai)
#pragma unroll
            for (int m = 0; m < 4; ++m) { bf16_t* rowp = O + (size_t)(row0 + ai * HALF + m * 16) * ldc + col0;
#pragma unroll
                for (int bj = 0; bj < 2; ++bj) { const f32x4 v0 = acc[ai][bj][m][0], v1 = acc[ai][bj][m][1];
                    u32x4 w; w.x = cvt_pk_bf16(v0[0], v0[1]); w.y = cvt_pk_bf16(v0[2], v0[3]); w.z = cvt_pk_bf16(v1[0], v1[1]); w.w = cvt_pk_bf16(v1[2], v1[3]);
                    *(u32x4*)(rowp + bj * HALF) = w; } }
    }
};
struct EpiInProj {
    static constexpr bool PERM = true, AFTER_DRAIN = false;
    bf16_t* O; int ldc; const float* rope;
    __device__ __forceinline__ void operator()(const f32x4 (&acc)[2][2][4][2], const Unit& u, int wr, int wc, int fr, int fq) const {
        const int row0 = u.pm * BM + wr * 64 + fr, col0 = u.pn * BM + wc * 32 + 8 * fq;
        const bool do_rope = (u.pn < 8) && (u.pm < 64);
#pragma unroll
        for (int ai = 0; ai < 2; ++ai)
#pragma unroll
            for (int m = 0; m < 4; ++m) { const int row = row0 + ai * HALF + m * 16; bf16_t* rowp = O + (size_t)row * ldc + col0;
                f32x4 cs01 = {1.f, 0.f, 1.f, 0.f}, cs23 = {1.f, 0.f, 1.f, 0.f};
                if (do_rope) { const int pos = (wc & 1) ? (row & 63) : ((row >> 6) & 31); const f32x4* rp = (const f32x4*)(rope + (size_t)(pos * 16 + 4 * fq) * 2); cs01 = rp[0]; cs23 = rp[1]; }
#pragma unroll
                for (int bj = 0; bj < 2; ++bj) { f32x4 v0 = acc[ai][bj][m][0], v1 = acc[ai][bj][m][1];
                    if (do_rope) {
                        const float a0 = v0[0] * cs01[0] - v0[1] * cs01[1], a1 = v0[0] * cs01[1] + v0[1] * cs01[0];
                        const float a2 = v0[2] * cs01[2] - v0[3] * cs01[3], a3 = v0[2] * cs01[3] + v0[3] * cs01[2];
                        const float b0 = v1[0] * cs23[0] - v1[1] * cs23[1], b1 = v1[0] * cs23[1] + v1[1] * cs23[0];
                        const float b2 = v1[2] * cs23[2] - v1[3] * cs23[3], b3 = v1[2] * cs23[3] + v1[3] * cs23[2];
                        v0 = (f32x4){a0, a1, a2, a3}; v1 = (f32x4){b0, b1, b2, b3};
                    }
                    u32x4 w; w.x = cvt_pk_bf16(v0[0], v0[1]); w.y = cvt_pk_bf16(v0[2], v0[3]); w.z = cvt_pk_bf16(v1[0], v1[1]); w.w = cvt_pk_bf16(v1[2], v1[3]);
                    *(u32x4*)(rowp + bj * HALF) = w; } }
    }
};

template <class Epi, class Sched, bool ALIGN_EPI = false, bool SP2 = false>
__device__ __forceinline__ void gemm_phase(PG8_LAS unsigned char* lds, const Gemm g, const Sched& S, const Epi& E) {
    const int tid = opaque_tid(), wid = __builtin_amdgcn_readfirstlane(tid >> 6), lane = tid & 63, wr = wid >> 2, wc = wid & 3, fr = lane & 15, fq = lane >> 4;
    const int K = g.K, nt = K / BK;
    unsigned voffA[2], voffB[2];
#pragma unroll
    for (int i = 0; i < 2; ++i) { int R, C; stage_rc(tid * 16 + i * 8192, R, C); const int Rb = Epi::PERM ? ((R & ~31) + perm32(R & 31)) : R;
        voffA[i] = (unsigned)(R * K + C) * 2u; voffB[i] = (unsigned)(Rb * K + C) * 2u; }
    const size_t kstep = (size_t)(BK * 2);
    const size_t hstep = (size_t)HALF * K * 2;
    const size_t tstep = 2 * hstep;
    const unsigned ldsw = (unsigned)wid * 1024u;
    const int aoff = lds_byte(wr * 64 + fr, fq * 8), boff = lds_byte(wc * 32 + fr, fq * 8);
#define PG8_SA(b, h) (((b) * 2 + (h)) * HTB)
#define PG8_SB(b, h) ((4 + (b) * 2 + (h)) * HTB)
#define PG8_STAGE(bufoff, gbase, voff) do { _Pragma("unroll") for (int _i = 0; _i < 2; ++_i) \
        __builtin_amdgcn_global_load_lds((const unsigned*)((const char*)(gbase) + (voff)[_i]), (PG8_LAS unsigned*)(lds + (bufoff) + ldsw + _i * 8192), 16, 0, 0); } while (0)
#define PG8_LDA(dst, b, h) do { _Pragma("unroll") for (int m = 0; m < 4; ++m) _Pragma("unroll") for (int k = 0; k < 2; ++k) dst[m][k] = *(const PG8_LAS bf16x8*)(lds + PG8_SA(b, h) + aoff + m * 2048 + k * 1024); } while (0)
#define PG8_LDB(dst, b, h) do { _Pragma("unroll") for (int n = 0; n < 2; ++n) _Pragma("unroll") for (int k = 0; k < 2; ++k) dst[n][k] = *(const PG8_LAS bf16x8*)(lds + PG8_SB(b, h) + boff + n * 2048 + k * 1024); } while (0)
#define PG8_MMA(ai, bj, At, Bt) do { __builtin_amdgcn_s_setprio(1); _Pragma("unroll") for (int m = 0; m < 4; ++m) _Pragma("unroll") for (int n = 0; n < 2; ++n) _Pragma("unroll") for (int k = 0; k < 2; ++k) \
        acc[ai][bj][m][n] = __builtin_amdgcn_mfma_f32_16x16x32_bf16(Bt[n][k], At[m][k], acc[ai][bj][m][n], 0, 0, 0); __builtin_amdgcn_s_setprio(0); } while (0)
#define PG8_WAIT_V(n) asm volatile("s_waitcnt vmcnt(" #n ")" ::: "memory")
#define PG8_WAIT_L(n) asm volatile("s_waitcnt lgkmcnt(" #n ")" ::: "memory")
#define PG8_BAR __builtin_amdgcn_s_barrier()
#define PG8_SCHED __builtin_amdgcn_sched_barrier(0)
    Unit cur, nxt; int ui = 0;
    if (!S.next(0, cur)) return;
    f32x4 acc[2][2][4][2];
#pragma unroll
    for (int a = 0; a < 2; ++a)
#pragma unroll
        for (int b = 0; b < 2; ++b)
#pragma unroll
            for (int m = 0; m < 4; ++m)
#pragma unroll
                for (int n = 0; n < 2; ++n) acc[a][b][m][n] = (f32x4){0.f, 0.f, 0.f, 0.f};
    bf16x8 At[4][2], B0[2][2], B1[2][2];
    const char* cA = (const char*)g.A + (size_t)cur.pm * tstep; const char* cB = (const char*)g.Bt + (size_t)cur.pn * tstep;
    S.a_ready(cur);
    if constexpr (SP2) {
        PG8_STAGE(PG8_SB(0, 0), cB, voffB); PG8_STAGE(PG8_SB(0, 1), cB + hstep, voffB); PG8_STAGE(PG8_SA(0, 0), cA, voffA); PG8_STAGE(PG8_SA(0, 1), cA + hstep, voffA);
        if (wr == 1) PG8_BAR;
        PG8_WAIT_V(2); PG8_BAR;
        PG8_STAGE(PG8_SB(1, 0), cB + kstep, voffB); PG8_STAGE(PG8_SA(1, 0), cA + kstep, voffA); PG8_STAGE(PG8_SB(1, 1), cB + hstep + kstep, voffB);
        PG8_WAIT_V(6); PG8_BAR;
    } else {
        PG8_STAGE(PG8_SB(0, 0), cB, voffB); PG8_STAGE(PG8_SA(0, 0), cA, voffA); PG8_STAGE(PG8_SB(0, 1), cB + hstep, voffB); PG8_STAGE(PG8_SA(0, 1), cA + hstep, voffA);
        if (wr == 1) PG8_BAR;
        PG8_WAIT_V(4); PG8_BAR;
        PG8_STAGE(PG8_SB(1, 0), cB + kstep, voffB); PG8_STAGE(PG8_SA(1, 0), cA + kstep, voffA); PG8_STAGE(PG8_SB(1, 1), cB + hstep + kstep, voffB);
        PG8_WAIT_V(6); PG8_BAR;
    }
    for (;;) {
        const bool has_next = S.next(ui + 1, nxt);
        const char* nA = has_next ? (const char*)g.A + (size_t)nxt.pm * tstep : cA; const char* nB = has_next ? (const char*)g.Bt + (size_t)nxt.pn * tstep : cB;
        for (int t = 0; t < nt; t += 2) {
            const bool last = (t == nt - 2);
            const char* a1 = cA + (size_t)(t + 1) * kstep;
            const char* a2 = last ? nA : cA + (size_t)(t + 2) * kstep; const char* b2 = last ? nB : cB + (size_t)(t + 2) * kstep;
            const char* a3 = a2 + kstep; const char* b3 = b2 + kstep;
            if (last && has_next) S.a_ready(nxt);
            if constexpr (SP2) {
            PG8_LDB(B0, 0, 0); PG8_LDB(B1, 0, 1); PG8_SCHED; PG8_LDA(At, 0, 0); PG8_STAGE(PG8_SA(1, 1), a1 + hstep, voffA);
            PG8_WAIT_V(8); PG8_WAIT_L(0); PG8_BAR; PG8_MMA(0, 0, At, B0); PG8_MMA(0, 1, At, B1); PG8_BAR; PG8_SCHED;
            PG8_LDA(At, 0, 1); PG8_STAGE(PG8_SB(0, 0), b2, voffB); PG8_STAGE(PG8_SB(0, 1), b2 + hstep, voffB); PG8_STAGE(PG8_SA(0, 0), a2, voffA);
            PG8_WAIT_V(8); PG8_WAIT_L(0); PG8_BAR; PG8_MMA(1, 0, At, B0); PG8_MMA(1, 1, At, B1); PG8_BAR; PG8_SCHED;
            PG8_LDB(B0, 1, 0); PG8_LDB(B1, 1, 1); PG8_SCHED; PG8_LDA(At, 1, 0); PG8_STAGE(PG8_SA(0, 1), a2 + hstep, voffA);
            PG8_WAIT_V(8); PG8_WAIT_L(0); PG8_BAR; PG8_MMA(0, 0, At, B0); PG8_MMA(0, 1, At, B1); PG8_BAR; PG8_SCHED;
            PG8_LDA(At, 1, 1); PG8_STAGE(PG8_SB(1, 0), b3, voffB); PG8_STAGE(PG8_SB(1, 1), b3 + hstep, voffB); PG8_STAGE(PG8_SA(1, 0), a3, voffA);
            PG8_WAIT_V(8); PG8_WAIT_L(0); PG8_BAR; PG8_MMA(1, 0, At, B0); PG8_MMA(1, 1, At, B1); PG8_BAR; PG8_SCHED;
            } else {
            PG8_LDB(B0, 0, 0); PG8_SCHED; PG8_LDA(At, 0, 0); PG8_STAGE(PG8_SA(1, 1), a1 + hstep, voffA);
            PG8_WAIT_L(8); PG8_BAR; PG8_WAIT_L(0); PG8_MMA(0, 0, At, B0); PG8_BAR; PG8_SCHED;
            PG8_LDB(B1, 0, 1); PG8_STAGE(PG8_SB(0, 0), b2, voffB);
            PG8_BAR; PG8_WAIT_L(0); PG8_MMA(0, 1, At, B1); PG8_BAR;
            PG8_LDA(At, 0, 1); PG8_STAGE(PG8_SA(0, 0), a2, voffA);
            PG8_BAR; PG8_WAIT_L(0); PG8_MMA(1, 0, At, B0); PG8_BAR; PG8_SCHED;
            PG8_STAGE(PG8_SB(0, 1), b2 + hstep, voffB);
            PG8_WAIT_V(6); PG8_BAR; PG8_MMA(1, 1, At, B1); PG8_BAR;
            PG8_LDB(B0, 1, 0); PG8_SCHED; PG8_LDA(At, 1, 0); PG8_STAGE(PG8_SA(0, 1), a2 + hstep, voffA);
            PG8_WAIT_L(8); PG8_BAR; PG8_WAIT_L(0); PG8_MMA(0, 0, At, B0); PG8_BAR; PG8_SCHED;
            PG8_LDB(B1, 1, 1); PG8_STAGE(PG8_SB(1, 0), b3, voffB);
            PG8_BAR; PG8_WAIT_L(0); PG8_MMA(0, 1, At, B1); PG8_BAR;
            PG8_LDA(At, 1, 1); PG8_STAGE(PG8_SA(1, 0), a3, voffA);
            PG8_BAR; PG8_WAIT_L(0); PG8_MMA(1, 0, At, B0); PG8_BAR; PG8_SCHED;
            PG8_STAGE(PG8_SB(1, 1), b3 + hstep, voffB);
            PG8_WAIT_V(6); PG8_BAR; PG8_MMA(1, 1, At, B1); PG8_BAR;
            }
        }
        if constexpr (ALIGN_EPI) { if (wr == 0) PG8_BAR; }
        if constexpr (!Epi::AFTER_DRAIN) { E(acc, cur, wr, wc, fr, fq); S.done(cur); }
        if (!has_next) break;
#pragma unroll
        for (int a = 0; a < 2; ++a)
#pragma unroll
            for (int b = 0; b < 2; ++b)
#pragma unroll
                for (int m = 0; m < 4; ++m)
#pragma unroll
                    for (int n = 0; n < 2; ++n) acc[a][b][m][n] = (f32x4){0.f, 0.f, 0.f, 0.f};
        cur = nxt; cA = nA; cB = nB; ++ui;
        if constexpr (ALIGN_EPI) { if (wr == 1) PG8_BAR; }
    }
    PG8_WAIT_V(0);
    if constexpr (!ALIGN_EPI) { if (wr == 0) PG8_BAR; }
    PG8_BAR;
    if constexpr (Epi::AFTER_DRAIN) { E.fused(acc, cur, wr, wc, fr, fq, lds, wid, lane); S.done(cur); }
#undef PG8_SA
#undef PG8_SB
#undef PG8_STAGE
#undef PG8_LDA
#undef PG8_LDB
#undef PG8_MMA
#undef PG8_WAIT_V
#undef PG8_WAIT_L
#undef PG8_BAR
#undef PG8_SCHED
}
}

namespace att {
using bf16x8 = __attribute__((ext_vector_type(8))) short;
using s16x4  = __attribute__((ext_vector_type(4))) short;
using f32x16 = __attribute__((ext_vector_type(16))) float;
using u32x4  = __attribute__((ext_vector_type(4))) unsigned;
constexpr int NW = 8, QBLK = 32, KVBLK = 64, QROWS = 128;
constexpr float SCALE = 0.125f, THR = 6.f;
constexpr int SHM_V = KVBLK * 128 * 2, SHM_K = KVBLK * 128 * 2, SHM_ATTN = 2 * SHM_V + 2 * SHM_K + NW * 64 * 4;
#define KSWZ(row, colB) ((row) * 256 + ((colB) ^ (((row) & 7) << 4)))
#define SBAR() __builtin_amdgcn_sched_barrier(0)
__device__ __forceinline__ int crow(int r, int hi) { return (r & 3) + 8 * (r >> 2) + 4 * hi; }
__device__ __forceinline__ unsigned cvtpk(float lo, float hi) { unsigned r; asm volatile("v_cvt_pk_bf16_f32 %0, %1, %2" : "=v"(r) : "v"(lo), "v"(hi)); return r; }
__device__ __forceinline__ void partialSM(f32x16& p0, f32x16& p1, float& m_reg, float& mn, float& alpha) {
  constexpr float C = SCALE * 1.4426950408889634f;
  float pmax = p0[0];
#pragma unroll
  for (int r = 1; r < 16; ++r) pmax = fmaxf(pmax, p0[r]);
#pragma unroll
  for (int r = 0; r < 16; ++r) pmax = fmaxf(pmax, p1[r]);
  { auto rr = __builtin_amdgcn_permlane32_swap(__float_as_uint(pmax), __float_as_uint(pmax), false, false);
    pmax = fmaxf(__uint_as_float(rr[0]), __uint_as_float(rr[1])); }
  if (__builtin_expect(__all(pmax - m_reg <= THR / SCALE), 1)) { mn = m_reg; alpha = 1.f; }
  else { mn = fmaxf(m_reg, pmax); alpha = __builtin_amdgcn_exp2f((m_reg - mn) * C); m_reg = mn; }
  const float mnC = -mn * C;
#pragma unroll
  for (int r = 0; r < 16; ++r) p0[r] = fmaf(p0[r], C, mnC);
#pragma unroll
  for (int r = 0; r < 16; ++r) p1[r] = fmaf(p1[r], C, mnC);
#pragma unroll
  for (int r = 0; r < 16; ++r) p0[r] = __builtin_amdgcn_exp2f(p0[r]);
}
__device__ __forceinline__ void finishSM(f32x16& p0, f32x16& p1, float alpha, float& l_reg, bf16x8& pa0, bf16x8& pa1, bf16x8& pa2, bf16x8& pa3) {
#pragma unroll
  for (int r = 0; r < 16; ++r) p1[r] = __builtin_amdgcn_exp2f(p1[r]);
  float ps = 0;
#pragma unroll
  for (int r = 0; r < 16; ++r) ps += p0[r];
#pragma unroll
  for (int r = 0; r < 16; ++r) ps += p1[r];
  { auto rr = __builtin_amdgcn_permlane32_swap(__float_as_uint(ps), __float_as_uint(ps), false, false);
    ps = __uint_as_float(rr[0]) + __uint_as_float(rr[1]); }
  l_reg = l_reg * alpha + ps;
#define PK4(P, BASE, OUT) do { unsigned a0 = cvtpk(P[BASE + 0], P[BASE + 1]), a1 = cvtpk(P[BASE + 2], P[BASE + 3]);   \
    unsigned b0 = cvtpk(P[BASE + 4], P[BASE + 5]), b1 = cvtpk(P[BASE + 6], P[BASE + 7]);                              \
    auto r0 = __builtin_amdgcn_permlane32_swap(a0, b0, false, false); auto r1 = __builtin_amdgcn_permlane32_swap(a1, b1, false, false); \
    u32x4 w = {r0[0], r1[0], r0[1], r1[1]}; OUT = *reinterpret_cast<bf16x8*>(&w); } while (0)
  PK4(p0, 0, pa0); PK4(p0, 8, pa1); PK4(p1, 0, pa2); PK4(p1, 8, pa3);
#undef PK4
}
__device__ __forceinline__ void qkt(f32x16& p0, f32x16& p1, const char* Ks, const bf16x8* qr, int r32, int hi, int sub) {
  p0 = f32x16{}; p1 = f32x16{};
#pragma unroll
  for (int d0 = 0; d0 < 4; ++d0) { const int cb = (sub * 64 + d0 * 16 + hi * 8) * 2;
    const bf16x8 b0 = *reinterpret_cast<const bf16x8*>(Ks + KSWZ(r32, cb));
    const bf16x8 b1 = *reinterpret_cast<const bf16x8*>(Ks + KSWZ(32 + r32, cb));
    p0 = __builtin_amdgcn_mfma_f32_32x32x16_bf16(b0, qr[d0], p0, 0, 0, 0);
    p1 = __builtin_amdgcn_mfma_f32_32x32x16_bf16(b1, qr[d0], p1, 0, 0, 0); }
}
__device__ __forceinline__ int v_st(int k, int c) { const int kk = (k & ~0xC) | ((k & 4) << 1) | ((k & 8) >> 1); return ((kk >> 3) * 4 + (c >> 5)) * 512 + ((kk & 7) * 32 + (c & 31)) * 2; }
__device__ __forceinline__ int v_rd_base(int lane) { return ((lane & 3) << 3) | (((lane >> 2) & 3) << 6) | (((lane >> 4) & 1) << 5) | (((lane >> 5) & 1) << 8); }
constexpr int v_rd_off(int d0, int ks, int half) { return d0 * 512 + ks * 4096 + half * 2048; }
template <int OFF> __device__ __forceinline__ s16x4 tr_read(int vb) {
  s16x4 r; asm volatile("ds_read_b64_tr_b16 %0, %1 offset:%2" : "=&v"(r) : "v"(vb), "i"(OFF) : "memory"); return r;
}
template <int D0> __device__ __forceinline__ void pv_one(f32x16& od, int vb, bf16x8 pa0, bf16x8 pa1, bf16x8 pa2, bf16x8 pa3) {
  const s16x4 l0 = tr_read<v_rd_off(D0, 0, 0)>(vb), h0 = tr_read<v_rd_off(D0, 0, 1)>(vb), l1 = tr_read<v_rd_off(D0, 1, 0)>(vb), h1 = tr_read<v_rd_off(D0, 1, 1)>(vb);
  const s16x4 l2 = tr_read<v_rd_off(D0, 2, 0)>(vb), h2 = tr_read<v_rd_off(D0, 2, 1)>(vb), l3 = tr_read<v_rd_off(D0, 3, 0)>(vb), h3 = tr_read<v_rd_off(D0, 3, 1)>(vb);
  asm volatile("s_waitcnt lgkmcnt(0)" ::: "memory"); SBAR();
#define PK(L, H) (bf16x8){L[0], L[1], L[2], L[3], H[0], H[1], H[2], H[3]}
  od = __builtin_amdgcn_mfma_f32_32x32x16_bf16(pa0, PK(l0, h0), od, 0, 0, 0);
  od = __builtin_amdgcn_mfma_f32_32x32x16_bf16(pa1, PK(l1, h1), od, 0, 0, 0);
  od = __builtin_amdgcn_mfma_f32_32x32x16_bf16(pa2, PK(l2, h2), od, 0, 0, 0);
  od = __builtin_amdgcn_mfma_f32_32x32x16_bf16(pa3, PK(l3, h3), od, 0, 0, 0);
#undef PK
}
__device__ __forceinline__ void pv_d0(f32x16* o, int vb, bf16x8 pa0, bf16x8 pa1, bf16x8 pa2, bf16x8 pa3) {
  pv_one<0>(o[0], vb, pa0, pa1, pa2, pa3); pv_one<1>(o[1], vb, pa0, pa1, pa2, pa3); pv_one<2>(o[2], vb, pa0, pa1, pa2, pa3); pv_one<3>(o[3], vb, pa0, pa1, pa2, pa3);
}
__device__ __forceinline__ long ktile_row(int b, int t) { return t < 4 ? (long)(NLAT + b * CTXL + 64 * t) : (long)(b * SEQ + 64 * (t - 4)); }

__device__ __forceinline__ void attn_unit(const bf16_t* __restrict__ Pm, bf16_t* __restrict__ Y, long qrow0, int b, int hh, int NT, float lam, float lam_init,
                                          const float* __restrict__ subln, char* lds) {
  const int tid = opaque_tid(), wid = tid >> 6, lane = tid & 63, r32 = lane & 31, hi = lane >> 5;
  const int sub = wid & 1, pr = wid >> 1;
  char* V_lds = lds; char* K_lds = lds + 2 * SHM_V;
  float* ws = (float*)(lds + 2 * SHM_V + 2 * SHM_K) + wid * 64; float* li_l = ws; float* al_l = ws + 32;
  float m_reg = -1e30f, l_reg = 0; f32x16 o[4] = {}; bf16x8 qr[4];
  const bf16_t* Qw = Pm + (qrow0 + pr * QBLK + r32) * NP + C_QA + hh * 128 + sub * 64 + hi * 8;
#pragma unroll
  for (int d0 = 0; d0 < 4; ++d0) qr[d0] = *reinterpret_cast<const bf16x8*>(Qw + d0 * 16);
  const int sr = tid >> 4, sc = (tid & 15) * 8, vst0 = v_st(sr, sc), vst1 = v_st(32 + sr, sc);
  const int vb0 = (int)(uintptr_t)V_lds + v_rd_base(lane);
  const bf16_t* Kcol = Pm + C_KA + hh * 128 + sc; const bf16_t* Vcol = Pm + C_VA + hh * 128 + sc;
  struct { bf16x8 vs0, vs1, ks0, ks1; } sr_[2];
#define SLOAD(i, t) do { const long r0_ = ktile_row(b, (t)) + sr; \
    sr_[i].vs0 = *reinterpret_cast<const bf16x8*>(Vcol + r0_ * NP); sr_[i].vs1 = *reinterpret_cast<const bf16x8*>(Vcol + (r0_ + 32) * NP); \
    sr_[i].ks0 = *reinterpret_cast<const bf16x8*>(Kcol + r0_ * NP); sr_[i].ks1 = *reinterpret_cast<const bf16x8*>(Kcol + (r0_ + 32) * NP); } while (0)
#define SWRITE(bb, i) do { *(bf16x8*)(V_lds + (bb) * SHM_V + vst0) = sr_[i].vs0; *(bf16x8*)(V_lds + (bb) * SHM_V + vst1) = sr_[i].vs1; const int kc = sc * 2; \
    *(bf16x8*)(K_lds + (bb) * SHM_K + KSWZ(sr, kc)) = sr_[i].ks0; *(bf16x8*)(K_lds + (bb) * SHM_K + KSWZ(32 + sr, kc)) = sr_[i].ks1; } while (0)
#define SWAIT() asm volatile("s_waitcnt vmcnt(4)" ::: "memory")
#define RESC(a) do { if (__any((a) < 1.f)) { if (hi == 0) al_l[r32] = (a); asm volatile("s_waitcnt lgkmcnt(0)" ::: "memory"); \
    _Pragma("unroll") for (int d = 0; d < 4; ++d) _Pragma("unroll") for (int r = 0; r < 16; ++r) o[d][r] *= al_l[crow(r, hi)]; } } while (0)
  f32x16 pA0, pA1, pB0, pB1; float mnA, mnB, alA, alB; bf16x8 pa0, pa1, pa2, pa3;
  constexpr int SE = 0, SO = 1;
  SLOAD(SE, 0); asm volatile("s_waitcnt vmcnt(0)" ::: "memory"); SWRITE(0, SE); __syncthreads();
  qkt(pA0, pA1, K_lds, qr, r32, hi, sub); partialSM(pA0, pA1, m_reg, mnA, alA);
  SLOAD(SO, 1); if (2 < NT) SLOAD(SE, 2);
  SWAIT(); SWRITE(1, SO); __syncthreads();
  for (int j = 1; j + 1 < NT; j += 2) {
    SBAR(); qkt(pB0, pB1, K_lds + SHM_K, qr, r32, hi, sub);
    finishSM(pA0, pA1, alA, l_reg, pa0, pa1, pa2, pa3); SBAR();
    SLOAD(SO, j + 2); SBAR();
    pv_d0(o, vb0, pa0, pa1, pa2, pa3); partialSM(pB0, pB1, m_reg, mnB, alB);
    __syncthreads(); SWAIT(); SWRITE(0, SE);
    RESC(alB); __syncthreads();
    SBAR(); qkt(pA0, pA1, K_lds, qr, r32, hi, sub);
    finishSM(pB0, pB1, alB, l_reg, pa0, pa1, pa2, pa3); SBAR();
    if (j + 3 < NT) SLOAD(SE, j + 3); SBAR();
    pv_d0(o, vb0 + SHM_V, pa0, pa1, pa2, pa3); partialSM(pA0, pA1, m_reg, mnA, alA);
    __syncthreads(); SWAIT(); SWRITE(1, SO);
    RESC(alA); __syncthreads();
  }
  SBAR(); qkt(pB0, pB1, K_lds + SHM_K, qr, r32, hi, sub);
  finishSM(pA0, pA1, alA, l_reg, pa0, pa1, pa2, pa3); SBAR();
  pv_d0(o, vb0, pa0, pa1, pa2, pa3); partialSM(pB0, pB1, m_reg, mnB, alB);
  __syncthreads(); RESC(alB);
  finishSM(pB0, pB1, alB, l_reg, pa0, pa1, pa2, pa3); SBAR();
  pv_d0(o, vb0 + SHM_V, pa0, pa1, pa2, pa3);
  if (hi == 0) li_l[r32] = l_reg; asm volatile("s_waitcnt lgkmcnt(0)" ::: "memory");
  const float fac = sub ? lam : 1.f;
#pragma unroll
  for (int r = 0; r < 16; ++r) { const float rl = fac * __builtin_amdgcn_rcpf(li_l[crow(r, hi)]);
#pragma unroll
    for (int d0 = 0; d0 < 4; ++d0) o[d0][r] *= rl; }
  __syncthreads();
  float* XB = (float*)lds + pr * 4096;
  if (sub == 1) {
#pragma unroll
    for (int d0 = 0; d0 < 4; ++d0)
#pragma unroll
      for (int r = 0; r < 16; ++r) XB[(d0 * 16 + r) * 64 + lane] = o[d0][r];
  }
  __syncthreads();
  if (sub == 0) {
    float ss[16];
#pragma unroll
    for (int r = 0; r < 16; ++r) { float a = 0.f;
#pragma unroll
      for (int d0 = 0; d0 < 4; ++d0) { o[d0][r] -= XB[(d0 * 16 + r) * 64 + lane]; a += o[d0][r] * o[d0][r]; }
      ss[r] = a; }
#pragma unroll
    for (int r = 0; r < 16; ++r) {
#pragma unroll
      for (int off = 1; off < 32; off <<= 1) ss[r] += __shfl_xor(ss[r], off);
      ss[r] = rsqrtf(ss[r] * (1.f / 128.f) + EPS) * (1.f - lam_init);
    }
    float sw[4];
#pragma unroll
    for (int d0 = 0; d0 < 4; ++d0) sw[d0] = subln[d0 * 32 + r32];
#pragma unroll
    for (int r = 0; r < 16; ++r) { const long row = qrow0 + pr * QBLK + crow(r, hi);
      const bf16_t* gp = Pm + row * NP + C_GA + hh * 128 + r32; bf16_t* yp = Y + row * DM + hh * 128 + r32;
#pragma unroll
      for (int d0 = 0; d0 < 4; ++d0) { const float g = bf2f(gp[d0 * 32]); yp[d0 * 32] = f2bf(o[d0][r] * ss[r] * sw[d0] * (g / (1.f + __expf(-g)))); } }
  }
  __syncthreads();
#undef SLOAD
#undef SWRITE
#undef SWAIT
#undef RESC
}
__device__ __forceinline__ void attn_phase(const bf16_t* __restrict__ Pm, bf16_t* __restrict__ Y, const float* lq1, const float* lk1, const float* lq2, const float* lk2,
                                           const float* __restrict__ subln, float lam_init, bool ctx_out, char* lds) {
  const int lane = opaque_tid() & 63;
  const float lam = expf(wave_sum(lq1[lane] * lk1[lane])) - expf(wave_sum(lq2[lane] * lk2[lane])) + lam_init;
  const int G = gridDim.x, bx = blockIdx.x; const int vcu = (G % 8 == 0) ? (bx % 8) * (G / 8) + bx / 8 : bx;
  const int nunits = 1024 + (ctx_out ? 128 : 0);
  for (int u = vcu; u < nunits; u += G) {
    if (u < 1024) { const int bh = u >> 4, qb = u & 15, b = bh >> 3, hh = bh & 7; attn_unit(Pm, Y, (long)b * SEQ + qb * QROWS, b, hh, 36, lam, lam_init, subln, lds); }
    else { const int v = u - 1024, bh = v >> 1, qb = v & 1, b = bh >> 3, hh = bh & 7; attn_unit(Pm, Y, (long)NLAT + b * CTXL + qb * QROWS, b, hh, 4, lam, lam_init, subln, lds); }
  }
}
#undef KSWZ
#undef SBAR
}

namespace mls {
using bf16x8 = __attribute__((ext_vector_type(8))) short;
using s16x4  = __attribute__((ext_vector_type(4))) short;
using f32x4  = __attribute__((ext_vector_type(4))) float;
constexpr int QSTRB = 272, SSTRB = 144;
constexpr int L_Q = 0, L_K = L_Q + 64 * QSTRB, L_V = L_K + 64 * QSTRB, L_VW = L_V + 64 * SSTRB, L_S = L_VW + 64 * SSTRB, L_CT = L_S + 64 * SSTRB, L_SM = L_CT + 2 * 64 * QSTRB, L_END = L_SM + 3072;
static_assert(L_END <= 131072 && (L_K % 16) == 0 && (L_V % 16) == 0 && (L_VW % 16) == 0 && (L_S % 16) == 0 && (L_CT % 16) == 0 && (L_SM % 16) == 0, "mlstm LDS map");
__device__ __forceinline__ f32x4 mfma16(bf16x8 a, bf16x8 b, f32x4 c) { return __builtin_amdgcn_mfma_f32_16x16x32_bf16(a, b, c, 0, 0, 0); }
__device__ __forceinline__ bf16x8 tr_frag(unsigned addr, int rsb) {
  s16x4 lo, hi;
  asm volatile("ds_read_b64_tr_b16 %0, %1" : "=&v"(lo) : "v"(addr) : "memory");
  asm volatile("ds_read_b64_tr_b16 %0, %1" : "=&v"(hi) : "v"(addr + 4u * (unsigned)rsb) : "memory");
  asm volatile("s_waitcnt lgkmcnt(0)" : "+v"(lo), "+v"(hi) :: "memory");
  return (bf16x8){lo[0], lo[1], lo[2], lo[3], hi[0], hi[1], hi[2], hi[3]};
}

__device__ __forceinline__ void mlstm_unit(const bf16_t* __restrict__ Pm, const bf16_t* __restrict__ QKC  , const float* __restrict__ GATES,
                                           bf16_t* __restrict__ HM, const float* __restrict__ i_bias, const float* __restrict__ f_bias,
                                           int b, int head, int dir, int es, bool ctx_out, char* lds) {
  const int tid = opaque_tid(), wid = tid >> 6, lane = tid & 63, lr = lane & 15, kg = lane >> 4;
  char* q_lds = lds + L_Q; char* k_lds = lds + L_K; char* v_lds = lds + L_V; char* vw_lds = lds + L_VW; char* s_lds = lds + L_S; char* ct_lds = lds + L_CT;
  float* bl = (float*)(lds + L_SM); float* bsp = bl + 64; float* av = bsp + 64; float* wkl = av + 64; float* rs = wkl + 64; float* qn = rs + 256; float* nvec = qn + 64;
  const unsigned lds0 = (unsigned)(uintptr_t)lds;
  const unsigned trq = (unsigned)((8 * kg + (lr >> 2)) * QSTRB + (4 * (lr & 3)) * 2), trs = (unsigned)((8 * kg + (lr >> 2)) * SSTRB + (4 * (lr & 3)) * 2);
  for (int i = tid; i < 64 * QSTRB / 4; i += 512) ((unsigned*)ct_lds)[i] = 0u;
  if (tid < 128) nvec[tid] = 0.f;
  const float ibias = i_bias[dir * 4 + head], fbias = f_bias[dir * 4 + head];
  const int chg = tid & 31, rg = tid >> 5; const bool isk = chg >= 16;
  const int qkcol = 1024 + (isk ? 512 : 0) + head * 128 + (chg & 15) * 8;
  const int vrow = tid >> 3, vch = tid & 7;
  uint4 pq0, pq1, pq2, pq3, pv; float pgi, pgf;
#define MLS_LOAD(c_) do { const int c__ = (c_); const bool ic_ = c__ < 4; const int T_ = ic_ ? CTXL : SEQ, cc_ = ic_ ? c__ : c__ - 4; \
    const long rb_ = ic_ ? (long)(NLAT + b * CTXL) : (long)b * SEQ; const int t0_ = dir ? (T_ - 64 * (cc_ + 1)) : 64 * cc_; \
    { const bf16_t* qp_ = QKC + (rb_ + t0_ + rg) * DM + qkcol; pq0 = *(const uint4*)qp_; pq1 = *(const uint4*)(qp_ + 16 * DM); pq2 = *(const uint4*)(qp_ + 32 * DM); pq3 = *(const uint4*)(qp_ + 48 * DM); } \
    pv = *(const uint4*)(Pm + (rb_ + t0_ + vrow) * NP + C_VB + head * 256 + es * 64 + vch * 8); \
    const float* gr_ = GATES + (rb_ + t0_ + (dir ? 63 - lane : lane)) * 16; pgi = gr_[dir * 4 + head]; pgf = gr_[8 + dir * 4 + head]; } while (0)
  MLS_LOAD(0);
  f32x4 Cacc[4];
#pragma unroll
  for (int e = 0; e < 4; ++e) Cacc[e] = (f32x4){0.f, 0.f, 0.f, 0.f};
  __syncthreads();
  for (int c = 0; c < 36; ++c) {
    const bool isctx = c < 4; const int T = isctx ? CTXL : SEQ, cc = isctx ? c : c - 4;
    const long rowbase = isctx ? (long)(NLAT + b * CTXL) : (long)b * SEQ;
    const int t0 = dir ? (T - 64 * (cc + 1)) : 64 * cc;
    const bool need_h = ctx_out || !isctx;
    char* ct_cur = ct_lds + (c & 1) * 64 * QSTRB; char* ct_nxt = ct_lds + ((c + 1) & 1) * 64 * QSTRB;
    float gamma, wk_l;
    {
      const float igv = 15.f * tanhf((pgi + ibias) * (1.f / 15.f));
      const float fc = 15.f * tanhf((pgf + fbias) * (1.f / 15.f));
      float bcum = fminf(fc, 0.f) - log1pf(expf(-fabsf(fc)));
#pragma unroll
      for (int off = 1; off < 64; off <<= 1) { const float y = __shfl_up(bcum, off); if (lane >= off) bcum += y; }
      const float b63 = __shfl(bcum, 63);
      gamma = __expf(b63); wk_l = __expf(b63 - bcum + igv);
      if (wid == 0) { bl[lane] = bcum; bsp[lane] = bcum - igv; av[lane] = __expf(bcum); wkl[lane] = wk_l; }
    }
    { char* dst = (isk ? k_lds : q_lds) + (chg & 15) * 16;
      *(uint4*)(dst + (dir ? 63 - rg : rg) * QSTRB) = pq0; *(uint4*)(dst + (dir ? 47 - rg : rg + 16) * QSTRB) = pq1;
      *(uint4*)(dst + (dir ? 31 - rg : rg + 32) * QSTRB) = pq2; *(uint4*)(dst + (dir ? 15 - rg : rg + 48) * QSTRB) = pq3; }
    { const int l = dir ? 63 - vrow : vrow; const float wkv = __shfl(wk_l, l);
      *(uint4*)(v_lds + l * SSTRB + vch * 16) = pv;
      const unsigned vv[4] = {pv.x, pv.y, pv.z, pv.w}; uint4 w;
      w.x = pk2(__uint_as_float(vv[0] << 16) * wkv, __uint_as_float(vv[0] & 0xffff0000u) * wkv); w.y = pk2(__uint_as_float(vv[1] << 16) * wkv, __uint_as_float(vv[1] & 0xffff0000u) * wkv);
      w.z = pk2(__uint_as_float(vv[2] << 16) * wkv, __uint_as_float(vv[2] & 0xffff0000u) * wkv); w.w = pk2(__uint_as_float(vv[3] << 16) * wkv, __uint_as_float(vv[3] & 0xffff0000u) * wkv);
      *(uint4*)(vw_lds + l * SSTRB + vch * 16) = w; }
    if (c + 1 < 36) MLS_LOAD(c + 1);
    __syncthreads();
    if (need_h) {
      const int lblk = wid >> 1;
#pragma unroll
      for (int u2 = 0; u2 < 2; ++u2) {
        const int sblk = 2 * (wid & 1) + u2;
        if (sblk <= lblk) {
          f32x4 acc = {0.f, 0.f, 0.f, 0.f};
#pragma unroll
          for (int ks = 0; ks < 4; ++ks) {
            const bf16x8 ka = *(const bf16x8*)(k_lds + (sblk * 16 + lr) * QSTRB + (ks * 32 + 8 * kg) * 2);
            const bf16x8 qb = *(const bf16x8*)(q_lds + (lblk * 16 + lr) * QSTRB + (ks * 32 + 8 * kg) * 2);
            acc = mfma16(ka, qb, acc);
          }
          const int l = lblk * 16 + lr; const float blv = bl[l];
          float v4[4]; float sum = 0.f;
#pragma unroll
          for (int r = 0; r < 4; ++r) { const int sidx = sblk * 16 + 4 * kg + r; const float w = (sidx <= l) ? __expf(blv - bsp[sidx]) : 0.f; v4[r] = acc[r] * w; sum += v4[r]; }
          uint2 w; w.x = pk2(v4[0], v4[1]); w.y = pk2(v4[2], v4[3]);
          *(uint2*)(s_lds + l * SSTRB + (sblk * 16 + 4 * kg) * 2) = w;
          sum += __shfl_xor(sum, 16); sum += __shfl_xor(sum, 32);
          if (kg == 0) rs[sblk * 64 + l] = sum;
        } else if ((lblk == 0 && sblk == 1) || (lblk == 2 && sblk == 3)) {
          *(uint2*)(s_lds + (lblk * 16 + lr) * SSTRB + (sblk * 16 + 4 * kg) * 2) = make_uint2(0u, 0u);
        }
      }
      { const int l = tid >> 3, part = tid & 7; float a = 0.f;
        const unsigned* qp = (const unsigned*)(q_lds + l * QSTRB + part * 32);
#pragma unroll
        for (int i = 0; i < 8; ++i) { const unsigned wd = qp[i]; a += __uint_as_float(wd << 16) * nvec[part * 16 + 2 * i] + __uint_as_float(wd & 0xffff0000u) * nvec[part * 16 + 2 * i + 1]; }
        a += __shfl_xor(a, 1); a += __shfl_xor(a, 2); a += __shfl_xor(a, 4);
        if (part == 0) qn[l] = a; }
    }
    __syncthreads();
    if (need_h) {
      const int lblk = wid >> 1; const int l = lblk * 16 + lr;
      float d = av[l] * qn[l];
      for (int sb = 0; sb <= lblk; ++sb) d += rs[sb * 64 + l];
      const float a_l = av[l], dinv = 1.f / fmaxf(fabsf(d), 1.f);
      bf16x8 qb[4];
#pragma unroll
      for (int ks = 0; ks < 4; ++ks) qb[ks] = *(const bf16x8*)(q_lds + l * QSTRB + (ks * 32 + 8 * kg) * 2);
      const bf16x8 sb0 = *(const bf16x8*)(s_lds + l * SSTRB + (8 * kg) * 2);
      bf16x8 sb1 = sb0; if (lblk >= 2) sb1 = *(const bf16x8*)(s_lds + l * SSTRB + (32 + 8 * kg) * 2);
      const int t = dir ? (t0 + 63 - l) : (t0 + l);
      bf16_t* hp = HM + ((size_t)dir * NTOK + rowbase + t) * 1024 + head * 256 + es * 64 + 4 * kg;
#pragma unroll
      for (int u2 = 0; u2 < 2; ++u2) {
        const int eblk = 2 * (wid & 1) + u2;
        f32x4 acc1 = {0.f, 0.f, 0.f, 0.f}, acc2 = {0.f, 0.f, 0.f, 0.f};
#pragma unroll
        for (int ks = 0; ks < 4; ++ks) { const bf16x8 ca = *(const bf16x8*)(ct_cur + (eblk * 16 + lr) * QSTRB + (ks * 32 + 8 * kg) * 2); acc1 = mfma16(ca, qb[ks], acc1); }
        { const bf16x8 va = tr_frag(lds0 + L_V + trs + (unsigned)(eblk * 32), SSTRB); acc2 = mfma16(va, sb0, acc2); }
        if (lblk >= 2) { const bf16x8 va = tr_frag(lds0 + L_V + trs + (unsigned)(32 * SSTRB + eblk * 32), SSTRB); acc2 = mfma16(va, sb1, acc2); }
        uint2 w; w.x = pk2((a_l * acc1[0] + acc2[0]) * dinv, (a_l * acc1[1] + acc2[1]) * dinv); w.y = pk2((a_l * acc1[2] + acc2[2]) * dinv, (a_l * acc1[3] + acc2[3]) * dinv);
        *(uint2*)(hp + eblk * 16) = w;
      }
    }
    {
      const int dblk = wid;
      const bf16x8 ka0 = tr_frag(lds0 + L_K + trq + (unsigned)(dblk * 32), QSTRB), ka1 = tr_frag(lds0 + L_K + trq + (unsigned)(32 * QSTRB + dblk * 32), QSTRB);
#pragma unroll
      for (int eblk = 0; eblk < 4; ++eblk) {
        const bf16x8 vb0 = tr_frag(lds0 + L_VW + trs + (unsigned)(eblk * 32), SSTRB), vb1 = tr_frag(lds0 + L_VW + trs + (unsigned)(32 * SSTRB + eblk * 32), SSTRB);
        f32x4 cc_ = Cacc[eblk] * gamma;
        cc_ = mfma16(ka0, vb0, cc_); cc_ = mfma16(ka1, vb1, cc_);
        Cacc[eblk] = cc_;
        uint2 w; w.x = pk2(cc_[0], cc_[1]); w.y = pk2(cc_[2], cc_[3]);
        *(uint2*)(ct_nxt + (eblk * 16 + lr) * QSTRB + (dblk * 16 + 4 * kg) * 2) = w;
      }
      if (tid < 128) { float a = gamma * nvec[tid]; const bf16_t* kp = (const bf16_t*)k_lds + tid;
#pragma unroll 8
        for (int sidx = 0; sidx < 64; ++sidx) a += bf2f(kp[sidx * (QSTRB / 2)]) * wkl[sidx];
        nvec[tid] = a; }
    }
    __syncthreads();
  }
#undef MLS_LOAD
}
__device__ __forceinline__ void qkconv_phase(const bf16_t* __restrict__ Pm, bf16_t* __restrict__ QKC, const float* __restrict__ conv_w, const float* __restrict__ conv_b) {
  const int tid = opaque_tid(), lane = tid & 63, wave = tid >> 6;
  const int gw = blockIdx.x * 8 + wave, ngw = gridDim.x * 8;
  const int half = gw & 1, c0 = half * 512 + lane * 8;
  float cw0[8], cw1[8], cw2[8], cbv[8];
#pragma unroll
  for (int i = 0; i < 8; ++i) { cw0[i] = conv_w[c0 + i]; cw1[i] = conv_w[1024 + c0 + i]; cw2[i] = conv_w[2048 + c0 + i]; cbv[i] = conv_b[c0 + i]; }
  const float osc = half ? 0.08838834764831845f : 1.f;
  for (int it = gw >> 1; it < NTOK / 8; it += ngw >> 1) {
    const int r0 = it * 8; const bool isl = r0 < NLAT; const int seq0 = isl ? (r0 / SEQ) * SEQ : NLAT + ((r0 - NLAT) / CTXL) * CTXL, T = isl ? SEQ : CTXL;
    uint4 x[10];
#pragma unroll
    for (int r = 0; r < 10; ++r) { const int t = r0 - seq0 - 1 + r; x[r] = (t >= 0 && t < T) ? *(const uint4*)(Pm + (size_t)(seq0 + t) * NP + C_QB + c0) : make_uint4(0u, 0u, 0u, 0u); }
#pragma unroll
    for (int r = 0; r < 8; ++r) {
      const unsigned a0[4] = {x[r].x, x[r].y, x[r].z, x[r].w}, a1[4] = {x[r + 1].x, x[r + 1].y, x[r + 1].z, x[r + 1].w}, a2[4] = {x[r + 2].x, x[r + 2].y, x[r + 2].z, x[r + 2].w};
      float o[8];
#pragma unroll
      for (int i = 0; i < 8; ++i) {
        const float v0 = (i & 1) ? __uint_as_float(a0[i >> 1] & 0xffff0000u) : __uint_as_float(a0[i >> 1] << 16);
        const float v1 = (i & 1) ? __uint_as_float(a1[i >> 1] & 0xffff0000u) : __uint_as_float(a1[i >> 1] << 16);
        const float v2 = (i & 1) ? __uint_as_float(a2[i >> 1] & 0xffff0000u) : __uint_as_float(a2[i >> 1] << 16);
        const float z = cbv[i] + cw0[i] * v0 + cw1[i] * v1 + cw2[i] * v2;
        o[i] = osc * z / (1.f + __expf(-z));
      }
      uint4 w; w.x = pk2(o[0], o[1]); w.y = pk2(o[2], o[3]); w.z = pk2(o[4], o[5]); w.w = pk2(o[6], o[7]);
      *(uint4*)(QKC + (size_t)(r0 + r) * DM + 1024 + c0) = w;
    }
  }
}
__device__ __forceinline__ void mlstm_phase(const bf16_t* __restrict__ Pm, const bf16_t* __restrict__ QKC, const float* __restrict__ GATES, bf16_t* __restrict__ HM,
                                            const float* __restrict__ i_bias, const float* __restrict__ f_bias, bool ctx_out, char* lds) {
  const int G = gridDim.x, bx = blockIdx.x; const int vcu = (G % 8 == 0) ? (bx % 8) * (G / 8) + bx / 8 : bx;
  for (int u = vcu; u < 256; u += G) { const int es = u & 3, dir = (u >> 2) & 1, head = (u >> 3) & 3, b = u >> 5; mlstm_unit(Pm, QKC, GATES, HM, i_bias, f_bias, b, head, dir, es, ctx_out, lds); }
}
}

DEVI void mod_unit(int unit, const float* __restrict__ c, const float* __restrict__ c_ctx, const float* __restrict__ w_ada, const float* __restrict__ b_ada, float* __restrict__ MOD, float* ldsf) {
    const int tid = opaque_tid(), ci = tid & 63, kgp = tid >> 6;
    const int l = unit / 96, cb = unit % 96;
    float* sc = ldsf; float* red = ldsf + 9 * DM;
    for (int i = tid; i < 9 * DM; i += 512) { const float v = (i < 8 * DM) ? c[i] : c_ctx[i - 8 * DM]; sc[i] = silu_f(v); }
    __syncthreads();
    float acc[9];
#pragma unroll
    for (int r = 0; r < 9; ++r) acc[r] = 0.f;
    const float* w = w_ada + (size_t)l * DM * MODW + cb * 64 + ci;
#pragma unroll 8
    for (int k = kgp * 256; k < kgp * 256 + 256; ++k) {
        const float wv = w[(size_t)k * MODW];
#pragma unroll
        for (int r = 0; r < 9; ++r) acc[r] += sc[r * DM + k] * wv;
    }
#pragma unroll
    for (int r = 0; r < 9; ++r) red[(kgp * 9 + r) * 64 + ci] = acc[r];
    __syncthreads();
    for (int idx = tid; idx < 9 * 64; idx += 512) {
        const int r = idx >> 6, cc = idx & 63; float s = 0.f;
#pragma unroll
        for (int g = 0; g < 8; ++g) s += red[(g * 9 + r) * 64 + cc];
        MOD[(size_t)(l * 9 + r) * MODW + cb * 64 + cc] = s + b_ada[l * MODW + cb * 64 + cc];
    }
    __syncthreads();
}
DEVI void transpose_items(const float* __restrict__ W, int ldw, int K, int N, bf16_t* __restrict__ WT, float* scr, int gw, int ngw, int lane) {
    const int nitems = (K / 64) * (N / 32);
    for (int it = gw; it < nitems; it += ngw) transpose_item(W, ldw, K, N, WT, scr, it, lane);
}
DEVI void finish_row(const bf16_t* __restrict__ P, const bf16_t* __restrict__ HM, const float* __restrict__ mnorm, bf16_t* __restrict__ Y, int row, int lane) {
#pragma unroll
    for (int head = 0; head < 4; ++head) {
        const int col = head * 256 + 4 * lane;
        const uint2 a = *(const uint2*)(HM + (size_t)row * 1024 + col), c = *(const uint2*)(HM + ((size_t)NTOK + row) * 1024 + col);
        float h[4];
        h[0] = __uint_as_float(a.x << 16) + __uint_as_float(c.x << 16); h[1] = __uint_as_float(a.x & 0xffff0000u) + __uint_as_float(c.x & 0xffff0000u);
        h[2] = __uint_as_float(a.y << 16) + __uint_as_float(c.y << 16); h[3] = __uint_as_float(a.y & 0xffff0000u) + __uint_as_float(c.y & 0xffff0000u);
        const float ss = wave_sum(h[0] * h[0] + h[1] * h[1] + h[2] * h[2] + h[3] * h[3]);
        const float r = rsqrtf(ss * (1.f / 256.f) + EPS);
        const uint2 ov = *(const uint2*)(P + (size_t)row * NP + C_OB + col), gv = *(const uint2*)(P + (size_t)row * NP + C_GB + col);
        const float o[4] = {__uint_as_float(ov.x << 16), __uint_as_float(ov.x & 0xffff0000u), __uint_as_float(ov.y << 16), __uint_as_float(ov.y & 0xffff0000u)};
        const float g[4] = {__uint_as_float(gv.x << 16), __uint_as_float(gv.x & 0xffff0000u), __uint_as_float(gv.y << 16), __uint_as_float(gv.y & 0xffff0000u)};
        const float4 w = *(const float4*)(mnorm + col);
        const float wv[4] = {w.x, w.y, w.z, w.w};
        float y[4];
#pragma unroll
        for (int e = 0; e < 4; ++e) y[e] = h[e] * r * wv[e] * sigmoid_f(o[e]) * silu_f(g[e]);
        uint2 out; out.x = pk2(y[0], y[1]); out.y = pk2(y[2], y[3]);
        *(uint2*)(Y + (size_t)row * DM + 1024 + col) = out;
    }
}
DEVI void load_row(const float* __restrict__ xr, float4 (&v)[8], int lane) {
#pragma unroll
    for (int j = 0; j < 8; ++j) v[j] = ((const float4*)xr)[lane + 64 * j];
}
DEVI void post_regs(float4 (&v)[8], const bf16_t* __restrict__ y2row, const float* __restrict__ gate, const float* __restrict__ npost, float* __restrict__ orow, int lane) {
    uint2 yv[8]; float ss = 0.f;
#pragma unroll
    for (int j = 0; j < 8; ++j) {
        yv[j] = *(const uint2*)(y2row + 4 * (lane + 64 * j));
        const float y0 = __uint_as_float(yv[j].x << 16), y1 = __uint_as_float(yv[j].x & 0xffff0000u), y2 = __uint_as_float(yv[j].y << 16), y3 = __uint_as_float(yv[j].y & 0xffff0000u);
        ss += y0 * y0 + y1 * y1 + y2 * y2 + y3 * y3;
    }
    ss = wave_sum(ss);
    const float rstd = rsqrtf(ss * (1.f / DM) + EPS);
#pragma unroll
    for (int j = 0; j < 8; ++j) {
        const int k0 = 4 * (lane + 64 * j);
        const float4 gt = *(const float4*)(gate + k0), w = *(const float4*)(npost + k0);
        const float y0 = __uint_as_float(yv[j].x << 16), y1 = __uint_as_float(yv[j].x & 0xffff0000u), y2 = __uint_as_float(yv[j].y << 16), y3 = __uint_as_float(yv[j].y & 0xffff0000u);
        v[j].x += gt.x * (y0 * rstd * w.x); v[j].y += gt.y * (y1 * rstd * w.y); v[j].z += gt.z * (y2 * rstd * w.z); v[j].w += gt.w * (y3 * rstd * w.w);
        *(float4*)(orow + k0) = v[j];
        asm volatile("" ::: "memory");
    }
}
DEVI void norm_regs(const float4 (&v)[8], const float* __restrict__ shift, const float* __restrict__ scale, const float* __restrict__ npre, bf16_t* __restrict__ hrow, char* trow, int lane) {
    float ss = 0.f;
#pragma unroll
    for (int j = 0; j < 8; ++j) ss += v[j].x * v[j].x + v[j].y * v[j].y + v[j].z * v[j].z + v[j].w * v[j].w;
    ss = wave_sum(ss);
    const float rstd = rsqrtf(ss * (1.f / DM) + EPS);
#pragma unroll
    for (int j = 0; j < 8; ++j) {
        const int k0 = 4 * (lane + 64 * j);
        const float4 w = *(const float4*)(npre + k0), sh = *(const float4*)(shift + k0), sc = *(const float4*)(scale + k0);
        uint2 o;
        o.x = pk2(v[j].x * rstd * w.x * (1.f + sc.x) + sh.x, v[j].y * rstd * w.y * (1.f + sc.y) + sh.y);
        o.y = pk2(v[j].z * rstd * w.z * (1.f + sc.z) + sh.z, v[j].w * rstd * w.w * (1.f + sc.w) + sh.w);
        *(uint2*)(hrow + k0) = o; *(uint2*)(trow + k0 * 2) = o;
        asm volatile("" ::: "memory");
    }
}
constexpr int NT_ROWB = (DM + 8) * 2;
template <bool POST>
DEVI void norm_phase(const float* __restrict__ xlat, const float* __restrict__ xctx, const bf16_t* __restrict__ Y2, const float* __restrict__ mod_post, const float* __restrict__ npost,
                     float* olat, float* octx, const float* __restrict__ mod_n, const float* __restrict__ npre, const float* __restrict__ wg, bf16_t* __restrict__ H,
                     float* __restrict__ GATES, char* lds) {
    typedef short bf16x8 __attribute__((ext_vector_type(8))); typedef float f32x4 __attribute__((ext_vector_type(4)));
    const int tid = opaque_tid(), lane = tid & 63, wave = tid >> 6, lr = lane & 15, kgp = lane >> 4;
    char* tile = lds; float* red = (float*)(lds + 8 * NT_ROWB);
    bf16x8 bfrag[8];
    {
        const float* wp = wg + (size_t)(wave * 256 + 8 * kgp) * INC + lr;
#pragma unroll
        for (int ks = 0; ks < 8; ++ks) {
            unsigned w4[4];
#pragma unroll
            for (int q = 0; q < 4; ++q) { w4[q] = pk2(wp[0], wp[INC]); wp += 2 * INC; asm volatile("" : "+v"(wp)); }
            wp += (size_t)24 * INC; asm volatile("" : "+v"(wp));
            bfrag[ks] = __builtin_bit_cast(bf16x8, make_uint4(w4[0], w4[1], w4[2], w4[3]));
        }
    }
    for (int grp = blockIdx.x; grp < NTOK / 8; grp += gridDim.x) {
        const int row = grp * 8 + wave; const bool isl = row < NLAT; const int b = isl ? row / SEQ : 8;
        {
            float4 v[8];
            load_row(isl ? xlat + (size_t)row * DM : xctx + (size_t)(row - NLAT) * DM, v, lane);
            if (POST) post_regs(v, Y2 + (size_t)row * DM, mod_post + (size_t)b * MODW + 2 * DM, npost, isl ? olat + (size_t)row * DM : octx + (size_t)(row - NLAT) * DM, lane);
            norm_regs(v, mod_n + (size_t)b * MODW, mod_n + (size_t)b * MODW + DM, npre, H + (size_t)row * DM, tile + wave * NT_ROWB, lane);
        }
        __syncthreads();
        f32x4 acc = {0.f, 0.f, 0.f, 0.f};
#pragma unroll
        for (int ks = 0; ks < 8; ++ks) {
            bf16x8 af = {0, 0, 0, 0, 0, 0, 0, 0};
            if (lr < 8) af = *(const bf16x8*)(tile + lr * NT_ROWB + (wave * 256 + ks * 32 + 8 * kgp) * 2);
            acc = __builtin_amdgcn_mfma_f32_16x16x32_bf16(af, bfrag[ks], acc, 0, 0, 0);
        }
        if (kgp < 2) {
#pragma unroll
            for (int r = 0; r < 4; ++r) red[(wave * 8 + 4 * kgp + r) * 16 + lr] = acc[r];
        }
        __syncthreads();
        if (tid < 128) { const int rr = tid >> 4, cc = tid & 15; float sum = 0.f;
#pragma unroll
            for (int w8 = 0; w8 < 8; ++w8) sum += red[(w8 * 8 + rr) * 16 + cc];
            GATES[(size_t)(grp * 8 + rr) * 16 + cc] = sum; }
    }
    __syncthreads();
}

#define XB_TMO      128
#define XB_XCNT(j)  (256  + 64 * (j))
#define XB_XSUB(j)  (1280 + 64 * (j))
#define XB_XGEN(j)  (2304 + 64 * (j))
#define XB_TOP      3328
#define XB_TOPGEN   3392
#define XCD_BAR_WORDS 3456
#define XB_SPIN_CAP (1u << 18)

__device__ __forceinline__ unsigned xb_ld(unsigned* p)              { return __hip_atomic_load(p, __ATOMIC_RELAXED, __HIP_MEMORY_SCOPE_AGENT); }
__device__ __forceinline__ unsigned xb_add(unsigned* p, unsigned v) { return __hip_atomic_fetch_add(p, v, __ATOMIC_RELAXED, __HIP_MEMORY_SCOPE_AGENT); }
__device__ __forceinline__ unsigned xb_xcc_id() { return (unsigned)__builtin_amdgcn_s_getreg((3 << 11) | 20) & 0xFu; }
#define XB_SPIN(cond, bar) do { unsigned _sp = 0; while (cond) { __builtin_amdgcn_s_sleep(1); \
    if ((++_sp & 255u) == 0u) { if (xb_ld(&(bar)[XB_TMO])) break; if (_sp > XB_SPIN_CAP) { atomicAdd(&(bar)[XB_TMO], 1u); break; } } } } while (0)

struct XcdBarrier {
    unsigned* bar; unsigned x;
    volatile __attribute__((address_space(3))) unsigned* st;
};

__device__ __forceinline__ XcdBarrier xcd_barrier_post(unsigned* bar, volatile __attribute__((address_space(3))) unsigned* st) {
    XcdBarrier b; b.bar = bar; b.x = xb_xcc_id(); b.st = st;
    if (threadIdx.x == 0) (void)xb_add(&bar[XB_XCNT(b.x)], 1u);
    return b;
}
__device__ __forceinline__ void xcd_barrier_complete(unsigned* bar, unsigned x, unsigned& nloc, unsigned& nx) {
    const unsigned G = gridDim.x * gridDim.y * gridDim.z;
    unsigned sum, cnt, mine, sp = 0u;
    for (;;) {
        sum = 0u; cnt = 0u; mine = 0u;
#pragma unroll
        for (unsigned j = 0; j < 16; ++j) { const unsigned c = xb_ld(&bar[XB_XCNT(j)]); sum += c; cnt += (c > 0u) ? 1u : 0u; mine = (j == x) ? c : mine; }
        if (sum == G) break;
        __builtin_amdgcn_s_sleep(1);
        if ((++sp & 255u) == 0u) { if (xb_ld(&bar[XB_TMO])) break; if (sp > XB_SPIN_CAP) { atomicAdd(&bar[XB_TMO], 1u); break; } }
    }
    nloc = mine > 0u ? mine : 1u; nx = cnt > 0u ? cnt : 1u;
}

__device__ __forceinline__ void xcd_barrier(const XcdBarrier& b) {
    asm volatile("s_waitcnt vmcnt(0)" ::: "memory");
    __syncthreads();
    if (threadIdx.x == 0) {
        unsigned* bar = b.bar;
        __builtin_amdgcn_s_waitcnt(0);
        unsigned nloc = b.st[0], nx = b.st[1];
        if (nloc == 0u) { xcd_barrier_complete(bar, b.x, nloc, nx); b.st[0] = nloc; b.st[1] = nx; }
        const unsigned old = xb_add(&bar[XB_XSUB(b.x)], 1u);
        const unsigned gen = old / nloc;
        if (old + 1u == (gen + 1u) * nloc) {
            __builtin_amdgcn_fence(__ATOMIC_RELEASE, "agent");
            asm volatile("s_waitcnt vmcnt(0)" ::: "memory");
            const unsigned og = xb_add(&bar[XB_TOP], 1u);
            const unsigned tg = og / nx;
            if (og + 1u == (tg + 1u) * nx) xb_add(&bar[XB_TOPGEN], 1u);
            else XB_SPIN(xb_ld(&bar[XB_TOPGEN]) == tg, bar);
            __builtin_amdgcn_fence(__ATOMIC_ACQUIRE, "agent");
            xb_add(&bar[XB_XGEN(b.x)], 1u);
            asm volatile("s_waitcnt vmcnt(0)" ::: "memory");
        } else {
            XB_SPIN(xb_ld(&bar[XB_XGEN(b.x)]) == gen, bar);
            __builtin_amdgcn_fence(__ATOMIC_ACQUIRE, "agent");
            asm volatile("s_waitcnt vmcnt(0)" ::: "memory");
        }
    }
    __syncthreads();
}

namespace cg = cooperative_groups;
#ifndef PROBE_DUP
#define PROBE_DUP 0
#endif
#define DUPN(k) ((PROBE_DUP == (k)) ? 2 : 1)
constexpr int MEGA_LDS = 131072 + 256;
struct MegaArgs { const float* in[20]; float* out; unsigned char* ws; };
__global__ __launch_bounds__(512, 2) void mega_fwd(MegaArgs a) {
    extern __shared__ __attribute__((aligned(16))) unsigned char lds[];
    cg::grid_group grid = cg::this_grid();
    volatile __attribute__((address_space(3))) unsigned* MISC = (volatile __attribute__((address_space(3))) unsigned*)((__attribute__((address_space(3))) unsigned char*)lds + 131072);
    if (threadIdx.x < 64) MISC[threadIdx.x] = 0u;
    __syncthreads();
    const XcdBarrier bar = xcd_barrier_post((unsigned*)(a.ws + WS_CTL) + 4096, MISC + 8);
    const int G = gridDim.x;
#define PHASE_IDS const int tid = opaque_tid(), lane = tid & 63, wave = tid >> 6, gw = blockIdx.x * 8 + wave, ngw = G * 8; (void)tid; (void)lane; (void)gw; (void)ngw; float* scr = (float*)lds + wave * (64 * 33); (void)scr
    const float* x = a.in[0]; const float* c = a.in[1]; const float* ctx = a.in[2]; const float* c_ctx = a.in[3];
    const float* w_ada = a.in[4]; const float* b_ada = a.in[5]; const float* norm_pre = a.in[6]; const float* norm_post = a.in[7];
    const float* w_in = a.in[8]; const float* w_out = a.in[9];
    float* out = a.out; unsigned char* ws = a.ws;
    float* MOD = (float*)(ws + WS_MOD); float* ROPE = (float*)(ws + WS_ROPE); float* GATES = (float*)(ws + WS_GATES);
    bf16_t* WOUT = (bf16_t*)(ws + WS_WOUT); bf16_t* WIN = (bf16_t*)(ws + WS_WIN); float* XC = (float*)(ws + WS_XC);
    bf16_t* H = (bf16_t*)(ws + WS_H); bf16_t* HM = (bf16_t*)(ws + WS_HM); bf16_t* P = (bf16_t*)(ws + WS_P);
    bf16_t* Y = H; bf16_t* Y2 = HM;

    { PHASE_IDS;
    for (int u = blockIdx.x; u < 192; u += G) mod_unit(u, c, c_ctx, w_ada, b_ada, MOD, (float*)lds);
    for (int i = blockIdx.x * 512 + tid; i < 1024; i += G * 512) { const int pos = i >> 4, f = i & 15; const float inv = powf(10000.f, -(float)f / 16.f); const float ang = (float)pos * inv;
        ROPE[2 * i] = cosf(ang); ROPE[2 * i + 1] = sinf(ang); }
    transpose_items(w_in, INC, DM, NP, WIN, scr, gw, ngw, lane);
    transpose_items(w_out, DM, DM, DM, WOUT, scr, gw, ngw, lane);
    transpose_items(w_out + (size_t)DM * DM, DM, DM, DM, WOUT + (size_t)DM * DM, scr, gw, ngw, lane); }
    grid.sync();
    norm_phase<false>(x, ctx, nullptr, nullptr, nullptr, nullptr, nullptr, MOD, norm_pre, w_in + NP, H, GATES, (char*)lds);
    xcd_barrier(bar);
    for (int l = 0; l < 2; ++l) {
        const float lam_init = l == 0 ? 0.2f : 0.35550906759f;
        const float* mod_l = MOD + (size_t)l * 9 * MODW;
        for (int rep_ = 0; rep_ < DUPN(2); ++rep_)
        { pg8::Gemm g{H, WIN, NTOK, NP, DM}; pg8::StaticOrder S; S.init(NTOK, NP, G, (int)blockIdx.x); pg8::EpiInProj E{P, NP, ROPE};
          pg8::gemm_phase<pg8::EpiInProj, pg8::StaticOrder, true, true>((PG8_LAS unsigned char*)lds, g, S, E); }
        xcd_barrier(bar);
        mls::qkconv_phase(P, Y, a.in[15] + (size_t)l * 3 * 1024, a.in[16] + l * 1024);
        xcd_barrier(bar);
        for (int rep_ = 0; rep_ < DUPN(3); ++rep_)
        mls::mlstm_phase(P, Y, GATES, HM, a.in[17] + l * 8, a.in[18] + l * 8, l == 0, (char*)lds);
        for (int rep_ = 0; rep_ < DUPN(4); ++rep_)
        att::attn_phase(P, Y, a.in[10] + l * 64, a.in[11] + l * 64, a.in[12] + l * 64, a.in[13] + l * 64, a.in[14] + l * 128, lam_init, l == 0, (char*)lds);
        xcd_barrier(bar);
        { PHASE_IDS; const int nrows = l == 0 ? NTOK : NLAT; for (int row = gw; row < nrows; row += ngw) finish_row(P, HM, a.in[19] + l * 1024, Y, row, lane); }
        xcd_barrier(bar);
        for (int rep_ = 0; rep_ < DUPN(5); ++rep_)
        { const int M = l == 0 ? NTOK : NLAT; pg8::Gemm g{Y, WOUT + (size_t)l * DM * DM, M, DM, DM}; pg8::StaticOrder S; S.init(M, DM, G, (int)blockIdx.x); pg8::EpiBf16 E{Y2, DM};
          pg8::gemm_phase<pg8::EpiBf16, pg8::StaticOrder, true, true>((PG8_LAS unsigned char*)lds, g, S, E); }
        if (l == 0) { PHASE_IDS;
            const int nbusy = (NTOK / 256) * (DM / 256) - 2 * G;
            if (nbusy >= 0 && nbusy < G) { if ((int)blockIdx.x >= nbusy) transpose_items(w_in + (size_t)DM * INC, INC, DM, NP, WIN, scr, ((int)blockIdx.x - nbusy) * 8 + wave, (G - nbusy) * 8, lane); }
            else transpose_items(w_in + (size_t)DM * INC, INC, DM, NP, WIN, scr, gw, ngw, lane);
        }
        xcd_barrier(bar);
        if (l == 0) {
            norm_phase<true>(x, ctx, Y2, mod_l, norm_post, out, XC, MOD + (size_t)9 * MODW, norm_pre + DM, w_in + (size_t)DM * INC + NP, H, GATES, (char*)lds);
            xcd_barrier(bar);
        } else { PHASE_IDS;
            for (int row = gw; row < NLAT; row += ngw) {
                float4 v[8];
                load_row(out + (size_t)row * DM, v, lane);
                post_regs(v, Y2 + (size_t)row * DM, mod_l + (size_t)(row / SEQ) * MODW + 2 * DM, norm_post + DM, out + (size_t)row * DM, lane);
            }
        }
    }
}

extern "C" void kernel_launch(void* const* d_in, const int* in_sizes, int n_in, void* d_out, int out_size, void* d_ws, size_t ws_size, hipStream_t stream) {
    (void)in_sizes; (void)n_in; (void)out_size; (void)ws_size;
    static int grid_blocks = 0;
    if (!grid_blocks) {
        int dev = 0, cus = 0, per_cu = 0;
        (void)hipGetDevice(&dev);
        (void)hipDeviceGetAttribute(&cus, hipDeviceAttributeMultiprocessorCount, dev);
        (void)hipFuncSetAttribute((const void*)mega_fwd, hipFuncAttributeMaxDynamicSharedMemorySize, MEGA_LDS);
        (void)hipOccupancyMaxActiveBlocksPerMultiprocessor(&per_cu, (const void*)mega_fwd, 512, MEGA_LDS);
        if (per_cu < 1) per_cu = 1;
        if (per_cu > 1) per_cu = 1;
        grid_blocks = cus * per_cu;
    }
    (void)hipMemsetAsync((char*)d_ws + WS_CTL, 0, 65536, stream);
    MegaArgs a{};
    for (int i = 0; i < 20; ++i) a.in[i] = (const float*)d_in[i];
    a.out = (float*)d_out; a.ws = (unsigned char*)d_ws;
    void* args[] = {&a};
    (void)hipLaunchCooperativeKernel((const void*)mega_fwd, dim3(grid_blocks), dim3(512), args, (size_t)MEGA_LDS, stream);
}
```

```cpp
#include <hip/hip_runtime.h>
#include <hip/hip_cooperative_groups.h>
#include <stdint.h>
#include <math.h>

#define DEVI __device__ __forceinline__
typedef unsigned short bf16_t;

constexpr int DM = 2048, NBATCH = 8, SEQ = 2048, CTXL = 256;
constexpr int NLAT = NBATCH * SEQ, NCTX = NBATCH * CTXL, NTOK = NLAT + NCTX;
constexpr int INC = 8208, NP = 8192, MODW = 6144;
constexpr int C_QA = 0, C_KA = 1024, C_VA = 2048, C_GA = 3072, C_QB = 4096, C_KB = 4608, C_VB = 5120, C_OB = 6144, C_GB = 7168;
constexpr float EPS = 1e-6f;

constexpr size_t MiB = (size_t)1 << 20;
constexpr size_t WS_CTL = 0, WS_MOD = 1 * MiB, WS_SC = WS_MOD + 512 * 1024, WS_ROPE = 2 * MiB, WS_GATES = 3 * MiB, WS_WOUT = 8 * MiB,
                 WS_WIN = 24 * MiB, WS_XC = 56 * MiB, WS_H = 72 * MiB, WS_HM = 144 * MiB, WS_P = 216 * MiB, WS_END = 504 * MiB;

DEVI int opaque_tid() { int t = threadIdx.x; asm volatile("" : "+v"(t)); return t; }
DEVI float bf2f(bf16_t v) { return __uint_as_float(((unsigned)v) << 16); }
DEVI bf16_t f2bf(float f) { unsigned u = __float_as_uint(f); return (bf16_t)((u + 0x7fffu + ((u >> 16) & 1u)) >> 16); }
DEVI unsigned pk2(float lo, float hi) { return (unsigned)f2bf(lo) | ((unsigned)f2bf(hi) << 16); }
DEVI float wave_sum(float v) {
#pragma unroll
    for (int o = 32; o > 0; o >>= 1) v += __shfl_xor(v, o);
    return v;
}
DEVI float wave_max(float v) {
#pragma unroll
    for (int o = 32; o > 0; o >>= 1) v = fmaxf(v, __shfl_xor(v, o));
    return v;
}
DEVI float silu_f(float x) { return x / (1.f + expf(-x)); }
DEVI float sigmoid_f(float x) { return 1.f / (1.f + expf(-x)); }


DEVI void transpose_item(const float* __restrict__ W, int ldw, int K, int N, bf16_t* __restrict__ WT, float* scr, int item, int lane) {
    const int nblk = N / 32, kb = item / nblk, nb = item % nblk, k0 = 64 * kb, n0 = 32 * nb;
#pragma unroll 8
    for (int i = 0; i < 32; ++i) { const int kk = 2 * i + (lane >> 5); scr[kk * 33 + (lane & 31)] = W[(size_t)(k0 + kk) * ldw + n0 + (lane & 31)]; }
    asm volatile("s_waitcnt lgkmcnt(0)" ::: "memory");
    const int c = lane & 7;
#pragma unroll
    for (int j = 0; j < 4; ++j) {
        const int n = (lane >> 3) + 8 * j; const float* s = scr + (8 * c) * 33 + n;
        uint4 o; o.x = pk2(s[0 * 33], s[1 * 33]); o.y = pk2(s[2 * 33], s[3 * 33]); o.z = pk2(s[4 * 33], s[5 * 33]); o.w = pk2(s[6 * 33], s[7 * 33]);
        *(uint4*)(WT + (size_t)(n0 + n) * K + k0 + 8 * c) = o;
    }
    asm volatile("s_waitcnt lgkmcnt(0)" ::: "memory");
}

namespace pg8 {
#define PG8_LAS __attribute__((address_space(3)))
typedef unsigned short bf16_t;
typedef short bf16x8 __attribute__((ext_vector_type(8)));
typedef float f32x4 __attribute__((ext_vector_type(4)));
typedef unsigned u32x4 __attribute__((ext_vector_type(4)));
constexpr int BM = 256, BK = 64, HALF = 128, HTB = HALF * BK * 2  , STAGE_BYTES = 8 * HTB, NXCD = 8, WGM = 8;

__host__ __device__ __forceinline__ int lds_byte(int r, int c) { const int st = (r >> 4) * 2 + (c >> 5), rr = r & 15, cc = c & 31, ob = rr * 64 + cc * 2; return st * 1024 + (ob ^ (((ob >> 9) & 1) << 5)); }
__host__ __device__ __forceinline__ void stage_rc(int b, int& R, int& C) { const int st = b / 1024, sb = b % 1024, swz = sb ^ (((sb >> 9) & 1) << 5); R = (st >> 1) * 16 + swz / 64; C = (st & 1) * 32 + (swz % 64) / 2; }
__host__ __device__ __forceinline__ int perm32(int rho) { const int n = rho >> 4, i = rho & 15; return 8 * (i >> 2) + 4 * n + (i & 3); }

struct Unit { int pm, pn; };
struct Gemm { const bf16_t* A; const bf16_t* Bt; int M, N, K; };

struct StaticOrder {
    int nM, nN, nwg, G, c;
    __host__ __device__ void init(int M, int N, int G_, int c_) { nM = M / BM; nN = N / BM; nwg = nM * nN; G = G_; c = c_; }
    __host__ __device__ bool next(int i, Unit& u) const {
        const long L = (long)i * G + c; if (L >= nwg) return false;
        int wgid = (int)L; { const int q = nwg / NXCD, r = nwg % NXCD, xcd = wgid % NXCD, off = wgid / NXCD; wgid = (xcd < r ? xcd * (q + 1) : r * (q + 1) + (xcd - r) * q) + off; }
        const int nig = WGM * nN, gid = wgid / nig, fm = gid * WGM, gsz = (nM - fm) < WGM ? (nM - fm) : WGM;
        u.pm = fm + ((wgid % nig) % gsz); u.pn = (wgid % nig) / gsz; return true;
    }
    __device__ __forceinline__ void a_ready(const Unit&) const {}
    __device__ __forceinline__ void done(const Unit&) const {}
};

__device__ __forceinline__ unsigned cvt_pk_bf16(float lo, float hi) { unsigned r; asm volatile("v_cvt_pk_bf16_f32 %0, %1, %2" : "=v"(r) : "v"(lo), "v"(hi)); return r; }

struct EpiBf16 {
    static constexpr bool PERM = true, AFTER_DRAIN = false;
    bf16_t* O; int ldc;
    __device__ __forceinline__ void operator()(const f32x4 (&acc)[2][2][4][2], const Unit& u, int wr, int wc, int fr, int fq) const {
        const int row0 = u.pm * BM + wr * 64 + fr, col0 = u.pn * BM + wc * 32 + 8 * fq;
#pragma unroll
        for (int ai = 0; ai < 2; ++ai)
#pragma unroll
            for (int m = 0; m < 4; ++m) { bf16_t* rowp = O + (size_t)(row0 + ai * HALF + m * 16) * ldc + col0;
#pragma unroll
                for (int bj = 0; bj < 2; ++bj) { const f32x4 v0 = acc[ai][bj][m][0], v1 = acc[ai][bj][m][1];
                    u32x4 w; w.x = cvt_pk_bf16(v0[0], v0[1]); w.y = cvt_pk_bf16(v0[2], v0[3]); w.z = cvt_pk_bf16(v1[0], v1[1]); w.w = cvt_pk_bf16(v1[2], v1[3]);
                    *(u32x4*)(rowp + bj * HALF) = w; } }
    }
};
struct EpiInProj {
    static constexpr bool PERM = true, AFTER_DRAIN = false;
    bf16_t* O; int ldc; const float* rope;
    __device__ __forceinline__ void operator()(const f32x4 (&acc)[2][2][4][2], const Unit& u, int wr, int wc, int fr, int fq) const {
        const int row0 = u.pm * BM + wr * 64 + fr, col0 = u.pn * BM + wc * 32 + 8 * fq;
        const bool do_rope = (u.pn < 8) && (u.pm < 64);
#pragma unroll
        for (int ai = 0; ai < 2; ++ai)
#pragma unroll
            for (int m = 0; m < 4; ++m) { const int row = row0 + ai * HALF + m * 16; bf16_t* rowp = O + (size_t)row * ldc + col0;
                f32x4 cs01 = {1.f, 0.f, 1.f, 0.f}, cs23 = {1.f, 0.f, 1.f, 0.f};
                if (do_rope) { const int pos = (wc & 1) ? (row & 63) : ((row >> 6) & 31); const f32x4* rp = (const f32x4*)(rope + (size_t)(pos * 16 + 4 * fq) * 2); cs01 = rp[0]; cs23 = rp[1]; }
#pragma unroll
                for (int bj = 0; bj < 2; ++bj) { f32x4 v0 = acc[ai][bj][m][0], v1 = acc[ai][bj][m][1];
                    if (do_rope) {
                        const float a0 = v0[0] * cs01[0] - v0[1] * cs01[1], a1 = v0[0] * cs01[1] + v0[1] * cs01[0];
                        const float a2 = v0[2] * cs01[2] - v0[3] * cs01[3], a3 = v0[2] * cs01[3] + v0[3] * cs01[2];
                        const float b0 = v1[0] * cs23[0] - v1[1] * cs23[1], b1 = v1[0] * cs23[1] + v1[1] * cs23[0];
                        const float b2 = v1[2] * cs23[2] - v1[3] * cs23[3], b3 = v1[2] * cs23[3] + v1[3] * cs23[2];
                        v0 = (f32x4){a0, a1, a2, a3}; v1 = (f32x4){b0, b1, b2, b3};
                    }
                    u32x4 w; w.x = cvt_pk_bf16(v0[0], v0[1]); w.y = cvt_pk_bf16(v0[2], v0[3]); w.z = cvt_pk_bf16(v1[0], v1[1]); w.w = cvt_pk_bf16(v1[2], v1[3]);
                    *(u32x4*)(rowp + bj * HALF) = w; } }
    }
};

template <class Epi, class Sched, bool ALIGN_EPI = false, bool SP2 = false>
__device__ __forceinline__ void gemm_phase(PG8_LAS unsigned char* lds, const Gemm g, const Sched& S, const Epi& E) {
    const int tid = opaque_tid(), wid = __builtin_amdgcn_readfirstlane(tid >> 6), lane = tid & 63, wr = wid >> 2, wc = wid & 3, fr = lane & 15, fq = lane >> 4;
    const int K = g.K, nt = K / BK;
    unsigned voffA[2], voffB[2];
#pragma unroll
    for (int i = 0; i < 2; ++i) { int R, C; stage_rc(tid * 16 + i * 8192, R, C); const int Rb = Epi::PERM ? ((R & ~31) + perm32(R & 31)) : R;
        voffA[i] = (unsigned)(R * K + C) * 2u; voffB[i] = (unsigned)(Rb * K + C) * 2u; }
    const size_t kstep = (size_t)(BK * 2);
    const size_t hstep = (size_t)HALF * K * 2;
    const size_t tstep = 2 * hstep;
    const unsigned ldsw = (unsigned)wid * 1024u;
    const int aoff = lds_byte(wr * 64 + fr, fq * 8), boff = lds_byte(wc * 32 + fr, fq * 8);
#define PG8_SA(b, h) (((b) * 2 + (h)) * HTB)
#define PG8_SB(b, h) ((4 + (b) * 2 + (h)) * HTB)
#define PG8_STAGE(bufoff, gbase, voff) do { _Pragma("unroll") for (int _i = 0; _i < 2; ++_i) \
        __builtin_amdgcn_global_load_lds((const unsigned*)((const char*)(gbase) + (voff)[_i]), (PG8_LAS unsigned*)(lds + (bufoff) + ldsw + _i * 8192), 16, 0, 0); } while (0)
#define PG8_LDA(dst, b, h) do { _Pragma("unroll") for (int m = 0; m < 4; ++m) _Pragma("unroll") for (int k = 0; k < 2; ++k) dst[m][k] = *(const PG8_LAS bf16x8*)(lds + PG8_SA(b, h) + aoff + m * 2048 + k * 1024); } while (0)
#define PG8_LDB(dst, b, h) do { _Pragma("unroll") for (int n = 0; n < 2; ++n) _Pragma("unroll") for (int k = 0; k < 2; ++k) dst[n][k] = *(const PG8_LAS bf16x8*)(lds + PG8_SB(b, h) + boff + n * 2048 + k * 1024); } while (0)
#define PG8_MMA(ai, bj, At, Bt) do { __builtin_amdgcn_s_setprio(1); _Pragma("unroll") for (int m = 0; m < 4; ++m) _Pragma("unroll") for (int n = 0; n < 2; ++n) _Pragma("unroll") for (int k = 0; k < 2; ++k) \
        acc[ai][bj][m][n] = __builtin_amdgcn_mfma_f32_16x16x32_bf16(Bt[n][k], At[m][k], acc[ai][bj][m][n], 0, 0, 0); __builtin_amdgcn_s_setprio(0); } while (0)
#define PG8_WAIT_V(n) asm volatile("s_waitcnt vmcnt(" #n ")" ::: "memory")
#define PG8_WAIT_L(n) asm volatile("s_waitcnt lgkmcnt(" #n ")" ::: "memory")
#define PG8_BAR __builtin_amdgcn_s_barrier()
#define PG8_SCHED __builtin_amdgcn_sched_barrier(0)
    Unit cur, nxt; int ui = 0;
    if (!S.next(0, cur)) return;
    f32x4 acc[2][2][4][2];
#pragma unroll
    for (int a = 0; a < 2; ++a)
#pragma unroll
        for (int b = 0; b < 2; ++b)
#pragma unroll
            for (int m = 0; m < 4; ++m)
#pragma unroll
                for (int n = 0; n < 2; ++n) acc[a][b][m][n] = (f32x4){0.f, 0.f, 0.f, 0.f};
    bf16x8 At[4][2], B0[2][2], B1[2][2];
    const char* cA = (const char*)g.A + (size_t)cur.pm * tstep; const char* cB = (const char*)g.Bt + (size_t)cur.pn * tstep;
    S.a_ready(cur);
    if constexpr (SP2) {
        PG8_STAGE(PG8_SB(0, 0), cB, voffB); PG8_STAGE(PG8_SB(0, 1), cB + hstep, voffB); PG8_STAGE(PG8_SA(0, 0), cA, voffA); PG8_STAGE(PG8_SA(0, 1), cA + hstep, voffA);
        if (wr == 1) PG8_BAR;
        PG8_WAIT_V(2); PG8_BAR;
        PG8_STAGE(PG8_SB(1, 0), cB + kstep, voffB); PG8_STAGE(PG8_SA(1, 0), cA + kstep, voffA); PG8_STAGE(PG8_SB(1, 1), cB + hstep + kstep, voffB);
        PG8_WAIT_V(6); PG8_BAR;
    } else {
        PG8_STAGE(PG8_SB(0, 0), cB, voffB); PG8_STAGE(PG8_SA(0, 0), cA, voffA); PG8_STAGE(PG8_SB(0, 1), cB + hstep, voffB); PG8_STAGE(PG8_SA(0, 1), cA + hstep, voffA);
        if (wr == 1) PG8_BAR;
        PG8_WAIT_V(4); PG8_BAR;
        PG8_STAGE(PG8_SB(1, 0), cB + kstep, voffB); PG8_STAGE(PG8_SA(1, 0), cA + kstep, voffA); PG8_STAGE(PG8_SB(1, 1), cB + hstep + kstep, voffB);
        PG8_WAIT_V(6); PG8_BAR;
    }
    for (;;) {
        const bool has_next = S.next(ui + 1, nxt);
        const char* nA = has_next ? (const char*)g.A + (size_t)nxt.pm * tstep : cA; const char* nB = has_next ? (const char*)g.Bt + (size_t)nxt.pn * tstep : cB;
        for (int t = 0; t < nt; t += 2) {
            const bool last = (t == nt - 2);
            const char* a1 = cA + (size_t)(t + 1) * kstep;
            const char* a2 = last ? nA : cA + (size_t)(t + 2) * kstep; const char* b2 = last ? nB : cB + (size_t)(t + 2) * kstep;
            const char* a3 = a2 + kstep; const char* b3 = b2 + kstep;
            if (last && has_next) S.a_ready(nxt);
            if constexpr (SP2) {
            PG8_LDB(B0, 0, 0); PG8_LDB(B1, 0, 1); PG8_SCHED; PG8_LDA(At, 0, 0); PG8_STAGE(PG8_SA(1, 1), a1 + hstep, voffA);
            PG8_WAIT_V(8); PG8_WAIT_L(0); PG8_BAR; PG8_MMA(0, 0, At, B0); PG8_MMA(0, 1, At, B1); PG8_BAR; PG8_SCHED;
            PG8_LDA(At, 0, 1); PG8_STAGE(PG8_SB(0, 0), b2, voffB); PG8_STAGE(PG8_SB(0, 1), b2 + hstep, voffB); PG8_STAGE(PG8_SA(0, 0), a2, voffA);
            PG8_WAIT_V(8); PG8_WAIT_L(0); PG8_BAR; PG8_MMA(1, 0, At, B0); PG8_MMA(1, 1, At, B1); PG8_BAR; PG8_SCHED;
            PG8_LDB(B0, 1, 0); PG8_LDB(B1, 1, 1); PG8_SCHED; PG8_LDA(At, 1, 0); PG8_STAGE(PG8_SA(0, 1), a2 + hstep, voffA);
            PG8_WAIT_V(8); PG8_WAIT_L(0); PG8_BAR; PG8_MMA(0, 0, At, B0); PG8_MMA(0, 1, At, B1); PG8_BAR; PG8_SCHED;
            PG8_LDA(At, 1, 1); PG8_STAGE(PG8_SB(1, 0), b3, voffB); PG8_STAGE(PG8_SB(1, 1), b3 + hstep, voffB); PG8_STAGE(PG8_SA(1, 0), a3, voffA);
            PG8_WAIT_V(8); PG8_WAIT_L(0); PG8_BAR; PG8_MMA(1, 0, At, B0); PG8_MMA(1, 1, At, B1); PG8_BAR; PG8_SCHED;
            } else {
            PG8_LDB(B0, 0, 0); PG8_SCHED; PG8_LDA(At, 0, 0); PG8_STAGE(PG8_SA(1, 1), a1 + hstep, voffA);
            PG8_WAIT_L(8); PG8_BAR; PG8_WAIT_L(0); PG8_MMA(0, 0, At, B0); PG8_BAR; PG8_SCHED;
            PG8_LDB(B1, 0, 1); PG8_STAGE(PG8_SB(0, 0), b2, voffB);
            PG8_BAR; PG8_WAIT_L(0); PG8_MMA(0, 1, At, B1); PG8_BAR;
            PG8_LDA(At, 0, 1); PG8_STAGE(PG8_SA(0, 0), a2, voffA);
            PG8_BAR; PG8_WAIT_L(0); PG8_MMA(1, 0, At, B0); PG8_BAR; PG8_SCHED;
            PG8_STAGE(PG8_SB(0, 1), b2 + hstep, voffB);
            PG8_WAIT_V(6); PG8_BAR; PG8_MMA(1, 1, At, B1); PG8_BAR;
            PG8_LDB(B0, 1, 0); PG8_SCHED; PG8_LDA(At, 1, 0); PG8_STAGE(PG8_SA(0, 1), a2 + hstep, voffA);
            PG8_WAIT_L(8); PG8_BAR; PG8_WAIT_L(0); PG8_MMA(0, 0, At, B0); PG8_BAR; PG8_SCHED;
            PG8_LDB(B1, 1, 1); PG8_STAGE(PG8_SB(1, 0), b3, voffB);
            PG8_BAR; PG8_WAIT_L(0); PG8_MMA(0, 1, At, B1); PG8_BAR;
            PG8_LDA(At, 1, 1); PG8_STAGE(PG8_SA(1, 0), a3, voffA);
            PG8_BAR; PG8_WAIT_L(0); PG8_MMA(1, 0, At, B0); PG8_BAR; PG8_SCHED;
            PG8_STAGE(PG8_SB(1, 1), b3 + hstep, voffB);
            PG8_WAIT_V(6); PG8_BAR; PG8_MMA(1, 1, At, B1); PG8_BAR;
            }
        }
        if constexpr (ALIGN_EPI) { if (wr == 0) PG8_BAR; }
        if constexpr (!Epi::AFTER_DRAIN) { E(acc, cur, wr, wc, fr, fq); S.done(cur); }
        if (!has_next) break;
#pragma unroll
        for (int a = 0; a < 2; ++a)
#pragma unroll
            for (int b = 0; b < 2; ++b)
#pragma unroll
                for (int m = 0; m < 4; ++m)
#pragma unroll
                    for (int n = 0; n < 2; ++n) acc[a][b][m][n] = (f32x4){0.f, 0.f, 0.f, 0.f};
        cur = nxt; cA = nA; cB = nB; ++ui;
        if constexpr (ALIGN_EPI) { if (wr == 1) PG8_BAR; }
    }
    PG8_WAIT_V(0);
    if constexpr (!ALIGN_EPI) { if (wr == 0) PG8_BAR; }
    PG8_BAR;
    if constexpr (Epi::AFTER_DRAIN) { E.fused(acc, cur, wr, wc, fr, fq, lds, wid, lane); S.done(cur); }
#undef PG8_SA
#undef PG8_SB
#undef PG8_STAGE
#undef PG8_LDA
#undef PG8_LDB
#undef PG8_MMA
#undef PG8_WAIT_V
#undef PG8_WAIT_L
#undef PG8_BAR
#undef PG8_SCHED
}
}

namespace att {
using bf16x8 = __attribute__((ext_vector_type(8))) short;
using s16x4  = __attribute__((ext_vector_type(4))) short;
using f32x16 = __attribute__((ext_vector_type(16))) float;
using u32x4  = __attribute__((ext_vector_type(4))) unsigned;
constexpr int NW = 8, QBLK = 32, KVBLK = 64, QROWS = 128;
constexpr float SCALE = 0.125f, THR = 6.f;
constexpr int SHM_V = KVBLK * 128 * 2, SHM_K = KVBLK * 128 * 2, SHM_ATTN = 2 * SHM_V + 2 * SHM_K + NW * 64 * 4;
#define KSWZ(row, colB) ((row) * 256 + ((colB) ^ (((row) & 7) << 4)))
#define SBAR() __builtin_amdgcn_sched_barrier(0)
__device__ __forceinline__ int crow(int r, int hi) { return (r & 3) + 8 * (r >> 2) + 4 * hi; }
__device__ __forceinline__ unsigned cvtpk(float lo, float hi) { unsigned r; asm volatile("v_cvt_pk_bf16_f32 %0, %1, %2" : "=v"(r) : "v"(lo), "v"(hi)); return r; }
__device__ __forceinline__ void partialSM(f32x16& p0, f32x16& p1, float& m_reg, float& mn, float& alpha) {
  constexpr float C = SCALE * 1.4426950408889634f;
  float pmax = p0[0];
#pragma unroll
  for (int r = 1; r < 16; ++r) pmax = fmaxf(pmax, p0[r]);
#pragma unroll
  for (int r = 0; r < 16; ++r) pmax = fmaxf(pmax, p1[r]);
  { auto rr = __builtin_amdgcn_permlane32_swap(__float_as_uint(pmax), __float_as_uint(pmax), false, false);
    pmax = fmaxf(__uint_as_float(rr[0]), __uint_as_float(rr[1])); }
  if (__builtin_expect(__all(pmax - m_reg <= THR / SCALE), 1)) { mn = m_reg; alpha = 1.f; }
  else { mn = fmaxf(m_reg, pmax); alpha = __builtin_amdgcn_exp2f((m_reg - mn) * C); m_reg = mn; }
  const float mnC = -mn * C;
#pragma unroll
  for (int r = 0; r < 16; ++r) p0[r] = fmaf(p0[r], C, mnC);
#pragma unroll
  for (int r = 0; r < 16; ++r) p1[r] = fmaf(p1[r], C, mnC);
#pragma unroll
  for (int r = 0; r < 16; ++r) p0[r] = __builtin_amdgcn_exp2f(p0[r]);
}
__device__ __forceinline__ void finishSM(f32x16& p0, f32x16& p1, float alpha, float& l_reg, bf16x8& pa0, bf16x8& pa1, bf16x8& pa2, bf16x8& pa3) {
#pragma unroll
  for (int r = 0; r < 16; ++r) p1[r] = __builtin_amdgcn_exp2f(p1[r]);
  float ps = 0;
#pragma unroll
  for (int r = 0; r < 16; ++r) ps += p0[r];
#pragma unroll
  for (int r = 0; r < 16; ++r) ps += p1[r];
  { auto rr = __builtin_amdgcn_permlane32_swap(__float_as_uint(ps), __float_as_uint(ps), false, false);
    ps = __uint_as_float(rr[0]) + __uint_as_float(rr[1]); }
  l_reg = l_reg * alpha + ps;
#define PK4(P, BASE, OUT) do { unsigned a0 = cvtpk(P[BASE + 0], P[BASE + 1]), a1 = cvtpk(P[BASE + 2], P[BASE + 3]);   \
    unsigned b0 = cvtpk(P[BASE + 4], P[BASE + 5]), b1 = cvtpk(P[BASE + 6], P[BASE + 7]);                              \
    auto r0 = __builtin_amdgcn_permlane32_swap(a0, b0, false, false); auto r1 = __builtin_amdgcn_permlane32_swap(a1, b1, false, false); \
    u32x4 w = {r0[0], r1[0], r0[1], r1[1]}; OUT = *reinterpret_cast<bf16x8*>(&w); } while (0)
  PK4(p0, 0, pa0); PK4(p0, 8, pa1); PK4(p1, 0, pa2); PK4(p1, 8, pa3);
#undef PK4
}
__device__ __forceinline__ void qkt(f32x16& p0, f32x16& p1, const char* Ks, const bf16x8* qr, int r32, int hi, int sub) {
  p0 = f32x16{}; p1 = f32x16{};
#pragma unroll
  for (int d0 = 0; d0 < 4; ++d0) { const int cb = (sub * 64 + d0 * 16 + hi * 8) * 2;
    const bf16x8 b0 = *reinterpret_cast<const bf16x8*>(Ks + KSWZ(r32, cb));
    const bf16x8 b1 = *reinterpret_cast<const bf16x8*>(Ks + KSWZ(32 + r32, cb));
    p0 = __builtin_amdgcn_mfma_f32_32x32x16_bf16(b0, qr[d0], p0, 0, 0, 0);
    p1 = __builtin_amdgcn_mfma_f32_32x32x16_bf16(b1, qr[d0], p1, 0, 0, 0); }
}
__device__ __forceinline__ int v_st(int k, int c) { const int kk = (k & ~0xC) | ((k & 4) << 1) | ((k & 8) >> 1); return ((kk >> 3) * 4 + (c >> 5)) * 512 + ((kk & 7) * 32 + (c & 31)) * 2; }
__device__ __forceinline__ int v_rd_base(int lane) { return ((lane & 3) << 3) | (((lane >> 2) & 3) << 6) | (((lane >> 4) & 1) << 5) | (((lane >> 5) & 1) << 8); }
constexpr int v_rd_off(int d0, int ks, int half) { return d0 * 512 + ks * 4096 + half * 2048; }
template <int OFF> __device__ __forceinline__ s16x4 tr_read(int vb) {
  s16x4 r; asm volatile("ds_read_b64_tr_b16 %0, %1 offset:%2" : "=&v"(r) : "v"(vb), "i"(OFF) : "memory"); return r;
}
template <int D0> __device__ __forceinline__ void pv_one(f32x16& od, int vb, bf16x8 pa0, bf16x8 pa1, bf16x8 pa2, bf16x8 pa3) {
  const s16x4 l0 = tr_read<v_rd_off(D0, 0, 0)>(vb), h0 = tr_read<v_rd_off(D0, 0, 1)>(vb), l1 = tr_read<v_rd_off(D0, 1, 0)>(vb), h1 = tr_read<v_rd_off(D0, 1, 1)>(vb);
  const s16x4 l2 = tr_read<v_rd_off(D0, 2, 0)>(vb), h2 = tr_read<v_rd_off(D0, 2, 1)>(vb), l3 = tr_read<v_rd_off(D0, 3, 0)>(vb), h3 = tr_read<v_rd_off(D0, 3, 1)>(vb);
  asm volatile("s_waitcnt lgkmcnt(0)" ::: "memory"); SBAR();
#define PK(L, H) (bf16x8){L[0], L[1], L[2], L[3], H[0], H[1], H[2], H[3]}
  od = __builtin_amdgcn_mfma_f32_32x32x16_bf16(pa0, PK(l0, h0), od, 0, 0, 0);
  od = __builtin_amdgcn_mfma_f32_32x32x16_bf16(pa1, PK(l1, h1), od, 0, 0, 0);
  od = __builtin_amdgcn_mfma_f32_32x32x16_bf16(pa2, PK(l2, h2), od, 0, 0, 0);
  od = __builtin_amdgcn_mfma_f32_32x32x16_bf16(pa3, PK(l3, h3), od, 0, 0, 0);
#undef PK
}
__device__ __forceinline__ void pv_d0(f32x16* o, int vb, bf16x8 pa0, bf16x8 pa1, bf16x8 pa2, bf16x8 pa3) {
  pv_one<0>(o[0], vb, pa0, pa1, pa2, pa3); pv_one<1>(o[1], vb, pa0, pa1, pa2, pa3); pv_one<2>(o[2], vb, pa0, pa1, pa2, pa3); pv_one<3>(o[3], vb, pa0, pa1, pa2, pa3);
}
__device__ __forceinline__ long ktile_row(int b, int t) { return t < 4 ? (long)(NLAT + b * CTXL + 64 * t) : (long)(b * SEQ + 64 * (t - 4)); }

__device__ __forceinline__ void attn_unit(const bf16_t* __restrict__ Pm, bf16_t* __restrict__ Y, long qrow0, int b, int hh, int NT, float lam, float lam_init,
                                          const float* __restrict__ subln, char* lds) {
  const int tid = opaque_tid(), wid = tid >> 6, lane = tid & 63, r32 = lane & 31, hi = lane >> 5;
  const int sub = wid & 1, pr = wid >> 1;
  char* V_lds = lds; char* K_lds = lds + 2 * SHM_V;
  float* ws = (float*)(lds + 2 * SHM_V + 2 * SHM_K) + wid * 64; float* li_l = ws; float* al_l = ws + 32;
  float m_reg = -1e30f, l_reg = 0; f32x16 o[4] = {}; bf16x8 qr[4];
  const bf16_t* Qw = Pm + (qrow0 + pr * QBLK + r32) * NP + C_QA + hh * 128 + sub * 64 + hi * 8;
#pragma unroll
  for (int d0 = 0; d0 < 4; ++d0) qr[d0] = *reinterpret_cast<const bf16x8*>(Qw + d0 * 16);
  const int sr = tid >> 4, sc = (tid & 15) * 8, vst0 = v_st(sr, sc), vst1 = v_st(32 + sr, sc);
  const int vb0 = (int)(uintptr_t)V_lds + v_rd_base(lane);
  const bf16_t* Kcol = Pm + C_KA + hh * 128 + sc; const bf16_t* Vcol = Pm + C_VA + hh * 128 + sc;
  struct { bf16x8 vs0, vs1, ks0, ks1; } sr_[2];
#define SLOAD(i, t) do { const long r0_ = ktile_row(b, (t)) + sr; \
    sr_[i].vs0 = *reinterpret_cast<const bf16x8*>(Vcol + r0_ * NP); sr_[i].vs1 = *reinterpret_cast<const bf16x8*>(Vcol + (r0_ + 32) * NP); \
    sr_[i].ks0 = *reinterpret_cast<const bf16x8*>(Kcol + r0_ * NP); sr_[i].ks1 = *reinterpret_cast<const bf16x8*>(Kcol + (r0_ + 32) * NP); } while (0)
#define SWRITE(bb, i) do { *(bf16x8*)(V_lds + (bb) * SHM_V + vst0) = sr_[i].vs0; *(bf16x8*)(V_lds + (bb) * SHM_V + vst1) = sr_[i].vs1; const int kc = sc * 2; \
    *(bf16x8*)(K_lds + (bb) * SHM_K + KSWZ(sr, kc)) = sr_[i].ks0; *(bf16x8*)(K_lds + (bb) * SHM_K + KSWZ(32 + sr, kc)) = sr_[i].ks1; } while (0)
#define SWAIT() asm volatile("s_waitcnt vmcnt(4)" ::: "memory")
#define RESC(a) do { if (__any((a) < 1.f)) { if (hi == 0) al_l[r32] = (a); asm volatile("s_waitcnt lgkmcnt(0)" ::: "memory"); \
    _Pragma("unroll") for (int d = 0; d < 4; ++d) _Pragma("unroll") for (int r = 0; r < 16; ++r) o[d][r] *= al_l[crow(r, hi)]; } } while (0)
  f32x16 pA0, pA1, pB0, pB1; float mnA, mnB, alA, alB; bf16x8 pa0, pa1, pa2, pa3;
  constexpr int SE = 0, SO = 1;
  SLOAD(SE, 0); asm volatile("s_waitcnt vmcnt(0)" ::: "memory"); SWRITE(0, SE); __syncthreads();
  qkt(pA0, pA1, K_lds, qr, r32, hi, sub); partialSM(pA0, pA1, m_reg, mnA, alA);
  SLOAD(SO, 1); if (2 < NT) SLOAD(SE, 2);
  SWAIT(); SWRITE(1, SO); __syncthreads();
  for (int j = 1; j + 1 < NT; j += 2) {
    SBAR(); qkt(pB0, pB1, K_lds + SHM_K, qr, r32, hi, sub);
    finishSM(pA0, pA1, alA, l_reg, pa0, pa1, pa2, pa3); SBAR();
    SLOAD(SO, j + 2); SBAR();
    pv_d0(o, vb0, pa0, pa1, pa2, pa3); partialSM(pB0, pB1, m_reg, mnB, alB);
    __syncthreads(); SWAIT(); SWRITE(0, SE);
    RESC(alB); __syncthreads();
    SBAR(); qkt(pA0, pA1, K_lds, qr, r32, hi, sub);
    finishSM(pB0, pB1, alB, l_reg, pa0, pa1, pa2, pa3); SBAR();
    if (j + 3 < NT) SLOAD(SE, j + 3); SBAR();
    pv_d0(o, vb0 + SHM_V, pa0, pa1, pa2, pa3); partialSM(pA0, pA1, m_reg, mnA, alA);
    __syncthreads(); SWAIT(); SWRITE(1, SO);
    RESC(alA); __syncthreads();
  }
  SBAR(); qkt(pB0, pB1, K_lds + SHM_K, qr, r32, hi, sub);
  finishSM(pA0, pA1, alA, l_reg, pa0, pa1, pa2, pa3); SBAR();
  pv_d0(o, vb0, pa0, pa1, pa2, pa3); partialSM(pB0, pB1, m_reg, mnB, alB);
  __syncthreads(); RESC(alB);
  finishSM(pB0, pB1, alB, l_reg, pa0, pa1, pa2, pa3); SBAR();
  pv_d0(o, vb0 + SHM_V, pa0, pa1, pa2, pa3);
  if (hi == 0) li_l[r32] = l_reg; asm volatile("s_waitcnt lgkmcnt(0)" ::: "memory");
  const float fac = sub ? lam : 1.f;
#pragma unroll
  for (int r = 0; r < 16; ++r) { const float rl = fac * __builtin_amdgcn_rcpf(li_l[crow(r, hi)]);
#pragma unroll
    for (int d0 = 0; d0 < 4; ++d0) o[d0][r] *= rl; }
  __syncthreads();
  float* XB = (float*)lds + pr * 4096;
  if (sub == 1) {
#pragma unroll
    for (int d0 = 0; d0 < 4; ++d0)
#pragma unroll
      for (int r = 0; r < 16; ++r) XB[(d0 * 16 + r) * 64 + lane] = o[d0][r];
  }
  __syncthreads();
  if (sub == 0) {
    float ss[16];
#pragma unroll
    for (int r = 0; r < 16; ++r) { float a = 0.f;
#pragma unroll
      for (int d0 = 0; d0 < 4; ++d0) { o[d0][r] -= XB[(d0 * 16 + r) * 64 + lane]; a += o[d0][r] * o[d0][r]; }
      ss[r] = a; }
#pragma unroll
    for (int r = 0; r < 16; ++r) {
#pragma unroll
      for (int off = 1; off < 32; off <<= 1) ss[r] += __shfl_xor(ss[r], off);
      ss[r] = rsqrtf(ss[r] * (1.f / 128.f) + EPS) * (1.f - lam_init);
    }
    float sw[4];
#pragma unroll
    for (int d0 = 0; d0 < 4; ++d0) sw[d0] = subln[d0 * 32 + r32];
#pragma unroll
    for (int r = 0; r < 16; ++r) { const long row = qrow0 + pr * QBLK + crow(r, hi);
      const bf16_t* gp = Pm + row * NP + C_GA + hh * 128 + r32; bf16_t* yp = Y + row * DM + hh * 128 + r32;
#pragma unroll
      for (int d0 = 0; d0 < 4; ++d0) { const float g = bf2f(gp[d0 * 32]); yp[d0 * 32] = f2bf(o[d0][r] * ss[r] * sw[d0] * (g / (1.f + __expf(-g)))); } }
  }
  __syncthreads();
#undef SLOAD
#undef SWRITE
#undef SWAIT
#undef RESC
}
__device__ __forceinline__ void attn_phase(const bf16_t* __restrict__ Pm, bf16_t* __restrict__ Y, const float* lq1, const float* lk1, const float* lq2, const float* lk2,
                                           const float* __restrict__ subln, float lam_init, bool ctx_out, char* lds) {
  const int lane = opaque_tid() & 63;
  const float lam = expf(wave_sum(lq1[lane] * lk1[lane])) - expf(wave_sum(lq2[lane] * lk2[lane])) + lam_init;
  const int G = gridDim.x, bx = blockIdx.x; const int vcu = (G % 8 == 0) ? (bx % 8) * (G / 8) + bx / 8 : bx;
  const int nunits = 1024 + (ctx_out ? 128 : 0);
  for (int u = vcu; u < nunits; u += G) {
    if (u < 1024) { const int bh = u >> 4, qb = u & 15, b = bh >> 3, hh = bh & 7; attn_unit(Pm, Y, (long)b * SEQ + qb * QROWS, b, hh, 36, lam, lam_init, subln, lds); }
    else { const int v = u - 1024, bh = v >> 1, qb = v & 1, b = bh >> 3, hh = bh & 7; attn_unit(Pm, Y, (long)NLAT + b * CTXL + qb * QROWS, b, hh, 4, lam, lam_init, subln, lds); }
  }
}
#undef KSWZ
#undef SBAR
}

namespace mls {
using bf16x8 = __attribute__((ext_vector_type(8))) short;
using s16x4  = __attribute__((ext_vector_type(4))) short;
using f32x4  = __attribute__((ext_vector_type(4))) float;
constexpr int QSTRB = 272, SSTRB = 144;
constexpr int L_Q = 0, L_K = L_Q + 64 * QSTRB, L_V = L_K + 64 * QSTRB, L_VW = L_V + 64 * SSTRB, L_S = L_VW + 64 * SSTRB, L_CT = L_S + 64 * SSTRB, L_SM = L_CT + 2 * 64 * QSTRB, L_END = L_SM + 8192;
static_assert(L_END <= 131072 && (L_K % 16) == 0 && (L_V % 16) == 0 && (L_VW % 16) == 0 && (L_S % 16) == 0 && (L_CT % 16) == 0 && (L_SM % 16) == 0, "mlstm LDS map");
__device__ __forceinline__ f32x4 mfma16(bf16x8 a, bf16x8 b, f32x4 c) { return __builtin_amdgcn_mfma_f32_16x16x32_bf16(a, b, c, 0, 0, 0); }
struct TrPair { s16x4 lo, hi; };
__device__ __forceinline__ TrPair tr_issue(unsigned addr, int rsb) {
  TrPair t;
  asm volatile("ds_read_b64_tr_b16 %0, %1" : "=&v"(t.lo) : "v"(addr) : "memory");
  asm volatile("ds_read_b64_tr_b16 %0, %1" : "=&v"(t.hi) : "v"(addr + 4u * (unsigned)rsb) : "memory");
  return t;
}
__device__ __forceinline__ bf16x8 tr_pack(const TrPair& t) { return (bf16x8){t.lo[0], t.lo[1], t.lo[2], t.lo[3], t.hi[0], t.hi[1], t.hi[2], t.hi[3]}; }
#define TR_PIN(t) asm volatile("" : "+v"((t).lo), "+v"((t).hi))
__device__ __forceinline__ float wave_scan_incl(float v) {
  v += __builtin_bit_cast(float, __builtin_amdgcn_update_dpp(0, __builtin_bit_cast(int, v), 0x111, 0xF, 0xF, false));
  v += __builtin_bit_cast(float, __builtin_amdgcn_update_dpp(0, __builtin_bit_cast(int, v), 0x112, 0xF, 0xF, false));
  v += __builtin_bit_cast(float, __builtin_amdgcn_update_dpp(0, __builtin_bit_cast(int, v), 0x114, 0xF, 0xF, false));
  v += __builtin_bit_cast(float, __builtin_amdgcn_update_dpp(0, __builtin_bit_cast(int, v), 0x118, 0xF, 0xF, false));
  v += __builtin_bit_cast(float, __builtin_amdgcn_update_dpp(0, __builtin_bit_cast(int, v), 0x142, 0xA, 0xF, false));
  v += __builtin_bit_cast(float, __builtin_amdgcn_update_dpp(0, __builtin_bit_cast(int, v), 0x143, 0xC, 0xF, false));
  return v;
}
__device__ __forceinline__ float fast_tanh(float x) { return 1.f - 2.f * __builtin_amdgcn_rcpf(1.f + __expf(2.f * x)); }

__device__ __forceinline__ void mlstm_unit(const bf16_t* __restrict__ Pm, const bf16_t* __restrict__ QKC  , const float* __restrict__ GATES,
                                           bf16_t* __restrict__ HM, const float* __restrict__ i_bias, const float* __restrict__ f_bias,
                                           int b, int head, int dir, int es, bool ctx_out, char* lds) {
  const int tid = opaque_tid(), wid = __builtin_amdgcn_readfirstlane(tid >> 6), lane = tid & 63, lr = lane & 15, kg = lane >> 4;
  char* q_lds = lds + L_Q; char* k_lds = lds + L_K; char* v_lds = lds + L_V; char* vw_lds = lds + L_VW; char* s_lds = lds + L_S; char* ct_lds = lds + L_CT;
  float* bl = (float*)(lds + L_SM); float* bsp = bl + 64; float* av = bsp + 64; float* wkl = av + 64; float* qn = wkl + 64; float* nvec = qn + 64; float* rs = nvec + 128; float* npart = rs + 1024;
  const unsigned lds0 = (unsigned)(uintptr_t)lds;
  const unsigned trq = (unsigned)((8 * kg + (lr >> 2)) * QSTRB + (4 * (lr & 3)) * 2), trs = (unsigned)((8 * kg + (lr >> 2)) * SSTRB + (4 * (lr & 3)) * 2);
  for (int i = tid; i < 64 * QSTRB / 4; i += 512) ((unsigned*)ct_lds)[i] = 0u;
  if (tid < 128) nvec[tid] = 0.f;
  const float ibias = i_bias[dir * 4 + head], fbias = f_bias[dir * 4 + head];
  const int chg = tid & 31, rg = tid >> 5; const bool isk = chg >= 16;
  const int qkcol = 1024 + (isk ? 512 : 0) + head * 128 + (chg & 15) * 8;
  const int vrow = tid >> 3, vch = tid & 7;
  uint4 pq0, pq1, pq2, pq3, pv; float pgi, pgf;
#define MLS_LOAD(c_) do { const int c__ = (c_); const bool ic_ = c__ < 4; const int T_ = ic_ ? CTXL : SEQ, cc_ = ic_ ? c__ : c__ - 4; \
    const long rb_ = ic_ ? (long)(NLAT + b * CTXL) : (long)b * SEQ; const int t0_ = dir ? (T_ - 64 * (cc_ + 1)) : 64 * cc_; \
    { const bf16_t* qp_ = QKC + (rb_ + t0_ + rg) * DM + qkcol; pq0 = *(const uint4*)qp_; pq1 = *(const uint4*)(qp_ + 16 * DM); pq2 = *(const uint4*)(qp_ + 32 * DM); pq3 = *(const uint4*)(qp_ + 48 * DM); } \
    pv = *(const uint4*)(Pm + (rb_ + t0_ + vrow) * NP + C_VB + head * 256 + es * 64 + vch * 8); \
    const float* gr_ = GATES + (rb_ + t0_ + (dir ? 63 - lane : lane)) * 16; pgi = gr_[dir * 4 + head]; pgf = gr_[8 + dir * 4 + head]; } while (0)
  MLS_LOAD(0);
  f32x4 Cacc[4];
#pragma unroll
  for (int e = 0; e < 4; ++e) Cacc[e] = (f32x4){0.f, 0.f, 0.f, 0.f};
  float gprev = 0.f;
  __syncthreads();
  for (int c = 0; c < 36; ++c) {
    const bool isctx = c < 4; const int T = isctx ? CTXL : SEQ, cc = isctx ? c : c - 4;
    const long rowbase = isctx ? (long)(NLAT + b * CTXL) : (long)b * SEQ;
    const int t0 = dir ? (T - 64 * (cc + 1)) : 64 * cc;
    const bool need_h = ctx_out || !isctx;
    char* ct_cur = ct_lds + (c & 1) * 64 * QSTRB; char* ct_nxt = ct_lds + ((c + 1) & 1) * 64 * QSTRB;
    float gamma, wk_l;
    {
      const float igv = 15.f * fast_tanh((pgi + ibias) * (1.f / 15.f));
      const float fc = 15.f * fast_tanh((pgf + fbias) * (1.f / 15.f));
      const float lfv = fminf(fc, 0.f) - __logf(1.f + __expf(-fabsf(fc)));
      const float bcum = wave_scan_incl(lfv);
      const float b63 = __builtin_bit_cast(float, __builtin_amdgcn_readlane(__builtin_bit_cast(int, bcum), 63));
      gamma = __expf(b63); wk_l = __expf(b63 - bcum + igv);
      if (wid == 0) { bl[lane] = bcum; bsp[lane] = bcum - igv; av[lane] = __expf(bcum); wkl[lane] = wk_l; }
      if (c > 0 && tid < 128) nvec[tid] = gprev * nvec[tid] + (npart[tid] + npart[128 + tid]) + (npart[256 + tid] + npart[384 + tid]);
    }
    { char* dst = (isk ? k_lds : q_lds) + (chg & 15) * 16;
      *(uint4*)(dst + (dir ? 63 - rg : rg) * QSTRB) = pq0; *(uint4*)(dst + (dir ? 47 - rg : rg + 16) * QSTRB) = pq1;
      *(uint4*)(dst + (dir ? 31 - rg : rg + 32) * QSTRB) = pq2; *(uint4*)(dst + (dir ? 15 - rg : rg + 48) * QSTRB) = pq3; }
    { const int l = dir ? 63 - vrow : vrow; const float wkv = __shfl(wk_l, l);
      *(uint4*)(v_lds + l * SSTRB + vch * 16) = pv;
      const unsigned vv[4] = {pv.x, pv.y, pv.z, pv.w}; uint4 w;
      w.x = pk2(__uint_as_float(vv[0] << 16) * wkv, __uint_as_float(vv[0] & 0xffff0000u) * wkv); w.y = pk2(__uint_as_float(vv[1] << 16) * wkv, __uint_as_float(vv[1] & 0xffff0000u) * wkv);
      w.z = pk2(__uint_as_float(vv[2] << 16) * wkv, __uint_as_float(vv[2] & 0xffff0000u) * wkv); w.w = pk2(__uint_as_float(vv[3] << 16) * wkv, __uint_as_float(vv[3] & 0xffff0000u) * wkv);
      *(uint4*)(vw_lds + l * SSTRB + vch * 16) = w; }
    if (c + 1 < 36) MLS_LOAD(c + 1);
    __syncthreads();
    if (need_h) {
      const int lblk = wid >> 1;
#pragma unroll
      for (int u2 = 0; u2 < 2; ++u2) {
        const int sblk = 2 * (wid & 1) + u2;
        if (sblk <= lblk) {
          f32x4 acc = {0.f, 0.f, 0.f, 0.f};
#pragma unroll
          for (int ks = 0; ks < 4; ++ks) {
            const bf16x8 ka = *(const bf16x8*)(k_lds + (sblk * 16 + lr) * QSTRB + (ks * 32 + 8 * kg) * 2);
            const bf16x8 qb = *(const bf16x8*)(q_lds + (lblk * 16 + lr) * QSTRB + (ks * 32 + 8 * kg) * 2);
            acc = mfma16(ka, qb, acc);
          }
          const int l = lblk * 16 + lr; const float blv = bl[l];
          float v4[4]; float sum = 0.f;
#pragma unroll
          for (int r = 0; r < 4; ++r) { const int sidx = sblk * 16 + 4 * kg + r; const float w = (sidx <= l) ? __expf(blv - bsp[sidx]) : 0.f; v4[r] = acc[r] * w; sum += v4[r]; }
          uint2 w; w.x = pk2(v4[0], v4[1]); w.y = pk2(v4[2], v4[3]);
          *(uint2*)(s_lds + l * SSTRB + (sblk * 16 + 4 * kg) * 2) = w;
          rs[(sblk * 4 + kg) * 64 + l] = sum;
        } else if ((lblk == 0 && sblk == 1) || (lblk == 2 && sblk == 3)) {
          *(uint2*)(s_lds + (lblk * 16 + lr) * SSTRB + (sblk * 16 + 4 * kg) * 2) = make_uint2(0u, 0u);
        }
      }
      { const int l = tid >> 3, part = tid & 7; float a = 0.f;
        const unsigned* qp = (const unsigned*)(q_lds + l * QSTRB + part * 32);
#pragma unroll
        for (int i = 0; i < 8; ++i) { const unsigned wd = qp[i]; a += __uint_as_float(wd << 16) * nvec[part * 16 + 2 * i] + __uint_as_float(wd & 0xffff0000u) * nvec[part * 16 + 2 * i + 1]; }
        a += __builtin_bit_cast(float, __builtin_amdgcn_update_dpp(0, __builtin_bit_cast(int, a), 0xB1, 0xF, 0xF, false));
        a += __builtin_bit_cast(float, __builtin_amdgcn_update_dpp(0, __builtin_bit_cast(int, a), 0x4E, 0xF, 0xF, false));
        a += __builtin_bit_cast(float, __builtin_amdgcn_update_dpp(0, __builtin_bit_cast(int, a), 0x141, 0xF, 0xF, false));
        if (part == 0) qn[l] = a; }
    }
    __syncthreads();
    {
      const int dblk = wid, lblk = wid >> 1, l = lblk * 16 + lr, eb0 = 2 * (wid & 1);
      TrPair ka0, ka1, vb00, vb01, vb10, vb11, vb20, vb21, vb30, vb31, va00, va01, va10, va11;
      {
        const unsigned ak = lds0 + L_K + trq + (unsigned)(dblk * 32), aw = lds0 + L_VW + trs, avv = lds0 + L_V + trs + (unsigned)(eb0 * 32);
        asm volatile(
          "ds_read_b64_tr_b16 %0, %20\n\tds_read_b64_tr_b16 %1, %20 offset:1088\n\tds_read_b64_tr_b16 %2, %20 offset:8704\n\tds_read_b64_tr_b16 %3, %20 offset:9792\n\t"
          "ds_read_b64_tr_b16 %4, %21\n\tds_read_b64_tr_b16 %5, %21 offset:576\n\tds_read_b64_tr_b16 %6, %21 offset:4608\n\tds_read_b64_tr_b16 %7, %21 offset:5184\n\t"
          "ds_read_b64_tr_b16 %8, %21 offset:32\n\tds_read_b64_tr_b16 %9, %21 offset:608\n\tds_read_b64_tr_b16 %10, %21 offset:4640\n\tds_read_b64_tr_b16 %11, %21 offset:5216\n\t"
          "ds_read_b64_tr_b16 %12, %21 offset:64\n\tds_read_b64_tr_b16 %13, %21 offset:640\n\tds_read_b64_tr_b16 %14, %21 offset:4672\n\tds_read_b64_tr_b16 %15, %21 offset:5248\n\t"
          "ds_read_b64_tr_b16 %16, %21 offset:96\n\tds_read_b64_tr_b16 %17, %21 offset:672\n\tds_read_b64_tr_b16 %18, %21 offset:4704\n\tds_read_b64_tr_b16 %19, %21 offset:5280\n\t"
          "s_waitcnt lgkmcnt(0)"
          : "=&v"(ka0.lo), "=&v"(ka0.hi), "=&v"(ka1.lo), "=&v"(ka1.hi),
            "=&v"(vb00.lo), "=&v"(vb00.hi), "=&v"(vb01.lo), "=&v"(vb01.hi), "=&v"(vb10.lo), "=&v"(vb10.hi), "=&v"(vb11.lo), "=&v"(vb11.hi),
            "=&v"(vb20.lo), "=&v"(vb20.hi), "=&v"(vb21.lo), "=&v"(vb21.hi), "=&v"(vb30.lo), "=&v"(vb30.hi), "=&v"(vb31.lo), "=&v"(vb31.hi)
          : "v"(ak), "v"(aw) : "memory");
        asm volatile(
          "ds_read_b64_tr_b16 %0, %8\n\tds_read_b64_tr_b16 %1, %8 offset:576\n\tds_read_b64_tr_b16 %2, %8 offset:4608\n\tds_read_b64_tr_b16 %3, %8 offset:5184\n\t"
          "ds_read_b64_tr_b16 %4, %8 offset:32\n\tds_read_b64_tr_b16 %5, %8 offset:608\n\tds_read_b64_tr_b16 %6, %8 offset:4640\n\tds_read_b64_tr_b16 %7, %8 offset:5216\n\t"
          "s_waitcnt lgkmcnt(0)"
          : "=&v"(va00.lo), "=&v"(va00.hi), "=&v"(va01.lo), "=&v"(va01.hi), "=&v"(va10.lo), "=&v"(va10.hi), "=&v"(va11.lo), "=&v"(va11.hi)
          : "v"(avv) : "memory");
      }
      __builtin_amdgcn_sched_barrier(0);
      {
        const bf16x8 kA0 = tr_pack(ka0), kA1 = tr_pack(ka1);
#define MLS_CUPD(eblk, V0, V1) do { f32x4 cc_ = Cacc[eblk] * gamma; cc_ = mfma16(kA0, tr_pack(V0), cc_); cc_ = mfma16(kA1, tr_pack(V1), cc_); Cacc[eblk] = cc_; \
          uint2 w_; w_.x = pk2(cc_[0], cc_[1]); w_.y = pk2(cc_[2], cc_[3]); *(uint2*)(ct_nxt + ((eblk) * 16 + lr) * QSTRB + (dblk * 16 + 4 * kg) * 2) = w_; } while (0)
        MLS_CUPD(0, vb00, vb01); MLS_CUPD(1, vb10, vb11); MLS_CUPD(2, vb20, vb21); MLS_CUPD(3, vb30, vb31);
#undef MLS_CUPD
      }
      if (need_h) {
        float d = av[l] * qn[l];
        for (int sb = 0; sb <= lblk; ++sb) d += (rs[(sb * 4 + 0) * 64 + l] + rs[(sb * 4 + 1) * 64 + l]) + (rs[(sb * 4 + 2) * 64 + l] + rs[(sb * 4 + 3) * 64 + l]);
        const float a_l = av[l], dinv = 1.f / fmaxf(fabsf(d), 1.f);
        bf16x8 qb[4];
#pragma unroll
        for (int ks = 0; ks < 4; ++ks) qb[ks] = *(const bf16x8*)(q_lds + l * QSTRB + (ks * 32 + 8 * kg) * 2);
        const bf16x8 sb0 = *(const bf16x8*)(s_lds + l * SSTRB + (8 * kg) * 2);
        bf16x8 sb1 = sb0; if (lblk >= 2) sb1 = *(const bf16x8*)(s_lds + l * SSTRB + (32 + 8 * kg) * 2);
        const int t = dir ? (t0 + 63 - l) : (t0 + l);
        bf16_t* hp = HM + ((size_t)dir * NTOK + rowbase + t) * 1024 + head * 256 + es * 64 + 4 * kg;
#define MLS_HTILE(u2, VA0, VA1) do { const int eblk = eb0 + (u2); f32x4 acc1 = {0.f, 0.f, 0.f, 0.f}, acc2 = {0.f, 0.f, 0.f, 0.f}; \
          _Pragma("unroll") for (int ks = 0; ks < 4; ++ks) { const bf16x8 ca = *(const bf16x8*)(ct_cur + (eblk * 16 + lr) * QSTRB + (ks * 32 + 8 * kg) * 2); acc1 = mfma16(ca, qb[ks], acc1); } \
          acc2 = mfma16(tr_pack(VA0), sb0, acc2); if (lblk >= 2) acc2 = mfma16(tr_pack(VA1), sb1, acc2); \
          uint2 w_; w_.x = pk2((a_l * acc1[0] + acc2[0]) * dinv, (a_l * acc1[1] + acc2[1]) * dinv); w_.y = pk2((a_l * acc1[2] + acc2[2]) * dinv, (a_l * acc1[3] + acc2[3]) * dinv); \
          *(uint2*)(hp + eblk * 16) = w_; } while (0)
        MLS_HTILE(0, va00, va01); MLS_HTILE(1, va10, va11);
#undef MLS_HTILE
      }
      { const int dd = tid & 127, sq = tid >> 7; float a = 0.f; const bf16_t* kp = (const bf16_t*)k_lds + (sq * 16) * (QSTRB / 2) + dd;
#pragma unroll
        for (int si = 0; si < 16; ++si) a += bf2f(kp[si * (QSTRB / 2)]) * wkl[sq * 16 + si];
        npart[sq * 128 + dd] = a; }
      gprev = gamma;
    }
    __syncthreads();
  }
#undef MLS_LOAD
}
__device__ __forceinline__ void qkconv_phase(const bf16_t* __restrict__ Pm, bf16_t* __restrict__ QKC, const float* __restrict__ conv_w, const float* __restrict__ conv_b) {
  const int tid = opaque_tid(), lane = tid & 63, wave = tid >> 6;
  const int gw = blockIdx.x * 8 + wave, ngw = gridDim.x * 8;
  const int half = gw & 1, c0 = half * 512 + lane * 8;
  float cw0[8], cw1[8], cw2[8], cbv[8];
#pragma unroll
  for (int i = 0; i < 8; ++i) { cw0[i] = conv_w[c0 + i]; cw1[i] = conv_w[1024 + c0 + i]; cw2[i] = conv_w[2048 + c0 + i]; cbv[i] = conv_b[c0 + i]; }
  const float osc = half ? 0.08838834764831845f : 1.f;
  for (int it = gw >> 1; it < NTOK / 8; it += ngw >> 1) {
    const int r0 = it * 8; const bool isl = r0 < NLAT; const int seq0 = isl ? (r0 / SEQ) * SEQ : NLAT + ((r0 - NLAT) / CTXL) * CTXL, T = isl ? SEQ : CTXL;
    uint4 x[10];
#pragma unroll
    for (int r = 0; r < 10; ++r) { const int t = r0 - seq0 - 1 + r; x[r] = (t >= 0 && t < T) ? *(const uint4*)(Pm + (size_t)(seq0 + t) * NP + C_QB + c0) : make_uint4(0u, 0u, 0u, 0u); }
#pragma unroll
    for (int r = 0; r < 8; ++r) {
      const unsigned a0[4] = {x[r].x, x[r].y, x[r].z, x[r].w}, a1[4] = {x[r + 1].x, x[r + 1].y, x[r + 1].z, x[r + 1].w}, a2[4] = {x[r + 2].x, x[r + 2].y, x[r + 2].z, x[r + 2].w};
      float o[8];
#pragma unroll
      for (int i = 0; i < 8; ++i) {
        const float v0 = (i & 1) ? __uint_as_float(a0[i >> 1] & 0xffff0000u) : __uint_as_float(a0[i >> 1] << 16);
        const float v1 = (i & 1) ? __uint_as_float(a1[i >> 1] & 0xffff0000u) : __uint_as_float(a1[i >> 1] << 16);
        const float v2 = (i & 1) ? __uint_as_float(a2[i >> 1] & 0xffff0000u) : __uint_as_float(a2[i >> 1] << 16);
        const float z = cbv[i] + cw0[i] * v0 + cw1[i] * v1 + cw2[i] * v2;
        o[i] = osc * z / (1.f + __expf(-z));
      }
      uint4 w; w.x = pk2(o[0], o[1]); w.y = pk2(o[2], o[3]); w.z = pk2(o[4], o[5]); w.w = pk2(o[6], o[7]);
      *(uint4*)(QKC + (size_t)(r0 + r) * DM + 1024 + c0) = w;
    }
  }
}
__device__ __forceinline__ void mlstm_phase(const bf16_t* __restrict__ Pm, const bf16_t* __restrict__ QKC, const float* __restrict__ GATES, bf16_t* __restrict__ HM,
                                            const float* __restrict__ i_bias, const float* __restrict__ f_bias, bool ctx_out, char* lds) {
  const int G = gridDim.x, bx = blockIdx.x; const int vcu = (G % 8 == 0) ? (bx % 8) * (G / 8) + bx / 8 : bx;
  for (int u = vcu; u < 256; u += G) { const int es = u & 3, dir = (u >> 2) & 1, head = (u >> 3) & 3, b = u >> 5; mlstm_unit(Pm, QKC, GATES, HM, i_bias, f_bias, b, head, dir, es, ctx_out, lds); }
}
}

DEVI void mod_unit(int unit, const float* __restrict__ c, const float* __restrict__ c_ctx, const float* __restrict__ w_ada, const float* __restrict__ b_ada, float* __restrict__ MOD, float* ldsf) {
    const int tid = opaque_tid(), ci = tid & 63, kgp = tid >> 6;
    const int l = unit / 96, cb = unit % 96;
    float* sc = ldsf; float* red = ldsf + 9 * DM;
    for (int i = tid; i < 9 * DM; i += 512) { const float v = (i < 8 * DM) ? c[i] : c_ctx[i - 8 * DM]; sc[i] = silu_f(v); }
    __syncthreads();
    float acc[9];
#pragma unroll
    for (int r = 0; r < 9; ++r) acc[r] = 0.f;
    const float* w = w_ada + (size_t)l * DM * MODW + cb * 64 + ci;
#pragma unroll 8
    for (int k = kgp * 256; k < kgp * 256 + 256; ++k) {
        const float wv = w[(size_t)k * MODW];
#pragma unroll
        for (int r = 0; r < 9; ++r) acc[r] += sc[r * DM + k] * wv;
    }
#pragma unroll
    for (int r = 0; r < 9; ++r) red[(kgp * 9 + r) * 64 + ci] = acc[r];
    __syncthreads();
    for (int idx = tid; idx < 9 * 64; idx += 512) {
        const int r = idx >> 6, cc = idx & 63; float s = 0.f;
#pragma unroll
        for (int g = 0; g < 8; ++g) s += red[(g * 9 + r) * 64 + cc];
        MOD[(size_t)(l * 9 + r) * MODW + cb * 64 + cc] = s + b_ada[l * MODW + cb * 64 + cc];
    }
    __syncthreads();
}
DEVI void transpose_items(const float* __restrict__ W, int ldw, int K, int N, bf16_t* __restrict__ WT, float* scr, int gw, int ngw, int lane) {
    const int nitems = (K / 64) * (N / 32);
    for (int it = gw; it < nitems; it += ngw) transpose_item(W, ldw, K, N, WT, scr, it, lane);
}
DEVI void finish_row(const bf16_t* __restrict__ P, const bf16_t* __restrict__ HM, const float* __restrict__ mnorm, bf16_t* __restrict__ Y, int row, int lane) {
#pragma unroll
    for (int head = 0; head < 4; ++head) {
        const int col = head * 256 + 4 * lane;
        const uint2 a = *(const uint2*)(HM + (size_t)row * 1024 + col), c = *(const uint2*)(HM + ((size_t)NTOK + row) * 1024 + col);
        float h[4];
        h[0] = __uint_as_float(a.x << 16) + __uint_as_float(c.x << 16); h[1] = __uint_as_float(a.x & 0xffff0000u) + __uint_as_float(c.x & 0xffff0000u);
        h[2] = __uint_as_float(a.y << 16) + __uint_as_float(c.y << 16); h[3] = __uint_as_float(a.y & 0xffff0000u) + __uint_as_float(c.y & 0xffff0000u);
        const float ss = wave_sum(h[0] * h[0] + h[1] * h[1] + h[2] * h[2] + h[3] * h[3]);
        const float r = rsqrtf(ss * (1.f / 256.f) + EPS);
        const uint2 ov = *(const uint2*)(P + (size_t)row * NP + C_OB + col), gv = *(const uint2*)(P + (size_t)row * NP + C_GB + col);
        const float o[4] = {__uint_as_float(ov.x << 16), __uint_as_float(ov.x & 0xffff0000u), __uint_as_float(ov.y << 16), __uint_as_float(ov.y & 0xffff0000u)};
        const float g[4] = {__uint_as_float(gv.x << 16), __uint_as_float(gv.x & 0xffff0000u), __uint_as_float(gv.y << 16), __uint_as_float(gv.y & 0xffff0000u)};
        const float4 w = *(const float4*)(mnorm + col);
        const float wv[4] = {w.x, w.y, w.z, w.w};
        float y[4];
#pragma unroll
        for (int e = 0; e < 4; ++e) y[e] = h[e] * r * wv[e] * sigmoid_f(o[e]) * silu_f(g[e]);
        uint2 out; out.x = pk2(y[0], y[1]); out.y = pk2(y[2], y[3]);
        *(uint2*)(Y + (size_t)row * DM + 1024 + col) = out;
    }
}
DEVI void load_row(const float* __restrict__ xr, float4 (&v)[8], int lane) {
#pragma unroll
    for (int j = 0; j < 8; ++j) v[j] = ((const float4*)xr)[lane + 64 * j];
}
DEVI void post_regs(float4 (&v)[8], const bf16_t* __restrict__ y2row, const float* __restrict__ gate, const float* __restrict__ npost, float* __restrict__ orow, int lane) {
    uint2 yv[8]; float ss = 0.f;
#pragma unroll
    for (int j = 0; j < 8; ++j) {
        yv[j] = *(const uint2*)(y2row + 4 * (lane + 64 * j));
        const float y0 = __uint_as_float(yv[j].x << 16), y1 = __uint_as_float(yv[j].x & 0xffff0000u), y2 = __uint_as_float(yv[j].y << 16), y3 = __uint_as_float(yv[j].y & 0xffff0000u);
        ss += y0 * y0 + y1 * y1 + y2 * y2 + y3 * y3;
    }
    ss = wave_sum(ss);
    const float rstd = rsqrtf(ss * (1.f / DM) + EPS);
#pragma unroll
    for (int j = 0; j < 8; ++j) {
        const int k0 = 4 * (lane + 64 * j);
        const float4 gt = *(const float4*)(gate + k0), w = *(const float4*)(npost + k0);
        const float y0 = __uint_as_float(yv[j].x << 16), y1 = __uint_as_float(yv[j].x & 0xffff0000u), y2 = __uint_as_float(yv[j].y << 16), y3 = __uint_as_float(yv[j].y & 0xffff0000u);
        v[j].x += gt.x * (y0 * rstd * w.x); v[j].y += gt.y * (y1 * rstd * w.y); v[j].z += gt.z * (y2 * rstd * w.z); v[j].w += gt.w * (y3 * rstd * w.w);
        *(float4*)(orow + k0) = v[j];
        asm volatile("" ::: "memory");
    }
}
DEVI void norm_regs(const float4 (&v)[8], const float* __restrict__ shift, const float* __restrict__ scale, const float* __restrict__ npre, bf16_t* __restrict__ hrow, char* trow, int lane) {
    float ss = 0.f;
#pragma unroll
    for (int j = 0; j < 8; ++j) ss += v[j].x * v[j].x + v[j].y * v[j].y + v[j].z * v[j].z + v[j].w * v[j].w;
    ss = wave_sum(ss);
    const float rstd = rsqrtf(ss * (1.f / DM) + EPS);
#pragma unroll
    for (int j = 0; j < 8; ++j) {
        const int k0 = 4 * (lane + 64 * j);
        const float4 w = *(const float4*)(npre + k0), sh = *(const float4*)(shift + k0), sc = *(const float4*)(scale + k0);
        uint2 o;
        o.x = pk2(v[j].x * rstd * w.x * (1.f + sc.x) + sh.x, v[j].y * rstd * w.y * (1.f + sc.y) + sh.y);
        o.y = pk2(v[j].z * rstd * w.z * (1.f + sc.z) + sh.z, v[j].w * rstd * w.w * (1.f + sc.w) + sh.w);
        *(uint2*)(hrow + k0) = o; *(uint2*)(trow + k0 * 2) = o;
        asm volatile("" ::: "memory");
    }
}
constexpr int NT_ROWB = (DM + 8) * 2;
template <bool POST>
DEVI void norm_phase(const float* __restrict__ xlat, const float* __restrict__ xctx, const bf16_t* __restrict__ Y2, const float* __restrict__ mod_post, const float* __restrict__ npost,
                     float* olat, float* octx, const float* __restrict__ mod_n, const float* __restrict__ npre, const float* __restrict__ wg, bf16_t* __restrict__ H,
                     float* __restrict__ GATES, char* lds) {
    typedef short bf16x8 __attribute__((ext_vector_type(8))); typedef float f32x4 __attribute__((ext_vector_type(4)));
    const int tid = opaque_tid(), lane = tid & 63, wave = tid >> 6, lr = lane & 15, kgp = lane >> 4;
    char* tile = lds; float* red = (float*)(lds + 8 * NT_ROWB);
    bf16x8 bfrag[8];
    {
        const float* wp = wg + (size_t)(wave * 256 + 8 * kgp) * INC + lr;
#pragma unroll
        for (int ks = 0; ks < 8; ++ks) {
            unsigned w4[4];
#pragma unroll
            for (int q = 0; q < 4; ++q) { w4[q] = pk2(wp[0], wp[INC]); wp += 2 * INC; asm volatile("" : "+v"(wp)); }
            wp += (size_t)24 * INC; asm volatile("" : "+v"(wp));
            bfrag[ks] = __builtin_bit_cast(bf16x8, make_uint4(w4[0], w4[1], w4[2], w4[3]));
        }
    }
    for (int grp = blockIdx.x; grp < NTOK / 8; grp += gridDim.x) {
        const int row = grp * 8 + wave; const bool isl = row < NLAT; const int b = isl ? row / SEQ : 8;
        {
            float4 v[8];
            load_row(isl ? xlat + (size_t)row * DM : xctx + (size_t)(row - NLAT) * DM, v, lane);
            if (POST) post_regs(v, Y2 + (size_t)row * DM, mod_post + (size_t)b * MODW + 2 * DM, npost, isl ? olat + (size_t)row * DM : octx + (size_t)(row - NLAT) * DM, lane);
            norm_regs(v, mod_n + (size_t)b * MODW, mod_n + (size_t)b * MODW + DM, npre, H + (size_t)row * DM, tile + wave * NT_ROWB, lane);
        }
        __syncthreads();
        f32x4 acc = {0.f, 0.f, 0.f, 0.f};
#pragma unroll
        for (int ks = 0; ks < 8; ++ks) {
            bf16x8 af = {0, 0, 0, 0, 0, 0, 0, 0};
            if (lr < 8) af = *(const bf16x8*)(tile + lr * NT_ROWB + (wave * 256 + ks * 32 + 8 * kgp) * 2);
            acc = __builtin_amdgcn_mfma_f32_16x16x32_bf16(af, bfrag[ks], acc, 0, 0, 0);
        }
        if (kgp < 2) {
#pragma unroll
            for (int r = 0; r < 4; ++r) red[(wave * 8 + 4 * kgp + r) * 16 + lr] = acc[r];
        }
        __syncthreads();
        if (tid < 128) { const int rr = tid >> 4, cc = tid & 15; float sum = 0.f;
#pragma unroll
            for (int w8 = 0; w8 < 8; ++w8) sum += red[(w8 * 8 + rr) * 16 + cc];
            GATES[(size_t)(grp * 8 + rr) * 16 + cc] = sum; }
    }
    __syncthreads();
}

#define XB_TMO      128
#define XB_XCNT(j)  (256  + 64 * (j))
#define XB_XSUB(j)  (1280 + 64 * (j))
#define XB_XGEN(j)  (2304 + 64 * (j))
#define XB_TOP      3328
#define XB_TOPGEN   3392
#define XCD_BAR_WORDS 3456
#define XB_SPIN_CAP (1u << 18)

__device__ __forceinline__ unsigned xb_ld(unsigned* p)              { return __hip_atomic_load(p, __ATOMIC_RELAXED, __HIP_MEMORY_SCOPE_AGENT); }
__device__ __forceinline__ unsigned xb_add(unsigned* p, unsigned v) { return __hip_atomic_fetch_add(p, v, __ATOMIC_RELAXED, __HIP_MEMORY_SCOPE_AGENT); }
__device__ __forceinline__ unsigned xb_xcc_id() { return (unsigned)__builtin_amdgcn_s_getreg((3 << 11) | 20) & 0xFu; }
#define XB_SPIN(cond, bar) do { unsigned _sp = 0; while (cond) { __builtin_amdgcn_s_sleep(1); \
    if ((++_sp & 255u) == 0u) { if (xb_ld(&(bar)[XB_TMO])) break; if (_sp > XB_SPIN_CAP) { atomicAdd(&(bar)[XB_TMO], 1u); break; } } } } while (0)

struct XcdBarrier {
    unsigned* bar; unsigned x;
    volatile __attribute__((address_space(3))) unsigned* st;
};

__device__ __forceinline__ XcdBarrier xcd_barrier_post(unsigned* bar, volatile __attribute__((address_space(3))) unsigned* st) {
    XcdBarrier b; b.bar = bar; b.x = xb_xcc_id(); b.st = st;
    if (threadIdx.x == 0) (void)xb_add(&bar[XB_XCNT(b.x)], 1u);
    return b;
}
__device__ __forceinline__ void xcd_barrier_complete(unsigned* bar, unsigned x, unsigned& nloc, unsigned& nx) {
    const unsigned G = gridDim.x * gridDim.y * gridDim.z;
    unsigned sum, cnt, mine, sp = 0u;
    for (;;) {
        sum = 0u; cnt = 0u; mine = 0u;
#pragma unroll
        for (unsigned j = 0; j < 16; ++j) { const unsigned c = xb_ld(&bar[XB_XCNT(j)]); sum += c; cnt += (c > 0u) ? 1u : 0u; mine = (j == x) ? c : mine; }
        if (sum == G) break;
        __builtin_amdgcn_s_sleep(1);
        if ((++sp & 255u) == 0u) { if (xb_ld(&bar[XB_TMO])) break; if (sp > XB_SPIN_CAP) { atomicAdd(&bar[XB_TMO], 1u); break; } }
    }
    nloc = mine > 0u ? mine : 1u; nx = cnt > 0u ? cnt : 1u;
}

__device__ __forceinline__ void xcd_barrier(const XcdBarrier& b) {
    asm volatile("s_waitcnt vmcnt(0)" ::: "memory");
    __syncthreads();
    if (threadIdx.x == 0) {
        unsigned* bar = b.bar;
        __builtin_amdgcn_s_waitcnt(0);
        unsigned nloc = b.st[0], nx = b.st[1];
        if (nloc == 0u) { xcd_barrier_complete(bar, b.x, nloc, nx); b.st[0] = nloc; b.st[1] = nx; }
        const unsigned old = xb_add(&bar[XB_XSUB(b.x)], 1u);
        const unsigned gen = old / nloc;
        if (old + 1u == (gen + 1u) * nloc) {
            __builtin_amdgcn_fence(__ATOMIC_RELEASE, "agent");
            asm volatile("s_waitcnt vmcnt(0)" ::: "memory");
            const unsigned og = xb_add(&bar[XB_TOP], 1u);
            const unsigned tg = og / nx;
            if (og + 1u == (tg + 1u) * nx) xb_add(&bar[XB_TOPGEN], 1u);
            else XB_SPIN(xb_ld(&bar[XB_TOPGEN]) == tg, bar);
            __builtin_amdgcn_fence(__ATOMIC_ACQUIRE, "agent");
            xb_add(&bar[XB_XGEN(b.x)], 1u);
            asm volatile("s_waitcnt vmcnt(0)" ::: "memory");
        } else {
            XB_SPIN(xb_ld(&bar[XB_XGEN(b.x)]) == gen, bar);
            __builtin_amdgcn_fence(__ATOMIC_ACQUIRE, "agent");
            asm volatile("s_waitcnt vmcnt(0)" ::: "memory");
        }
    }
    __syncthreads();
}

namespace cg = cooperative_groups;
#ifndef PROBE_DUP
#define PROBE_DUP 0
#endif
#define DUPN(k) ((PROBE_DUP == (k)) ? 2 : 1)
constexpr int MEGA_LDS = 131072 + 256;
struct MegaArgs { const float* in[20]; float* out; unsigned char* ws; };
__global__ __launch_bounds__(512, 2) void mega_fwd(MegaArgs a) {
    extern __shared__ __attribute__((aligned(16))) unsigned char lds[];
    cg::grid_group grid = cg::this_grid();
    volatile __attribute__((address_space(3))) unsigned* MISC = (volatile __attribute__((address_space(3))) unsigned*)((__attribute__((address_space(3))) unsigned char*)lds + 131072);
    if (threadIdx.x < 64) MISC[threadIdx.x] = 0u;
    __syncthreads();
    const XcdBarrier bar = xcd_barrier_post((unsigned*)(a.ws + WS_CTL) + 4096, MISC + 8);
    const int G = gridDim.x;
#define PHASE_IDS const int tid = opaque_tid(), lane = tid & 63, wave = tid >> 6, gw = blockIdx.x * 8 + wave, ngw = G * 8; (void)tid; (void)lane; (void)gw; (void)ngw; float* scr = (float*)lds + wave * (64 * 33); (void)scr
    const float* x = a.in[0]; const float* c = a.in[1]; const float* ctx = a.in[2]; const float* c_ctx = a.in[3];
    const float* w_ada = a.in[4]; const float* b_ada = a.in[5]; const float* norm_pre = a.in[6]; const float* norm_post = a.in[7];
    const float* w_in = a.in[8]; const float* w_out = a.in[9];
    float* out = a.out; unsigned char* ws = a.ws;
    float* MOD = (float*)(ws + WS_MOD); float* ROPE = (float*)(ws + WS_ROPE); float* GATES = (float*)(ws + WS_GATES);
    bf16_t* WOUT = (bf16_t*)(ws + WS_WOUT); bf16_t* WIN = (bf16_t*)(ws + WS_WIN); float* XC = (float*)(ws + WS_XC);
    bf16_t* H = (bf16_t*)(ws + WS_H); bf16_t* HM = (bf16_t*)(ws + WS_HM); bf16_t* P = (bf16_t*)(ws + WS_P);
    bf16_t* Y = H; bf16_t* Y2 = HM;

    { PHASE_IDS;
    for (int u = blockIdx.x; u < 192; u += G) mod_unit(u, c, c_ctx, w_ada, b_ada, MOD, (float*)lds);
    for (int i = blockIdx.x * 512 + tid; i < 1024; i += G * 512) { const int pos = i >> 4, f = i & 15; const float inv = powf(10000.f, -(float)f / 16.f); const float ang = (float)pos * inv;
        ROPE[2 * i] = cosf(ang); ROPE[2 * i + 1] = sinf(ang); }
    transpose_items(w_in, INC, DM, NP, WIN, scr, gw, ngw, lane);
    transpose_items(w_out, DM, DM, DM, WOUT, scr, gw, ngw, lane);
    transpose_items(w_out + (size_t)DM * DM, DM, DM, DM, WOUT + (size_t)DM * DM, scr, gw, ngw, lane); }
    grid.sync();
    norm_phase<false>(x, ctx, nullptr, nullptr, nullptr, nullptr, nullptr, MOD, norm_pre, w_in + NP, H, GATES, (char*)lds);
    xcd_barrier(bar);
    for (int l = 0; l < 2; ++l) {
        const float lam_init = l == 0 ? 0.2f : 0.35550906759f;
        const float* mod_l = MOD + (size_t)l * 9 * MODW;
        for (int rep_ = 0; rep_ < DUPN(2); ++rep_)
        { pg8::Gemm g{H, WIN, NTOK, NP, DM}; pg8::StaticOrder S; S.init(NTOK, NP, G, (int)blockIdx.x); pg8::EpiInProj E{P, NP, ROPE};
          pg8::gemm_phase<pg8::EpiInProj, pg8::StaticOrder, true, true>((PG8_LAS unsigned char*)lds, g, S, E); }
        xcd_barrier(bar);
        mls::qkconv_phase(P, Y, a.in[15] + (size_t)l * 3 * 1024, a.in[16] + l * 1024);
        xcd_barrier(bar);
        for (int rep_ = 0; rep_ < DUPN(3); ++rep_)
        mls::mlstm_phase(P, Y, GATES, HM, a.in[17] + l * 8, a.in[18] + l * 8, l == 0, (char*)lds);
        for (int rep_ = 0; rep_ < DUPN(4); ++rep_)
        att::attn_phase(P, Y, a.in[10] + l * 64, a.in[11] + l * 64, a.in[12] + l * 64, a.in[13] + l * 64, a.in[14] + l * 128, lam_init, l == 0, (char*)lds);
        xcd_barrier(bar);
        { PHASE_IDS; const int nrows = l == 0 ? NTOK : NLAT; for (int row = gw; row < nrows; row += ngw) finish_row(P, HM, a.in[19] + l * 1024, Y, row, lane); }
        xcd_barrier(bar);
        for (int rep_ = 0; rep_ < DUPN(5); ++rep_)
        { const int M = l == 0 ? NTOK : NLAT; pg8::Gemm g{Y, WOUT + (size_t)l * DM * DM, M, DM, DM}; pg8::StaticOrder S; S.init(M, DM, G, (int)blockIdx.x); pg8::EpiBf16 E{Y2, DM};
          pg8::gemm_phase<pg8::EpiBf16, pg8::StaticOrder, true, true>((PG8_LAS unsigned char*)lds, g, S, E); }
        if (l == 0) { PHASE_IDS;
            const int nbusy = (NTOK / 256) * (DM / 256) - 2 * G;
            if (nbusy >= 0 && nbusy < G) { if ((int)blockIdx.x >= nbusy) transpose_items(w_in + (size_t)DM * INC, INC, DM, NP, WIN, scr, ((int)blockIdx.x - nbusy) * 8 + wave, (G - nbusy) * 8, lane); }
            else transpose_items(w_in + (size_t)DM * INC, INC, DM, NP, WIN, scr, gw, ngw, lane);
        }
        xcd_barrier(bar);
        if (l == 0) {
            norm_phase<true>(x, ctx, Y2, mod_l, norm_post, out, XC, MOD + (size_t)9 * MODW, norm_pre + DM, w_in + (size_t)DM * INC + NP, H, GATES, (char*)lds);
            xcd_barrier(bar);
        } else { PHASE_IDS;
            for (int row = gw; row < NLAT; row += ngw) {
                float4 v[8];
                load_row(out + (size_t)row * DM, v, lane);
                post_regs(v, Y2 + (size_t)row * DM, mod_l + (size_t)(row / SEQ) * MODW + 2 * DM, norm_post + DM, out + (size_t)row * DM, lane);
            }
        }
    }
}

extern "C" void kernel_launch(void* const* d_in, const int* in_sizes, int n_in, void* d_out, int out_size, void* d_ws, size_t ws_size, hipStream_t stream) {
    (void)in_sizes; (void)n_in; (void)out_size; (void)ws_size;
    static int grid_blocks = 0;
    if (!grid_blocks) {
        int dev = 0, cus = 0, per_cu = 0;
        (void)hipGetDevice(&dev);
        (void)hipDeviceGetAttribute(&cus, hipDeviceAttributeMultiprocessorCount, dev);
        (void)hipFuncSetAttribute((const void*)mega_fwd, hipFuncAttributeMaxDynamicSharedMemorySize, MEGA_LDS);
        (void)hipOccupancyMaxActiveBlocksPerMultiprocessor(&per_cu, (const void*)mega_fwd, 512, MEGA_LDS);
        if (per_cu < 1) per_cu = 1;
        if (per_cu > 1) per_cu = 1;
        grid_blocks = cus * per_cu;
    }
    (void)hipMemsetAsync((char*)d_ws + WS_CTL, 0, 65536, stream);
    MegaArgs a{};
    for (int i = 0; i < 20; ++i) a.in[i] = (const float*)d_in[i];
    a.out = (float*)d_out; a.ws = (unsigned char*)d_ws;
    void* args[] = {&a};
    (void)hipLaunchCooperativeKernel((const void*)mega_fwd, dim3(grid_blocks), dim3(512), args, (size_t)MEGA_LDS, stream);
}
```

```cpp
#include <hip/hip_runtime.h>
#include <hip/hip_cooperative_groups.h>
#include <stdint.h>
#include <math.h>

#define DEVI __device__ __forceinline__
typedef unsigned short bf16_t;

constexpr int DM = 2048, NBATCH = 8, SEQ = 2048, CTXL = 256;
constexpr int NLAT = NBATCH * SEQ, NCTX = NBATCH * CTXL, NTOK = NLAT + NCTX;
constexpr int INC = 8208, NP = 8192, MODW = 6144;
constexpr int C_QA = 0, C_KA = 1024, C_VA = 2048, C_GA = 3072, C_QB = 4096, C_KB = 4608, C_VB = 5120, C_OB = 6144, C_GB = 7168;
constexpr float EPS = 1e-6f;

constexpr size_t MiB = (size_t)1 << 20;
constexpr size_t WS_CTL = 0, WS_MOD = 1 * MiB, WS_SC = WS_MOD + 512 * 1024, WS_ROPE = 2 * MiB, WS_GATES = 3 * MiB, WS_WOUT = 8 * MiB,
                 WS_WIN = 24 * MiB, WS_XC = 56 * MiB, WS_H = 72 * MiB, WS_HM = 144 * MiB, WS_P = 216 * MiB, WS_END = 504 * MiB;

DEVI int opaque_tid() { int t = threadIdx.x; asm volatile("" : "+v"(t)); return t; }
DEVI float bf2f(bf16_t v) { return __uint_as_float(((unsigned)v) << 16); }
DEVI bf16_t f2bf(float f) { unsigned u = __float_as_uint(f); return (bf16_t)((u + 0x7fffu + ((u >> 16) & 1u)) >> 16); }
DEVI unsigned pk2(float lo, float hi) { return (unsigned)f2bf(lo) | ((unsigned)f2bf(hi) << 16); }
DEVI float wave_sum(float v) {
#pragma unroll
    for (int o = 32; o > 0; o >>= 1) v += __shfl_xor(v, o);
    return v;
}
DEVI float wave_max(float v) {
#pragma unroll
    for (int o = 32; o > 0; o >>= 1) v = fmaxf(v, __shfl_xor(v, o));
    return v;
}
DEVI float silu_f(float x) { return x / (1.f + expf(-x)); }
DEVI float sigmoid_f(float x) { return 1.f / (1.f + expf(-x)); }


DEVI void transpose_item(const float* __restrict__ W, int ldw, int K, int N, bf16_t* __restrict__ WT, float* scr, int item, int lane) {
    const int nblk = N / 32, kb = item / nblk, nb = item % nblk, k0 = 64 * kb, n0 = 32 * nb;
#pragma unroll 8
    for (int i = 0; i < 32; ++i) { const int kk = 2 * i + (lane >> 5); scr[kk * 33 + (lane & 31)] = W[(size_t)(k0 + kk) * ldw + n0 + (lane & 31)]; }
    asm volatile("s_waitcnt lgkmcnt(0)" ::: "memory");
    const int c = lane & 7;
#pragma unroll
    for (int j = 0; j < 4; ++j) {
        const int n = (lane >> 3) + 8 * j; const float* s = scr + (8 * c) * 33 + n;
        uint4 o; o.x = pk2(s[0 * 33], s[1 * 33]); o.y = pk2(s[2 * 33], s[3 * 33]); o.z = pk2(s[4 * 33], s[5 * 33]); o.w = pk2(s[6 * 33], s[7 * 33]);
        *(uint4*)(WT + (size_t)(n0 + n) * K + k0 + 8 * c) = o;
    }
    asm volatile("s_waitcnt lgkmcnt(0)" ::: "memory");
}

namespace pg8 {
#define PG8_LAS __attribute__((address_space(3)))
typedef unsigned short bf16_t;
typedef short bf16x8 __attribute__((ext_vector_type(8)));
typedef float f32x4 __attribute__((ext_vector_type(4)));
typedef unsigned u32x4 __attribute__((ext_vector_type(4)));
constexpr int BM = 256, BK = 64, HALF = 128, HTB = HALF * BK * 2  , STAGE_BYTES = 8 * HTB, NXCD = 8, WGM = 8;

__host__ __device__ __forceinline__ int lds_byte(int r, int c) { const int st = (r >> 4) * 2 + (c >> 5), rr = r & 15, cc = c & 31, ob = rr * 64 + cc * 2; return st * 1024 + (ob ^ (((ob >> 9) & 1) << 5)); }
__host__ __device__ __forceinline__ void stage_rc(int b, int& R, int& C) { const int st = b / 1024, sb = b % 1024, swz = sb ^ (((sb >> 9) & 1) << 5); R = (st >> 1) * 16 + swz / 64; C = (st & 1) * 32 + (swz % 64) / 2; }
__host__ __device__ __forceinline__ int perm32(int rho) { const int n = rho >> 4, i = rho & 15; return 8 * (i >> 2) + 4 * n + (i & 3); }

struct Unit { int pm, pn; };
struct Gemm { const bf16_t* A; const bf16_t* Bt; int M, N, K; };

struct StaticOrder {
    int nM, nN, nwg, G, c;
    __host__ __device__ void init(int M, int N, int G_, int c_) { nM = M / BM; nN = N / BM; nwg = nM * nN; G = G_; c = c_; }
    __host__ __device__ bool next(int i, Unit& u) const {
        const long L = (long)i * G + c; if (L >= nwg) return false;
        int wgid = (int)L; { const int q = nwg / NXCD, r = nwg % NXCD, xcd = wgid % NXCD, off = wgid / NXCD; wgid = (xcd < r ? xcd * (q + 1) : r * (q + 1) + (xcd - r) * q) + off; }
        const int nig = WGM * nN, gid = wgid / nig, fm = gid * WGM, gsz = (nM - fm) < WGM ? (nM - fm) : WGM;
        u.pm = fm + ((wgid % nig) % gsz); u.pn = (wgid % nig) / gsz; return true;
    }
    __device__ __forceinline__ void a_ready(const Unit&) const {}
    __device__ __forceinline__ void done(const Unit&) const {}
};

__device__ __forceinline__ unsigned cvt_pk_bf16(float lo, float hi) { unsigned r; asm volatile("v_cvt_pk_bf16_f32 %0, %1, %2" : "=v"(r) : "v"(lo), "v"(hi)); return r; }

struct EpiBf16 {
    static constexpr bool PERM = true, AFTER_DRAIN = false;
    bf16_t* O; int ldc;
    __device__ __forceinline__ void operator()(const f32x4 (&acc)[2][2][4][2], const Unit& u, int wr, int wc, int fr, int fq) const {
        const int row0 = u.pm * BM + wr * 64 + fr, col0 = u.pn * BM + wc * 32 + 8 * fq;
#pragma unroll
        for (int ai = 0; ai < 2; ++ai)
#pragma unroll
            for (int m = 0; m < 4; ++m) { bf16_t* rowp = O + (size_t)(row0 + ai * HALF + m * 16) * ldc + col0;
#pragma unroll
                for (int bj = 0; bj < 2; ++bj) { const f32x4 v0 = acc[ai][bj][m][0], v1 = acc[ai][bj][m][1];
                    u32x4 w; w.x = cvt_pk_bf16(v0[0], v0[1]); w.y = cvt_pk_bf16(v0[2], v0[3]); w.z = cvt_pk_bf16(v1[0], v1[1]); w.w = cvt_pk_bf16(v1[2], v1[3]);
                    *(u32x4*)(rowp + bj * HALF) = w; } }
    }
};
struct EpiInProj {
    static constexpr bool PERM = true, AFTER_DRAIN = false;
    bf16_t* O; int ldc; const float* rope;
    __device__ __forceinline__ void operator()(const f32x4 (&acc)[2][2][4][2], const Unit& u, int wr, int wc, int fr, int fq) const {
        const int row0 = u.pm * BM + wr * 64 + fr, col0 = u.pn * BM + wc * 32 + 8 * fq;
        const bool do_rope = (u.pn < 8) && (u.pm < 64);
        const float qsc = (u.pn < 4) ? 0.18033688011112042f : 1.f;
#pragma unroll
        for (int ai = 0; ai < 2; ++ai)
#pragma unroll
            for (int m = 0; m < 4; ++m) { const int row = row0 + ai * HALF + m * 16; bf16_t* rowp = O + (size_t)row * ldc + col0;
                f32x4 cs01 = {1.f, 0.f, 1.f, 0.f}, cs23 = {1.f, 0.f, 1.f, 0.f};
                if (do_rope) { const int pos = (wc & 1) ? (row & 63) : ((row >> 6) & 31); const f32x4* rp = (const f32x4*)(rope + (size_t)(pos * 16 + 4 * fq) * 2); cs01 = rp[0]; cs23 = rp[1]; }
#pragma unroll
                for (int bj = 0; bj < 2; ++bj) { f32x4 v0 = acc[ai][bj][m][0], v1 = acc[ai][bj][m][1];
                    if (do_rope) {
                        const float a0 = v0[0] * cs01[0] - v0[1] * cs01[1], a1 = v0[0] * cs01[1] + v0[1] * cs01[0];
                        const float a2 = v0[2] * cs01[2] - v0[3] * cs01[3], a3 = v0[2] * cs01[3] + v0[3] * cs01[2];
                        const float b0 = v1[0] * cs23[0] - v1[1] * cs23[1], b1 = v1[0] * cs23[1] + v1[1] * cs23[0];
                        const float b2 = v1[2] * cs23[2] - v1[3] * cs23[3], b3 = v1[2] * cs23[3] + v1[3] * cs23[2];
                        v0 = (f32x4){a0, a1, a2, a3}; v1 = (f32x4){b0, b1, b2, b3};
                    }
                    v0 = v0 * qsc; v1 = v1 * qsc;
                    u32x4 w; w.x = cvt_pk_bf16(v0[0], v0[1]); w.y = cvt_pk_bf16(v0[2], v0[3]); w.z = cvt_pk_bf16(v1[0], v1[1]); w.w = cvt_pk_bf16(v1[2], v1[3]);
                    *(u32x4*)(rowp + bj * HALF) = w; } }
    }
};

template <class Epi, class Sched, bool ALIGN_EPI = false, bool SP2 = false>
__device__ __forceinline__ void gemm_phase(PG8_LAS unsigned char* lds, const Gemm g, const Sched& S, const Epi& E) {
    const int tid = opaque_tid(), wid = __builtin_amdgcn_readfirstlane(tid >> 6), lane = tid & 63, wr = wid >> 2, wc = wid & 3, fr = lane & 15, fq = lane >> 4;
    const int K = g.K, nt = K / BK;
    unsigned voffA[2], voffB[2];
#pragma unroll
    for (int i = 0; i < 2; ++i) { int R, C; stage_rc(tid * 16 + i * 8192, R, C); const int Rb = Epi::PERM ? ((R & ~31) + perm32(R & 31)) : R;
        voffA[i] = (unsigned)(R * K + C) * 2u; voffB[i] = (unsigned)(Rb * K + C) * 2u; }
    const size_t kstep = (size_t)(BK * 2);
    const size_t hstep = (size_t)HALF * K * 2;
    const size_t tstep = 2 * hstep;
    const unsigned ldsw = (unsigned)wid * 1024u;
    const int aoff = lds_byte(wr * 64 + fr, fq * 8), boff = lds_byte(wc * 32 + fr, fq * 8);
#define PG8_SA(b, h) (((b) * 2 + (h)) * HTB)
#define PG8_SB(b, h) ((4 + (b) * 2 + (h)) * HTB)
#define PG8_STAGE(bufoff, gbase, voff) do { _Pragma("unroll") for (int _i = 0; _i < 2; ++_i) \
        __builtin_amdgcn_global_load_lds((const unsigned*)((const char*)(gbase) + (voff)[_i]), (PG8_LAS unsigned*)(lds + (bufoff) + ldsw + _i * 8192), 16, 0, 0); } while (0)
#define PG8_LDA(dst, b, h) do { _Pragma("unroll") for (int m = 0; m < 4; ++m) _Pragma("unroll") for (int k = 0; k < 2; ++k) dst[m][k] = *(const PG8_LAS bf16x8*)(lds + PG8_SA(b, h) + aoff + m * 2048 + k * 1024); } while (0)
#define PG8_LDB(dst, b, h) do { _Pragma("unroll") for (int n = 0; n < 2; ++n) _Pragma("unroll") for (int k = 0; k < 2; ++k) dst[n][k] = *(const PG8_LAS bf16x8*)(lds + PG8_SB(b, h) + boff + n * 2048 + k * 1024); } while (0)
#define PG8_MMA(ai, bj, At, Bt) do { __builtin_amdgcn_s_setprio(1); _Pragma("unroll") for (int m = 0; m < 4; ++m) _Pragma("unroll") for (int n = 0; n < 2; ++n) _Pragma("unroll") for (int k = 0; k < 2; ++k) \
        acc[ai][bj][m][n] = __builtin_amdgcn_mfma_f32_16x16x32_bf16(Bt[n][k], At[m][k], acc[ai][bj][m][n], 0, 0, 0); __builtin_amdgcn_s_setprio(0); } while (0)
#define PG8_WAIT_V(n) asm volatile("s_waitcnt vmcnt(" #n ")" ::: "memory")
#define PG8_WAIT_L(n) asm volatile("s_waitcnt lgkmcnt(" #n ")" ::: "memory")
#define PG8_BAR __builtin_amdgcn_s_barrier()
#define PG8_SCHED __builtin_amdgcn_sched_barrier(0)
    Unit cur, nxt; int ui = 0;
    if (!S.next(0, cur)) return;
    f32x4 acc[2][2][4][2];
#pragma unroll
    for (int a = 0; a < 2; ++a)
#pragma unroll
        for (int b = 0; b < 2; ++b)
#pragma unroll
            for (int m = 0; m < 4; ++m)
#pragma unroll
                for (int n = 0; n < 2; ++n) acc[a][b][m][n] = (f32x4){0.f, 0.f, 0.f, 0.f};
    bf16x8 At[4][2], B0[2][2], B1[2][2];
    const char* cA = (const char*)g.A + (size_t)cur.pm * tstep; const char* cB = (const char*)g.Bt + (size_t)cur.pn * tstep;
    S.a_ready(cur);
    if constexpr (SP2) {
        PG8_STAGE(PG8_SB(0, 0), cB, voffB); PG8_STAGE(PG8_SB(0, 1), cB + hstep, voffB); PG8_STAGE(PG8_SA(0, 0), cA, voffA); PG8_STAGE(PG8_SA(0, 1), cA + hstep, voffA);
        if (wr == 1) PG8_BAR;
        PG8_WAIT_V(2); PG8_BAR;
        PG8_STAGE(PG8_SB(1, 0), cB + kstep, voffB); PG8_STAGE(PG8_SA(1, 0), cA + kstep, voffA); PG8_STAGE(PG8_SB(1, 1), cB + hstep + kstep, voffB);
        PG8_WAIT_V(6); PG8_BAR;
    } else {
        PG8_STAGE(PG8_SB(0, 0), cB, voffB); PG8_STAGE(PG8_SA(0, 0), cA, voffA); PG8_STAGE(PG8_SB(0, 1), cB + hstep, voffB); PG8_STAGE(PG8_SA(0, 1), cA + hstep, voffA);
        if (wr == 1) PG8_BAR;
        PG8_WAIT_V(4); PG8_BAR;
        PG8_STAGE(PG8_SB(1, 0), cB + kstep, voffB); PG8_STAGE(PG8_SA(1, 0), cA + kstep, voffA); PG8_STAGE(PG8_SB(1, 1), cB + hstep + kstep, voffB);
        PG8_WAIT_V(6); PG8_BAR;
    }
    for (;;) {
        const bool has_next = S.next(ui + 1, nxt);
        const char* nA = has_next ? (const char*)g.A + (size_t)nxt.pm * tstep : cA; const char* nB = has_next ? (const char*)g.Bt + (size_t)nxt.pn * tstep : cB;
        for (int t = 0; t < nt; t += 2) {
            const bool last = (t == nt - 2);
            const char* a1 = cA + (size_t)(t + 1) * kstep;
            const char* a2 = last ? nA : cA + (size_t)(t + 2) * kstep; const char* b2 = last ? nB : cB + (size_t)(t + 2) * kstep;
            const char* a3 = a2 + kstep; const char* b3 = b2 + kstep;
            if (last && has_next) S.a_ready(nxt);
            if constexpr (SP2) {
            PG8_LDB(B0, 0, 0); PG8_LDB(B1, 0, 1); PG8_SCHED; PG8_LDA(At, 0, 0); PG8_STAGE(PG8_SA(1, 1), a1 + hstep, voffA);
            PG8_WAIT_V(8); PG8_WAIT_L(0); PG8_BAR; PG8_MMA(0, 0, At, B0); PG8_MMA(0, 1, At, B1); PG8_BAR; PG8_SCHED;
            PG8_LDA(At, 0, 1); PG8_STAGE(PG8_SB(0, 0), b2, voffB); PG8_STAGE(PG8_SB(0, 1), b2 + hstep, voffB); PG8_STAGE(PG8_SA(0, 0), a2, voffA);
            PG8_WAIT_V(8); PG8_WAIT_L(0); PG8_BAR; PG8_MMA(1, 0, At, B0); PG8_MMA(1, 1, At, B1); PG8_BAR; PG8_SCHED;
            PG8_LDB(B0, 1, 0); PG8_LDB(B1, 1, 1); PG8_SCHED; PG8_LDA(At, 1, 0); PG8_STAGE(PG8_SA(0, 1), a2 + hstep, voffA);
            PG8_WAIT_V(8); PG8_WAIT_L(0); PG8_BAR; PG8_MMA(0, 0, At, B0); PG8_MMA(0, 1, At, B1); PG8_BAR; PG8_SCHED;
            PG8_LDA(At, 1, 1); PG8_STAGE(PG8_SB(1, 0), b3, voffB); PG8_STAGE(PG8_SB(1, 1), b3 + hstep, voffB); PG8_STAGE(PG8_SA(1, 0), a3, voffA);
            PG8_WAIT_V(8); PG8_WAIT_L(0); PG8_BAR; PG8_MMA(1, 0, At, B0); PG8_MMA(1, 1, At, B1); PG8_BAR; PG8_SCHED;
            } else {
            PG8_LDB(B0, 0, 0); PG8_SCHED; PG8_LDA(At, 0, 0); PG8_STAGE(PG8_SA(1, 1), a1 + hstep, voffA);
            PG8_WAIT_L(8); PG8_BAR; PG8_WAIT_L(0); PG8_MMA(0, 0, At, B0); PG8_BAR; PG8_SCHED;
            PG8_LDB(B1, 0, 1); PG8_STAGE(PG8_SB(0, 0), b2, voffB);
            PG8_BAR; PG8_WAIT_L(0); PG8_MMA(0, 1, At, B1); PG8_BAR;
            PG8_LDA(At, 0, 1); PG8_STAGE(PG8_SA(0, 0), a2, voffA);
            PG8_BAR; PG8_WAIT_L(0); PG8_MMA(1, 0, At, B0); PG8_BAR; PG8_SCHED;
            PG8_STAGE(PG8_SB(0, 1), b2 + hstep, voffB);
            PG8_WAIT_V(6); PG8_BAR; PG8_MMA(1, 1, At, B1); PG8_BAR;
            PG8_LDB(B0, 1, 0); PG8_SCHED; PG8_LDA(At, 1, 0); PG8_STAGE(PG8_SA(0, 1), a2 + hstep, voffA);
            PG8_WAIT_L(8); PG8_BAR; PG8_WAIT_L(0); PG8_MMA(0, 0, At, B0); PG8_BAR; PG8_SCHED;
            PG8_LDB(B1, 1, 1); PG8_STAGE(PG8_SB(1, 0), b3, voffB);
            PG8_BAR; PG8_WAIT_L(0); PG8_MMA(0, 1, At, B1); PG8_BAR;
            PG8_LDA(At, 1, 1); PG8_STAGE(PG8_SA(1, 0), a3, voffA);
            PG8_BAR; PG8_WAIT_L(0); PG8_MMA(1, 0, At, B0); PG8_BAR; PG8_SCHED;
            PG8_STAGE(PG8_SB(1, 1), b3 + hstep, voffB);
            PG8_WAIT_V(6); PG8_BAR; PG8_MMA(1, 1, At, B1); PG8_BAR;
            }
        }
        if constexpr (ALIGN_EPI) { if (wr == 0) PG8_BAR; }
        if constexpr (!Epi::AFTER_DRAIN) { E(acc, cur, wr, wc, fr, fq); S.done(cur); }
        if (!has_next) break;
#pragma unroll
        for (int a = 0; a < 2; ++a)
#pragma unroll
            for (int b = 0; b < 2; ++b)
#pragma unroll
                for (int m = 0; m < 4; ++m)
#pragma unroll
                    for (int n = 0; n < 2; ++n) acc[a][b][m][n] = (f32x4){0.f, 0.f, 0.f, 0.f};
        cur = nxt; cA = nA; cB = nB; ++ui;
        if constexpr (ALIGN_EPI) { if (wr == 1) PG8_BAR; }
    }
    PG8_WAIT_V(0);
    if constexpr (!ALIGN_EPI) { if (wr == 0) PG8_BAR; }
    PG8_BAR;
    if constexpr (Epi::AFTER_DRAIN) { E.fused(acc, cur, wr, wc, fr, fq, lds, wid, lane); S.done(cur); }
#undef PG8_SA
#undef PG8_SB
#undef PG8_STAGE
#undef PG8_LDA
#undef PG8_LDB
#undef PG8_MMA
#undef PG8_WAIT_V
#undef PG8_WAIT_L
#undef PG8_BAR
#undef PG8_SCHED
}
}

namespace att {
using bf16x8 = __attribute__((ext_vector_type(8))) short;
using s16x4  = __attribute__((ext_vector_type(4))) short;
using f32x16 = __attribute__((ext_vector_type(16))) float;
using u32x4  = __attribute__((ext_vector_type(4))) unsigned;
constexpr int NW = 8, QBLK = 32, KVBLK = 64, QROWS = 128;
constexpr float SCALE = 0.125f, QPRESCALE = SCALE * 1.4426950408889634f, THRL = 8.f;
constexpr int SHM_V = KVBLK * 128 * 2, SHM_K = KVBLK * 128 * 2, SHM_ATTN = 2 * SHM_V + 2 * SHM_K + NW * 64 * 4;
#define KSWZ(row, colB) ((row) * 256 + ((colB) ^ (((row) & 7) << 4)))
#define SBAR() __builtin_amdgcn_sched_barrier(0)
__device__ __forceinline__ int crow(int r, int hi) { return (r & 3) + 8 * (r >> 2) + 4 * hi; }
__device__ __forceinline__ unsigned cvtpk(float lo, float hi) { unsigned r; asm volatile("v_cvt_pk_bf16_f32 %0, %1, %2" : "=v"(r) : "v"(lo), "v"(hi)); return r; }
__device__ __forceinline__ void partialSM(f32x16& p0, f32x16& p1, float& mhat, f32x16& negm, float& alpha) {
  float a = fmaxf(fmaxf(p0[0], p0[1]), p1[0]), b2 = fmaxf(fmaxf(p0[2], p0[3]), p1[1]); a = fmaxf(fmaxf(a, p1[2]), p1[3]);
#pragma unroll
  for (int r = 4; r < 16; r += 4) { a = fmaxf(fmaxf(a, p0[r]), p0[r + 1]); b2 = fmaxf(fmaxf(b2, p0[r + 2]), p0[r + 3]); a = fmaxf(fmaxf(a, p1[r]), p1[r + 1]); b2 = fmaxf(fmaxf(b2, p1[r + 2]), p1[r + 3]); }
  float rm = fmaxf(a, b2);
  { auto rr = __builtin_amdgcn_permlane32_swap(__float_as_uint(rm), __float_as_uint(rm), false, false);
    rm = fmaxf(__uint_as_float(rr[0]), __uint_as_float(rr[1])); }
  alpha = 1.f;
  if (__builtin_expect(__any(rm > THRL), 0)) {
    const float dl = fmaxf(rm, 0.f); mhat += dl;
#pragma unroll
    for (int r = 0; r < 16; ++r) { p0[r] -= dl; p1[r] -= dl; }
#pragma unroll
    for (int r = 0; r < 16; ++r) negm[r] = -mhat;
    alpha = __builtin_amdgcn_exp2f(-dl);
  }
#pragma unroll
  for (int r = 0; r < 16; ++r) p0[r] = __builtin_amdgcn_exp2f(p0[r]);
}
__device__ __forceinline__ void finishSM(f32x16& p0, f32x16& p1, float alpha, float& l_reg, bf16x8& pa0, bf16x8& pa1, bf16x8& pa2, bf16x8& pa3) {
#pragma unroll
  for (int r = 0; r < 16; ++r) p1[r] = __builtin_amdgcn_exp2f(p1[r]);
  float ps = 0;
#pragma unroll
  for (int r = 0; r < 16; ++r) ps += p0[r];
#pragma unroll
  for (int r = 0; r < 16; ++r) ps += p1[r];
  { auto rr = __builtin_amdgcn_permlane32_swap(__float_as_uint(ps), __float_as_uint(ps), false, false);
    ps = __uint_as_float(rr[0]) + __uint_as_float(rr[1]); }
  l_reg = l_reg * alpha + ps;
#define PK4(P, BASE, OUT) do { unsigned a0 = cvtpk(P[BASE + 0], P[BASE + 1]), a1 = cvtpk(P[BASE + 2], P[BASE + 3]);   \
    unsigned b0 = cvtpk(P[BASE + 4], P[BASE + 5]), b1 = cvtpk(P[BASE + 6], P[BASE + 7]);                              \
    auto r0 = __builtin_amdgcn_permlane32_swap(a0, b0, false, false); auto r1 = __builtin_amdgcn_permlane32_swap(a1, b1, false, false); \
    u32x4 w = {r0[0], r1[0], r0[1], r1[1]}; OUT = *reinterpret_cast<bf16x8*>(&w); } while (0)
  PK4(p0, 0, pa0); PK4(p0, 8, pa1); PK4(p1, 0, pa2); PK4(p1, 8, pa3);
#undef PK4
}
__device__ __forceinline__ void qkt(f32x16& p0, f32x16& p1, const char* Ks, const bf16x8* qr, const f32x16& negm, int r32, int hi, int sub) {
#pragma unroll
  for (int d0 = 0; d0 < 4; ++d0) { const int cb = (sub * 64 + d0 * 16 + hi * 8) * 2;
    const bf16x8 b0 = *reinterpret_cast<const bf16x8*>(Ks + KSWZ(r32, cb));
    const bf16x8 b1 = *reinterpret_cast<const bf16x8*>(Ks + KSWZ(32 + r32, cb));
    if (d0 == 0) { p0 = __builtin_amdgcn_mfma_f32_32x32x16_bf16(b0, qr[0], negm, 0, 0, 0); p1 = __builtin_amdgcn_mfma_f32_32x32x16_bf16(b1, qr[0], negm, 0, 0, 0); }
    else { p0 = __builtin_amdgcn_mfma_f32_32x32x16_bf16(b0, qr[d0], p0, 0, 0, 0); p1 = __builtin_amdgcn_mfma_f32_32x32x16_bf16(b1, qr[d0], p1, 0, 0, 0); } }
}
__device__ __forceinline__ int v_st(int k, int c) { const int kk = (k & ~0xC) | ((k & 4) << 1) | ((k & 8) >> 1); return ((kk >> 3) * 4 + (c >> 5)) * 512 + ((kk & 7) * 32 + (c & 31)) * 2; }
__device__ __forceinline__ int v_rd_base(int lane) { return ((lane & 3) << 3) | (((lane >> 2) & 3) << 6) | (((lane >> 4) & 1) << 5) | (((lane >> 5) & 1) << 8); }
constexpr int v_rd_off(int d0, int ks, int half) { return d0 * 512 + ks * 4096 + half * 2048; }
template <int OFF> __device__ __forceinline__ s16x4 tr_read(int vb) {
  s16x4 r; asm volatile("ds_read_b64_tr_b16 %0, %1 offset:%2" : "=&v"(r) : "v"(vb), "i"(OFF) : "memory"); return r;
}
template <int D0> __device__ __forceinline__ void pv_one(f32x16& od, int vb, bf16x8 pa0, bf16x8 pa1, bf16x8 pa2, bf16x8 pa3) {
  const s16x4 l0 = tr_read<v_rd_off(D0, 0, 0)>(vb), h0 = tr_read<v_rd_off(D0, 0, 1)>(vb), l1 = tr_read<v_rd_off(D0, 1, 0)>(vb), h1 = tr_read<v_rd_off(D0, 1, 1)>(vb);
  const s16x4 l2 = tr_read<v_rd_off(D0, 2, 0)>(vb), h2 = tr_read<v_rd_off(D0, 2, 1)>(vb), l3 = tr_read<v_rd_off(D0, 3, 0)>(vb), h3 = tr_read<v_rd_off(D0, 3, 1)>(vb);
  asm volatile("s_waitcnt lgkmcnt(0)" ::: "memory"); SBAR();
#define PK(L, H) (bf16x8){L[0], L[1], L[2], L[3], H[0], H[1], H[2], H[3]}
  od = __builtin_amdgcn_mfma_f32_32x32x16_bf16(pa0, PK(l0, h0), od, 0, 0, 0);
  od = __builtin_amdgcn_mfma_f32_32x32x16_bf16(pa1, PK(l1, h1), od, 0, 0, 0);
  od = __builtin_amdgcn_mfma_f32_32x32x16_bf16(pa2, PK(l2, h2), od, 0, 0, 0);
  od = __builtin_amdgcn_mfma_f32_32x32x16_bf16(pa3, PK(l3, h3), od, 0, 0, 0);
#undef PK
}
__device__ __forceinline__ void pv_d0(f32x16* o, int vb, bf16x8 pa0, bf16x8 pa1, bf16x8 pa2, bf16x8 pa3) {
  pv_one<0>(o[0], vb, pa0, pa1, pa2, pa3); pv_one<1>(o[1], vb, pa0, pa1, pa2, pa3); pv_one<2>(o[2], vb, pa0, pa1, pa2, pa3); pv_one<3>(o[3], vb, pa0, pa1, pa2, pa3);
}
__device__ __forceinline__ long ktile_row(int b, int t) { return t < 4 ? (long)(NLAT + b * CTXL + 64 * t) : (long)(b * SEQ + 64 * (t - 4)); }

__device__ __forceinline__ void attn_unit(const bf16_t* __restrict__ Pm, bf16_t* __restrict__ Y, long qrow0, int b, int hh, int NT, float lam, float lam_init,
                                          const float* __restrict__ subln, char* lds) {
  const int tid = opaque_tid(), wid = tid >> 6, lane = tid & 63, r32 = lane & 31, hi = lane >> 5;
  const int sub = wid & 1, pr = wid >> 1;
  char* V_lds = lds; char* K_lds = lds + 2 * SHM_V;
  float* ws = (float*)(lds + 2 * SHM_V + 2 * SHM_K) + wid * 64; float* li_l = ws; float* al_l = ws + 32;
  float mhat = 0.f, l_reg = 0; f32x16 o[4] = {}; f32x16 negm = {}; bf16x8 qr[4];
  const bf16_t* Qw = Pm + (qrow0 + pr * QBLK + r32) * NP + C_QA + hh * 128 + sub * 64 + hi * 8;
#pragma unroll
  for (int d0 = 0; d0 < 4; ++d0) qr[d0] = *reinterpret_cast<const bf16x8*>(Qw + d0 * 16);
  const int sr = tid >> 4, sc = (tid & 15) * 8, vst0 = v_st(sr, sc), vst1 = v_st(32 + sr, sc);
  const int vb0 = (int)(uintptr_t)V_lds + v_rd_base(lane);
  const bf16_t* Kcol = Pm + C_KA + hh * 128 + sc; const bf16_t* Vcol = Pm + C_VA + hh * 128 + sc;
  struct { bf16x8 vs0, vs1, ks0, ks1; } sr_[1];
#define SLOAD(i, t) do { const long r0_ = ktile_row(b, (t)) + sr; \
    sr_[i].vs0 = *reinterpret_cast<const bf16x8*>(Vcol + r0_ * NP); sr_[i].vs1 = *reinterpret_cast<const bf16x8*>(Vcol + (r0_ + 32) * NP); \
    sr_[i].ks0 = *reinterpret_cast<const bf16x8*>(Kcol + r0_ * NP); sr_[i].ks1 = *reinterpret_cast<const bf16x8*>(Kcol + (r0_ + 32) * NP); } while (0)
#define SWRITE(bb, i) do { *(bf16x8*)(V_lds + (bb) * SHM_V + vst0) = sr_[i].vs0; *(bf16x8*)(V_lds + (bb) * SHM_V + vst1) = sr_[i].vs1; const int kc = sc * 2; \
    *(bf16x8*)(K_lds + (bb) * SHM_K + KSWZ(sr, kc)) = sr_[i].ks0; *(bf16x8*)(K_lds + (bb) * SHM_K + KSWZ(32 + sr, kc)) = sr_[i].ks1; } while (0)
#define SWAIT() asm volatile("s_waitcnt vmcnt(0)" ::: "memory")
#define RESC(a) do { if (__any((a) < 1.f)) { if (hi == 0) al_l[r32] = (a); asm volatile("s_waitcnt lgkmcnt(0)" ::: "memory"); \
    _Pragma("unroll") for (int d = 0; d < 4; ++d) _Pragma("unroll") for (int r = 0; r < 16; ++r) o[d][r] *= al_l[crow(r, hi)]; } } while (0)
  f32x16 pA0, pA1, pB0, pB1; float alA, alB; bf16x8 pa0, pa1, pa2, pa3;
  constexpr int SE = 0, SO = 0;
  SLOAD(SE, 0); asm volatile("s_waitcnt vmcnt(0)" ::: "memory"); SWRITE(0, SE); __syncthreads();
  qkt(pA0, pA1, K_lds, qr, negm, r32, hi, sub); partialSM(pA0, pA1, mhat, negm, alA);
  SLOAD(SO, 1);
  SWAIT(); SWRITE(1, SO); __syncthreads();
  for (int j = 1; j + 1 < NT; j += 2) {
    SBAR(); qkt(pB0, pB1, K_lds + SHM_K, qr, negm, r32, hi, sub);
    finishSM(pA0, pA1, alA, l_reg, pa0, pa1, pa2, pa3); SBAR();
    SLOAD(SO, j + 1); SBAR();
    pv_d0(o, vb0, pa0, pa1, pa2, pa3); partialSM(pB0, pB1, mhat, negm, alB);
    __syncthreads(); SWAIT(); SWRITE(0, SE);
    RESC(alB); __syncthreads();
    SBAR(); qkt(pA0, pA1, K_lds, qr, negm, r32, hi, sub);
    finishSM(pB0, pB1, alB, l_reg, pa0, pa1, pa2, pa3); SBAR();
    SLOAD(SE, j + 2); SBAR();
    pv_d0(o, vb0 + SHM_V, pa0, pa1, pa2, pa3); partialSM(pA0, pA1, mhat, negm, alA);
    __syncthreads(); SWAIT(); SWRITE(1, SO);
    RESC(alA); __syncthreads();
  }
  SBAR(); qkt(pB0, pB1, K_lds + SHM_K, qr, negm, r32, hi, sub);
  finishSM(pA0, pA1, alA, l_reg, pa0, pa1, pa2, pa3); SBAR();
  pv_d0(o, vb0, pa0, pa1, pa2, pa3); partialSM(pB0, pB1, mhat, negm, alB);
  __syncthreads(); RESC(alB);
  finishSM(pB0, pB1, alB, l_reg, pa0, pa1, pa2, pa3); SBAR();
  pv_d0(o, vb0 + SHM_V, pa0, pa1, pa2, pa3);
  if (hi == 0) li_l[r32] = l_reg; asm volatile("s_waitcnt lgkmcnt(0)" ::: "memory");
  const float fac = sub ? lam : 1.f;
#pragma unroll
  for (int r = 0; r < 16; ++r) { const float rl = fac * __builtin_amdgcn_rcpf(li_l[crow(r, hi)]);
#pragma unroll
    for (int d0 = 0; d0 < 4; ++d0) o[d0][r] *= rl; }
  __syncthreads();
  float* XB = (float*)lds + pr * 4096;
  if (sub == 1) {
#pragma unroll
    for (int d0 = 0; d0 < 4; ++d0)
#pragma unroll
      for (int r = 0; r < 16; ++r) XB[(d0 * 16 + r) * 64 + lane] = o[d0][r];
  }
  __syncthreads();
  if (sub == 0) {
    float ss[16];
#pragma unroll
    for (int r = 0; r < 16; ++r) { float a = 0.f;
#pragma unroll
      for (int d0 = 0; d0 < 4; ++d0) { o[d0][r] -= XB[(d0 * 16 + r) * 64 + lane]; a += o[d0][r] * o[d0][r]; }
      ss[r] = a; }
#pragma unroll
    for (int r = 0; r < 16; ++r) {
#pragma unroll
      for (int off = 1; off < 32; off <<= 1) ss[r] += __shfl_xor(ss[r], off);
      ss[r] = rsqrtf(ss[r] * (1.f / 128.f) + EPS) * (1.f - lam_init);
    }
    float sw[4];
#pragma unroll
    for (int d0 = 0; d0 < 4; ++d0) sw[d0] = subln[d0 * 32 + r32];
#pragma unroll
    for (int r = 0; r < 16; ++r) { const long row = qrow0 + pr * QBLK + crow(r, hi);
      const bf16_t* gp = Pm + row * NP + C_GA + hh * 128 + r32; bf16_t* yp = Y + row * DM + hh * 128 + r32;
#pragma unroll
      for (int d0 = 0; d0 < 4; ++d0) { const float g = bf2f(gp[d0 * 32]); yp[d0 * 32] = f2bf(o[d0][r] * ss[r] * sw[d0] * (g / (1.f + __expf(-g)))); } }
  }
  __syncthreads();
#undef SLOAD
#undef SWRITE
#undef SWAIT
#undef RESC
}
__device__ __forceinline__ void attn_phase(const bf16_t* __restrict__ Pm, bf16_t* __restrict__ Y, const float* lq1, const float* lk1, const float* lq2, const float* lk2,
                                           const float* __restrict__ subln, float lam_init, bool ctx_out, char* lds) {
  const int lane = opaque_tid() & 63;
  const float lam = expf(wave_sum(lq1[lane] * lk1[lane])) - expf(wave_sum(lq2[lane] * lk2[lane])) + lam_init;
  const int G = gridDim.x, bx = blockIdx.x; const int vcu = (G % 8 == 0) ? (bx % 8) * (G / 8) + bx / 8 : bx;
  const int nunits = 1024 + (ctx_out ? 128 : 0);
  for (int u = vcu; u < nunits; u += G) {
    if (u < 1024) { const int bh = u >> 4, qb = u & 15, b = bh >> 3, hh = bh & 7; attn_unit(Pm, Y, (long)b * SEQ + qb * QROWS, b, hh, 36, lam, lam_init, subln, lds); }
    else { const int v = u - 1024, bh = v >> 1, qb = v & 1, b = bh >> 3, hh = bh & 7; attn_unit(Pm, Y, (long)NLAT + b * CTXL + qb * QROWS, b, hh, 4, lam, lam_init, subln, lds); }
  }
}
#undef KSWZ
#undef SBAR
}

namespace mls {
using bf16x8 = __attribute__((ext_vector_type(8))) short;
using s16x4  = __attribute__((ext_vector_type(4))) short;
using f32x4  = __attribute__((ext_vector_type(4))) float;
constexpr int QSTRB = 272, SSTRB = 144;
constexpr int L_Q = 0, L_K = L_Q + 64 * QSTRB, L_V = L_K + 64 * QSTRB, L_VW = L_V + 64 * SSTRB, L_S = L_VW + 64 * SSTRB, L_CT = L_S + 64 * SSTRB, L_SM = L_CT + 2 * 64 * QSTRB, L_END = L_SM + 8192;
static_assert(L_END <= 131072 && (L_K % 16) == 0 && (L_V % 16) == 0 && (L_VW % 16) == 0 && (L_S % 16) == 0 && (L_CT % 16) == 0 && (L_SM % 16) == 0, "mlstm LDS map");
__device__ __forceinline__ f32x4 mfma16(bf16x8 a, bf16x8 b, f32x4 c) { return __builtin_amdgcn_mfma_f32_16x16x32_bf16(a, b, c, 0, 0, 0); }
struct TrPair { s16x4 lo, hi; };
__device__ __forceinline__ TrPair tr_issue(unsigned addr, int rsb) {
  TrPair t;
  asm volatile("ds_read_b64_tr_b16 %0, %1" : "=&v"(t.lo) : "v"(addr) : "memory");
  asm volatile("ds_read_b64_tr_b16 %0, %1" : "=&v"(t.hi) : "v"(addr + 4u * (unsigned)rsb) : "memory");
  return t;
}
__device__ __forceinline__ bf16x8 tr_pack(const TrPair& t) { return (bf16x8){t.lo[0], t.lo[1], t.lo[2], t.lo[3], t.hi[0], t.hi[1], t.hi[2], t.hi[3]}; }
#define TR_PIN(t) asm volatile("" : "+v"((t).lo), "+v"((t).hi))
__device__ __forceinline__ float wave_scan_incl(float v) {
  v += __builtin_bit_cast(float, __builtin_amdgcn_update_dpp(0, __builtin_bit_cast(int, v), 0x111, 0xF, 0xF, false));
  v += __builtin_bit_cast(float, __builtin_amdgcn_update_dpp(0, __builtin_bit_cast(int, v), 0x112, 0xF, 0xF, false));
  v += __builtin_bit_cast(float, __builtin_amdgcn_update_dpp(0, __builtin_bit_cast(int, v), 0x114, 0xF, 0xF, false));
  v += __builtin_bit_cast(float, __builtin_amdgcn_update_dpp(0, __builtin_bit_cast(int, v), 0x118, 0xF, 0xF, false));
  v += __builtin_bit_cast(float, __builtin_amdgcn_update_dpp(0, __builtin_bit_cast(int, v), 0x142, 0xA, 0xF, false));
  v += __builtin_bit_cast(float, __builtin_amdgcn_update_dpp(0, __builtin_bit_cast(int, v), 0x143, 0xC, 0xF, false));
  return v;
}
__device__ __forceinline__ float fast_tanh(float x) { return 1.f - 2.f * __builtin_amdgcn_rcpf(1.f + __expf(2.f * x)); }

__device__ __forceinline__ void mlstm_unit(const bf16_t* __restrict__ Pm, const bf16_t* __restrict__ QKC  , const float* __restrict__ GATES,
                                           bf16_t* __restrict__ HM, const float* __restrict__ i_bias, const float* __restrict__ f_bias,
                                           int b, int head, int dir, int es, bool ctx_out, char* lds) {
  const int tid = opaque_tid(), wid = __builtin_amdgcn_readfirstlane(tid >> 6), lane = tid & 63, lr = lane & 15, kg = lane >> 4;
  char* q_lds = lds + L_Q; char* k_lds = lds + L_K; char* v_lds = lds + L_V; char* vw_lds = lds + L_VW; char* s_lds = lds + L_S; char* ct_lds = lds + L_CT;
  float* bl = (float*)(lds + L_SM); float* bsp = bl + 64; float* av = bsp + 64; float* wkl = av + 64; float* qn = wkl + 64; float* nvec = qn + 64; float* rs = nvec + 128; float* npart = rs + 1024;
  const unsigned lds0 = (unsigned)(uintptr_t)lds;
  const unsigned trq = (unsigned)((8 * kg + (lr >> 2)) * QSTRB + (4 * (lr & 3)) * 2), trs = (unsigned)((8 * kg + (lr >> 2)) * SSTRB + (4 * (lr & 3)) * 2);
  for (int i = tid; i < 64 * QSTRB / 4; i += 512) ((unsigned*)ct_lds)[i] = 0u;
  if (tid < 128) nvec[tid] = 0.f;
  const float ibias = i_bias[dir * 4 + head], fbias = f_bias[dir * 4 + head];
  const int chg = tid & 31, rg = tid >> 5; const bool isk = chg >= 16;
  const int qkcol = 1024 + (isk ? 512 : 0) + head * 128 + (chg & 15) * 8;
  const int vrow = tid >> 3, vch = tid & 7;
  uint4 pq0, pq1, pq2, pq3, pv; float pgi, pgf;
#define MLS_LOAD(c_) do { const int c__ = (c_); const bool ic_ = c__ < 4; const int T_ = ic_ ? CTXL : SEQ, cc_ = ic_ ? c__ : c__ - 4; \
    const long rb_ = ic_ ? (long)(NLAT + b * CTXL) : (long)b * SEQ; const int t0_ = dir ? (T_ - 64 * (cc_ + 1)) : 64 * cc_; \
    { const bf16_t* qp_ = QKC + (rb_ + t0_ + rg) * DM + qkcol; pq0 = *(const uint4*)qp_; pq1 = *(const uint4*)(qp_ + 16 * DM); pq2 = *(const uint4*)(qp_ + 32 * DM); pq3 = *(const uint4*)(qp_ + 48 * DM); } \
    pv = *(const uint4*)(Pm + (rb_ + t0_ + vrow) * NP + C_VB + head * 256 + es * 64 + vch * 8); \
    const float* gr_ = GATES + (rb_ + t0_ + (dir ? 63 - lane : lane)) * 16; pgi = gr_[dir * 4 + head]; pgf = gr_[8 + dir * 4 + head]; } while (0)
  MLS_LOAD(0);
  f32x4 Cacc[4];
#pragma unroll
  for (int e = 0; e < 4; ++e) Cacc[e] = (f32x4){0.f, 0.f, 0.f, 0.f};
  float gprev = 0.f;
  __syncthreads();
  for (int c = 0; c < 36; ++c) {
    const bool isctx = c < 4; const int T = isctx ? CTXL : SEQ, cc = isctx ? c : c - 4;
    const long rowbase = isctx ? (long)(NLAT + b * CTXL) : (long)b * SEQ;
    const int t0 = dir ? (T - 64 * (cc + 1)) : 64 * cc;
    const bool need_h = ctx_out || !isctx;
    char* ct_cur = ct_lds + (c & 1) * 64 * QSTRB; char* ct_nxt = ct_lds + ((c + 1) & 1) * 64 * QSTRB;
    float gamma, wk_l;
    {
      const float igv = 15.f * fast_tanh((pgi + ibias) * (1.f / 15.f));
      const float fc = 15.f * fast_tanh((pgf + fbias) * (1.f / 15.f));
      const float lfv = fminf(fc, 0.f) - __logf(1.f + __expf(-fabsf(fc)));
      const float bcum = wave_scan_incl(lfv);
      const float b63 = __builtin_bit_cast(float, __builtin_amdgcn_readlane(__builtin_bit_cast(int, bcum), 63));
      gamma = __expf(b63); wk_l = __expf(b63 - bcum + igv);
      if (wid == 0) { bl[lane] = bcum; bsp[lane] = bcum - igv; av[lane] = __expf(bcum); wkl[lane] = wk_l; }
      if (c > 0 && tid < 128) nvec[tid] = gprev * nvec[tid] + (npart[tid] + npart[128 + tid]) + (npart[256 + tid] + npart[384 + tid]);
    }
    { char* dst = (isk ? k_lds : q_lds) + (chg & 15) * 16;
      *(uint4*)(dst + (dir ? 63 - rg : rg) * QSTRB) = pq0; *(uint4*)(dst + (dir ? 47 - rg : rg + 16) * QSTRB) = pq1;
      *(uint4*)(dst + (dir ? 31 - rg : rg + 32) * QSTRB) = pq2; *(uint4*)(dst + (dir ? 15 - rg : rg + 48) * QSTRB) = pq3; }
    { const int l = dir ? 63 - vrow : vrow; const float wkv = __shfl(wk_l, l);
      *(uint4*)(v_lds + l * SSTRB + vch * 16) = pv;
      const unsigned vv[4] = {pv.x, pv.y, pv.z, pv.w}; uint4 w;
      w.x = pk2(__uint_as_float(vv[0] << 16) * wkv, __uint_as_float(vv[0] & 0xffff0000u) * wkv); w.y = pk2(__uint_as_float(vv[1] << 16) * wkv, __uint_as_float(vv[1] & 0xffff0000u) * wkv);
      w.z = pk2(__uint_as_float(vv[2] << 16) * wkv, __uint_as_float(vv[2] & 0xffff0000u) * wkv); w.w = pk2(__uint_as_float(vv[3] << 16) * wkv, __uint_as_float(vv[3] & 0xffff0000u) * wkv);
      *(uint4*)(vw_lds + l * SSTRB + vch * 16) = w; }
    if (c + 1 < 36) MLS_LOAD(c + 1);
    __syncthreads();
    if (need_h) {
      const int lblk = wid >> 1;
#pragma unroll
      for (int u2 = 0; u2 < 2; ++u2) {
        const int sblk = 2 * (wid & 1) + u2;
        if (sblk <= lblk) {
          f32x4 acc = {0.f, 0.f, 0.f, 0.f};
#pragma unroll
          for (int ks = 0; ks < 4; ++ks) {
            const bf16x8 ka = *(const bf16x8*)(k_lds + (sblk * 16 + lr) * QSTRB + (ks * 32 + 8 * kg) * 2);
            const bf16x8 qb = *(const bf16x8*)(q_lds + (lblk * 16 + lr) * QSTRB + (ks * 32 + 8 * kg) * 2);
            acc = mfma16(ka, qb, acc);
          }
          const int l = lblk * 16 + lr; const float blv = bl[l];
          float v4[4]; float sum = 0.f;
#pragma unroll
          for (int r = 0; r < 4; ++r) { const int sidx = sblk * 16 + 4 * kg + r; const float w = (sidx <= l) ? __expf(blv - bsp[sidx]) : 0.f; v4[r] = acc[r] * w; sum += v4[r]; }
          uint2 w; w.x = pk2(v4[0], v4[1]); w.y = pk2(v4[2], v4[3]);
          *(uint2*)(s_lds + l * SSTRB + (sblk * 16 + 4 * kg) * 2) = w;
          rs[(sblk * 4 + kg) * 64 + l] = sum;
        } else if ((lblk == 0 && sblk == 1) || (lblk == 2 && sblk == 3)) {
          *(uint2*)(s_lds + (lblk * 16 + lr) * SSTRB + (sblk * 16 + 4 * kg) * 2) = make_uint2(0u, 0u);
        }
      }
      { const int l = tid >> 3, part = tid & 7; float a = 0.f;
        const unsigned* qp = (const unsigned*)(q_lds + l * QSTRB + part * 32);
#pragma unroll
        for (int i = 0; i < 8; ++i) { const unsigned wd = qp[i]; a += __uint_as_float(wd << 16) * nvec[part * 16 + 2 * i] + __uint_as_float(wd & 0xffff0000u) * nvec[part * 16 + 2 * i + 1]; }
        a += __builtin_bit_cast(float, __builtin_amdgcn_update_dpp(0, __builtin_bit_cast(int, a), 0xB1, 0xF, 0xF, false));
        a += __builtin_bit_cast(float, __builtin_amdgcn_update_dpp(0, __builtin_bit_cast(int, a), 0x4E, 0xF, 0xF, false));
        a += __builtin_bit_cast(float, __builtin_amdgcn_update_dpp(0, __builtin_bit_cast(int, a), 0x141, 0xF, 0xF, false));
        if (part == 0) qn[l] = a; }
    }
    __syncthreads();
    {
      const int dblk = wid, lblk = wid >> 1, l = lblk * 16 + lr, eb0 = 2 * (wid & 1);
      TrPair ka0, ka1, vb00, vb01, vb10, vb11, vb20, vb21, vb30, vb31, va00, va01, va10, va11;
      {
        const unsigned ak = lds0 + L_K + trq + (unsigned)(dblk * 32), aw = lds0 + L_VW + trs, avv = lds0 + L_V + trs + (unsigned)(eb0 * 32);
        asm volatile(
          "ds_read_b64_tr_b16 %0, %20\n\tds_read_b64_tr_b16 %1, %20 offset:1088\n\tds_read_b64_tr_b16 %2, %20 offset:8704\n\tds_read_b64_tr_b16 %3, %20 offset:9792\n\t"
          "ds_read_b64_tr_b16 %4, %21\n\tds_read_b64_tr_b16 %5, %21 offset:576\n\tds_read_b64_tr_b16 %6, %21 offset:4608\n\tds_read_b64_tr_b16 %7, %21 offset:5184\n\t"
          "ds_read_b64_tr_b16 %8, %21 offset:32\n\tds_read_b64_tr_b16 %9, %21 offset:608\n\tds_read_b64_tr_b16 %10, %21 offset:4640\n\tds_read_b64_tr_b16 %11, %21 offset:5216\n\t"
          "ds_read_b64_tr_b16 %12, %21 offset:64\n\tds_read_b64_tr_b16 %13, %21 offset:640\n\tds_read_b64_tr_b16 %14, %21 offset:4672\n\tds_read_b64_tr_b16 %15, %21 offset:5248\n\t"
          "ds_read_b64_tr_b16 %16, %21 offset:96\n\tds_read_b64_tr_b16 %17, %21 offset:672\n\tds_read_b64_tr_b16 %18, %21 offset:4704\n\tds_read_b64_tr_b16 %19, %21 offset:5280\n\t"
          "s_waitcnt lgkmcnt(0)"
          : "=&v"(ka0.lo), "=&v"(ka0.hi), "=&v"(ka1.lo), "=&v"(ka1.hi),
            "=&v"(vb00.lo), "=&v"(vb00.hi), "=&v"(vb01.lo), "=&v"(vb01.hi), "=&v"(vb10.lo), "=&v"(vb10.hi), "=&v"(vb11.lo), "=&v"(vb11.hi),
            "=&v"(vb20.lo), "=&v"(vb20.hi), "=&v"(vb21.lo), "=&v"(vb21.hi), "=&v"(vb30.lo), "=&v"(vb30.hi), "=&v"(vb31.lo), "=&v"(vb31.hi)
          : "v"(ak), "v"(aw) : "memory");
        asm volatile(
          "ds_read_b64_tr_b16 %0, %8\n\tds_read_b64_tr_b16 %1, %8 offset:576\n\tds_read_b64_tr_b16 %2, %8 offset:4608\n\tds_read_b64_tr_b16 %3, %8 offset:5184\n\t"
          "ds_read_b64_tr_b16 %4, %8 offset:32\n\tds_read_b64_tr_b16 %5, %8 offset:608\n\tds_read_b64_tr_b16 %6, %8 offset:4640\n\tds_read_b64_tr_b16 %7, %8 offset:5216\n\t"
          "s_waitcnt lgkmcnt(0)"
          : "=&v"(va00.lo), "=&v"(va00.hi), "=&v"(va01.lo), "=&v"(va01.hi), "=&v"(va10.lo), "=&v"(va10.hi), "=&v"(va11.lo), "=&v"(va11.hi)
          : "v"(avv) : "memory");
      }
      __builtin_amdgcn_sched_barrier(0);
      {
        const bf16x8 kA0 = tr_pack(ka0), kA1 = tr_pack(ka1);
#define MLS_CUPD(eblk, V0, V1) do { f32x4 cc_ = Cacc[eblk] * gamma; cc_ = mfma16(kA0, tr_pack(V0), cc_); cc_ = mfma16(kA1, tr_pack(V1), cc_); Cacc[eblk] = cc_; \
          uint2 w_; w_.x = pk2(cc_[0], cc_[1]); w_.y = pk2(cc_[2], cc_[3]); *(uint2*)(ct_nxt + ((eblk) * 16 + lr) * QSTRB + (dblk * 16 + 4 * kg) * 2) = w_; } while (0)
        MLS_CUPD(0, vb00, vb01); MLS_CUPD(1, vb10, vb11); MLS_CUPD(2, vb20, vb21); MLS_CUPD(3, vb30, vb31);
#undef MLS_CUPD
      }
      if (need_h) {
        float d = av[l] * qn[l];
        for (int sb = 0; sb <= lblk; ++sb) d += (rs[(sb * 4 + 0) * 64 + l] + rs[(sb * 4 + 1) * 64 + l]) + (rs[(sb * 4 + 2) * 64 + l] + rs[(sb * 4 + 3) * 64 + l]);
        const float a_l = av[l], dinv = 1.f / fmaxf(fabsf(d), 1.f);
        bf16x8 qb[4];
#pragma unroll
        for (int ks = 0; ks < 4; ++ks) qb[ks] = *(const bf16x8*)(q_lds + l * QSTRB + (ks * 32 + 8 * kg) * 2);
        const bf16x8 sb0 = *(const bf16x8*)(s_lds + l * SSTRB + (8 * kg) * 2);
        bf16x8 sb1 = sb0; if (lblk >= 2) sb1 = *(const bf16x8*)(s_lds + l * SSTRB + (32 + 8 * kg) * 2);
        const int t = dir ? (t0 + 63 - l) : (t0 + l);
        bf16_t* hp = HM + ((size_t)dir * NTOK + rowbase + t) * 1024 + head * 256 + es * 64 + 4 * kg;
#define MLS_HTILE(u2, VA0, VA1) do { const int eblk = eb0 + (u2); f32x4 acc1 = {0.f, 0.f, 0.f, 0.f}, acc2 = {0.f, 0.f, 0.f, 0.f}; \
          _Pragma("unroll") for (int ks = 0; ks < 4; ++ks) { const bf16x8 ca = *(const bf16x8*)(ct_cur + (eblk * 16 + lr) * QSTRB + (ks * 32 + 8 * kg) * 2); acc1 = mfma16(ca, qb[ks], acc1); } \
          acc2 = mfma16(tr_pack(VA0), sb0, acc2); if (lblk >= 2) acc2 = mfma16(tr_pack(VA1), sb1, acc2); \
          uint2 w_; w_.x = pk2((a_l * acc1[0] + acc2[0]) * dinv, (a_l * acc1[1] + acc2[1]) * dinv); w_.y = pk2((a_l * acc1[2] + acc2[2]) * dinv, (a_l * acc1[3] + acc2[3]) * dinv); \
          *(uint2*)(hp + eblk * 16) = w_; } while (0)
        MLS_HTILE(0, va00, va01); MLS_HTILE(1, va10, va11);
#undef MLS_HTILE
      }
      { const int dd = tid & 127, sq = tid >> 7; float a = 0.f; const bf16_t* kp = (const bf16_t*)k_lds + (sq * 16) * (QSTRB / 2) + dd;
#pragma unroll
        for (int si = 0; si < 16; ++si) a += bf2f(kp[si * (QSTRB / 2)]) * wkl[sq * 16 + si];
        npart[sq * 128 + dd] = a; }
      gprev = gamma;
    }
    __syncthreads();
  }
#undef MLS_LOAD
}
__device__ __forceinline__ void qkconv_phase(const bf16_t* __restrict__ Pm, bf16_t* __restrict__ QKC, const float* __restrict__ conv_w, const float* __restrict__ conv_b) {
  const int tid = opaque_tid(), lane = tid & 63, wave = tid >> 6;
  const int gw = blockIdx.x * 8 + wave, ngw = gridDim.x * 8;
  const int half = gw & 1, c0 = half * 512 + lane * 8;
  float cw0[8], cw1[8], cw2[8], cbv[8];
#pragma unroll
  for (int i = 0; i < 8; ++i) { cw0[i] = conv_w[c0 + i]; cw1[i] = conv_w[1024 + c0 + i]; cw2[i] = conv_w[2048 + c0 + i]; cbv[i] = conv_b[c0 + i]; }
  const float osc = half ? 0.08838834764831845f : 1.f;
  for (int it = gw >> 1; it < NTOK / 8; it += ngw >> 1) {
    const int r0 = it * 8; const bool isl = r0 < NLAT; const int seq0 = isl ? (r0 / SEQ) * SEQ : NLAT + ((r0 - NLAT) / CTXL) * CTXL, T = isl ? SEQ : CTXL;
    uint4 x[10];
#pragma unroll
    for (int r = 0; r < 10; ++r) { const int t = r0 - seq0 - 1 + r; x[r] = (t >= 0 && t < T) ? *(const uint4*)(Pm + (size_t)(seq0 + t) * NP + C_QB + c0) : make_uint4(0u, 0u, 0u, 0u); }
#pragma unroll
    for (int r = 0; r < 8; ++r) {
      const unsigned a0[4] = {x[r].x, x[r].y, x[r].z, x[r].w}, a1[4] = {x[r + 1].x, x[r + 1].y, x[r + 1].z, x[r + 1].w}, a2[4] = {x[r + 2].x, x[r + 2].y, x[r + 2].z, x[r + 2].w};
      float o[8];
#pragma unroll
      for (int i = 0; i < 8; ++i) {
        const float v0 = (i & 1) ? __uint_as_float(a0[i >> 1] & 0xffff0000u) : __uint_as_float(a0[i >> 1] << 16);
        const float v1 = (i & 1) ? __uint_as_float(a1[i >> 1] & 0xffff0000u) : __uint_as_float(a1[i >> 1] << 16);
        const float v2 = (i & 1) ? __uint_as_float(a2[i >> 1] & 0xffff0000u) : __uint_as_float(a2[i >> 1] << 16);
        const float z = cbv[i] + cw0[i] * v0 + cw1[i] * v1 + cw2[i] * v2;
        o[i] = osc * z / (1.f + __expf(-z));
      }
      uint4 w; w.x = pk2(o[0], o[1]); w.y = pk2(o[2], o[3]); w.z = pk2(o[4], o[5]); w.w = pk2(o[6], o[7]);
      *(uint4*)(QKC + (size_t)(r0 + r) * DM + 1024 + c0) = w;
    }
  }
}
__device__ __forceinline__ void mlstm_phase(const bf16_t* __restrict__ Pm, const bf16_t* __restrict__ QKC, const float* __restrict__ GATES, bf16_t* __restrict__ HM,
                                            const float* __restrict__ i_bias, const float* __restrict__ f_bias, bool ctx_out, char* lds) {
  const int G = gridDim.x, bx = blockIdx.x; const int vcu = (G % 8 == 0) ? (bx % 8) * (G / 8) + bx / 8 : bx;
  for (int u = vcu; u < 256; u += G) { const int es = u & 3, dir = (u >> 2) & 1, head = (u >> 3) & 3, b = u >> 5; mlstm_unit(Pm, QKC, GATES, HM, i_bias, f_bias, b, head, dir, es, ctx_out, lds); }
}
}

DEVI void mod_unit(int unit, const float* __restrict__ c, const float* __restrict__ c_ctx, const float* __restrict__ w_ada, const float* __restrict__ b_ada, float* __restrict__ MOD, float* ldsf) {
    const int tid = opaque_tid(), ci = tid & 63, kgp = tid >> 6;
    const int l = unit / 96, cb = unit % 96;
    float* sc = ldsf; float* red = ldsf + 9 * DM;
    for (int i = tid; i < 9 * DM; i += 512) { const float v = (i < 8 * DM) ? c[i] : c_ctx[i - 8 * DM]; sc[i] = silu_f(v); }
    __syncthreads();
    float acc[9];
#pragma unroll
    for (int r = 0; r < 9; ++r) acc[r] = 0.f;
    const float* w = w_ada + (size_t)l * DM * MODW + cb * 64 + ci;
#pragma unroll 8
    for (int k = kgp * 256; k < kgp * 256 + 256; ++k) {
        const float wv = w[(size_t)k * MODW];
#pragma unroll
        for (int r = 0; r < 9; ++r) acc[r] += sc[r * DM + k] * wv;
    }
#pragma unroll
    for (int r = 0; r < 9; ++r) red[(kgp * 9 + r) * 64 + ci] = acc[r];
    __syncthreads();
    for (int idx = tid; idx < 9 * 64; idx += 512) {
        const int r = idx >> 6, cc = idx & 63; float s = 0.f;
#pragma unroll
        for (int g = 0; g < 8; ++g) s += red[(g * 9 + r) * 64 + cc];
        MOD[(size_t)(l * 9 + r) * MODW + cb * 64 + cc] = s + b_ada[l * MODW + cb * 64 + cc];
    }
    __syncthreads();
}
DEVI void transpose_items(const float* __restrict__ W, int ldw, int K, int N, bf16_t* __restrict__ WT, float* scr, int gw, int ngw, int lane) {
    const int nitems = (K / 64) * (N / 32);
    for (int it = gw; it < nitems; it += ngw) transpose_item(W, ldw, K, N, WT, scr, it, lane);
}
DEVI void finish_row(const bf16_t* __restrict__ P, const bf16_t* __restrict__ HM, const float* __restrict__ mnorm, bf16_t* __restrict__ Y, int row, int lane) {
#pragma unroll
    for (int head = 0; head < 4; ++head) {
        const int col = head * 256 + 4 * lane;
        const uint2 a = *(const uint2*)(HM + (size_t)row * 1024 + col), c = *(const uint2*)(HM + ((size_t)NTOK + row) * 1024 + col);
        float h[4];
        h[0] = __uint_as_float(a.x << 16) + __uint_as_float(c.x << 16); h[1] = __uint_as_float(a.x & 0xffff0000u) + __uint_as_float(c.x & 0xffff0000u);
        h[2] = __uint_as_float(a.y << 16) + __uint_as_float(c.y << 16); h[3] = __uint_as_float(a.y & 0xffff0000u) + __uint_as_float(c.y & 0xffff0000u);
        const float ss = wave_sum(h[0] * h[0] + h[1] * h[1] + h[2] * h[2] + h[3] * h[3]);
        const float r = rsqrtf(ss * (1.f / 256.f) + EPS);
        const uint2 ov = *(const uint2*)(P + (size_t)row * NP + C_OB + col), gv = *(const uint2*)(P + (size_t)row * NP + C_GB + col);
        const float o[4] = {__uint_as_float(ov.x << 16), __uint_as_float(ov.x & 0xffff0000u), __uint_as_float(ov.y << 16), __uint_as_float(ov.y & 0xffff0000u)};
        const float g[4] = {__uint_as_float(gv.x << 16), __uint_as_float(gv.x & 0xffff0000u), __uint_as_float(gv.y << 16), __uint_as_float(gv.y & 0xffff0000u)};
        const float4 w = *(const float4*)(mnorm + col);
        const float wv[4] = {w.x, w.y, w.z, w.w};
        float y[4];
#pragma unroll
        for (int e = 0; e < 4; ++e) y[e] = h[e] * r * wv[e] * sigmoid_f(o[e]) * silu_f(g[e]);
        uint2 out; out.x = pk2(y[0], y[1]); out.y = pk2(y[2], y[3]);
        *(uint2*)(Y + (size_t)row * DM + 1024 + col) = out;
    }
}
DEVI void load_row(const float* __restrict__ xr, float4 (&v)[8], int lane) {
#pragma unroll
    for (int j = 0; j < 8; ++j) v[j] = ((const float4*)xr)[lane + 64 * j];
}
DEVI void post_regs(float4 (&v)[8], const bf16_t* __restrict__ y2row, const float* __restrict__ gate, const float* __restrict__ npost, float* __restrict__ orow, int lane) {
    uint2 yv[8]; float ss = 0.f;
#pragma unroll
    for (int j = 0; j < 8; ++j) {
        yv[j] = *(const uint2*)(y2row + 4 * (lane + 64 * j));
        const float y0 = __uint_as_float(yv[j].x << 16), y1 = __uint_as_float(yv[j].x & 0xffff0000u), y2 = __uint_as_float(yv[j].y << 16), y3 = __uint_as_float(yv[j].y & 0xffff0000u);
        ss += y0 * y0 + y1 * y1 + y2 * y2 + y3 * y3;
    }
    ss = wave_sum(ss);
    const float rstd = rsqrtf(ss * (1.f / DM) + EPS);
#pragma unroll
    for (int j = 0; j < 8; ++j) {
        const int k0 = 4 * (lane + 64 * j);
        const float4 gt = *(const float4*)(gate + k0), w = *(const float4*)(npost + k0);
        const float y0 = __uint_as_float(yv[j].x << 16), y1 = __uint_as_float(yv[j].x & 0xffff0000u), y2 = __uint_as_float(yv[j].y << 16), y3 = __uint_as_float(yv[j].y & 0xffff0000u);
        v[j].x += gt.x * (y0 * rstd * w.x); v[j].y += gt.y * (y1 * rstd * w.y); v[j].z += gt.z * (y2 * rstd * w.z); v[j].w += gt.w * (y3 * rstd * w.w);
        *(float4*)(orow + k0) = v[j];
        asm volatile("" ::: "memory");
    }
}
DEVI void norm_regs(const float4 (&v)[8], const float* __restrict__ shift, const float* __restrict__ scale, const float* __restrict__ npre, bf16_t* __restrict__ hrow, char* trow, int lane) {
    float ss = 0.f;
#pragma unroll
    for (int j = 0; j < 8; ++j) ss += v[j].x * v[j].x + v[j].y * v[j].y + v[j].z * v[j].z + v[j].w * v[j].w;
    ss = wave_sum(ss);
    const float rstd = rsqrtf(ss * (1.f / DM) + EPS);
#pragma unroll
    for (int j = 0; j < 8; ++j) {
        const int k0 = 4 * (lane + 64 * j);
        const float4 w = *(const float4*)(npre + k0), sh = *(const float4*)(shift + k0), sc = *(const float4*)(scale + k0);
        uint2 o;
        o.x = pk2(v[j].x * rstd * w.x * (1.f + sc.x) + sh.x, v[j].y * rstd * w.y * (1.f + sc.y) + sh.y);
        o.y = pk2(v[j].z * rstd * w.z * (1.f + sc.z) + sh.z, v[j].w * rstd * w.w * (1.f + sc.w) + sh.w);
        *(uint2*)(hrow + k0) = o; *(uint2*)(trow + k0 * 2) = o;
        asm volatile("" ::: "memory");
    }
}
constexpr int NT_ROWB = (DM + 8) * 2;
template <bool POST>
DEVI void norm_phase(const float* __restrict__ xlat, const float* __restrict__ xctx, const bf16_t* __restrict__ Y2, const float* __restrict__ mod_post, const float* __restrict__ npost,
                     float* olat, float* octx, const float* __restrict__ mod_n, const float* __restrict__ npre, const float* __restrict__ wg, bf16_t* __restrict__ H,
                     float* __restrict__ GATES, char* lds) {
    typedef short bf16x8 __attribute__((ext_vector_type(8))); typedef float f32x4 __attribute__((ext_vector_type(4)));
    const int tid = opaque_tid(), lane = tid & 63, wave = tid >> 6, lr = lane & 15, kgp = lane >> 4;
    char* tile = lds; float* red = (float*)(lds + 8 * NT_ROWB);
    bf16x8 bfrag[8];
    {
        const float* wp = wg + (size_t)(wave * 256 + 8 * kgp) * INC + lr;
#pragma unroll
        for (int ks = 0; ks < 8; ++ks) {
            unsigned w4[4];
#pragma unroll
            for (int q = 0; q < 4; ++q) { w4[q] = pk2(wp[0], wp[INC]); wp += 2 * INC; asm volatile("" : "+v"(wp)); }
            wp += (size_t)24 * INC; asm volatile("" : "+v"(wp));
            bfrag[ks] = __builtin_bit_cast(bf16x8, make_uint4(w4[0], w4[1], w4[2], w4[3]));
        }
    }
    for (int grp = blockIdx.x; grp < NTOK / 8; grp += gridDim.x) {
        const int row = grp * 8 + wave; const bool isl = row < NLAT; const int b = isl ? row / SEQ : 8;
        {
            float4 v[8];
            load_row(isl ? xlat + (size_t)row * DM : xctx + (size_t)(row - NLAT) * DM, v, lane);
            if (POST) post_regs(v, Y2 + (size_t)row * DM, mod_post + (size_t)b * MODW + 2 * DM, npost, isl ? olat + (size_t)row * DM : octx + (size_t)(row - NLAT) * DM, lane);
            norm_regs(v, mod_n + (size_t)b * MODW, mod_n + (size_t)b * MODW + DM, npre, H + (size_t)row * DM, tile + wave * NT_ROWB, lane);
        }
        __syncthreads();
        f32x4 acc = {0.f, 0.f, 0.f, 0.f};
#pragma unroll
        for (int ks = 0; ks < 8; ++ks) {
            bf16x8 af = {0, 0, 0, 0, 0, 0, 0, 0};
            if (lr < 8) af = *(const bf16x8*)(tile + lr * NT_ROWB + (wave * 256 + ks * 32 + 8 * kgp) * 2);
            acc = __builtin_amdgcn_mfma_f32_16x16x32_bf16(af, bfrag[ks], acc, 0, 0, 0);
        }
        if (kgp < 2) {
#pragma unroll
            for (int r = 0; r < 4; ++r) red[(wave * 8 + 4 * kgp + r) * 16 + lr] = acc[r];
        }
        __syncthreads();
        if (tid < 128) { const int rr = tid >> 4, cc = tid & 15; float sum = 0.f;
#pragma unroll
            for (int w8 = 0; w8 < 8; ++w8) sum += red[(w8 * 8 + rr) * 16 + cc];
            GATES[(size_t)(grp * 8 + rr) * 16 + cc] = sum; }
    }
    __syncthreads();
}

#define XB_TMO      128
#define XB_XCNT(j)  (256  + 64 * (j))
#define XB_XSUB(j)  (1280 + 64 * (j))
#define XB_XGEN(j)  (2304 + 64 * (j))
#define XB_TOP      3328
#define XB_TOPGEN   3392
#define XCD_BAR_WORDS 3456
#define XB_SPIN_CAP (1u << 18)

__device__ __forceinline__ unsigned xb_ld(unsigned* p)              { return __hip_atomic_load(p, __ATOMIC_RELAXED, __HIP_MEMORY_SCOPE_AGENT); }
__device__ __forceinline__ unsigned xb_add(unsigned* p, unsigned v) { return __hip_atomic_fetch_add(p, v, __ATOMIC_RELAXED, __HIP_MEMORY_SCOPE_AGENT); }
__device__ __forceinline__ unsigned xb_xcc_id() { return (unsigned)__builtin_amdgcn_s_getreg((3 << 11) | 20) & 0xFu; }
#define XB_SPIN(cond, bar) do { unsigned _sp = 0; while (cond) { __builtin_amdgcn_s_sleep(1); \
    if ((++_sp & 255u) == 0u) { if (xb_ld(&(bar)[XB_TMO])) break; if (_sp > XB_SPIN_CAP) { atomicAdd(&(bar)[XB_TMO], 1u); break; } } } } while (0)

struct XcdBarrier {
    unsigned* bar; unsigned x;
    volatile __attribute__((address_space(3))) unsigned* st;
};

__device__ __forceinline__ XcdBarrier xcd_barrier_post(unsigned* bar, volatile __attribute__((address_space(3))) unsigned* st) {
    XcdBarrier b; b.bar = bar; b.x = xb_xcc_id(); b.st = st;
    if (threadIdx.x == 0) (void)xb_add(&bar[XB_XCNT(b.x)], 1u);
    return b;
}
__device__ __forceinline__ void xcd_barrier_complete(unsigned* bar, unsigned x, unsigned& nloc, unsigned& nx) {
    const unsigned G = gridDim.x * gridDim.y * gridDim.z;
    unsigned sum, cnt, mine, sp = 0u;
    for (;;) {
        sum = 0u; cnt = 0u; mine = 0u;
#pragma unroll
        for (unsigned j = 0; j < 16; ++j) { const unsigned c = xb_ld(&bar[XB_XCNT(j)]); sum += c; cnt += (c > 0u) ? 1u : 0u; mine = (j == x) ? c : mine; }
        if (sum == G) break;
        __builtin_amdgcn_s_sleep(1);
        if ((++sp & 255u) == 0u) { if (xb_ld(&bar[XB_TMO])) break; if (sp > XB_SPIN_CAP) { atomicAdd(&bar[XB_TMO], 1u); break; } }
    }
    nloc = mine > 0u ? mine : 1u; nx = cnt > 0u ? cnt : 1u;
}

__device__ __forceinline__ void xcd_barrier(const XcdBarrier& b) {
    asm volatile("s_waitcnt vmcnt(0)" ::: "memory");
    __syncthreads();
    if (threadIdx.x == 0) {
        unsigned* bar = b.bar;
        __builtin_amdgcn_s_waitcnt(0);
        unsigned nloc = b.st[0], nx = b.st[1];
        if (nloc == 0u) { xcd_barrier_complete(bar, b.x, nloc, nx); b.st[0] = nloc; b.st[1] = nx; }
        const unsigned old = xb_add(&bar[XB_XSUB(b.x)], 1u);
        const unsigned gen = old / nloc;
        if (old + 1u == (gen + 1u) * nloc) {
            __builtin_amdgcn_fence(__ATOMIC_RELEASE, "agent");
            asm volatile("s_waitcnt vmcnt(0)" ::: "memory");
            const unsigned og = xb_add(&bar[XB_TOP], 1u);
            const unsigned tg = og / nx;
            if (og + 1u == (tg + 1u) * nx) xb_add(&bar[XB_TOPGEN], 1u);
            else XB_SPIN(xb_ld(&bar[XB_TOPGEN]) == tg, bar);
            __builtin_amdgcn_fence(__ATOMIC_ACQUIRE, "agent");
            xb_add(&bar[XB_XGEN(b.x)], 1u);
            asm volatile("s_waitcnt vmcnt(0)" ::: "memory");
        } else {
            XB_SPIN(xb_ld(&bar[XB_XGEN(b.x)]) == gen, bar);
            __builtin_amdgcn_fence(__ATOMIC_ACQUIRE, "agent");
            asm volatile("s_waitcnt vmcnt(0)" ::: "memory");
        }
    }
    __syncthreads();
}

namespace cg = cooperative_groups;
#ifndef PROBE_DUP
#define PROBE_DUP 0
#endif
#define DUPN(k) ((PROBE_DUP == (k)) ? 2 : 1)
constexpr int MEGA_LDS = 131072 + 256;
struct MegaArgs { const float* in[20]; float* out; unsigned char* ws; };
DEVI const float* karg_in(int i) { const char* kp = (const char*)__builtin_amdgcn_kernarg_segment_ptr(); asm volatile("" : "+s"(kp)); return *(const float* const*)(kp + 8 * i); }
DEVI unsigned char* karg_ws() { const char* kp = (const char*)__builtin_amdgcn_kernarg_segment_ptr(); asm volatile("" : "+s"(kp)); return *(unsigned char* const*)(kp + 168); }
DEVI float* karg_out() { const char* kp = (const char*)__builtin_amdgcn_kernarg_segment_ptr(); asm volatile("" : "+s"(kp)); return *(float* const*)(kp + 160); }
__global__ __launch_bounds__(512, 2) void mega_fwd(MegaArgs a) {
    extern __shared__ __attribute__((aligned(16))) unsigned char lds[];
    cg::grid_group grid = cg::this_grid();
    volatile __attribute__((address_space(3))) unsigned* MISC = (volatile __attribute__((address_space(3))) unsigned*)((__attribute__((address_space(3))) unsigned char*)lds + 131072);
    if (threadIdx.x < 64) MISC[threadIdx.x] = 0u;
    __syncthreads();
    (void)xcd_barrier_post((unsigned*)(a.ws + WS_CTL) + 4096, MISC + 8);
#define GRID_BAR() do { XcdBarrier b_; b_.bar = (unsigned*)(a.ws + WS_CTL) + 4096; b_.x = xb_xcc_id(); b_.st = (volatile __attribute__((address_space(3))) unsigned*)((__attribute__((address_space(3))) unsigned char*)lds + 131072) + 8; xcd_barrier(b_); } while (0)
    const int G = gridDim.x;
#define PHASE_IDS const int tid = opaque_tid(), lane = tid & 63, wave = tid >> 6, gw = blockIdx.x * 8 + wave, ngw = G * 8; (void)tid; (void)lane; (void)gw; (void)ngw; float* scr = (float*)lds + wave * (64 * 33); (void)scr
    const float* x = a.in[0]; const float* c = a.in[1]; const float* ctx = a.in[2]; const float* c_ctx = a.in[3];
    const float* w_ada = a.in[4]; const float* b_ada = a.in[5]; const float* norm_pre = a.in[6]; const float* norm_post = a.in[7];
    const float* w_in = a.in[8]; const float* w_out = a.in[9];
    float* out = a.out; unsigned char* ws = a.ws;
    float* MOD = (float*)(ws + WS_MOD); float* ROPE = (float*)(ws + WS_ROPE); float* GATES = (float*)(ws + WS_GATES);
    bf16_t* WOUT = (bf16_t*)(ws + WS_WOUT); bf16_t* WIN = (bf16_t*)(ws + WS_WIN); float* XC = (float*)(ws + WS_XC);
    bf16_t* H = (bf16_t*)(ws + WS_H); bf16_t* HM = (bf16_t*)(ws + WS_HM); bf16_t* P = (bf16_t*)(ws + WS_P);
    bf16_t* Y = H; bf16_t* Y2 = HM;

    { PHASE_IDS;
    for (int u = blockIdx.x; u < 192; u += G) mod_unit(u, c, c_ctx, w_ada, b_ada, MOD, (float*)lds);
    for (int i = blockIdx.x * 512 + tid; i < 1024; i += G * 512) { const int pos = i >> 4, f = i & 15; const float inv = powf(10000.f, -(float)f / 16.f); const float ang = (float)pos * inv;
        ROPE[2 * i] = cosf(ang); ROPE[2 * i + 1] = sinf(ang); }
    transpose_items(w_in, INC, DM, NP, WIN, scr, gw, ngw, lane);
    transpose_items(w_out, DM, DM, DM, WOUT, scr, gw, ngw, lane);
    transpose_items(w_out + (size_t)DM * DM, DM, DM, DM, WOUT + (size_t)DM * DM, scr, gw, ngw, lane); }
    grid.sync();
    norm_phase<false>(x, ctx, nullptr, nullptr, nullptr, nullptr, nullptr, MOD, norm_pre, w_in + NP, H, GATES, (char*)lds);
    GRID_BAR();
    for (int l = 0; l < 2; ++l) {
        const float lam_init = l == 0 ? 0.2f : 0.35550906759f;
        const float* mod_l = MOD + (size_t)l * 9 * MODW;
        for (int rep_ = 0; rep_ < DUPN(2); ++rep_)
        { pg8::Gemm g{H, WIN, NTOK, NP, DM}; pg8::StaticOrder S; S.init(NTOK, NP, G, (int)blockIdx.x); pg8::EpiInProj E{P, NP, ROPE};
          pg8::gemm_phase<pg8::EpiInProj, pg8::StaticOrder, true, true>((PG8_LAS unsigned char*)lds, g, S, E); }
        GRID_BAR();
        mls::qkconv_phase(P, Y, a.in[15] + (size_t)l * 3 * 1024, a.in[16] + l * 1024);
        GRID_BAR();
        for (int rep_ = 0; rep_ < DUPN(3); ++rep_)
        mls::mlstm_phase(P, Y, GATES, HM, a.in[17] + l * 8, a.in[18] + l * 8, l == 0, (char*)lds);
        for (int rep_ = 0; rep_ < DUPN(4); ++rep_)
        att::attn_phase(P, Y, a.in[10] + l * 64, a.in[11] + l * 64, a.in[12] + l * 64, a.in[13] + l * 64, a.in[14] + l * 128, lam_init, l == 0, (char*)lds);
        GRID_BAR();
        { PHASE_IDS; const int nrows = l == 0 ? NTOK : NLAT; for (int row = gw; row < nrows; row += ngw) finish_row(P, HM, a.in[19] + l * 1024, Y, row, lane); }
        GRID_BAR();
        for (int rep_ = 0; rep_ < DUPN(5); ++rep_)
        { const int M = l == 0 ? NTOK : NLAT; pg8::Gemm g{Y, WOUT + (size_t)l * DM * DM, M, DM, DM}; pg8::StaticOrder S; S.init(M, DM, G, (int)blockIdx.x); pg8::EpiBf16 E{Y2, DM};
          pg8::gemm_phase<pg8::EpiBf16, pg8::StaticOrder, true, true>((PG8_LAS unsigned char*)lds, g, S, E); }
        if (l == 0) { PHASE_IDS;
            const int nbusy = (NTOK / 256) * (DM / 256) - 2 * G;
            if (nbusy >= 0 && nbusy < G) { if ((int)blockIdx.x >= nbusy) transpose_items(w_in + (size_t)DM * INC, INC, DM, NP, WIN, scr, ((int)blockIdx.x - nbusy) * 8 + wave, (G - nbusy) * 8, lane); }
            else transpose_items(w_in + (size_t)DM * INC, INC, DM, NP, WIN, scr, gw, ngw, lane);
        }
        GRID_BAR();
        if (l == 0) {
            norm_phase<true>(x, ctx, Y2, mod_l, norm_post, out, XC, MOD + (size_t)9 * MODW, norm_pre + DM, w_in + (size_t)DM * INC + NP, H, GATES, (char*)lds);
            GRID_BAR();
        } else { PHASE_IDS;
            for (int row = gw; row < NLAT; row += ngw) {
                float4 v[8];
                load_row(out + (size_t)row * DM, v, lane);
                post_regs(v, Y2 + (size_t)row * DM, mod_l + (size_t)(row / SEQ) * MODW + 2 * DM, norm_post + DM, out + (size_t)row * DM, lane);
            }
        }
    }
}

extern "C" void kernel_launch(void* const* d_in, const int* in_sizes, int n_in, void* d_out, int out_size, void* d_ws, size_t ws_size, hipStream_t stream) {
    (void)in_sizes; (void)n_in; (void)out_size; (void)ws_size;
    static int grid_blocks = 0;
    if (!grid_blocks) {
        int dev = 0, cus = 0, per_cu = 0;
        (void)hipGetDevice(&dev);
        (void)hipDeviceGetAttribute(&cus, hipDeviceAttributeMultiprocessorCount, dev);
        (void)hipFuncSetAttribute((const void*)mega_fwd, hipFuncAttributeMaxDynamicSharedMemorySize, MEGA_LDS);
        (void)hipOccupancyMaxActiveBlocksPerMultiprocessor(&per_cu, (const void*)mega_fwd, 512, MEGA_LDS);
        if (per_cu < 1) per_cu = 1;
        if (per_cu > 1) per_cu = 1;
        grid_blocks = cus * per_cu;
    }
    (void)hipMemsetAsync((char*)d_ws + WS_CTL, 0, 65536, stream);
    MegaArgs a{};
    for (int i = 0; i < 20; ++i) a.in[i] = (const float*)d_in[i];
    a.out = (float*)d_out; a.ws = (unsigned char*)d_ws;
    void* args[] = {&a};
    (void)hipLaunchCooperativeKernel((const void*)mega_fwd, dim3(grid_blocks), dim3(512), args, (size_t)MEGA_LDS, stream);
}
```

```cpp
#include <hip/hip_runtime.h>
#include <hip/hip_cooperative_groups.h>
#include <stdint.h>
#include <math.h>

#define DEVI __device__ __forceinline__
typedef unsigned short bf16_t;

constexpr int DM = 2048, NBATCH = 8, SEQ = 2048, CTXL = 256;
constexpr int NLAT = NBATCH * SEQ, NCTX = NBATCH * CTXL, NTOK = NLAT + NCTX;
constexpr int INC = 8208, NP = 8192, MODW = 6144;
constexpr int C_QA = 0, C_KA = 1024, C_VA = 2048, C_GA = 3072, C_QB = 4096, C_KB = 4608, C_VB = 5120, C_OB = 6144, C_GB = 7168;
constexpr float EPS = 1e-6f;

constexpr size_t MiB = (size_t)1 << 20;
constexpr size_t WS_CTL = 0, WS_MOD = 1 * MiB, WS_SC = WS_MOD + 512 * 1024, WS_ROPE = 2 * MiB, WS_GATES = 3 * MiB, WS_WOUT = 8 * MiB,
                 WS_WIN = 24 * MiB, WS_XC = 56 * MiB, WS_H = 72 * MiB, WS_HM = 144 * MiB, WS_P = 216 * MiB, WS_END = 504 * MiB;

DEVI int opaque_tid() { int t = threadIdx.x; asm volatile("" : "+v"(t)); return t; }
DEVI float bf2f(bf16_t v) { return __uint_as_float(((unsigned)v) << 16); }
DEVI bf16_t f2bf(float f) { unsigned u = __float_as_uint(f); return (bf16_t)((u + 0x7fffu + ((u >> 16) & 1u)) >> 16); }
DEVI unsigned pk2(float lo, float hi) { return (unsigned)f2bf(lo) | ((unsigned)f2bf(hi) << 16); }
DEVI float wave_sum(float v) {
#pragma unroll
    for (int o = 32; o > 0; o >>= 1) v += __shfl_xor(v, o);
    return v;
}
DEVI float wave_max(float v) {
#pragma unroll
    for (int o = 32; o > 0; o >>= 1) v = fmaxf(v, __shfl_xor(v, o));
    return v;
}
DEVI float silu_f(float x) { return x / (1.f + expf(-x)); }
DEVI float sigmoid_f(float x) { return 1.f / (1.f + expf(-x)); }


DEVI void transpose_item(const float* __restrict__ W, int ldw, int K, int N, bf16_t* __restrict__ WT, float* scr, int item, int lane) {
    const int nblk = N / 32, kb = item / nblk, nb = item % nblk, k0 = 64 * kb, n0 = 32 * nb;
    float tv[32];
#pragma unroll
    for (int i = 0; i < 32; ++i) tv[i] = W[(size_t)(k0 + 2 * i + (lane >> 5)) * ldw + n0 + (lane & 31)];
#pragma unroll
    for (int i = 0; i < 32; ++i) scr[(2 * i + (lane >> 5)) * 33 + (lane & 31)] = tv[i];
    asm volatile("s_waitcnt lgkmcnt(0)" ::: "memory");
    const int c = lane & 7;
#pragma unroll
    for (int j = 0; j < 4; ++j) {
        const int n = (lane >> 3) + 8 * j; const float* s = scr + (8 * c) * 33 + n;
        uint4 o; o.x = pk2(s[0 * 33], s[1 * 33]); o.y = pk2(s[2 * 33], s[3 * 33]); o.z = pk2(s[4 * 33], s[5 * 33]); o.w = pk2(s[6 * 33], s[7 * 33]);
        *(uint4*)(WT + (size_t)(n0 + n) * K + k0 + 8 * c) = o;
    }
    asm volatile("s_waitcnt lgkmcnt(0)" ::: "memory");
}

namespace pg8 {
#define PG8_LAS __attribute__((address_space(3)))
typedef unsigned short bf16_t;
typedef short bf16x8 __attribute__((ext_vector_type(8)));
typedef float f32x4 __attribute__((ext_vector_type(4)));
typedef unsigned u32x4 __attribute__((ext_vector_type(4)));
constexpr int BM = 256, BK = 64, HALF = 128, HTB = HALF * BK * 2  , STAGE_BYTES = 8 * HTB, NXCD = 8, WGM = 8;

__host__ __device__ __forceinline__ int lds_byte(int r, int c) { const int st = (r >> 4) * 2 + (c >> 5), rr = r & 15, cc = c & 31, ob = rr * 64 + cc * 2; return st * 1024 + (ob ^ (((ob >> 9) & 1) << 5)); }
__host__ __device__ __forceinline__ void stage_rc(int b, int& R, int& C) { const int st = b / 1024, sb = b % 1024, swz = sb ^ (((sb >> 9) & 1) << 5); R = (st >> 1) * 16 + swz / 64; C = (st & 1) * 32 + (swz % 64) / 2; }
__host__ __device__ __forceinline__ int perm32(int rho) { const int n = rho >> 4, i = rho & 15; return 8 * (i >> 2) + 4 * n + (i & 3); }

struct Unit { int pm, pn; };
struct Gemm { const bf16_t* A; const bf16_t* Bt; int M, N, K; };

struct StaticOrder {
    int nM, nN, nwg, G, c;
    __host__ __device__ void init(int M, int N, int G_, int c_) { nM = M / BM; nN = N / BM; nwg = nM * nN; G = G_; c = c_; }
    __host__ __device__ bool next(int i, Unit& u) const {
        const long L = (long)i * G + c; if (L >= nwg) return false;
        int wgid = (int)L; { const int q = nwg / NXCD, r = nwg % NXCD, xcd = wgid % NXCD, off = wgid / NXCD; wgid = (xcd < r ? xcd * (q + 1) : r * (q + 1) + (xcd - r) * q) + off; }
        const int nig = WGM * nN, gid = wgid / nig, fm = gid * WGM, gsz = (nM - fm) < WGM ? (nM - fm) : WGM;
        u.pm = fm + ((wgid % nig) % gsz); u.pn = (wgid % nig) / gsz; return true;
    }
    __device__ __forceinline__ void a_ready(const Unit&) const {}
    __device__ __forceinline__ void done(const Unit&) const {}
};

__device__ __forceinline__ unsigned cvt_pk_bf16(float lo, float hi) { unsigned r; asm volatile("v_cvt_pk_bf16_f32 %0, %1, %2" : "=v"(r) : "v"(lo), "v"(hi)); return r; }

struct EpiBf16 {
    static constexpr bool PERM = true, AFTER_DRAIN = false;
    bf16_t* O; int ldc;
    __device__ __forceinline__ void operator()(const f32x4 (&acc)[2][2][4][2], const Unit& u, int wr, int wc, int fr, int fq) const {
        const int row0 = u.pm * BM + wr * 64 + fr, col0 = u.pn * BM + wc * 32 + 8 * fq;
#pragma unroll
        for (int ai = 0; ai < 2; ++ai)
#pragma unroll
            for (int m = 0; m < 4; ++m) { bf16_t* rowp = O + (size_t)(row0 + ai * HALF + m * 16) * ldc + col0;
#pragma unroll
                for (int bj = 0; bj < 2; ++bj) { const f32x4 v0 = acc[ai][bj][m][0], v1 = acc[ai][bj][m][1];
                    u32x4 w; w.x = cvt_pk_bf16(v0[0], v0[1]); w.y = cvt_pk_bf16(v0[2], v0[3]); w.z = cvt_pk_bf16(v1[0], v1[1]); w.w = cvt_pk_bf16(v1[2], v1[3]);
                    *(u32x4*)(rowp + bj * HALF) = w; } }
    }
};
struct EpiInProj {
    static constexpr bool PERM = true, AFTER_DRAIN = false;
    bf16_t* O; int ldc; const float* rope;
    __device__ __forceinline__ void operator()(const f32x4 (&acc)[2][2][4][2], const Unit& u, int wr, int wc, int fr, int fq) const {
        const int row0 = u.pm * BM + wr * 64 + fr, col0 = u.pn * BM + wc * 32 + 8 * fq;
        const bool do_rope = (u.pn < 8) && (u.pm < 64);
        const float qsc = (u.pn < 4) ? 0.18033688011112042f : 1.f;
#pragma unroll
        for (int ai = 0; ai < 2; ++ai)
#pragma unroll
            for (int m = 0; m < 4; ++m) { const int row = row0 + ai * HALF + m * 16; bf16_t* rowp = O + (size_t)row * ldc + col0;
                f32x4 cs01 = {1.f, 0.f, 1.f, 0.f}, cs23 = {1.f, 0.f, 1.f, 0.f};
                if (do_rope) { const int pos = (wc & 1) ? (row & 63) : ((row >> 6) & 31); const f32x4* rp = (const f32x4*)(rope + (size_t)(pos * 16 + 4 * fq) * 2); cs01 = rp[0]; cs23 = rp[1]; }
#pragma unroll
                for (int bj = 0; bj < 2; ++bj) { f32x4 v0 = acc[ai][bj][m][0], v1 = acc[ai][bj][m][1];
                    if (do_rope) {
                        const float a0 = v0[0] * cs01[0] - v0[1] * cs01[1], a1 = v0[0] * cs01[1] + v0[1] * cs01[0];
                        const float a2 = v0[2] * cs01[2] - v0[3] * cs01[3], a3 = v0[2] * cs01[3] + v0[3] * cs01[2];
                        const float b0 = v1[0] * cs23[0] - v1[1] * cs23[1], b1 = v1[0] * cs23[1] + v1[1] * cs23[0];
                        const float b2 = v1[2] * cs23[2] - v1[3] * cs23[3], b3 = v1[2] * cs23[3] + v1[3] * cs23[2];
                        v0 = (f32x4){a0, a1, a2, a3}; v1 = (f32x4){b0, b1, b2, b3};
                    }
                    v0 = v0 * qsc; v1 = v1 * qsc;
                    u32x4 w; w.x = cvt_pk_bf16(v0[0], v0[1]); w.y = cvt_pk_bf16(v0[2], v0[3]); w.z = cvt_pk_bf16(v1[0], v1[1]); w.w = cvt_pk_bf16(v1[2], v1[3]);
                    *(u32x4*)(rowp + bj * HALF) = w; } }
    }
};

template <class Epi, class Sched, bool ALIGN_EPI = false, bool SP2 = false>
__device__ __forceinline__ void gemm_phase(PG8_LAS unsigned char* lds, const Gemm g, const Sched& S, const Epi& E) {
    const int tid = opaque_tid(), wid = __builtin_amdgcn_readfirstlane(tid >> 6), lane = tid & 63, wr = wid >> 2, wc = wid & 3, fr = lane & 15, fq = lane >> 4;
    const int K = g.K, nt = K / BK;
    unsigned voffA[2], voffB[2];
#pragma unroll
    for (int i = 0; i < 2; ++i) { int R, C; stage_rc(tid * 16 + i * 8192, R, C); const int Rb = Epi::PERM ? ((R & ~31) + perm32(R & 31)) : R;
        voffA[i] = (unsigned)(R * K + C) * 2u; voffB[i] = (unsigned)(Rb * K + C) * 2u; }
    const size_t kstep = (size_t)(BK * 2);
    const size_t hstep = (size_t)HALF * K * 2;
    const size_t tstep = 2 * hstep;
    const unsigned ldsw = (unsigned)wid * 1024u;
    const int aoff = lds_byte(wr * 64 + fr, fq * 8), boff = lds_byte(wc * 32 + fr, fq * 8);
#define PG8_SA(b, h) (((b) * 2 + (h)) * HTB)
#define PG8_SB(b, h) ((4 + (b) * 2 + (h)) * HTB)
#define PG8_STAGE(bufoff, gbase, voff) do { _Pragma("unroll") for (int _i = 0; _i < 2; ++_i) \
        __builtin_amdgcn_global_load_lds((const unsigned*)((const char*)(gbase) + (voff)[_i]), (PG8_LAS unsigned*)(lds + (bufoff) + ldsw + _i * 8192), 16, 0, 0); } while (0)
#define PG8_LDA(dst, b, h) do { _Pragma("unroll") for (int m = 0; m < 4; ++m) _Pragma("unroll") for (int k = 0; k < 2; ++k) dst[m][k] = *(const PG8_LAS bf16x8*)(lds + PG8_SA(b, h) + aoff + m * 2048 + k * 1024); } while (0)
#define PG8_LDB(dst, b, h) do { _Pragma("unroll") for (int n = 0; n < 2; ++n) _Pragma("unroll") for (int k = 0; k < 2; ++k) dst[n][k] = *(const PG8_LAS bf16x8*)(lds + PG8_SB(b, h) + boff + n * 2048 + k * 1024); } while (0)
#define PG8_MMA(ai, bj, At, Bt) do { __builtin_amdgcn_s_setprio(1); _Pragma("unroll") for (int m = 0; m < 4; ++m) _Pragma("unroll") for (int n = 0; n < 2; ++n) _Pragma("unroll") for (int k = 0; k < 2; ++k) \
        acc[ai][bj][m][n] = __builtin_amdgcn_mfma_f32_16x16x32_bf16(Bt[n][k], At[m][k], acc[ai][bj][m][n], 0, 0, 0); __builtin_amdgcn_s_setprio(0); } while (0)
#define PG8_WAIT_V(n) asm volatile("s_waitcnt vmcnt(" #n ")" ::: "memory")
#define PG8_WAIT_L(n) asm volatile("s_waitcnt lgkmcnt(" #n ")" ::: "memory")
#define PG8_BAR __builtin_amdgcn_s_barrier()
#define PG8_SCHED __builtin_amdgcn_sched_barrier(0)
    Unit cur, nxt; int ui = 0;
    if (!S.next(0, cur)) return;
    f32x4 acc[2][2][4][2];
#pragma unroll
    for (int a = 0; a < 2; ++a)
#pragma unroll
        for (int b = 0; b < 2; ++b)
#pragma unroll
            for (int m = 0; m < 4; ++m)
#pragma unroll
                for (int n = 0; n < 2; ++n) acc[a][b][m][n] = (f32x4){0.f, 0.f, 0.f, 0.f};
    bf16x8 At[4][2], B0[2][2], B1[2][2];
    const char* cA = (const char*)g.A + (size_t)cur.pm * tstep; const char* cB = (const char*)g.Bt + (size_t)cur.pn * tstep;
    S.a_ready(cur);
    if constexpr (SP2) {
        PG8_STAGE(PG8_SB(0, 0), cB, voffB); PG8_STAGE(PG8_SB(0, 1), cB + hstep, voffB); PG8_STAGE(PG8_SA(0, 0), cA, voffA); PG8_STAGE(PG8_SA(0, 1), cA + hstep, voffA);
        if (wr == 1) PG8_BAR;
        PG8_WAIT_V(2); PG8_BAR;
        PG8_STAGE(PG8_SB(1, 0), cB + kstep, voffB); PG8_STAGE(PG8_SA(1, 0), cA + kstep, voffA); PG8_STAGE(PG8_SB(1, 1), cB + hstep + kstep, voffB);
        PG8_WAIT_V(6); PG8_BAR;
    } else {
        PG8_STAGE(PG8_SB(0, 0), cB, voffB); PG8_STAGE(PG8_SA(0, 0), cA, voffA); PG8_STAGE(PG8_SB(0, 1), cB + hstep, voffB); PG8_STAGE(PG8_SA(0, 1), cA + hstep, voffA);
        if (wr == 1) PG8_BAR;
        PG8_WAIT_V(4); PG8_BAR;
        PG8_STAGE(PG8_SB(1, 0), cB + kstep, voffB); PG8_STAGE(PG8_SA(1, 0), cA + kstep, voffA); PG8_STAGE(PG8_SB(1, 1), cB + hstep + kstep, voffB);
        PG8_WAIT_V(6); PG8_BAR;
    }
    for (;;) {
        const bool has_next = S.next(ui + 1, nxt);
        const char* nA = has_next ? (const char*)g.A + (size_t)nxt.pm * tstep : cA; const char* nB = has_next ? (const char*)g.Bt + (size_t)nxt.pn * tstep : cB;
        for (int t = 0; t < nt; t += 2) {
            const bool last = (t == nt - 2);
            const char* a1 = cA + (size_t)(t + 1) * kstep;
            const char* a2 = last ? nA : cA + (size_t)(t + 2) * kstep; const char* b2 = last ? nB : cB + (size_t)(t + 2) * kstep;
            const char* a3 = a2 + kstep; const char* b3 = b2 + kstep;
            if (last && has_next) S.a_ready(nxt);
            if constexpr (SP2) {
            PG8_LDB(B0, 0, 0); PG8_LDB(B1, 0, 1); PG8_SCHED; PG8_LDA(At, 0, 0); PG8_STAGE(PG8_SA(1, 1), a1 + hstep, voffA);
            PG8_WAIT_V(8); PG8_WAIT_L(0); PG8_BAR; PG8_MMA(0, 0, At, B0); PG8_MMA(0, 1, At, B1); PG8_BAR; PG8_SCHED;
            PG8_LDA(At, 0, 1); PG8_STAGE(PG8_SB(0, 0), b2, voffB); PG8_STAGE(PG8_SB(0, 1), b2 + hstep, voffB); PG8_STAGE(PG8_SA(0, 0), a2, voffA);
            PG8_WAIT_V(8); PG8_WAIT_L(0); PG8_BAR; PG8_MMA(1, 0, At, B0); PG8_MMA(1, 1, At, B1); PG8_BAR; PG8_SCHED;
            PG8_LDB(B0, 1, 0); PG8_LDB(B1, 1, 1); PG8_SCHED; PG8_LDA(At, 1, 0); PG8_STAGE(PG8_SA(0, 1), a2 + hstep, voffA);
            PG8_WAIT_V(8); PG8_WAIT_L(0); PG8_BAR; PG8_MMA(0, 0, At, B0); PG8_MMA(0, 1, At, B1); PG8_BAR; PG8_SCHED;
            PG8_LDA(At, 1, 1); PG8_STAGE(PG8_SB(1, 0), b3, voffB); PG8_STAGE(PG8_SB(1, 1), b3 + hstep, voffB); PG8_STAGE(PG8_SA(1, 0), a3, voffA);
            PG8_WAIT_V(8); PG8_WAIT_L(0); PG8_BAR; PG8_MMA(1, 0, At, B0); PG8_MMA(1, 1, At, B1); PG8_BAR; PG8_SCHED;
            } else {
            PG8_LDB(B0, 0, 0); PG8_SCHED; PG8_LDA(At, 0, 0); PG8_STAGE(PG8_SA(1, 1), a1 + hstep, voffA);
            PG8_WAIT_L(8); PG8_BAR; PG8_WAIT_L(0); PG8_MMA(0, 0, At, B0); PG8_BAR; PG8_SCHED;
            PG8_LDB(B1, 0, 1); PG8_STAGE(PG8_SB(0, 0), b2, voffB);
            PG8_BAR; PG8_WAIT_L(0); PG8_MMA(0, 1, At, B1); PG8_BAR;
            PG8_LDA(At, 0, 1); PG8_STAGE(PG8_SA(0, 0), a2, voffA);
            PG8_BAR; PG8_WAIT_L(0); PG8_MMA(1, 0, At, B0); PG8_BAR; PG8_SCHED;
            PG8_STAGE(PG8_SB(0, 1), b2 + hstep, voffB);
            PG8_WAIT_V(6); PG8_BAR; PG8_MMA(1, 1, At, B1); PG8_BAR;
            PG8_LDB(B0, 1, 0); PG8_SCHED; PG8_LDA(At, 1, 0); PG8_STAGE(PG8_SA(0, 1), a2 + hstep, voffA);
            PG8_WAIT_L(8); PG8_BAR; PG8_WAIT_L(0); PG8_MMA(0, 0, At, B0); PG8_BAR; PG8_SCHED;
            PG8_LDB(B1, 1, 1); PG8_STAGE(PG8_SB(1, 0), b3, voffB);
            PG8_BAR; PG8_WAIT_L(0); PG8_MMA(0, 1, At, B1); PG8_BAR;
            PG8_LDA(At, 1, 1); PG8_STAGE(PG8_SA(1, 0), a3, voffA);
            PG8_BAR; PG8_WAIT_L(0); PG8_MMA(1, 0, At, B0); PG8_BAR; PG8_SCHED;
            PG8_STAGE(PG8_SB(1, 1), b3 + hstep, voffB);
            PG8_WAIT_V(6); PG8_BAR; PG8_MMA(1, 1, At, B1); PG8_BAR;
            }
        }
        if constexpr (ALIGN_EPI) { if (wr == 0) PG8_BAR; }
        if constexpr (!Epi::AFTER_DRAIN) { E(acc, cur, wr, wc, fr, fq); S.done(cur); }
        if (!has_next) break;
#pragma unroll
        for (int a = 0; a < 2; ++a)
#pragma unroll
            for (int b = 0; b < 2; ++b)
#pragma unroll
                for (int m = 0; m < 4; ++m)
#pragma unroll
                    for (int n = 0; n < 2; ++n) acc[a][b][m][n] = (f32x4){0.f, 0.f, 0.f, 0.f};
        cur = nxt; cA = nA; cB = nB; ++ui;
        if constexpr (ALIGN_EPI) { if (wr == 1) PG8_BAR; }
    }
    PG8_WAIT_V(0);
    if constexpr (!ALIGN_EPI) { if (wr == 0) PG8_BAR; }
    PG8_BAR;
    if constexpr (Epi::AFTER_DRAIN) { E.fused(acc, cur, wr, wc, fr, fq, lds, wid, lane); S.done(cur); }
#undef PG8_SA
#undef PG8_SB
#undef PG8_STAGE
#undef PG8_LDA
#undef PG8_LDB
#undef PG8_MMA
#undef PG8_WAIT_V
#undef PG8_WAIT_L
#undef PG8_BAR
#undef PG8_SCHED
}
}

namespace att {
using bf16x8 = __attribute__((ext_vector_type(8))) short;
using s16x4  = __attribute__((ext_vector_type(4))) short;
using f32x16 = __attribute__((ext_vector_type(16))) float;
using u32x4  = __attribute__((ext_vector_type(4))) unsigned;
constexpr int NW = 8, QBLK = 32, KVBLK = 64, QROWS = 128;
constexpr float SCALE = 0.125f, QPRESCALE = SCALE * 1.4426950408889634f, THRL = 8.f;
constexpr int SHM_V = KVBLK * 128 * 2, SHM_K = KVBLK * 128 * 2, SHM_ATTN = 2 * SHM_V + 2 * SHM_K + NW * 64 * 4;
#define KSWZ(row, colB) ((row) * 256 + ((colB) ^ (((row) & 7) << 4)))
#define SBAR() __builtin_amdgcn_sched_barrier(0)
__device__ __forceinline__ int crow(int r, int hi) { return (r & 3) + 8 * (r >> 2) + 4 * hi; }
__device__ __forceinline__ unsigned cvtpk(float lo, float hi) { unsigned r; asm volatile("v_cvt_pk_bf16_f32 %0, %1, %2" : "=v"(r) : "v"(lo), "v"(hi)); return r; }
__device__ __forceinline__ void partialSM(f32x16& p0, f32x16& p1, float& mhat, f32x16& negm, float& alpha) {
  float a = fmaxf(fmaxf(p0[0], p0[1]), p1[0]), b2 = fmaxf(fmaxf(p0[2], p0[3]), p1[1]); a = fmaxf(fmaxf(a, p1[2]), p1[3]);
#pragma unroll
  for (int r = 4; r < 16; r += 4) { a = fmaxf(fmaxf(a, p0[r]), p0[r + 1]); b2 = fmaxf(fmaxf(b2, p0[r + 2]), p0[r + 3]); a = fmaxf(fmaxf(a, p1[r]), p1[r + 1]); b2 = fmaxf(fmaxf(b2, p1[r + 2]), p1[r + 3]); }
  float rm = fmaxf(a, b2);
  { auto rr = __builtin_amdgcn_permlane32_swap(__float_as_uint(rm), __float_as_uint(rm), false, false);
    rm = fmaxf(__uint_as_float(rr[0]), __uint_as_float(rr[1])); }
  alpha = 1.f;
  if (__builtin_expect(__any(rm > THRL), 0)) {
    const float dl = fmaxf(rm, 0.f); mhat += dl;
#pragma unroll
    for (int r = 0; r < 16; ++r) { p0[r] -= dl; p1[r] -= dl; }
#pragma unroll
    for (int r = 0; r < 16; ++r) negm[r] = -mhat;
    alpha = __builtin_amdgcn_exp2f(-dl);
  }
#pragma unroll
  for (int r = 0; r < 16; ++r) p0[r] = __builtin_amdgcn_exp2f(p0[r]);
}
__device__ __forceinline__ void finishSM(f32x16& p0, f32x16& p1, float alpha, float& l_reg, bf16x8& pa0, bf16x8& pa1, bf16x8& pa2, bf16x8& pa3) {
#pragma unroll
  for (int r = 0; r < 16; ++r) p1[r] = __builtin_amdgcn_exp2f(p1[r]);
  float ps = 0;
#pragma unroll
  for (int r = 0; r < 16; ++r) ps += p0[r];
#pragma unroll
  for (int r = 0; r < 16; ++r) ps += p1[r];
  { auto rr = __builtin_amdgcn_permlane32_swap(__float_as_uint(ps), __float_as_uint(ps), false, false);
    ps = __uint_as_float(rr[0]) + __uint_as_float(rr[1]); }
  l_reg = l_reg * alpha + ps;
#define PK4(P, BASE, OUT) do { unsigned a0 = cvtpk(P[BASE + 0], P[BASE + 1]), a1 = cvtpk(P[BASE + 2], P[BASE + 3]);   \
    unsigned b0 = cvtpk(P[BASE + 4], P[BASE + 5]), b1 = cvtpk(P[BASE + 6], P[BASE + 7]);                              \
    auto r0 = __builtin_amdgcn_permlane32_swap(a0, b0, false, false); auto r1 = __builtin_amdgcn_permlane32_swap(a1, b1, false, false); \
    u32x4 w = {r0[0], r1[0], r0[1], r1[1]}; OUT = *reinterpret_cast<bf16x8*>(&w); } while (0)
  PK4(p0, 0, pa0); PK4(p0, 8, pa1); PK4(p1, 0, pa2); PK4(p1, 8, pa3);
#undef PK4
}
__device__ __forceinline__ void qkt(f32x16& p0, f32x16& p1, const char* Ks, const bf16x8* qr, const f32x16& negm, int r32, int hi, int sub) {
#pragma unroll
  for (int d0 = 0; d0 < 4; ++d0) { const int cb = (sub * 64 + d0 * 16 + hi * 8) * 2;
    const bf16x8 b0 = *reinterpret_cast<const bf16x8*>(Ks + KSWZ(r32, cb));
    const bf16x8 b1 = *reinterpret_cast<const bf16x8*>(Ks + KSWZ(32 + r32, cb));
    if (d0 == 0) { p0 = __builtin_amdgcn_mfma_f32_32x32x16_bf16(b0, qr[0], negm, 0, 0, 0); p1 = __builtin_amdgcn_mfma_f32_32x32x16_bf16(b1, qr[0], negm, 0, 0, 0); }
    else { p0 = __builtin_amdgcn_mfma_f32_32x32x16_bf16(b0, qr[d0], p0, 0, 0, 0); p1 = __builtin_amdgcn_mfma_f32_32x32x16_bf16(b1, qr[d0], p1, 0, 0, 0); } }
}
__device__ __forceinline__ int v_st(int k, int c) { const int kk = (k & ~0xC) | ((k & 4) << 1) | ((k & 8) >> 1); return ((kk >> 3) * 4 + (c >> 5)) * 512 + ((kk & 7) * 32 + (c & 31)) * 2; }
__device__ __forceinline__ int v_rd_base(int lane) { return ((lane & 3) << 3) | (((lane >> 2) & 3) << 6) | (((lane >> 4) & 1) << 5) | (((lane >> 5) & 1) << 8); }
constexpr int v_rd_off(int d0, int ks, int half) { return d0 * 512 + ks * 4096 + half * 2048; }
template <int OFF> __device__ __forceinline__ s16x4 tr_read(int vb) {
  s16x4 r; asm volatile("ds_read_b64_tr_b16 %0, %1 offset:%2" : "=&v"(r) : "v"(vb), "i"(OFF) : "memory"); return r;
}
template <int D0> __device__ __forceinline__ void pv_one(f32x16& od, int vb, bf16x8 pa0, bf16x8 pa1, bf16x8 pa2, bf16x8 pa3) {
  const s16x4 l0 = tr_read<v_rd_off(D0, 0, 0)>(vb), h0 = tr_read<v_rd_off(D0, 0, 1)>(vb), l1 = tr_read<v_rd_off(D0, 1, 0)>(vb), h1 = tr_read<v_rd_off(D0, 1, 1)>(vb);
  const s16x4 l2 = tr_read<v_rd_off(D0, 2, 0)>(vb), h2 = tr_read<v_rd_off(D0, 2, 1)>(vb), l3 = tr_read<v_rd_off(D0, 3, 0)>(vb), h3 = tr_read<v_rd_off(D0, 3, 1)>(vb);
  asm volatile("s_waitcnt lgkmcnt(0)" ::: "memory"); SBAR();
#define PK(L, H) (bf16x8){L[0], L[1], L[2], L[3], H[0], H[1], H[2], H[3]}
  od = __builtin_amdgcn_mfma_f32_32x32x16_bf16(pa0, PK(l0, h0), od, 0, 0, 0);
  od = __builtin_amdgcn_mfma_f32_32x32x16_bf16(pa1, PK(l1, h1), od, 0, 0, 0);
  od = __builtin_amdgcn_mfma_f32_32x32x16_bf16(pa2, PK(l2, h2), od, 0, 0, 0);
  od = __builtin_amdgcn_mfma_f32_32x32x16_bf16(pa3, PK(l3, h3), od, 0, 0, 0);
#undef PK
}
__device__ __forceinline__ void pv_d0(f32x16* o, int vb, bf16x8 pa0, bf16x8 pa1, bf16x8 pa2, bf16x8 pa3) {
  pv_one<0>(o[0], vb, pa0, pa1, pa2, pa3); pv_one<1>(o[1], vb, pa0, pa1, pa2, pa3); pv_one<2>(o[2], vb, pa0, pa1, pa2, pa3); pv_one<3>(o[3], vb, pa0, pa1, pa2, pa3);
}
__device__ __forceinline__ long ktile_row(int b, int t) { return t < 4 ? (long)(NLAT + b * CTXL + 64 * t) : (long)(b * SEQ + 64 * (t - 4)); }

__device__ __forceinline__ void attn_unit(const bf16_t* __restrict__ Pm, bf16_t* __restrict__ Y, long qrow0, int b, int hh, int NT, float lam, float lam_init,
                                          const float* __restrict__ subln, char* lds) {
  const int tid = opaque_tid(), wid = tid >> 6, lane = tid & 63, r32 = lane & 31, hi = lane >> 5;
  const int sub = wid & 1, pr = wid >> 1;
  char* V_lds = lds; char* K_lds = lds + 2 * SHM_V;
  float* ws = (float*)(lds + 2 * SHM_V + 2 * SHM_K) + wid * 64; float* li_l = ws; float* al_l = ws + 32;
  float mhat = 0.f, l_reg = 0; f32x16 o[4] = {}; f32x16 negm = {}; bf16x8 qr[4];
  const bf16_t* Qw = Pm + (qrow0 + pr * QBLK + r32) * NP + C_QA + hh * 128 + sub * 64 + hi * 8;
#pragma unroll
  for (int d0 = 0; d0 < 4; ++d0) qr[d0] = *reinterpret_cast<const bf16x8*>(Qw + d0 * 16);
  const int sr = tid >> 4, sc = (tid & 15) * 8, vst0 = v_st(sr, sc), vst1 = v_st(32 + sr, sc);
  const int vb0 = (int)(uintptr_t)V_lds + v_rd_base(lane);
  const bf16_t* Kcol = Pm + C_KA + hh * 128 + sc; const bf16_t* Vcol = Pm + C_VA + hh * 128 + sc;
  struct { bf16x8 vs0, vs1, ks0, ks1; } sr_[1];
#define SLOAD(i, t) do { const long r0_ = ktile_row(b, (t)) + sr; \
    sr_[i].vs0 = *reinterpret_cast<const bf16x8*>(Vcol + r0_ * NP); sr_[i].vs1 = *reinterpret_cast<const bf16x8*>(Vcol + (r0_ + 32) * NP); \
    sr_[i].ks0 = *reinterpret_cast<const bf16x8*>(Kcol + r0_ * NP); sr_[i].ks1 = *reinterpret_cast<const bf16x8*>(Kcol + (r0_ + 32) * NP); } while (0)
#define SWRITE(bb, i) do { *(bf16x8*)(V_lds + (bb) * SHM_V + vst0) = sr_[i].vs0; *(bf16x8*)(V_lds + (bb) * SHM_V + vst1) = sr_[i].vs1; const int kc = sc * 2; \
    *(bf16x8*)(K_lds + (bb) * SHM_K + KSWZ(sr, kc)) = sr_[i].ks0; *(bf16x8*)(K_lds + (bb) * SHM_K + KSWZ(32 + sr, kc)) = sr_[i].ks1; } while (0)
#define SWAIT() asm volatile("s_waitcnt vmcnt(0)" ::: "memory")
#define RESC(a) do { if (__any((a) < 1.f)) { if (hi == 0) al_l[r32] = (a); asm volatile("s_waitcnt lgkmcnt(0)" ::: "memory"); \
    _Pragma("unroll") for (int d = 0; d < 4; ++d) _Pragma("unroll") for (int r = 0; r < 16; ++r) o[d][r] *= al_l[crow(r, hi)]; } } while (0)
  f32x16 pA0, pA1, pB0, pB1; float alA, alB; bf16x8 pa0, pa1, pa2, pa3;
  constexpr int SE = 0, SO = 0;
  SLOAD(SE, 0); asm volatile("s_waitcnt vmcnt(0)" ::: "memory"); SWRITE(0, SE); __syncthreads();
  qkt(pA0, pA1, K_lds, qr, negm, r32, hi, sub); partialSM(pA0, pA1, mhat, negm, alA);
  SLOAD(SO, 1);
  SWAIT(); SWRITE(1, SO); __syncthreads();
  for (int j = 1; j + 1 < NT; j += 2) {
    SBAR(); qkt(pB0, pB1, K_lds + SHM_K, qr, negm, r32, hi, sub);
    finishSM(pA0, pA1, alA, l_reg, pa0, pa1, pa2, pa3); SBAR();
    SLOAD(SO, j + 1); SBAR();
    pv_d0(o, vb0, pa0, pa1, pa2, pa3); partialSM(pB0, pB1, mhat, negm, alB);
    __syncthreads(); SWAIT(); SWRITE(0, SE);
    RESC(alB); __syncthreads();
    SBAR(); qkt(pA0, pA1, K_lds, qr, negm, r32, hi, sub);
    finishSM(pB0, pB1, alB, l_reg, pa0, pa1, pa2, pa3); SBAR();
    SLOAD(SE, j + 2); SBAR();
    pv_d0(o, vb0 + SHM_V, pa0, pa1, pa2, pa3); partialSM(pA0, pA1, mhat, negm, alA);
    __syncthreads(); SWAIT(); SWRITE(1, SO);
    RESC(alA); __syncthreads();
  }
  SBAR(); qkt(pB0, pB1, K_lds + SHM_K, qr, negm, r32, hi, sub);
  finishSM(pA0, pA1, alA, l_reg, pa0, pa1, pa2, pa3); SBAR();
  pv_d0(o, vb0, pa0, pa1, pa2, pa3); partialSM(pB0, pB1, mhat, negm, alB);
  __syncthreads(); RESC(alB);
  finishSM(pB0, pB1, alB, l_reg, pa0, pa1, pa2, pa3); SBAR();
  pv_d0(o, vb0 + SHM_V, pa0, pa1, pa2, pa3);
  if (hi == 0) li_l[r32] = l_reg; asm volatile("s_waitcnt lgkmcnt(0)" ::: "memory");
  const float fac = sub ? lam : 1.f;
#pragma unroll
  for (int r = 0; r < 16; ++r) { const float rl = fac * __builtin_amdgcn_rcpf(li_l[crow(r, hi)]);
#pragma unroll
    for (int d0 = 0; d0 < 4; ++d0) o[d0][r] *= rl; }
  __syncthreads();
  float* XB = (float*)lds + pr * 4096;
  if (sub == 1) {
#pragma unroll
    for (int d0 = 0; d0 < 4; ++d0)
#pragma unroll
      for (int r = 0; r < 16; ++r) XB[(d0 * 16 + r) * 64 + lane] = o[d0][r];
  }
  __syncthreads();
  if (sub == 0) {
    float ss[16];
#pragma unroll
    for (int r = 0; r < 16; ++r) { float a = 0.f;
#pragma unroll
      for (int d0 = 0; d0 < 4; ++d0) { o[d0][r] -= XB[(d0 * 16 + r) * 64 + lane]; a += o[d0][r] * o[d0][r]; }
      ss[r] = a; }
#pragma unroll
    for (int r = 0; r < 16; ++r) {
#pragma unroll
      for (int off = 1; off < 32; off <<= 1) ss[r] += __shfl_xor(ss[r], off);
      ss[r] = rsqrtf(ss[r] * (1.f / 128.f) + EPS) * (1.f - lam_init);
    }
    float sw[4];
#pragma unroll
    for (int d0 = 0; d0 < 4; ++d0) sw[d0] = subln[d0 * 32 + r32];
#pragma unroll
    for (int r = 0; r < 16; ++r) { const long row = qrow0 + pr * QBLK + crow(r, hi);
      const bf16_t* gp = Pm + row * NP + C_GA + hh * 128 + r32; bf16_t* yp = Y + row * DM + hh * 128 + r32;
#pragma unroll
      for (int d0 = 0; d0 < 4; ++d0) { const float g = bf2f(gp[d0 * 32]); yp[d0 * 32] = f2bf(o[d0][r] * ss[r] * sw[d0] * (g / (1.f + __expf(-g)))); } }
  }
  __syncthreads();
#undef SLOAD
#undef SWRITE
#undef SWAIT
#undef RESC
}
__device__ __forceinline__ void attn_phase(const bf16_t* __restrict__ Pm, bf16_t* __restrict__ Y, const float* lq1, const float* lk1, const float* lq2, const float* lk2,
                                           const float* __restrict__ subln, float lam_init, bool ctx_out, char* lds) {
  const int lane = opaque_tid() & 63;
  const float lam = expf(wave_sum(lq1[lane] * lk1[lane])) - expf(wave_sum(lq2[lane] * lk2[lane])) + lam_init;
  const int G = gridDim.x, bx = blockIdx.x; const int vcu = (G % 8 == 0) ? (bx % 8) * (G / 8) + bx / 8 : bx;
  const int nunits = 1024 + (ctx_out ? 128 : 0);
  for (int u = vcu; u < nunits; u += G) {
    if (u < 1024) { const int bh = u >> 4, qb = u & 15, b = bh >> 3, hh = bh & 7; attn_unit(Pm, Y, (long)b * SEQ + qb * QROWS, b, hh, 36, lam, lam_init, subln, lds); }
    else { const int v = u - 1024, bh = v >> 1, qb = v & 1, b = bh >> 3, hh = bh & 7; attn_unit(Pm, Y, (long)NLAT + b * CTXL + qb * QROWS, b, hh, 4, lam, lam_init, subln, lds); }
  }
}
#undef KSWZ
#undef SBAR
}

namespace mls {
using bf16x8 = __attribute__((ext_vector_type(8))) short;
using s16x4  = __attribute__((ext_vector_type(4))) short;
using f32x4  = __attribute__((ext_vector_type(4))) float;
constexpr int QSTRB = 272, SSTRB = 144;
constexpr int L_Q = 0, L_K = L_Q + 64 * QSTRB, L_V = L_K + 64 * QSTRB, L_VW = L_V + 64 * SSTRB, L_S = L_VW + 64 * SSTRB, L_CT = L_S + 64 * SSTRB, L_SM = L_CT + 2 * 64 * QSTRB, L_END = L_SM + 8192;
static_assert(L_END <= 131072 && (L_K % 16) == 0 && (L_V % 16) == 0 && (L_VW % 16) == 0 && (L_S % 16) == 0 && (L_CT % 16) == 0 && (L_SM % 16) == 0, "mlstm LDS map");
__device__ __forceinline__ f32x4 mfma16(bf16x8 a, bf16x8 b, f32x4 c) { return __builtin_amdgcn_mfma_f32_16x16x32_bf16(a, b, c, 0, 0, 0); }
struct TrPair { s16x4 lo, hi; };
__device__ __forceinline__ TrPair tr_issue(unsigned addr, int rsb) {
  TrPair t;
  asm volatile("ds_read_b64_tr_b16 %0, %1" : "=&v"(t.lo) : "v"(addr) : "memory");
  asm volatile("ds_read_b64_tr_b16 %0, %1" : "=&v"(t.hi) : "v"(addr + 4u * (unsigned)rsb) : "memory");
  return t;
}
__device__ __forceinline__ bf16x8 tr_pack(const TrPair& t) { return (bf16x8){t.lo[0], t.lo[1], t.lo[2], t.lo[3], t.hi[0], t.hi[1], t.hi[2], t.hi[3]}; }
#define TR_PIN(t) asm volatile("" : "+v"((t).lo), "+v"((t).hi))
__device__ __forceinline__ float wave_scan_incl(float v) {
  v += __builtin_bit_cast(float, __builtin_amdgcn_update_dpp(0, __builtin_bit_cast(int, v), 0x111, 0xF, 0xF, false));
  v += __builtin_bit_cast(float, __builtin_amdgcn_update_dpp(0, __builtin_bit_cast(int, v), 0x112, 0xF, 0xF, false));
  v += __builtin_bit_cast(float, __builtin_amdgcn_update_dpp(0, __builtin_bit_cast(int, v), 0x114, 0xF, 0xF, false));
  v += __builtin_bit_cast(float, __builtin_amdgcn_update_dpp(0, __builtin_bit_cast(int, v), 0x118, 0xF, 0xF, false));
  v += __builtin_bit_cast(float, __builtin_amdgcn_update_dpp(0, __builtin_bit_cast(int, v), 0x142, 0xA, 0xF, false));
  v += __builtin_bit_cast(float, __builtin_amdgcn_update_dpp(0, __builtin_bit_cast(int, v), 0x143, 0xC, 0xF, false));
  return v;
}
__device__ __forceinline__ float fast_tanh(float x) { return 1.f - 2.f * __builtin_amdgcn_rcpf(1.f + __expf(2.f * x)); }

__device__ __forceinline__ void mlstm_unit(const bf16_t* __restrict__ Pm, const bf16_t* __restrict__ QKC  , const float* __restrict__ GATES,
                                           bf16_t* __restrict__ HM, const float* __restrict__ i_bias, const float* __restrict__ f_bias,
                                           int b, int head, int dir, int es, bool ctx_out, char* lds) {
  const int tid = opaque_tid(), wid = __builtin_amdgcn_readfirstlane(tid >> 6), lane = tid & 63, lr = lane & 15, kg = lane >> 4;
  char* q_lds = lds + L_Q; char* k_lds = lds + L_K; char* v_lds = lds + L_V; char* vw_lds = lds + L_VW; char* s_lds = lds + L_S; char* ct_lds = lds + L_CT;
  float* bl = (float*)(lds + L_SM); float* bsp = bl + 64; float* av = bsp + 64; float* wkl = av + 64; float* qn = wkl + 64; float* nvec = qn + 64; float* rs = nvec + 128; float* npart = rs + 1024;
  const unsigned lds0 = (unsigned)(uintptr_t)lds;
  const unsigned trq = (unsigned)((8 * kg + (lr >> 2)) * QSTRB + (4 * (lr & 3)) * 2), trs = (unsigned)((8 * kg + (lr >> 2)) * SSTRB + (4 * (lr & 3)) * 2);
  for (int i = tid; i < 64 * QSTRB / 4; i += 512) ((unsigned*)ct_lds)[i] = 0u;
  if (tid < 128) nvec[tid] = 0.f;
  const float ibias = i_bias[dir * 4 + head], fbias = f_bias[dir * 4 + head];
  const int chg = tid & 31, rg = tid >> 5; const bool isk = chg >= 16;
  const int qkcol = 1024 + (isk ? 512 : 0) + head * 128 + (chg & 15) * 8;
  const int vrow = tid >> 3, vch = tid & 7;
  uint4 pq0, pq1, pq2, pq3, pv; float pgi, pgf;
#define MLS_LOAD(c_) do { const int c__ = (c_); const bool ic_ = c__ < 4; const int T_ = ic_ ? CTXL : SEQ, cc_ = ic_ ? c__ : c__ - 4; \
    const long rb_ = ic_ ? (long)(NLAT + b * CTXL) : (long)b * SEQ; const int t0_ = dir ? (T_ - 64 * (cc_ + 1)) : 64 * cc_; \
    { const bf16_t* qp_ = QKC + (rb_ + t0_ + rg) * DM + qkcol; pq0 = *(const uint4*)qp_; pq1 = *(const uint4*)(qp_ + 16 * DM); pq2 = *(const uint4*)(qp_ + 32 * DM); pq3 = *(const uint4*)(qp_ + 48 * DM); } \
    pv = *(const uint4*)(Pm + (rb_ + t0_ + vrow) * NP + C_VB + head * 256 + es * 64 + vch * 8); \
    const float* gr_ = GATES + (rb_ + t0_ + (dir ? 63 - lane : lane)) * 16; pgi = gr_[dir * 4 + head]; pgf = gr_[8 + dir * 4 + head]; } while (0)
  MLS_LOAD(0);
  f32x4 Cacc[4];
#pragma unroll
  for (int e = 0; e < 4; ++e) Cacc[e] = (f32x4){0.f, 0.f, 0.f, 0.f};
  float gprev = 0.f;
  __syncthreads();
  for (int c = 0; c < 36; ++c) {
    const bool isctx = c < 4; const int T = isctx ? CTXL : SEQ, cc = isctx ? c : c - 4;
    const long rowbase = isctx ? (long)(NLAT + b * CTXL) : (long)b * SEQ;
    const int t0 = dir ? (T - 64 * (cc + 1)) : 64 * cc;
    const bool need_h = ctx_out || !isctx;
    char* ct_cur = ct_lds + (c & 1) * 64 * QSTRB; char* ct_nxt = ct_lds + ((c + 1) & 1) * 64 * QSTRB;
    float gamma, wk_l;
    {
      const float igv = 15.f * fast_tanh((pgi + ibias) * (1.f / 15.f));
      const float fc = 15.f * fast_tanh((pgf + fbias) * (1.f / 15.f));
      const float lfv = fminf(fc, 0.f) - __logf(1.f + __expf(-fabsf(fc)));
      const float bcum = wave_scan_incl(lfv);
      const float b63 = __builtin_bit_cast(float, __builtin_amdgcn_readlane(__builtin_bit_cast(int, bcum), 63));
      gamma = __expf(b63); wk_l = __expf(b63 - bcum + igv);
      if (wid == 0) { bl[lane] = bcum; bsp[lane] = bcum - igv; av[lane] = __expf(bcum); wkl[lane] = wk_l; }
      if (c > 0 && tid < 128) nvec[tid] = gprev * nvec[tid] + (npart[tid] + npart[128 + tid]) + (npart[256 + tid] + npart[384 + tid]);
    }
    { char* dst = (isk ? k_lds : q_lds) + (chg & 15) * 16;
      *(uint4*)(dst + (dir ? 63 - rg : rg) * QSTRB) = pq0; *(uint4*)(dst + (dir ? 47 - rg : rg + 16) * QSTRB) = pq1;
      *(uint4*)(dst + (dir ? 31 - rg : rg + 32) * QSTRB) = pq2; *(uint4*)(dst + (dir ? 15 - rg : rg + 48) * QSTRB) = pq3; }
    { const int l = dir ? 63 - vrow : vrow; const float wkv = __shfl(wk_l, l);
      *(uint4*)(v_lds + l * SSTRB + vch * 16) = pv;
      const unsigned vv[4] = {pv.x, pv.y, pv.z, pv.w}; uint4 w;
      w.x = pk2(__uint_as_float(vv[0] << 16) * wkv, __uint_as_float(vv[0] & 0xffff0000u) * wkv); w.y = pk2(__uint_as_float(vv[1] << 16) * wkv, __uint_as_float(vv[1] & 0xffff0000u) * wkv);
      w.z = pk2(__uint_as_float(vv[2] << 16) * wkv, __uint_as_float(vv[2] & 0xffff0000u) * wkv); w.w = pk2(__uint_as_float(vv[3] << 16) * wkv, __uint_as_float(vv[3] & 0xffff0000u) * wkv);
      *(uint4*)(vw_lds + l * SSTRB + vch * 16) = w; }
    if (c + 1 < 36) MLS_LOAD(c + 1);
    __syncthreads();
    if (need_h) {
      const int lblk = wid >> 1;
#pragma unroll
      for (int u2 = 0; u2 < 2; ++u2) {
        const int sblk = 2 * (wid & 1) + u2;
        if (sblk <= lblk) {
          f32x4 acc = {0.f, 0.f, 0.f, 0.f};
#pragma unroll
          for (int ks = 0; ks < 4; ++ks) {
            const bf16x8 ka = *(const bf16x8*)(k_lds + (sblk * 16 + lr) * QSTRB + (ks * 32 + 8 * kg) * 2);
            const bf16x8 qb = *(const bf16x8*)(q_lds + (lblk * 16 + lr) * QSTRB + (ks * 32 + 8 * kg) * 2);
            acc = mfma16(ka, qb, acc);
          }
          const int l = lblk * 16 + lr; const float blv = bl[l];
          float v4[4]; float sum = 0.f;
#pragma unroll
          for (int r = 0; r < 4; ++r) { const int sidx = sblk * 16 + 4 * kg + r; const float w = (sidx <= l) ? __expf(blv - bsp[sidx]) : 0.f; v4[r] = acc[r] * w; sum += v4[r]; }
          uint2 w; w.x = pk2(v4[0], v4[1]); w.y = pk2(v4[2], v4[3]);
          *(uint2*)(s_lds + l * SSTRB + (sblk * 16 + 4 * kg) * 2) = w;
          rs[(sblk * 4 + kg) * 64 + l] = sum;
        } else if ((lblk == 0 && sblk == 1) || (lblk == 2 && sblk == 3)) {
          *(uint2*)(s_lds + (lblk * 16 + lr) * SSTRB + (sblk * 16 + 4 * kg) * 2) = make_uint2(0u, 0u);
        }
      }
      { const int l = tid >> 3, part = tid & 7; float a = 0.f;
        const unsigned* qp = (const unsigned*)(q_lds + l * QSTRB + part * 32);
#pragma unroll
        for (int i = 0; i < 8; ++i) { const unsigned wd = qp[i]; a += __uint_as_float(wd << 16) * nvec[part * 16 + 2 * i] + __uint_as_float(wd & 0xffff0000u) * nvec[part * 16 + 2 * i + 1]; }
        a += __builtin_bit_cast(float, __builtin_amdgcn_update_dpp(0, __builtin_bit_cast(int, a), 0xB1, 0xF, 0xF, false));
        a += __builtin_bit_cast(float, __builtin_amdgcn_update_dpp(0, __builtin_bit_cast(int, a), 0x4E, 0xF, 0xF, false));
        a += __builtin_bit_cast(float, __builtin_amdgcn_update_dpp(0, __builtin_bit_cast(int, a), 0x141, 0xF, 0xF, false));
        if (part == 0) qn[l] = a; }
    }
    __syncthreads();
    {
      const int dblk = wid, lblk = wid >> 1, l = lblk * 16 + lr, eb0 = 2 * (wid & 1);
      TrPair ka0, ka1, vb00, vb01, vb10, vb11, vb20, vb21, vb30, vb31, va00, va01, va10, va11;
      {
        const unsigned ak = lds0 + L_K + trq + (unsigned)(dblk * 32), aw = lds0 + L_VW + trs, avv = lds0 + L_V + trs + (unsigned)(eb0 * 32);
        asm volatile(
          "ds_read_b64_tr_b16 %0, %20\n\tds_read_b64_tr_b16 %1, %20 offset:1088\n\tds_read_b64_tr_b16 %2, %20 offset:8704\n\tds_read_b64_tr_b16 %3, %20 offset:9792\n\t"
          "ds_read_b64_tr_b16 %4, %21\n\tds_read_b64_tr_b16 %5, %21 offset:576\n\tds_read_b64_tr_b16 %6, %21 offset:4608\n\tds_read_b64_tr_b16 %7, %21 offset:5184\n\t"
          "ds_read_b64_tr_b16 %8, %21 offset:32\n\tds_read_b64_tr_b16 %9, %21 offset:608\n\tds_read_b64_tr_b16 %10, %21 offset:4640\n\tds_read_b64_tr_b16 %11, %21 offset:5216\n\t"
          "ds_read_b64_tr_b16 %12, %21 offset:64\n\tds_read_b64_tr_b16 %13, %21 offset:640\n\tds_read_b64_tr_b16 %14, %21 offset:4672\n\tds_read_b64_tr_b16 %15, %21 offset:5248\n\t"
          "ds_read_b64_tr_b16 %16, %21 offset:96\n\tds_read_b64_tr_b16 %17, %21 offset:672\n\tds_read_b64_tr_b16 %18, %21 offset:4704\n\tds_read_b64_tr_b16 %19, %21 offset:5280\n\t"
          "s_waitcnt lgkmcnt(0)"
          : "=&v"(ka0.lo), "=&v"(ka0.hi), "=&v"(ka1.lo), "=&v"(ka1.hi),
            "=&v"(vb00.lo), "=&v"(vb00.hi), "=&v"(vb01.lo), "=&v"(vb01.hi), "=&v"(vb10.lo), "=&v"(vb10.hi), "=&v"(vb11.lo), "=&v"(vb11.hi),
            "=&v"(vb20.lo), "=&v"(vb20.hi), "=&v"(vb21.lo), "=&v"(vb21.hi), "=&v"(vb30.lo), "=&v"(vb30.hi), "=&v"(vb31.lo), "=&v"(vb31.hi)
          : "v"(ak), "v"(aw) : "memory");
        asm volatile(
          "ds_read_b64_tr_b16 %0, %8\n\tds_read_b64_tr_b16 %1, %8 offset:576\n\tds_read_b64_tr_b16 %2, %8 offset:4608\n\tds_read_b64_tr_b16 %3, %8 offset:5184\n\t"
          "ds_read_b64_tr_b16 %4, %8 offset:32\n\tds_read_b64_tr_b16 %5, %8 offset:608\n\tds_read_b64_tr_b16 %6, %8 offset:4640\n\tds_read_b64_tr_b16 %7, %8 offset:5216\n\t"
          "s_waitcnt lgkmcnt(0)"
          : "=&v"(va00.lo), "=&v"(va00.hi), "=&v"(va01.lo), "=&v"(va01.hi), "=&v"(va10.lo), "=&v"(va10.hi), "=&v"(va11.lo), "=&v"(va11.hi)
          : "v"(avv) : "memory");
      }
      __builtin_amdgcn_sched_barrier(0);
      {
        const bf16x8 kA0 = tr_pack(ka0), kA1 = tr_pack(ka1);
#define MLS_CUPD(eblk, V0, V1) do { f32x4 cc_ = Cacc[eblk] * gamma; cc_ = mfma16(kA0, tr_pack(V0), cc_); cc_ = mfma16(kA1, tr_pack(V1), cc_); Cacc[eblk] = cc_; \
          uint2 w_; w_.x = pk2(cc_[0], cc_[1]); w_.y = pk2(cc_[2], cc_[3]); *(uint2*)(ct_nxt + ((eblk) * 16 + lr) * QSTRB + (dblk * 16 + 4 * kg) * 2) = w_; } while (0)
        MLS_CUPD(0, vb00, vb01); MLS_CUPD(1, vb10, vb11); MLS_CUPD(2, vb20, vb21); MLS_CUPD(3, vb30, vb31);
#undef MLS_CUPD
      }
      if (need_h) {
        float d = av[l] * qn[l];
        for (int sb = 0; sb <= lblk; ++sb) d += (rs[(sb * 4 + 0) * 64 + l] + rs[(sb * 4 + 1) * 64 + l]) + (rs[(sb * 4 + 2) * 64 + l] + rs[(sb * 4 + 3) * 64 + l]);
        const float a_l = av[l], dinv = 1.f / fmaxf(fabsf(d), 1.f);
        bf16x8 qb[4];
#pragma unroll
        for (int ks = 0; ks < 4; ++ks) qb[ks] = *(const bf16x8*)(q_lds + l * QSTRB + (ks * 32 + 8 * kg) * 2);
        const bf16x8 sb0 = *(const bf16x8*)(s_lds + l * SSTRB + (8 * kg) * 2);
        bf16x8 sb1 = sb0; if (lblk >= 2) sb1 = *(const bf16x8*)(s_lds + l * SSTRB + (32 + 8 * kg) * 2);
        const int t = dir ? (t0 + 63 - l) : (t0 + l);
        bf16_t* hp = HM + ((size_t)dir * NTOK + rowbase + t) * 1024 + head * 256 + es * 64 + 4 * kg;
#define MLS_HTILE(u2, VA0, VA1) do { const int eblk = eb0 + (u2); f32x4 acc1 = {0.f, 0.f, 0.f, 0.f}, acc2 = {0.f, 0.f, 0.f, 0.f}; \
          _Pragma("unroll") for (int ks = 0; ks < 4; ++ks) { const bf16x8 ca = *(const bf16x8*)(ct_cur + (eblk * 16 + lr) * QSTRB + (ks * 32 + 8 * kg) * 2); acc1 = mfma16(ca, qb[ks], acc1); } \
          acc2 = mfma16(tr_pack(VA0), sb0, acc2); if (lblk >= 2) acc2 = mfma16(tr_pack(VA1), sb1, acc2); \
          uint2 w_; w_.x = pk2((a_l * acc1[0] + acc2[0]) * dinv, (a_l * acc1[1] + acc2[1]) * dinv); w_.y = pk2((a_l * acc1[2] + acc2[2]) * dinv, (a_l * acc1[3] + acc2[3]) * dinv); \
          *(uint2*)(hp + eblk * 16) = w_; } while (0)
        MLS_HTILE(0, va00, va01); MLS_HTILE(1, va10, va11);
#undef MLS_HTILE
      }
      { const int dd = tid & 127, sq = tid >> 7; float a = 0.f; const bf16_t* kp = (const bf16_t*)k_lds + (sq * 16) * (QSTRB / 2) + dd;
#pragma unroll
        for (int si = 0; si < 16; ++si) a += bf2f(kp[si * (QSTRB / 2)]) * wkl[sq * 16 + si];
        npart[sq * 128 + dd] = a; }
      gprev = gamma;
    }
    __syncthreads();
  }
#undef MLS_LOAD
}
__device__ __forceinline__ void qkconv_phase(const bf16_t* __restrict__ Pm, bf16_t* __restrict__ QKC, const float* __restrict__ conv_w, const float* __restrict__ conv_b) {
  const int tid = opaque_tid(), lane = tid & 63, wave = tid >> 6;
  const int gw = blockIdx.x * 8 + wave, ngw = gridDim.x * 8;
  const int half = gw & 1, c0 = half * 512 + lane * 8;
  float cw0[8], cw1[8], cw2[8], cbv[8];
#pragma unroll
  for (int i = 0; i < 8; ++i) { cw0[i] = conv_w[c0 + i]; cw1[i] = conv_w[1024 + c0 + i]; cw2[i] = conv_w[2048 + c0 + i]; cbv[i] = conv_b[c0 + i]; }
  const float osc = half ? 0.08838834764831845f : 1.f;
  for (int it = gw >> 1; it < NTOK / 8; it += ngw >> 1) {
    const int r0 = it * 8; const bool isl = r0 < NLAT; const int seq0 = isl ? (r0 / SEQ) * SEQ : NLAT + ((r0 - NLAT) / CTXL) * CTXL, T = isl ? SEQ : CTXL;
    uint4 x[10];
#pragma unroll
    for (int r = 0; r < 10; ++r) { const int t = r0 - seq0 - 1 + r; x[r] = (t >= 0 && t < T) ? *(const uint4*)(Pm + (size_t)(seq0 + t) * NP + C_QB + c0) : make_uint4(0u, 0u, 0u, 0u); }
#pragma unroll
    for (int r = 0; r < 8; ++r) {
      const unsigned a0[4] = {x[r].x, x[r].y, x[r].z, x[r].w}, a1[4] = {x[r + 1].x, x[r + 1].y, x[r + 1].z, x[r + 1].w}, a2[4] = {x[r + 2].x, x[r + 2].y, x[r + 2].z, x[r + 2].w};
      float o[8];
#pragma unroll
      for (int i = 0; i < 8; ++i) {
        const float v0 = (i & 1) ? __uint_as_float(a0[i >> 1] & 0xffff0000u) : __uint_as_float(a0[i >> 1] << 16);
        const float v1 = (i & 1) ? __uint_as_float(a1[i >> 1] & 0xffff0000u) : __uint_as_float(a1[i >> 1] << 16);
        const float v2 = (i & 1) ? __uint_as_float(a2[i >> 1] & 0xffff0000u) : __uint_as_float(a2[i >> 1] << 16);
        const float z = cbv[i] + cw0[i] * v0 + cw1[i] * v1 + cw2[i] * v2;
        o[i] = osc * z / (1.f + __expf(-z));
      }
      uint4 w; w.x = pk2(o[0], o[1]); w.y = pk2(o[2], o[3]); w.z = pk2(o[4], o[5]); w.w = pk2(o[6], o[7]);
      *(uint4*)(QKC + (size_t)(r0 + r) * DM + 1024 + c0) = w;
    }
  }
}
__device__ __forceinline__ void mlstm_phase(const bf16_t* __restrict__ Pm, const bf16_t* __restrict__ QKC, const float* __restrict__ GATES, bf16_t* __restrict__ HM,
                                            const float* __restrict__ i_bias, const float* __restrict__ f_bias, bool ctx_out, char* lds) {
  const int G = gridDim.x, bx = blockIdx.x; const int vcu = (G % 8 == 0) ? (bx % 8) * (G / 8) + bx / 8 : bx;
  for (int u = vcu; u < 256; u += G) { const int es = u & 3, dir = (u >> 2) & 1, head = (u >> 3) & 3, b = u >> 5; mlstm_unit(Pm, QKC, GATES, HM, i_bias, f_bias, b, head, dir, es, ctx_out, lds); }
}
}

DEVI void mod_unit(int unit, const float* __restrict__ c, const float* __restrict__ c_ctx, const float* __restrict__ w_ada, const float* __restrict__ b_ada, float* __restrict__ MOD, float* ldsf) {
    const int tid = opaque_tid(), ci = tid & 63, kgp = tid >> 6;
    const int l = unit / 96, cb = unit % 96;
    float* sc = ldsf; float* red = ldsf + 9 * DM;
    for (int i = tid; i < 9 * DM; i += 512) { const float v = (i < 8 * DM) ? c[i] : c_ctx[i - 8 * DM]; sc[i] = silu_f(v); }
    __syncthreads();
    float acc[9];
#pragma unroll
    for (int r = 0; r < 9; ++r) acc[r] = 0.f;
    const float* w = w_ada + (size_t)l * DM * MODW + cb * 64 + ci;
#pragma unroll 32
    for (int k = kgp * 256; k < kgp * 256 + 256; ++k) {
        const float wv = w[(size_t)k * MODW];
#pragma unroll
        for (int r = 0; r < 9; ++r) acc[r] += sc[r * DM + k] * wv;
    }
#pragma unroll
    for (int r = 0; r < 9; ++r) red[(kgp * 9 + r) * 64 + ci] = acc[r];
    __syncthreads();
    for (int idx = tid; idx < 9 * 64; idx += 512) {
        const int r = idx >> 6, cc = idx & 63; float s = 0.f;
#pragma unroll
        for (int g = 0; g < 8; ++g) s += red[(g * 9 + r) * 64 + cc];
        MOD[(size_t)(l * 9 + r) * MODW + cb * 64 + cc] = s + b_ada[l * MODW + cb * 64 + cc];
    }
    __syncthreads();
}
DEVI void transpose_items(const float* __restrict__ W, int ldw, int K, int N, bf16_t* __restrict__ WT, float* scr, int gw, int ngw, int lane) {
    const int nitems = (K / 64) * (N / 32);
    for (int it = gw; it < nitems; it += ngw) transpose_item(W, ldw, K, N, WT, scr, it, lane);
}
DEVI void finish_row(const bf16_t* __restrict__ P, const bf16_t* __restrict__ HM, const float* __restrict__ mnorm, bf16_t* __restrict__ Y, int row, int lane) {
#pragma unroll
    for (int head = 0; head < 4; ++head) {
        const int col = head * 256 + 4 * lane;
        const uint2 a = *(const uint2*)(HM + (size_t)row * 1024 + col), c = *(const uint2*)(HM + ((size_t)NTOK + row) * 1024 + col);
        float h[4];
        h[0] = __uint_as_float(a.x << 16) + __uint_as_float(c.x << 16); h[1] = __uint_as_float(a.x & 0xffff0000u) + __uint_as_float(c.x & 0xffff0000u);
        h[2] = __uint_as_float(a.y << 16) + __uint_as_float(c.y << 16); h[3] = __uint_as_float(a.y & 0xffff0000u) + __uint_as_float(c.y & 0xffff0000u);
        const float ss = wave_sum(h[0] * h[0] + h[1] * h[1] + h[2] * h[2] + h[3] * h[3]);
        const float r = rsqrtf(ss * (1.f / 256.f) + EPS);
        const uint2 ov = *(const uint2*)(P + (size_t)row * NP + C_OB + col), gv = *(const uint2*)(P + (size_t)row * NP + C_GB + col);
        const float o[4] = {__uint_as_float(ov.x << 16), __uint_as_float(ov.x & 0xffff0000u), __uint_as_float(ov.y << 16), __uint_as_float(ov.y & 0xffff0000u)};
        const float g[4] = {__uint_as_float(gv.x << 16), __uint_as_float(gv.x & 0xffff0000u), __uint_as_float(gv.y << 16), __uint_as_float(gv.y & 0xffff0000u)};
        const float4 w = *(const float4*)(mnorm + col);
        const float wv[4] = {w.x, w.y, w.z, w.w};
        float y[4];
#pragma unroll
        for (int e = 0; e < 4; ++e) y[e] = h[e] * r * wv[e] * sigmoid_f(o[e]) * silu_f(g[e]);
        uint2 out; out.x = pk2(y[0], y[1]); out.y = pk2(y[2], y[3]);
        *(uint2*)(Y + (size_t)row * DM + 1024 + col) = out;
    }
}
DEVI void load_row(const float* __restrict__ xr, float4 (&v)[8], int lane) {
#pragma unroll
    for (int j = 0; j < 8; ++j) v[j] = ((const float4*)xr)[lane + 64 * j];
}
DEVI void post_regs(float4 (&v)[8], const bf16_t* __restrict__ y2row, const float* __restrict__ gate, const float* __restrict__ npost, float* __restrict__ orow, int lane) {
    uint2 yv[8]; float ss = 0.f;
#pragma unroll
    for (int j = 0; j < 8; ++j) {
        yv[j] = *(const uint2*)(y2row + 4 * (lane + 64 * j));
        const float y0 = __uint_as_float(yv[j].x << 16), y1 = __uint_as_float(yv[j].x & 0xffff0000u), y2 = __uint_as_float(yv[j].y << 16), y3 = __uint_as_float(yv[j].y & 0xffff0000u);
        ss += y0 * y0 + y1 * y1 + y2 * y2 + y3 * y3;
    }
    ss = wave_sum(ss);
    const float rstd = rsqrtf(ss * (1.f / DM) + EPS);
#pragma unroll
    for (int j = 0; j < 8; ++j) {
        const int k0 = 4 * (lane + 64 * j);
        const float4 gt = *(const float4*)(gate + k0), w = *(const float4*)(npost + k0);
        const float y0 = __uint_as_float(yv[j].x << 16), y1 = __uint_as_float(yv[j].x & 0xffff0000u), y2 = __uint_as_float(yv[j].y << 16), y3 = __uint_as_float(yv[j].y & 0xffff0000u);
        v[j].x += gt.x * (y0 * rstd * w.x); v[j].y += gt.y * (y1 * rstd * w.y); v[j].z += gt.z * (y2 * rstd * w.z); v[j].w += gt.w * (y3 * rstd * w.w);
        *(float4*)(orow + k0) = v[j];
        asm volatile("" ::: "memory");
    }
}
DEVI void norm_regs(const float4 (&v)[8], const float* __restrict__ shift, const float* __restrict__ scale, const float* __restrict__ npre, bf16_t* __restrict__ hrow, char* trow, int lane) {
    float ss = 0.f;
#pragma unroll
    for (int j = 0; j < 8; ++j) ss += v[j].x * v[j].x + v[j].y * v[j].y + v[j].z * v[j].z + v[j].w * v[j].w;
    ss = wave_sum(ss);
    const float rstd = rsqrtf(ss * (1.f / DM) + EPS);
#pragma unroll
    for (int j = 0; j < 8; ++j) {
        const int k0 = 4 * (lane + 64 * j);
        const float4 w = *(const float4*)(npre + k0), sh = *(const float4*)(shift + k0), sc = *(const float4*)(scale + k0);
        uint2 o;
        o.x = pk2(v[j].x * rstd * w.x * (1.f + sc.x) + sh.x, v[j].y * rstd * w.y * (1.f + sc.y) + sh.y);
        o.y = pk2(v[j].z * rstd * w.z * (1.f + sc.z) + sh.z, v[j].w * rstd * w.w * (1.f + sc.w) + sh.w);
        *(uint2*)(hrow + k0) = o; *(uint2*)(trow + k0 * 2) = o;
        asm volatile("" ::: "memory");
    }
}
constexpr int NT_ROWB = (DM + 8) * 2;
template <bool POST>
DEVI void norm_phase(const float* __restrict__ xlat, const float* __restrict__ xctx, const bf16_t* __restrict__ Y2, const float* __restrict__ mod_post, const float* __restrict__ npost,
                     float* olat, float* octx, const float* __restrict__ mod_n, const float* __restrict__ npre, const float* __restrict__ wg, bf16_t* __restrict__ H,
                     float* __restrict__ GATES, char* lds) {
    typedef short bf16x8 __attribute__((ext_vector_type(8))); typedef float f32x4 __attribute__((ext_vector_type(4)));
    const int tid = opaque_tid(), lane = tid & 63, wave = tid >> 6, lr = lane & 15, kgp = lane >> 4;
    char* tile = lds; float* red = (float*)(lds + 8 * NT_ROWB);
    bf16x8 bfrag[8];
    {
        const float* wp = wg + (size_t)(wave * 256 + 8 * kgp) * INC + lr;
#pragma unroll
        for (int ks = 0; ks < 8; ++ks) {
            unsigned w4[4];
#pragma unroll
            for (int q = 0; q < 4; ++q) { w4[q] = pk2(wp[0], wp[INC]); wp += 2 * INC; asm volatile("" : "+v"(wp)); }
            wp += (size_t)24 * INC; asm volatile("" : "+v"(wp));
            bfrag[ks] = __builtin_bit_cast(bf16x8, make_uint4(w4[0], w4[1], w4[2], w4[3]));
        }
    }
    for (int grp = blockIdx.x; grp < NTOK / 8; grp += gridDim.x) {
        const int row = grp * 8 + wave; const bool isl = row < NLAT; const int b = isl ? row / SEQ : 8;
        {
            float4 v[8];
            load_row(isl ? xlat + (size_t)row * DM : xctx + (size_t)(row - NLAT) * DM, v, lane);
            if (POST) post_regs(v, Y2 + (size_t)row * DM, mod_post + (size_t)b * MODW + 2 * DM, npost, isl ? olat + (size_t)row * DM : octx + (size_t)(row - NLAT) * DM, lane);
            norm_regs(v, mod_n + (size_t)b * MODW, mod_n + (size_t)b * MODW + DM, npre, H + (size_t)row * DM, tile + wave * NT_ROWB, lane);
        }
        __syncthreads();
        f32x4 acc = {0.f, 0.f, 0.f, 0.f};
#pragma unroll
        for (int ks = 0; ks < 8; ++ks) {
            bf16x8 af = {0, 0, 0, 0, 0, 0, 0, 0};
            if (lr < 8) af = *(const bf16x8*)(tile + lr * NT_ROWB + (wave * 256 + ks * 32 + 8 * kgp) * 2);
            acc = __builtin_amdgcn_mfma_f32_16x16x32_bf16(af, bfrag[ks], acc, 0, 0, 0);
        }
        if (kgp < 2) {
#pragma unroll
            for (int r = 0; r < 4; ++r) red[(wave * 8 + 4 * kgp + r) * 16 + lr] = acc[r];
        }
        __syncthreads();
        if (tid < 128) { const int rr = tid >> 4, cc = tid & 15; float sum = 0.f;
#pragma unroll
            for (int w8 = 0; w8 < 8; ++w8) sum += red[(w8 * 8 + rr) * 16 + cc];
            GATES[(size_t)(grp * 8 + rr) * 16 + cc] = sum; }
    }
    __syncthreads();
}

#define XB_TMO      128
#define XB_XCNT(j)  (256  + 64 * (j))
#define XB_XSUB(j)  (1280 + 64 * (j))
#define XB_XGEN(j)  (2304 + 64 * (j))
#define XB_TOP      3328
#define XB_TOPGEN   3392
#define XCD_BAR_WORDS 3456
#define XB_SPIN_CAP (1u << 18)

__device__ __forceinline__ unsigned xb_ld(unsigned* p)              { return __hip_atomic_load(p, __ATOMIC_RELAXED, __HIP_MEMORY_SCOPE_AGENT); }
__device__ __forceinline__ unsigned xb_add(unsigned* p, unsigned v) { return __hip_atomic_fetch_add(p, v, __ATOMIC_RELAXED, __HIP_MEMORY_SCOPE_AGENT); }
__device__ __forceinline__ unsigned xb_xcc_id() { return (unsigned)__builtin_amdgcn_s_getreg((3 << 11) | 20) & 0xFu; }
#define XB_SPIN(cond, bar) do { unsigned _sp = 0; while (cond) { __builtin_amdgcn_s_sleep(1); \
    if ((++_sp & 255u) == 0u) { if (xb_ld(&(bar)[XB_TMO])) break; if (_sp > XB_SPIN_CAP) { atomicAdd(&(bar)[XB_TMO], 1u); break; } } } } while (0)

struct XcdBarrier {
    unsigned* bar; unsigned x;
    volatile __attribute__((address_space(3))) unsigned* st;
};

__device__ __forceinline__ XcdBarrier xcd_barrier_post(unsigned* bar, volatile __attribute__((address_space(3))) unsigned* st) {
    XcdBarrier b; b.bar = bar; b.x = xb_xcc_id(); b.st = st;
    if (threadIdx.x == 0) (void)xb_add(&bar[XB_XCNT(b.x)], 1u);
    return b;
}
__device__ __forceinline__ void xcd_barrier_complete(unsigned* bar, unsigned x, unsigned& nloc, unsigned& nx) {
    const unsigned G = gridDim.x * gridDim.y * gridDim.z;
    unsigned sum, cnt, mine, sp = 0u;
    for (;;) {
        sum = 0u; cnt = 0u; mine = 0u;
#pragma unroll
        for (unsigned j = 0; j < 16; ++j) { const unsigned c = xb_ld(&bar[XB_XCNT(j)]); sum += c; cnt += (c > 0u) ? 1u : 0u; mine = (j == x) ? c : mine; }
        if (sum == G) break;
        __builtin_amdgcn_s_sleep(1);
        if ((++sp & 255u) == 0u) { if (xb_ld(&bar[XB_TMO])) break; if (sp > XB_SPIN_CAP) { atomicAdd(&bar[XB_TMO], 1u); break; } }
    }
    nloc = mine > 0u ? mine : 1u; nx = cnt > 0u ? cnt : 1u;
}

__device__ __forceinline__ void xcd_barrier(const XcdBarrier& b) {
    asm volatile("s_waitcnt vmcnt(0)" ::: "memory");
    __syncthreads();
    if (threadIdx.x == 0) {
        unsigned* bar = b.bar;
        __builtin_amdgcn_s_waitcnt(0);
        unsigned nloc = b.st[0], nx = b.st[1];
        if (nloc == 0u) { xcd_barrier_complete(bar, b.x, nloc, nx); b.st[0] = nloc; b.st[1] = nx; }
        const unsigned old = xb_add(&bar[XB_XSUB(b.x)], 1u);
        const unsigned gen = old / nloc;
        if (old + 1u == (gen + 1u) * nloc) {
            __builtin_amdgcn_fence(__ATOMIC_RELEASE, "agent");
            asm volatile("s_waitcnt vmcnt(0)" ::: "memory");
            const unsigned og = xb_add(&bar[XB_TOP], 1u);
            const unsigned tg = og / nx;
            if (og + 1u == (tg + 1u) * nx) xb_add(&bar[XB_TOPGEN], 1u);
            else XB_SPIN(xb_ld(&bar[XB_TOPGEN]) == tg, bar);
            __builtin_amdgcn_fence(__ATOMIC_ACQUIRE, "agent");
            xb_add(&bar[XB_XGEN(b.x)], 1u);
            asm volatile("s_waitcnt vmcnt(0)" ::: "memory");
        } else {
            XB_SPIN(xb_ld(&bar[XB_XGEN(b.x)]) == gen, bar);
            __builtin_amdgcn_fence(__ATOMIC_ACQUIRE, "agent");
            asm volatile("s_waitcnt vmcnt(0)" ::: "memory");
        }
    }
    __syncthreads();
}

namespace cg = cooperative_groups;
#ifndef PROBE_DUP
#define PROBE_DUP 0
#endif
#define DUPN(k) ((PROBE_DUP == (k)) ? 2 : 1)
constexpr int MEGA_LDS = 131072 + 256;
struct MegaArgs { const float* in[20]; float* out; unsigned char* ws; };
DEVI const float* karg_in(int i) { const char* kp = (const char*)__builtin_amdgcn_kernarg_segment_ptr(); asm volatile("" : "+s"(kp)); return *(const float* const*)(kp + 8 * i); }
DEVI unsigned char* karg_ws() { const char* kp = (const char*)__builtin_amdgcn_kernarg_segment_ptr(); asm volatile("" : "+s"(kp)); return *(unsigned char* const*)(kp + 168); }
DEVI float* karg_out() { const char* kp = (const char*)__builtin_amdgcn_kernarg_segment_ptr(); asm volatile("" : "+s"(kp)); return *(float* const*)(kp + 160); }
__global__ __launch_bounds__(512, 2) void mega_fwd(MegaArgs a) {
    extern __shared__ __attribute__((aligned(16))) unsigned char lds[];
    cg::grid_group grid = cg::this_grid();
    volatile __attribute__((address_space(3))) unsigned* MISC = (volatile __attribute__((address_space(3))) unsigned*)((__attribute__((address_space(3))) unsigned char*)lds + 131072);
    if (threadIdx.x < 64) MISC[threadIdx.x] = 0u;
    __syncthreads();
    (void)xcd_barrier_post((unsigned*)(a.ws + WS_CTL) + 4096, MISC + 8);
#define GRID_BAR() do { XcdBarrier b_; b_.bar = (unsigned*)(a.ws + WS_CTL) + 4096; b_.x = xb_xcc_id(); b_.st = (volatile __attribute__((address_space(3))) unsigned*)((__attribute__((address_space(3))) unsigned char*)lds + 131072) + 8; xcd_barrier(b_); } while (0)
    const int G = gridDim.x;
#define PHASE_IDS const int tid = opaque_tid(), lane = tid & 63, wave = tid >> 6, gw = blockIdx.x * 8 + wave, ngw = G * 8; (void)tid; (void)lane; (void)gw; (void)ngw; float* scr = (float*)lds + wave * (64 * 33); (void)scr
    const float* x = a.in[0]; const float* c = a.in[1]; const float* ctx = a.in[2]; const float* c_ctx = a.in[3];
    const float* w_ada = a.in[4]; const float* b_ada = a.in[5]; const float* norm_pre = a.in[6]; const float* norm_post = a.in[7];
    const float* w_in = a.in[8]; const float* w_out = a.in[9];
    float* out = a.out; unsigned char* ws = a.ws;
    float* MOD = (float*)(ws + WS_MOD); float* ROPE = (float*)(ws + WS_ROPE); float* GATES = (float*)(ws + WS_GATES);
    bf16_t* WOUT = (bf16_t*)(ws + WS_WOUT); bf16_t* WIN = (bf16_t*)(ws + WS_WIN); float* XC = (float*)(ws + WS_XC);
    bf16_t* H = (bf16_t*)(ws + WS_H); bf16_t* HM = (bf16_t*)(ws + WS_HM); bf16_t* P = (bf16_t*)(ws + WS_P);
    bf16_t* Y = H; bf16_t* Y2 = HM;

    { PHASE_IDS;
    for (int u = blockIdx.x; u < 192; u += G) mod_unit(u, c, c_ctx, w_ada, b_ada, MOD, (float*)lds);
    for (int i = blockIdx.x * 512 + tid; i < 1024; i += G * 512) { const int pos = i >> 4, f = i & 15; const float inv = powf(10000.f, -(float)f / 16.f); const float ang = (float)pos * inv;
        ROPE[2 * i] = cosf(ang); ROPE[2 * i + 1] = sinf(ang); }
    {
        const bool light = (G == 256) && ((int)blockIdx.x < 192);
        const int nv = (G == 256) ? (light ? 5 : 9) : 1, v0 = (G == 256) ? (light ? gw * 5 : 192 * 8 * 5 + (gw - 192 * 8) * 9) : gw, nvw = (G == 256) ? 12288 : ngw;
        for (int q = 0; q < nv; ++q) {
            const int vw_ = v0 + q;
            for (int it = vw_; it < 12288; it += nvw) {
                if (it < 8192) transpose_item(w_in, INC, DM, NP, WIN, scr, it, lane);
                else if (it < 10240) transpose_item(w_out, DM, DM, DM, WOUT, scr, it - 8192, lane);
                else transpose_item(w_out + (size_t)DM * DM, DM, DM, DM, WOUT + (size_t)DM * DM, scr, it - 10240, lane);
            }
        }
    } }
    grid.sync();
    norm_phase<false>(x, ctx, nullptr, nullptr, nullptr, nullptr, nullptr, MOD, norm_pre, w_in + NP, H, GATES, (char*)lds);
    GRID_BAR();
    for (int l = 0; l < 2; ++l) {
        const float lam_init = l == 0 ? 0.2f : 0.35550906759f;
        const float* mod_l = MOD + (size_t)l * 9 * MODW;
        for (int rep_ = 0; rep_ < DUPN(2); ++rep_)
        { pg8::Gemm g{H, WIN, NTOK, NP, DM}; pg8::StaticOrder S; S.init(NTOK, NP, G, (int)blockIdx.x); pg8::EpiInProj E{P, NP, ROPE};
          pg8::gemm_phase<pg8::EpiInProj, pg8::StaticOrder, true, true>((PG8_LAS unsigned char*)lds, g, S, E); }
        GRID_BAR();
        mls::qkconv_phase(P, Y, a.in[15] + (size_t)l * 3 * 1024, a.in[16] + l * 1024);
        GRID_BAR();
        for (int rep_ = 0; rep_ < DUPN(3); ++rep_)
        mls::mlstm_phase(P, Y, GATES, HM, a.in[17] + l * 8, a.in[18] + l * 8, l == 0, (char*)lds);
        for (int rep_ = 0; rep_ < DUPN(4); ++rep_)
        att::attn_phase(P, Y, a.in[10] + l * 64, a.in[11] + l * 64, a.in[12] + l * 64, a.in[13] + l * 64, a.in[14] + l * 128, lam_init, l == 0, (char*)lds);
        GRID_BAR();
        { PHASE_IDS; const int nrows = l == 0 ? NTOK : NLAT; for (int row = gw; row < nrows; row += ngw) finish_row(P, HM, a.in[19] + l * 1024, Y, row, lane); }
        GRID_BAR();
        for (int rep_ = 0; rep_ < DUPN(5); ++rep_)
        { const int M = l == 0 ? NTOK : NLAT; pg8::Gemm g{Y, WOUT + (size_t)l * DM * DM, M, DM, DM}; pg8::StaticOrder S; S.init(M, DM, G, (int)blockIdx.x); pg8::EpiBf16 E{Y2, DM};
          pg8::gemm_phase<pg8::EpiBf16, pg8::StaticOrder, true, true>((PG8_LAS unsigned char*)lds, g, S, E); }
        if (l == 0) { PHASE_IDS;
            const int nbusy = (NTOK / 256) * (DM / 256) - 2 * G;
            if (nbusy >= 0 && nbusy < G) { if ((int)blockIdx.x >= nbusy) transpose_items(w_in + (size_t)DM * INC, INC, DM, NP, WIN, scr, ((int)blockIdx.x - nbusy) * 8 + wave, (G - nbusy) * 8, lane); }
            else transpose_items(w_in + (size_t)DM * INC, INC, DM, NP, WIN, scr, gw, ngw, lane);
        }
        GRID_BAR();
        if (l == 0) {
            norm_phase<true>(x, ctx, Y2, mod_l, norm_post, out, XC, MOD + (size_t)9 * MODW, norm_pre + DM, w_in + (size_t)DM * INC + NP, H, GATES, (char*)lds);
            GRID_BAR();
        } else { PHASE_IDS;
            for (int row = gw; row < NLAT; row += ngw) {
                float4 v[8];
                load_row(out + (size_t)row * DM, v, lane);
                post_regs(v, Y2 + (size_t)row * DM, mod_l + (size_t)(row / SEQ) * MODW + 2 * DM, norm_post + DM, out + (size_t)row * DM, lane);
            }
        }
    }
}

extern "C" void kernel_launch(void* const* d_in, const int* in_sizes, int n_in, void* d_out, int out_size, void* d_ws, size_t ws_size, hipStream_t stream) {
    (void)in_sizes; (void)n_in; (void)out_size; (void)ws_size;
    static int grid_blocks = 0;
    if (!grid_blocks) {
        int dev = 0, cus = 0, per_cu = 0;
        (void)hipGetDevice(&dev);
        (void)hipDeviceGetAttribute(&cus, hipDeviceAttributeMultiprocessorCount, dev);
        (void)hipFuncSetAttribute((const void*)mega_fwd, hipFuncAttributeMaxDynamicSharedMemorySize, MEGA_LDS);
        (void)hipOccupancyMaxActiveBlocksPerMultiprocessor(&per_cu, (const void*)mega_fwd, 512, MEGA_LDS);
        if (per_cu < 1) per_cu = 1;
        if (per_cu > 1) per_cu = 1;
        grid_blocks = cus * per_cu;
    }
    (void)hipMemsetAsync((char*)d_ws + WS_CTL, 0, 65536, stream);
    MegaArgs a{};
    for (int i = 0; i < 20; ++i) a.in[i] = (const float*)d_in[i];
    a.out = (float*)d_out; a.ws = (unsigned char*)d_ws;
    void* args[] = {&a};
    (void)hipLaunchCooperativeKernel((const void*)mega_fwd, dim3(grid_blocks), dim3(512), args, (size_t)MEGA_LDS, stream);
}
```

```cpp
#include <hip/hip_runtime.h>
#include <hip/hip_cooperative_groups.h>
#include <stdint.h>
#include <math.h>

#define DEVI __device__ __forceinline__
typedef unsigned short bf16_t;

constexpr int DM = 2048, NBATCH = 8, SEQ = 2048, CTXL = 256;
constexpr int NLAT = NBATCH * SEQ, NCTX = NBATCH * CTXL, NTOK = NLAT + NCTX;
constexpr int INC = 8208, NP = 8192, MODW = 6144;
constexpr int C_QA = 0, C_KA = 1024, C_VA = 2048, C_GA = 3072, C_QB = 4096, C_KB = 4608, C_VB = 5120, C_OB = 6144, C_GB = 7168;
constexpr float EPS = 1e-6f;
constexpr int LDS_PHASE_BYTES = 155648;

constexpr size_t MiB = (size_t)1 << 20;
constexpr size_t WS_CTL = 0, WS_MOD = 1 * MiB, WS_SC = WS_MOD + 512 * 1024, WS_ROPE = 2 * MiB, WS_GATES = 3 * MiB, WS_WOUT = 8 * MiB,
                 WS_WIN = 24 * MiB, WS_XC = 56 * MiB, WS_H = 72 * MiB, WS_HM = 144 * MiB, WS_P = 216 * MiB, WS_END = 504 * MiB;

DEVI int opaque_tid() { int t = threadIdx.x; asm volatile("" : "+v"(t)); return t; }
DEVI float bf2f(bf16_t v) { return __uint_as_float(((unsigned)v) << 16); }
DEVI bf16_t f2bf(float f) { unsigned u = __float_as_uint(f); return (bf16_t)((u + 0x7fffu + ((u >> 16) & 1u)) >> 16); }
DEVI unsigned pk2(float lo, float hi) { return (unsigned)f2bf(lo) | ((unsigned)f2bf(hi) << 16); }
DEVI float wave_sum(float v) {
#pragma unroll
    for (int o = 32; o > 0; o >>= 1) v += __shfl_xor(v, o);
    return v;
}
DEVI float wave_max(float v) {
#pragma unroll
    for (int o = 32; o > 0; o >>= 1) v = fmaxf(v, __shfl_xor(v, o));
    return v;
}
DEVI float silu_f(float x) { return x / (1.f + expf(-x)); }
DEVI float sigmoid_f(float x) { return 1.f / (1.f + expf(-x)); }


DEVI void transpose_item(const float* __restrict__ W, int ldw, int K, int N, bf16_t* __restrict__ WT, float* scr, int item, int lane) {
    const int nblk = N / 32, kb = item / nblk, nb = item % nblk, k0 = 64 * kb, n0 = 32 * nb;
    float tv[32];
#pragma unroll
    for (int i = 0; i < 32; ++i) tv[i] = W[(size_t)(k0 + 2 * i + (lane >> 5)) * ldw + n0 + (lane & 31)];
#pragma unroll
    for (int i = 0; i < 32; ++i) scr[(2 * i + (lane >> 5)) * 33 + (lane & 31)] = tv[i];
    asm volatile("s_waitcnt lgkmcnt(0)" ::: "memory");
    const int c = lane & 7;
#pragma unroll
    for (int j = 0; j < 4; ++j) {
        const int n = (lane >> 3) + 8 * j; const float* s = scr + (8 * c) * 33 + n;
        uint4 o; o.x = pk2(s[0 * 33], s[1 * 33]); o.y = pk2(s[2 * 33], s[3 * 33]); o.z = pk2(s[4 * 33], s[5 * 33]); o.w = pk2(s[6 * 33], s[7 * 33]);
        *(uint4*)(WT + (size_t)(n0 + n) * K + k0 + 8 * c) = o;
    }
    asm volatile("s_waitcnt lgkmcnt(0)" ::: "memory");
}

namespace pg8 {
#define PG8_LAS __attribute__((address_space(3)))
typedef unsigned short bf16_t;
typedef short bf16x8 __attribute__((ext_vector_type(8)));
typedef float f32x4 __attribute__((ext_vector_type(4)));
typedef unsigned u32x4 __attribute__((ext_vector_type(4)));
constexpr int BM = 256, BK = 64, HALF = 128, HTB = HALF * BK * 2  , STAGE_BYTES = 8 * HTB, NXCD = 8, WGM = 8;

__host__ __device__ __forceinline__ int lds_byte(int r, int c) { const int st = (r >> 4) * 2 + (c >> 5), rr = r & 15, cc = c & 31, ob = rr * 64 + cc * 2; return st * 1024 + (ob ^ (((ob >> 9) & 1) << 5)); }
__host__ __device__ __forceinline__ void stage_rc(int b, int& R, int& C) { const int st = b / 1024, sb = b % 1024, swz = sb ^ (((sb >> 9) & 1) << 5); R = (st >> 1) * 16 + swz / 64; C = (st & 1) * 32 + (swz % 64) / 2; }
__host__ __device__ __forceinline__ int perm32(int rho) { const int n = rho >> 4, i = rho & 15; return 8 * (i >> 2) + 4 * n + (i & 3); }

struct Unit { int pm, pn; };
struct Gemm { const bf16_t* A; const bf16_t* Bt; int M, N, K; };

struct StaticOrder {
    int nM, nN, nwg, G, c;
    __host__ __device__ void init(int M, int N, int G_, int c_) { nM = M / BM; nN = N / BM; nwg = nM * nN; G = G_; c = c_; }
    __host__ __device__ bool next(int i, Unit& u) const {
        const long L = (long)i * G + c; if (L >= nwg) return false;
        int wgid = (int)L; { const int q = nwg / NXCD, r = nwg % NXCD, xcd = wgid % NXCD, off = wgid / NXCD; wgid = (xcd < r ? xcd * (q + 1) : r * (q + 1) + (xcd - r) * q) + off; }
        const int nig = WGM * nN, gid = wgid / nig, fm = gid * WGM, gsz = (nM - fm) < WGM ? (nM - fm) : WGM;
        u.pm = fm + ((wgid % nig) % gsz); u.pn = (wgid % nig) / gsz; return true;
    }
    __device__ __forceinline__ void a_ready(const Unit&) const {}
    __device__ __forceinline__ void done(const Unit&) const {}
};

__device__ __forceinline__ unsigned cvt_pk_bf16(float lo, float hi) { unsigned r; asm volatile("v_cvt_pk_bf16_f32 %0, %1, %2" : "=v"(r) : "v"(lo), "v"(hi)); return r; }

struct EpiBf16 {
    static constexpr bool PERM = true, AFTER_DRAIN = false;
    bf16_t* O; int ldc;
    __device__ __forceinline__ void operator()(const f32x4 (&acc)[2][2][4][2], const Unit& u, int wr, int wc, int fr, int fq) const {
        const int row0 = u.pm * BM + wr * 64 + fr, col0 = u.pn * BM + wc * 32 + 8 * fq;
#pragma unroll
        for (int ai = 0; ai < 2; ++ai)
#pragma unroll
            for (int m = 0; m < 4; ++m) { bf16_t* rowp = O + (size_t)(row0 + ai * HALF + m * 16) * ldc + col0;
#pragma unroll
                for (int bj = 0; bj < 2; ++bj) { const f32x4 v0 = acc[ai][bj][m][0], v1 = acc[ai][bj][m][1];
                    u32x4 w; w.x = cvt_pk_bf16(v0[0], v0[1]); w.y = cvt_pk_bf16(v0[2], v0[3]); w.z = cvt_pk_bf16(v1[0], v1[1]); w.w = cvt_pk_bf16(v1[2], v1[3]);
                    *(u32x4*)(rowp + bj * HALF) = w; } }
    }
};
struct EpiInProj {
    static constexpr bool PERM = true, AFTER_DRAIN = false;
    bf16_t* O; int ldc; const float* rope;
    __device__ __forceinline__ void operator()(const f32x4 (&acc)[2][2][4][2], const Unit& u, int wr, int wc, int fr, int fq) const {
        const int row0 = u.pm * BM + wr * 64 + fr, col0 = u.pn * BM + wc * 32 + 8 * fq;
        const bool do_rope = (u.pn < 8) && (u.pm < 64);
        const float qsc = (u.pn < 4) ? 0.18033688011112042f : 1.f;
#pragma unroll
        for (int ai = 0; ai < 2; ++ai)
#pragma unroll
            for (int m = 0; m < 4; ++m) { const int row = row0 + ai * HALF + m * 16; bf16_t* rowp = O + (size_t)row * ldc + col0;
                f32x4 cs01 = {1.f, 0.f, 1.f, 0.f}, cs23 = {1.f, 0.f, 1.f, 0.f};
                if (do_rope) { const int pos = (wc & 1) ? (row & 63) : ((row >> 6) & 31); const f32x4* rp = (const f32x4*)(rope + (size_t)(pos * 16 + 4 * fq) * 2); cs01 = rp[0]; cs23 = rp[1]; }
#pragma unroll
                for (int bj = 0; bj < 2; ++bj) { f32x4 v0 = acc[ai][bj][m][0], v1 = acc[ai][bj][m][1];
                    if (do_rope) {
                        const float a0 = v0[0] * cs01[0] - v0[1] * cs01[1], a1 = v0[0] * cs01[1] + v0[1] * cs01[0];
                        const float a2 = v0[2] * cs01[2] - v0[3] * cs01[3], a3 = v0[2] * cs01[3] + v0[3] * cs01[2];
                        const float b0 = v1[0] * cs23[0] - v1[1] * cs23[1], b1 = v1[0] * cs23[1] + v1[1] * cs23[0];
                        const float b2 = v1[2] * cs23[2] - v1[3] * cs23[3], b3 = v1[2] * cs23[3] + v1[3] * cs23[2];
                        v0 = (f32x4){a0, a1, a2, a3}; v1 = (f32x4){b0, b1, b2, b3};
                    }
                    v0 = v0 * qsc; v1 = v1 * qsc;
                    u32x4 w; w.x = cvt_pk_bf16(v0[0], v0[1]); w.y = cvt_pk_bf16(v0[2], v0[3]); w.z = cvt_pk_bf16(v1[0], v1[1]); w.w = cvt_pk_bf16(v1[2], v1[3]);
                    *(u32x4*)(rowp + bj * HALF) = w; } }
    }
};

template <class Epi, class Sched, bool ALIGN_EPI = false, bool SP2 = false>
__device__ __forceinline__ void gemm_phase(PG8_LAS unsigned char* lds, const Gemm g, const Sched& S, const Epi& E) {
    const int tid = opaque_tid(), wid = __builtin_amdgcn_readfirstlane(tid >> 6), lane = tid & 63, wr = wid >> 2, wc = wid & 3, fr = lane & 15, fq = lane >> 4;
    const int K = g.K, nt = K / BK;
    unsigned voffA[2], voffB[2];
#pragma unroll
    for (int i = 0; i < 2; ++i) { int R, C; stage_rc(tid * 16 + i * 8192, R, C); const int Rb = Epi::PERM ? ((R & ~31) + perm32(R & 31)) : R;
        voffA[i] = (unsigned)(R * K + C) * 2u; voffB[i] = (unsigned)(Rb * K + C) * 2u; }
    const size_t kstep = (size_t)(BK * 2);
    const size_t hstep = (size_t)HALF * K * 2;
    const size_t tstep = 2 * hstep;
    const unsigned ldsw = (unsigned)wid * 1024u;
    const int aoff = lds_byte(wr * 64 + fr, fq * 8), boff = lds_byte(wc * 32 + fr, fq * 8);
#define PG8_SA(b, h) (((b) * 2 + (h)) * HTB)
#define PG8_SB(b, h) ((4 + (b) * 2 + (h)) * HTB)
#define PG8_STAGE(bufoff, gbase, voff) do { _Pragma("unroll") for (int _i = 0; _i < 2; ++_i) \
        __builtin_amdgcn_global_load_lds((const unsigned*)((const char*)(gbase) + (voff)[_i]), (PG8_LAS unsigned*)(lds + (bufoff) + ldsw + _i * 8192), 16, 0, 0); } while (0)
#define PG8_LDA(dst, b, h) do { _Pragma("unroll") for (int m = 0; m < 4; ++m) _Pragma("unroll") for (int k = 0; k < 2; ++k) dst[m][k] = *(const PG8_LAS bf16x8*)(lds + PG8_SA(b, h) + aoff + m * 2048 + k * 1024); } while (0)
#define PG8_LDB(dst, b, h) do { _Pragma("unroll") for (int n = 0; n < 2; ++n) _Pragma("unroll") for (int k = 0; k < 2; ++k) dst[n][k] = *(const PG8_LAS bf16x8*)(lds + PG8_SB(b, h) + boff + n * 2048 + k * 1024); } while (0)
#define PG8_MMA(ai, bj, At, Bt) do { __builtin_amdgcn_s_setprio(1); _Pragma("unroll") for (int m = 0; m < 4; ++m) _Pragma("unroll") for (int n = 0; n < 2; ++n) _Pragma("unroll") for (int k = 0; k < 2; ++k) \
        acc[ai][bj][m][n] = __builtin_amdgcn_mfma_f32_16x16x32_bf16(Bt[n][k], At[m][k], acc[ai][bj][m][n], 0, 0, 0); __builtin_amdgcn_s_setprio(0); } while (0)
#define PG8_WAIT_V(n) asm volatile("s_waitcnt vmcnt(" #n ")" ::: "memory")
#define PG8_WAIT_L(n) asm volatile("s_waitcnt lgkmcnt(" #n ")" ::: "memory")
#define PG8_BAR __builtin_amdgcn_s_barrier()
#define PG8_SCHED __builtin_amdgcn_sched_barrier(0)
    Unit cur, nxt; int ui = 0;
    if (!S.next(0, cur)) return;
    f32x4 acc[2][2][4][2];
#pragma unroll
    for (int a = 0; a < 2; ++a)
#pragma unroll
        for (int b = 0; b < 2; ++b)
#pragma unroll
            for (int m = 0; m < 4; ++m)
#pragma unroll
                for (int n = 0; n < 2; ++n) acc[a][b][m][n] = (f32x4){0.f, 0.f, 0.f, 0.f};
    bf16x8 At[4][2], B0[2][2], B1[2][2];
    const char* cA = (const char*)g.A + (size_t)cur.pm * tstep; const char* cB = (const char*)g.Bt + (size_t)cur.pn * tstep;
    S.a_ready(cur);
    if constexpr (SP2) {
        PG8_STAGE(PG8_SB(0, 0), cB, voffB); PG8_STAGE(PG8_SB(0, 1), cB + hstep, voffB); PG8_STAGE(PG8_SA(0, 0), cA, voffA); PG8_STAGE(PG8_SA(0, 1), cA + hstep, voffA);
        if (wr == 1) PG8_BAR;
        PG8_WAIT_V(2); PG8_BAR;
        PG8_STAGE(PG8_SB(1, 0), cB + kstep, voffB); PG8_STAGE(PG8_SA(1, 0), cA + kstep, voffA); PG8_STAGE(PG8_SB(1, 1), cB + hstep + kstep, voffB);
        PG8_WAIT_V(6); PG8_BAR;
    } else {
        PG8_STAGE(PG8_SB(0, 0), cB, voffB); PG8_STAGE(PG8_SA(0, 0), cA, voffA); PG8_STAGE(PG8_SB(0, 1), cB + hstep, voffB); PG8_STAGE(PG8_SA(0, 1), cA + hstep, voffA);
        if (wr == 1) PG8_BAR;
        PG8_WAIT_V(4); PG8_BAR;
        PG8_STAGE(PG8_SB(1, 0), cB + kstep, voffB); PG8_STAGE(PG8_SA(1, 0), cA + kstep, voffA); PG8_STAGE(PG8_SB(1, 1), cB + hstep + kstep, voffB);
        PG8_WAIT_V(6); PG8_BAR;
    }
    for (;;) {
        const bool has_next = S.next(ui + 1, nxt);
        const char* nA = has_next ? (const char*)g.A + (size_t)nxt.pm * tstep : cA; const char* nB = has_next ? (const char*)g.Bt + (size_t)nxt.pn * tstep : cB;
        for (int t = 0; t < nt; t += 2) {
            const bool last = (t == nt - 2);
            const char* a1 = cA + (size_t)(t + 1) * kstep;
            const char* a2 = last ? nA : cA + (size_t)(t + 2) * kstep; const char* b2 = last ? nB : cB + (size_t)(t + 2) * kstep;
            const char* a3 = a2 + kstep; const char* b3 = b2 + kstep;
            if (last && has_next) S.a_ready(nxt);
            if constexpr (SP2) {
            PG8_LDB(B0, 0, 0); PG8_LDB(B1, 0, 1); PG8_SCHED; PG8_LDA(At, 0, 0); PG8_STAGE(PG8_SA(1, 1), a1 + hstep, voffA);
            PG8_WAIT_V(8); PG8_WAIT_L(0); PG8_BAR; PG8_MMA(0, 0, At, B0); PG8_MMA(0, 1, At, B1); PG8_BAR; PG8_SCHED;
            PG8_LDA(At, 0, 1); PG8_STAGE(PG8_SB(0, 0), b2, voffB); PG8_STAGE(PG8_SB(0, 1), b2 + hstep, voffB); PG8_STAGE(PG8_SA(0, 0), a2, voffA);
            PG8_WAIT_V(8); PG8_WAIT_L(0); PG8_BAR; PG8_MMA(1, 0, At, B0); PG8_MMA(1, 1, At, B1); PG8_BAR; PG8_SCHED;
            PG8_LDB(B0, 1, 0); PG8_LDB(B1, 1, 1); PG8_SCHED; PG8_LDA(At, 1, 0); PG8_STAGE(PG8_SA(0, 1), a2 + hstep, voffA);
            PG8_WAIT_V(8); PG8_WAIT_L(0); PG8_BAR; PG8_MMA(0, 0, At, B0); PG8_MMA(0, 1, At, B1); PG8_BAR; PG8_SCHED;
            PG8_LDA(At, 1, 1); PG8_STAGE(PG8_SB(1, 0), b3, voffB); PG8_STAGE(PG8_SB(1, 1), b3 + hstep, voffB); PG8_STAGE(PG8_SA(1, 0), a3, voffA);
            PG8_WAIT_V(8); PG8_WAIT_L(0); PG8_BAR; PG8_MMA(1, 0, At, B0); PG8_MMA(1, 1, At, B1); PG8_BAR; PG8_SCHED;
            } else {
            PG8_LDB(B0, 0, 0); PG8_SCHED; PG8_LDA(At, 0, 0); PG8_STAGE(PG8_SA(1, 1), a1 + hstep, voffA);
            PG8_WAIT_L(8); PG8_BAR; PG8_WAIT_L(0); PG8_MMA(0, 0, At, B0); PG8_BAR; PG8_SCHED;
            PG8_LDB(B1, 0, 1); PG8_STAGE(PG8_SB(0, 0), b2, voffB);
            PG8_BAR; PG8_WAIT_L(0); PG8_MMA(0, 1, At, B1); PG8_BAR;
            PG8_LDA(At, 0, 1); PG8_STAGE(PG8_SA(0, 0), a2, voffA);
            PG8_BAR; PG8_WAIT_L(0); PG8_MMA(1, 0, At, B0); PG8_BAR; PG8_SCHED;
            PG8_STAGE(PG8_SB(0, 1), b2 + hstep, voffB);
            PG8_WAIT_V(6); PG8_BAR; PG8_MMA(1, 1, At, B1); PG8_BAR;
            PG8_LDB(B0, 1, 0); PG8_SCHED; PG8_LDA(At, 1, 0); PG8_STAGE(PG8_SA(0, 1), a2 + hstep, voffA);
            PG8_WAIT_L(8); PG8_BAR; PG8_WAIT_L(0); PG8_MMA(0, 0, At, B0); PG8_BAR; PG8_SCHED;
            PG8_LDB(B1, 1, 1); PG8_STAGE(PG8_SB(1, 0), b3, voffB);
            PG8_BAR; PG8_WAIT_L(0); PG8_MMA(0, 1, At, B1); PG8_BAR;
            PG8_LDA(At, 1, 1); PG8_STAGE(PG8_SA(1, 0), a3, voffA);
            PG8_BAR; PG8_WAIT_L(0); PG8_MMA(1, 0, At, B0); PG8_BAR; PG8_SCHED;
            PG8_STAGE(PG8_SB(1, 1), b3 + hstep, voffB);
            PG8_WAIT_V(6); PG8_BAR; PG8_MMA(1, 1, At, B1); PG8_BAR;
            }
        }
        if constexpr (ALIGN_EPI) { if (wr == 0) PG8_BAR; }
        if constexpr (!Epi::AFTER_DRAIN) { E(acc, cur, wr, wc, fr, fq); S.done(cur); }
        if (!has_next) break;
#pragma unroll
        for (int a = 0; a < 2; ++a)
#pragma unroll
            for (int b = 0; b < 2; ++b)
#pragma unroll
                for (int m = 0; m < 4; ++m)
#pragma unroll
                    for (int n = 0; n < 2; ++n) acc[a][b][m][n] = (f32x4){0.f, 0.f, 0.f, 0.f};
        cur = nxt; cA = nA; cB = nB; ++ui;
        if constexpr (ALIGN_EPI) { if (wr == 1) PG8_BAR; }
    }
    PG8_WAIT_V(0);
    if constexpr (!ALIGN_EPI) { if (wr == 0) PG8_BAR; }
    PG8_BAR;
    if constexpr (Epi::AFTER_DRAIN) { E.fused(acc, cur, wr, wc, fr, fq, lds, wid, lane); S.done(cur); }
#undef PG8_SA
#undef PG8_SB
#undef PG8_STAGE
#undef PG8_LDA
#undef PG8_LDB
#undef PG8_MMA
#undef PG8_WAIT_V
#undef PG8_WAIT_L
#undef PG8_BAR
#undef PG8_SCHED
}
}

namespace att {
using bf16x8 = __attribute__((ext_vector_type(8))) short;
using s16x4  = __attribute__((ext_vector_type(4))) short;
using f32x16 = __attribute__((ext_vector_type(16))) float;
using u32x4  = __attribute__((ext_vector_type(4))) unsigned;
constexpr int NW = 8, QBLK = 32, KVBLK = 64, QROWS = 128;
constexpr float SCALE = 0.125f, QPRESCALE = SCALE * 1.4426950408889634f, THRL = 8.f;
constexpr int SHM_V = KVBLK * 128 * 2, SHM_K = KVBLK * 128 * 2, SHM_ATTN = 2 * SHM_V + 2 * SHM_K + NW * 64 * 4;
#define KSWZ(row, colB) ((row) * 256 + ((colB) ^ (((row) & 7) << 4)))
#define SBAR() __builtin_amdgcn_sched_barrier(0)
__device__ __forceinline__ int crow(int r, int hi) { return (r & 3) + 8 * (r >> 2) + 4 * hi; }
__device__ __forceinline__ unsigned cvtpk(float lo, float hi) { unsigned r; asm volatile("v_cvt_pk_bf16_f32 %0, %1, %2" : "=v"(r) : "v"(lo), "v"(hi)); return r; }
__device__ __forceinline__ void partialSM(f32x16& p0, f32x16& p1, float& mhat, f32x16& negm, float& alpha) {
  float a = fmaxf(fmaxf(p0[0], p0[1]), p1[0]), b2 = fmaxf(fmaxf(p0[2], p0[3]), p1[1]); a = fmaxf(fmaxf(a, p1[2]), p1[3]);
#pragma unroll
  for (int r = 4; r < 16; r += 4) { a = fmaxf(fmaxf(a, p0[r]), p0[r + 1]); b2 = fmaxf(fmaxf(b2, p0[r + 2]), p0[r + 3]); a = fmaxf(fmaxf(a, p1[r]), p1[r + 1]); b2 = fmaxf(fmaxf(b2, p1[r + 2]), p1[r + 3]); }
  float rm = fmaxf(a, b2);
  { auto rr = __builtin_amdgcn_permlane32_swap(__float_as_uint(rm), __float_as_uint(rm), false, false);
    rm = fmaxf(__uint_as_float(rr[0]), __uint_as_float(rr[1])); }
  alpha = 1.f;
  if (__builtin_expect(__any(rm > THRL), 0)) {
    const float dl = fmaxf(rm, 0.f); mhat += dl;
#pragma unroll
    for (int r = 0; r < 16; ++r) { p0[r] -= dl; p1[r] -= dl; }
#pragma unroll
    for (int r = 0; r < 16; ++r) negm[r] = -mhat;
    alpha = __builtin_amdgcn_exp2f(-dl);
  }
#pragma unroll
  for (int r = 0; r < 16; ++r) p0[r] = __builtin_amdgcn_exp2f(p0[r]);
}
__device__ __forceinline__ void finishSM(f32x16& p0, f32x16& p1, float alpha, float& l_reg, bf16x8& pa0, bf16x8& pa1, bf16x8& pa2, bf16x8& pa3) {
#pragma unroll
  for (int r = 0; r < 16; ++r) p1[r] = __builtin_amdgcn_exp2f(p1[r]);
  float ps = 0;
#pragma unroll
  for (int r = 0; r < 16; ++r) ps += p0[r];
#pragma unroll
  for (int r = 0; r < 16; ++r) ps += p1[r];
  { auto rr = __builtin_amdgcn_permlane32_swap(__float_as_uint(ps), __float_as_uint(ps), false, false);
    ps = __uint_as_float(rr[0]) + __uint_as_float(rr[1]); }
  l_reg = l_reg * alpha + ps;
#define PK4(P, BASE, OUT) do { unsigned a0 = cvtpk(P[BASE + 0], P[BASE + 1]), a1 = cvtpk(P[BASE + 2], P[BASE + 3]);   \
    unsigned b0 = cvtpk(P[BASE + 4], P[BASE + 5]), b1 = cvtpk(P[BASE + 6], P[BASE + 7]);                              \
    auto r0 = __builtin_amdgcn_permlane32_swap(a0, b0, false, false); auto r1 = __builtin_amdgcn_permlane32_swap(a1, b1, false, false); \
    u32x4 w = {r0[0], r1[0], r0[1], r1[1]}; OUT = *reinterpret_cast<bf16x8*>(&w); } while (0)
  PK4(p0, 0, pa0); PK4(p0, 8, pa1); PK4(p1, 0, pa2); PK4(p1, 8, pa3);
#undef PK4
}
__device__ __forceinline__ void qkt(f32x16& p0, f32x16& p1, const char* Ks, const bf16x8* qr, const f32x16& negm, int r32, int hi, int sub) {
#pragma unroll
  for (int d0 = 0; d0 < 4; ++d0) { const int cb = (sub * 64 + d0 * 16 + hi * 8) * 2;
    const bf16x8 b0 = *reinterpret_cast<const bf16x8*>(Ks + KSWZ(r32, cb));
    const bf16x8 b1 = *reinterpret_cast<const bf16x8*>(Ks + KSWZ(32 + r32, cb));
    if (d0 == 0) { p0 = __builtin_amdgcn_mfma_f32_32x32x16_bf16(b0, qr[0], negm, 0, 0, 0); p1 = __builtin_amdgcn_mfma_f32_32x32x16_bf16(b1, qr[0], negm, 0, 0, 0); }
    else { p0 = __builtin_amdgcn_mfma_f32_32x32x16_bf16(b0, qr[d0], p0, 0, 0, 0); p1 = __builtin_amdgcn_mfma_f32_32x32x16_bf16(b1, qr[d0], p1, 0, 0, 0); } }
}
__device__ __forceinline__ int v_st(int k, int c) { const int kk = (k & ~0xC) | ((k & 4) << 1) | ((k & 8) >> 1); return ((kk >> 3) * 4 + (c >> 5)) * 512 + ((kk & 7) * 32 + (c & 31)) * 2; }
__device__ __forceinline__ int v_rd_base(int lane) { return ((lane & 3) << 3) | (((lane >> 2) & 3) << 6) | (((lane >> 4) & 1) << 5) | (((lane >> 5) & 1) << 8); }
constexpr int v_rd_off(int d0, int ks, int half) { return d0 * 512 + ks * 4096 + half * 2048; }
template <int OFF> __device__ __forceinline__ s16x4 tr_read(int vb) {
  s16x4 r; asm volatile("ds_read_b64_tr_b16 %0, %1 offset:%2" : "=&v"(r) : "v"(vb), "i"(OFF) : "memory"); return r;
}
template <int D0> __device__ __forceinline__ void pv_one(f32x16& od, int vb, bf16x8 pa0, bf16x8 pa1, bf16x8 pa2, bf16x8 pa3) {
  const s16x4 l0 = tr_read<v_rd_off(D0, 0, 0)>(vb), h0 = tr_read<v_rd_off(D0, 0, 1)>(vb), l1 = tr_read<v_rd_off(D0, 1, 0)>(vb), h1 = tr_read<v_rd_off(D0, 1, 1)>(vb);
  const s16x4 l2 = tr_read<v_rd_off(D0, 2, 0)>(vb), h2 = tr_read<v_rd_off(D0, 2, 1)>(vb), l3 = tr_read<v_rd_off(D0, 3, 0)>(vb), h3 = tr_read<v_rd_off(D0, 3, 1)>(vb);
  asm volatile("s_waitcnt lgkmcnt(0)" ::: "memory"); SBAR();
#define PK(L, H) (bf16x8){L[0], L[1], L[2], L[3], H[0], H[1], H[2], H[3]}
  od = __builtin_amdgcn_mfma_f32_32x32x16_bf16(pa0, PK(l0, h0), od, 0, 0, 0);
  od = __builtin_amdgcn_mfma_f32_32x32x16_bf16(pa1, PK(l1, h1), od, 0, 0, 0);
  od = __builtin_amdgcn_mfma_f32_32x32x16_bf16(pa2, PK(l2, h2), od, 0, 0, 0);
  od = __builtin_amdgcn_mfma_f32_32x32x16_bf16(pa3, PK(l3, h3), od, 0, 0, 0);
#undef PK
}
__device__ __forceinline__ void pv_d0(f32x16* o, int vb, bf16x8 pa0, bf16x8 pa1, bf16x8 pa2, bf16x8 pa3) {
  pv_one<0>(o[0], vb, pa0, pa1, pa2, pa3); pv_one<1>(o[1], vb, pa0, pa1, pa2, pa3); pv_one<2>(o[2], vb, pa0, pa1, pa2, pa3); pv_one<3>(o[3], vb, pa0, pa1, pa2, pa3);
}
__device__ __forceinline__ long ktile_row(int b, int t) { return t < 4 ? (long)(NLAT + b * CTXL + 64 * t) : (long)(b * SEQ + 64 * (t - 4)); }

__device__ __forceinline__ void attn_unit(const bf16_t* __restrict__ Pm, bf16_t* __restrict__ Y, long qrow0, int b, int hh, int NT, float lam, float lam_init,
                                          const float* __restrict__ subln, char* lds) {
  const int tid = opaque_tid(), wid = tid >> 6, lane = tid & 63, r32 = lane & 31, hi = lane >> 5;
  const int sub = wid & 1, pr = wid >> 1;
  char* V_lds = lds; char* K_lds = lds + 2 * SHM_V;
  float* ws = (float*)(lds + 2 * SHM_V + 2 * SHM_K) + wid * 64; float* li_l = ws; float* al_l = ws + 32;
  float mhat = 0.f, l_reg = 0; f32x16 o[4] = {}; f32x16 negm = {}; bf16x8 qr[4];
  const bf16_t* Qw = Pm + (qrow0 + pr * QBLK + r32) * NP + C_QA + hh * 128 + sub * 64 + hi * 8;
#pragma unroll
  for (int d0 = 0; d0 < 4; ++d0) qr[d0] = *reinterpret_cast<const bf16x8*>(Qw + d0 * 16);
  const int sr = tid >> 4, sc = (tid & 15) * 8, vst0 = v_st(sr, sc), vst1 = v_st(32 + sr, sc);
  const int vb0 = (int)(uintptr_t)V_lds + v_rd_base(lane);
  const bf16_t* Kcol = Pm + C_KA + hh * 128 + sc; const bf16_t* Vcol = Pm + C_VA + hh * 128 + sc;
  struct { bf16x8 vs0, vs1, ks0, ks1; } sr_[1];
#define SLOAD(i, t) do { const long r0_ = ktile_row(b, (t)) + sr; \
    sr_[i].vs0 = *reinterpret_cast<const bf16x8*>(Vcol + r0_ * NP); sr_[i].vs1 = *reinterpret_cast<const bf16x8*>(Vcol + (r0_ + 32) * NP); \
    sr_[i].ks0 = *reinterpret_cast<const bf16x8*>(Kcol + r0_ * NP); sr_[i].ks1 = *reinterpret_cast<const bf16x8*>(Kcol + (r0_ + 32) * NP); } while (0)
#define SWRITE(bb, i) do { *(bf16x8*)(V_lds + (bb) * SHM_V + vst0) = sr_[i].vs0; *(bf16x8*)(V_lds + (bb) * SHM_V + vst1) = sr_[i].vs1; const int kc = sc * 2; \
    *(bf16x8*)(K_lds + (bb) * SHM_K + KSWZ(sr, kc)) = sr_[i].ks0; *(bf16x8*)(K_lds + (bb) * SHM_K + KSWZ(32 + sr, kc)) = sr_[i].ks1; } while (0)
#define SWAIT() asm volatile("s_waitcnt vmcnt(0)" ::: "memory")
#define RESC(a) do { if (__any((a) < 1.f)) { if (hi == 0) al_l[r32] = (a); asm volatile("s_waitcnt lgkmcnt(0)" ::: "memory"); \
    _Pragma("unroll") for (int d = 0; d < 4; ++d) _Pragma("unroll") for (int r = 0; r < 16; ++r) o[d][r] *= al_l[crow(r, hi)]; } } while (0)
  f32x16 pA0, pA1, pB0, pB1; float alA, alB; bf16x8 pa0, pa1, pa2, pa3;
  constexpr int SE = 0, SO = 0;
  SLOAD(SE, 0); asm volatile("s_waitcnt vmcnt(0)" ::: "memory"); SWRITE(0, SE); __syncthreads();
  qkt(pA0, pA1, K_lds, qr, negm, r32, hi, sub); partialSM(pA0, pA1, mhat, negm, alA);
  SLOAD(SO, 1);
  SWAIT(); SWRITE(1, SO); __syncthreads();
  for (int j = 1; j + 1 < NT; j += 2) {
    SBAR(); qkt(pB0, pB1, K_lds + SHM_K, qr, negm, r32, hi, sub);
    finishSM(pA0, pA1, alA, l_reg, pa0, pa1, pa2, pa3); SBAR();
    SLOAD(SO, j + 1); SBAR();
    pv_d0(o, vb0, pa0, pa1, pa2, pa3); partialSM(pB0, pB1, mhat, negm, alB);
    __syncthreads(); SWAIT(); SWRITE(0, SE);
    RESC(alB); __syncthreads();
    SBAR(); qkt(pA0, pA1, K_lds, qr, negm, r32, hi, sub);
    finishSM(pB0, pB1, alB, l_reg, pa0, pa1, pa2, pa3); SBAR();
    SLOAD(SE, j + 2); SBAR();
    pv_d0(o, vb0 + SHM_V, pa0, pa1, pa2, pa3); partialSM(pA0, pA1, mhat, negm, alA);
    __syncthreads(); SWAIT(); SWRITE(1, SO);
    RESC(alA); __syncthreads();
  }
  SBAR(); qkt(pB0, pB1, K_lds + SHM_K, qr, negm, r32, hi, sub);
  finishSM(pA0, pA1, alA, l_reg, pa0, pa1, pa2, pa3); SBAR();
  pv_d0(o, vb0, pa0, pa1, pa2, pa3); partialSM(pB0, pB1, mhat, negm, alB);
  __syncthreads(); RESC(alB);
  finishSM(pB0, pB1, alB, l_reg, pa0, pa1, pa2, pa3); SBAR();
  pv_d0(o, vb0 + SHM_V, pa0, pa1, pa2, pa3);
  if (hi == 0) li_l[r32] = l_reg; asm volatile("s_waitcnt lgkmcnt(0)" ::: "memory");
  const float fac = sub ? lam : 1.f;
#pragma unroll
  for (int r = 0; r < 16; ++r) { const float rl = fac * __builtin_amdgcn_rcpf(li_l[crow(r, hi)]);
#pragma unroll
    for (int d0 = 0; d0 < 4; ++d0) o[d0][r] *= rl; }
  __syncthreads();
  float* XB = (float*)lds + pr * 4096;
  if (sub == 1) {
#pragma unroll
    for (int d0 = 0; d0 < 4; ++d0)
#pragma unroll
      for (int r = 0; r < 16; ++r) XB[(d0 * 16 + r) * 64 + lane] = o[d0][r];
  }
  __syncthreads();
  if (sub == 0) {
    float ss[16];
#pragma unroll
    for (int r = 0; r < 16; ++r) { float a = 0.f;
#pragma unroll
      for (int d0 = 0; d0 < 4; ++d0) { o[d0][r] -= XB[(d0 * 16 + r) * 64 + lane]; a += o[d0][r] * o[d0][r]; }
      ss[r] = a; }
#pragma unroll
    for (int r = 0; r < 16; ++r) {
#pragma unroll
      for (int off = 1; off < 32; off <<= 1) ss[r] += __shfl_xor(ss[r], off);
      ss[r] = rsqrtf(ss[r] * (1.f / 128.f) + EPS) * (1.f - lam_init);
    }
    float sw[4];
#pragma unroll
    for (int d0 = 0; d0 < 4; ++d0) sw[d0] = subln[d0 * 32 + r32];
#pragma unroll
    for (int r = 0; r < 16; ++r) { const long row = qrow0 + pr * QBLK + crow(r, hi);
      const bf16_t* gp = Pm + row * NP + C_GA + hh * 128 + r32; bf16_t* yp = Y + row * DM + hh * 128 + r32;
#pragma unroll
      for (int d0 = 0; d0 < 4; ++d0) { const float g = bf2f(gp[d0 * 32]); yp[d0 * 32] = f2bf(o[d0][r] * ss[r] * sw[d0] * (g / (1.f + __expf(-g)))); } }
  }
  __syncthreads();
#undef SLOAD
#undef SWRITE
#undef SWAIT
#undef RESC
}
__device__ __forceinline__ void attn_phase(const bf16_t* __restrict__ Pm, bf16_t* __restrict__ Y, const float* lq1, const float* lk1, const float* lq2, const float* lk2,
                                           const float* __restrict__ subln, float lam_init, bool ctx_out, unsigned* qcnt  ,
                                           volatile __attribute__((address_space(3))) unsigned* bcast, char* lds) {
  const int tid = opaque_tid(), lane = tid & 63;
  const float lam = expf(wave_sum(lq1[lane] * lk1[lane])) - expf(wave_sum(lq2[lane] * lk2[lane])) + lam_init;
  const int G = gridDim.x, bx = blockIdx.x; const int vcu = (G % 8 == 0) ? (bx % 8) * (G / 8) + bx / 8 : bx;
  const int g0 = (G == 256) ? (vcu >> 5) : (bx & 7);
  const int nun = 128 + (ctx_out ? 16 : 0);
  for (int gi = 0; gi < 8; ++gi) {
    const int g = (g0 + gi) & 7;
    for (;;) {
      if (tid == 0) bcast[0] = __hip_atomic_fetch_add(qcnt + 64 * g, 1u, __ATOMIC_RELAXED, __HIP_MEMORY_SCOPE_AGENT);
      __syncthreads();
      const int u = (int)bcast[0];
      __syncthreads();
      if (u >= nun) break;
      if (u < 128) { const int bh = g * 8 + (u >> 4), qb = u & 15, b = bh >> 3, hh = bh & 7; attn_unit(Pm, Y, (long)b * SEQ + qb * QROWS, b, hh, 36, lam, lam_init, subln, lds); }
      else { const int v = u - 128, bh = g * 8 + (v >> 1), qb = v & 1, b = bh >> 3, hh = bh & 7; attn_unit(Pm, Y, (long)NLAT + b * CTXL + qb * QROWS, b, hh, 4, lam, lam_init, subln, lds); }
    }
  }
}
#undef KSWZ
#undef SBAR
}

namespace mls {
using bf16x8 = __attribute__((ext_vector_type(8))) short;
using s16x4  = __attribute__((ext_vector_type(4))) short;
using f32x4  = __attribute__((ext_vector_type(4))) float;
constexpr int QSTRB = 272, SSTRB = 144;
constexpr int VSTRB = 528;
constexpr int L_Q = 0, L_K = L_Q + 64 * QSTRB, L_V = L_K + 64 * QSTRB, L_S = L_V + 64 * VSTRB, L_CT = L_S + 64 * SSTRB, L_SM = L_CT + 256 * QSTRB, L_END = L_SM + 8192;
static_assert(L_END <= LDS_PHASE_BYTES && (L_K % 16) == 0 && (L_V % 16) == 0 && (L_S % 16) == 0 && (L_CT % 16) == 0 && (L_SM % 16) == 0, "mlstm LDS map");
__device__ __forceinline__ f32x4 mfma16(bf16x8 a, bf16x8 b, f32x4 c) { return __builtin_amdgcn_mfma_f32_16x16x32_bf16(a, b, c, 0, 0, 0); }
struct TrPair { s16x4 lo, hi; };
__device__ __forceinline__ TrPair tr_issue(unsigned addr, int rsb) {
  TrPair t;
  asm volatile("ds_read_b64_tr_b16 %0, %1" : "=&v"(t.lo) : "v"(addr) : "memory");
  asm volatile("ds_read_b64_tr_b16 %0, %1" : "=&v"(t.hi) : "v"(addr + 4u * (unsigned)rsb) : "memory");
  return t;
}
__device__ __forceinline__ bf16x8 tr_pack(const TrPair& t) { return (bf16x8){t.lo[0], t.lo[1], t.lo[2], t.lo[3], t.hi[0], t.hi[1], t.hi[2], t.hi[3]}; }
#define TR_PIN(t) asm volatile("" : "+v"((t).lo), "+v"((t).hi))
__device__ __forceinline__ float wave_scan_incl(float v) {
  v += __builtin_bit_cast(float, __builtin_amdgcn_update_dpp(0, __builtin_bit_cast(int, v), 0x111, 0xF, 0xF, false));
  v += __builtin_bit_cast(float, __builtin_amdgcn_update_dpp(0, __builtin_bit_cast(int, v), 0x112, 0xF, 0xF, false));
  v += __builtin_bit_cast(float, __builtin_amdgcn_update_dpp(0, __builtin_bit_cast(int, v), 0x114, 0xF, 0xF, false));
  v += __builtin_bit_cast(float, __builtin_amdgcn_update_dpp(0, __builtin_bit_cast(int, v), 0x118, 0xF, 0xF, false));
  v += __builtin_bit_cast(float, __builtin_amdgcn_update_dpp(0, __builtin_bit_cast(int, v), 0x142, 0xA, 0xF, false));
  v += __builtin_bit_cast(float, __builtin_amdgcn_update_dpp(0, __builtin_bit_cast(int, v), 0x143, 0xC, 0xF, false));
  return v;
}
__device__ __forceinline__ float fast_tanh(float x) { return 1.f - 2.f * __builtin_amdgcn_rcpf(1.f + __expf(2.f * x)); }

__device__ __forceinline__ void tr_v4(unsigned base, TrPair& a0, TrPair& a1, TrPair& b0, TrPair& b1, TrPair& c0, TrPair& c1, TrPair& d0, TrPair& d1) {
  asm volatile(
    "ds_read_b64_tr_b16 %0, %16\n\tds_read_b64_tr_b16 %1, %16 offset:2112\n\tds_read_b64_tr_b16 %2, %16 offset:16896\n\tds_read_b64_tr_b16 %3, %16 offset:19008\n\t"
    "ds_read_b64_tr_b16 %4, %16 offset:32\n\tds_read_b64_tr_b16 %5, %16 offset:2144\n\tds_read_b64_tr_b16 %6, %16 offset:16928\n\tds_read_b64_tr_b16 %7, %16 offset:19040\n\t"
    "ds_read_b64_tr_b16 %8, %16 offset:64\n\tds_read_b64_tr_b16 %9, %16 offset:2176\n\tds_read_b64_tr_b16 %10, %16 offset:16960\n\tds_read_b64_tr_b16 %11, %16 offset:19072\n\t"
    "ds_read_b64_tr_b16 %12, %16 offset:96\n\tds_read_b64_tr_b16 %13, %16 offset:2208\n\tds_read_b64_tr_b16 %14, %16 offset:16992\n\tds_read_b64_tr_b16 %15, %16 offset:19104\n\t"
    "s_waitcnt lgkmcnt(0)"
    : "=&v"(a0.lo), "=&v"(a0.hi), "=&v"(a1.lo), "=&v"(a1.hi), "=&v"(b0.lo), "=&v"(b0.hi), "=&v"(b1.lo), "=&v"(b1.hi),
      "=&v"(c0.lo), "=&v"(c0.hi), "=&v"(c1.lo), "=&v"(c1.hi), "=&v"(d0.lo), "=&v"(d0.hi), "=&v"(d1.lo), "=&v"(d1.hi)
    : "v"(base) : "memory");
}
__device__ __forceinline__ bf16x8 scale_frag(const TrPair& t, const float4 wa, const float4 wb) {
  const float f0 = bf2f((bf16_t)t.lo[0]) * wa.x, f1 = bf2f((bf16_t)t.lo[1]) * wa.y, f2 = bf2f((bf16_t)t.lo[2]) * wa.z, f3 = bf2f((bf16_t)t.lo[3]) * wa.w;
  const float f4 = bf2f((bf16_t)t.hi[0]) * wb.x, f5 = bf2f((bf16_t)t.hi[1]) * wb.y, f6 = bf2f((bf16_t)t.hi[2]) * wb.z, f7 = bf2f((bf16_t)t.hi[3]) * wb.w;
  return __builtin_bit_cast(bf16x8, make_uint4(pk2(f0, f1), pk2(f2, f3), pk2(f4, f5), pk2(f6, f7)));
}

__device__ __forceinline__ void mlstm_unit(const bf16_t* __restrict__ Pm, const bf16_t* __restrict__ QKC  , const float* __restrict__ GATES,
                                           bf16_t* __restrict__ HM, const float* __restrict__ i_bias, const float* __restrict__ f_bias,
                                           int b, int head, int dir, bool ctx_out, char* lds) {
  const int tid = opaque_tid(), wid = __builtin_amdgcn_readfirstlane(tid >> 6), lane = tid & 63, lr = lane & 15, kg = lane >> 4;
  char* q_lds = lds + L_Q; char* k_lds = lds + L_K; char* v_lds = lds + L_V; char* s_lds = lds + L_S; char* ct_lds = lds + L_CT;
  float* bl = (float*)(lds + L_SM); float* bsp = bl + 64; float* av = bsp + 64; float* wkl = av + 64; float* qn = wkl + 64; float* nvec = qn + 64; float* rs = nvec + 128; float* npart = rs + 1024;
  const unsigned lds0 = (unsigned)(uintptr_t)lds;
  const unsigned trq = (unsigned)((8 * kg + (lr >> 2)) * QSTRB + (4 * (lr & 3)) * 2), trv = (unsigned)((8 * kg + (lr >> 2)) * VSTRB + (4 * (lr & 3)) * 2);
  if (tid < 128) nvec[tid] = 0.f;
  const float ibias = i_bias[dir * 4 + head], fbias = f_bias[dir * 4 + head];
  const int chg = tid & 31, rg = tid >> 5; const bool isk = chg >= 16;
  const int qkcol = 1024 + (isk ? 512 : 0) + head * 128 + (chg & 15) * 8;
  const int vrow = tid >> 3, vch = tid & 7;
  uint4 pq0, pq1, pq2, pq3, pv0, pv1, pv2, pv3; float pgi, pgf;
#define MLS_LOAD(c_) do { const int c__ = (c_); const bool ic_ = c__ < 4; const int T_ = ic_ ? CTXL : SEQ, cc_ = ic_ ? c__ : c__ - 4; \
    const long rb_ = ic_ ? (long)(NLAT + b * CTXL) : (long)b * SEQ; const int t0_ = dir ? (T_ - 64 * (cc_ + 1)) : 64 * cc_; \
    { const bf16_t* qp_ = QKC + (rb_ + t0_ + rg) * DM + qkcol; pq0 = *(const uint4*)qp_; pq1 = *(const uint4*)(qp_ + 16 * DM); pq2 = *(const uint4*)(qp_ + 32 * DM); pq3 = *(const uint4*)(qp_ + 48 * DM); } \
    { const uint4* vp_ = (const uint4*)(Pm + (rb_ + t0_ + vrow) * NP + C_VB + head * 256 + vch * 32); pv0 = vp_[0]; pv1 = vp_[1]; pv2 = vp_[2]; pv3 = vp_[3]; } \
    const float* gr_ = GATES + (rb_ + t0_ + (dir ? 63 - lane : lane)) * 16; pgi = gr_[dir * 4 + head]; pgf = gr_[8 + dir * 4 + head]; } while (0)
  MLS_LOAD(0);
  f32x4 Cacc[16];
#pragma unroll
  for (int e = 0; e < 16; ++e) Cacc[e] = (f32x4){0.f, 0.f, 0.f, 0.f};
  float gprev = 0.f;
  __syncthreads();
  for (int c = 0; c < 36; ++c) {
    const bool isctx = c < 4; const int T = isctx ? CTXL : SEQ, cc = isctx ? c : c - 4;
    const long rowbase = isctx ? (long)(NLAT + b * CTXL) : (long)b * SEQ;
    const int t0 = dir ? (T - 64 * (cc + 1)) : 64 * cc;
    const bool need_h = ctx_out || !isctx;
    float gamma, wk_l;
    {
      const float igv = 15.f * fast_tanh((pgi + ibias) * (1.f / 15.f));
      const float fc = 15.f * fast_tanh((pgf + fbias) * (1.f / 15.f));
      const float lfv = fminf(fc, 0.f) - __logf(1.f + __expf(-fabsf(fc)));
      const float bcum = wave_scan_incl(lfv);
      const float b63 = __builtin_bit_cast(float, __builtin_amdgcn_readlane(__builtin_bit_cast(int, bcum), 63));
      gamma = __expf(b63); wk_l = __expf(b63 - bcum + igv);
      if (wid == 0) { bl[lane] = bcum; bsp[lane] = bcum - igv; av[lane] = __expf(bcum); wkl[lane] = wk_l; }
      if (c > 0 && tid < 128) nvec[tid] = gprev * nvec[tid] + (npart[tid] + npart[128 + tid]) + (npart[256 + tid] + npart[384 + tid]);
    }
#pragma unroll
    for (int eblk = 0; eblk < 16; ++eblk) { uint2 w_; w_.x = pk2(Cacc[eblk][0], Cacc[eblk][1]); w_.y = pk2(Cacc[eblk][2], Cacc[eblk][3]);
      *(uint2*)(ct_lds + (eblk * 16 + lr) * QSTRB + (wid * 16 + 4 * kg) * 2) = w_; }
    { char* dst = (isk ? k_lds : q_lds) + (chg & 15) * 16;
      *(uint4*)(dst + (dir ? 63 - rg : rg) * QSTRB) = pq0; *(uint4*)(dst + (dir ? 47 - rg : rg + 16) * QSTRB) = pq1;
      *(uint4*)(dst + (dir ? 31 - rg : rg + 32) * QSTRB) = pq2; *(uint4*)(dst + (dir ? 15 - rg : rg + 48) * QSTRB) = pq3; }
    { char* dst = v_lds + (dir ? 63 - vrow : vrow) * VSTRB + vch * 64;
      *(uint4*)dst = pv0; *(uint4*)(dst + 16) = pv1; *(uint4*)(dst + 32) = pv2; *(uint4*)(dst + 48) = pv3; }
    if (c + 1 < 36) MLS_LOAD(c + 1);
    __syncthreads();
    if (need_h) {
      const int lblk = wid >> 1;
#pragma unroll
      for (int u2 = 0; u2 < 2; ++u2) {
        const int sblk = 2 * (wid & 1) + u2;
        if (sblk <= lblk) {
          f32x4 acc = {0.f, 0.f, 0.f, 0.f};
#pragma unroll
          for (int ks = 0; ks < 4; ++ks) {
            const bf16x8 ka = *(const bf16x8*)(k_lds + (sblk * 16 + lr) * QSTRB + (ks * 32 + 8 * kg) * 2);
            const bf16x8 qb = *(const bf16x8*)(q_lds + (lblk * 16 + lr) * QSTRB + (ks * 32 + 8 * kg) * 2);
            acc = mfma16(ka, qb, acc);
          }
          const int l = lblk * 16 + lr; const float blv = bl[l];
          float v4[4]; float sum = 0.f;
#pragma unroll
          for (int r = 0; r < 4; ++r) { const int sidx = sblk * 16 + 4 * kg + r; const float w = (sidx <= l) ? __expf(blv - bsp[sidx]) : 0.f; v4[r] = acc[r] * w; sum += v4[r]; }
          uint2 w; w.x = pk2(v4[0], v4[1]); w.y = pk2(v4[2], v4[3]);
          *(uint2*)(s_lds + l * SSTRB + (sblk * 16 + 4 * kg) * 2) = w;
          rs[(sblk * 4 + kg) * 64 + l] = sum;
        } else if ((lblk == 0 && sblk == 1) || (lblk == 2 && sblk == 3)) {
          *(uint2*)(s_lds + (lblk * 16 + lr) * SSTRB + (sblk * 16 + 4 * kg) * 2) = make_uint2(0u, 0u);
        }
      }
      { const int l = tid >> 3, part = tid & 7; float a = 0.f;
        const unsigned* qp = (const unsigned*)(q_lds + l * QSTRB + part * 32);
#pragma unroll
        for (int i = 0; i < 8; ++i) { const unsigned wd = qp[i]; a += __uint_as_float(wd << 16) * nvec[part * 16 + 2 * i] + __uint_as_float(wd & 0xffff0000u) * nvec[part * 16 + 2 * i + 1]; }
        a += __builtin_bit_cast(float, __builtin_amdgcn_update_dpp(0, __builtin_bit_cast(int, a), 0xB1, 0xF, 0xF, false));
        a += __builtin_bit_cast(float, __builtin_amdgcn_update_dpp(0, __builtin_bit_cast(int, a), 0x4E, 0xF, 0xF, false));
        a += __builtin_bit_cast(float, __builtin_amdgcn_update_dpp(0, __builtin_bit_cast(int, a), 0x141, 0xF, 0xF, false));
        if (part == 0) qn[l] = a; }
    }
    __syncthreads();
    if (need_h) {
      const int lblk = wid >> 1, l = lblk * 16 + lr, eh = wid & 1;
      float d = av[l] * qn[l];
      for (int sb = 0; sb <= lblk; ++sb) d += (rs[(sb * 4 + 0) * 64 + l] + rs[(sb * 4 + 1) * 64 + l]) + (rs[(sb * 4 + 2) * 64 + l] + rs[(sb * 4 + 3) * 64 + l]);
      const float a_l = av[l], dinv = 1.f / fmaxf(fabsf(d), 1.f);
      bf16x8 qb[4];
#pragma unroll
      for (int ks = 0; ks < 4; ++ks) qb[ks] = *(const bf16x8*)(q_lds + l * QSTRB + (ks * 32 + 8 * kg) * 2);
      const bf16x8 sb0 = *(const bf16x8*)(s_lds + l * SSTRB + (8 * kg) * 2);
      bf16x8 sb1 = sb0; if (lblk >= 2) sb1 = *(const bf16x8*)(s_lds + l * SSTRB + (32 + 8 * kg) * 2);
      const int t = dir ? (t0 + 63 - l) : (t0 + l);
      bf16_t* hp = HM + ((size_t)dir * NTOK + rowbase + t) * 1024 + head * 256 + eh * 128 + 4 * kg;
#pragma unroll
      for (int half = 0; half < 2; ++half) {
        TrPair a0, a1, b0, b1, c0, c1, d0, d1;
        tr_v4(lds0 + L_V + trv + (unsigned)((eh * 8 + half * 4) * 32), a0, a1, b0, b1, c0, c1, d0, d1);
        __builtin_amdgcn_sched_barrier(0);
#define MLS_HTILE(ti, VA0, VA1) do { const int eblk = eh * 8 + half * 4 + (ti); f32x4 acc1 = {0.f, 0.f, 0.f, 0.f}, acc2 = {0.f, 0.f, 0.f, 0.f}; \
          _Pragma("unroll") for (int ks = 0; ks < 4; ++ks) { const bf16x8 ca = *(const bf16x8*)(ct_lds + (eblk * 16 + lr) * QSTRB + (ks * 32 + 8 * kg) * 2); acc1 = mfma16(ca, qb[ks], acc1); } \
          acc2 = mfma16(tr_pack(VA0), sb0, acc2); if (lblk >= 2) acc2 = mfma16(tr_pack(VA1), sb1, acc2); \
          uint2 w_; w_.x = pk2((a_l * acc1[0] + acc2[0]) * dinv, (a_l * acc1[1] + acc2[1]) * dinv); w_.y = pk2((a_l * acc1[2] + acc2[2]) * dinv, (a_l * acc1[3] + acc2[3]) * dinv); \
          *(uint2*)(hp + (half * 4 + (ti)) * 16) = w_; } while (0)
        MLS_HTILE(0, a0, a1); MLS_HTILE(1, b0, b1); MLS_HTILE(2, c0, c1); MLS_HTILE(3, d0, d1);
#undef MLS_HTILE
      }
    }
    {
      bf16x8 kA0, kA1;
      { TrPair ka0, ka1; const unsigned ak = lds0 + L_K + trq + (unsigned)(wid * 32);
        asm volatile("ds_read_b64_tr_b16 %0, %4\n\tds_read_b64_tr_b16 %1, %4 offset:1088\n\tds_read_b64_tr_b16 %2, %4 offset:8704\n\tds_read_b64_tr_b16 %3, %4 offset:9792\n\ts_waitcnt lgkmcnt(0)"
                     : "=&v"(ka0.lo), "=&v"(ka0.hi), "=&v"(ka1.lo), "=&v"(ka1.hi) : "v"(ak) : "memory");
        const float4 w0 = *(const float4*)(wkl + 8 * kg), w1 = *(const float4*)(wkl + 8 * kg + 4), w2 = *(const float4*)(wkl + 32 + 8 * kg), w3 = *(const float4*)(wkl + 36 + 8 * kg);
        kA0 = scale_frag(ka0, w0, w1); kA1 = scale_frag(ka1, w2, w3); }
#pragma unroll
      for (int q4 = 0; q4 < 4; ++q4) {
        TrPair a0, a1, b0, b1, c0, c1, d0, d1;
        tr_v4(lds0 + L_V + trv + (unsigned)(q4 * 128), a0, a1, b0, b1, c0, c1, d0, d1);
        __builtin_amdgcn_sched_barrier(0);
#define MLS_CUPD(ti, V0, V1) do { f32x4 cc_ = Cacc[q4 * 4 + (ti)] * gamma; cc_ = mfma16(kA0, tr_pack(V0), cc_); cc_ = mfma16(kA1, tr_pack(V1), cc_); Cacc[q4 * 4 + (ti)] = cc_; } while (0)
        MLS_CUPD(0, a0, a1); MLS_CUPD(1, b0, b1); MLS_CUPD(2, c0, c1); MLS_CUPD(3, d0, d1);
#undef MLS_CUPD
      }
      { const int dd = tid & 127, sq = tid >> 7; float a = 0.f; const bf16_t* kp = (const bf16_t*)k_lds + (sq * 16) * (QSTRB / 2) + dd;
#pragma unroll
        for (int si = 0; si < 16; ++si) a += bf2f(kp[si * (QSTRB / 2)]) * wkl[sq * 16 + si];
        npart[sq * 128 + dd] = a; }
      gprev = gamma;
    }
    __syncthreads();
  }
#undef MLS_LOAD
}
__device__ __forceinline__ void qkconv_phase(const bf16_t* __restrict__ Pm, bf16_t* __restrict__ QKC, const float* __restrict__ conv_w, const float* __restrict__ conv_b) {
  const int tid = opaque_tid(), lane = tid & 63, wave = tid >> 6;
  const int gw = blockIdx.x * 8 + wave, ngw = gridDim.x * 8;
  const int half = gw & 1, c0 = half * 512 + lane * 8;
  float cw0[8], cw1[8], cw2[8], cbv[8];
#pragma unroll
  for (int i = 0; i < 8; ++i) { cw0[i] = conv_w[c0 + i]; cw1[i] = conv_w[1024 + c0 + i]; cw2[i] = conv_w[2048 + c0 + i]; cbv[i] = conv_b[c0 + i]; }
  const float osc = half ? 0.08838834764831845f : 1.f;
  for (int it = gw >> 1; it < NTOK / 8; it += ngw >> 1) {
    const int r0 = it * 8; const bool isl = r0 < NLAT; const int seq0 = isl ? (r0 / SEQ) * SEQ : NLAT + ((r0 - NLAT) / CTXL) * CTXL, T = isl ? SEQ : CTXL;
    uint4 x[10];
#pragma unroll
    for (int r = 0; r < 10; ++r) { const int t = r0 - seq0 - 1 + r; x[r] = (t >= 0 && t < T) ? *(const uint4*)(Pm + (size_t)(seq0 + t) * NP + C_QB + c0) : make_uint4(0u, 0u, 0u, 0u); }
#pragma unroll
    for (int r = 0; r < 8; ++r) {
      const unsigned a0[4] = {x[r].x, x[r].y, x[r].z, x[r].w}, a1[4] = {x[r + 1].x, x[r + 1].y, x[r + 1].z, x[r + 1].w}, a2[4] = {x[r + 2].x, x[r + 2].y, x[r + 2].z, x[r + 2].w};
      float o[8];
#pragma unroll
      for (int i = 0; i < 8; ++i) {
        const float v0 = (i & 1) ? __uint_as_float(a0[i >> 1] & 0xffff0000u) : __uint_as_float(a0[i >> 1] << 16);
        const float v1 = (i & 1) ? __uint_as_float(a1[i >> 1] & 0xffff0000u) : __uint_as_float(a1[i >> 1] << 16);
        const float v2 = (i & 1) ? __uint_as_float(a2[i >> 1] & 0xffff0000u) : __uint_as_float(a2[i >> 1] << 16);
        const float z = cbv[i] + cw0[i] * v0 + cw1[i] * v1 + cw2[i] * v2;
        o[i] = osc * z / (1.f + __expf(-z));
      }
      uint4 w; w.x = pk2(o[0], o[1]); w.y = pk2(o[2], o[3]); w.z = pk2(o[4], o[5]); w.w = pk2(o[6], o[7]);
      *(uint4*)(QKC + (size_t)(r0 + r) * DM + 1024 + c0) = w;
    }
  }
}
__device__ __forceinline__ void mlstm_phase(const bf16_t* __restrict__ Pm, const bf16_t* __restrict__ QKC, const float* __restrict__ GATES, bf16_t* __restrict__ HM,
                                            const float* __restrict__ i_bias, const float* __restrict__ f_bias, bool ctx_out, char* lds) {
  const int G = gridDim.x, bx = blockIdx.x;
  if (G == 256) { const int vcu = (bx % 8) * 32 + bx / 8; if ((vcu & 31) < 8) { const int u = (vcu >> 5) * 8 + (vcu & 31); mlstm_unit(Pm, QKC, GATES, HM, i_bias, f_bias, u >> 3, (u >> 1) & 3, u & 1, ctx_out, lds); } }
  else for (int u = bx; u < 64; u += G) mlstm_unit(Pm, QKC, GATES, HM, i_bias, f_bias, u >> 3, (u >> 1) & 3, u & 1, ctx_out, lds);
}
}

DEVI void mod_unit(int unit, const float* __restrict__ c, const float* __restrict__ c_ctx, const float* __restrict__ w_ada, const float* __restrict__ b_ada, float* __restrict__ MOD, float* ldsf) {
    const int tid = opaque_tid(), ci = tid & 63, kgp = tid >> 6;
    const int l = unit / 96, cb = unit % 96;
    float* sc = ldsf; float* red = ldsf + 9 * DM;
    for (int i = tid; i < 9 * DM; i += 512) { const float v = (i < 8 * DM) ? c[i] : c_ctx[i - 8 * DM]; sc[i] = silu_f(v); }
    __syncthreads();
    float acc[9];
#pragma unroll
    for (int r = 0; r < 9; ++r) acc[r] = 0.f;
    const float* w = w_ada + (size_t)l * DM * MODW + cb * 64 + ci;
#pragma unroll 32
    for (int k = kgp * 256; k < kgp * 256 + 256; ++k) {
        const float wv = w[(size_t)k * MODW];
#pragma unroll
        for (int r = 0; r < 9; ++r) acc[r] += sc[r * DM + k] * wv;
    }
#pragma unroll
    for (int r = 0; r < 9; ++r) red[(kgp * 9 + r) * 64 + ci] = acc[r];
    __syncthreads();
    for (int idx = tid; idx < 9 * 64; idx += 512) {
        const int r = idx >> 6, cc = idx & 63; float s = 0.f;
#pragma unroll
        for (int g = 0; g < 8; ++g) s += red[(g * 9 + r) * 64 + cc];
        MOD[(size_t)(l * 9 + r) * MODW + cb * 64 + cc] = s + b_ada[l * MODW + cb * 64 + cc];
    }
    __syncthreads();
}
DEVI void transpose_items(const float* __restrict__ W, int ldw, int K, int N, bf16_t* __restrict__ WT, float* scr, int gw, int ngw, int lane) {
    const int nitems = (K / 64) * (N / 32);
    for (int it = gw; it < nitems; it += ngw) transpose_item(W, ldw, K, N, WT, scr, it, lane);
}
DEVI void finish_row(const bf16_t* __restrict__ P, const bf16_t* __restrict__ HM, const float* __restrict__ mnorm, bf16_t* __restrict__ Y, int row, int lane) {
#pragma unroll
    for (int head = 0; head < 4; ++head) {
        const int col = head * 256 + 4 * lane;
        const uint2 a = *(const uint2*)(HM + (size_t)row * 1024 + col), c = *(const uint2*)(HM + ((size_t)NTOK + row) * 1024 + col);
        float h[4];
        h[0] = __uint_as_float(a.x << 16) + __uint_as_float(c.x << 16); h[1] = __uint_as_float(a.x & 0xffff0000u) + __uint_as_float(c.x & 0xffff0000u);
        h[2] = __uint_as_float(a.y << 16) + __uint_as_float(c.y << 16); h[3] = __uint_as_float(a.y & 0xffff0000u) + __uint_as_float(c.y & 0xffff0000u);
        const float ss = wave_sum(h[0] * h[0] + h[1] * h[1] + h[2] * h[2] + h[3] * h[3]);
        const float r = rsqrtf(ss * (1.f / 256.f) + EPS);
        const uint2 ov = *(const uint2*)(P + (size_t)row * NP + C_OB + col), gv = *(const uint2*)(P + (size_t)row * NP + C_GB + col);
        const float o[4] = {__uint_as_float(ov.x << 16), __uint_as_float(ov.x & 0xffff0000u), __uint_as_float(ov.y << 16), __uint_as_float(ov.y & 0xffff0000u)};
        const float g[4] = {__uint_as_float(gv.x << 16), __uint_as_float(gv.x & 0xffff0000u), __uint_as_float(gv.y << 16), __uint_as_float(gv.y & 0xffff0000u)};
        const float4 w = *(const float4*)(mnorm + col);
        const float wv[4] = {w.x, w.y, w.z, w.w};
        float y[4];
#pragma unroll
        for (int e = 0; e < 4; ++e) y[e] = h[e] * r * wv[e] * sigmoid_f(o[e]) * silu_f(g[e]);
        uint2 out; out.x = pk2(y[0], y[1]); out.y = pk2(y[2], y[3]);
        *(uint2*)(Y + (size_t)row * DM + 1024 + col) = out;
    }
}
DEVI void load_row(const float* __restrict__ xr, float4 (&v)[8], int lane) {
#pragma unroll
    for (int j = 0; j < 8; ++j) v[j] = ((const float4*)xr)[lane + 64 * j];
}
DEVI void post_regs(float4 (&v)[8], const bf16_t* __restrict__ y2row, const float* __restrict__ gate, const float* __restrict__ npost, float* __restrict__ orow, int lane) {
    uint2 yv[8]; float ss = 0.f;
#pragma unroll
    for (int j = 0; j < 8; ++j) {
        yv[j] = *(const uint2*)(y2row + 4 * (lane + 64 * j));
        const float y0 = __uint_as_float(yv[j].x << 16), y1 = __uint_as_float(yv[j].x & 0xffff0000u), y2 = __uint_as_float(yv[j].y << 16), y3 = __uint_as_float(yv[j].y & 0xffff0000u);
        ss += y0 * y0 + y1 * y1 + y2 * y2 + y3 * y3;
    }
    ss = wave_sum(ss);
    const float rstd = rsqrtf(ss * (1.f / DM) + EPS);
#pragma unroll
    for (int j = 0; j < 8; ++j) {
        const int k0 = 4 * (lane + 64 * j);
        const float4 gt = *(const float4*)(gate + k0), w = *(const float4*)(npost + k0);
        const float y0 = __uint_as_float(yv[j].x << 16), y1 = __uint_as_float(yv[j].x & 0xffff0000u), y2 = __uint_as_float(yv[j].y << 16), y3 = __uint_as_float(yv[j].y & 0xffff0000u);
        v[j].x += gt.x * (y0 * rstd * w.x); v[j].y += gt.y * (y1 * rstd * w.y); v[j].z += gt.z * (y2 * rstd * w.z); v[j].w += gt.w * (y3 * rstd * w.w);
        *(float4*)(orow + k0) = v[j];
        asm volatile("" ::: "memory");
    }
}
DEVI void norm_regs(const float4 (&v)[8], const float* __restrict__ shift, const float* __restrict__ scale, const float* __restrict__ npre, bf16_t* __restrict__ hrow, char* trow, int lane) {
    float ss = 0.f;
#pragma unroll
    for (int j = 0; j < 8; ++j) ss += v[j].x * v[j].x + v[j].y * v[j].y + v[j].z * v[j].z + v[j].w * v[j].w;
    ss = wave_sum(ss);
    const float rstd = rsqrtf(ss * (1.f / DM) + EPS);
#pragma unroll
    for (int j = 0; j < 8; ++j) {
        const int k0 = 4 * (lane + 64 * j);
        const float4 w = *(const float4*)(npre + k0), sh = *(const float4*)(shift + k0), sc = *(const float4*)(scale + k0);
        uint2 o;
        o.x = pk2(v[j].x * rstd * w.x * (1.f + sc.x) + sh.x, v[j].y * rstd * w.y * (1.f + sc.y) + sh.y);
        o.y = pk2(v[j].z * rstd * w.z * (1.f + sc.z) + sh.z, v[j].w * rstd * w.w * (1.f + sc.w) + sh.w);
        *(uint2*)(hrow + k0) = o; *(uint2*)(trow + k0 * 2) = o;
        asm volatile("" ::: "memory");
    }
}
constexpr int NT_ROWB = (DM + 8) * 2;
template <bool POST>
DEVI void norm_phase(const float* __restrict__ xlat, const float* __restrict__ xctx, const bf16_t* __restrict__ Y2, const float* __restrict__ mod_post, const float* __restrict__ npost,
                     float* olat, float* octx, const float* __restrict__ mod_n, const float* __restrict__ npre, const float* __restrict__ wg, bf16_t* __restrict__ H,
                     float* __restrict__ GATES, char* lds) {
    typedef short bf16x8 __attribute__((ext_vector_type(8))); typedef float f32x4 __attribute__((ext_vector_type(4)));
    const int tid = opaque_tid(), lane = tid & 63, wave = tid >> 6, lr = lane & 15, kgp = lane >> 4;
    char* tile = lds; float* red = (float*)(lds + 8 * NT_ROWB);
    bf16x8 bfrag[8];
    {
        const float* wp = wg + (size_t)(wave * 256 + 8 * kgp) * INC + lr;
#pragma unroll
        for (int ks = 0; ks < 8; ++ks) {
            unsigned w4[4];
#pragma unroll
            for (int q = 0; q < 4; ++q) { w4[q] = pk2(wp[0], wp[INC]); wp += 2 * INC; asm volatile("" : "+v"(wp)); }
            wp += (size_t)24 * INC; asm volatile("" : "+v"(wp));
            bfrag[ks] = __builtin_bit_cast(bf16x8, make_uint4(w4[0], w4[1], w4[2], w4[3]));
        }
    }
    for (int grp = blockIdx.x; grp < NTOK / 8; grp += gridDim.x) {
        const int row = grp * 8 + wave; const bool isl = row < NLAT; const int b = isl ? row / SEQ : 8;
        {
            float4 v[8];
            load_row(isl ? xlat + (size_t)row * DM : xctx + (size_t)(row - NLAT) * DM, v, lane);
            if (POST) post_regs(v, Y2 + (size_t)row * DM, mod_post + (size_t)b * MODW + 2 * DM, npost, isl ? olat + (size_t)row * DM : octx + (size_t)(row - NLAT) * DM, lane);
            norm_regs(v, mod_n + (size_t)b * MODW, mod_n + (size_t)b * MODW + DM, npre, H + (size_t)row * DM, tile + wave * NT_ROWB, lane);
        }
        __syncthreads();
        f32x4 acc = {0.f, 0.f, 0.f, 0.f};
#pragma unroll
        for (int ks = 0; ks < 8; ++ks) {
            bf16x8 af = {0, 0, 0, 0, 0, 0, 0, 0};
            if (lr < 8) af = *(const bf16x8*)(tile + lr * NT_ROWB + (wave * 256 + ks * 32 + 8 * kgp) * 2);
            acc = __builtin_amdgcn_mfma_f32_16x16x32_bf16(af, bfrag[ks], acc, 0, 0, 0);
        }
        if (kgp < 2) {
#pragma unroll
            for (int r = 0; r < 4; ++r) red[(wave * 8 + 4 * kgp + r) * 16 + lr] = acc[r];
        }
        __syncthreads();
        if (tid < 128) { const int rr = tid >> 4, cc = tid & 15; float sum = 0.f;
#pragma unroll
            for (int w8 = 0; w8 < 8; ++w8) sum += red[(w8 * 8 + rr) * 16 + cc];
            GATES[(size_t)(grp * 8 + rr) * 16 + cc] = sum; }
    }
    __syncthreads();
}

#define XB_TMO      128
#define XB_XCNT(j)  (256  + 64 * (j))
#define XB_XSUB(j)  (1280 + 64 * (j))
#define XB_XGEN(j)  (2304 + 64 * (j))
#define XB_TOP      3328
#define XB_TOPGEN   3392
#define XCD_BAR_WORDS 3456
#define XB_SPIN_CAP (1u << 18)

__device__ __forceinline__ unsigned xb_ld(unsigned* p)              { return __hip_atomic_load(p, __ATOMIC_RELAXED, __HIP_MEMORY_SCOPE_AGENT); }
__device__ __forceinline__ unsigned xb_add(unsigned* p, unsigned v) { return __hip_atomic_fetch_add(p, v, __ATOMIC_RELAXED, __HIP_MEMORY_SCOPE_AGENT); }
__device__ __forceinline__ unsigned xb_xcc_id() { return (unsigned)__builtin_amdgcn_s_getreg((3 << 11) | 20) & 0xFu; }
#define XB_SPIN(cond, bar) do { unsigned _sp = 0; while (cond) { __builtin_amdgcn_s_sleep(1); \
    if ((++_sp & 255u) == 0u) { if (xb_ld(&(bar)[XB_TMO])) break; if (_sp > XB_SPIN_CAP) { atomicAdd(&(bar)[XB_TMO], 1u); break; } } } } while (0)

struct XcdBarrier {
    unsigned* bar; unsigned x;
    volatile __attribute__((address_space(3))) unsigned* st;
};

__device__ __forceinline__ XcdBarrier xcd_barrier_post(unsigned* bar, volatile __attribute__((address_space(3))) unsigned* st) {
    XcdBarrier b; b.bar = bar; b.x = xb_xcc_id(); b.st = st;
    if (threadIdx.x == 0) (void)xb_add(&bar[XB_XCNT(b.x)], 1u);
    return b;
}
__device__ __forceinline__ void xcd_barrier_complete(unsigned* bar, unsigned x, unsigned& nloc, unsigned& nx) {
    const unsigned G = gridDim.x * gridDim.y * gridDim.z;
    unsigned sum, cnt, mine, sp = 0u;
    for (;;) {
        sum = 0u; cnt = 0u; mine = 0u;
#pragma unroll
        for (unsigned j = 0; j < 16; ++j) { const unsigned c = xb_ld(&bar[XB_XCNT(j)]); sum += c; cnt += (c > 0u) ? 1u : 0u; mine = (j == x) ? c : mine; }
        if (sum == G) break;
        __builtin_amdgcn_s_sleep(1);
        if ((++sp & 255u) == 0u) { if (xb_ld(&bar[XB_TMO])) break; if (sp > XB_SPIN_CAP) { atomicAdd(&bar[XB_TMO], 1u); break; } }
    }
    nloc = mine > 0u ? mine : 1u; nx = cnt > 0u ? cnt : 1u;
}

__device__ __forceinline__ void xcd_barrier(const XcdBarrier& b) {
    asm volatile("s_waitcnt vmcnt(0)" ::: "memory");
    __syncthreads();
    if (threadIdx.x == 0) {
        unsigned* bar = b.bar;
        __builtin_amdgcn_s_waitcnt(0);
        unsigned nloc = b.st[0], nx = b.st[1];
        if (nloc == 0u) { xcd_barrier_complete(bar, b.x, nloc, nx); b.st[0] = nloc; b.st[1] = nx; }
        const unsigned old = xb_add(&bar[XB_XSUB(b.x)], 1u);
        const unsigned gen = old / nloc;
        if (old + 1u == (gen + 1u) * nloc) {
            __builtin_amdgcn_fence(__ATOMIC_RELEASE, "agent");
            asm volatile("s_waitcnt vmcnt(0)" ::: "memory");
            const unsigned og = xb_add(&bar[XB_TOP], 1u);
            const unsigned tg = og / nx;
            if (og + 1u == (tg + 1u) * nx) xb_add(&bar[XB_TOPGEN], 1u);
            else XB_SPIN(xb_ld(&bar[XB_TOPGEN]) == tg, bar);
            __builtin_amdgcn_fence(__ATOMIC_ACQUIRE, "agent");
            xb_add(&bar[XB_XGEN(b.x)], 1u);
            asm volatile("s_waitcnt vmcnt(0)" ::: "memory");
        } else {
            XB_SPIN(xb_ld(&bar[XB_XGEN(b.x)]) == gen, bar);
            __builtin_amdgcn_fence(__ATOMIC_ACQUIRE, "agent");
            asm volatile("s_waitcnt vmcnt(0)" ::: "memory");
        }
    }
    __syncthreads();
}

namespace cg = cooperative_groups;
#ifndef PROBE_DUP
#define PROBE_DUP 0
#endif
#define DUPN(k) ((PROBE_DUP == (k)) ? 2 : 1)
constexpr int MEGA_LDS = LDS_PHASE_BYTES + 256;
struct MegaArgs { const float* in[20]; float* out; unsigned char* ws; };
DEVI const float* karg_in(int i) { const char* kp = (const char*)__builtin_amdgcn_kernarg_segment_ptr(); asm volatile("" : "+s"(kp)); return *(const float* const*)(kp + 8 * i); }
DEVI unsigned char* karg_ws() { const char* kp = (const char*)__builtin_amdgcn_kernarg_segment_ptr(); asm volatile("" : "+s"(kp)); return *(unsigned char* const*)(kp + 168); }
DEVI float* karg_out() { const char* kp = (const char*)__builtin_amdgcn_kernarg_segment_ptr(); asm volatile("" : "+s"(kp)); return *(float* const*)(kp + 160); }
__global__ __launch_bounds__(512, 2) void mega_fwd(MegaArgs a) {
    extern __shared__ __attribute__((aligned(16))) unsigned char lds[];
    cg::grid_group grid = cg::this_grid();
    volatile __attribute__((address_space(3))) unsigned* MISC = (volatile __attribute__((address_space(3))) unsigned*)((__attribute__((address_space(3))) unsigned char*)lds + LDS_PHASE_BYTES);
    if (threadIdx.x < 64) MISC[threadIdx.x] = 0u;
    __syncthreads();
    (void)xcd_barrier_post((unsigned*)(a.ws + WS_CTL) + 4096, MISC + 8);
#define GRID_BAR() do { XcdBarrier b_; b_.bar = (unsigned*)(a.ws + WS_CTL) + 4096; b_.x = xb_xcc_id(); b_.st = (volatile __attribute__((address_space(3))) unsigned*)((__attribute__((address_space(3))) unsigned char*)lds + LDS_PHASE_BYTES) + 8; xcd_barrier(b_); } while (0)
    const int G = gridDim.x;
#define PHASE_IDS const int tid = opaque_tid(), lane = tid & 63, wave = tid >> 6, gw = blockIdx.x * 8 + wave, ngw = G * 8; (void)tid; (void)lane; (void)gw; (void)ngw; float* scr = (float*)lds + wave * (64 * 33); (void)scr
    const float* x = a.in[0]; const float* c = a.in[1]; const float* ctx = a.in[2]; const float* c_ctx = a.in[3];
    const float* w_ada = a.in[4]; const float* b_ada = a.in[5]; const float* norm_pre = a.in[6]; const float* norm_post = a.in[7];
    const float* w_in = a.in[8]; const float* w_out = a.in[9];
    float* out = a.out; unsigned char* ws = a.ws;
    float* MOD = (float*)(ws + WS_MOD); float* ROPE = (float*)(ws + WS_ROPE); float* GATES = (float*)(ws + WS_GATES);
    bf16_t* WOUT = (bf16_t*)(ws + WS_WOUT); bf16_t* WIN = (bf16_t*)(ws + WS_WIN); float* XC = (float*)(ws + WS_XC);
    bf16_t* H = (bf16_t*)(ws + WS_H); bf16_t* HM = (bf16_t*)(ws + WS_HM); bf16_t* P = (bf16_t*)(ws + WS_P);
    bf16_t* Y = H; bf16_t* Y2 = HM;

    { PHASE_IDS;
    for (int u = blockIdx.x; u < 192; u += G) mod_unit(u, c, c_ctx, w_ada, b_ada, MOD, (float*)lds);
    for (int i = blockIdx.x * 512 + tid; i < 1024; i += G * 512) { const int pos = i >> 4, f = i & 15; const float inv = powf(10000.f, -(float)f / 16.f); const float ang = (float)pos * inv;
        ROPE[2 * i] = cosf(ang); ROPE[2 * i + 1] = sinf(ang); }
    {
        const bool light = (G == 256) && ((int)blockIdx.x < 192);
        const int nv = (G == 256) ? (light ? 5 : 9) : 1, v0 = (G == 256) ? (light ? gw * 5 : 192 * 8 * 5 + (gw - 192 * 8) * 9) : gw, nvw = (G == 256) ? 12288 : ngw;
        for (int q = 0; q < nv; ++q) {
            const int vw_ = v0 + q;
            for (int it = vw_; it < 12288; it += nvw) {
                if (it < 8192) transpose_item(w_in, INC, DM, NP, WIN, scr, it, lane);
                else if (it < 10240) transpose_item(w_out, DM, DM, DM, WOUT, scr, it - 8192, lane);
                else transpose_item(w_out + (size_t)DM * DM, DM, DM, DM, WOUT + (size_t)DM * DM, scr, it - 10240, lane);
            }
        }
    } }
    grid.sync();
    norm_phase<false>(x, ctx, nullptr, nullptr, nullptr, nullptr, nullptr, MOD, norm_pre, w_in + NP, H, GATES, (char*)lds);
    GRID_BAR();
    for (int l = 0; l < 2; ++l) {
        const float lam_init = l == 0 ? 0.2f : 0.35550906759f;
        const float* mod_l = MOD + (size_t)l * 9 * MODW;
        for (int rep_ = 0; rep_ < DUPN(2); ++rep_)
        { pg8::Gemm g{H, WIN, NTOK, NP, DM}; pg8::StaticOrder S; S.init(NTOK, NP, G, (int)blockIdx.x); pg8::EpiInProj E{P, NP, ROPE};
          pg8::gemm_phase<pg8::EpiInProj, pg8::StaticOrder, true, true>((PG8_LAS unsigned char*)lds, g, S, E); }
        GRID_BAR();
        mls::qkconv_phase(P, Y, a.in[15] + (size_t)l * 3 * 1024, a.in[16] + l * 1024);
        GRID_BAR();
        mls::mlstm_phase(P, Y, GATES, HM, a.in[17] + l * 8, a.in[18] + l * 8, l == 0, (char*)lds);
        att::attn_phase(P, Y, a.in[10] + l * 64, a.in[11] + l * 64, a.in[12] + l * 64, a.in[13] + l * 64, a.in[14] + l * 128, lam_init, l == 0,
                        (unsigned*)(a.ws + WS_CTL) + 8192 + l * 512, (volatile __attribute__((address_space(3))) unsigned*)((__attribute__((address_space(3))) unsigned char*)lds + LDS_PHASE_BYTES) + 16, (char*)lds);
        GRID_BAR();
        { PHASE_IDS; const int nrows = l == 0 ? NTOK : NLAT; for (int row = gw; row < nrows; row += ngw) finish_row(P, HM, a.in[19] + l * 1024, Y, row, lane); }
        GRID_BAR();
        for (int rep_ = 0; rep_ < DUPN(5); ++rep_)
        { const int M = l == 0 ? NTOK : NLAT; pg8::Gemm g{Y, WOUT + (size_t)l * DM * DM, M, DM, DM}; pg8::StaticOrder S; S.init(M, DM, G, (int)blockIdx.x); pg8::EpiBf16 E{Y2, DM};
          pg8::gemm_phase<pg8::EpiBf16, pg8::StaticOrder, true, true>((PG8_LAS unsigned char*)lds, g, S, E); }
        if (l == 0) { PHASE_IDS;
            const int nbusy = (NTOK / 256) * (DM / 256) - 2 * G;
            if (nbusy >= 0 && nbusy < G) { if ((int)blockIdx.x >= nbusy) transpose_items(w_in + (size_t)DM * INC, INC, DM, NP, WIN, scr, ((int)blockIdx.x - nbusy) * 8 + wave, (G - nbusy) * 8, lane); }
            else transpose_items(w_in + (size_t)DM * INC, INC, DM, NP, WIN, scr, gw, ngw, lane);
        }
        GRID_BAR();
        if (l == 0) {
            norm_phase<true>(x, ctx, Y2, mod_l, norm_post, out, XC, MOD + (size_t)9 * MODW, norm_pre + DM, w_in + (size_t)DM * INC + NP, H, GATES, (char*)lds);
            GRID_BAR();
        } else { PHASE_IDS;
            for (int row = gw; row < NLAT; row += ngw) {
                float4 v[8];
                load_row(out + (size_t)row * DM, v, lane);
                post_regs(v, Y2 + (size_t)row * DM, mod_l + (size_t)(row / SEQ) * MODW + 2 * DM, norm_post + DM, out + (size_t)row * DM, lane);
            }
        }
    }
}

extern "C" void kernel_launch(void* const* d_in, const int* in_sizes, int n_in, void* d_out, int out_size, void* d_ws, size_t ws_size, hipStream_t stream) {
    (void)in_sizes; (void)n_in; (void)out_size; (void)ws_size;
    static int grid_blocks = 0;
    if (!grid_blocks) {
        int dev = 0, cus = 0, per_cu = 0;
        (void)hipGetDevice(&dev);
        (void)hipDeviceGetAttribute(&cus, hipDeviceAttributeMultiprocessorCount, dev);
        (void)hipFuncSetAttribute((const void*)mega_fwd, hipFuncAttributeMaxDynamicSharedMemorySize, MEGA_LDS);
        (void)hipOccupancyMaxActiveBlocksPerMultiprocessor(&per_cu, (const void*)mega_fwd, 512, MEGA_LDS);
        if (per_cu < 1) per_cu = 1;
        if (per_cu > 1) per_cu = 1;
        grid_blocks = cus * per_cu;
    }
    (void)hipMemsetAsync((char*)d_ws + WS_CTL, 0, 65536, stream);
    MegaArgs a{};
    for (int i = 0; i < 20; ++i) a.in[i] = (const float*)d_in[i];
    a.out = (float*)d_out; a.ws = (unsigned char*)d_ws;
    void* args[] = {&a};
    (void)hipLaunchCooperativeKernel((const void*)mega_fwd, dim3(grid_blocks), dim3(512), args, (size_t)MEGA_LDS, stream);
}
```

```cpp
#include <hip/hip_runtime.h>
#include <hip/hip_cooperative_groups.h>
#include <stdint.h>
#include <math.h>

#define DEVI __device__ __forceinline__
typedef unsigned short bf16_t;

constexpr int DM = 2048, NBATCH = 8, SEQ = 2048, CTXL = 256;
constexpr int NLAT = NBATCH * SEQ, NCTX = NBATCH * CTXL, NTOK = NLAT + NCTX;
constexpr int INC = 8208, NP = 8192, MODW = 6144;
constexpr int C_QA = 0, C_KA = 1024, C_VA = 2048, C_GA = 3072, C_QB = 4096, C_KB = 4608, C_VB = 5120, C_OB = 6144, C_GB = 7168;
constexpr float EPS = 1e-6f;
constexpr int LDS_PHASE_BYTES = 155648;

constexpr size_t MiB = (size_t)1 << 20;
constexpr size_t WS_CTL = 0, WS_MOD = 1 * MiB, WS_SC = WS_MOD + 512 * 1024, WS_ROPE = 2 * MiB, WS_GATES = 3 * MiB, WS_WOUT = 8 * MiB,
                 WS_WIN = 24 * MiB, WS_XC = 56 * MiB, WS_H = 72 * MiB, WS_HM = 144 * MiB, WS_P = 216 * MiB, WS_END = 504 * MiB;

DEVI int opaque_tid() { int t = threadIdx.x; asm volatile("" : "+v"(t)); return t; }
DEVI float bf2f(bf16_t v) { return __uint_as_float(((unsigned)v) << 16); }
DEVI bf16_t f2bf(float f) { unsigned u = __float_as_uint(f); return (bf16_t)((u + 0x7fffu + ((u >> 16) & 1u)) >> 16); }
DEVI unsigned pk2(float lo, float hi) { return (unsigned)f2bf(lo) | ((unsigned)f2bf(hi) << 16); }
DEVI float row16_sum(float v) {
    v += __builtin_bit_cast(float, __builtin_amdgcn_update_dpp(0, __builtin_bit_cast(int, v), 0xB1, 0xF, 0xF, false));
    v += __builtin_bit_cast(float, __builtin_amdgcn_update_dpp(0, __builtin_bit_cast(int, v), 0x4E, 0xF, 0xF, false));
    v += __builtin_bit_cast(float, __builtin_amdgcn_update_dpp(0, __builtin_bit_cast(int, v), 0x141, 0xF, 0xF, false));
    v += __builtin_bit_cast(float, __builtin_amdgcn_update_dpp(0, __builtin_bit_cast(int, v), 0x140, 0xF, 0xF, false));
    return v;
}
DEVI float rl_f(float v, int l) { return __builtin_bit_cast(float, __builtin_amdgcn_readlane(__builtin_bit_cast(int, v), l)); }
DEVI float wave_sum(float v) { v = row16_sum(v); return (rl_f(v, 0) + rl_f(v, 16)) + (rl_f(v, 32) + rl_f(v, 48)); }
DEVI float half_sum(float v, int hi) { v = row16_sum(v); const float a = rl_f(v, 0) + rl_f(v, 16), b = rl_f(v, 32) + rl_f(v, 48); return hi ? b : a; }
DEVI float silu_f(float x) { return x / (1.f + expf(-x)); }
DEVI float sigmoid_f(float x) { return 1.f / (1.f + expf(-x)); }


DEVI void transpose_item(const float* __restrict__ W, int ldw, int K, int N, bf16_t* __restrict__ WT, float* scr, int item, int lane) {
    const int nblk = N / 32, kb = item / nblk, nb = item % nblk, k0 = 64 * kb, n0 = 32 * nb;
    float tv[32];
#pragma unroll
    for (int i = 0; i < 32; ++i) tv[i] = W[(size_t)(k0 + 2 * i + (lane >> 5)) * ldw + n0 + (lane & 31)];
#pragma unroll
    for (int i = 0; i < 32; ++i) scr[(2 * i + (lane >> 5)) * 33 + (lane & 31)] = tv[i];
    asm volatile("s_waitcnt lgkmcnt(0)" ::: "memory");
    const int c = lane & 7;
#pragma unroll
    for (int j = 0; j < 4; ++j) {
        const int n = (lane >> 3) + 8 * j; const float* s = scr + (8 * c) * 33 + n;
        uint4 o; o.x = pk2(s[0 * 33], s[1 * 33]); o.y = pk2(s[2 * 33], s[3 * 33]); o.z = pk2(s[4 * 33], s[5 * 33]); o.w = pk2(s[6 * 33], s[7 * 33]);
        *(uint4*)(WT + (size_t)(n0 + n) * K + k0 + 8 * c) = o;
    }
    asm volatile("s_waitcnt lgkmcnt(0)" ::: "memory");
}

namespace pg8 {
#define PG8_LAS __attribute__((address_space(3)))
typedef unsigned short bf16_t;
typedef short bf16x8 __attribute__((ext_vector_type(8)));
typedef float f32x4 __attribute__((ext_vector_type(4)));
typedef unsigned u32x4 __attribute__((ext_vector_type(4)));
constexpr int BM = 256, BK = 64, HALF = 128, HTB = HALF * BK * 2  , STAGE_BYTES = 8 * HTB, NXCD = 8, WGM = 8;

__host__ __device__ __forceinline__ int lds_byte(int r, int c) { const int st = (r >> 4) * 2 + (c >> 5), rr = r & 15, cc = c & 31, ob = rr * 64 + cc * 2; return st * 1024 + (ob ^ (((ob >> 9) & 1) << 5)); }
__host__ __device__ __forceinline__ void stage_rc(int b, int& R, int& C) { const int st = b / 1024, sb = b % 1024, swz = sb ^ (((sb >> 9) & 1) << 5); R = (st >> 1) * 16 + swz / 64; C = (st & 1) * 32 + (swz % 64) / 2; }
__host__ __device__ __forceinline__ int perm32(int rho) { const int n = rho >> 4, i = rho & 15; return 8 * (i >> 2) + 4 * n + (i & 3); }

struct Unit { int pm, pn; };
struct Gemm { const bf16_t* A; const bf16_t* Bt; int M, N, K; };

struct StaticOrder {
    int nM, nN, nwg, G, c;
    __host__ __device__ void init(int M, int N, int G_, int c_) { nM = M / BM; nN = N / BM; nwg = nM * nN; G = G_; c = c_; }
    __host__ __device__ bool next(int i, Unit& u) const {
        const long L = (long)i * G + c; if (L >= nwg) return false;
        int wgid = (int)L; { const int q = nwg / NXCD, r = nwg % NXCD, xcd = wgid % NXCD, off = wgid / NXCD; wgid = (xcd < r ? xcd * (q + 1) : r * (q + 1) + (xcd - r) * q) + off; }
        const int nig = WGM * nN, gid = wgid / nig, fm = gid * WGM, gsz = (nM - fm) < WGM ? (nM - fm) : WGM;
        u.pm = fm + ((wgid % nig) % gsz); u.pn = (wgid % nig) / gsz; return true;
    }
    __device__ __forceinline__ void a_ready(const Unit&) const {}
    __device__ __forceinline__ void done(const Unit&) const {}
};

__device__ __forceinline__ unsigned cvt_pk_bf16(float lo, float hi) { unsigned r; asm volatile("v_cvt_pk_bf16_f32 %0, %1, %2" : "=v"(r) : "v"(lo), "v"(hi)); return r; }

struct EpiBf16 {
    static constexpr bool PERM = true, AFTER_DRAIN = false;
    bf16_t* O; int ldc;
    __device__ __forceinline__ void operator()(const f32x4 (&acc)[2][2][4][2], const Unit& u, int wr, int wc, int fr, int fq) const {
        const int row0 = u.pm * BM + wr * 64 + fr, col0 = u.pn * BM + wc * 32 + 8 * fq;
#pragma unroll
        for (int ai = 0; ai < 2; ++ai)
#pragma unroll
            for (int m = 0; m < 4; ++m) { bf16_t* rowp = O + (size_t)(row0 + ai * HALF + m * 16) * ldc + col0;
#pragma unroll
                for (int bj = 0; bj < 2; ++bj) { const f32x4 v0 = acc[ai][bj][m][0], v1 = acc[ai][bj][m][1];
                    u32x4 w; w.x = cvt_pk_bf16(v0[0], v0[1]); w.y = cvt_pk_bf16(v0[2], v0[3]); w.z = cvt_pk_bf16(v1[0], v1[1]); w.w = cvt_pk_bf16(v1[2], v1[3]);
                    *(u32x4*)(rowp + bj * HALF) = w; } }
    }
};
struct EpiInProj {
    static constexpr bool PERM = true, AFTER_DRAIN = false;
    bf16_t* O; int ldc; const float* rope;
    __device__ __forceinline__ void operator()(const f32x4 (&acc)[2][2][4][2], const Unit& u, int wr, int wc, int fr, int fq) const {
        const int row0 = u.pm * BM + wr * 64 + fr, col0 = u.pn * BM + wc * 32 + 8 * fq;
        const bool do_rope = (u.pn < 8) && (u.pm < 64);
        const float qsc = (u.pn < 4) ? 0.18033688011112042f : 1.f;
#pragma unroll
        for (int ai = 0; ai < 2; ++ai)
#pragma unroll
            for (int m = 0; m < 4; ++m) { const int row = row0 + ai * HALF + m * 16; bf16_t* rowp = O + (size_t)row * ldc + col0;
                f32x4 cs01 = {1.f, 0.f, 1.f, 0.f}, cs23 = {1.f, 0.f, 1.f, 0.f};
                if (do_rope) { const int pos = (wc & 1) ? (row & 63) : ((row >> 6) & 31); const f32x4* rp = (const f32x4*)(rope + (size_t)(pos * 16 + 4 * fq) * 2); cs01 = rp[0]; cs23 = rp[1]; }
#pragma unroll
                for (int bj = 0; bj < 2; ++bj) { f32x4 v0 = acc[ai][bj][m][0], v1 = acc[ai][bj][m][1];
                    if (do_rope) {
                        const float a0 = v0[0] * cs01[0] - v0[1] * cs01[1], a1 = v0[0] * cs01[1] + v0[1] * cs01[0];
                        const float a2 = v0[2] * cs01[2] - v0[3] * cs01[3], a3 = v0[2] * cs01[3] + v0[3] * cs01[2];
                        const float b0 = v1[0] * cs23[0] - v1[1] * cs23[1], b1 = v1[0] * cs23[1] + v1[1] * cs23[0];
                        const float b2 = v1[2] * cs23[2] - v1[3] * cs23[3], b3 = v1[2] * cs23[3] + v1[3] * cs23[2];
                        v0 = (f32x4){a0, a1, a2, a3}; v1 = (f32x4){b0, b1, b2, b3};
                    }
                    v0 = v0 * qsc; v1 = v1 * qsc;
                    u32x4 w; w.x = cvt_pk_bf16(v0[0], v0[1]); w.y = cvt_pk_bf16(v0[2], v0[3]); w.z = cvt_pk_bf16(v1[0], v1[1]); w.w = cvt_pk_bf16(v1[2], v1[3]);
                    *(u32x4*)(rowp + bj * HALF) = w; } }
    }
};

template <class Epi, class Sched, bool ALIGN_EPI = false, bool SP2 = false>
__device__ __forceinline__ void gemm_phase(PG8_LAS unsigned char* lds, const Gemm g, const Sched& S, const Epi& E) {
    const int tid = opaque_tid(), wid = __builtin_amdgcn_readfirstlane(tid >> 6), lane = tid & 63, wr = wid >> 2, wc = wid & 3, fr = lane & 15, fq = lane >> 4;
    const int K = g.K, nt = K / BK;
    unsigned voffA[2], voffB[2];
#pragma unroll
    for (int i = 0; i < 2; ++i) { int R, C; stage_rc(tid * 16 + i * 8192, R, C); const int Rb = Epi::PERM ? ((R & ~31) + perm32(R & 31)) : R;
        voffA[i] = (unsigned)(R * K + C) * 2u; voffB[i] = (unsigned)(Rb * K + C) * 2u; }
    const size_t kstep = (size_t)(BK * 2);
    const size_t hstep = (size_t)HALF * K * 2;
    const size_t tstep = 2 * hstep;
    const unsigned ldsw = (unsigned)wid * 1024u;
    const int aoff = lds_byte(wr * 64 + fr, fq * 8), boff = lds_byte(wc * 32 + fr, fq * 8);
#define PG8_SA(b, h) (((b) * 2 + (h)) * HTB)
#define PG8_SB(b, h) ((4 + (b) * 2 + (h)) * HTB)
#define PG8_STAGE(bufoff, gbase, voff) do { _Pragma("unroll") for (int _i = 0; _i < 2; ++_i) \
        __builtin_amdgcn_global_load_lds((const unsigned*)((const char*)(gbase) + (voff)[_i]), (PG8_LAS unsigned*)(lds + (bufoff) + ldsw + _i * 8192), 16, 0, 0); } while (0)
#define PG8_LDA(dst, b, h) do { _Pragma("unroll") for (int m = 0; m < 4; ++m) _Pragma("unroll") for (int k = 0; k < 2; ++k) dst[m][k] = *(const PG8_LAS bf16x8*)(lds + PG8_SA(b, h) + aoff + m * 2048 + k * 1024); } while (0)
#define PG8_LDB(dst, b, h) do { _Pragma("unroll") for (int n = 0; n < 2; ++n) _Pragma("unroll") for (int k = 0; k < 2; ++k) dst[n][k] = *(const PG8_LAS bf16x8*)(lds + PG8_SB(b, h) + boff + n * 2048 + k * 1024); } while (0)
#define PG8_MMA(ai, bj, At, Bt) do { __builtin_amdgcn_s_setprio(1); _Pragma("unroll") for (int m = 0; m < 4; ++m) _Pragma("unroll") for (int n = 0; n < 2; ++n) _Pragma("unroll") for (int k = 0; k < 2; ++k) \
        acc[ai][bj][m][n] = __builtin_amdgcn_mfma_f32_16x16x32_bf16(Bt[n][k], At[m][k], acc[ai][bj][m][n], 0, 0, 0); __builtin_amdgcn_s_setprio(0); } while (0)
#define PG8_WAIT_V(n) asm volatile("s_waitcnt vmcnt(" #n ")" ::: "memory")
#define PG8_WAIT_L(n) asm volatile("s_waitcnt lgkmcnt(" #n ")" ::: "memory")
#define PG8_BAR __builtin_amdgcn_s_barrier()
#define PG8_SCHED __builtin_amdgcn_sched_barrier(0)
    Unit cur, nxt; int ui = 0;
    if (!S.next(0, cur)) return;
    f32x4 acc[2][2][4][2];
#pragma unroll
    for (int a = 0; a < 2; ++a)
#pragma unroll
        for (int b = 0; b < 2; ++b)
#pragma unroll
            for (int m = 0; m < 4; ++m)
#pragma unroll
                for (int n = 0; n < 2; ++n) acc[a][b][m][n] = (f32x4){0.f, 0.f, 0.f, 0.f};
    bf16x8 At[4][2], B0[2][2], B1[2][2];
    const char* cA = (const char*)g.A + (size_t)cur.pm * tstep; const char* cB = (const char*)g.Bt + (size_t)cur.pn * tstep;
    S.a_ready(cur);
    if constexpr (SP2) {
        PG8_STAGE(PG8_SB(0, 0), cB, voffB); PG8_STAGE(PG8_SB(0, 1), cB + hstep, voffB); PG8_STAGE(PG8_SA(0, 0), cA, voffA); PG8_STAGE(PG8_SA(0, 1), cA + hstep, voffA);
        if (wr == 1) PG8_BAR;
        PG8_WAIT_V(2); PG8_BAR;
        PG8_STAGE(PG8_SB(1, 0), cB + kstep, voffB); PG8_STAGE(PG8_SA(1, 0), cA + kstep, voffA); PG8_STAGE(PG8_SB(1, 1), cB + hstep + kstep, voffB);
        PG8_WAIT_V(6); PG8_BAR;
    } else {
        PG8_STAGE(PG8_SB(0, 0), cB, voffB); PG8_STAGE(PG8_SA(0, 0), cA, voffA); PG8_STAGE(PG8_SB(0, 1), cB + hstep, voffB); PG8_STAGE(PG8_SA(0, 1), cA + hstep, voffA);
        if (wr == 1) PG8_BAR;
        PG8_WAIT_V(4); PG8_BAR;
        PG8_STAGE(PG8_SB(1, 0), cB + kstep, voffB); PG8_STAGE(PG8_SA(1, 0), cA + kstep, voffA); PG8_STAGE(PG8_SB(1, 1), cB + hstep + kstep, voffB);
        PG8_WAIT_V(6); PG8_BAR;
    }
    for (;;) {
        const bool has_next = S.next(ui + 1, nxt);
        const char* nA = has_next ? (const char*)g.A + (size_t)nxt.pm * tstep : cA; const char* nB = has_next ? (const char*)g.Bt + (size_t)nxt.pn * tstep : cB;
        for (int t = 0; t < nt; t += 2) {
            const bool last = (t == nt - 2);
            const char* a1 = cA + (size_t)(t + 1) * kstep;
            const char* a2 = last ? nA : cA + (size_t)(t + 2) * kstep; const char* b2 = last ? nB : cB + (size_t)(t + 2) * kstep;
            const char* a3 = a2 + kstep; const char* b3 = b2 + kstep;
            if (last && has_next) S.a_ready(nxt);
            if constexpr (SP2) {
            PG8_LDB(B0, 0, 0); PG8_LDB(B1, 0, 1); PG8_SCHED; PG8_LDA(At, 0, 0); PG8_STAGE(PG8_SA(1, 1), a1 + hstep, voffA);
            PG8_WAIT_V(8); PG8_WAIT_L(0); PG8_BAR; PG8_MMA(0, 0, At, B0); PG8_MMA(0, 1, At, B1); PG8_BAR; PG8_SCHED;
            PG8_LDA(At, 0, 1); PG8_STAGE(PG8_SB(0, 0), b2, voffB); PG8_STAGE(PG8_SB(0, 1), b2 + hstep, voffB); PG8_STAGE(PG8_SA(0, 0), a2, voffA);
            PG8_WAIT_V(8); PG8_WAIT_L(0); PG8_BAR; PG8_MMA(1, 0, At, B0); PG8_MMA(1, 1, At, B1); PG8_BAR; PG8_SCHED;
            PG8_LDB(B0, 1, 0); PG8_LDB(B1, 1, 1); PG8_SCHED; PG8_LDA(At, 1, 0); PG8_STAGE(PG8_SA(0, 1), a2 + hstep, voffA);
            PG8_WAIT_V(8); PG8_WAIT_L(0); PG8_BAR; PG8_MMA(0, 0, At, B0); PG8_MMA(0, 1, At, B1); PG8_BAR; PG8_SCHED;
            PG8_LDA(At, 1, 1); PG8_STAGE(PG8_SB(1, 0), b3, voffB); PG8_STAGE(PG8_SB(1, 1), b3 + hstep, voffB); PG8_STAGE(PG8_SA(1, 0), a3, voffA);
            PG8_WAIT_V(8); PG8_WAIT_L(0); PG8_BAR; PG8_MMA(1, 0, At, B0); PG8_MMA(1, 1, At, B1); PG8_BAR; PG8_SCHED;
            } else {
            PG8_LDB(B0, 0, 0); PG8_SCHED; PG8_LDA(At, 0, 0); PG8_STAGE(PG8_SA(1, 1), a1 + hstep, voffA);
            PG8_WAIT_L(8); PG8_BAR; PG8_WAIT_L(0); PG8_MMA(0, 0, At, B0); PG8_BAR; PG8_SCHED;
            PG8_LDB(B1, 0, 1); PG8_STAGE(PG8_SB(0, 0), b2, voffB);
            PG8_BAR; PG8_WAIT_L(0); PG8_MMA(0, 1, At, B1); PG8_BAR;
            PG8_LDA(At, 0, 1); PG8_STAGE(PG8_SA(0, 0), a2, voffA);
            PG8_BAR; PG8_WAIT_L(0); PG8_MMA(1, 0, At, B0); PG8_BAR; PG8_SCHED;
            PG8_STAGE(PG8_SB(0, 1), b2 + hstep, voffB);
            PG8_WAIT_V(6); PG8_BAR; PG8_MMA(1, 1, At, B1); PG8_BAR;
            PG8_LDB(B0, 1, 0); PG8_SCHED; PG8_LDA(At, 1, 0); PG8_STAGE(PG8_SA(0, 1), a2 + hstep, voffA);
            PG8_WAIT_L(8); PG8_BAR; PG8_WAIT_L(0); PG8_MMA(0, 0, At, B0); PG8_BAR; PG8_SCHED;
            PG8_LDB(B1, 1, 1); PG8_STAGE(PG8_SB(1, 0), b3, voffB);
            PG8_BAR; PG8_WAIT_L(0); PG8_MMA(0, 1, At, B1); PG8_BAR;
            PG8_LDA(At, 1, 1); PG8_STAGE(PG8_SA(1, 0), a3, voffA);
            PG8_BAR; PG8_WAIT_L(0); PG8_MMA(1, 0, At, B0); PG8_BAR; PG8_SCHED;
            PG8_STAGE(PG8_SB(1, 1), b3 + hstep, voffB);
            PG8_WAIT_V(6); PG8_BAR; PG8_MMA(1, 1, At, B1); PG8_BAR;
            }
        }
        if constexpr (ALIGN_EPI) { if (wr == 0) PG8_BAR; }
        if constexpr (!Epi::AFTER_DRAIN) { E(acc, cur, wr, wc, fr, fq); S.done(cur); }
        if (!has_next) break;
#pragma unroll
        for (int a = 0; a < 2; ++a)
#pragma unroll
            for (int b = 0; b < 2; ++b)
#pragma unroll
                for (int m = 0; m < 4; ++m)
#pragma unroll
                    for (int n = 0; n < 2; ++n) acc[a][b][m][n] = (f32x4){0.f, 0.f, 0.f, 0.f};
        cur = nxt; cA = nA; cB = nB; ++ui;
        if constexpr (ALIGN_EPI) { if (wr == 1) PG8_BAR; }
    }
    PG8_WAIT_V(0);
    if constexpr (!ALIGN_EPI) { if (wr == 0) PG8_BAR; }
    PG8_BAR;
    if constexpr (Epi::AFTER_DRAIN) { E.fused(acc, cur, wr, wc, fr, fq, lds, wid, lane); S.done(cur); }
#undef PG8_SA
#undef PG8_SB
#undef PG8_STAGE
#undef PG8_LDA
#undef PG8_LDB
#undef PG8_MMA
#undef PG8_WAIT_V
#undef PG8_WAIT_L
#undef PG8_BAR
#undef PG8_SCHED
}
}

namespace att {
using bf16x8 = __attribute__((ext_vector_type(8))) short;
using s16x4  = __attribute__((ext_vector_type(4))) short;
using f32x16 = __attribute__((ext_vector_type(16))) float;
using u32x4  = __attribute__((ext_vector_type(4))) unsigned;
constexpr int NW = 8, QBLK = 32, KVBLK = 64, QROWS = 128;
constexpr float SCALE = 0.125f, QPRESCALE = SCALE * 1.4426950408889634f, THRL = 8.f;
constexpr int SHM_V = KVBLK * 128 * 2, SHM_K = KVBLK * 128 * 2, SHM_ATTN = 2 * SHM_V + 2 * SHM_K + NW * 64 * 4;
#define KSWZ(row, colB) ((row) * 256 + ((colB) ^ (((row) & 7) << 4)))
#define SBAR() __builtin_amdgcn_sched_barrier(0)
__device__ __forceinline__ int crow(int r, int hi) { return (r & 3) + 8 * (r >> 2) + 4 * hi; }
__device__ __forceinline__ unsigned cvtpk(float lo, float hi) { unsigned r; asm volatile("v_cvt_pk_bf16_f32 %0, %1, %2" : "=v"(r) : "v"(lo), "v"(hi)); return r; }
__device__ __forceinline__ void partialSM(f32x16& p0, f32x16& p1, float& mhat, f32x16& negm, float& alpha) {
  float a = fmaxf(fmaxf(p0[0], p0[1]), p1[0]), b2 = fmaxf(fmaxf(p0[2], p0[3]), p1[1]); a = fmaxf(fmaxf(a, p1[2]), p1[3]);
#pragma unroll
  for (int r = 4; r < 16; r += 4) { a = fmaxf(fmaxf(a, p0[r]), p0[r + 1]); b2 = fmaxf(fmaxf(b2, p0[r + 2]), p0[r + 3]); a = fmaxf(fmaxf(a, p1[r]), p1[r + 1]); b2 = fmaxf(fmaxf(b2, p1[r + 2]), p1[r + 3]); }
  float rm = fmaxf(a, b2);
  { auto rr = __builtin_amdgcn_permlane32_swap(__float_as_uint(rm), __float_as_uint(rm), false, false);
    rm = fmaxf(__uint_as_float(rr[0]), __uint_as_float(rr[1])); }
  alpha = 1.f;
  if (__builtin_expect(__any(rm > THRL), 0)) {
    const float dl = fmaxf(rm, 0.f); mhat += dl;
#pragma unroll
    for (int r = 0; r < 16; ++r) { p0[r] -= dl; p1[r] -= dl; }
#pragma unroll
    for (int r = 0; r < 16; ++r) negm[r] = -mhat;
    alpha = __builtin_amdgcn_exp2f(-dl);
  }
#pragma unroll
  for (int r = 0; r < 16; ++r) p0[r] = __builtin_amdgcn_exp2f(p0[r]);
}
__device__ __forceinline__ void finishSM(f32x16& p0, f32x16& p1, float alpha, float& l_reg, bf16x8& pa0, bf16x8& pa1, bf16x8& pa2, bf16x8& pa3) {
#pragma unroll
  for (int r = 0; r < 16; ++r) p1[r] = __builtin_amdgcn_exp2f(p1[r]);
  float ps = 0;
#pragma unroll
  for (int r = 0; r < 16; ++r) ps += p0[r];
#pragma unroll
  for (int r = 0; r < 16; ++r) ps += p1[r];
  { auto rr = __builtin_amdgcn_permlane32_swap(__float_as_uint(ps), __float_as_uint(ps), false, false);
    ps = __uint_as_float(rr[0]) + __uint_as_float(rr[1]); }
  l_reg = l_reg * alpha + ps;
#define PK4(P, BASE, OUT) do { unsigned a0 = cvtpk(P[BASE + 0], P[BASE + 1]), a1 = cvtpk(P[BASE + 2], P[BASE + 3]);   \
    unsigned b0 = cvtpk(P[BASE + 4], P[BASE + 5]), b1 = cvtpk(P[BASE + 6], P[BASE + 7]);                              \
    auto r0 = __builtin_amdgcn_permlane32_swap(a0, b0, false, false); auto r1 = __builtin_amdgcn_permlane32_swap(a1, b1, false, false); \
    u32x4 w = {r0[0], r1[0], r0[1], r1[1]}; OUT = *reinterpret_cast<bf16x8*>(&w); } while (0)
  PK4(p0, 0, pa0); PK4(p0, 8, pa1); PK4(p1, 0, pa2); PK4(p1, 8, pa3);
#undef PK4
}
__device__ __forceinline__ void qkt(f32x16& p0, f32x16& p1, const char* Ks, const bf16x8* qr, const f32x16& negm, int r32, int hi, int sub) {
#pragma unroll
  for (int d0 = 0; d0 < 4; ++d0) { const int cb = (sub * 64 + d0 * 16 + hi * 8) * 2;
    const bf16x8 b0 = *reinterpret_cast<const bf16x8*>(Ks + KSWZ(r32, cb));
    const bf16x8 b1 = *reinterpret_cast<const bf16x8*>(Ks + KSWZ(32 + r32, cb));
    if (d0 == 0) { p0 = __builtin_amdgcn_mfma_f32_32x32x16_bf16(b0, qr[0], negm, 0, 0, 0); p1 = __builtin_amdgcn_mfma_f32_32x32x16_bf16(b1, qr[0], negm, 0, 0, 0); }
    else { p0 = __builtin_amdgcn_mfma_f32_32x32x16_bf16(b0, qr[d0], p0, 0, 0, 0); p1 = __builtin_amdgcn_mfma_f32_32x32x16_bf16(b1, qr[d0], p1, 0, 0, 0); } }
}
__device__ __forceinline__ void qkt_lds(f32x16& p0, f32x16& p1, const char* Ks, const char* qrow  , float mh, int r32, int hi, int sub) {
#pragma unroll
  for (int r = 0; r < 16; ++r) { p0[r] = -mh; p1[r] = -mh; }
#pragma unroll
  for (int d0 = 0; d0 < 4; ++d0) { const int cb = (sub * 64 + d0 * 16 + hi * 8) * 2;
    const bf16x8 qf = *reinterpret_cast<const bf16x8*>(qrow + d0 * 32);
    const bf16x8 b0 = *reinterpret_cast<const bf16x8*>(Ks + KSWZ(r32, cb));
    const bf16x8 b1 = *reinterpret_cast<const bf16x8*>(Ks + KSWZ(32 + r32, cb));
    p0 = __builtin_amdgcn_mfma_f32_32x32x16_bf16(b0, qf, p0, 0, 0, 0);
    p1 = __builtin_amdgcn_mfma_f32_32x32x16_bf16(b1, qf, p1, 0, 0, 0); }
}
__device__ __forceinline__ void partialSM2(f32x16& p0, f32x16& p1, float& mhat, float& alpha) {
  float a = fmaxf(fmaxf(p0[0], p0[1]), p1[0]), b2 = fmaxf(fmaxf(p0[2], p0[3]), p1[1]); a = fmaxf(fmaxf(a, p1[2]), p1[3]);
#pragma unroll
  for (int r = 4; r < 16; r += 4) { a = fmaxf(fmaxf(a, p0[r]), p0[r + 1]); b2 = fmaxf(fmaxf(b2, p0[r + 2]), p0[r + 3]); a = fmaxf(fmaxf(a, p1[r]), p1[r + 1]); b2 = fmaxf(fmaxf(b2, p1[r + 2]), p1[r + 3]); }
  float rm = fmaxf(a, b2);
  { auto rr = __builtin_amdgcn_permlane32_swap(__float_as_uint(rm), __float_as_uint(rm), false, false);
    rm = fmaxf(__uint_as_float(rr[0]), __uint_as_float(rr[1])); }
  alpha = 1.f;
  if (__builtin_expect(__any(rm > THRL), 0)) {
    const float dl = fmaxf(rm, 0.f); mhat += dl;
#pragma unroll
    for (int r = 0; r < 16; ++r) { p0[r] -= dl; p1[r] -= dl; }
    alpha = __builtin_amdgcn_exp2f(-dl);
  }
#pragma unroll
  for (int r = 0; r < 16; ++r) p0[r] = __builtin_amdgcn_exp2f(p0[r]);
}
__device__ __forceinline__ int v_st(int k, int c) { const int kk = (k & ~0xC) | ((k & 4) << 1) | ((k & 8) >> 1); return ((kk >> 3) * 4 + (c >> 5)) * 512 + ((kk & 7) * 32 + (c & 31)) * 2; }
__device__ __forceinline__ int v_rd_base(int lane) { return ((lane & 3) << 3) | (((lane >> 2) & 3) << 6) | (((lane >> 4) & 1) << 5) | (((lane >> 5) & 1) << 8); }
constexpr int v_rd_off(int d0, int ks, int half) { return d0 * 512 + ks * 4096 + half * 2048; }
template <int OFF> __device__ __forceinline__ s16x4 tr_read(int vb) {
  s16x4 r; asm volatile("ds_read_b64_tr_b16 %0, %1 offset:%2" : "=&v"(r) : "v"(vb), "i"(OFF) : "memory"); return r;
}
template <int D0> __device__ __forceinline__ void pv_one(f32x16& od, int vb, bf16x8 pa0, bf16x8 pa1, bf16x8 pa2, bf16x8 pa3) {
  const s16x4 l0 = tr_read<v_rd_off(D0, 0, 0)>(vb), h0 = tr_read<v_rd_off(D0, 0, 1)>(vb), l1 = tr_read<v_rd_off(D0, 1, 0)>(vb), h1 = tr_read<v_rd_off(D0, 1, 1)>(vb);
  const s16x4 l2 = tr_read<v_rd_off(D0, 2, 0)>(vb), h2 = tr_read<v_rd_off(D0, 2, 1)>(vb), l3 = tr_read<v_rd_off(D0, 3, 0)>(vb), h3 = tr_read<v_rd_off(D0, 3, 1)>(vb);
  asm volatile("s_waitcnt lgkmcnt(0)" ::: "memory"); SBAR();
#define PK(L, H) (bf16x8){L[0], L[1], L[2], L[3], H[0], H[1], H[2], H[3]}
  od = __builtin_amdgcn_mfma_f32_32x32x16_bf16(pa0, PK(l0, h0), od, 0, 0, 0);
  od = __builtin_amdgcn_mfma_f32_32x32x16_bf16(pa1, PK(l1, h1), od, 0, 0, 0);
  od = __builtin_amdgcn_mfma_f32_32x32x16_bf16(pa2, PK(l2, h2), od, 0, 0, 0);
  od = __builtin_amdgcn_mfma_f32_32x32x16_bf16(pa3, PK(l3, h3), od, 0, 0, 0);
#undef PK
}
__device__ __forceinline__ void pv_d0(f32x16* o, int vb, bf16x8 pa0, bf16x8 pa1, bf16x8 pa2, bf16x8 pa3) {
  pv_one<0>(o[0], vb, pa0, pa1, pa2, pa3); pv_one<1>(o[1], vb, pa0, pa1, pa2, pa3); pv_one<2>(o[2], vb, pa0, pa1, pa2, pa3); pv_one<3>(o[3], vb, pa0, pa1, pa2, pa3);
}
__device__ __forceinline__ long ktile_row(int b, int t) { return t < 4 ? (long)(NLAT + b * CTXL + 64 * t) : (long)(b * SEQ + 64 * (t - 4)); }

constexpr int QROWS2 = 256, QT_ROWB = 272, QT_OFF = 2 * SHM_V + 2 * SHM_K + NW * 64 * 4, SHM_ATTN2 = QT_OFF + NW * 32 * QT_ROWB;
static_assert(SHM_ATTN2 <= LDS_PHASE_BYTES, "attention LDS map");
__device__ __forceinline__ void attn_unit2(const bf16_t* __restrict__ Pm, bf16_t* __restrict__ Y, long qrow0, int b, int hh, int NT, float lam, float lam_init,
                                           const float* __restrict__ subln, char* lds) {
  const int tid = opaque_tid(), wid = __builtin_amdgcn_readfirstlane(tid >> 6), lane = tid & 63, r32 = lane & 31, hi = lane >> 5;
  char* V_lds = lds; char* K_lds = lds + 2 * SHM_V;
  float* ws = (float*)(lds + 2 * SHM_V + 2 * SHM_K) + wid * 64; float* li_l = ws; float* al_l = ws + 32;
  char* qt = lds + QT_OFF + wid * (32 * QT_ROWB);
  const long wrow0 = qrow0 + wid * QBLK;
#pragma unroll
  for (int c8 = 0; c8 < 8; ++c8) { const int row = c8 * 4 + (lane >> 4), ch = lane & 15;
    *(uint4*)(qt + row * QT_ROWB + ch * 16) = *(const uint4*)(Pm + (wrow0 + row) * NP + C_QA + hh * 128 + ch * 8); }
  float mh0 = 0.f, mh1 = 0.f, l0 = 0.f, l1 = 0.f; f32x16 o0[4] = {}, o1[4] = {};
  const int vb0 = (int)(uintptr_t)V_lds + v_rd_base(lane);
  const unsigned ldsb = (unsigned)(uintptr_t)lds + (unsigned)(wid * 2048);
#define SDMA(t, bb) do { const char* tb_ = (const char*)(Pm + ktile_row(b, (t)) * NP + hh * 128); int ln_ = lane; asm volatile("" : "+v"(ln_)); \
    _Pragma("unroll") for (int i2 = 0; i2 < 2; ++i2) { const int sl = (wid * 2 + i2) * 64 + ln_; \
      const int krow = sl >> 4, kch = (sl & 15) ^ (krow & 7); const int kof = (krow * NP + C_KA + kch * 8) * 2; \
      const int kk = (sl >> 7) * 8 + ((sl & 31) >> 2), vc = ((sl >> 5) & 3) * 32 + (sl & 3) * 8, vk = (kk & ~0xC) | ((kk & 4) << 1) | ((kk & 8) >> 1); const int vof = (vk * NP + C_VA + vc) * 2; \
    __builtin_amdgcn_global_load_lds((const unsigned*)(tb_ + vof), (__attribute__((address_space(3))) unsigned*)(ldsb + (unsigned)((bb) * SHM_V + i2 * 1024)), 16, 0, 0); \
    __builtin_amdgcn_global_load_lds((const unsigned*)(tb_ + kof), (__attribute__((address_space(3))) unsigned*)(ldsb + (unsigned)(2 * SHM_V + (bb) * SHM_K + i2 * 1024)), 16, 0, 0); } } while (0)
#define RESC(o, a) do { if (__any((a) < 1.f)) { if (hi == 0) al_l[r32] = (a); asm volatile("s_waitcnt lgkmcnt(0)" ::: "memory"); \
    _Pragma("unroll") for (int d = 0; d < 4; ++d) _Pragma("unroll") for (int r = 0; r < 16; ++r) o[d][r] *= al_l[crow(r, hi)]; } } while (0)
#define SUBSTEP(SUB, MH, LSUM, OACC, KB, VB) do { \
    f32x16 p0, p1; float al; bf16x8 pa0, pa1, pa2, pa3; \
    qkt_lds(p0, p1, (KB), qt + r32 * QT_ROWB + ((SUB) * 64 + hi * 8) * 2, (MH), r32, hi, (SUB)); \
    partialSM2(p0, p1, (MH), al); \
    RESC(OACC, al); \
    finishSM(p0, p1, al, (LSUM), pa0, pa1, pa2, pa3); SBAR(); \
    pv_d0((OACC), (VB), pa0, pa1, pa2, pa3); SBAR(); } while (0)
  SDMA(0, 0); asm volatile("s_waitcnt vmcnt(0)" ::: "memory"); __syncthreads();
  for (int t = 0; t < NT; ++t) {
    const int cur = t & 1;
    if (t + 1 < NT) SDMA(t + 1, cur ^ 1);
    SBAR();
    SUBSTEP(0, mh0, l0, o0, K_lds + cur * SHM_K, vb0 + cur * SHM_V);
    SUBSTEP(1, mh1, l1, o1, K_lds + cur * SHM_K, vb0 + cur * SHM_V);
    asm volatile("s_waitcnt vmcnt(0)" ::: "memory");
    __syncthreads();
  }
  if (hi == 0) { li_l[r32] = l0; al_l[r32] = l1; } asm volatile("s_waitcnt lgkmcnt(0)" ::: "memory");
#pragma unroll
  for (int c8 = 0; c8 < 8; ++c8) { const int row = c8 * 4 + (lane >> 4), ch = lane & 15;
    *(uint4*)(qt + row * QT_ROWB + ch * 16) = *(const uint4*)(Pm + (wrow0 + row) * NP + C_GA + hh * 128 + ch * 8); }
  float ss[16];
#pragma unroll
  for (int r = 0; r < 16; ++r) { const float ra = __builtin_amdgcn_rcpf(li_l[crow(r, hi)]), rb = lam * __builtin_amdgcn_rcpf(al_l[crow(r, hi)]); float a = 0.f;
#pragma unroll
    for (int d0 = 0; d0 < 4; ++d0) { o0[d0][r] = o0[d0][r] * ra - o1[d0][r] * rb; a += o0[d0][r] * o0[d0][r]; }
    ss[r] = a; }
#pragma unroll
  for (int r = 0; r < 16; ++r) {
    ss[r] = rsqrtf(half_sum(ss[r], hi) * (1.f / 128.f) + EPS) * (1.f - lam_init);
  }
  float sw[4];
#pragma unroll
  for (int d0 = 0; d0 < 4; ++d0) sw[d0] = subln[d0 * 32 + r32];
  asm volatile("s_waitcnt vmcnt(0) lgkmcnt(0)" ::: "memory");
#pragma unroll
  for (int r = 0; r < 16; ++r) { bf16_t* tp = (bf16_t*)(qt + crow(r, hi) * QT_ROWB) + r32;
#pragma unroll
    for (int d0 = 0; d0 < 4; ++d0) { const float g = bf2f(tp[d0 * 32]); tp[d0 * 32] = f2bf(o0[d0][r] * ss[r] * sw[d0] * (g / (1.f + __expf(-g)))); } }
  asm volatile("s_waitcnt lgkmcnt(0)" ::: "memory");
#pragma unroll
  for (int c8 = 0; c8 < 8; ++c8) { const int row = c8 * 4 + (lane >> 4), ch = lane & 15;
    *(uint4*)(Y + (wrow0 + row) * DM + hh * 128 + ch * 8) = *(const uint4*)(qt + row * QT_ROWB + ch * 16); }
  asm volatile("s_waitcnt lgkmcnt(0)" ::: "memory");
#undef SDMA
#undef RESC
#undef SUBSTEP
}
__device__ __forceinline__ void attn_phase(const bf16_t* __restrict__ Pm, bf16_t* __restrict__ Y, const float* lq1, const float* lk1, const float* lq2, const float* lk2,
                                           const float* __restrict__ subln, float lam_init, bool ctx_out, unsigned* qcnt  ,
                                           volatile __attribute__((address_space(3))) unsigned* bcast, char* lds) {
  const int tid = opaque_tid(), lane = tid & 63;
  const float lam = rl_f(expf(wave_sum(lq1[lane] * lk1[lane])) - expf(wave_sum(lq2[lane] * lk2[lane])) + lam_init, 0);
  const int G = gridDim.x, bx = blockIdx.x; const int vcu = (G % 8 == 0) ? (bx % 8) * (G / 8) + bx / 8 : bx;
  const int g0 = (G == 256) ? (vcu >> 5) : (bx & 7);
  const int nun = 64 + (ctx_out ? 8 : 0);
  for (int gi = 0; gi < 8; ++gi) {
    const int g = (g0 + gi) & 7;
    for (;;) {
      if (tid == 0) bcast[0] = __hip_atomic_fetch_add(qcnt + 64 * g, 1u, __ATOMIC_RELAXED, __HIP_MEMORY_SCOPE_AGENT);
      __syncthreads();
      const int u = (int)bcast[0];
      __syncthreads();
      if (u >= nun) break;
      if (u < 64) { const int bh = g * 8 + (u >> 3), qb = u & 7, b = bh >> 3, hh = bh & 7; attn_unit2(Pm, Y, (long)b * SEQ + qb * QROWS2, b, hh, 36, lam, lam_init, subln, lds); }
      else { const int bh = g * 8 + (u - 64), b = bh >> 3, hh = bh & 7; attn_unit2(Pm, Y, (long)NLAT + b * CTXL, b, hh, 4, lam, lam_init, subln, lds); }
    }
  }
}
#undef KSWZ
#undef SBAR
}

namespace mls {
using bf16x8 = __attribute__((ext_vector_type(8))) short;
using s16x4  = __attribute__((ext_vector_type(4))) short;
using f32x4  = __attribute__((ext_vector_type(4))) float;
constexpr int QSTRB = 272, SSTRB = 144;
constexpr int VSTRB = 528;
constexpr int L_Q = 0, L_K = L_Q + 64 * QSTRB, L_V = L_K + 64 * QSTRB, L_S = L_V + 64 * VSTRB, L_CT = L_S + 64 * SSTRB, L_SM = L_CT + 256 * QSTRB, L_END = L_SM + 8192;
static_assert(L_END <= LDS_PHASE_BYTES && (L_K % 16) == 0 && (L_V % 16) == 0 && (L_S % 16) == 0 && (L_CT % 16) == 0 && (L_SM % 16) == 0, "mlstm LDS map");
__device__ __forceinline__ f32x4 mfma16(bf16x8 a, bf16x8 b, f32x4 c) { return __builtin_amdgcn_mfma_f32_16x16x32_bf16(a, b, c, 0, 0, 0); }
struct TrPair { s16x4 lo, hi; };
__device__ __forceinline__ TrPair tr_issue(unsigned addr, int rsb) {
  TrPair t;
  asm volatile("ds_read_b64_tr_b16 %0, %1" : "=&v"(t.lo) : "v"(addr) : "memory");
  asm volatile("ds_read_b64_tr_b16 %0, %1" : "=&v"(t.hi) : "v"(addr + 4u * (unsigned)rsb) : "memory");
  return t;
}
__device__ __forceinline__ bf16x8 tr_pack(const TrPair& t) { return (bf16x8){t.lo[0], t.lo[1], t.lo[2], t.lo[3], t.hi[0], t.hi[1], t.hi[2], t.hi[3]}; }
#define TR_PIN(t) asm volatile("" : "+v"((t).lo), "+v"((t).hi))
__device__ __forceinline__ float wave_scan_incl(float v) {
  v += __builtin_bit_cast(float, __builtin_amdgcn_update_dpp(0, __builtin_bit_cast(int, v), 0x111, 0xF, 0xF, false));
  v += __builtin_bit_cast(float, __builtin_amdgcn_update_dpp(0, __builtin_bit_cast(int, v), 0x112, 0xF, 0xF, false));
  v += __builtin_bit_cast(float, __builtin_amdgcn_update_dpp(0, __builtin_bit_cast(int, v), 0x114, 0xF, 0xF, false));
  v += __builtin_bit_cast(float, __builtin_amdgcn_update_dpp(0, __builtin_bit_cast(int, v), 0x118, 0xF, 0xF, false));
  v += __builtin_bit_cast(float, __builtin_amdgcn_update_dpp(0, __builtin_bit_cast(int, v), 0x142, 0xA, 0xF, false));
  v += __builtin_bit_cast(float, __builtin_amdgcn_update_dpp(0, __builtin_bit_cast(int, v), 0x143, 0xC, 0xF, false));
  return v;
}
__device__ __forceinline__ float fast_tanh(float x) { return 1.f - 2.f * __builtin_amdgcn_rcpf(1.f + __expf(2.f * x)); }

__device__ __forceinline__ void tr_v4(unsigned base, TrPair& a0, TrPair& a1, TrPair& b0, TrPair& b1, TrPair& c0, TrPair& c1, TrPair& d0, TrPair& d1) {
  asm volatile(
    "ds_read_b64_tr_b16 %0, %16\n\tds_read_b64_tr_b16 %1, %16 offset:2112\n\tds_read_b64_tr_b16 %2, %16 offset:16896\n\tds_read_b64_tr_b16 %3, %16 offset:19008\n\t"
    "ds_read_b64_tr_b16 %4, %16 offset:32\n\tds_read_b64_tr_b16 %5, %16 offset:2144\n\tds_read_b64_tr_b16 %6, %16 offset:16928\n\tds_read_b64_tr_b16 %7, %16 offset:19040\n\t"
    "ds_read_b64_tr_b16 %8, %16 offset:64\n\tds_read_b64_tr_b16 %9, %16 offset:2176\n\tds_read_b64_tr_b16 %10, %16 offset:16960\n\tds_read_b64_tr_b16 %11, %16 offset:19072\n\t"
    "ds_read_b64_tr_b16 %12, %16 offset:96\n\tds_read_b64_tr_b16 %13, %16 offset:2208\n\tds_read_b64_tr_b16 %14, %16 offset:16992\n\tds_read_b64_tr_b16 %15, %16 offset:19104\n\t"
    "s_waitcnt lgkmcnt(0)"
    : "=&v"(a0.lo), "=&v"(a0.hi), "=&v"(a1.lo), "=&v"(a1.hi), "=&v"(b0.lo), "=&v"(b0.hi), "=&v"(b1.lo), "=&v"(b1.hi),
      "=&v"(c0.lo), "=&v"(c0.hi), "=&v"(c1.lo), "=&v"(c1.hi), "=&v"(d0.lo), "=&v"(d0.hi), "=&v"(d1.lo), "=&v"(d1.hi)
    : "v"(base) : "memory");
}
__device__ __forceinline__ bf16x8 scale_frag(const TrPair& t, const float4 wa, const float4 wb) {
  const float f0 = bf2f((bf16_t)t.lo[0]) * wa.x, f1 = bf2f((bf16_t)t.lo[1]) * wa.y, f2 = bf2f((bf16_t)t.lo[2]) * wa.z, f3 = bf2f((bf16_t)t.lo[3]) * wa.w;
  const float f4 = bf2f((bf16_t)t.hi[0]) * wb.x, f5 = bf2f((bf16_t)t.hi[1]) * wb.y, f6 = bf2f((bf16_t)t.hi[2]) * wb.z, f7 = bf2f((bf16_t)t.hi[3]) * wb.w;
  return __builtin_bit_cast(bf16x8, make_uint4(pk2(f0, f1), pk2(f2, f3), pk2(f4, f5), pk2(f6, f7)));
}

__device__ __forceinline__ void mlstm_unit(const bf16_t* __restrict__ Pm, const bf16_t* __restrict__ QKC  , const float* __restrict__ GATES,
                                           bf16_t* __restrict__ HM, const float* __restrict__ i_bias, const float* __restrict__ f_bias,
                                           int b, int head, int dir, bool ctx_out, char* lds) {
  const int tid = opaque_tid(), wid = __builtin_amdgcn_readfirstlane(tid >> 6), lane = tid & 63, lr = lane & 15, kg = lane >> 4;
  char* q_lds = lds + L_Q; char* k_lds = lds + L_K; char* v_lds = lds + L_V; char* s_lds = lds + L_S; char* ct_lds = lds + L_CT;
  float* bl = (float*)(lds + L_SM); float* bsp = bl + 64; float* av = bsp + 64; float* wkl = av + 64; float* qn = wkl + 64; float* nvec = qn + 64; float* rs = nvec + 128; float* npart = rs + 1024;
  const unsigned lds0 = (unsigned)(uintptr_t)lds;
  const unsigned trq = (unsigned)((8 * kg + (lr >> 2)) * QSTRB + (4 * (lr & 3)) * 2), trv = (unsigned)((8 * kg + (lr >> 2)) * VSTRB + (4 * (lr & 3)) * 2);
  if (tid < 128) nvec[tid] = 0.f;
  const float ibias = i_bias[dir * 4 + head], fbias = f_bias[dir * 4 + head];
  const int chg = tid & 31, rg = tid >> 5; const bool isk = chg >= 16;
  const int qkcol = 1024 + (isk ? 512 : 0) + head * 128 + (chg & 15) * 8;
  const int vrow = tid >> 3, vch = tid & 7;
  uint4 pq0, pq1, pq2, pq3, pv0, pv1, pv2, pv3; float pgi, pgf;
#define MLS_LOAD(c_) do { const int c__ = (c_); const bool ic_ = c__ < 4; const int T_ = ic_ ? CTXL : SEQ, cc_ = ic_ ? c__ : c__ - 4; \
    const long rb_ = ic_ ? (long)(NLAT + b * CTXL) : (long)b * SEQ; const int t0_ = dir ? (T_ - 64 * (cc_ + 1)) : 64 * cc_; \
    { const bf16_t* qp_ = QKC + (rb_ + t0_ + rg) * DM + qkcol; pq0 = *(const uint4*)qp_; pq1 = *(const uint4*)(qp_ + 16 * DM); pq2 = *(const uint4*)(qp_ + 32 * DM); pq3 = *(const uint4*)(qp_ + 48 * DM); } \
    { const uint4* vp_ = (const uint4*)(Pm + (rb_ + t0_ + vrow) * NP + C_VB + head * 256 + vch * 32); pv0 = vp_[0]; pv1 = vp_[1]; pv2 = vp_[2]; pv3 = vp_[3]; } \
    const float* gr_ = GATES + (rb_ + t0_ + (dir ? 63 - lane : lane)) * 16; pgi = gr_[dir * 4 + head]; pgf = gr_[8 + dir * 4 + head]; } while (0)
  MLS_LOAD(0);
  f32x4 Cacc[16];
#pragma unroll
  for (int e = 0; e < 16; ++e) Cacc[e] = (f32x4){0.f, 0.f, 0.f, 0.f};
  float gprev = 0.f;
  __syncthreads();
  for (int c = 0; c < 36; ++c) {
    const bool isctx = c < 4; const int T = isctx ? CTXL : SEQ, cc = isctx ? c : c - 4;
    const long rowbase = isctx ? (long)(NLAT + b * CTXL) : (long)b * SEQ;
    const int t0 = dir ? (T - 64 * (cc + 1)) : 64 * cc;
    const bool need_h = ctx_out || !isctx;
    float gamma, wk_l;
    {
      const float igv = 15.f * fast_tanh((pgi + ibias) * (1.f / 15.f));
      const float fc = 15.f * fast_tanh((pgf + fbias) * (1.f / 15.f));
      const float lfv = fminf(fc, 0.f) - __logf(1.f + __expf(-fabsf(fc)));
      const float bcum = wave_scan_incl(lfv);
      const float b63 = __builtin_bit_cast(float, __builtin_amdgcn_readlane(__builtin_bit_cast(int, bcum), 63));
      gamma = __expf(b63); wk_l = __expf(b63 - bcum + igv);
      if (wid == 0) { bl[lane] = bcum; bsp[lane] = bcum - igv; av[lane] = __expf(bcum); wkl[lane] = wk_l; }
      if (c > 0 && tid < 128) nvec[tid] = gprev * nvec[tid] + (npart[tid] + npart[128 + tid]) + (npart[256 + tid] + npart[384 + tid]);
    }
#pragma unroll
    for (int eblk = 0; eblk < 16; ++eblk) { uint2 w_; w_.x = pk2(Cacc[eblk][0], Cacc[eblk][1]); w_.y = pk2(Cacc[eblk][2], Cacc[eblk][3]);
      *(uint2*)(ct_lds + (eblk * 16 + lr) * QSTRB + (wid * 16 + 4 * kg) * 2) = w_; }
    { char* dst = (isk ? k_lds : q_lds) + (chg & 15) * 16;
      *(uint4*)(dst + (dir ? 63 - rg : rg) * QSTRB) = pq0; *(uint4*)(dst + (dir ? 47 - rg : rg + 16) * QSTRB) = pq1;
      *(uint4*)(dst + (dir ? 31 - rg : rg + 32) * QSTRB) = pq2; *(uint4*)(dst + (dir ? 15 - rg : rg + 48) * QSTRB) = pq3; }
    { char* dst = v_lds + (dir ? 63 - vrow : vrow) * VSTRB + vch * 64;
      *(uint4*)dst = pv0; *(uint4*)(dst + 16) = pv1; *(uint4*)(dst + 32) = pv2; *(uint4*)(dst + 48) = pv3; }
    if (c + 1 < 36) MLS_LOAD(c + 1);
    __syncthreads();
    if (need_h) {
      const int lblk = wid >> 1;
#pragma unroll
      for (int u2 = 0; u2 < 2; ++u2) {
        const int sblk = 2 * (wid & 1) + u2;
        if (sblk <= lblk) {
          f32x4 acc = {0.f, 0.f, 0.f, 0.f};
#pragma unroll
          for (int ks = 0; ks < 4; ++ks) {
            const bf16x8 ka = *(const bf16x8*)(k_lds + (sblk * 16 + lr) * QSTRB + (ks * 32 + 8 * kg) * 2);
            const bf16x8 qb = *(const bf16x8*)(q_lds + (lblk * 16 + lr) * QSTRB + (ks * 32 + 8 * kg) * 2);
            acc = mfma16(ka, qb, acc);
          }
          const int l = lblk * 16 + lr; const float blv = bl[l];
          float v4[4]; float sum = 0.f;
#pragma unroll
          for (int r = 0; r < 4; ++r) { const int sidx = sblk * 16 + 4 * kg + r; const float w = (sidx <= l) ? __expf(blv - bsp[sidx]) : 0.f; v4[r] = acc[r] * w; sum += v4[r]; }
          uint2 w; w.x = pk2(v4[0], v4[1]); w.y = pk2(v4[2], v4[3]);
          *(uint2*)(s_lds + l * SSTRB + (sblk * 16 + 4 * kg) * 2) = w;
          rs[(sblk * 4 + kg) * 64 + l] = sum;
        } else if ((lblk == 0 && sblk == 1) || (lblk == 2 && sblk == 3)) {
          uint2 z_; z_.x = 0u; z_.y = 0u; asm volatile("" : "+v"(z_.x), "+v"(z_.y));
          *(uint2*)(s_lds + (lblk * 16 + lr) * SSTRB + (sblk * 16 + 4 * kg) * 2) = z_;
        }
      }
      { const int l = tid >> 3, part = tid & 7; float a = 0.f;
        const unsigned* qp = (const unsigned*)(q_lds + l * QSTRB + part * 32);
#pragma unroll
        for (int i = 0; i < 8; ++i) { const unsigned wd = qp[i]; a += __uint_as_float(wd << 16) * nvec[part * 16 + 2 * i] + __uint_as_float(wd & 0xffff0000u) * nvec[part * 16 + 2 * i + 1]; }
        a += __builtin_bit_cast(float, __builtin_amdgcn_update_dpp(0, __builtin_bit_cast(int, a), 0xB1, 0xF, 0xF, false));
        a += __builtin_bit_cast(float, __builtin_amdgcn_update_dpp(0, __builtin_bit_cast(int, a), 0x4E, 0xF, 0xF, false));
        a += __builtin_bit_cast(float, __builtin_amdgcn_update_dpp(0, __builtin_bit_cast(int, a), 0x141, 0xF, 0xF, false));
        if (part == 0) qn[l] = a; }
    }
    __syncthreads();
    if (need_h) {
      const int lblk = wid >> 1, l = lblk * 16 + lr, eh = wid & 1;
      float d = av[l] * qn[l];
      for (int sb = 0; sb <= lblk; ++sb) d += (rs[(sb * 4 + 0) * 64 + l] + rs[(sb * 4 + 1) * 64 + l]) + (rs[(sb * 4 + 2) * 64 + l] + rs[(sb * 4 + 3) * 64 + l]);
      const float a_l = av[l], dinv = 1.f / fmaxf(fabsf(d), 1.f);
      bf16x8 qb[4];
#pragma unroll
      for (int ks = 0; ks < 4; ++ks) qb[ks] = *(const bf16x8*)(q_lds + l * QSTRB + (ks * 32 + 8 * kg) * 2);
      const bf16x8 sb0 = *(const bf16x8*)(s_lds + l * SSTRB + (8 * kg) * 2);
      bf16x8 sb1 = sb0; if (lblk >= 2) sb1 = *(const bf16x8*)(s_lds + l * SSTRB + (32 + 8 * kg) * 2);
      const int t = dir ? (t0 + 63 - l) : (t0 + l);
      bf16_t* hp = HM + ((size_t)dir * NTOK + rowbase + t) * 1024 + head * 256 + eh * 128 + 4 * kg;
#pragma unroll
      for (int half = 0; half < 2; ++half) {
        TrPair a0, a1, b0, b1, c0, c1, d0, d1;
        tr_v4(lds0 + L_V + trv + (unsigned)((eh * 8 + half * 4) * 32), a0, a1, b0, b1, c0, c1, d0, d1);
        __builtin_amdgcn_sched_barrier(0);
#define MLS_HTILE(ti, VA0, VA1) do { const int eblk = eh * 8 + half * 4 + (ti); f32x4 acc1 = {0.f, 0.f, 0.f, 0.f}, acc2 = {0.f, 0.f, 0.f, 0.f}; \
          _Pragma("unroll") for (int ks = 0; ks < 4; ++ks) { const bf16x8 ca = *(const bf16x8*)(ct_lds + (eblk * 16 + lr) * QSTRB + (ks * 32 + 8 * kg) * 2); acc1 = mfma16(ca, qb[ks], acc1); } \
          acc2 = mfma16(tr_pack(VA0), sb0, acc2); if (lblk >= 2) acc2 = mfma16(tr_pack(VA1), sb1, acc2); \
          uint2 w_; w_.x = pk2((a_l * acc1[0] + acc2[0]) * dinv, (a_l * acc1[1] + acc2[1]) * dinv); w_.y = pk2((a_l * acc1[2] + acc2[2]) * dinv, (a_l * acc1[3] + acc2[3]) * dinv); \
          *(uint2*)(hp + (half * 4 + (ti)) * 16) = w_; } while (0)
        MLS_HTILE(0, a0, a1); MLS_HTILE(1, b0, b1); MLS_HTILE(2, c0, c1); MLS_HTILE(3, d0, d1);
#undef MLS_HTILE
      }
    }
    {
      bf16x8 kA0, kA1;
      { TrPair ka0, ka1; const unsigned ak = lds0 + L_K + trq + (unsigned)(wid * 32);
        asm volatile("ds_read_b64_tr_b16 %0, %4\n\tds_read_b64_tr_b16 %1, %4 offset:1088\n\tds_read_b64_tr_b16 %2, %4 offset:8704\n\tds_read_b64_tr_b16 %3, %4 offset:9792\n\ts_waitcnt lgkmcnt(0)"
                     : "=&v"(ka0.lo), "=&v"(ka0.hi), "=&v"(ka1.lo), "=&v"(ka1.hi) : "v"(ak) : "memory");
        const float4 w0 = *(const float4*)(wkl + 8 * kg), w1 = *(const float4*)(wkl + 8 * kg + 4), w2 = *(const float4*)(wkl + 32 + 8 * kg), w3 = *(const float4*)(wkl + 36 + 8 * kg);
        kA0 = scale_frag(ka0, w0, w1); kA1 = scale_frag(ka1, w2, w3); }
#pragma unroll
      for (int q4 = 0; q4 < 4; ++q4) {
        TrPair a0, a1, b0, b1, c0, c1, d0, d1;
        tr_v4(lds0 + L_V + trv + (unsigned)(q4 * 128), a0, a1, b0, b1, c0, c1, d0, d1);
        __builtin_amdgcn_sched_barrier(0);
#define MLS_CUPD(ti, V0, V1) do { f32x4 cc_ = Cacc[q4 * 4 + (ti)] * gamma; cc_ = mfma16(kA0, tr_pack(V0), cc_); cc_ = mfma16(kA1, tr_pack(V1), cc_); Cacc[q4 * 4 + (ti)] = cc_; } while (0)
        MLS_CUPD(0, a0, a1); MLS_CUPD(1, b0, b1); MLS_CUPD(2, c0, c1); MLS_CUPD(3, d0, d1);
#undef MLS_CUPD
      }
      { const int dd = tid & 127, sq = tid >> 7; float a = 0.f; const bf16_t* kp = (const bf16_t*)k_lds + (sq * 16) * (QSTRB / 2) + dd;
#pragma unroll
        for (int si = 0; si < 16; ++si) a += bf2f(kp[si * (QSTRB / 2)]) * wkl[sq * 16 + si];
        npart[sq * 128 + dd] = a; }
      gprev = gamma;
    }
    __syncthreads();
  }
#undef MLS_LOAD
}
__device__ __forceinline__ void qkconv_phase(const bf16_t* __restrict__ Pm, bf16_t* __restrict__ QKC, const float* __restrict__ conv_w, const float* __restrict__ conv_b) {
  const int tid = opaque_tid(), lane = tid & 63, wave = tid >> 6;
  const int gw = blockIdx.x * 8 + wave, ngw = gridDim.x * 8;
  const int half = gw & 1, c0 = half * 512 + lane * 8;
  float cw0[8], cw1[8], cw2[8], cbv[8];
#pragma unroll
  for (int i = 0; i < 8; ++i) { cw0[i] = conv_w[c0 + i]; cw1[i] = conv_w[1024 + c0 + i]; cw2[i] = conv_w[2048 + c0 + i]; cbv[i] = conv_b[c0 + i]; }
  const float osc = half ? 0.08838834764831845f : 1.f;
  for (int it = gw >> 1; it < NTOK / 8; it += ngw >> 1) {
    const int r0 = it * 8; const bool isl = r0 < NLAT; const int seq0 = isl ? (r0 / SEQ) * SEQ : NLAT + ((r0 - NLAT) / CTXL) * CTXL, T = isl ? SEQ : CTXL;
    uint4 x[10];
#pragma unroll
    for (int r = 0; r < 10; ++r) { const int t = r0 - seq0 - 1 + r; x[r] = (t >= 0 && t < T) ? *(const uint4*)(Pm + (size_t)(seq0 + t) * NP + C_QB + c0) : make_uint4(0u, 0u, 0u, 0u); }
#pragma unroll
    for (int r = 0; r < 8; ++r) {
      const unsigned a0[4] = {x[r].x, x[r].y, x[r].z, x[r].w}, a1[4] = {x[r + 1].x, x[r + 1].y, x[r + 1].z, x[r + 1].w}, a2[4] = {x[r + 2].x, x[r + 2].y, x[r + 2].z, x[r + 2].w};
      float o[8];
#pragma unroll
      for (int i = 0; i < 8; ++i) {
        const float v0 = (i & 1) ? __uint_as_float(a0[i >> 1] & 0xffff0000u) : __uint_as_float(a0[i >> 1] << 16);
        const float v1 = (i & 1) ? __uint_as_float(a1[i >> 1] & 0xffff0000u) : __uint_as_float(a1[i >> 1] << 16);
        const float v2 = (i & 1) ? __uint_as_float(a2[i >> 1] & 0xffff0000u) : __uint_as_float(a2[i >> 1] << 16);
        const float z = cbv[i] + cw0[i] * v0 + cw1[i] * v1 + cw2[i] * v2;
        o[i] = osc * z / (1.f + __expf(-z));
      }
      uint4 w; w.x = pk2(o[0], o[1]); w.y = pk2(o[2], o[3]); w.z = pk2(o[4], o[5]); w.w = pk2(o[6], o[7]);
      *(uint4*)(QKC + (size_t)(r0 + r) * DM + 1024 + c0) = w;
    }
  }
}
__device__ __forceinline__ void mlstm_phase(const bf16_t* __restrict__ Pm, const bf16_t* __restrict__ QKC, const float* __restrict__ GATES, bf16_t* __restrict__ HM,
                                            const float* __restrict__ i_bias, const float* __restrict__ f_bias, bool ctx_out, char* lds) {
  const int G = gridDim.x, bx = blockIdx.x;
  if (G == 256) { const int vcu = (bx % 8) * 32 + bx / 8; if ((vcu & 31) < 8) { const int u = (vcu >> 5) * 8 + (vcu & 31); mlstm_unit(Pm, QKC, GATES, HM, i_bias, f_bias, u >> 3, (u >> 1) & 3, u & 1, ctx_out, lds); } }
  else for (int u = bx; u < 64; u += G) mlstm_unit(Pm, QKC, GATES, HM, i_bias, f_bias, u >> 3, (u >> 1) & 3, u & 1, ctx_out, lds);
}
}

DEVI void mod_unit(int unit, const float* __restrict__ c, const float* __restrict__ c_ctx, const float* __restrict__ w_ada, const float* __restrict__ b_ada, float* __restrict__ MOD, float* ldsf) {
    const int tid = opaque_tid(), ci = tid & 63, kgp = tid >> 6;
    const int l = unit / 96, cb = unit % 96;
    float* sc = ldsf; float* red = ldsf + 9 * DM;
    for (int i = tid; i < 9 * DM; i += 512) { const float v = (i < 8 * DM) ? c[i] : c_ctx[i - 8 * DM]; sc[i] = silu_f(v); }
    __syncthreads();
    float acc[9];
#pragma unroll
    for (int r = 0; r < 9; ++r) acc[r] = 0.f;
    const float* w = w_ada + (size_t)l * DM * MODW + cb * 64 + ci;
#pragma unroll 32
    for (int k = kgp * 256; k < kgp * 256 + 256; ++k) {
        const float wv = w[(size_t)k * MODW];
#pragma unroll
        for (int r = 0; r < 9; ++r) acc[r] += sc[r * DM + k] * wv;
    }
#pragma unroll
    for (int r = 0; r < 9; ++r) red[(kgp * 9 + r) * 64 + ci] = acc[r];
    __syncthreads();
    for (int idx = tid; idx < 9 * 64; idx += 512) {
        const int r = idx >> 6, cc = idx & 63; float s = 0.f;
#pragma unroll
        for (int g = 0; g < 8; ++g) s += red[(g * 9 + r) * 64 + cc];
        MOD[(size_t)(l * 9 + r) * MODW + cb * 64 + cc] = s + b_ada[l * MODW + cb * 64 + cc];
    }
    __syncthreads();
}
DEVI void transpose_items(const float* __restrict__ W, int ldw, int K, int N, bf16_t* __restrict__ WT, float* scr, int gw, int ngw, int lane) {
    const int nitems = (K / 64) * (N / 32);
    for (int it = gw; it < nitems; it += ngw) transpose_item(W, ldw, K, N, WT, scr, it, lane);
}
DEVI void finish_row(const bf16_t* __restrict__ P, const bf16_t* __restrict__ HM, const float* __restrict__ mnorm, bf16_t* __restrict__ Y, int row, int lane) {
#pragma unroll
    for (int head = 0; head < 4; ++head) {
        const int col = head * 256 + 4 * lane;
        const uint2 a = *(const uint2*)(HM + (size_t)row * 1024 + col), c = *(const uint2*)(HM + ((size_t)NTOK + row) * 1024 + col);
        float h[4];
        h[0] = __uint_as_float(a.x << 16) + __uint_as_float(c.x << 16); h[1] = __uint_as_float(a.x & 0xffff0000u) + __uint_as_float(c.x & 0xffff0000u);
        h[2] = __uint_as_float(a.y << 16) + __uint_as_float(c.y << 16); h[3] = __uint_as_float(a.y & 0xffff0000u) + __uint_as_float(c.y & 0xffff0000u);
        const float ss = wave_sum(h[0] * h[0] + h[1] * h[1] + h[2] * h[2] + h[3] * h[3]);
        const float r = rsqrtf(ss * (1.f / 256.f) + EPS);
        const uint2 ov = *(const uint2*)(P + (size_t)row * NP + C_OB + col), gv = *(const uint2*)(P + (size_t)row * NP + C_GB + col);
        const float o[4] = {__uint_as_float(ov.x << 16), __uint_as_float(ov.x & 0xffff0000u), __uint_as_float(ov.y << 16), __uint_as_float(ov.y & 0xffff0000u)};
        const float g[4] = {__uint_as_float(gv.x << 16), __uint_as_float(gv.x & 0xffff0000u), __uint_as_float(gv.y << 16), __uint_as_float(gv.y & 0xffff0000u)};
        const float4 w = *(const float4*)(mnorm + col);
        const float wv[4] = {w.x, w.y, w.z, w.w};
        float y[4];
#pragma unroll
        for (int e = 0; e < 4; ++e) y[e] = h[e] * r * wv[e] * sigmoid_f(o[e]) * silu_f(g[e]);
        uint2 out; out.x = pk2(y[0], y[1]); out.y = pk2(y[2], y[3]);
        *(uint2*)(Y + (size_t)row * DM + 1024 + col) = out;
    }
}
DEVI void load_row(const float* __restrict__ xr, float4 (&v)[8], int lane) {
#pragma unroll
    for (int j = 0; j < 8; ++j) v[j] = ((const float4*)xr)[lane + 64 * j];
}
DEVI void post_regs(float4 (&v)[8], const bf16_t* __restrict__ y2row, const float* __restrict__ gate, const float* __restrict__ npost, float* __restrict__ orow, int lane) {
    uint2 yv[8]; float ss = 0.f;
#pragma unroll
    for (int j = 0; j < 8; ++j) {
        yv[j] = *(const uint2*)(y2row + 4 * (lane + 64 * j));
        const float y0 = __uint_as_float(yv[j].x << 16), y1 = __uint_as_float(yv[j].x & 0xffff0000u), y2 = __uint_as_float(yv[j].y << 16), y3 = __uint_as_float(yv[j].y & 0xffff0000u);
        ss += y0 * y0 + y1 * y1 + y2 * y2 + y3 * y3;
    }
    ss = wave_sum(ss);
    const float rstd = rsqrtf(ss * (1.f / DM) + EPS);
#pragma unroll
    for (int j = 0; j < 8; ++j) {
        const int k0 = 4 * (lane + 64 * j);
        const float4 gt = *(const float4*)(gate + k0), w = *(const float4*)(npost + k0);
        const float y0 = __uint_as_float(yv[j].x << 16), y1 = __uint_as_float(yv[j].x & 0xffff0000u), y2 = __uint_as_float(yv[j].y << 16), y3 = __uint_as_float(yv[j].y & 0xffff0000u);
        v[j].x += gt.x * (y0 * rstd * w.x); v[j].y += gt.y * (y1 * rstd * w.y); v[j].z += gt.z * (y2 * rstd * w.z); v[j].w += gt.w * (y3 * rstd * w.w);
        *(float4*)(orow + k0) = v[j];
        asm volatile("" ::: "memory");
    }
}
DEVI void norm_regs(const float4 (&v)[8], const float* __restrict__ shift, const float* __restrict__ scale, const float* __restrict__ npre, bf16_t* __restrict__ hrow, char* trow, int lane) {
    float ss = 0.f;
#pragma unroll
    for (int j = 0; j < 8; ++j) ss += v[j].x * v[j].x + v[j].y * v[j].y + v[j].z * v[j].z + v[j].w * v[j].w;
    ss = wave_sum(ss);
    const float rstd = rsqrtf(ss * (1.f / DM) + EPS);
#pragma unroll
    for (int j = 0; j < 8; ++j) {
        const int k0 = 4 * (lane + 64 * j);
        const float4 w = *(const float4*)(npre + k0), sh = *(const float4*)(shift + k0), sc = *(const float4*)(scale + k0);
        uint2 o;
        o.x = pk2(v[j].x * rstd * w.x * (1.f + sc.x) + sh.x, v[j].y * rstd * w.y * (1.f + sc.y) + sh.y);
        o.y = pk2(v[j].z * rstd * w.z * (1.f + sc.z) + sh.z, v[j].w * rstd * w.w * (1.f + sc.w) + sh.w);
        *(uint2*)(hrow + k0) = o; *(uint2*)(trow + k0 * 2) = o;
        asm volatile("" ::: "memory");
    }
}
constexpr int NT_ROWB = (DM + 8) * 2;
template <bool POST>
DEVI void norm_phase(const float* __restrict__ xlat, const float* __restrict__ xctx, const bf16_t* __restrict__ Y2, const float* __restrict__ mod_post, const float* __restrict__ npost,
                     float* olat, float* octx, const float* __restrict__ mod_n, const float* __restrict__ npre, const float* __restrict__ wg, bf16_t* __restrict__ H,
                     float* __restrict__ GATES, char* lds) {
    typedef short bf16x8 __attribute__((ext_vector_type(8))); typedef float f32x4 __attribute__((ext_vector_type(4)));
    const int tid = opaque_tid(), lane = tid & 63, wave = tid >> 6, lr = lane & 15, kgp = lane >> 4;
    char* tile = lds; float* red = (float*)(lds + 8 * NT_ROWB);
    bf16x8 bfrag[8];
    {
        const float* wp = wg + (size_t)(wave * 256 + 8 * kgp) * INC + lr;
#pragma unroll
        for (int ks = 0; ks < 8; ++ks) {
            unsigned w4[4];
#pragma unroll
            for (int q = 0; q < 4; ++q) { w4[q] = pk2(wp[0], wp[INC]); wp += 2 * INC; asm volatile("" : "+v"(wp)); }
            wp += (size_t)24 * INC; asm volatile("" : "+v"(wp));
            bfrag[ks] = __builtin_bit_cast(bf16x8, make_uint4(w4[0], w4[1], w4[2], w4[3]));
        }
    }
    for (int grp = blockIdx.x; grp < NTOK / 8; grp += gridDim.x) {
        const int row = grp * 8 + wave; const bool isl = row < NLAT; const int b = isl ? row / SEQ : 8;
        {
            float4 v[8];
            load_row(isl ? xlat + (size_t)row * DM : xctx + (size_t)(row - NLAT) * DM, v, lane);
            if (POST) post_regs(v, Y2 + (size_t)row * DM, mod_post + (size_t)b * MODW + 2 * DM, npost, isl ? olat + (size_t)row * DM : octx + (size_t)(row - NLAT) * DM, lane);
            norm_regs(v, mod_n + (size_t)b * MODW, mod_n + (size_t)b * MODW + DM, npre, H + (size_t)row * DM, tile + wave * NT_ROWB, lane);
        }
        __syncthreads();
        f32x4 acc = {0.f, 0.f, 0.f, 0.f};
#pragma unroll
        for (int ks = 0; ks < 8; ++ks) {
            bf16x8 af = {0, 0, 0, 0, 0, 0, 0, 0};
            if (lr < 8) af = *(const bf16x8*)(tile + lr * NT_ROWB + (wave * 256 + ks * 32 + 8 * kgp) * 2);
            acc = __builtin_amdgcn_mfma_f32_16x16x32_bf16(af, bfrag[ks], acc, 0, 0, 0);
        }
        if (kgp < 2) {
#pragma unroll
            for (int r = 0; r < 4; ++r) red[(wave * 8 + 4 * kgp + r) * 16 + lr] = acc[r];
        }
        __syncthreads();
        if (tid < 128) { const int rr = tid >> 4, cc = tid & 15; float sum = 0.f;
#pragma unroll
            for (int w8 = 0; w8 < 8; ++w8) sum += red[(w8 * 8 + rr) * 16 + cc];
            GATES[(size_t)(grp * 8 + rr) * 16 + cc] = sum; }
    }
    __syncthreads();
}

#define XB_TMO      128
#define XB_XCNT(j)  (256  + 64 * (j))
#define XB_XSUB(j)  (1280 + 64 * (j))
#define XB_XGEN(j)  (2304 + 64 * (j))
#define XB_TOP      3328
#define XB_TOPGEN   3392
#define XCD_BAR_WORDS 3456
#define XB_SPIN_CAP (1u << 18)

__device__ __forceinline__ unsigned xb_ld(unsigned* p)              { return __hip_atomic_load(p, __ATOMIC_RELAXED, __HIP_MEMORY_SCOPE_AGENT); }
__device__ __forceinline__ unsigned xb_add(unsigned* p, unsigned v) { return __hip_atomic_fetch_add(p, v, __ATOMIC_RELAXED, __HIP_MEMORY_SCOPE_AGENT); }
__device__ __forceinline__ unsigned xb_xcc_id() { return (unsigned)__builtin_amdgcn_s_getreg((3 << 11) | 20) & 0xFu; }
#define XB_SPIN(cond, bar) do { unsigned _sp = 0; while (cond) { __builtin_amdgcn_s_sleep(1); \
    if ((++_sp & 255u) == 0u) { if (xb_ld(&(bar)[XB_TMO])) break; if (_sp > XB_SPIN_CAP) { atomicAdd(&(bar)[XB_TMO], 1u); break; } } } } while (0)

struct XcdBarrier {
    unsigned* bar; unsigned x;
    volatile __attribute__((address_space(3))) unsigned* st;
};

__device__ __forceinline__ XcdBarrier xcd_barrier_post(unsigned* bar, volatile __attribute__((address_space(3))) unsigned* st) {
    XcdBarrier b; b.bar = bar; b.x = xb_xcc_id(); b.st = st;
    if (threadIdx.x == 0) (void)xb_add(&bar[XB_XCNT(b.x)], 1u);
    return b;
}
__device__ __forceinline__ void xcd_barrier_complete(unsigned* bar, unsigned x, unsigned& nloc, unsigned& nx) {
    const unsigned G = gridDim.x * gridDim.y * gridDim.z;
    unsigned sum, cnt, mine, sp = 0u;
    for (;;) {
        sum = 0u; cnt = 0u; mine = 0u;
#pragma unroll
        for (unsigned j = 0; j < 16; ++j) { const unsigned c = xb_ld(&bar[XB_XCNT(j)]); sum += c; cnt += (c > 0u) ? 1u : 0u; mine = (j == x) ? c : mine; }
        if (sum == G) break;
        __builtin_amdgcn_s_sleep(1);
        if ((++sp & 255u) == 0u) { if (xb_ld(&bar[XB_TMO])) break; if (sp > XB_SPIN_CAP) { atomicAdd(&bar[XB_TMO], 1u); break; } }
    }
    nloc = mine > 0u ? mine : 1u; nx = cnt > 0u ? cnt : 1u;
}

__device__ __forceinline__ void xcd_barrier(const XcdBarrier& b) {
    asm volatile("s_waitcnt vmcnt(0)" ::: "memory");
    __syncthreads();
    if (threadIdx.x == 0) {
        unsigned* bar = b.bar;
        __builtin_amdgcn_s_waitcnt(0);
        unsigned nloc = b.st[0], nx = b.st[1];
        if (nloc == 0u) { xcd_barrier_complete(bar, b.x, nloc, nx); b.st[0] = nloc; b.st[1] = nx; }
        const unsigned old = xb_add(&bar[XB_XSUB(b.x)], 1u);
        const unsigned gen = old / nloc;
        if (old + 1u == (gen + 1u) * nloc) {
            __builtin_amdgcn_fence(__ATOMIC_RELEASE, "agent");
            asm volatile("s_waitcnt vmcnt(0)" ::: "memory");
            const unsigned og = xb_add(&bar[XB_TOP], 1u);
            const unsigned tg = og / nx;
            if (og + 1u == (tg + 1u) * nx) xb_add(&bar[XB_TOPGEN], 1u);
            else XB_SPIN(xb_ld(&bar[XB_TOPGEN]) == tg, bar);
            __builtin_amdgcn_fence(__ATOMIC_ACQUIRE, "agent");
            xb_add(&bar[XB_XGEN(b.x)], 1u);
            asm volatile("s_waitcnt vmcnt(0)" ::: "memory");
        } else {
            XB_SPIN(xb_ld(&bar[XB_XGEN(b.x)]) == gen, bar);
            __builtin_amdgcn_fence(__ATOMIC_ACQUIRE, "agent");
            asm volatile("s_waitcnt vmcnt(0)" ::: "memory");
        }
    }
    __syncthreads();
}

namespace cg = cooperative_groups;
#ifndef PROBE_DUP
#define PROBE_DUP 0
#endif
#define DUPN(k) ((PROBE_DUP == (k)) ? 2 : 1)
constexpr int MEGA_LDS = LDS_PHASE_BYTES + 256;
struct MegaArgs { const float* in[20]; float* out; unsigned char* ws; };
DEVI const float* karg_in(int i) { const char* kp = (const char*)__builtin_amdgcn_kernarg_segment_ptr(); asm volatile("" : "+s"(kp)); return *(const float* const*)(kp + 8 * i); }
DEVI unsigned char* karg_ws() { const char* kp = (const char*)__builtin_amdgcn_kernarg_segment_ptr(); asm volatile("" : "+s"(kp)); return *(unsigned char* const*)(kp + 168); }
DEVI float* karg_out() { const char* kp = (const char*)__builtin_amdgcn_kernarg_segment_ptr(); asm volatile("" : "+s"(kp)); return *(float* const*)(kp + 160); }
typedef const __attribute__((address_space(4))) MegaArgs* KArgP;
DEVI KArgP kargs() {
    const unsigned long long p = (unsigned long long)__builtin_amdgcn_kernarg_segment_ptr();
    unsigned lo = (unsigned)p, hi = (unsigned)(p >> 32);
    asm volatile("" : "+s"(lo), "+s"(hi));
    lo = __builtin_amdgcn_readfirstlane(lo); hi = __builtin_amdgcn_readfirstlane(hi);
    return (KArgP)(((unsigned long long)hi << 32) | lo);
}
#define LAS3 __attribute__((address_space(3)))
__global__ __launch_bounds__(512, 2) void mega_fwd(MegaArgs a_unused) {
    (void)a_unused;
    extern __shared__ __attribute__((aligned(16))) unsigned char lds[];
    cg::grid_group grid = cg::this_grid();
    { volatile LAS3 unsigned* MISC = (volatile LAS3 unsigned*)((LAS3 unsigned char*)lds + LDS_PHASE_BYTES);
      if (threadIdx.x < 64) MISC[threadIdx.x] = 0u;
      __syncthreads();
      (void)xcd_barrier_post((unsigned*)(kargs()->ws + WS_CTL) + 4096, MISC + 8); }
#define GRID_BAR() do { XcdBarrier b_; b_.bar = (unsigned*)(kargs()->ws + WS_CTL) + 4096; b_.x = xb_xcc_id(); b_.st = (volatile LAS3 unsigned*)((LAS3 unsigned char*)lds + LDS_PHASE_BYTES) + 8; xcd_barrier(b_); } while (0)
#define PHASE_IDS const int G = gridDim.x; const int tid = opaque_tid(), lane = tid & 63, wave = tid >> 6, gw = blockIdx.x * 8 + wave, ngw = G * 8; (void)tid; (void)lane; (void)gw; (void)ngw; float* scr = (float*)lds + wave * (64 * 33); (void)scr
#define WSP(T, off) ((T*)(A->ws + (off)))

    { PHASE_IDS; KArgP A = kargs();
      const float* w_in = A->in[8]; const float* w_out = A->in[9]; bf16_t* WIN = WSP(bf16_t, WS_WIN); bf16_t* WOUT = WSP(bf16_t, WS_WOUT); float* ROPE = WSP(float, WS_ROPE);
      for (int u = blockIdx.x; u < 192; u += G) mod_unit(u, A->in[1], A->in[3], A->in[4], A->in[5], WSP(float, WS_MOD), (float*)lds);
      for (int i = blockIdx.x * 512 + tid; i < 1024; i += G * 512) { const int pos = i >> 4, f = i & 15; const float inv = powf(10000.f, -(float)f / 16.f); const float ang = (float)pos * inv;
          ROPE[2 * i] = cosf(ang); ROPE[2 * i + 1] = sinf(ang); }
      {
          const bool light = (G == 256) && ((int)blockIdx.x < 192);
          const int nv = (G == 256) ? (light ? 5 : 9) : 1, v0 = (G == 256) ? (light ? gw * 5 : 192 * 8 * 5 + (gw - 192 * 8) * 9) : gw, nvw = (G == 256) ? 12288 : ngw;
          for (int q = 0; q < nv; ++q) {
              const int vw_ = v0 + q;
              for (int it = vw_; it < 12288; it += nvw) {
                  if (it < 8192) transpose_item(w_in, INC, DM, NP, WIN, scr, it, lane);
                  else if (it < 10240) transpose_item(w_out, DM, DM, DM, WOUT, scr, it - 8192, lane);
                  else transpose_item(w_out + (size_t)DM * DM, DM, DM, DM, WOUT + (size_t)DM * DM, scr, it - 10240, lane);
              }
          }
      } }
    grid.sync();
    { KArgP A = kargs();
      norm_phase<false>(A->in[0], A->in[2], nullptr, nullptr, nullptr, nullptr, nullptr, WSP(float, WS_MOD), A->in[6], A->in[8] + NP, WSP(bf16_t, WS_H), WSP(float, WS_GATES), (char*)lds); }
    GRID_BAR();
    for (int l = 0; l < 2; ++l) {
        for (int rep_ = 0; rep_ < DUPN(2); ++rep_)
        { KArgP A = kargs();
          pg8::Gemm g{WSP(bf16_t, WS_H), WSP(bf16_t, WS_WIN), NTOK, NP, DM}; pg8::StaticOrder S; S.init(NTOK, NP, (int)gridDim.x, (int)blockIdx.x); pg8::EpiInProj E{WSP(bf16_t, WS_P), NP, WSP(float, WS_ROPE)};
          pg8::gemm_phase<pg8::EpiInProj, pg8::StaticOrder, true, true>((PG8_LAS unsigned char*)lds, g, S, E); }
        GRID_BAR();
        { KArgP A = kargs(); mls::qkconv_phase(WSP(bf16_t, WS_P), WSP(bf16_t, WS_H), A->in[15] + (size_t)l * 3 * 1024, A->in[16] + l * 1024); }
        GRID_BAR();
        { KArgP A = kargs(); mls::mlstm_phase(WSP(bf16_t, WS_P), WSP(bf16_t, WS_H), WSP(float, WS_GATES), WSP(bf16_t, WS_HM), A->in[17] + l * 8, A->in[18] + l * 8, l == 0, (char*)lds); }
        { KArgP A = kargs(); const float lam_init = l == 0 ? 0.2f : 0.35550906759f;
          att::attn_phase(WSP(bf16_t, WS_P), WSP(bf16_t, WS_H), A->in[10] + l * 64, A->in[11] + l * 64, A->in[12] + l * 64, A->in[13] + l * 64, A->in[14] + l * 128, lam_init, l == 0,
                          WSP(unsigned, WS_CTL) + 8192 + l * 512, (volatile LAS3 unsigned*)((LAS3 unsigned char*)lds + LDS_PHASE_BYTES) + 16, (char*)lds); }
        GRID_BAR();
        { PHASE_IDS; KArgP A = kargs(); const bf16_t* P = WSP(bf16_t, WS_P); const bf16_t* HM = WSP(bf16_t, WS_HM); bf16_t* Y = WSP(bf16_t, WS_H); const float* mn = A->in[19] + l * 1024;
          const int nrows = l == 0 ? NTOK : NLAT; for (int row = gw; row < nrows; row += ngw) finish_row(P, HM, mn, Y, row, lane); }
        GRID_BAR();
        for (int rep_ = 0; rep_ < DUPN(5); ++rep_)
        { KArgP A = kargs(); const int M = l == 0 ? NTOK : NLAT;
          pg8::Gemm g{WSP(bf16_t, WS_H), WSP(bf16_t, WS_WOUT) + (size_t)l * DM * DM, M, DM, DM}; pg8::StaticOrder S; S.init(M, DM, (int)gridDim.x, (int)blockIdx.x); pg8::EpiBf16 E{WSP(bf16_t, WS_HM), DM};
          pg8::gemm_phase<pg8::EpiBf16, pg8::StaticOrder, true, true>((PG8_LAS unsigned char*)lds, g, S, E); }
        if (l == 0) { PHASE_IDS; KArgP A = kargs(); const float* w_in1 = A->in[8] + (size_t)DM * INC; bf16_t* WIN = WSP(bf16_t, WS_WIN);
            const int nbusy = (NTOK / 256) * (DM / 256) - 2 * G;
            if (nbusy >= 0 && nbusy < G) { if ((int)blockIdx.x >= nbusy) transpose_items(w_in1, INC, DM, NP, WIN, scr, ((int)blockIdx.x - nbusy) * 8 + wave, (G - nbusy) * 8, lane); }
            else transpose_items(w_in1, INC, DM, NP, WIN, scr, gw, ngw, lane);
        }
        GRID_BAR();
        if (l == 0) {
            { KArgP A = kargs(); float* MOD = WSP(float, WS_MOD);
              norm_phase<true>(A->in[0], A->in[2], WSP(bf16_t, WS_HM), MOD, A->in[7], A->out, WSP(float, WS_XC), MOD + (size_t)9 * MODW, A->in[6] + DM, A->in[8] + (size_t)DM * INC + NP, WSP(bf16_t, WS_H), WSP(float, WS_GATES), (char*)lds); }
            GRID_BAR();
        } else { PHASE_IDS; KArgP A = kargs(); float* out = A->out; const bf16_t* Y2 = WSP(bf16_t, WS_HM); const float* mod_l = WSP(float, WS_MOD) + (size_t)9 * MODW; const float* npost = A->in[7] + DM;
            for (int row = gw; row < NLAT; row += ngw) {
                float4 v[8];
                load_row(out + (size_t)row * DM, v, lane);
                post_regs(v, Y2 + (size_t)row * DM, mod_l + (size_t)(row / SEQ) * MODW + 2 * DM, npost, out + (size_t)row * DM, lane);
            }
        }
    }
}

extern "C" void kernel_launch(void* const* d_in, const int* in_sizes, int n_in, void* d_out, int out_size, void* d_ws, size_t ws_size, hipStream_t stream) {
    (void)in_sizes; (void)n_in; (void)out_size; (void)ws_size;
    static int grid_blocks = 0;
    if (!grid_blocks) {
        int dev = 0, cus = 0, per_cu = 0;
        (void)hipGetDevice(&dev);
        (void)hipDeviceGetAttribute(&cus, hipDeviceAttributeMultiprocessorCount, dev);
        (void)hipFuncSetAttribute((const void*)mega_fwd, hipFuncAttributeMaxDynamicSharedMemorySize, MEGA_LDS);
        (void)hipOccupancyMaxActiveBlocksPerMultiprocessor(&per_cu, (const void*)mega_fwd, 512, MEGA_LDS);
        if (per_cu < 1) per_cu = 1;
        if (per_cu > 1) per_cu = 1;
        grid_blocks = cus * per_cu;
    }
    (void)hipMemsetAsync((char*)d_ws + WS_CTL, 0, 65536, stream);
    MegaArgs a{};
    for (int i = 0; i < 20; ++i) a.in[i] = (const float*)d_in[i];
    a.out = (float*)d_out; a.ws = (unsigned char*)d_ws;
    void* args[] = {&a};
    (void)hipLaunchCooperativeKernel((const void*)mega_fwd, dim3(grid_blocks), dim3(512), args, (size_t)MEGA_LDS, stream);
}
```

```cpp
#include <hip/hip_runtime.h>
#include <hip/hip_cooperative_groups.h>
#include <stdint.h>
#include <math.h>

#define DEVI __device__ __forceinline__
constexpr int LDS_PHASE_BYTES = 155648;
typedef unsigned short bf16_t;

constexpr int DM = 2048, NBATCH = 8, SEQ = 2048, CTXL = 256;
constexpr int NLAT = NBATCH * SEQ, NCTX = NBATCH * CTXL, NTOK = NLAT + NCTX;
constexpr int INC = 8208, NP = 8192, MODW = 6144;
constexpr int C_QA = 0, C_KA = 1024, C_VA = 2048, C_GA = 3072, C_QB = 4096, C_KB = 4608, C_VB = 5120, C_OB = 6144, C_GB = 7168;
constexpr float EPS = 1e-6f;

constexpr size_t MiB = (size_t)1 << 20;
constexpr size_t WS_CTL = 0, WS_MOD = 1 * MiB, WS_SC = WS_MOD + 512 * 1024, WS_ROPE = 2 * MiB, WS_GATES = 3 * MiB, WS_WOUT = 8 * MiB,
                 WS_WIN = 24 * MiB, WS_XC = 56 * MiB, WS_H = 72 * MiB, WS_HM = 144 * MiB, WS_P = 216 * MiB, WS_END = 504 * MiB;

DEVI int opaque_tid() {
    const unsigned hw = (unsigned)__builtin_amdgcn_s_getreg((5 << 11) | 4) & 63u;
    const unsigned w = *((const volatile __attribute__((address_space(3))) unsigned char*)(LDS_PHASE_BYTES + 128) + hw);
    int ln; asm volatile("v_mbcnt_lo_u32_b32 %0, -1, 0\n\tv_mbcnt_hi_u32_b32 %0, -1, %0" : "=v"(ln));
    return (int)(__builtin_amdgcn_readfirstlane(w) << 6) | ln;
}
DEVI float bf2f(bf16_t v) { return __uint_as_float(((unsigned)v) << 16); }
DEVI bf16_t f2bf(float f) { unsigned u = __float_as_uint(f); return (bf16_t)((u + 0x7fffu + ((u >> 16) & 1u)) >> 16); }
DEVI unsigned pk2(float lo, float hi) { return (unsigned)f2bf(lo) | ((unsigned)f2bf(hi) << 16); }
DEVI float row16_sum(float v) {
    v += __builtin_bit_cast(float, __builtin_amdgcn_update_dpp(0, __builtin_bit_cast(int, v), 0xB1, 0xF, 0xF, false));
    v += __builtin_bit_cast(float, __builtin_amdgcn_update_dpp(0, __builtin_bit_cast(int, v), 0x4E, 0xF, 0xF, false));
    v += __builtin_bit_cast(float, __builtin_amdgcn_update_dpp(0, __builtin_bit_cast(int, v), 0x141, 0xF, 0xF, false));
    v += __builtin_bit_cast(float, __builtin_amdgcn_update_dpp(0, __builtin_bit_cast(int, v), 0x140, 0xF, 0xF, false));
    return v;
}
DEVI float rl_f(float v, int l) { return __builtin_bit_cast(float, __builtin_amdgcn_readlane(__builtin_bit_cast(int, v), l)); }
DEVI float wave_sum(float v) { v = row16_sum(v); return (rl_f(v, 0) + rl_f(v, 16)) + (rl_f(v, 32) + rl_f(v, 48)); }
DEVI float half_sum(float v, int hi) { v = row16_sum(v); const float a = rl_f(v, 0) + rl_f(v, 16), b = rl_f(v, 32) + rl_f(v, 48); return hi ? b : a; }
DEVI float silu_f(float x) { return x / (1.f + expf(-x)); }
DEVI float sigmoid_f(float x) { return 1.f / (1.f + expf(-x)); }


DEVI void transpose_item(const float* __restrict__ W, int ldw, int K, int N, bf16_t* __restrict__ WT, float* scr, int item, int lane) {
    const int nblk = N / 32, kb = item / nblk, nb = item % nblk, k0 = 64 * kb, n0 = 32 * nb;
    float tv[32];
#pragma unroll
    for (int i = 0; i < 32; ++i) tv[i] = W[(size_t)(k0 + 2 * i + (lane >> 5)) * ldw + n0 + (lane & 31)];
#pragma unroll
    for (int i = 0; i < 32; ++i) scr[(2 * i + (lane >> 5)) * 33 + (lane & 31)] = tv[i];
    asm volatile("s_waitcnt lgkmcnt(0)" ::: "memory");
    const int c = lane & 7;
#pragma unroll
    for (int j = 0; j < 4; ++j) {
        const int n = (lane >> 3) + 8 * j; const float* s = scr + (8 * c) * 33 + n;
        uint4 o; o.x = pk2(s[0 * 33], s[1 * 33]); o.y = pk2(s[2 * 33], s[3 * 33]); o.z = pk2(s[4 * 33], s[5 * 33]); o.w = pk2(s[6 * 33], s[7 * 33]);
        *(uint4*)(WT + (size_t)(n0 + n) * K + k0 + 8 * c) = o;
    }
    asm volatile("s_waitcnt lgkmcnt(0)" ::: "memory");
}

namespace pg8 {
#define PG8_LAS __attribute__((address_space(3)))
typedef unsigned short bf16_t;
typedef short bf16x8 __attribute__((ext_vector_type(8)));
typedef float f32x4 __attribute__((ext_vector_type(4)));
typedef unsigned u32x4 __attribute__((ext_vector_type(4)));
constexpr int BM = 256, BK = 64, HALF = 128, HTB = HALF * BK * 2  , STAGE_BYTES = 8 * HTB, NXCD = 8, WGM = 8;

__host__ __device__ __forceinline__ int lds_byte(int r, int c) { const int st = (r >> 4) * 2 + (c >> 5), rr = r & 15, cc = c & 31, ob = rr * 64 + cc * 2; return st * 1024 + (ob ^ (((ob >> 9) & 1) << 5)); }
__host__ __device__ __forceinline__ void stage_rc(int b, int& R, int& C) { const int st = b / 1024, sb = b % 1024, swz = sb ^ (((sb >> 9) & 1) << 5); R = (st >> 1) * 16 + swz / 64; C = (st & 1) * 32 + (swz % 64) / 2; }
__host__ __device__ __forceinline__ int perm32(int rho) { const int n = rho >> 4, i = rho & 15; return 8 * (i >> 2) + 4 * n + (i & 3); }

struct Unit { int pm, pn; };
struct Gemm { const bf16_t* A; const bf16_t* Bt; int M, N, K; };

struct StaticOrder {
    int nM, nN, nwg, G, c;
    __host__ __device__ void init(int M, int N, int G_, int c_) { nM = M / BM; nN = N / BM; nwg = nM * nN; G = G_; c = c_; }
    __host__ __device__ bool next(int i, Unit& u) const {
        const long L = (long)i * G + c; if (L >= nwg) return false;
        int wgid = (int)L; { const int q = nwg / NXCD, r = nwg % NXCD, xcd = wgid % NXCD, off = wgid / NXCD; wgid = (xcd < r ? xcd * (q + 1) : r * (q + 1) + (xcd - r) * q) + off; }
        const int nig = WGM * nN, gid = wgid / nig, fm = gid * WGM, gsz = (nM - fm) < WGM ? (nM - fm) : WGM;
        u.pm = fm + ((wgid % nig) % gsz); u.pn = (wgid % nig) / gsz; return true;
    }
    __device__ __forceinline__ void a_ready(const Unit&) const {}
    __device__ __forceinline__ void done(const Unit&) const {}
};

__device__ __forceinline__ unsigned cvt_pk_bf16(float lo, float hi) { unsigned r; asm volatile("v_cvt_pk_bf16_f32 %0, %1, %2" : "=v"(r) : "v"(lo), "v"(hi)); return r; }

struct EpiBf16 {
    static constexpr bool PERM = true, AFTER_DRAIN = false;
    bf16_t* O; int ldc;
    __device__ __forceinline__ void operator()(const f32x4 (&acc)[2][2][4][2], const Unit& u, int wr, int wc, int fr, int fq) const {
        const int row0 = u.pm * BM + wr * 64 + fr, col0 = u.pn * BM + wc * 32 + 8 * fq;
#pragma unroll
        for (int ai = 0; ai < 2; ++ai)
#pragma unroll
            for (int m = 0; m < 4; ++m) { bf16_t* rowp = O + (size_t)(row0 + ai * HALF + m * 16) * ldc + col0;
#pragma unroll
                for (int bj = 0; bj < 2; ++bj) { const f32x4 v0 = acc[ai][bj][m][0], v1 = acc[ai][bj][m][1];
                    u32x4 w; w.x = cvt_pk_bf16(v0[0], v0[1]); w.y = cvt_pk_bf16(v0[2], v0[3]); w.z = cvt_pk_bf16(v1[0], v1[1]); w.w = cvt_pk_bf16(v1[2], v1[3]);
                    *(u32x4*)(rowp + bj * HALF) = w; } }
    }
};
struct EpiInProj {
    static constexpr bool PERM = true, AFTER_DRAIN = false;
    bf16_t* O; int ldc; const float* rope;
    __device__ __forceinline__ void operator()(const f32x4 (&acc)[2][2][4][2], const Unit& u, int wr, int wc, int fr, int fq) const {
        const int row0 = u.pm * BM + wr * 64 + fr, col0 = u.pn * BM + wc * 32 + 8 * fq;
        const bool do_rope = (u.pn < 8) && (u.pm < 64);
        const float qsc = (u.pn < 4) ? 0.18033688011112042f : 1.f;
#pragma unroll
        for (int ai = 0; ai < 2; ++ai)
#pragma unroll
            for (int m = 0; m < 4; ++m) { const int row = row0 + ai * HALF + m * 16; bf16_t* rowp = O + (size_t)row * ldc + col0;
                f32x4 cs01 = {1.f, 0.f, 1.f, 0.f}, cs23 = {1.f, 0.f, 1.f, 0.f};
                if (do_rope) { const int pos = (wc & 1) ? (row & 63) : ((row >> 6) & 31); const f32x4* rp = (const f32x4*)(rope + (size_t)(pos * 16 + 4 * fq) * 2); cs01 = rp[0]; cs23 = rp[1]; }
#pragma unroll
                for (int bj = 0; bj < 2; ++bj) { f32x4 v0 = acc[ai][bj][m][0], v1 = acc[ai][bj][m][1];
                    if (do_rope) {
                        const float a0 = v0[0] * cs01[0] - v0[1] * cs01[1], a1 = v0[0] * cs01[1] + v0[1] * cs01[0];
                        const float a2 = v0[2] * cs01[2] - v0[3] * cs01[3], a3 = v0[2] * cs01[3] + v0[3] * cs01[2];
                        const float b0 = v1[0] * cs23[0] - v1[1] * cs23[1], b1 = v1[0] * cs23[1] + v1[1] * cs23[0];
                        const float b2 = v1[2] * cs23[2] - v1[3] * cs23[3], b3 = v1[2] * cs23[3] + v1[3] * cs23[2];
                        v0 = (f32x4){a0, a1, a2, a3}; v1 = (f32x4){b0, b1, b2, b3};
                    }
                    v0 = v0 * qsc; v1 = v1 * qsc;
                    u32x4 w; w.x = cvt_pk_bf16(v0[0], v0[1]); w.y = cvt_pk_bf16(v0[2], v0[3]); w.z = cvt_pk_bf16(v1[0], v1[1]); w.w = cvt_pk_bf16(v1[2], v1[3]);
                    *(u32x4*)(rowp + bj * HALF) = w; } }
    }
};

template <class Epi, class Sched, bool ALIGN_EPI = false, bool SP2 = false>
__device__ __forceinline__ void gemm_phase(PG8_LAS unsigned char* lds, const Gemm g, const Sched& S, const Epi& E) {
    const int tid = opaque_tid(), wid = __builtin_amdgcn_readfirstlane(tid >> 6), lane = tid & 63, wr = wid >> 2, wc = wid & 3, fr = lane & 15, fq = lane >> 4;
    const int K = g.K, nt = K / BK;
    unsigned voffA[2], voffB[2];
#pragma unroll
    for (int i = 0; i < 2; ++i) { int R, C; stage_rc(tid * 16 + i * 8192, R, C); const int Rb = Epi::PERM ? ((R & ~31) + perm32(R & 31)) : R;
        voffA[i] = (unsigned)(R * K + C) * 2u; voffB[i] = (unsigned)(Rb * K + C) * 2u; }
    const size_t kstep = (size_t)(BK * 2);
    const size_t hstep = (size_t)HALF * K * 2;
    const size_t tstep = 2 * hstep;
    const unsigned ldsw = (unsigned)wid * 1024u;
    const int aoff = lds_byte(wr * 64 + fr, fq * 8), boff = lds_byte(wc * 32 + fr, fq * 8);
#define PG8_SA(b, h) (((b) * 2 + (h)) * HTB)
#define PG8_SB(b, h) ((4 + (b) * 2 + (h)) * HTB)
#define PG8_STAGE(bufoff, gbase, voff) do { _Pragma("unroll") for (int _i = 0; _i < 2; ++_i) \
        __builtin_amdgcn_global_load_lds((const unsigned*)((const char*)(gbase) + (voff)[_i]), (PG8_LAS unsigned*)(lds + (bufoff) + ldsw + _i * 8192), 16, 0, 0); } while (0)
#define PG8_LDA(dst, b, h) do { _Pragma("unroll") for (int m = 0; m < 4; ++m) _Pragma("unroll") for (int k = 0; k < 2; ++k) dst[m][k] = *(const PG8_LAS bf16x8*)(lds + PG8_SA(b, h) + aoff + m * 2048 + k * 1024); } while (0)
#define PG8_LDB(dst, b, h) do { _Pragma("unroll") for (int n = 0; n < 2; ++n) _Pragma("unroll") for (int k = 0; k < 2; ++k) dst[n][k] = *(const PG8_LAS bf16x8*)(lds + PG8_SB(b, h) + boff + n * 2048 + k * 1024); } while (0)
#define PG8_MMA(ai, bj, At, Bt) do { __builtin_amdgcn_s_setprio(1); _Pragma("unroll") for (int m = 0; m < 4; ++m) _Pragma("unroll") for (int n = 0; n < 2; ++n) _Pragma("unroll") for (int k = 0; k < 2; ++k) \
        acc[ai][bj][m][n] = __builtin_amdgcn_mfma_f32_16x16x32_bf16(Bt[n][k], At[m][k], acc[ai][bj][m][n], 0, 0, 0); __builtin_amdgcn_s_setprio(0); } while (0)
#define PG8_WAIT_V(n) asm volatile("s_waitcnt vmcnt(" #n ")" ::: "memory")
#define PG8_WAIT_L(n) asm volatile("s_waitcnt lgkmcnt(" #n ")" ::: "memory")
#define PG8_BAR __builtin_amdgcn_s_barrier()
#define PG8_SCHED __builtin_amdgcn_sched_barrier(0)
    Unit cur, nxt; int ui = 0;
    if (!S.next(0, cur)) return;
    f32x4 acc[2][2][4][2];
#pragma unroll
    for (int a = 0; a < 2; ++a)
#pragma unroll
        for (int b = 0; b < 2; ++b)
#pragma unroll
            for (int m = 0; m < 4; ++m)
#pragma unroll
                for (int n = 0; n < 2; ++n) acc[a][b][m][n] = (f32x4){0.f, 0.f, 0.f, 0.f};
    bf16x8 At[4][2], B0[2][2], B1[2][2];
    const char* cA = (const char*)g.A + (size_t)cur.pm * tstep; const char* cB = (const char*)g.Bt + (size_t)cur.pn * tstep;
    S.a_ready(cur);
    if constexpr (SP2) {
        PG8_STAGE(PG8_SB(0, 0), cB, voffB); PG8_STAGE(PG8_SB(0, 1), cB + hstep, voffB); PG8_STAGE(PG8_SA(0, 0), cA, voffA); PG8_STAGE(PG8_SA(0, 1), cA + hstep, voffA);
        if (wr == 1) PG8_BAR;
        PG8_WAIT_V(2); PG8_BAR;
        PG8_STAGE(PG8_SB(1, 0), cB + kstep, voffB); PG8_STAGE(PG8_SA(1, 0), cA + kstep, voffA); PG8_STAGE(PG8_SB(1, 1), cB + hstep + kstep, voffB);
        PG8_WAIT_V(6); PG8_BAR;
    } else {
        PG8_STAGE(PG8_SB(0, 0), cB, voffB); PG8_STAGE(PG8_SA(0, 0), cA, voffA); PG8_STAGE(PG8_SB(0, 1), cB + hstep, voffB); PG8_STAGE(PG8_SA(0, 1), cA + hstep, voffA);
        if (wr == 1) PG8_BAR;
        PG8_WAIT_V(4); PG8_BAR;
        PG8_STAGE(PG8_SB(1, 0), cB + kstep, voffB); PG8_STAGE(PG8_SA(1, 0), cA + kstep, voffA); PG8_STAGE(PG8_SB(1, 1), cB + hstep + kstep, voffB);
        PG8_WAIT_V(6); PG8_BAR;
    }
    for (;;) {
        const bool has_next = S.next(ui + 1, nxt);
        const char* nA = has_next ? (const char*)g.A + (size_t)nxt.pm * tstep : cA; const char* nB = has_next ? (const char*)g.Bt + (size_t)nxt.pn * tstep : cB;
        for (int t = 0; t < nt; t += 2) {
            const bool last = (t == nt - 2);
            const char* a1 = cA + (size_t)(t + 1) * kstep;
            const char* a2 = last ? nA : cA + (size_t)(t + 2) * kstep; const char* b2 = last ? nB : cB + (size_t)(t + 2) * kstep;
            const char* a3 = a2 + kstep; const char* b3 = b2 + kstep;
            if (last && has_next) S.a_ready(nxt);
            if constexpr (SP2) {
            PG8_LDB(B0, 0, 0); PG8_LDB(B1, 0, 1); PG8_SCHED; PG8_LDA(At, 0, 0); PG8_STAGE(PG8_SA(1, 1), a1 + hstep, voffA);
            PG8_WAIT_V(8); PG8_WAIT_L(0); PG8_BAR; PG8_MMA(0, 0, At, B0); PG8_MMA(0, 1, At, B1); PG8_BAR; PG8_SCHED;
            PG8_LDA(At, 0, 1); PG8_STAGE(PG8_SB(0, 0), b2, voffB); PG8_STAGE(PG8_SB(0, 1), b2 + hstep, voffB); PG8_STAGE(PG8_SA(0, 0), a2, voffA);
            PG8_WAIT_V(8); PG8_WAIT_L(0); PG8_BAR; PG8_MMA(1, 0, At, B0); PG8_MMA(1, 1, At, B1); PG8_BAR; PG8_SCHED;
            PG8_LDB(B0, 1, 0); PG8_LDB(B1, 1, 1); PG8_SCHED; PG8_LDA(At, 1, 0); PG8_STAGE(PG8_SA(0, 1), a2 + hstep, voffA);
            PG8_WAIT_V(8); PG8_WAIT_L(0); PG8_BAR; PG8_MMA(0, 0, At, B0); PG8_MMA(0, 1, At, B1); PG8_BAR; PG8_SCHED;
            PG8_LDA(At, 1, 1); PG8_STAGE(PG8_SB(1, 0), b3, voffB); PG8_STAGE(PG8_SB(1, 1), b3 + hstep, voffB); PG8_STAGE(PG8_SA(1, 0), a3, voffA);
            PG8_WAIT_V(8); PG8_WAIT_L(0); PG8_BAR; PG8_MMA(1, 0, At, B0); PG8_MMA(1, 1, At, B1); PG8_BAR; PG8_SCHED;
            } else {
            PG8_LDB(B0, 0, 0); PG8_SCHED; PG8_LDA(At, 0, 0); PG8_STAGE(PG8_SA(1, 1), a1 + hstep, voffA);
            PG8_WAIT_L(8); PG8_BAR; PG8_WAIT_L(0); PG8_MMA(0, 0, At, B0); PG8_BAR; PG8_SCHED;
            PG8_LDB(B1, 0, 1); PG8_STAGE(PG8_SB(0, 0), b2, voffB);
            PG8_BAR; PG8_WAIT_L(0); PG8_MMA(0, 1, At, B1); PG8_BAR;
            PG8_LDA(At, 0, 1); PG8_STAGE(PG8_SA(0, 0), a2, voffA);
            PG8_BAR; PG8_WAIT_L(0); PG8_MMA(1, 0, At, B0); PG8_BAR; PG8_SCHED;
            PG8_STAGE(PG8_SB(0, 1), b2 + hstep, voffB);
            PG8_WAIT_V(6); PG8_BAR; PG8_MMA(1, 1, At, B1); PG8_BAR;
            PG8_LDB(B0, 1, 0); PG8_SCHED; PG8_LDA(At, 1, 0); PG8_STAGE(PG8_SA(0, 1), a2 + hstep, voffA);
            PG8_WAIT_L(8); PG8_BAR; PG8_WAIT_L(0); PG8_MMA(0, 0, At, B0); PG8_BAR; PG8_SCHED;
            PG8_LDB(B1, 1, 1); PG8_STAGE(PG8_SB(1, 0), b3, voffB);
            PG8_BAR; PG8_WAIT_L(0); PG8_MMA(0, 1, At, B1); PG8_BAR;
            PG8_LDA(At, 1, 1); PG8_STAGE(PG8_SA(1, 0), a3, voffA);
            PG8_BAR; PG8_WAIT_L(0); PG8_MMA(1, 0, At, B0); PG8_BAR; PG8_SCHED;
            PG8_STAGE(PG8_SB(1, 1), b3 + hstep, voffB);
            PG8_WAIT_V(6); PG8_BAR; PG8_MMA(1, 1, At, B1); PG8_BAR;
            }
        }
        if constexpr (ALIGN_EPI) { if (wr == 0) PG8_BAR; }
        if constexpr (!Epi::AFTER_DRAIN) { E(acc, cur, wr, wc, fr, fq); S.done(cur); }
        if (!has_next) break;
#pragma unroll
        for (int a = 0; a < 2; ++a)
#pragma unroll
            for (int b = 0; b < 2; ++b)
#pragma unroll
                for (int m = 0; m < 4; ++m)
#pragma unroll
                    for (int n = 0; n < 2; ++n) acc[a][b][m][n] = (f32x4){0.f, 0.f, 0.f, 0.f};
        cur = nxt; cA = nA; cB = nB; ++ui;
        if constexpr (ALIGN_EPI) { if (wr == 1) PG8_BAR; }
    }
    PG8_WAIT_V(0);
    if constexpr (!ALIGN_EPI) { if (wr == 0) PG8_BAR; }
    PG8_BAR;
    if constexpr (Epi::AFTER_DRAIN) { E.fused(acc, cur, wr, wc, fr, fq, lds, wid, lane); S.done(cur); }
#undef PG8_SA
#undef PG8_SB
#undef PG8_STAGE
#undef PG8_LDA
#undef PG8_LDB
#undef PG8_MMA
#undef PG8_WAIT_V
#undef PG8_WAIT_L
#undef PG8_BAR
#undef PG8_SCHED
}
}

namespace att {
using bf16x8 = __attribute__((ext_vector_type(8))) short;
using s16x4  = __attribute__((ext_vector_type(4))) short;
using f32x16 = __attribute__((ext_vector_type(16))) float;
using u32x4  = __attribute__((ext_vector_type(4))) unsigned;
constexpr int NW = 8, QBLK = 32, KVBLK = 64, QROWS = 128;
constexpr float SCALE = 0.125f, QPRESCALE = SCALE * 1.4426950408889634f, THRL = 8.f;
constexpr int SHM_V = KVBLK * 128 * 2, SHM_K = KVBLK * 128 * 2, SHM_ATTN = 2 * SHM_V + 2 * SHM_K + NW * 64 * 4;
#define KSWZ(row, colB) ((row) * 256 + ((colB) ^ (((row) & 7) << 4)))
#define SBAR() __builtin_amdgcn_sched_barrier(0)
__device__ __forceinline__ int crow(int r, int hi) { return (r & 3) + 8 * (r >> 2) + 4 * hi; }
__device__ __forceinline__ unsigned cvtpk(float lo, float hi) { unsigned r; asm volatile("v_cvt_pk_bf16_f32 %0, %1, %2" : "=v"(r) : "v"(lo), "v"(hi)); return r; }
__device__ __forceinline__ void partialSM(f32x16& p0, f32x16& p1, float& mhat, f32x16& negm, float& alpha) {
  float a = fmaxf(fmaxf(p0[0], p0[1]), p1[0]), b2 = fmaxf(fmaxf(p0[2], p0[3]), p1[1]); a = fmaxf(fmaxf(a, p1[2]), p1[3]);
#pragma unroll
  for (int r = 4; r < 16; r += 4) { a = fmaxf(fmaxf(a, p0[r]), p0[r + 1]); b2 = fmaxf(fmaxf(b2, p0[r + 2]), p0[r + 3]); a = fmaxf(fmaxf(a, p1[r]), p1[r + 1]); b2 = fmaxf(fmaxf(b2, p1[r + 2]), p1[r + 3]); }
  float rm = fmaxf(a, b2);
  { auto rr = __builtin_amdgcn_permlane32_swap(__float_as_uint(rm), __float_as_uint(rm), false, false);
    rm = fmaxf(__uint_as_float(rr[0]), __uint_as_float(rr[1])); }
  alpha = 1.f;
  if (__builtin_expect(__any(rm > THRL), 0)) {
    const float dl = fmaxf(rm, 0.f); mhat += dl;
#pragma unroll
    for (int r = 0; r < 16; ++r) { p0[r] -= dl; p1[r] -= dl; }
#pragma unroll
    for (int r = 0; r < 16; ++r) negm[r] = -mhat;
    alpha = __builtin_amdgcn_exp2f(-dl);
  }
#pragma unroll
  for (int r = 0; r < 16; ++r) p0[r] = __builtin_amdgcn_exp2f(p0[r]);
}
__device__ __forceinline__ void finishSM(f32x16& p0, f32x16& p1, float alpha, float& l_reg, bf16x8& pa0, bf16x8& pa1, bf16x8& pa2, bf16x8& pa3) {
#pragma unroll
  for (int r = 0; r < 16; ++r) p1[r] = __builtin_amdgcn_exp2f(p1[r]);
  float ps = 0;
#pragma unroll
  for (int r = 0; r < 16; ++r) ps += p0[r];
#pragma unroll
  for (int r = 0; r < 16; ++r) ps += p1[r];
  { auto rr = __builtin_amdgcn_permlane32_swap(__float_as_uint(ps), __float_as_uint(ps), false, false);
    ps = __uint_as_float(rr[0]) + __uint_as_float(rr[1]); }
  l_reg = l_reg * alpha + ps;
#define PK4(P, BASE, OUT) do { unsigned a0 = cvtpk(P[BASE + 0], P[BASE + 1]), a1 = cvtpk(P[BASE + 2], P[BASE + 3]);   \
    unsigned b0 = cvtpk(P[BASE + 4], P[BASE + 5]), b1 = cvtpk(P[BASE + 6], P[BASE + 7]);                              \
    auto r0 = __builtin_amdgcn_permlane32_swap(a0, b0, false, false); auto r1 = __builtin_amdgcn_permlane32_swap(a1, b1, false, false); \
    u32x4 w = {r0[0], r1[0], r0[1], r1[1]}; OUT = *reinterpret_cast<bf16x8*>(&w); } while (0)
  PK4(p0, 0, pa0); PK4(p0, 8, pa1); PK4(p1, 0, pa2); PK4(p1, 8, pa3);
#undef PK4
}
__device__ __forceinline__ void qkt(f32x16& p0, f32x16& p1, const char* Ks, const bf16x8* qr, const f32x16& negm, int r32, int hi, int sub) {
#pragma unroll
  for (int d0 = 0; d0 < 4; ++d0) { const int cb = (sub * 64 + d0 * 16 + hi * 8) * 2;
    const bf16x8 b0 = *reinterpret_cast<const bf16x8*>(Ks + KSWZ(r32, cb));
    const bf16x8 b1 = *reinterpret_cast<const bf16x8*>(Ks + KSWZ(32 + r32, cb));
    if (d0 == 0) { p0 = __builtin_amdgcn_mfma_f32_32x32x16_bf16(b0, qr[0], negm, 0, 0, 0); p1 = __builtin_amdgcn_mfma_f32_32x32x16_bf16(b1, qr[0], negm, 0, 0, 0); }
    else { p0 = __builtin_amdgcn_mfma_f32_32x32x16_bf16(b0, qr[d0], p0, 0, 0, 0); p1 = __builtin_amdgcn_mfma_f32_32x32x16_bf16(b1, qr[d0], p1, 0, 0, 0); } }
}
__device__ __forceinline__ void qkt_lds(f32x16& p0, f32x16& p1, const char* Ks, const char* qrow  , float mh, int r32, int hi, int sub) {
#pragma unroll
  for (int r = 0; r < 16; ++r) { p0[r] = -mh; p1[r] = -mh; }
#pragma unroll
  for (int d0 = 0; d0 < 4; ++d0) { const int cb = (sub * 64 + d0 * 16 + hi * 8) * 2;
    const bf16x8 qf = *reinterpret_cast<const bf16x8*>(qrow + d0 * 32);
    const bf16x8 b0 = *reinterpret_cast<const bf16x8*>(Ks + KSWZ(r32, cb));
    const bf16x8 b1 = *reinterpret_cast<const bf16x8*>(Ks + KSWZ(32 + r32, cb));
    p0 = __builtin_amdgcn_mfma_f32_32x32x16_bf16(b0, qf, p0, 0, 0, 0);
    p1 = __builtin_amdgcn_mfma_f32_32x32x16_bf16(b1, qf, p1, 0, 0, 0); }
}
__device__ __forceinline__ void partialSM2(f32x16& p0, f32x16& p1, float& mhat, float& alpha) {
  float a = fmaxf(fmaxf(p0[0], p0[1]), p1[0]), b2 = fmaxf(fmaxf(p0[2], p0[3]), p1[1]); a = fmaxf(fmaxf(a, p1[2]), p1[3]);
#pragma unroll
  for (int r = 4; r < 16; r += 4) { a = fmaxf(fmaxf(a, p0[r]), p0[r + 1]); b2 = fmaxf(fmaxf(b2, p0[r + 2]), p0[r + 3]); a = fmaxf(fmaxf(a, p1[r]), p1[r + 1]); b2 = fmaxf(fmaxf(b2, p1[r + 2]), p1[r + 3]); }
  float rm = fmaxf(a, b2);
  { auto rr = __builtin_amdgcn_permlane32_swap(__float_as_uint(rm), __float_as_uint(rm), false, false);
    rm = fmaxf(__uint_as_float(rr[0]), __uint_as_float(rr[1])); }
  alpha = 1.f;
  if (__builtin_expect(__any(rm > THRL), 0)) {
    const float dl = fmaxf(rm, 0.f); mhat += dl;
#pragma unroll
    for (int r = 0; r < 16; ++r) { p0[r] -= dl; p1[r] -= dl; }
    alpha = __builtin_amdgcn_exp2f(-dl);
  }
#pragma unroll
  for (int r = 0; r < 16; ++r) p0[r] = __builtin_amdgcn_exp2f(p0[r]);
}
#define ATT_PK4(P, BASE, OUT) do { unsigned a0_ = cvtpk(P[BASE + 0], P[BASE + 1]), a1_ = cvtpk(P[BASE + 2], P[BASE + 3]);   \
    unsigned b0_ = cvtpk(P[BASE + 4], P[BASE + 5]), b1_ = cvtpk(P[BASE + 6], P[BASE + 7]);                              \
    auto r0_ = __builtin_amdgcn_permlane32_swap(a0_, b0_, false, false); auto r1_ = __builtin_amdgcn_permlane32_swap(a1_, b1_, false, false); \
    u32x4 w_ = {r0_[0], r1_[0], r0_[1], r1_[1]}; OUT = *reinterpret_cast<bf16x8*>(&w_); } while (0)
__device__ __forceinline__ void partialSM3(f32x16& p0, f32x16& p1, float& mhat, float& alpha, bf16x8& pa0, bf16x8& pa1, float& ps0) {
  float a = fmaxf(fmaxf(p0[0], p0[1]), p1[0]), b2 = fmaxf(fmaxf(p0[2], p0[3]), p1[1]); a = fmaxf(fmaxf(a, p1[2]), p1[3]);
#pragma unroll
  for (int r = 4; r < 16; r += 4) { a = fmaxf(fmaxf(a, p0[r]), p0[r + 1]); b2 = fmaxf(fmaxf(b2, p0[r + 2]), p0[r + 3]); a = fmaxf(fmaxf(a, p1[r]), p1[r + 1]); b2 = fmaxf(fmaxf(b2, p1[r + 2]), p1[r + 3]); }
  float rm = fmaxf(a, b2);
  { auto rr = __builtin_amdgcn_permlane32_swap(__float_as_uint(rm), __float_as_uint(rm), false, false);
    rm = fmaxf(__uint_as_float(rr[0]), __uint_as_float(rr[1])); }
  alpha = 1.f;
  if (__builtin_expect(__any(rm > THRL), 0)) {
    const float dl = fmaxf(rm, 0.f); mhat += dl;
#pragma unroll
    for (int r = 0; r < 16; ++r) { p0[r] -= dl; p1[r] -= dl; }
    alpha = __builtin_amdgcn_exp2f(-dl);
  }
  float s_ = 0.f;
#pragma unroll
  for (int r = 0; r < 16; ++r) { p0[r] = __builtin_amdgcn_exp2f(p0[r]); s_ += p0[r]; }
  ps0 = s_;
  ATT_PK4(p0, 0, pa0); ATT_PK4(p0, 8, pa1);
}
__device__ __forceinline__ void finishSM3(f32x16& p1, float alpha, float ps0, float& l_reg, bf16x8& pa2, bf16x8& pa3) {
#pragma unroll
  for (int r = 0; r < 16; ++r) p1[r] = __builtin_amdgcn_exp2f(p1[r]);
  float ps = ps0;
#pragma unroll
  for (int r = 0; r < 16; ++r) ps += p1[r];
  { auto rr = __builtin_amdgcn_permlane32_swap(__float_as_uint(ps), __float_as_uint(ps), false, false);
    ps = __uint_as_float(rr[0]) + __uint_as_float(rr[1]); }
  l_reg = l_reg * alpha + ps;
  ATT_PK4(p1, 0, pa2); ATT_PK4(p1, 8, pa3);
}
__device__ __forceinline__ int v_st(int k, int c) { const int kk = (k & ~0xC) | ((k & 4) << 1) | ((k & 8) >> 1); return ((kk >> 3) * 4 + (c >> 5)) * 512 + ((kk & 7) * 32 + (c & 31)) * 2; }
__device__ __forceinline__ int v_rd_base(int lane) { return ((lane & 3) << 3) | (((lane >> 2) & 3) << 6) | (((lane >> 4) & 1) << 5) | (((lane >> 5) & 1) << 8); }
constexpr int v_rd_off(int d0, int ks, int half) { return d0 * 512 + ks * 4096 + half * 2048; }
template <int OFF> __device__ __forceinline__ s16x4 tr_read(int vb) {
  s16x4 r; asm volatile("ds_read_b64_tr_b16 %0, %1 offset:%2" : "=&v"(r) : "v"(vb), "i"(OFF) : "memory"); return r;
}
template <int D0> __device__ __forceinline__ void pv_one(f32x16& od, int vb, bf16x8 pa0, bf16x8 pa1, bf16x8 pa2, bf16x8 pa3) {
  const s16x4 l0 = tr_read<v_rd_off(D0, 0, 0)>(vb), h0 = tr_read<v_rd_off(D0, 0, 1)>(vb), l1 = tr_read<v_rd_off(D0, 1, 0)>(vb), h1 = tr_read<v_rd_off(D0, 1, 1)>(vb);
  const s16x4 l2 = tr_read<v_rd_off(D0, 2, 0)>(vb), h2 = tr_read<v_rd_off(D0, 2, 1)>(vb), l3 = tr_read<v_rd_off(D0, 3, 0)>(vb), h3 = tr_read<v_rd_off(D0, 3, 1)>(vb);
  asm volatile("s_waitcnt lgkmcnt(0)" ::: "memory"); SBAR();
#define PK(L, H) (bf16x8){L[0], L[1], L[2], L[3], H[0], H[1], H[2], H[3]}
  od = __builtin_amdgcn_mfma_f32_32x32x16_bf16(pa0, PK(l0, h0), od, 0, 0, 0);
  od = __builtin_amdgcn_mfma_f32_32x32x16_bf16(pa1, PK(l1, h1), od, 0, 0, 0);
  od = __builtin_amdgcn_mfma_f32_32x32x16_bf16(pa2, PK(l2, h2), od, 0, 0, 0);
  od = __builtin_amdgcn_mfma_f32_32x32x16_bf16(pa3, PK(l3, h3), od, 0, 0, 0);
#undef PK
}
__device__ __forceinline__ void pv_d0(f32x16* o, int vb, bf16x8 pa0, bf16x8 pa1, bf16x8 pa2, bf16x8 pa3) {
  pv_one<0>(o[0], vb, pa0, pa1, pa2, pa3); pv_one<1>(o[1], vb, pa0, pa1, pa2, pa3); pv_one<2>(o[2], vb, pa0, pa1, pa2, pa3); pv_one<3>(o[3], vb, pa0, pa1, pa2, pa3);
}
__device__ __forceinline__ long ktile_row(int b, int t) { return t < 4 ? (long)(NLAT + b * CTXL + 64 * t) : (long)(b * SEQ + 64 * (t - 4)); }

constexpr int QROWS2 = 256, QT_ROWB = 272, QT_OFF = 2 * SHM_V + 2 * SHM_K + NW * 64 * 4, SHM_ATTN2 = QT_OFF + NW * 32 * QT_ROWB;
static_assert(SHM_ATTN2 <= LDS_PHASE_BYTES, "attention LDS map");
__device__ __forceinline__ void attn_unit2(const bf16_t* __restrict__ Pm, bf16_t* __restrict__ Y, long qrow0, int b, int hh, int NT, float lam, float lam_init,
                                           const float* __restrict__ subln, char* lds) {
  const int tid = opaque_tid(), wid = __builtin_amdgcn_readfirstlane(tid >> 6), lane = tid & 63, r32 = lane & 31, hi = lane >> 5;
  char* V_lds = lds; char* K_lds = lds + 2 * SHM_V;
  float* ws = (float*)(lds + 2 * SHM_V + 2 * SHM_K) + wid * 64; float* li_l = ws; float* al_l = ws + 32;
  char* qt = lds + QT_OFF + wid * (32 * QT_ROWB);
  const long wrow0 = qrow0 + wid * QBLK;
#pragma unroll
  for (int c8 = 0; c8 < 8; ++c8) { const int row = c8 * 4 + (lane >> 4), ch = lane & 15;
    *(uint4*)(qt + row * QT_ROWB + ch * 16) = *(const uint4*)(Pm + (wrow0 + row) * NP + C_QA + hh * 128 + ch * 8); }
  float mh0 = 0.f, mh1 = 0.f, l0 = 0.f, l1 = 0.f; f32x16 o0[4] = {}, o1[4] = {};
  const int vb0 = (int)(uintptr_t)V_lds + v_rd_base(lane);
  const unsigned ldsb = (unsigned)(uintptr_t)lds + (unsigned)(wid * 2048);
#define SDMA(t, bb) do { const char* tb_ = (const char*)(Pm + ktile_row(b, (t)) * NP + hh * 128); int ln_ = lane; asm volatile("" : "+v"(ln_)); \
    _Pragma("unroll") for (int i2 = 0; i2 < 2; ++i2) { const int sl = (wid * 2 + i2) * 64 + ln_; \
      const int krow = sl >> 4, kch = (sl & 15) ^ (krow & 7); const int kof = (krow * NP + C_KA + kch * 8) * 2; \
      const int kk = (sl >> 7) * 8 + ((sl & 31) >> 2), vc = ((sl >> 5) & 3) * 32 + (sl & 3) * 8, vk = (kk & ~0xC) | ((kk & 4) << 1) | ((kk & 8) >> 1); const int vof = (vk * NP + C_VA + vc) * 2; \
    __builtin_amdgcn_global_load_lds((const unsigned*)(tb_ + vof), (__attribute__((address_space(3))) unsigned*)(ldsb + (unsigned)((bb) * SHM_V + i2 * 1024)), 16, 0, 0); \
    __builtin_amdgcn_global_load_lds((const unsigned*)(tb_ + kof), (__attribute__((address_space(3))) unsigned*)(ldsb + (unsigned)(2 * SHM_V + (bb) * SHM_K + i2 * 1024)), 16, 0, 0); } } while (0)
#define RESC(o, a) do { if (__any((a) < 1.f)) { if (hi == 0) al_l[r32] = (a); asm volatile("s_waitcnt lgkmcnt(0)" ::: "memory"); \
    _Pragma("unroll") for (int r = 0; r < 16; ++r) { const float f_ = al_l[crow(r, hi)]; _Pragma("unroll") for (int d = 0; d < 4; ++d) o[d][r] *= f_; asm volatile("" ::: "memory"); } } } while (0)
  f32x16 pA1, pB1; float alA, alB, psA, psB; bf16x8 aA0, aA1, aB0, aB1, pa2, pa3;
  const char* qA = qt + r32 * QT_ROWB + (hi * 8) * 2; const char* qB = qA + 128;
  SDMA(0, 0); asm volatile("s_waitcnt vmcnt(0)" ::: "memory"); __syncthreads();
  { f32x16 t0; SBAR(); qkt_lds(t0, pA1, K_lds, qA, mh0, r32, hi, 0); partialSM3(t0, pA1, mh0, alA, aA0, aA1, psA); SBAR(); }
  if (1 < NT) SDMA(1, 1);
  { f32x16 t0; SBAR(); qkt_lds(t0, pB1, K_lds, qB, mh1, r32, hi, 1); finishSM3(pA1, alA, psA, l0, pa2, pa3); SBAR();
    pv_d0(o0, vb0, aA0, aA1, pa2, pa3); partialSM3(t0, pB1, mh1, alB, aB0, aB1, psB); SBAR(); }
  asm volatile("s_waitcnt vmcnt(0)" ::: "memory"); __syncthreads();
  for (int t = 1; t < NT; ++t) {
    const int cur = t & 1, prev = cur ^ 1;
    { f32x16 t0; SBAR(); qkt_lds(t0, pA1, K_lds + cur * SHM_K, qA, mh0, r32, hi, 0); RESC(o1, alB); finishSM3(pB1, alB, psB, l1, pa2, pa3); SBAR();
      pv_d0(o1, vb0 + prev * SHM_V, aB0, aB1, pa2, pa3); partialSM3(t0, pA1, mh0, alA, aA0, aA1, psA); SBAR(); }
    __syncthreads();
    if (t + 1 < NT) SDMA(t + 1, prev);
    RESC(o0, alA);
    { f32x16 t0; SBAR(); qkt_lds(t0, pB1, K_lds + cur * SHM_K, qB, mh1, r32, hi, 1); finishSM3(pA1, alA, psA, l0, pa2, pa3); SBAR();
      pv_d0(o0, vb0 + cur * SHM_V, aA0, aA1, pa2, pa3); partialSM3(t0, pB1, mh1, alB, aB0, aB1, psB); SBAR(); }
    asm volatile("s_waitcnt vmcnt(0)" ::: "memory"); __syncthreads();
  }
  RESC(o1, alB); finishSM3(pB1, alB, psB, l1, pa2, pa3); SBAR();
  pv_d0(o1, vb0 + ((NT - 1) & 1) * SHM_V, aB0, aB1, pa2, pa3);
  if (hi == 0) { li_l[r32] = l0; al_l[r32] = l1; } asm volatile("s_waitcnt lgkmcnt(0)" ::: "memory");
#pragma unroll
  for (int c8 = 0; c8 < 8; ++c8) { const int row = c8 * 4 + (lane >> 4), ch = lane & 15;
    *(uint4*)(qt + row * QT_ROWB + ch * 16) = *(const uint4*)(Pm + (wrow0 + row) * NP + C_GA + hh * 128 + ch * 8); }
  float ss[16];
#pragma unroll
  for (int r = 0; r < 16; ++r) { const float ra = __builtin_amdgcn_rcpf(li_l[crow(r, hi)]), rb = lam * __builtin_amdgcn_rcpf(al_l[crow(r, hi)]); float a = 0.f;
#pragma unroll
    for (int d0 = 0; d0 < 4; ++d0) { o0[d0][r] = o0[d0][r] * ra - o1[d0][r] * rb; a += o0[d0][r] * o0[d0][r]; }
    ss[r] = a; }
#pragma unroll
  for (int r = 0; r < 16; ++r) {
    ss[r] = rsqrtf(half_sum(ss[r], hi) * (1.f / 128.f) + EPS) * (1.f - lam_init);
  }
  float sw[4];
#pragma unroll
  for (int d0 = 0; d0 < 4; ++d0) sw[d0] = subln[d0 * 32 + r32];
  asm volatile("s_waitcnt vmcnt(0) lgkmcnt(0)" ::: "memory");
#pragma unroll
  for (int r = 0; r < 16; ++r) { bf16_t* tp = (bf16_t*)(qt + crow(r, hi) * QT_ROWB) + r32;
#pragma unroll
    for (int d0 = 0; d0 < 4; ++d0) { const float g = bf2f(tp[d0 * 32]); tp[d0 * 32] = f2bf(o0[d0][r] * ss[r] * sw[d0] * (g / (1.f + __expf(-g)))); } }
  asm volatile("s_waitcnt lgkmcnt(0)" ::: "memory");
#pragma unroll
  for (int c8 = 0; c8 < 8; ++c8) { const int row = c8 * 4 + (lane >> 4), ch = lane & 15;
    *(uint4*)(Y + (wrow0 + row) * DM + hh * 128 + ch * 8) = *(const uint4*)(qt + row * QT_ROWB + ch * 16); }
  asm volatile("s_waitcnt lgkmcnt(0)" ::: "memory");
#undef SDMA
#undef RESC
}
__device__ __forceinline__ void attn_phase(const bf16_t* __restrict__ Pm, bf16_t* __restrict__ Y, const float* lq1, const float* lk1, const float* lq2, const float* lk2,
                                           const float* __restrict__ subln, float lam_init, bool ctx_out, unsigned* qcnt  ,
                                           volatile __attribute__((address_space(3))) unsigned* bcast, char* lds) {
  const int tid = opaque_tid(), lane = tid & 63;
  const float lam = rl_f(expf(wave_sum(lq1[lane] * lk1[lane])) - expf(wave_sum(lq2[lane] * lk2[lane])) + lam_init, 0);
  const int G = gridDim.x, bx = blockIdx.x; const int vcu = (G % 8 == 0) ? (bx % 8) * (G / 8) + bx / 8 : bx;
  const int g0 = (G == 256) ? (vcu >> 5) : (bx & 7);
  const int nun = 64 + (ctx_out ? 8 : 0);
  for (int gi = 0; gi < 8; ++gi) {
    const int g = (g0 + gi) & 7;
    for (;;) {
      if (tid == 0) bcast[0] = __hip_atomic_fetch_add(qcnt + 64 * g, 1u, __ATOMIC_RELAXED, __HIP_MEMORY_SCOPE_AGENT);
      __syncthreads();
      const int u = (int)bcast[0];
      __syncthreads();
      if (u >= nun) break;
      if (u < 64) { const int bh = g * 8 + (u >> 3), qb = u & 7, b = bh >> 3, hh = bh & 7; attn_unit2(Pm, Y, (long)b * SEQ + qb * QROWS2, b, hh, 36, lam, lam_init, subln, lds); }
      else { const int bh = g * 8 + (u - 64), b = bh >> 3, hh = bh & 7; attn_unit2(Pm, Y, (long)NLAT + b * CTXL, b, hh, 4, lam, lam_init, subln, lds); }
    }
  }
}
#undef KSWZ
#undef SBAR
}

namespace mls {
using bf16x8 = __attribute__((ext_vector_type(8))) short;
using s16x4  = __attribute__((ext_vector_type(4))) short;
using f32x4  = __attribute__((ext_vector_type(4))) float;
constexpr int QSTRB = 272, SSTRB = 144;
constexpr int VSTRB = 528;
constexpr int L_Q = 0, L_K = L_Q + 64 * QSTRB, L_V = L_K + 64 * QSTRB, L_S = L_V + 64 * VSTRB, L_CT = L_S + 64 * SSTRB, L_SM = L_CT + 256 * QSTRB, L_END = L_SM + 8192;
static_assert(L_END <= LDS_PHASE_BYTES && (L_K % 16) == 0 && (L_V % 16) == 0 && (L_S % 16) == 0 && (L_CT % 16) == 0 && (L_SM % 16) == 0, "mlstm LDS map");
__device__ __forceinline__ f32x4 mfma16(bf16x8 a, bf16x8 b, f32x4 c) { return __builtin_amdgcn_mfma_f32_16x16x32_bf16(a, b, c, 0, 0, 0); }
struct TrPair { s16x4 lo, hi; };
__device__ __forceinline__ TrPair tr_issue(unsigned addr, int rsb) {
  TrPair t;
  asm volatile("ds_read_b64_tr_b16 %0, %1" : "=&v"(t.lo) : "v"(addr) : "memory");
  asm volatile("ds_read_b64_tr_b16 %0, %1" : "=&v"(t.hi) : "v"(addr + 4u * (unsigned)rsb) : "memory");
  return t;
}
__device__ __forceinline__ bf16x8 tr_pack(const TrPair& t) { return (bf16x8){t.lo[0], t.lo[1], t.lo[2], t.lo[3], t.hi[0], t.hi[1], t.hi[2], t.hi[3]}; }
#define TR_PIN(t) asm volatile("" : "+v"((t).lo), "+v"((t).hi))
__device__ __forceinline__ float wave_scan_incl(float v) {
  v += __builtin_bit_cast(float, __builtin_amdgcn_update_dpp(0, __builtin_bit_cast(int, v), 0x111, 0xF, 0xF, false));
  v += __builtin_bit_cast(float, __builtin_amdgcn_update_dpp(0, __builtin_bit_cast(int, v), 0x112, 0xF, 0xF, false));
  v += __builtin_bit_cast(float, __builtin_amdgcn_update_dpp(0, __builtin_bit_cast(int, v), 0x114, 0xF, 0xF, false));
  v += __builtin_bit_cast(float, __builtin_amdgcn_update_dpp(0, __builtin_bit_cast(int, v), 0x118, 0xF, 0xF, false));
  v += __builtin_bit_cast(float, __builtin_amdgcn_update_dpp(0, __builtin_bit_cast(int, v), 0x142, 0xA, 0xF, false));
  v += __builtin_bit_cast(float, __builtin_amdgcn_update_dpp(0, __builtin_bit_cast(int, v), 0x143, 0xC, 0xF, false));
  return v;
}
__device__ __forceinline__ float fast_tanh(float x) { return 1.f - 2.f * __builtin_amdgcn_rcpf(1.f + __expf(2.f * x)); }

__device__ __forceinline__ void tr_v4(unsigned base, TrPair& a0, TrPair& a1, TrPair& b0, TrPair& b1, TrPair& c0, TrPair& c1, TrPair& d0, TrPair& d1) {
  asm volatile(
    "ds_read_b64_tr_b16 %0, %16\n\tds_read_b64_tr_b16 %1, %16 offset:2112\n\tds_read_b64_tr_b16 %2, %16 offset:16896\n\tds_read_b64_tr_b16 %3, %16 offset:19008\n\t"
    "ds_read_b64_tr_b16 %4, %16 offset:32\n\tds_read_b64_tr_b16 %5, %16 offset:2144\n\tds_read_b64_tr_b16 %6, %16 offset:16928\n\tds_read_b64_tr_b16 %7, %16 offset:19040\n\t"
    "ds_read_b64_tr_b16 %8, %16 offset:64\n\tds_read_b64_tr_b16 %9, %16 offset:2176\n\tds_read_b64_tr_b16 %10, %16 offset:16960\n\tds_read_b64_tr_b16 %11, %16 offset:19072\n\t"
    "ds_read_b64_tr_b16 %12, %16 offset:96\n\tds_read_b64_tr_b16 %13, %16 offset:2208\n\tds_read_b64_tr_b16 %14, %16 offset:16992\n\tds_read_b64_tr_b16 %15, %16 offset:19104\n\t"
    "s_waitcnt lgkmcnt(0)"
    : "=&v"(a0.lo), "=&v"(a0.hi), "=&v"(a1.lo), "=&v"(a1.hi), "=&v"(b0.lo), "=&v"(b0.hi), "=&v"(b1.lo), "=&v"(b1.hi),
      "=&v"(c0.lo), "=&v"(c0.hi), "=&v"(c1.lo), "=&v"(c1.hi), "=&v"(d0.lo), "=&v"(d0.hi), "=&v"(d1.lo), "=&v"(d1.hi)
    : "v"(base) : "memory");
}
__device__ __forceinline__ bf16x8 scale_frag(const TrPair& t, const float4 wa, const float4 wb) {
  const float f0 = bf2f((bf16_t)t.lo[0]) * wa.x, f1 = bf2f((bf16_t)t.lo[1]) * wa.y, f2 = bf2f((bf16_t)t.lo[2]) * wa.z, f3 = bf2f((bf16_t)t.lo[3]) * wa.w;
  const float f4 = bf2f((bf16_t)t.hi[0]) * wb.x, f5 = bf2f((bf16_t)t.hi[1]) * wb.y, f6 = bf2f((bf16_t)t.hi[2]) * wb.z, f7 = bf2f((bf16_t)t.hi[3]) * wb.w;
  return __builtin_bit_cast(bf16x8, make_uint4(pk2(f0, f1), pk2(f2, f3), pk2(f4, f5), pk2(f6, f7)));
}

__device__ __forceinline__ void mlstm_unit(const bf16_t* __restrict__ Pm, const bf16_t* __restrict__ QKC  , const float* __restrict__ GATES,
                                           bf16_t* __restrict__ HM, const float* __restrict__ i_bias, const float* __restrict__ f_bias,
                                           int b, int head, int dir, bool ctx_out, char* lds) {
  const int tid = opaque_tid(), wid = __builtin_amdgcn_readfirstlane(tid >> 6), lane = tid & 63, lr = lane & 15, kg = lane >> 4;
  char* q_lds = lds + L_Q; char* k_lds = lds + L_K; char* v_lds = lds + L_V; char* s_lds = lds + L_S; char* ct_lds = lds + L_CT;
  float* bl = (float*)(lds + L_SM); float* bsp = bl + 64; float* av = bsp + 64; float* wkl = av + 64; float* qn = wkl + 64; float* nvec = qn + 64; float* rs = nvec + 128; float* npart = rs + 1024;
  const unsigned lds0 = (unsigned)(uintptr_t)lds;
  const unsigned trq = (unsigned)((8 * kg + (lr >> 2)) * QSTRB + (4 * (lr & 3)) * 2), trv = (unsigned)((8 * kg + (lr >> 2)) * VSTRB + (4 * (lr & 3)) * 2);
  if (tid < 128) nvec[tid] = 0.f;
  const float ibias = i_bias[dir * 4 + head], fbias = f_bias[dir * 4 + head];
  const int chg = tid & 31, rg = tid >> 5; const bool isk = chg >= 16;
  const int qkcol = 1024 + (isk ? 512 : 0) + head * 128 + (chg & 15) * 8;
  const int vrow = tid >> 3, vch = tid & 7;
  uint4 pq0, pq1, pq2, pq3, pv0, pv1, pv2, pv3; float pgi, pgf;
#define MLS_LOAD(c_) do { const int c__ = (c_); const bool ic_ = c__ < 4; const int T_ = ic_ ? CTXL : SEQ, cc_ = ic_ ? c__ : c__ - 4; \
    const long rb_ = ic_ ? (long)(NLAT + b * CTXL) : (long)b * SEQ; const int t0_ = dir ? (T_ - 64 * (cc_ + 1)) : 64 * cc_; \
    { const bf16_t* qp_ = QKC + (rb_ + t0_ + rg) * DM + qkcol; pq0 = *(const uint4*)qp_; pq1 = *(const uint4*)(qp_ + 16 * DM); pq2 = *(const uint4*)(qp_ + 32 * DM); pq3 = *(const uint4*)(qp_ + 48 * DM); } \
    { const uint4* vp_ = (const uint4*)(Pm + (rb_ + t0_ + vrow) * NP + C_VB + head * 256 + vch * 32); pv0 = vp_[0]; pv1 = vp_[1]; pv2 = vp_[2]; pv3 = vp_[3]; } \
    const float* gr_ = GATES + (rb_ + t0_ + (dir ? 63 - lane : lane)) * 16; pgi = gr_[dir * 4 + head]; pgf = gr_[8 + dir * 4 + head]; } while (0)
  MLS_LOAD(0);
  f32x4 Cacc[16];
#pragma unroll
  for (int e = 0; e < 16; ++e) Cacc[e] = (f32x4){0.f, 0.f, 0.f, 0.f};
  float gprev = 0.f;
  __syncthreads();
  for (int c = 0; c < 36; ++c) {
    const bool isctx = c < 4; const int T = isctx ? CTXL : SEQ, cc = isctx ? c : c - 4;
    const long rowbase = isctx ? (long)(NLAT + b * CTXL) : (long)b * SEQ;
    const int t0 = dir ? (T - 64 * (cc + 1)) : 64 * cc;
    const bool need_h = ctx_out || !isctx;
    float gamma, wk_l;
    {
      const float igv = 15.f * fast_tanh((pgi + ibias) * (1.f / 15.f));
      const float fc = 15.f * fast_tanh((pgf + fbias) * (1.f / 15.f));
      const float lfv = fminf(fc, 0.f) - __logf(1.f + __expf(-fabsf(fc)));
      const float bcum = wave_scan_incl(lfv);
      const float b63 = __builtin_bit_cast(float, __builtin_amdgcn_readlane(__builtin_bit_cast(int, bcum), 63));
      gamma = __expf(b63); wk_l = __expf(b63 - bcum + igv);
      if (wid == 0) { bl[lane] = bcum; bsp[lane] = bcum - igv; av[lane] = __expf(bcum); wkl[lane] = wk_l; }
      if (c > 0 && tid < 128) nvec[tid] = gprev * nvec[tid] + (npart[tid] + npart[128 + tid]) + (npart[256 + tid] + npart[384 + tid]);
    }
#pragma unroll
    for (int eblk = 0; eblk < 16; ++eblk) { uint2 w_; w_.x = pk2(Cacc[eblk][0], Cacc[eblk][1]); w_.y = pk2(Cacc[eblk][2], Cacc[eblk][3]);
      *(uint2*)(ct_lds + (eblk * 16 + lr) * QSTRB + (wid * 16 + 4 * kg) * 2) = w_; }
    { char* dst = (isk ? k_lds : q_lds) + (chg & 15) * 16;
      *(uint4*)(dst + (dir ? 63 - rg : rg) * QSTRB) = pq0; *(uint4*)(dst + (dir ? 47 - rg : rg + 16) * QSTRB) = pq1;
      *(uint4*)(dst + (dir ? 31 - rg : rg + 32) * QSTRB) = pq2; *(uint4*)(dst + (dir ? 15 - rg : rg + 48) * QSTRB) = pq3; }
    { char* dst = v_lds + (dir ? 63 - vrow : vrow) * VSTRB + vch * 64;
      *(uint4*)dst = pv0; *(uint4*)(dst + 16) = pv1; *(uint4*)(dst + 32) = pv2; *(uint4*)(dst + 48) = pv3; }
    if (c + 1 < 36) MLS_LOAD(c + 1);
    __syncthreads();
    if (need_h) {
      const int lblk = wid >> 1;
#pragma unroll
      for (int u2 = 0; u2 < 2; ++u2) {
        const int sblk = 2 * (wid & 1) + u2;
        if (sblk <= lblk) {
          f32x4 acc = {0.f, 0.f, 0.f, 0.f};
#pragma unroll
          for (int ks = 0; ks < 4; ++ks) {
            const bf16x8 ka = *(const bf16x8*)(k_lds + (sblk * 16 + lr) * QSTRB + (ks * 32 + 8 * kg) * 2);
            const bf16x8 qb = *(const bf16x8*)(q_lds + (lblk * 16 + lr) * QSTRB + (ks * 32 + 8 * kg) * 2);
            acc = mfma16(ka, qb, acc);
          }
          const int l = lblk * 16 + lr; const float blv = bl[l];
          float v4[4]; float sum = 0.f;
#pragma unroll
          for (int r = 0; r < 4; ++r) { const int sidx = sblk * 16 + 4 * kg + r; const float w = (sidx <= l) ? __expf(blv - bsp[sidx]) : 0.f; v4[r] = acc[r] * w; sum += v4[r]; }
          uint2 w; w.x = pk2(v4[0], v4[1]); w.y = pk2(v4[2], v4[3]);
          *(uint2*)(s_lds + l * SSTRB + (sblk * 16 + 4 * kg) * 2) = w;
          rs[(sblk * 4 + kg) * 64 + l] = sum;
        } else if ((lblk == 0 && sblk == 1) || (lblk == 2 && sblk == 3)) {
          uint2 z_; z_.x = 0u; z_.y = 0u; asm volatile("" : "+v"(z_.x), "+v"(z_.y));
          *(uint2*)(s_lds + (lblk * 16 + lr) * SSTRB + (sblk * 16 + 4 * kg) * 2) = z_;
        }
      }
      { const int l = tid >> 3, part = tid & 7; float a = 0.f;
        const unsigned* qp = (const unsigned*)(q_lds + l * QSTRB + part * 32);
#pragma unroll
        for (int i = 0; i < 8; ++i) { const unsigned wd = qp[i]; a += __uint_as_float(wd << 16) * nvec[part * 16 + 2 * i] + __uint_as_float(wd & 0xffff0000u) * nvec[part * 16 + 2 * i + 1]; }
        a += __builtin_bit_cast(float, __builtin_amdgcn_update_dpp(0, __builtin_bit_cast(int, a), 0xB1, 0xF, 0xF, false));
        a += __builtin_bit_cast(float, __builtin_amdgcn_update_dpp(0, __builtin_bit_cast(int, a), 0x4E, 0xF, 0xF, false));
        a += __builtin_bit_cast(float, __builtin_amdgcn_update_dpp(0, __builtin_bit_cast(int, a), 0x141, 0xF, 0xF, false));
        if (part == 0) qn[l] = a; }
    }
    __syncthreads();
    if (need_h) {
      const int lblk = wid >> 1, l = lblk * 16 + lr, eh = wid & 1;
      float d = av[l] * qn[l];
      for (int sb = 0; sb <= lblk; ++sb) d += (rs[(sb * 4 + 0) * 64 + l] + rs[(sb * 4 + 1) * 64 + l]) + (rs[(sb * 4 + 2) * 64 + l] + rs[(sb * 4 + 3) * 64 + l]);
      const float a_l = av[l], dinv = 1.f / fmaxf(fabsf(d), 1.f);
      bf16x8 qb[4];
#pragma unroll
      for (int ks = 0; ks < 4; ++ks) qb[ks] = *(const bf16x8*)(q_lds + l * QSTRB + (ks * 32 + 8 * kg) * 2);
      const bf16x8 sb0 = *(const bf16x8*)(s_lds + l * SSTRB + (8 * kg) * 2);
      bf16x8 sb1 = sb0; if (lblk >= 2) sb1 = *(const bf16x8*)(s_lds + l * SSTRB + (32 + 8 * kg) * 2);
      const int t = dir ? (t0 + 63 - l) : (t0 + l);
      bf16_t* hp = HM + ((size_t)dir * NTOK + rowbase + t) * 1024 + head * 256 + eh * 128 + 4 * kg;
#pragma unroll
      for (int half = 0; half < 2; ++half) {
        TrPair a0, a1, b0, b1, c0, c1, d0, d1;
        tr_v4(lds0 + L_V + trv + (unsigned)((eh * 8 + half * 4) * 32), a0, a1, b0, b1, c0, c1, d0, d1);
        __builtin_amdgcn_sched_barrier(0);
#define MLS_HTILE(ti, VA0, VA1) do { const int eblk = eh * 8 + half * 4 + (ti); f32x4 acc1 = {0.f, 0.f, 0.f, 0.f}, acc2 = {0.f, 0.f, 0.f, 0.f}; \
          _Pragma("unroll") for (int ks = 0; ks < 4; ++ks) { const bf16x8 ca = *(const bf16x8*)(ct_lds + (eblk * 16 + lr) * QSTRB + (ks * 32 + 8 * kg) * 2); acc1 = mfma16(ca, qb[ks], acc1); } \
          acc2 = mfma16(tr_pack(VA0), sb0, acc2); if (lblk >= 2) acc2 = mfma16(tr_pack(VA1), sb1, acc2); \
          uint2 w_; w_.x = pk2((a_l * acc1[0] + acc2[0]) * dinv, (a_l * acc1[1] + acc2[1]) * dinv); w_.y = pk2((a_l * acc1[2] + acc2[2]) * dinv, (a_l * acc1[3] + acc2[3]) * dinv); \
          *(uint2*)(hp + (half * 4 + (ti)) * 16) = w_; } while (0)
        MLS_HTILE(0, a0, a1); MLS_HTILE(1, b0, b1); MLS_HTILE(2, c0, c1); MLS_HTILE(3, d0, d1);
#undef MLS_HTILE
      }
    }
    {
      bf16x8 kA0, kA1;
      { TrPair ka0, ka1; const unsigned ak = lds0 + L_K + trq + (unsigned)(wid * 32);
        asm volatile("ds_read_b64_tr_b16 %0, %4\n\tds_read_b64_tr_b16 %1, %4 offset:1088\n\tds_read_b64_tr_b16 %2, %4 offset:8704\n\tds_read_b64_tr_b16 %3, %4 offset:9792\n\ts_waitcnt lgkmcnt(0)"
                     : "=&v"(ka0.lo), "=&v"(ka0.hi), "=&v"(ka1.lo), "=&v"(ka1.hi) : "v"(ak) : "memory");
        const float4 w0 = *(const float4*)(wkl + 8 * kg), w1 = *(const float4*)(wkl + 8 * kg + 4), w2 = *(const float4*)(wkl + 32 + 8 * kg), w3 = *(const float4*)(wkl + 36 + 8 * kg);
        kA0 = scale_frag(ka0, w0, w1); kA1 = scale_frag(ka1, w2, w3); }
#pragma unroll
      for (int q4 = 0; q4 < 4; ++q4) {
        TrPair a0, a1, b0, b1, c0, c1, d0, d1;
        tr_v4(lds0 + L_V + trv + (unsigned)(q4 * 128), a0, a1, b0, b1, c0, c1, d0, d1);
        __builtin_amdgcn_sched_barrier(0);
#define MLS_CUPD(ti, V0, V1) do { f32x4 cc_ = Cacc[q4 * 4 + (ti)] * gamma; cc_ = mfma16(kA0, tr_pack(V0), cc_); cc_ = mfma16(kA1, tr_pack(V1), cc_); Cacc[q4 * 4 + (ti)] = cc_; } while (0)
        MLS_CUPD(0, a0, a1); MLS_CUPD(1, b0, b1); MLS_CUPD(2, c0, c1); MLS_CUPD(3, d0, d1);
#undef MLS_CUPD
      }
      { const int dd = tid & 127, sq = tid >> 7; float a = 0.f; const bf16_t* kp = (const bf16_t*)k_lds + (sq * 16) * (QSTRB / 2) + dd;
#pragma unroll
        for (int si = 0; si < 16; ++si) a += bf2f(kp[si * (QSTRB / 2)]) * wkl[sq * 16 + si];
        npart[sq * 128 + dd] = a; }
      gprev = gamma;
    }
    __syncthreads();
  }
#undef MLS_LOAD
}
__device__ __forceinline__ void qkconv_phase(const bf16_t* __restrict__ Pm, bf16_t* __restrict__ QKC, const float* __restrict__ conv_w, const float* __restrict__ conv_b) {
  const int tid = opaque_tid(), lane = tid & 63, wave = tid >> 6;
  const int gw = blockIdx.x * 8 + wave, ngw = gridDim.x * 8;
  const int half = gw & 1, c0 = half * 512 + lane * 8;
  float cw0[8], cw1[8], cw2[8], cbv[8];
#pragma unroll
  for (int i = 0; i < 8; ++i) { cw0[i] = conv_w[c0 + i]; cw1[i] = conv_w[1024 + c0 + i]; cw2[i] = conv_w[2048 + c0 + i]; cbv[i] = conv_b[c0 + i]; }
  const float osc = half ? 0.08838834764831845f : 1.f;
  for (int it = gw >> 1; it < NTOK / 8; it += ngw >> 1) {
    const int r0 = it * 8; const bool isl = r0 < NLAT; const int seq0 = isl ? (r0 / SEQ) * SEQ : NLAT + ((r0 - NLAT) / CTXL) * CTXL, T = isl ? SEQ : CTXL;
    uint4 x[10];
#pragma unroll
    for (int r = 0; r < 10; ++r) { const int t = r0 - seq0 - 1 + r; x[r] = (t >= 0 && t < T) ? *(const uint4*)(Pm + (size_t)(seq0 + t) * NP + C_QB + c0) : make_uint4(0u, 0u, 0u, 0u); }
#pragma unroll
    for (int r = 0; r < 8; ++r) {
      const unsigned a0[4] = {x[r].x, x[r].y, x[r].z, x[r].w}, a1[4] = {x[r + 1].x, x[r + 1].y, x[r + 1].z, x[r + 1].w}, a2[4] = {x[r + 2].x, x[r + 2].y, x[r + 2].z, x[r + 2].w};
      float o[8];
#pragma unroll
      for (int i = 0; i < 8; ++i) {
        const float v0 = (i & 1) ? __uint_as_float(a0[i >> 1] & 0xffff0000u) : __uint_as_float(a0[i >> 1] << 16);
        const float v1 = (i & 1) ? __uint_as_float(a1[i >> 1] & 0xffff0000u) : __uint_as_float(a1[i >> 1] << 16);
        const float v2 = (i & 1) ? __uint_as_float(a2[i >> 1] & 0xffff0000u) : __uint_as_float(a2[i >> 1] << 16);
        const float z = cbv[i] + cw0[i] * v0 + cw1[i] * v1 + cw2[i] * v2;
        o[i] = osc * z / (1.f + __expf(-z));
      }
      uint4 w; w.x = pk2(o[0], o[1]); w.y = pk2(o[2], o[3]); w.z = pk2(o[4], o[5]); w.w = pk2(o[6], o[7]);
      *(uint4*)(QKC + (size_t)(r0 + r) * DM + 1024 + c0) = w;
    }
  }
}
__device__ __forceinline__ void mlstm_phase(const bf16_t* __restrict__ Pm, const bf16_t* __restrict__ QKC, const float* __restrict__ GATES, bf16_t* __restrict__ HM,
                                            const float* __restrict__ i_bias, const float* __restrict__ f_bias, bool ctx_out, char* lds) {
  const int G = gridDim.x, bx = blockIdx.x;
  if (G == 256) { const int vcu = (bx % 8) * 32 + bx / 8; if ((vcu & 31) < 8) { const int u = (vcu >> 5) * 8 + (vcu & 31); mlstm_unit(Pm, QKC, GATES, HM, i_bias, f_bias, u >> 3, (u >> 1) & 3, u & 1, ctx_out, lds); } }
  else for (int u = bx; u < 64; u += G) mlstm_unit(Pm, QKC, GATES, HM, i_bias, f_bias, u >> 3, (u >> 1) & 3, u & 1, ctx_out, lds);
}
}

DEVI void mod_unit(int unit, const float* __restrict__ c, const float* __restrict__ c_ctx, const float* __restrict__ w_ada, const float* __restrict__ b_ada, float* __restrict__ MOD, float* ldsf) {
    const int tid = opaque_tid(), ci = tid & 63, kgp = tid >> 6;
    const int l = unit / 96, cb = unit % 96;
    float* sc = ldsf; float* red = ldsf + 9 * DM;
    for (int i = tid; i < 9 * DM; i += 512) { const float v = (i < 8 * DM) ? c[i] : c_ctx[i - 8 * DM]; sc[i] = silu_f(v); }
    __syncthreads();
    float acc[9];
#pragma unroll
    for (int r = 0; r < 9; ++r) acc[r] = 0.f;
    const float* w = w_ada + (size_t)l * DM * MODW + cb * 64 + ci;
#pragma unroll 32
    for (int k = kgp * 256; k < kgp * 256 + 256; ++k) {
        const float wv = w[(size_t)k * MODW];
#pragma unroll
        for (int r = 0; r < 9; ++r) acc[r] += sc[r * DM + k] * wv;
    }
#pragma unroll
    for (int r = 0; r < 9; ++r) red[(kgp * 9 + r) * 64 + ci] = acc[r];
    __syncthreads();
    for (int idx = tid; idx < 9 * 64; idx += 512) {
        const int r = idx >> 6, cc = idx & 63; float s = 0.f;
#pragma unroll
        for (int g = 0; g < 8; ++g) s += red[(g * 9 + r) * 64 + cc];
        MOD[(size_t)(l * 9 + r) * MODW + cb * 64 + cc] = s + b_ada[l * MODW + cb * 64 + cc];
    }
    __syncthreads();
}
DEVI void transpose_items(const float* __restrict__ W, int ldw, int K, int N, bf16_t* __restrict__ WT, float* scr, int gw, int ngw, int lane) {
    const int nitems = (K / 64) * (N / 32);
    for (int it = gw; it < nitems; it += ngw) transpose_item(W, ldw, K, N, WT, scr, it, lane);
}
DEVI void finish_row(const bf16_t* __restrict__ P, const bf16_t* __restrict__ HM, const float* __restrict__ mnorm, bf16_t* __restrict__ Y, int row, int lane) {
#pragma unroll
    for (int head = 0; head < 4; ++head) {
        const int col = head * 256 + 4 * lane;
        const uint2 a = *(const uint2*)(HM + (size_t)row * 1024 + col), c = *(const uint2*)(HM + ((size_t)NTOK + row) * 1024 + col);
        float h[4];
        h[0] = __uint_as_float(a.x << 16) + __uint_as_float(c.x << 16); h[1] = __uint_as_float(a.x & 0xffff0000u) + __uint_as_float(c.x & 0xffff0000u);
        h[2] = __uint_as_float(a.y << 16) + __uint_as_float(c.y << 16); h[3] = __uint_as_float(a.y & 0xffff0000u) + __uint_as_float(c.y & 0xffff0000u);
        const float ss = wave_sum(h[0] * h[0] + h[1] * h[1] + h[2] * h[2] + h[3] * h[3]);
        const float r = rsqrtf(ss * (1.f / 256.f) + EPS);
        const uint2 ov = *(const uint2*)(P + (size_t)row * NP + C_OB + col), gv = *(const uint2*)(P + (size_t)row * NP + C_GB + col);
        const float o[4] = {__uint_as_float(ov.x << 16), __uint_as_float(ov.x & 0xffff0000u), __uint_as_float(ov.y << 16), __uint_as_float(ov.y & 0xffff0000u)};
        const float g[4] = {__uint_as_float(gv.x << 16), __uint_as_float(gv.x & 0xffff0000u), __uint_as_float(gv.y << 16), __uint_as_float(gv.y & 0xffff0000u)};
        const float4 w = *(const float4*)(mnorm + col);
        const float wv[4] = {w.x, w.y, w.z, w.w};
        float y[4];
#pragma unroll
        for (int e = 0; e < 4; ++e) y[e] = h[e] * r * wv[e] * sigmoid_f(o[e]) * silu_f(g[e]);
        uint2 out; out.x = pk2(y[0], y[1]); out.y = pk2(y[2], y[3]);
        *(uint2*)(Y + (size_t)row * DM + 1024 + col) = out;
    }
}
DEVI void load_row(const float* __restrict__ xr, float4 (&v)[8], int lane) {
#pragma unroll
    for (int j = 0; j < 8; ++j) v[j] = ((const float4*)xr)[lane + 64 * j];
}
DEVI void post_regs(float4 (&v)[8], const bf16_t* __restrict__ y2row, const float* __restrict__ gate, const float* __restrict__ npost, float* __restrict__ orow, int lane) {
    uint2 yv[8]; float ss = 0.f;
#pragma unroll
    for (int j = 0; j < 8; ++j) {
        yv[j] = *(const uint2*)(y2row + 4 * (lane + 64 * j));
        const float y0 = __uint_as_float(yv[j].x << 16), y1 = __uint_as_float(yv[j].x & 0xffff0000u), y2 = __uint_as_float(yv[j].y << 16), y3 = __uint_as_float(yv[j].y & 0xffff0000u);
        ss += y0 * y0 + y1 * y1 + y2 * y2 + y3 * y3;
    }
    ss = wave_sum(ss);
    const float rstd = rsqrtf(ss * (1.f / DM) + EPS);
#pragma unroll
    for (int j = 0; j < 8; ++j) {
        const int k0 = 4 * (lane + 64 * j);
        const float4 gt = *(const float4*)(gate + k0), w = *(const float4*)(npost + k0);
        const float y0 = __uint_as_float(yv[j].x << 16), y1 = __uint_as_float(yv[j].x & 0xffff0000u), y2 = __uint_as_float(yv[j].y << 16), y3 = __uint_as_float(yv[j].y & 0xffff0000u);
        v[j].x += gt.x * (y0 * rstd * w.x); v[j].y += gt.y * (y1 * rstd * w.y); v[j].z += gt.z * (y2 * rstd * w.z); v[j].w += gt.w * (y3 * rstd * w.w);
        *(float4*)(orow + k0) = v[j];
        asm volatile("" ::: "memory");
    }
}
DEVI void norm_regs(const float4 (&v)[8], const float* __restrict__ shift, const float* __restrict__ scale, const float* __restrict__ npre, bf16_t* __restrict__ hrow, char* trow, int lane) {
    float ss = 0.f;
#pragma unroll
    for (int j = 0; j < 8; ++j) ss += v[j].x * v[j].x + v[j].y * v[j].y + v[j].z * v[j].z + v[j].w * v[j].w;
    ss = wave_sum(ss);
    const float rstd = rsqrtf(ss * (1.f / DM) + EPS);
#pragma unroll
    for (int j = 0; j < 8; ++j) {
        const int k0 = 4 * (lane + 64 * j);
        const float4 w = *(const float4*)(npre + k0), sh = *(const float4*)(shift + k0), sc = *(const float4*)(scale + k0);
        uint2 o;
        o.x = pk2(v[j].x * rstd * w.x * (1.f + sc.x) + sh.x, v[j].y * rstd * w.y * (1.f + sc.y) + sh.y);
        o.y = pk2(v[j].z * rstd * w.z * (1.f + sc.z) + sh.z, v[j].w * rstd * w.w * (1.f + sc.w) + sh.w);
        *(uint2*)(hrow + k0) = o; *(uint2*)(trow + k0 * 2) = o;
        asm volatile("" ::: "memory");
    }
}
constexpr int NT_ROWB = (DM + 8) * 2;
template <bool POST>
DEVI void norm_phase(const float* __restrict__ xlat, const float* __restrict__ xctx, const bf16_t* __restrict__ Y2, const float* __restrict__ mod_post, const float* __restrict__ npost,
                     float* olat, float* octx, const float* __restrict__ mod_n, const float* __restrict__ npre, const float* __restrict__ wg, bf16_t* __restrict__ H,
                     float* __restrict__ GATES, char* lds) {
    typedef short bf16x8 __attribute__((ext_vector_type(8))); typedef float f32x4 __attribute__((ext_vector_type(4)));
    const int tid = opaque_tid(), lane = tid & 63, wave = tid >> 6, lr = lane & 15, kgp = lane >> 4;
    char* tile = lds; float* red = (float*)(lds + 8 * NT_ROWB);
    bf16x8 bfrag[8];
    {
        const float* wp = wg + (size_t)(wave * 256 + 8 * kgp) * INC + lr;
#pragma unroll
        for (int ks = 0; ks < 8; ++ks) {
            unsigned w4[4];
#pragma unroll
            for (int q = 0; q < 4; ++q) { w4[q] = pk2(wp[0], wp[INC]); wp += 2 * INC; asm volatile("" : "+v"(wp)); }
            wp += (size_t)24 * INC; asm volatile("" : "+v"(wp));
            bfrag[ks] = __builtin_bit_cast(bf16x8, make_uint4(w4[0], w4[1], w4[2], w4[3]));
        }
    }
    for (int grp = blockIdx.x; grp < NTOK / 8; grp += gridDim.x) {
        const int row = grp * 8 + wave; const bool isl = row < NLAT; const int b = isl ? row / SEQ : 8;
        {
            float4 v[8];
            load_row(isl ? xlat + (size_t)row * DM : xctx + (size_t)(row - NLAT) * DM, v, lane);
            if (POST) post_regs(v, Y2 + (size_t)row * DM, mod_post + (size_t)b * MODW + 2 * DM, npost, isl ? olat + (size_t)row * DM : octx + (size_t)(row - NLAT) * DM, lane);
            norm_regs(v, mod_n + (size_t)b * MODW, mod_n + (size_t)b * MODW + DM, npre, H + (size_t)row * DM, tile + wave * NT_ROWB, lane);
        }
        __syncthreads();
        f32x4 acc = {0.f, 0.f, 0.f, 0.f};
#pragma unroll
        for (int ks = 0; ks < 8; ++ks) {
            bf16x8 af = {0, 0, 0, 0, 0, 0, 0, 0};
            if (lr < 8) af = *(const bf16x8*)(tile + lr * NT_ROWB + (wave * 256 + ks * 32 + 8 * kgp) * 2);
            acc = __builtin_amdgcn_mfma_f32_16x16x32_bf16(af, bfrag[ks], acc, 0, 0, 0);
        }
        if (kgp < 2) {
#pragma unroll
            for (int r = 0; r < 4; ++r) red[(wave * 8 + 4 * kgp + r) * 16 + lr] = acc[r];
        }
        __syncthreads();
        if (tid < 128) { const int rr = tid >> 4, cc = tid & 15; float sum = 0.f;
#pragma unroll
            for (int w8 = 0; w8 < 8; ++w8) sum += red[(w8 * 8 + rr) * 16 + cc];
            GATES[(size_t)(grp * 8 + rr) * 16 + cc] = sum; }
    }
    __syncthreads();
}

#define XB_TMO      128
#define XB_XCNT(j)  (256  + 64 * (j))
#define XB_XSUB(j)  (1280 + 64 * (j))
#define XB_XGEN(j)  (2304 + 64 * (j))
#define XB_TOP      3328
#define XB_TOPGEN   3392
#define XCD_BAR_WORDS 3456
#define XB_SPIN_CAP (1u << 18)

__device__ __forceinline__ unsigned xb_ld(unsigned* p)              { return __hip_atomic_load(p, __ATOMIC_RELAXED, __HIP_MEMORY_SCOPE_AGENT); }
__device__ __forceinline__ unsigned xb_add(unsigned* p, unsigned v) { return __hip_atomic_fetch_add(p, v, __ATOMIC_RELAXED, __HIP_MEMORY_SCOPE_AGENT); }
__device__ __forceinline__ unsigned xb_xcc_id() { return (unsigned)__builtin_amdgcn_s_getreg((3 << 11) | 20) & 0xFu; }
#define XB_SPIN(cond, bar) do { unsigned _sp = 0; while (cond) { __builtin_amdgcn_s_sleep(1); \
    if ((++_sp & 255u) == 0u) { if (xb_ld(&(bar)[XB_TMO])) break; if (_sp > XB_SPIN_CAP) { atomicAdd(&(bar)[XB_TMO], 1u); break; } } } } while (0)

struct XcdBarrier {
    unsigned* bar; unsigned x;
    volatile __attribute__((address_space(3))) unsigned* st;
};

__device__ __forceinline__ XcdBarrier xcd_barrier_post(unsigned* bar, volatile __attribute__((address_space(3))) unsigned* st) {
    XcdBarrier b; b.bar = bar; b.x = xb_xcc_id(); b.st = st;
    if (threadIdx.x == 0) (void)xb_add(&bar[XB_XCNT(b.x)], 1u);
    return b;
}
__device__ __forceinline__ void xcd_barrier_complete(unsigned* bar, unsigned x, unsigned& nloc, unsigned& nx) {
    const unsigned G = gridDim.x * gridDim.y * gridDim.z;
    unsigned sum, cnt, mine, sp = 0u;
    for (;;) {
        sum = 0u; cnt = 0u; mine = 0u;
#pragma unroll
        for (unsigned j = 0; j < 16; ++j) { const unsigned c = xb_ld(&bar[XB_XCNT(j)]); sum += c; cnt += (c > 0u) ? 1u : 0u; mine = (j == x) ? c : mine; }
        if (sum == G) break;
        __builtin_amdgcn_s_sleep(1);
        if ((++sp & 255u) == 0u) { if (xb_ld(&bar[XB_TMO])) break; if (sp > XB_SPIN_CAP) { atomicAdd(&bar[XB_TMO], 1u); break; } }
    }
    nloc = mine > 0u ? mine : 1u; nx = cnt > 0u ? cnt : 1u;
}

__device__ __forceinline__ void xcd_barrier(const XcdBarrier& b) {
    asm volatile("s_waitcnt vmcnt(0)" ::: "memory");
    __syncthreads();
    if (threadIdx.x == 0) {
        unsigned* bar = b.bar;
        __builtin_amdgcn_s_waitcnt(0);
        unsigned nloc = b.st[0], nx = b.st[1];
        if (nloc == 0u) { xcd_barrier_complete(bar, b.x, nloc, nx); b.st[0] = nloc; b.st[1] = nx; }
        const unsigned old = xb_add(&bar[XB_XSUB(b.x)], 1u);
        const unsigned gen = old / nloc;
        if (old + 1u == (gen + 1u) * nloc) {
            __builtin_amdgcn_fence(__ATOMIC_RELEASE, "agent");
            asm volatile("s_waitcnt vmcnt(0)" ::: "memory");
            const unsigned og = xb_add(&bar[XB_TOP], 1u);
            const unsigned tg = og / nx;
            if (og + 1u == (tg + 1u) * nx) xb_add(&bar[XB_TOPGEN], 1u);
            else XB_SPIN(xb_ld(&bar[XB_TOPGEN]) == tg, bar);
            __builtin_amdgcn_fence(__ATOMIC_ACQUIRE, "agent");
            xb_add(&bar[XB_XGEN(b.x)], 1u);
            asm volatile("s_waitcnt vmcnt(0)" ::: "memory");
        } else {
            XB_SPIN(xb_ld(&bar[XB_XGEN(b.x)]) == gen, bar);
            __builtin_amdgcn_fence(__ATOMIC_ACQUIRE, "agent");
            asm volatile("s_waitcnt vmcnt(0)" ::: "memory");
        }
    }
    __syncthreads();
}

namespace cg = cooperative_groups;
#ifndef PROBE_DUP
#define PROBE_DUP 0
#endif
#define DUPN(k) ((PROBE_DUP == (k)) ? 2 : 1)
constexpr int MEGA_LDS = LDS_PHASE_BYTES + 256;
struct MegaArgs { const float* in[20]; float* out; unsigned char* ws; };
DEVI const float* karg_in(int i) { const char* kp = (const char*)__builtin_amdgcn_kernarg_segment_ptr(); asm volatile("" : "+s"(kp)); return *(const float* const*)(kp + 8 * i); }
DEVI unsigned char* karg_ws() { const char* kp = (const char*)__builtin_amdgcn_kernarg_segment_ptr(); asm volatile("" : "+s"(kp)); return *(unsigned char* const*)(kp + 168); }
DEVI float* karg_out() { const char* kp = (const char*)__builtin_amdgcn_kernarg_segment_ptr(); asm volatile("" : "+s"(kp)); return *(float* const*)(kp + 160); }
typedef const __attribute__((address_space(4))) MegaArgs* KArgP;
DEVI KArgP kargs() {
    const unsigned long long p = (unsigned long long)__builtin_amdgcn_kernarg_segment_ptr();
    unsigned lo = (unsigned)p, hi = (unsigned)(p >> 32);
    asm volatile("" : "+s"(lo), "+s"(hi));
    lo = __builtin_amdgcn_readfirstlane(lo); hi = __builtin_amdgcn_readfirstlane(hi);
    return (KArgP)(((unsigned long long)hi << 32) | lo);
}
#define LAS3 __attribute__((address_space(3)))
__global__ __launch_bounds__(512, 2) void mega_fwd(MegaArgs a_unused) {
    (void)a_unused;
    extern __shared__ __attribute__((aligned(16))) unsigned char lds[];
    cg::grid_group grid = cg::this_grid();
    { volatile LAS3 unsigned* MISC = (volatile LAS3 unsigned*)((LAS3 unsigned char*)lds + LDS_PHASE_BYTES);
      if (threadIdx.x < 64) MISC[threadIdx.x] = 0u;
      __syncthreads();
      if ((threadIdx.x & 63) == 0) ((volatile LAS3 unsigned char*)MISC)[128 + ((unsigned)__builtin_amdgcn_s_getreg((5 << 11) | 4) & 63u)] = (unsigned char)(threadIdx.x >> 6);
      __syncthreads();
      (void)xcd_barrier_post((unsigned*)(kargs()->ws + WS_CTL) + 4096, MISC + 8); }
#define GRID_BAR() do { XcdBarrier b_; b_.bar = (unsigned*)(kargs()->ws + WS_CTL) + 4096; b_.x = xb_xcc_id(); b_.st = (volatile LAS3 unsigned*)((LAS3 unsigned char*)lds + LDS_PHASE_BYTES) + 8; xcd_barrier(b_); } while (0)
#define PHASE_IDS const int G = gridDim.x; const int tid = opaque_tid(), lane = tid & 63, wave = tid >> 6, gw = blockIdx.x * 8 + wave, ngw = G * 8; (void)tid; (void)lane; (void)gw; (void)ngw; float* scr = (float*)lds + wave * (64 * 33); (void)scr
#define WSP(T, off) ((T*)(A->ws + (off)))

    { PHASE_IDS; KArgP A = kargs();
      const float* w_in = A->in[8]; const float* w_out = A->in[9]; bf16_t* WIN = WSP(bf16_t, WS_WIN); bf16_t* WOUT = WSP(bf16_t, WS_WOUT); float* ROPE = WSP(float, WS_ROPE);
      for (int u = blockIdx.x; u < 192; u += G) mod_unit(u, A->in[1], A->in[3], A->in[4], A->in[5], WSP(float, WS_MOD), (float*)lds);
      for (int i = blockIdx.x * 512 + tid; i < 1024; i += G * 512) { const int pos = i >> 4, f = i & 15; const float inv = powf(10000.f, -(float)f / 16.f); const float ang = (float)pos * inv;
          ROPE[2 * i] = cosf(ang); ROPE[2 * i + 1] = sinf(ang); }
      {
          const bool light = (G == 256) && ((int)blockIdx.x < 192);
          const int nv = (G == 256) ? (light ? 5 : 9) : 1, v0 = (G == 256) ? (light ? gw * 5 : 192 * 8 * 5 + (gw - 192 * 8) * 9) : gw, nvw = (G == 256) ? 12288 : ngw;
          for (int q = 0; q < nv; ++q) {
              const int vw_ = v0 + q;
              for (int it = vw_; it < 12288; it += nvw) {
                  if (it < 8192) transpose_item(w_in, INC, DM, NP, WIN, scr, it, lane);
                  else if (it < 10240) transpose_item(w_out, DM, DM, DM, WOUT, scr, it - 8192, lane);
                  else transpose_item(w_out + (size_t)DM * DM, DM, DM, DM, WOUT + (size_t)DM * DM, scr, it - 10240, lane);
              }
          }
      } }
    grid.sync();
    { KArgP A = kargs();
      norm_phase<false>(A->in[0], A->in[2], nullptr, nullptr, nullptr, nullptr, nullptr, WSP(float, WS_MOD), A->in[6], A->in[8] + NP, WSP(bf16_t, WS_H), WSP(float, WS_GATES), (char*)lds); }
    GRID_BAR();
    for (int l = 0; l < 2; ++l) {
        for (int rep_ = 0; rep_ < DUPN(2); ++rep_)
        { KArgP A = kargs();
          pg8::Gemm g{WSP(bf16_t, WS_H), WSP(bf16_t, WS_WIN), NTOK, NP, DM}; pg8::StaticOrder S; S.init(NTOK, NP, (int)gridDim.x, (int)blockIdx.x); pg8::EpiInProj E{WSP(bf16_t, WS_P), NP, WSP(float, WS_ROPE)};
          pg8::gemm_phase<pg8::EpiInProj, pg8::StaticOrder, true, true>((PG8_LAS unsigned char*)lds, g, S, E); }
        GRID_BAR();
        { KArgP A = kargs(); mls::qkconv_phase(WSP(bf16_t, WS_P), WSP(bf16_t, WS_H), A->in[15] + (size_t)l * 3 * 1024, A->in[16] + l * 1024); }
        GRID_BAR();
        { KArgP A = kargs(); mls::mlstm_phase(WSP(bf16_t, WS_P), WSP(bf16_t, WS_H), WSP(float, WS_GATES), WSP(bf16_t, WS_HM), A->in[17] + l * 8, A->in[18] + l * 8, l == 0, (char*)lds); }
        { KArgP A = kargs(); const float lam_init = l == 0 ? 0.2f : 0.35550906759f;
          att::attn_phase(WSP(bf16_t, WS_P), WSP(bf16_t, WS_H), A->in[10] + l * 64, A->in[11] + l * 64, A->in[12] + l * 64, A->in[13] + l * 64, A->in[14] + l * 128, lam_init, l == 0,
                          WSP(unsigned, WS_CTL) + 8192 + l * 512, (volatile LAS3 unsigned*)((LAS3 unsigned char*)lds + LDS_PHASE_BYTES) + 16, (char*)lds); }
        GRID_BAR();
        { PHASE_IDS; KArgP A = kargs(); const bf16_t* P = WSP(bf16_t, WS_P); const bf16_t* HM = WSP(bf16_t, WS_HM); bf16_t* Y = WSP(bf16_t, WS_H); const float* mn = A->in[19] + l * 1024;
          const int nrows = l == 0 ? NTOK : NLAT; for (int row = gw; row < nrows; row += ngw) finish_row(P, HM, mn, Y, row, lane); }
        GRID_BAR();
        for (int rep_ = 0; rep_ < DUPN(5); ++rep_)
        { KArgP A = kargs(); const int M = l == 0 ? NTOK : NLAT;
          pg8::Gemm g{WSP(bf16_t, WS_H), WSP(bf16_t, WS_WOUT) + (size_t)l * DM * DM, M, DM, DM}; pg8::StaticOrder S; S.init(M, DM, (int)gridDim.x, (int)blockIdx.x); pg8::EpiBf16 E{WSP(bf16_t, WS_HM), DM};
          pg8::gemm_phase<pg8::EpiBf16, pg8::StaticOrder, true, true>((PG8_LAS unsigned char*)lds, g, S, E); }
        if (l == 0) { PHASE_IDS; KArgP A = kargs(); const float* w_in1 = A->in[8] + (size_t)DM * INC; bf16_t* WIN = WSP(bf16_t, WS_WIN);
            const int nbusy = (NTOK / 256) * (DM / 256) - 2 * G;
            if (nbusy >= 0 && nbusy < G) { if ((int)blockIdx.x >= nbusy) transpose_items(w_in1, INC, DM, NP, WIN, scr, ((int)blockIdx.x - nbusy) * 8 + wave, (G - nbusy) * 8, lane); }
            else transpose_items(w_in1, INC, DM, NP, WIN, scr, gw, ngw, lane);
        }
        GRID_BAR();
        if (l == 0) {
            { KArgP A = kargs(); float* MOD = WSP(float, WS_MOD);
              norm_phase<true>(A->in[0], A->in[2], WSP(bf16_t, WS_HM), MOD, A->in[7], A->out, WSP(float, WS_XC), MOD + (size_t)9 * MODW, A->in[6] + DM, A->in[8] + (size_t)DM * INC + NP, WSP(bf16_t, WS_H), WSP(float, WS_GATES), (char*)lds); }
            GRID_BAR();
        } else { PHASE_IDS; KArgP A = kargs(); float* out = A->out; const bf16_t* Y2 = WSP(bf16_t, WS_HM); const float* mod_l = WSP(float, WS_MOD) + (size_t)9 * MODW; const float* npost = A->in[7] + DM;
            for (int row = gw; row < NLAT; row += ngw) {
                float4 v[8];
                load_row(out + (size_t)row * DM, v, lane);
                post_regs(v, Y2 + (size_t)row * DM, mod_l + (size_t)(row / SEQ) * MODW + 2 * DM, npost, out + (size_t)row * DM, lane);
            }
        }
    }
}

extern "C" void kernel_launch(void* const* d_in, const int* in_sizes, int n_in, void* d_out, int out_size, void* d_ws, size_t ws_size, hipStream_t stream) {
    (void)in_sizes; (void)n_in; (void)out_size; (void)ws_size;
    static int grid_blocks = 0;
    if (!grid_blocks) {
        int dev = 0, cus = 0, per_cu = 0;
        (void)hipGetDevice(&dev);
        (void)hipDeviceGetAttribute(&cus, hipDeviceAttributeMultiprocessorCount, dev);
        (void)hipFuncSetAttribute((const void*)mega_fwd, hipFuncAttributeMaxDynamicSharedMemorySize, MEGA_LDS);
        (void)hipOccupancyMaxActiveBlocksPerMultiprocessor(&per_cu, (const void*)mega_fwd, 512, MEGA_LDS);
        if (per_cu < 1) per_cu = 1;
        if (per_cu > 1) per_cu = 1;
        grid_blocks = cus * per_cu;
    }
    (void)hipMemsetAsync((char*)d_ws + WS_CTL, 0, 65536, stream);
    MegaArgs a{};
    for (int i = 0; i < 20; ++i) a.in[i] = (const float*)d_in[i];
    a.out = (float*)d_out; a.ws = (unsigned char*)d_ws;
    void* args[] = {&a};
    (void)hipLaunchCooperativeKernel((const void*)mega_fwd, dim3(grid_blocks), dim3(512), args, (size_t)MEGA_LDS, stream);
}
```

```cpp
#include <hip/hip_runtime.h>
#include <hip/hip_cooperative_groups.h>
#include <stdint.h>
#include <math.h>

#define DEVI __device__ __forceinline__
constexpr int LDS_PHASE_BYTES = 155648;
typedef unsigned short bf16_t;

constexpr int DM = 2048, NBATCH = 8, SEQ = 2048, CTXL = 256;
constexpr int NLAT = NBATCH * SEQ, NCTX = NBATCH * CTXL, NTOK = NLAT + NCTX;
constexpr int INC = 8208, NP = 8192, MODW = 6144;
constexpr int C_QA = 0, C_KA = 1024, C_VA = 2048, C_GA = 3072, C_QB = 4096, C_KB = 4608, C_VB = 5120, C_OB = 6144, C_GB = 7168;
constexpr float EPS = 1e-6f;

constexpr size_t MiB = (size_t)1 << 20;
constexpr size_t WS_CTL = 0, WS_MOD = 1 * MiB, WS_SC = WS_MOD + 512 * 1024, WS_ROPE = 2 * MiB, WS_WGT = 2 * MiB + 65536  , WS_GATES = 3 * MiB, WS_WOUT = 8 * MiB,
                 WS_WIN = 24 * MiB, WS_XC = 56 * MiB, WS_H = 72 * MiB, WS_HM = 144 * MiB, WS_P = 216 * MiB, WS_END = 504 * MiB;

DEVI int opaque_tid() {
    const unsigned hw = (unsigned)__builtin_amdgcn_s_getreg((5 << 11) | 4) & 63u;
    const unsigned w = *((const volatile __attribute__((address_space(3))) unsigned char*)(LDS_PHASE_BYTES + 128) + hw);
    int ln; asm volatile("v_mbcnt_lo_u32_b32 %0, -1, 0\n\tv_mbcnt_hi_u32_b32 %0, -1, %0" : "=v"(ln));
    return (int)(__builtin_amdgcn_readfirstlane(w) << 6) | ln;
}
DEVI float bf2f(bf16_t v) { return __uint_as_float(((unsigned)v) << 16); }
DEVI bf16_t f2bf(float f) { unsigned u = __float_as_uint(f); return (bf16_t)((u + 0x7fffu + ((u >> 16) & 1u)) >> 16); }
DEVI unsigned pk2(float lo, float hi) { typedef float f32x2_ __attribute__((ext_vector_type(2))); typedef __bf16 bf16x2_ __attribute__((ext_vector_type(2))); const f32x2_ v = {lo, hi}; return __builtin_bit_cast(unsigned, __builtin_convertvector(v, bf16x2_)); }
DEVI float row16_sum(float v) {
    v += __builtin_bit_cast(float, __builtin_amdgcn_update_dpp(0, __builtin_bit_cast(int, v), 0xB1, 0xF, 0xF, false));
    v += __builtin_bit_cast(float, __builtin_amdgcn_update_dpp(0, __builtin_bit_cast(int, v), 0x4E, 0xF, 0xF, false));
    v += __builtin_bit_cast(float, __builtin_amdgcn_update_dpp(0, __builtin_bit_cast(int, v), 0x141, 0xF, 0xF, false));
    v += __builtin_bit_cast(float, __builtin_amdgcn_update_dpp(0, __builtin_bit_cast(int, v), 0x140, 0xF, 0xF, false));
    return v;
}
DEVI float rl_f(float v, int l) { return __builtin_bit_cast(float, __builtin_amdgcn_readlane(__builtin_bit_cast(int, v), l)); }
DEVI float wave_sum(float v) { v = row16_sum(v); return (rl_f(v, 0) + rl_f(v, 16)) + (rl_f(v, 32) + rl_f(v, 48)); }
DEVI float half_sum(float v, int hi) { v = row16_sum(v); const float a = rl_f(v, 0) + rl_f(v, 16), b = rl_f(v, 32) + rl_f(v, 48); return hi ? b : a; }
DEVI float sigmoid_f(float x) { return __builtin_amdgcn_rcpf(1.f + __expf(-x)); }
DEVI float silu_f(float x) { return x * sigmoid_f(x); }


DEVI void transpose_item(const float* __restrict__ W, int ldw, int K, int N, bf16_t* __restrict__ WT, float* scr, int item, int lane) {
    const int nblk = N / 64, kb = item / nblk, nb = item % nblk, k0 = 64 * kb, n0 = 64 * nb;
    float tv[64];
#pragma unroll
    for (int i = 0; i < 64; ++i) tv[i] = W[(size_t)(k0 + i) * ldw + n0 + lane];
#pragma unroll
    for (int i = 0; i < 64; ++i) scr[i * 65 + lane] = tv[i];
    asm volatile("s_waitcnt lgkmcnt(0)" ::: "memory");
    const int c = lane & 7;
#pragma unroll
    for (int j = 0; j < 8; ++j) {
        const int n = (lane >> 3) + 8 * j; const float* sp = scr + (8 * c) * 65 + n;
        uint4 o; o.x = pk2(sp[0 * 65], sp[1 * 65]); o.y = pk2(sp[2 * 65], sp[3 * 65]); o.z = pk2(sp[4 * 65], sp[5 * 65]); o.w = pk2(sp[6 * 65], sp[7 * 65]);
        *(uint4*)(WT + (size_t)(n0 + n) * K + k0 + 8 * c) = o;
    }
    asm volatile("s_waitcnt lgkmcnt(0)" ::: "memory");
}

namespace pg8 {
#define PG8_LAS __attribute__((address_space(3)))
typedef unsigned short bf16_t;
typedef short bf16x8 __attribute__((ext_vector_type(8)));
typedef float f32x4 __attribute__((ext_vector_type(4)));
typedef unsigned u32x4 __attribute__((ext_vector_type(4)));
constexpr int BM = 256, BK = 64, HALF = 128, HTB = HALF * BK * 2  , STAGE_BYTES = 8 * HTB, NXCD = 8, WGM = 8;

__host__ __device__ __forceinline__ int lds_byte(int r, int c) { const int st = (r >> 4) * 2 + (c >> 5), rr = r & 15, cc = c & 31, ob = rr * 64 + cc * 2; return st * 1024 + (ob ^ (((ob >> 9) & 1) << 5)); }
__host__ __device__ __forceinline__ void stage_rc(int b, int& R, int& C) { const int st = b / 1024, sb = b % 1024, swz = sb ^ (((sb >> 9) & 1) << 5); R = (st >> 1) * 16 + swz / 64; C = (st & 1) * 32 + (swz % 64) / 2; }
__host__ __device__ __forceinline__ int perm32(int rho) { const int n = rho >> 4, i = rho & 15; return 8 * (i >> 2) + 4 * n + (i & 3); }

struct Unit { int pm, pn; };
struct Gemm { const bf16_t* A; const bf16_t* Bt; int M, N, K; };

struct StaticOrder {
    int nM, nN, nwg, G, c;
    __host__ __device__ void init(int M, int N, int G_, int c_) { nM = M / BM; nN = N / BM; nwg = nM * nN; G = G_; c = c_; }
    __host__ __device__ bool next(int i, Unit& u) const {
        const long L = (long)i * G + c; if (L >= nwg) return false;
        int wgid = (int)L; { const int q = nwg / NXCD, r = nwg % NXCD, xcd = wgid % NXCD, off = wgid / NXCD; wgid = (xcd < r ? xcd * (q + 1) : r * (q + 1) + (xcd - r) * q) + off; }
        const int nig = WGM * nN, gid = wgid / nig, fm = gid * WGM, gsz = (nM - fm) < WGM ? (nM - fm) : WGM;
        u.pm = fm + ((wgid % nig) % gsz); u.pn = (wgid % nig) / gsz; return true;
    }
    __device__ __forceinline__ void a_ready(const Unit&) const {}
    __device__ __forceinline__ void done(const Unit&) const {}
};

__device__ __forceinline__ unsigned cvt_pk_bf16(float lo, float hi) { unsigned r; asm volatile("v_cvt_pk_bf16_f32 %0, %1, %2" : "=v"(r) : "v"(lo), "v"(hi)); return r; }

struct EpiBf16 {
    static constexpr bool PERM = true, AFTER_DRAIN = false;
    bf16_t* O; int ldc;
    __device__ __forceinline__ void operator()(const f32x4 (&acc)[2][2][4][2], const Unit& u, int wr, int wc, int fr, int fq) const {
        const int row0 = u.pm * BM + wr * 64 + fr, col0 = u.pn * BM + wc * 32 + 8 * fq;
#pragma unroll
        for (int ai = 0; ai < 2; ++ai)
#pragma unroll
            for (int m = 0; m < 4; ++m) { bf16_t* rowp = O + (size_t)(row0 + ai * HALF + m * 16) * ldc + col0;
#pragma unroll
                for (int bj = 0; bj < 2; ++bj) { const f32x4 v0 = acc[ai][bj][m][0], v1 = acc[ai][bj][m][1];
                    u32x4 w; w.x = cvt_pk_bf16(v0[0], v0[1]); w.y = cvt_pk_bf16(v0[2], v0[3]); w.z = cvt_pk_bf16(v1[0], v1[1]); w.w = cvt_pk_bf16(v1[2], v1[3]);
                    *(u32x4*)(rowp + bj * HALF) = w; } }
    }
};
struct EpiInProj {
    static constexpr bool PERM = true, AFTER_DRAIN = false;
    bf16_t* O; int ldc; const float* rope;
    __device__ __forceinline__ void operator()(const f32x4 (&acc)[2][2][4][2], const Unit& u, int wr, int wc, int fr, int fq) const {
        const int row0 = u.pm * BM + wr * 64 + fr, col0 = u.pn * BM + wc * 32 + 8 * fq;
        const bool do_rope = (u.pn < 8) && (u.pm < 64);
        const float qsc = (u.pn < 4) ? 0.18033688011112042f : 1.f;
#pragma unroll
        for (int ai = 0; ai < 2; ++ai)
#pragma unroll
            for (int m = 0; m < 4; ++m) { const int row = row0 + ai * HALF + m * 16; bf16_t* rowp = O + (size_t)row * ldc + col0;
                f32x4 cs01 = {1.f, 0.f, 1.f, 0.f}, cs23 = {1.f, 0.f, 1.f, 0.f};
                if (do_rope) { const int pos = (wc & 1) ? (row & 63) : ((row >> 6) & 31); const f32x4* rp = (const f32x4*)(rope + (size_t)(pos * 16 + 4 * fq) * 2); cs01 = rp[0]; cs23 = rp[1]; }
#pragma unroll
                for (int bj = 0; bj < 2; ++bj) { f32x4 v0 = acc[ai][bj][m][0], v1 = acc[ai][bj][m][1];
                    if (do_rope) {
                        const float a0 = v0[0] * cs01[0] - v0[1] * cs01[1], a1 = v0[0] * cs01[1] + v0[1] * cs01[0];
                        const float a2 = v0[2] * cs01[2] - v0[3] * cs01[3], a3 = v0[2] * cs01[3] + v0[3] * cs01[2];
                        const float b0 = v1[0] * cs23[0] - v1[1] * cs23[1], b1 = v1[0] * cs23[1] + v1[1] * cs23[0];
                        const float b2 = v1[2] * cs23[2] - v1[3] * cs23[3], b3 = v1[2] * cs23[3] + v1[3] * cs23[2];
                        v0 = (f32x4){a0, a1, a2, a3}; v1 = (f32x4){b0, b1, b2, b3};
                    }
                    v0 = v0 * qsc; v1 = v1 * qsc;
                    u32x4 w; w.x = cvt_pk_bf16(v0[0], v0[1]); w.y = cvt_pk_bf16(v0[2], v0[3]); w.z = cvt_pk_bf16(v1[0], v1[1]); w.w = cvt_pk_bf16(v1[2], v1[3]);
                    *(u32x4*)(rowp + bj * HALF) = w; } }
    }
};

template <class Epi, class Sched, bool ALIGN_EPI = false, bool SP2 = false>
__device__ __forceinline__ void gemm_phase(PG8_LAS unsigned char* lds, const Gemm g, const Sched& S, const Epi& E) {
    const int tid = opaque_tid(), wid = __builtin_amdgcn_readfirstlane(tid >> 6), lane = tid & 63, wr = wid >> 2, wc = wid & 3, fr = lane & 15, fq = lane >> 4;
    const int K = g.K, nt = K / BK;
    unsigned voffA[2], voffB[2];
#pragma unroll
    for (int i = 0; i < 2; ++i) { int R, C; stage_rc(tid * 16 + i * 8192, R, C); const int Rb = Epi::PERM ? ((R & ~31) + perm32(R & 31)) : R;
        voffA[i] = (unsigned)(R * K + C) * 2u; voffB[i] = (unsigned)(Rb * K + C) * 2u; }
    const size_t kstep = (size_t)(BK * 2);
    const size_t hstep = (size_t)HALF * K * 2;
    const size_t tstep = 2 * hstep;
    const unsigned ldsw = (unsigned)wid * 1024u;
    const int aoff = lds_byte(wr * 64 + fr, fq * 8), boff = lds_byte(wc * 32 + fr, fq * 8);
#define PG8_SA(b, h) (((b) * 2 + (h)) * HTB)
#define PG8_SB(b, h) ((4 + (b) * 2 + (h)) * HTB)
#define PG8_STAGE(bufoff, gbase, voff) do { _Pragma("unroll") for (int _i = 0; _i < 2; ++_i) \
        __builtin_amdgcn_global_load_lds((const unsigned*)((const char*)(gbase) + (voff)[_i]), (PG8_LAS unsigned*)(lds + (bufoff) + ldsw + _i * 8192), 16, 0, 0); } while (0)
#define PG8_LDA(dst, b, h) do { _Pragma("unroll") for (int m = 0; m < 4; ++m) _Pragma("unroll") for (int k = 0; k < 2; ++k) dst[m][k] = *(const PG8_LAS bf16x8*)(lds + PG8_SA(b, h) + aoff + m * 2048 + k * 1024); } while (0)
#define PG8_LDB(dst, b, h) do { _Pragma("unroll") for (int n = 0; n < 2; ++n) _Pragma("unroll") for (int k = 0; k < 2; ++k) dst[n][k] = *(const PG8_LAS bf16x8*)(lds + PG8_SB(b, h) + boff + n * 2048 + k * 1024); } while (0)
#define PG8_MMA(ai, bj, At, Bt) do { __builtin_amdgcn_s_setprio(1); _Pragma("unroll") for (int m = 0; m < 4; ++m) _Pragma("unroll") for (int n = 0; n < 2; ++n) _Pragma("unroll") for (int k = 0; k < 2; ++k) \
        acc[ai][bj][m][n] = __builtin_amdgcn_mfma_f32_16x16x32_bf16(Bt[n][k], At[m][k], acc[ai][bj][m][n], 0, 0, 0); __builtin_amdgcn_s_setprio(0); } while (0)
#define PG8_WAIT_V(n) asm volatile("s_waitcnt vmcnt(" #n ")" ::: "memory")
#define PG8_WAIT_L(n) asm volatile("s_waitcnt lgkmcnt(" #n ")" ::: "memory")
#define PG8_BAR __builtin_amdgcn_s_barrier()
#define PG8_SCHED __builtin_amdgcn_sched_barrier(0)
    Unit cur, nxt; int ui = 0;
    if (!S.next(0, cur)) return;
    f32x4 acc[2][2][4][2];
#pragma unroll
    for (int a = 0; a < 2; ++a)
#pragma unroll
        for (int b = 0; b < 2; ++b)
#pragma unroll
            for (int m = 0; m < 4; ++m)
#pragma unroll
                for (int n = 0; n < 2; ++n) acc[a][b][m][n] = (f32x4){0.f, 0.f, 0.f, 0.f};
    bf16x8 At[4][2], B0[2][2], B1[2][2];
    const char* cA = (const char*)g.A + (size_t)cur.pm * tstep; const char* cB = (const char*)g.Bt + (size_t)cur.pn * tstep;
    S.a_ready(cur);
    if constexpr (SP2) {
        PG8_STAGE(PG8_SB(0, 0), cB, voffB); PG8_STAGE(PG8_SB(0, 1), cB + hstep, voffB); PG8_STAGE(PG8_SA(0, 0), cA, voffA); PG8_STAGE(PG8_SA(0, 1), cA + hstep, voffA);
        if (wr == 1) PG8_BAR;
        PG8_WAIT_V(2); PG8_BAR;
        PG8_STAGE(PG8_SB(1, 0), cB + kstep, voffB); PG8_STAGE(PG8_SA(1, 0), cA + kstep, voffA); PG8_STAGE(PG8_SB(1, 1), cB + hstep + kstep, voffB);
        PG8_WAIT_V(6); PG8_BAR;
    } else {
        PG8_STAGE(PG8_SB(0, 0), cB, voffB); PG8_STAGE(PG8_SA(0, 0), cA, voffA); PG8_STAGE(PG8_SB(0, 1), cB + hstep, voffB); PG8_STAGE(PG8_SA(0, 1), cA + hstep, voffA);
        if (wr == 1) PG8_BAR;
        PG8_WAIT_V(4); PG8_BAR;
        PG8_STAGE(PG8_SB(1, 0), cB + kstep, voffB); PG8_STAGE(PG8_SA(1, 0), cA + kstep, voffA); PG8_STAGE(PG8_SB(1, 1), cB + hstep + kstep, voffB);
        PG8_WAIT_V(6); PG8_BAR;
    }
    for (;;) {
        const bool has_next = S.next(ui + 1, nxt);
        const char* nA = has_next ? (const char*)g.A + (size_t)nxt.pm * tstep : cA; const char* nB = has_next ? (const char*)g.Bt + (size_t)nxt.pn * tstep : cB;
        for (int t = 0; t < nt; t += 2) {
            const bool last = (t == nt - 2);
            const char* a1 = cA + (size_t)(t + 1) * kstep;
            const char* a2 = last ? nA : cA + (size_t)(t + 2) * kstep; const char* b2 = last ? nB : cB + (size_t)(t + 2) * kstep;
            const char* a3 = a2 + kstep; const char* b3 = b2 + kstep;
            if (last && has_next) S.a_ready(nxt);
            if constexpr (SP2) {
            PG8_LDB(B0, 0, 0); PG8_LDB(B1, 0, 1); PG8_SCHED; PG8_LDA(At, 0, 0); PG8_STAGE(PG8_SA(1, 1), a1 + hstep, voffA);
            PG8_WAIT_V(8); PG8_WAIT_L(0); PG8_BAR; PG8_MMA(0, 0, At, B0); PG8_MMA(0, 1, At, B1); PG8_BAR; PG8_SCHED;
            PG8_LDA(At, 0, 1); PG8_STAGE(PG8_SB(0, 0), b2, voffB); PG8_STAGE(PG8_SB(0, 1), b2 + hstep, voffB); PG8_STAGE(PG8_SA(0, 0), a2, voffA);
            PG8_WAIT_V(8); PG8_WAIT_L(0); PG8_BAR; PG8_MMA(1, 0, At, B0); PG8_MMA(1, 1, At, B1); PG8_BAR; PG8_SCHED;
            PG8_LDB(B0, 1, 0); PG8_LDB(B1, 1, 1); PG8_SCHED; PG8_LDA(At, 1, 0); PG8_STAGE(PG8_SA(0, 1), a2 + hstep, voffA);
            PG8_WAIT_V(8); PG8_WAIT_L(0); PG8_BAR; PG8_MMA(0, 0, At, B0); PG8_MMA(0, 1, At, B1); PG8_BAR; PG8_SCHED;
            PG8_LDA(At, 1, 1); PG8_STAGE(PG8_SB(1, 0), b3, voffB); PG8_STAGE(PG8_SB(1, 1), b3 + hstep, voffB); PG8_STAGE(PG8_SA(1, 0), a3, voffA);
            PG8_WAIT_V(8); PG8_WAIT_L(0); PG8_BAR; PG8_MMA(1, 0, At, B0); PG8_MMA(1, 1, At, B1); PG8_BAR; PG8_SCHED;
            } else {
            PG8_LDB(B0, 0, 0); PG8_SCHED; PG8_LDA(At, 0, 0); PG8_STAGE(PG8_SA(1, 1), a1 + hstep, voffA);
            PG8_WAIT_L(8); PG8_BAR; PG8_WAIT_L(0); PG8_MMA(0, 0, At, B0); PG8_BAR; PG8_SCHED;
            PG8_LDB(B1, 0, 1); PG8_STAGE(PG8_SB(0, 0), b2, voffB);
            PG8_BAR; PG8_WAIT_L(0); PG8_MMA(0, 1, At, B1); PG8_BAR;
            PG8_LDA(At, 0, 1); PG8_STAGE(PG8_SA(0, 0), a2, voffA);
            PG8_BAR; PG8_WAIT_L(0); PG8_MMA(1, 0, At, B0); PG8_BAR; PG8_SCHED;
            PG8_STAGE(PG8_SB(0, 1), b2 + hstep, voffB);
            PG8_WAIT_V(6); PG8_BAR; PG8_MMA(1, 1, At, B1); PG8_BAR;
            PG8_LDB(B0, 1, 0); PG8_SCHED; PG8_LDA(At, 1, 0); PG8_STAGE(PG8_SA(0, 1), a2 + hstep, voffA);
            PG8_WAIT_L(8); PG8_BAR; PG8_WAIT_L(0); PG8_MMA(0, 0, At, B0); PG8_BAR; PG8_SCHED;
            PG8_LDB(B1, 1, 1); PG8_STAGE(PG8_SB(1, 0), b3, voffB);
            PG8_BAR; PG8_WAIT_L(0); PG8_MMA(0, 1, At, B1); PG8_BAR;
            PG8_LDA(At, 1, 1); PG8_STAGE(PG8_SA(1, 0), a3, voffA);
            PG8_BAR; PG8_WAIT_L(0); PG8_MMA(1, 0, At, B0); PG8_BAR; PG8_SCHED;
            PG8_STAGE(PG8_SB(1, 1), b3 + hstep, voffB);
            PG8_WAIT_V(6); PG8_BAR; PG8_MMA(1, 1, At, B1); PG8_BAR;
            }
        }
        if constexpr (ALIGN_EPI) { if (wr == 0) PG8_BAR; }
        if constexpr (!Epi::AFTER_DRAIN) { E(acc, cur, wr, wc, fr, fq); S.done(cur); }
        if (!has_next) break;
#pragma unroll
        for (int a = 0; a < 2; ++a)
#pragma unroll
            for (int b = 0; b < 2; ++b)
#pragma unroll
                for (int m = 0; m < 4; ++m)
#pragma unroll
                    for (int n = 0; n < 2; ++n) acc[a][b][m][n] = (f32x4){0.f, 0.f, 0.f, 0.f};
        cur = nxt; cA = nA; cB = nB; ++ui;
        if constexpr (ALIGN_EPI) { if (wr == 1) PG8_BAR; }
    }
    PG8_WAIT_V(0);
    if constexpr (!ALIGN_EPI) { if (wr == 0) PG8_BAR; }
    PG8_BAR;
    if constexpr (Epi::AFTER_DRAIN) { E.fused(acc, cur, wr, wc, fr, fq, lds, wid, lane); S.done(cur); }
#undef PG8_SA
#undef PG8_SB
#undef PG8_STAGE
#undef PG8_LDA
#undef PG8_LDB
#undef PG8_MMA
#undef PG8_WAIT_V
#undef PG8_WAIT_L
#undef PG8_BAR
#undef PG8_SCHED
}
}

namespace att {
using bf16x8 = __attribute__((ext_vector_type(8))) short;
using s16x4  = __attribute__((ext_vector_type(4))) short;
using f32x16 = __attribute__((ext_vector_type(16))) float;
using u32x4  = __attribute__((ext_vector_type(4))) unsigned;
constexpr int NW = 8, QBLK = 32, KVBLK = 64, QROWS = 128;
constexpr float SCALE = 0.125f, QPRESCALE = SCALE * 1.4426950408889634f, THRL = 24.f;
constexpr int SHM_V = KVBLK * 128 * 2, SHM_K = KVBLK * 128 * 2, SHM_ATTN = 2 * SHM_V + 2 * SHM_K + NW * 64 * 4;
#define KSWZ(row, colB) ((row) * 256 + ((colB) ^ (((row) & 7) << 4)))
#define SBAR() __builtin_amdgcn_sched_barrier(0)
__device__ __forceinline__ int crow(int r, int hi) { return (r & 3) + 8 * (r >> 2) + 4 * hi; }
__device__ __forceinline__ unsigned cvtpk(float lo, float hi) { unsigned r; asm volatile("v_cvt_pk_bf16_f32 %0, %1, %2" : "=v"(r) : "v"(lo), "v"(hi)); return r; }
__device__ __forceinline__ void qkt_lds(f32x16& p0, f32x16& p1, const char* Ks, const char* qrow  , float mh, int r32, int hi, int sub) {
#pragma unroll
  for (int r = 0; r < 16; ++r) { p0[r] = -mh; p1[r] = -mh; }
#pragma unroll
  for (int d0 = 0; d0 < 4; ++d0) { const int cb = (sub * 64 + d0 * 16 + hi * 8) * 2;
    const bf16x8 qf = *reinterpret_cast<const bf16x8*>(qrow + d0 * 32);
    const bf16x8 b0 = *reinterpret_cast<const bf16x8*>(Ks + KSWZ(r32, cb));
    const bf16x8 b1 = *reinterpret_cast<const bf16x8*>(Ks + KSWZ(32 + r32, cb));
    p0 = __builtin_amdgcn_mfma_f32_32x32x16_bf16(b0, qf, p0, 0, 0, 0);
    p1 = __builtin_amdgcn_mfma_f32_32x32x16_bf16(b1, qf, p1, 0, 0, 0); }
}
#define ATT_PK4(P, BASE, OUT) do { unsigned a0_ = cvtpk(P[BASE + 0], P[BASE + 1]), a1_ = cvtpk(P[BASE + 2], P[BASE + 3]);   \
    unsigned b0_ = cvtpk(P[BASE + 4], P[BASE + 5]), b1_ = cvtpk(P[BASE + 6], P[BASE + 7]);                              \
    auto r0_ = __builtin_amdgcn_permlane32_swap(a0_, b0_, false, false); auto r1_ = __builtin_amdgcn_permlane32_swap(a1_, b1_, false, false); \
    u32x4 w_ = {r0_[0], r1_[0], r0_[1], r1_[1]}; OUT = *reinterpret_cast<bf16x8*>(&w_); } while (0)
__device__ __forceinline__ void partialSM3(f32x16& p0, f32x16& p1, float& mhat, float& alpha, bf16x8& pa0, bf16x8& pa1, float& ps0) {
  float a = fmaxf(fmaxf(p0[0], p0[1]), p1[0]), b2 = fmaxf(fmaxf(p0[2], p0[3]), p1[1]); a = fmaxf(fmaxf(a, p1[2]), p1[3]);
#pragma unroll
  for (int r = 4; r < 16; r += 4) { a = fmaxf(fmaxf(a, p0[r]), p0[r + 1]); b2 = fmaxf(fmaxf(b2, p0[r + 2]), p0[r + 3]); a = fmaxf(fmaxf(a, p1[r]), p1[r + 1]); b2 = fmaxf(fmaxf(b2, p1[r + 2]), p1[r + 3]); }
  float rm = fmaxf(a, b2);
  { auto rr = __builtin_amdgcn_permlane32_swap(__float_as_uint(rm), __float_as_uint(rm), false, false);
    rm = fmaxf(__uint_as_float(rr[0]), __uint_as_float(rr[1])); }
  alpha = 1.f;
  if (__builtin_expect(__any(rm > THRL), 0)) {
    const float dl = fmaxf(rm, 0.f); mhat += dl;
#pragma unroll
    for (int r = 0; r < 16; ++r) { p0[r] -= dl; p1[r] -= dl; }
    alpha = __builtin_amdgcn_exp2f(-dl);
  }
  float s_ = 0.f;
#pragma unroll
  for (int r = 0; r < 16; ++r) { p0[r] = __builtin_amdgcn_exp2f(p0[r]); s_ += p0[r]; }
  ps0 = s_;
  ATT_PK4(p0, 0, pa0); ATT_PK4(p0, 8, pa1);
}
__device__ __forceinline__ void finishSM3(f32x16& p1, float alpha, float ps0, float& l_reg, bf16x8& pa2, bf16x8& pa3) {
#pragma unroll
  for (int r = 0; r < 16; ++r) p1[r] = __builtin_amdgcn_exp2f(p1[r]);
  float ps = ps0;
#pragma unroll
  for (int r = 0; r < 16; ++r) ps += p1[r];
  { auto rr = __builtin_amdgcn_permlane32_swap(__float_as_uint(ps), __float_as_uint(ps), false, false);
    ps = __uint_as_float(rr[0]) + __uint_as_float(rr[1]); }
  l_reg = l_reg * alpha + ps;
  ATT_PK4(p1, 0, pa2); ATT_PK4(p1, 8, pa3);
}
__device__ __forceinline__ int v_st(int k, int c) { const int kk = (k & ~0xC) | ((k & 4) << 1) | ((k & 8) >> 1); return ((kk >> 3) * 4 + (c >> 5)) * 512 + ((kk & 7) * 32 + (c & 31)) * 2; }
__device__ __forceinline__ int v_rd_base(int lane) { return ((lane & 3) << 3) | (((lane >> 2) & 3) << 6) | (((lane >> 4) & 1) << 5) | (((lane >> 5) & 1) << 8); }
constexpr int v_rd_off(int d0, int ks, int half) { return d0 * 512 + ks * 4096 + half * 2048; }
template <int OFF> __device__ __forceinline__ s16x4 tr_read(int vb) {
  s16x4 r; asm volatile("ds_read_b64_tr_b16 %0, %1 offset:%2" : "=&v"(r) : "v"(vb), "i"(OFF) : "memory"); return r;
}
template <int D0> __device__ __forceinline__ void pv_one(f32x16& od, int vb, bf16x8 pa0, bf16x8 pa1, bf16x8 pa2, bf16x8 pa3) {
  const s16x4 l0 = tr_read<v_rd_off(D0, 0, 0)>(vb), h0 = tr_read<v_rd_off(D0, 0, 1)>(vb), l1 = tr_read<v_rd_off(D0, 1, 0)>(vb), h1 = tr_read<v_rd_off(D0, 1, 1)>(vb);
  const s16x4 l2 = tr_read<v_rd_off(D0, 2, 0)>(vb), h2 = tr_read<v_rd_off(D0, 2, 1)>(vb), l3 = tr_read<v_rd_off(D0, 3, 0)>(vb), h3 = tr_read<v_rd_off(D0, 3, 1)>(vb);
  asm volatile("s_waitcnt lgkmcnt(0)" ::: "memory"); SBAR();
#define PK(L, H) (bf16x8){L[0], L[1], L[2], L[3], H[0], H[1], H[2], H[3]}
  od = __builtin_amdgcn_mfma_f32_32x32x16_bf16(pa0, PK(l0, h0), od, 0, 0, 0);
  od = __builtin_amdgcn_mfma_f32_32x32x16_bf16(pa1, PK(l1, h1), od, 0, 0, 0);
  od = __builtin_amdgcn_mfma_f32_32x32x16_bf16(pa2, PK(l2, h2), od, 0, 0, 0);
  od = __builtin_amdgcn_mfma_f32_32x32x16_bf16(pa3, PK(l3, h3), od, 0, 0, 0);
#undef PK
}
__device__ __forceinline__ void pv_d0(f32x16* o, int vb, bf16x8 pa0, bf16x8 pa1, bf16x8 pa2, bf16x8 pa3) {
  pv_one<0>(o[0], vb, pa0, pa1, pa2, pa3); pv_one<1>(o[1], vb, pa0, pa1, pa2, pa3); pv_one<2>(o[2], vb, pa0, pa1, pa2, pa3); pv_one<3>(o[3], vb, pa0, pa1, pa2, pa3);
}
__device__ __forceinline__ long ktile_row(int b, int t) { return t < 4 ? (long)(NLAT + b * CTXL + 64 * t) : (long)(b * SEQ + 64 * (t - 4)); }

constexpr int QROWS2 = 256, QT_ROWB = 272, QT_OFF = 2 * SHM_V + 2 * SHM_K + NW * 64 * 4, SHM_ATTN2 = QT_OFF + NW * 32 * QT_ROWB;
static_assert(SHM_ATTN2 <= LDS_PHASE_BYTES, "attention LDS map");
__device__ __forceinline__ void attn_unit2(const bf16_t* __restrict__ Pm, bf16_t* __restrict__ Y, long qrow0, int b, int hh, int NT, float lam, float lam_init,
                                           const float* __restrict__ subln, char* lds) {
  const int tid = opaque_tid(), wid = __builtin_amdgcn_readfirstlane(tid >> 6), lane = tid & 63, r32 = lane & 31, hi = lane >> 5;
  char* V_lds = lds; char* K_lds = lds + 2 * SHM_V;
  float* ws = (float*)(lds + 2 * SHM_V + 2 * SHM_K) + wid * 64; float* li_l = ws; float* al_l = ws + 32;
  char* qt = lds + QT_OFF + wid * (32 * QT_ROWB);
  const long wrow0 = qrow0 + wid * QBLK;
#pragma unroll
  for (int c8 = 0; c8 < 8; ++c8) { const int row = c8 * 4 + (lane >> 4), ch = lane & 15;
    *(uint4*)(qt + row * QT_ROWB + ch * 16) = *(const uint4*)(Pm + (wrow0 + row) * NP + C_QA + hh * 128 + ch * 8); }
  float mh0 = 0.f, mh1 = 0.f, l0 = 0.f, l1 = 0.f; f32x16 o0[4] = {}, o1[4] = {};
  const int vb0 = (int)(uintptr_t)V_lds + v_rd_base(lane);
  const unsigned ldsb = (unsigned)(uintptr_t)lds + (unsigned)(wid * 2048);
#define SDMA(t, bb) do { const char* tb_ = (const char*)(Pm + ktile_row(b, (t)) * NP + hh * 128); int ln_ = lane; asm volatile("" : "+v"(ln_)); \
    _Pragma("unroll") for (int i2 = 0; i2 < 2; ++i2) { const int sl = (wid * 2 + i2) * 64 + ln_; \
      const int krow = sl >> 4, kch = (sl & 15) ^ (krow & 7); const int kof = (krow * NP + C_KA + kch * 8) * 2; \
      const int kk = (sl >> 7) * 8 + ((sl & 31) >> 2), vc = ((sl >> 5) & 3) * 32 + (sl & 3) * 8, vk = (kk & ~0xC) | ((kk & 4) << 1) | ((kk & 8) >> 1); const int vof = (vk * NP + C_VA + vc) * 2; \
    __builtin_amdgcn_global_load_lds((const unsigned*)(tb_ + vof), (__attribute__((address_space(3))) unsigned*)(ldsb + (unsigned)((bb) * SHM_V + i2 * 1024)), 16, 0, 0); \
    __builtin_amdgcn_global_load_lds((const unsigned*)(tb_ + kof), (__attribute__((address_space(3))) unsigned*)(ldsb + (unsigned)(2 * SHM_V + (bb) * SHM_K + i2 * 1024)), 16, 0, 0); } } while (0)
#define RESC(o, a) do { if (__any((a) < 1.f)) { if (hi == 0) al_l[r32] = (a); asm volatile("s_waitcnt lgkmcnt(0)" ::: "memory"); \
    _Pragma("unroll") for (int r = 0; r < 16; ++r) { const float f_ = al_l[crow(r, hi)]; _Pragma("unroll") for (int d = 0; d < 4; ++d) o[d][r] *= f_; asm volatile("" ::: "memory"); } } } while (0)
  f32x16 pA1, pB1; float alA, alB, psA, psB; bf16x8 aA0, aA1, aB0, aB1, pa2, pa3;
  const char* qA = qt + r32 * QT_ROWB + (hi * 8) * 2;
#define qB (qA + 128)
  SDMA(0, 0); asm volatile("s_waitcnt vmcnt(0)" ::: "memory"); __syncthreads();
  { f32x16 t0; SBAR(); qkt_lds(t0, pA1, K_lds, qA, mh0, r32, hi, 0); partialSM3(t0, pA1, mh0, alA, aA0, aA1, psA); SBAR(); }
  if (1 < NT) SDMA(1, 1);
  { f32x16 t0; SBAR(); qkt_lds(t0, pB1, K_lds, qB, mh1, r32, hi, 1); finishSM3(pA1, alA, psA, l0, pa2, pa3); SBAR();
    pv_d0(o0, vb0, aA0, aA1, pa2, pa3); partialSM3(t0, pB1, mh1, alB, aB0, aB1, psB); SBAR(); }
  asm volatile("s_waitcnt vmcnt(0)" ::: "memory"); __syncthreads();
  for (int t = 1; t < NT; ++t) {
    const int cur = t & 1, prev = cur ^ 1;
    { f32x16 t0; SBAR(); qkt_lds(t0, pA1, K_lds + cur * SHM_K, qA, mh0, r32, hi, 0); RESC(o1, alB); finishSM3(pB1, alB, psB, l1, pa2, pa3); SBAR();
      pv_d0(o1, vb0 + prev * SHM_V, aB0, aB1, pa2, pa3); partialSM3(t0, pA1, mh0, alA, aA0, aA1, psA); SBAR(); }
    __syncthreads();
    if (t + 1 < NT) SDMA(t + 1, prev);
    RESC(o0, alA);
    { f32x16 t0; SBAR(); qkt_lds(t0, pB1, K_lds + cur * SHM_K, qB, mh1, r32, hi, 1); finishSM3(pA1, alA, psA, l0, pa2, pa3); SBAR();
      pv_d0(o0, vb0 + cur * SHM_V, aA0, aA1, pa2, pa3); partialSM3(t0, pB1, mh1, alB, aB0, aB1, psB); SBAR(); }
    asm volatile("s_waitcnt vmcnt(0)" ::: "memory"); __syncthreads();
  }
  RESC(o1, alB); finishSM3(pB1, alB, psB, l1, pa2, pa3); SBAR();
  pv_d0(o1, vb0 + ((NT - 1) & 1) * SHM_V, aB0, aB1, pa2, pa3);
  if (hi == 0) { li_l[r32] = l0; al_l[r32] = l1; } asm volatile("s_waitcnt lgkmcnt(0)" ::: "memory");
#pragma unroll
  for (int c8 = 0; c8 < 8; ++c8) { const int row = c8 * 4 + (lane >> 4), ch = lane & 15;
    *(uint4*)(qt + row * QT_ROWB + ch * 16) = *(const uint4*)(Pm + (wrow0 + row) * NP + C_GA + hh * 128 + ch * 8); }
  float ss[16];
#pragma unroll
  for (int r = 0; r < 16; ++r) { const float ra = __builtin_amdgcn_rcpf(li_l[crow(r, hi)]), rb = lam * __builtin_amdgcn_rcpf(al_l[crow(r, hi)]); float a = 0.f;
#pragma unroll
    for (int d0 = 0; d0 < 4; ++d0) { o0[d0][r] = o0[d0][r] * ra - o1[d0][r] * rb; a += o0[d0][r] * o0[d0][r]; }
    ss[r] = a; }
#pragma unroll
  for (int r = 0; r < 16; ++r) {
    ss[r] = rsqrtf(half_sum(ss[r], hi) * (1.f / 128.f) + EPS) * (1.f - lam_init);
  }
  float sw[4];
#pragma unroll
  for (int d0 = 0; d0 < 4; ++d0) sw[d0] = subln[d0 * 32 + r32];
  asm volatile("s_waitcnt vmcnt(0) lgkmcnt(0)" ::: "memory");
#pragma unroll
  for (int r = 0; r < 16; ++r) { bf16_t* tp = (bf16_t*)(qt + crow(r, hi) * QT_ROWB) + r32;
#pragma unroll
    for (int d0 = 0; d0 < 4; ++d0) { const float g = bf2f(tp[d0 * 32]); tp[d0 * 32] = f2bf(o0[d0][r] * ss[r] * sw[d0] * silu_f(g)); } }
  asm volatile("s_waitcnt lgkmcnt(0)" ::: "memory");
#pragma unroll
  for (int c8 = 0; c8 < 8; ++c8) { const int row = c8 * 4 + (lane >> 4), ch = lane & 15;
    *(uint4*)(Y + (wrow0 + row) * DM + hh * 128 + ch * 8) = *(const uint4*)(qt + row * QT_ROWB + ch * 16); }
  asm volatile("s_waitcnt lgkmcnt(0)" ::: "memory");
#undef SDMA
#undef RESC
#undef qB
}
#undef KSWZ
#undef SBAR
}

namespace mls {
using bf16x8 = __attribute__((ext_vector_type(8))) short;
using s16x4  = __attribute__((ext_vector_type(4))) short;
using f32x4  = __attribute__((ext_vector_type(4))) float;
constexpr int QSTRB = 272, SSTRB = 144;
constexpr int VSTRB = 528;
constexpr int L_Q = 0, L_K = L_Q + 64 * QSTRB, L_V = L_K + 64 * QSTRB, L_S = L_V + 64 * VSTRB, L_CT = L_S + 64 * SSTRB, L_SM = L_CT + 256 * QSTRB, L_END = L_SM + 8192;
static_assert(L_END <= LDS_PHASE_BYTES && (L_K % 16) == 0 && (L_V % 16) == 0 && (L_S % 16) == 0 && (L_CT % 16) == 0 && (L_SM % 16) == 0, "mlstm LDS map");
__device__ __forceinline__ f32x4 mfma16(bf16x8 a, bf16x8 b, f32x4 c) { return __builtin_amdgcn_mfma_f32_16x16x32_bf16(a, b, c, 0, 0, 0); }
struct TrPair { s16x4 lo, hi; };
__device__ __forceinline__ bf16x8 tr_pack(const TrPair& t) { return (bf16x8){t.lo[0], t.lo[1], t.lo[2], t.lo[3], t.hi[0], t.hi[1], t.hi[2], t.hi[3]}; }
__device__ __forceinline__ float wave_scan_incl(float v) {
  v += __builtin_bit_cast(float, __builtin_amdgcn_update_dpp(0, __builtin_bit_cast(int, v), 0x111, 0xF, 0xF, false));
  v += __builtin_bit_cast(float, __builtin_amdgcn_update_dpp(0, __builtin_bit_cast(int, v), 0x112, 0xF, 0xF, false));
  v += __builtin_bit_cast(float, __builtin_amdgcn_update_dpp(0, __builtin_bit_cast(int, v), 0x114, 0xF, 0xF, false));
  v += __builtin_bit_cast(float, __builtin_amdgcn_update_dpp(0, __builtin_bit_cast(int, v), 0x118, 0xF, 0xF, false));
  v += __builtin_bit_cast(float, __builtin_amdgcn_update_dpp(0, __builtin_bit_cast(int, v), 0x142, 0xA, 0xF, false));
  v += __builtin_bit_cast(float, __builtin_amdgcn_update_dpp(0, __builtin_bit_cast(int, v), 0x143, 0xC, 0xF, false));
  return v;
}
__device__ __forceinline__ float fast_tanh(float x) { return 1.f - 2.f * __builtin_amdgcn_rcpf(1.f + __expf(2.f * x)); }

__device__ __forceinline__ void tr_v4(unsigned base, TrPair& a0, TrPair& a1, TrPair& b0, TrPair& b1, TrPair& c0, TrPair& c1, TrPair& d0, TrPair& d1) {
  asm volatile(
    "ds_read_b64_tr_b16 %0, %16\n\tds_read_b64_tr_b16 %1, %16 offset:2112\n\tds_read_b64_tr_b16 %2, %16 offset:16896\n\tds_read_b64_tr_b16 %3, %16 offset:19008\n\t"
    "ds_read_b64_tr_b16 %4, %16 offset:32\n\tds_read_b64_tr_b16 %5, %16 offset:2144\n\tds_read_b64_tr_b16 %6, %16 offset:16928\n\tds_read_b64_tr_b16 %7, %16 offset:19040\n\t"
    "ds_read_b64_tr_b16 %8, %16 offset:64\n\tds_read_b64_tr_b16 %9, %16 offset:2176\n\tds_read_b64_tr_b16 %10, %16 offset:16960\n\tds_read_b64_tr_b16 %11, %16 offset:19072\n\t"
    "ds_read_b64_tr_b16 %12, %16 offset:96\n\tds_read_b64_tr_b16 %13, %16 offset:2208\n\tds_read_b64_tr_b16 %14, %16 offset:16992\n\tds_read_b64_tr_b16 %15, %16 offset:19104\n\t"
    "s_waitcnt lgkmcnt(0)"
    : "=&v"(a0.lo), "=&v"(a0.hi), "=&v"(a1.lo), "=&v"(a1.hi), "=&v"(b0.lo), "=&v"(b0.hi), "=&v"(b1.lo), "=&v"(b1.hi),
      "=&v"(c0.lo), "=&v"(c0.hi), "=&v"(c1.lo), "=&v"(c1.hi), "=&v"(d0.lo), "=&v"(d0.hi), "=&v"(d1.lo), "=&v"(d1.hi)
    : "v"(base) : "memory");
}
__device__ __forceinline__ bf16x8 scale_frag(const TrPair& t, const float4 wa, const float4 wb) {
  const float f0 = bf2f((bf16_t)t.lo[0]) * wa.x, f1 = bf2f((bf16_t)t.lo[1]) * wa.y, f2 = bf2f((bf16_t)t.lo[2]) * wa.z, f3 = bf2f((bf16_t)t.lo[3]) * wa.w;
  const float f4 = bf2f((bf16_t)t.hi[0]) * wb.x, f5 = bf2f((bf16_t)t.hi[1]) * wb.y, f6 = bf2f((bf16_t)t.hi[2]) * wb.z, f7 = bf2f((bf16_t)t.hi[3]) * wb.w;
  return __builtin_bit_cast(bf16x8, make_uint4(pk2(f0, f1), pk2(f2, f3), pk2(f4, f5), pk2(f6, f7)));
}

__device__ __forceinline__ void mlstm_unit(const bf16_t* __restrict__ Pm, const bf16_t* __restrict__ QKC  , const float* __restrict__ GATES,
                                           bf16_t* __restrict__ HM, const float* __restrict__ i_bias, const float* __restrict__ f_bias,
                                           int b, int head, int dir, bool ctx_out, unsigned* mdone, char* lds) {
  const int tid = opaque_tid(), wid = __builtin_amdgcn_readfirstlane(tid >> 6), lane = tid & 63, lr = lane & 15, kg = lane >> 4;
  char* q_lds = lds + L_Q; char* k_lds = lds + L_K; char* v_lds = lds + L_V; char* s_lds = lds + L_S; char* ct_lds = lds + L_CT;
  float* bl = (float*)(lds + L_SM); float* bsp = bl + 64; float* av = bsp + 64; float* wkl = av + 64; float* qn = wkl + 64; float* nvec = qn + 64; float* rs = nvec + 128; float* npart = rs + 1024;
  const unsigned lds0 = (unsigned)(uintptr_t)lds;
  const unsigned trq = (unsigned)((8 * kg + (lr >> 2)) * QSTRB + (4 * (lr & 3)) * 2), trv = (unsigned)((8 * kg + (lr >> 2)) * VSTRB + (4 * (lr & 3)) * 2);
  if (tid < 128) nvec[tid] = 0.f;
  const float ibias = i_bias[dir * 4 + head], fbias = f_bias[dir * 4 + head];
  const int chg = tid & 31, rg = tid >> 5; const bool isk = chg >= 16;
  const int qkcol = 1024 + (isk ? 512 : 0) + head * 128 + (chg & 15) * 8;
  const int vrow = tid >> 3, vch = tid & 7;
  uint4 pq0, pq1, pq2, pq3, pv0, pv1, pv2, pv3; float pgi, pgf;
#define MLS_LOAD(c_) do { const int c__ = (c_); const bool ic_ = c__ < 4; const int T_ = ic_ ? CTXL : SEQ, cc_ = ic_ ? c__ : c__ - 4; \
    const long rb_ = ic_ ? (long)(NLAT + b * CTXL) : (long)b * SEQ; const int t0_ = dir ? (T_ - 64 * (cc_ + 1)) : 64 * cc_; \
    { const bf16_t* qp_ = QKC + (rb_ + t0_ + rg) * DM + qkcol; pq0 = *(const uint4*)qp_; pq1 = *(const uint4*)(qp_ + 16 * DM); pq2 = *(const uint4*)(qp_ + 32 * DM); pq3 = *(const uint4*)(qp_ + 48 * DM); } \
    { const uint4* vp_ = (const uint4*)(Pm + (rb_ + t0_ + vrow) * NP + C_VB + head * 256 + vch * 32); pv0 = vp_[0]; pv1 = vp_[1]; pv2 = vp_[2]; pv3 = vp_[3]; } \
    const float* gr_ = GATES + (rb_ + t0_ + (dir ? 63 - lane : lane)) * 16; pgi = gr_[dir * 4 + head]; pgf = gr_[8 + dir * 4 + head]; } while (0)
  MLS_LOAD(0);
  f32x4 Cacc[16];
#pragma unroll
  for (int e = 0; e < 16; ++e) Cacc[e] = (f32x4){0.f, 0.f, 0.f, 0.f};
  float gprev = 0.f;
  __syncthreads();
  for (int c = 0; c < 36; ++c) {
    const bool isctx = c < 4; const int T = isctx ? CTXL : SEQ, cc = isctx ? c : c - 4;
    const long rowbase = isctx ? (long)(NLAT + b * CTXL) : (long)b * SEQ;
    const int t0 = dir ? (T - 64 * (cc + 1)) : 64 * cc;
    const bool need_h = ctx_out || !isctx;
    float gamma, wk_l;
    {
      const float igv = 15.f * fast_tanh((pgi + ibias) * (1.f / 15.f));
      const float fc = 15.f * fast_tanh((pgf + fbias) * (1.f / 15.f));
      const float lfv = fminf(fc, 0.f) - __logf(1.f + __expf(-fabsf(fc)));
      const float bcum = wave_scan_incl(lfv);
      const float b63 = __builtin_bit_cast(float, __builtin_amdgcn_readlane(__builtin_bit_cast(int, bcum), 63));
      gamma = __expf(b63); wk_l = __expf(b63 - bcum + igv);
      if (wid == 0) { bl[lane] = bcum; bsp[lane] = bcum - igv; av[lane] = __expf(bcum); wkl[lane] = wk_l; }
      if (c > 0 && tid < 128) nvec[tid] = gprev * nvec[tid] + (npart[tid] + npart[128 + tid]) + (npart[256 + tid] + npart[384 + tid]);
    }
#pragma unroll
    for (int eblk = 0; eblk < 16; ++eblk) { uint2 w_; w_.x = pk2(Cacc[eblk][0], Cacc[eblk][1]); w_.y = pk2(Cacc[eblk][2], Cacc[eblk][3]);
      *(uint2*)(ct_lds + (eblk * 16 + lr) * QSTRB + (wid * 16 + 4 * kg) * 2) = w_; }
    { char* dst = (isk ? k_lds : q_lds) + (chg & 15) * 16;
      *(uint4*)(dst + (dir ? 63 - rg : rg) * QSTRB) = pq0; *(uint4*)(dst + (dir ? 47 - rg : rg + 16) * QSTRB) = pq1;
      *(uint4*)(dst + (dir ? 31 - rg : rg + 32) * QSTRB) = pq2; *(uint4*)(dst + (dir ? 15 - rg : rg + 48) * QSTRB) = pq3; }
    { char* dst = v_lds + (dir ? 63 - vrow : vrow) * VSTRB + vch * 64;
      *(uint4*)dst = pv0; *(uint4*)(dst + 16) = pv1; *(uint4*)(dst + 32) = pv2; *(uint4*)(dst + 48) = pv3; }
    if (c + 1 < 36) MLS_LOAD(c + 1);
    __syncthreads();
    if (need_h) {
      const int lblk = wid >> 1;
#pragma unroll
      for (int u2 = 0; u2 < 2; ++u2) {
        const int sblk = 2 * (wid & 1) + u2;
        if (sblk <= lblk) {
          f32x4 acc = {0.f, 0.f, 0.f, 0.f};
#pragma unroll
          for (int ks = 0; ks < 4; ++ks) {
            const bf16x8 ka = *(const bf16x8*)(k_lds + (sblk * 16 + lr) * QSTRB + (ks * 32 + 8 * kg) * 2);
            const bf16x8 qb = *(const bf16x8*)(q_lds + (lblk * 16 + lr) * QSTRB + (ks * 32 + 8 * kg) * 2);
            acc = mfma16(ka, qb, acc);
          }
          const int l = lblk * 16 + lr; const float blv = bl[l];
          float v4[4]; float sum = 0.f;
#pragma unroll
          for (int r = 0; r < 4; ++r) { const int sidx = sblk * 16 + 4 * kg + r; const float w = (sidx <= l) ? __expf(blv - bsp[sidx]) : 0.f; v4[r] = acc[r] * w; sum += v4[r]; }
          uint2 w; w.x = pk2(v4[0], v4[1]); w.y = pk2(v4[2], v4[3]);
          *(uint2*)(s_lds + l * SSTRB + (sblk * 16 + 4 * kg) * 2) = w;
          rs[(sblk * 4 + kg) * 64 + l] = sum;
        } else if ((lblk == 0 && sblk == 1) || (lblk == 2 && sblk == 3)) {
          uint2 z_; z_.x = 0u; z_.y = 0u; asm volatile("" : "+v"(z_.x), "+v"(z_.y));
          *(uint2*)(s_lds + (lblk * 16 + lr) * SSTRB + (sblk * 16 + 4 * kg) * 2) = z_;
        }
      }
      { const int l = tid >> 3, part = tid & 7; float a = 0.f;
        const unsigned* qp = (const unsigned*)(q_lds + l * QSTRB + part * 32);
#pragma unroll
        for (int i = 0; i < 8; ++i) { const unsigned wd = qp[i]; a += __uint_as_float(wd << 16) * nvec[part * 16 + 2 * i] + __uint_as_float(wd & 0xffff0000u) * nvec[part * 16 + 2 * i + 1]; }
        a += __builtin_bit_cast(float, __builtin_amdgcn_update_dpp(0, __builtin_bit_cast(int, a), 0xB1, 0xF, 0xF, false));
        a += __builtin_bit_cast(float, __builtin_amdgcn_update_dpp(0, __builtin_bit_cast(int, a), 0x4E, 0xF, 0xF, false));
        a += __builtin_bit_cast(float, __builtin_amdgcn_update_dpp(0, __builtin_bit_cast(int, a), 0x141, 0xF, 0xF, false));
        if (part == 0) qn[l] = a; }
    }
    __syncthreads();
    if (need_h) {
      const int lblk = wid >> 1, l = lblk * 16 + lr, eh = wid & 1;
      float d = av[l] * qn[l];
      for (int sb = 0; sb <= lblk; ++sb) d += (rs[(sb * 4 + 0) * 64 + l] + rs[(sb * 4 + 1) * 64 + l]) + (rs[(sb * 4 + 2) * 64 + l] + rs[(sb * 4 + 3) * 64 + l]);
      const float a_l = av[l], dinv = 1.f / fmaxf(fabsf(d), 1.f);
      bf16x8 qb[4];
#pragma unroll
      for (int ks = 0; ks < 4; ++ks) qb[ks] = *(const bf16x8*)(q_lds + l * QSTRB + (ks * 32 + 8 * kg) * 2);
      const bf16x8 sb0 = *(const bf16x8*)(s_lds + l * SSTRB + (8 * kg) * 2);
      bf16x8 sb1 = sb0; if (lblk >= 2) sb1 = *(const bf16x8*)(s_lds + l * SSTRB + (32 + 8 * kg) * 2);
      const int t = dir ? (t0 + 63 - l) : (t0 + l);
      bf16_t* hp = HM + ((size_t)dir * NTOK + rowbase + t) * 1024 + head * 256 + eh * 128 + 4 * kg;
#pragma unroll
      for (int half = 0; half < 2; ++half) {
        TrPair a0, a1, b0, b1, c0, c1, d0, d1;
        tr_v4(lds0 + L_V + trv + (unsigned)((eh * 8 + half * 4) * 32), a0, a1, b0, b1, c0, c1, d0, d1);
        __builtin_amdgcn_sched_barrier(0);
#define MLS_HTILE(ti, VA0, VA1) do { const int eblk = eh * 8 + half * 4 + (ti); f32x4 acc1 = {0.f, 0.f, 0.f, 0.f}, acc2 = {0.f, 0.f, 0.f, 0.f}; \
          _Pragma("unroll") for (int ks = 0; ks < 4; ++ks) { const bf16x8 ca = *(const bf16x8*)(ct_lds + (eblk * 16 + lr) * QSTRB + (ks * 32 + 8 * kg) * 2); acc1 = mfma16(ca, qb[ks], acc1); } \
          acc2 = mfma16(tr_pack(VA0), sb0, acc2); if (lblk >= 2) acc2 = mfma16(tr_pack(VA1), sb1, acc2); \
          uint2 w_; w_.x = pk2((a_l * acc1[0] + acc2[0]) * dinv, (a_l * acc1[1] + acc2[1]) * dinv); w_.y = pk2((a_l * acc1[2] + acc2[2]) * dinv, (a_l * acc1[3] + acc2[3]) * dinv); \
          *(uint2*)(hp + (half * 4 + (ti)) * 16) = w_; } while (0)
        MLS_HTILE(0, a0, a1); MLS_HTILE(1, b0, b1); MLS_HTILE(2, c0, c1); MLS_HTILE(3, d0, d1);
#undef MLS_HTILE
      }
    }
    {
      bf16x8 kA0, kA1;
      { TrPair ka0, ka1; const unsigned ak = lds0 + L_K + trq + (unsigned)(wid * 32);
        asm volatile("ds_read_b64_tr_b16 %0, %4\n\tds_read_b64_tr_b16 %1, %4 offset:1088\n\tds_read_b64_tr_b16 %2, %4 offset:8704\n\tds_read_b64_tr_b16 %3, %4 offset:9792\n\ts_waitcnt lgkmcnt(0)"
                     : "=&v"(ka0.lo), "=&v"(ka0.hi), "=&v"(ka1.lo), "=&v"(ka1.hi) : "v"(ak) : "memory");
        const float4 w0 = *(const float4*)(wkl + 8 * kg), w1 = *(const float4*)(wkl + 8 * kg + 4), w2 = *(const float4*)(wkl + 32 + 8 * kg), w3 = *(const float4*)(wkl + 36 + 8 * kg);
        kA0 = scale_frag(ka0, w0, w1); kA1 = scale_frag(ka1, w2, w3); }
#pragma unroll
      for (int q4 = 0; q4 < 4; ++q4) {
        TrPair a0, a1, b0, b1, c0, c1, d0, d1;
        tr_v4(lds0 + L_V + trv + (unsigned)(q4 * 128), a0, a1, b0, b1, c0, c1, d0, d1);
        __builtin_amdgcn_sched_barrier(0);
#define MLS_CUPD(ti, V0, V1) do { f32x4 cc_ = Cacc[q4 * 4 + (ti)] * gamma; cc_ = mfma16(kA0, tr_pack(V0), cc_); cc_ = mfma16(kA1, tr_pack(V1), cc_); Cacc[q4 * 4 + (ti)] = cc_; } while (0)
        MLS_CUPD(0, a0, a1); MLS_CUPD(1, b0, b1); MLS_CUPD(2, c0, c1); MLS_CUPD(3, d0, d1);
#undef MLS_CUPD
      }
      { const int dd = tid & 127, sq = tid >> 7; float a = 0.f; const bf16_t* kp = (const bf16_t*)k_lds + (sq * 16) * (QSTRB / 2) + dd;
#pragma unroll
        for (int si = 0; si < 16; ++si) a += bf2f(kp[si * (QSTRB / 2)]) * wkl[sq * 16 + si];
        npart[sq * 128 + dd] = a; }
      gprev = gamma;
    }
    __syncthreads();
  }
#undef MLS_LOAD
  asm volatile("s_waitcnt vmcnt(0)" ::: "memory");
  __syncthreads();
  if (tid == 0) { __builtin_amdgcn_fence(__ATOMIC_RELEASE, "agent"); asm volatile("s_waitcnt vmcnt(0)" ::: "memory"); __hip_atomic_fetch_add(mdone + 64 * b, 1u, __ATOMIC_RELAXED, __HIP_MEMORY_SCOPE_AGENT); }
}
__device__ __forceinline__ void qkconv_phase(const bf16_t* __restrict__ Pm, bf16_t* __restrict__ QKC, const float* __restrict__ conv_w, const float* __restrict__ conv_b) {
  const int tid = opaque_tid(), lane = tid & 63, wave = tid >> 6;
  const int gw = blockIdx.x * 8 + wave, ngw = gridDim.x * 8;
  const int half = gw & 1, c0 = half * 512 + lane * 8;
  float cw0[8], cw1[8], cw2[8], cbv[8];
#pragma unroll
  for (int i = 0; i < 8; ++i) { cw0[i] = conv_w[c0 + i]; cw1[i] = conv_w[1024 + c0 + i]; cw2[i] = conv_w[2048 + c0 + i]; cbv[i] = conv_b[c0 + i]; }
  const float osc = half ? 0.08838834764831845f : 1.f;
  for (int it = gw >> 1; it < NTOK / 8; it += ngw >> 1) {
    const int r0 = it * 8; const bool isl = r0 < NLAT; const int seq0 = isl ? (r0 / SEQ) * SEQ : NLAT + ((r0 - NLAT) / CTXL) * CTXL, T = isl ? SEQ : CTXL;
    uint4 x[10];
#pragma unroll
    for (int r = 0; r < 10; ++r) { const int t = r0 - seq0 - 1 + r; x[r] = (t >= 0 && t < T) ? *(const uint4*)(Pm + (size_t)(seq0 + t) * NP + C_QB + c0) : make_uint4(0u, 0u, 0u, 0u); }
#pragma unroll
    for (int r = 0; r < 8; ++r) {
      const unsigned a0[4] = {x[r].x, x[r].y, x[r].z, x[r].w}, a1[4] = {x[r + 1].x, x[r + 1].y, x[r + 1].z, x[r + 1].w}, a2[4] = {x[r + 2].x, x[r + 2].y, x[r + 2].z, x[r + 2].w};
      float o[8];
#pragma unroll
      for (int i = 0; i < 8; ++i) {
        const float v0 = (i & 1) ? __uint_as_float(a0[i >> 1] & 0xffff0000u) : __uint_as_float(a0[i >> 1] << 16);
        const float v1 = (i & 1) ? __uint_as_float(a1[i >> 1] & 0xffff0000u) : __uint_as_float(a1[i >> 1] << 16);
        const float v2 = (i & 1) ? __uint_as_float(a2[i >> 1] & 0xffff0000u) : __uint_as_float(a2[i >> 1] << 16);
        const float z = cbv[i] + cw0[i] * v0 + cw1[i] * v1 + cw2[i] * v2;
        o[i] = osc * silu_f(z);
      }
      uint4 w; w.x = pk2(o[0], o[1]); w.y = pk2(o[2], o[3]); w.z = pk2(o[4], o[5]); w.w = pk2(o[6], o[7]);
      *(uint4*)(QKC + (size_t)(r0 + r) * DM + 1024 + c0) = w;
    }
  }
}
__device__ __forceinline__ void mlstm_phase(const bf16_t* __restrict__ Pm, const bf16_t* __restrict__ QKC, const float* __restrict__ GATES, bf16_t* __restrict__ HM,
                                            const float* __restrict__ i_bias, const float* __restrict__ f_bias, bool ctx_out, unsigned* mdone, char* lds) {
  const int G = gridDim.x, bx = blockIdx.x;
  if (G == 256) { const int vcu = (bx % 8) * 32 + bx / 8; if ((vcu & 31) < 8) { const int u = (vcu >> 5) * 8 + (vcu & 31); mlstm_unit(Pm, QKC, GATES, HM, i_bias, f_bias, u >> 3, (u >> 1) & 3, u & 1, ctx_out, mdone, lds); } }
  else for (int u = bx; u < 64; u += G) mlstm_unit(Pm, QKC, GATES, HM, i_bias, f_bias, u >> 3, (u >> 1) & 3, u & 1, ctx_out, mdone, lds);
}
}

DEVI void mod_unit(int unit, const float* __restrict__ c, const float* __restrict__ c_ctx, const float* __restrict__ w_ada, const float* __restrict__ b_ada, float* __restrict__ MOD, float* ldsf) {
    const int tid = opaque_tid(), lane = tid & 63, wv = tid >> 6;
    const int l = unit / 96, rem = unit % 96, cb = rem >> 2, kq = rem & 3;
    float* sc = ldsf; float* red = ldsf + 9 * 512;
    for (int i = tid; i < 9 * 512; i += 512) { const int r = i >> 9, k = kq * 512 + (i & 511); const float v = (r < 8) ? c[r * DM + k] : c_ctx[k]; sc[i] = silu_f(v); }
    __syncthreads();
    float4 acc[9];
#pragma unroll
    for (int r = 0; r < 9; ++r) acc[r] = make_float4(0.f, 0.f, 0.f, 0.f);
    const float4* w = (const float4*)(w_ada + (size_t)l * DM * MODW + (size_t)(kq * 512 + wv * 64) * MODW + cb * 256) + lane;
#pragma unroll 16
    for (int k = 0; k < 64; ++k) {
        const float4 wvv = w[(size_t)k * (MODW / 4)];
#pragma unroll
        for (int r = 0; r < 9; ++r) { const float s_ = sc[r * 512 + wv * 64 + k]; acc[r].x += s_ * wvv.x; acc[r].y += s_ * wvv.y; acc[r].z += s_ * wvv.z; acc[r].w += s_ * wvv.w; }
    }
#pragma unroll
    for (int r = 0; r < 9; ++r) ((float4*)red)[(wv * 9 + r) * 64 + lane] = acc[r];
    __syncthreads();
    for (int idx = tid; idx < 9 * 256; idx += 512) {
        const int r = idx >> 8, cc = idx & 255; float s_ = (kq == 0) ? b_ada[l * MODW + cb * 256 + cc] : 0.f;
#pragma unroll
        for (int g = 0; g < 8; ++g) s_ += red[(g * 9 + r) * 256 + cc];
        atomicAdd(MOD + (size_t)(l * 9 + r) * MODW + cb * 256 + cc, s_);
    }
    __syncthreads();
}
DEVI void transpose_items(const float* __restrict__ W, int ldw, int K, int N, bf16_t* __restrict__ WT, float* scr, int gw, int ngw, int lane) {
    const int nitems = (K / 64) * (N / 64);
    for (int it = gw; it < nitems; it += ngw) transpose_item(W, ldw, K, N, WT, scr, it, lane);
}
DEVI void finish_row(const bf16_t* __restrict__ P, const bf16_t* __restrict__ HM, const float* __restrict__ mnorm, bf16_t* __restrict__ Y, int row, int lane) {
#pragma unroll
    for (int head = 0; head < 4; ++head) {
        const int col = head * 256 + 4 * lane;
        const uint2 a = *(const uint2*)(HM + (size_t)row * 1024 + col), c = *(const uint2*)(HM + ((size_t)NTOK + row) * 1024 + col);
        float h[4];
        h[0] = __uint_as_float(a.x << 16) + __uint_as_float(c.x << 16); h[1] = __uint_as_float(a.x & 0xffff0000u) + __uint_as_float(c.x & 0xffff0000u);
        h[2] = __uint_as_float(a.y << 16) + __uint_as_float(c.y << 16); h[3] = __uint_as_float(a.y & 0xffff0000u) + __uint_as_float(c.y & 0xffff0000u);
        const float ss = wave_sum(h[0] * h[0] + h[1] * h[1] + h[2] * h[2] + h[3] * h[3]);
        const float r = rsqrtf(ss * (1.f / 256.f) + EPS);
        const uint2 ov = *(const uint2*)(P + (size_t)row * NP + C_OB + col), gv = *(const uint2*)(P + (size_t)row * NP + C_GB + col);
        const float o[4] = {__uint_as_float(ov.x << 16), __uint_as_float(ov.x & 0xffff0000u), __uint_as_float(ov.y << 16), __uint_as_float(ov.y & 0xffff0000u)};
        const float g[4] = {__uint_as_float(gv.x << 16), __uint_as_float(gv.x & 0xffff0000u), __uint_as_float(gv.y << 16), __uint_as_float(gv.y & 0xffff0000u)};
        const float4 w = *(const float4*)(mnorm + col);
        const float wv[4] = {w.x, w.y, w.z, w.w};
        float y[4];
#pragma unroll
        for (int e = 0; e < 4; ++e) y[e] = h[e] * r * wv[e] * sigmoid_f(o[e]) * silu_f(g[e]);
        uint2 out; out.x = pk2(y[0], y[1]); out.y = pk2(y[2], y[3]);
        *(uint2*)(Y + (size_t)row * DM + 1024 + col) = out;
    }
}
DEVI void load_row(const float* __restrict__ xr, float4 (&v)[8], int lane) {
#pragma unroll
    for (int j = 0; j < 8; ++j) v[j] = ((const float4*)xr)[lane + 64 * j];
}
DEVI void load_row_y(const bf16_t* __restrict__ yr, uint2 (&yv)[8], int lane) {
#pragma unroll
    for (int j = 0; j < 8; ++j) yv[j] = *(const uint2*)(yr + 4 * (lane + 64 * j));
}
DEVI void post_regs(float4 (&v)[8], const uint2 (&yv)[8], const float* gate, const float* npost, float* __restrict__ orow, int lane) {
    float ss = 0.f;
#pragma unroll
    for (int j = 0; j < 8; ++j) {
        const float y0 = __uint_as_float(yv[j].x << 16), y1 = __uint_as_float(yv[j].x & 0xffff0000u), y2 = __uint_as_float(yv[j].y << 16), y3 = __uint_as_float(yv[j].y & 0xffff0000u);
        ss += y0 * y0 + y1 * y1 + y2 * y2 + y3 * y3;
    }
    ss = wave_sum(ss);
    const float rstd = rsqrtf(ss * (1.f / DM) + EPS);
#pragma unroll
    for (int j = 0; j < 8; ++j) {
        const float4 gt = ((const float4*)gate)[lane + 64 * j], w = ((const float4*)npost)[lane + 64 * j];
        const float y0 = __uint_as_float(yv[j].x << 16), y1 = __uint_as_float(yv[j].x & 0xffff0000u), y2 = __uint_as_float(yv[j].y << 16), y3 = __uint_as_float(yv[j].y & 0xffff0000u);
        v[j].x += gt.x * (y0 * rstd * w.x); v[j].y += gt.y * (y1 * rstd * w.y); v[j].z += gt.z * (y2 * rstd * w.z); v[j].w += gt.w * (y3 * rstd * w.w);
        ((float4*)orow)[lane + 64 * j] = v[j];
        if (j == 3) asm volatile("" ::: "memory");
    }
}
DEVI void norm_regs(const float4 (&v)[8], const float* shift, const float* scale, const float* npre, bf16_t* __restrict__ hrow, char* trow, int lane) {
    float ss = 0.f;
#pragma unroll
    for (int j = 0; j < 8; ++j) ss += v[j].x * v[j].x + v[j].y * v[j].y + v[j].z * v[j].z + v[j].w * v[j].w;
    ss = wave_sum(ss);
    const float rstd = rsqrtf(ss * (1.f / DM) + EPS);
#pragma unroll
    for (int j = 0; j < 8; ++j) {
        const float4 w = ((const float4*)npre)[lane + 64 * j], sh = ((const float4*)shift)[lane + 64 * j], sc = ((const float4*)scale)[lane + 64 * j];
        uint2 o;
        o.x = pk2(v[j].x * rstd * w.x * (1.f + sc.x) + sh.x, v[j].y * rstd * w.y * (1.f + sc.y) + sh.y);
        o.y = pk2(v[j].z * rstd * w.z * (1.f + sc.z) + sh.z, v[j].w * rstd * w.w * (1.f + sc.w) + sh.w);
        *(uint2*)(hrow + 4 * (lane + 64 * j)) = o; *(uint2*)(trow + 8 * (lane + 64 * j)) = o;
        if (j == 3) asm volatile("" ::: "memory");
    }
}
constexpr int NT_ROWB = (DM + 8) * 2;
constexpr int NV_OFF = 0, NT_OFF = 5 * DM * 4, NR_OFF = NT_OFF + 16 * NT_ROWB, NPH_LDS = NR_OFF + 8 * 16 * 16 * 4;
static_assert(NPH_LDS <= LDS_PHASE_BYTES, "norm phase LDS map");
template <bool POST>
DEVI void norm_phase(const float* __restrict__ xlat, const float* __restrict__ xctx, const bf16_t* __restrict__ Y2, const float* __restrict__ mod_post, const float* __restrict__ npost,
                     float* olat, float* octx, const float* __restrict__ mod_n, const float* __restrict__ npre, const bf16_t* __restrict__ wgt, bf16_t* __restrict__ H,
                     float* __restrict__ GATES, char* lds) {
    typedef short bf16x8 __attribute__((ext_vector_type(8))); typedef float f32x4 __attribute__((ext_vector_type(4)));
    const int tid = opaque_tid(), lane = tid & 63, wave = __builtin_amdgcn_readfirstlane(tid >> 6), lr = lane & 15, kgp = lane >> 4;
    float* vec = (float*)(lds + NV_OFF); float* v_npre = vec; float* v_shift = vec + DM; float* v_scale = vec + 2 * DM; float* v_npost = vec + 3 * DM; float* v_gate = vec + 4 * DM;
    char* tile = lds + NT_OFF; float* red = (float*)(lds + NR_OFF);
    ((float4*)v_npre)[tid] = ((const float4*)npre)[tid];
    if (POST) ((float4*)v_npost)[tid] = ((const float4*)npost)[tid];
    int cur_b = -1;
#define NP_ENSURE(bb) do { if ((bb) != cur_b) { __syncthreads(); const float* mn_ = mod_n + (size_t)(bb) * MODW; ((float4*)v_shift)[tid] = ((const float4*)mn_)[tid]; ((float4*)v_scale)[tid] = ((const float4*)(mn_ + DM))[tid]; \
        if (POST) ((float4*)v_gate)[tid] = ((const float4*)(mod_post + (size_t)(bb) * MODW + 2 * DM))[tid]; cur_b = (bb); __syncthreads(); } } while (0)
    const int row0 = (int)blockIdx.x * (NTOK / 256);
    for (int g = 0; g < 5; ++g) {
        const int gr0 = row0 + 16 * g; const bool two = g < 4;
        const int rowA = gr0 + wave, rowB = gr0 + 8 + wave;
        const bool islA = rowA < NLAT, islB = rowB < NLAT; const int bA = gr0 < NLAT ? gr0 / SEQ : 8, bB = (gr0 + 8) < NLAT ? (gr0 + 8) / SEQ : 8;
        float4 vA[8], vB[8]; uint2 yA[8], yB[8];
        load_row(islA ? xlat + (size_t)rowA * DM : xctx + (size_t)(rowA - NLAT) * DM, vA, lane);
        if (POST) load_row_y(Y2 + (size_t)rowA * DM, yA, lane);
        if (two) { load_row(islB ? xlat + (size_t)rowB * DM : xctx + (size_t)(rowB - NLAT) * DM, vB, lane); if (POST) load_row_y(Y2 + (size_t)rowB * DM, yB, lane); }
        NP_ENSURE(bA);
        if (POST) post_regs(vA, yA, v_gate, v_npost, islA ? olat + (size_t)rowA * DM : octx + (size_t)(rowA - NLAT) * DM, lane);
        norm_regs(vA, v_shift, v_scale, v_npre, H + (size_t)rowA * DM, tile + wave * NT_ROWB, lane);
        if (two) {
            NP_ENSURE(bB);
            if (POST) post_regs(vB, yB, v_gate, v_npost, islB ? olat + (size_t)rowB * DM : octx + (size_t)(rowB - NLAT) * DM, lane);
            norm_regs(vB, v_shift, v_scale, v_npre, H + (size_t)rowB * DM, tile + (8 + wave) * NT_ROWB, lane);
        }
        __syncthreads();
        f32x4 acc = {0.f, 0.f, 0.f, 0.f};
#pragma unroll
        for (int ks = 0; ks < 8; ++ks) {
            const bf16x8 af = *(const bf16x8*)(tile + lr * NT_ROWB + (wave * 256 + ks * 32 + 8 * kgp) * 2);
            const bf16x8 bf = *(const bf16x8*)(wgt + lr * DM + wave * 256 + ks * 32 + 8 * kgp);
            acc = __builtin_amdgcn_mfma_f32_16x16x32_bf16(af, bf, acc, 0, 0, 0);
        }
#pragma unroll
        for (int r = 0; r < 4; ++r) red[(wave * 16 + 4 * kgp + r) * 16 + lr] = acc[r];
        __syncthreads();
        if (tid < 256) { const int rr = tid >> 4, cc = tid & 15;
            if (two || rr < 8) { float sum = 0.f;
#pragma unroll
                for (int w8 = 0; w8 < 8; ++w8) sum += red[(w8 * 16 + rr) * 16 + cc];
                GATES[(size_t)(gr0 + rr) * 16 + cc] = sum; } }
    }
#undef NP_ENSURE
    __syncthreads();
}
DEVI void post_phase_final(float* out, const bf16_t* __restrict__ Y2, const float* __restrict__ mod_l, const float* __restrict__ npost, char* lds) {
    const int tid = opaque_tid(), lane = tid & 63, wave = tid >> 6;
    float* v_gate = (float*)lds; float* v_npost = v_gate + DM;
    const int row0 = (int)blockIdx.x * (NLAT / 256), b = row0 / SEQ;
    ((float4*)v_gate)[tid] = ((const float4*)(mod_l + (size_t)b * MODW + 2 * DM))[tid];
    ((float4*)v_npost)[tid] = ((const float4*)npost)[tid];
    __syncthreads();
    float4 vA[8], vB[8]; uint2 yA[8], yB[8];
    const int r0 = row0 + wave * 8;
    load_row(out + (size_t)r0 * DM, vA, lane); load_row_y(Y2 + (size_t)r0 * DM, yA, lane);
    load_row(out + (size_t)(r0 + 1) * DM, vB, lane); load_row_y(Y2 + (size_t)(r0 + 1) * DM, yB, lane);
#pragma unroll 1
    for (int i = 0; i < 4; ++i) {
        const int ra = r0 + 2 * i, rb = ra + 1;
        post_regs(vA, yA, v_gate, v_npost, out + (size_t)ra * DM, lane);
        if (i < 3) { load_row(out + (size_t)(ra + 2) * DM, vA, lane); load_row_y(Y2 + (size_t)(ra + 2) * DM, yA, lane); }
        post_regs(vB, yB, v_gate, v_npost, out + (size_t)rb * DM, lane);
        if (i < 3) { load_row(out + (size_t)(rb + 2) * DM, vB, lane); load_row_y(Y2 + (size_t)(rb + 2) * DM, yB, lane); }
    }
    __syncthreads();
}

DEVI void mixer_queue(const bf16_t* __restrict__ Pm, bf16_t* __restrict__ Y, const bf16_t* __restrict__ HM, const float* lq1, const float* lk1, const float* lq2, const float* lk2,
                      const float* __restrict__ subln, const float* __restrict__ mnorm, float lam_init, bool ctx_out, unsigned* qcnt  ,
                      unsigned* mdone  , volatile __attribute__((address_space(3))) unsigned* bcast, char* lds) {
  const int tid = opaque_tid(), lane = tid & 63;
  const float lam = rl_f(expf(wave_sum(lq1[lane] * lk1[lane])) - expf(wave_sum(lq2[lane] * lk2[lane])) + lam_init, 0);
  const int G = gridDim.x, bx = blockIdx.x; const int vcu = (G % 8 == 0) ? (bx % 8) * (G / 8) + bx / 8 : bx;
  const int g0 = (G == 256) ? (vcu >> 5) : (bx & 7);
  const int natt = 64 + (ctx_out ? 8 : 0), nun = natt + 32 + (ctx_out ? 4 : 0);
  for (int gi = 0; gi < 8; ++gi) {
    const int g = (g0 + gi) & 7;
    for (;;) {
      if (opaque_tid() == 0) bcast[0] = __hip_atomic_fetch_add(qcnt + 64 * g, 1u, __ATOMIC_RELAXED, __HIP_MEMORY_SCOPE_AGENT);
      __syncthreads();
      const int u = (int)bcast[0];
      __syncthreads();
      if (u >= nun) break;
      if (u < 64) { const int bh = g * 8 + (u >> 3), qb = u & 7, b = bh >> 3, hh = bh & 7; att::attn_unit2(Pm, Y, (long)b * SEQ + qb * att::QROWS2, b, hh, 36, lam, lam_init, subln, lds); }
      else if (u < natt) { const int bh = g * 8 + (u - 64), b = bh >> 3, hh = bh & 7; att::attn_unit2(Pm, Y, (long)NLAT + b * CTXL, b, hh, 4, lam, lam_init, subln, lds); }
      else {
        const int f = u - natt; const int row0 = f < 32 ? g * SEQ + f * 64 : NLAT + g * CTXL + (f - 32) * 64;
        if (opaque_tid() == 0) {
          unsigned spins = 0;
          while (__hip_atomic_load(mdone + 64 * g, __ATOMIC_RELAXED, __HIP_MEMORY_SCOPE_AGENT) < 8u) { __builtin_amdgcn_s_sleep(8); if (++spins > (1u << 22)) break; }
          __builtin_amdgcn_fence(__ATOMIC_ACQUIRE, "agent");
          asm volatile("s_waitcnt vmcnt(0)" ::: "memory");
        }
        __syncthreads();
        const int tid2 = opaque_tid();
#pragma unroll 1
        for (int r = 0; r < 8; ++r) finish_row(Pm, HM, mnorm, Y, row0 + (tid2 >> 6) * 8 + r, tid2 & 63);
      }
    }
  }
}

#define XB_TMO      128
#define XB_XCNT(j)  (256  + 64 * (j))
#define XB_XSUB(j)  (1280 + 64 * (j))
#define XB_XGEN(j)  (2304 + 64 * (j))
#define XB_TOP      3328
#define XB_TOPGEN   3392
#define XCD_BAR_WORDS 3456
#define XB_SPIN_CAP (1u << 18)

__device__ __forceinline__ unsigned xb_ld(unsigned* p)              { return __hip_atomic_load(p, __ATOMIC_RELAXED, __HIP_MEMORY_SCOPE_AGENT); }
__device__ __forceinline__ unsigned xb_add(unsigned* p, unsigned v) { return __hip_atomic_fetch_add(p, v, __ATOMIC_RELAXED, __HIP_MEMORY_SCOPE_AGENT); }
__device__ __forceinline__ unsigned xb_xcc_id() { return (unsigned)__builtin_amdgcn_s_getreg((3 << 11) | 20) & 0xFu; }
#define XB_SPIN(cond, bar) do { unsigned _sp = 0; while (cond) { __builtin_amdgcn_s_sleep(1); \
    if ((++_sp & 255u) == 0u) { if (xb_ld(&(bar)[XB_TMO])) break; if (_sp > XB_SPIN_CAP) { atomicAdd(&(bar)[XB_TMO], 1u); break; } } } } while (0)

struct XcdBarrier {
    unsigned* bar; unsigned x;
    volatile __attribute__((address_space(3))) unsigned* st;
};

__device__ __forceinline__ XcdBarrier xcd_barrier_post(unsigned* bar, volatile __attribute__((address_space(3))) unsigned* st) {
    XcdBarrier b; b.bar = bar; b.x = xb_xcc_id(); b.st = st;
    if (threadIdx.x == 0) (void)xb_add(&bar[XB_XCNT(b.x)], 1u);
    return b;
}
__device__ __forceinline__ void xcd_barrier_complete(unsigned* bar, unsigned x, unsigned& nloc, unsigned& nx) {
    const unsigned G = gridDim.x * gridDim.y * gridDim.z;
    unsigned sum, cnt, mine, sp = 0u;
    for (;;) {
        sum = 0u; cnt = 0u; mine = 0u;
#pragma unroll
        for (unsigned j = 0; j < 16; ++j) { const unsigned c = xb_ld(&bar[XB_XCNT(j)]); sum += c; cnt += (c > 0u) ? 1u : 0u; mine = (j == x) ? c : mine; }
        if (sum == G) break;
        __builtin_amdgcn_s_sleep(1);
        if ((++sp & 255u) == 0u) { if (xb_ld(&bar[XB_TMO])) break; if (sp > XB_SPIN_CAP) { atomicAdd(&bar[XB_TMO], 1u); break; } }
    }
    nloc = mine > 0u ? mine : 1u; nx = cnt > 0u ? cnt : 1u;
}

__device__ __forceinline__ void xcd_barrier(const XcdBarrier& b) {
    asm volatile("s_waitcnt vmcnt(0)" ::: "memory");
    __syncthreads();
    if (threadIdx.x == 0) {
        unsigned* bar = b.bar;
        __builtin_amdgcn_s_waitcnt(0);
        unsigned nloc = b.st[0], nx = b.st[1];
        if (nloc == 0u) { xcd_barrier_complete(bar, b.x, nloc, nx); b.st[0] = nloc; b.st[1] = nx; }
        const unsigned old = xb_add(&bar[XB_XSUB(b.x)], 1u);
        const unsigned gen = old / nloc;
        if (old + 1u == (gen + 1u) * nloc) {
            __builtin_amdgcn_fence(__ATOMIC_RELEASE, "agent");
            asm volatile("s_waitcnt vmcnt(0)" ::: "memory");
            const unsigned og = xb_add(&bar[XB_TOP], 1u);
            const unsigned tg = og / nx;
            if (og + 1u == (tg + 1u) * nx) xb_add(&bar[XB_TOPGEN], 1u);
            else XB_SPIN(xb_ld(&bar[XB_TOPGEN]) == tg, bar);
            __builtin_amdgcn_fence(__ATOMIC_ACQUIRE, "agent");
            xb_add(&bar[XB_XGEN(b.x)], 1u);
            asm volatile("s_waitcnt vmcnt(0)" ::: "memory");
        } else {
            XB_SPIN(xb_ld(&bar[XB_XGEN(b.x)]) == gen, bar);
            __builtin_amdgcn_fence(__ATOMIC_ACQUIRE, "agent");
            asm volatile("s_waitcnt vmcnt(0)" ::: "memory");
        }
    }
    __syncthreads();
}

namespace cg = cooperative_groups;
constexpr int MEGA_LDS = LDS_PHASE_BYTES + 256;
struct MegaArgs { const float* in[20]; float* out; unsigned char* ws; };
DEVI const float* karg_in(int i) { const char* kp = (const char*)__builtin_amdgcn_kernarg_segment_ptr(); asm volatile("" : "+s"(kp)); return *(const float* const*)(kp + 8 * i); }
DEVI unsigned char* karg_ws() { const char* kp = (const char*)__builtin_amdgcn_kernarg_segment_ptr(); asm volatile("" : "+s"(kp)); return *(unsigned char* const*)(kp + 168); }
DEVI float* karg_out() { const char* kp = (const char*)__builtin_amdgcn_kernarg_segment_ptr(); asm volatile("" : "+s"(kp)); return *(float* const*)(kp + 160); }
typedef const __attribute__((address_space(4))) MegaArgs* KArgP;
DEVI KArgP kargs() {
    const unsigned long long p = (unsigned long long)__builtin_amdgcn_kernarg_segment_ptr();
    unsigned lo = (unsigned)p, hi = (unsigned)(p >> 32);
    asm volatile("" : "+s"(lo), "+s"(hi));
    lo = __builtin_amdgcn_readfirstlane(lo); hi = __builtin_amdgcn_readfirstlane(hi);
    return (KArgP)(((unsigned long long)hi << 32) | lo);
}
#define LAS3 __attribute__((address_space(3)))
__global__ __launch_bounds__(512, 2) void mega_fwd(MegaArgs a_unused) {
    (void)a_unused;
    extern __shared__ __attribute__((aligned(16))) unsigned char lds[];
    cg::grid_group grid = cg::this_grid();
    { volatile LAS3 unsigned* MISC = (volatile LAS3 unsigned*)((LAS3 unsigned char*)lds + LDS_PHASE_BYTES);
      if (threadIdx.x < 64) MISC[threadIdx.x] = 0u;
      __syncthreads();
      if ((threadIdx.x & 63) == 0) ((volatile LAS3 unsigned char*)MISC)[128 + ((unsigned)__builtin_amdgcn_s_getreg((5 << 11) | 4) & 63u)] = (unsigned char)(threadIdx.x >> 6);
      __syncthreads();
      (void)xcd_barrier_post((unsigned*)(kargs()->ws + WS_CTL) + 4096, MISC + 8); }
#define GRID_BAR() do { XcdBarrier b_; b_.bar = (unsigned*)(kargs()->ws + WS_CTL) + 4096; b_.x = xb_xcc_id(); b_.st = (volatile LAS3 unsigned*)((LAS3 unsigned char*)lds + LDS_PHASE_BYTES) + 8; xcd_barrier(b_); } while (0)
#define PHASE_IDS const int G = gridDim.x; const int tid = opaque_tid(), lane = tid & 63, wave = tid >> 6, gw = blockIdx.x * 8 + wave, ngw = G * 8; (void)tid; (void)lane; (void)gw; (void)ngw; float* scr = (float*)lds + wave * (64 * 65); (void)scr
#define WSP(T, off) ((T*)(A->ws + (off)))

    { PHASE_IDS; KArgP A = kargs(); (void)scr; (void)wave; float acc_ = 0.f;
      const size_t n0_ = (size_t)2 * DM * MODW / 4, n1_ = (size_t)DM * INC / 4, n2_ = (size_t)2 * DM * DM / 4;
      const float4* p0_ = (const float4*)A->in[4]; const float4* p1_ = (const float4*)A->in[8]; const float4* p2_ = (const float4*)A->in[9];
      const size_t g_ = (size_t)blockIdx.x * 512 + tid, ng_ = (size_t)G * 512;
#pragma unroll 8
      for (size_t i = g_; i < n0_; i += ng_) { const float4 v_ = p0_[i]; acc_ += (v_.x + v_.y) + (v_.z + v_.w); }
#pragma unroll 8
      for (size_t i = g_; i < n1_; i += ng_) { const float4 v_ = p1_[i]; acc_ += (v_.x + v_.y) + (v_.z + v_.w); }
#pragma unroll 8
      for (size_t i = g_; i < n2_; i += ng_) { const float4 v_ = p2_[i]; acc_ += (v_.x + v_.y) + (v_.z + v_.w); }
      if (acc_ == 1.2345678e37f) WSP(float, WS_ROPE)[4096 + tid] = acc_; }
    { PHASE_IDS; KArgP A = kargs();
      const float* w_in = A->in[8]; const float* w_out = A->in[9]; bf16_t* WIN = WSP(bf16_t, WS_WIN); bf16_t* WOUT = WSP(bf16_t, WS_WOUT); float* ROPE = WSP(float, WS_ROPE);
      for (int u = blockIdx.x; u < 192; u += G) mod_unit(u, A->in[1], A->in[3], A->in[4], A->in[5], WSP(float, WS_MOD), (float*)lds);
      { bf16_t* WGT = WSP(bf16_t, WS_WGT); for (int i = blockIdx.x * 512 + tid; i < 2 * 16 * DM; i += G * 512) { const int l_ = i >> 15, k_ = (i >> 4) & (DM - 1), c_ = i & 15; WGT[(l_ * 16 + c_) * DM + k_] = f2bf(w_in[(size_t)l_ * DM * INC + (size_t)k_ * INC + NP + c_]); } }
      for (int i = blockIdx.x * 512 + tid; i < 1024; i += G * 512) { const int pos = i >> 4, f = i & 15; const float inv = powf(10000.f, -(float)f / 16.f); const float ang = (float)pos * inv;
          ROPE[2 * i] = cosf(ang); ROPE[2 * i + 1] = sinf(ang); }
      {
          const bool light = (G == 256) && ((int)blockIdx.x < 192);
          const int nv = (G == 256) ? (light ? 2 : 6) : 1, v0 = (G == 256) ? (light ? gw * 2 : 192 * 8 * 2 + (gw - 192 * 8) * 6) : gw, nvw = (G == 256) ? 6144 : ngw;
          for (int q = 0; q < nv; ++q) {
              const int vw_ = v0 + q;
              for (int it = vw_; it < 6144; it += nvw) {
                  if (it < 4096) transpose_item(w_in, INC, DM, NP, WIN, scr, it, lane);
                  else if (it < 5120) transpose_item(w_out, DM, DM, DM, WOUT, scr, it - 4096, lane);
                  else transpose_item(w_out + (size_t)DM * DM, DM, DM, DM, WOUT + (size_t)DM * DM, scr, it - 5120, lane);
              }
          }
      } }
    if (gridDim.x > 65536u) grid.sync();
    GRID_BAR();
    { KArgP A = kargs();
      norm_phase<false>(A->in[0], A->in[2], nullptr, nullptr, nullptr, nullptr, nullptr, WSP(float, WS_MOD), A->in[6], WSP(bf16_t, WS_WGT), WSP(bf16_t, WS_H), WSP(float, WS_GATES), (char*)lds); }
    GRID_BAR();
    for (int l = 0; l < 2; ++l) {
        { KArgP A = kargs();
          pg8::Gemm g{WSP(bf16_t, WS_H), WSP(bf16_t, WS_WIN), NTOK, NP, DM}; pg8::StaticOrder S; S.init(NTOK, NP, (int)gridDim.x, (int)blockIdx.x); pg8::EpiInProj E{WSP(bf16_t, WS_P), NP, WSP(float, WS_ROPE)};
          pg8::gemm_phase<pg8::EpiInProj, pg8::StaticOrder, true, true>((PG8_LAS unsigned char*)lds, g, S, E); }
        GRID_BAR();
        { KArgP A = kargs(); mls::qkconv_phase(WSP(bf16_t, WS_P), WSP(bf16_t, WS_H), A->in[15] + (size_t)l * 3 * 1024, A->in[16] + l * 1024); }
        GRID_BAR();
        { KArgP A = kargs(); mls::mlstm_phase(WSP(bf16_t, WS_P), WSP(bf16_t, WS_H), WSP(float, WS_GATES), WSP(bf16_t, WS_HM), A->in[17] + l * 8, A->in[18] + l * 8, l == 0, WSP(unsigned, WS_CTL) + 12288 + l * 512, (char*)lds); }
        { KArgP A = kargs(); const float lam_init = l == 0 ? 0.2f : 0.35550906759f;
          mixer_queue(WSP(bf16_t, WS_P), WSP(bf16_t, WS_H), WSP(bf16_t, WS_HM), A->in[10] + l * 64, A->in[11] + l * 64, A->in[12] + l * 64, A->in[13] + l * 64, A->in[14] + l * 128, A->in[19] + l * 1024, lam_init, l == 0,
                      WSP(unsigned, WS_CTL) + 8192 + l * 512, WSP(unsigned, WS_CTL) + 12288 + l * 512, (volatile LAS3 unsigned*)((LAS3 unsigned char*)lds + LDS_PHASE_BYTES) + 16, (char*)lds); }
        GRID_BAR();
        { KArgP A = kargs(); const int M = l == 0 ? NTOK : NLAT;
          pg8::Gemm g{WSP(bf16_t, WS_H), WSP(bf16_t, WS_WOUT) + (size_t)l * DM * DM, M, DM, DM}; pg8::StaticOrder S; S.init(M, DM, (int)gridDim.x, (int)blockIdx.x); pg8::EpiBf16 E{WSP(bf16_t, WS_HM), DM};
          pg8::gemm_phase<pg8::EpiBf16, pg8::StaticOrder, true, true>((PG8_LAS unsigned char*)lds, g, S, E); }
        if (l == 0) { PHASE_IDS; KArgP A = kargs(); const float* w_in1 = A->in[8] + (size_t)DM * INC; bf16_t* WIN = WSP(bf16_t, WS_WIN);
            const int nbusy = (NTOK / 256) * (DM / 256) - 2 * G;
            if (nbusy >= 0 && nbusy < G) { if ((int)blockIdx.x >= nbusy) transpose_items(w_in1, INC, DM, NP, WIN, scr, ((int)blockIdx.x - nbusy) * 8 + wave, (G - nbusy) * 8, lane); }
            else transpose_items(w_in1, INC, DM, NP, WIN, scr, gw, ngw, lane);
        }
        GRID_BAR();
        if (l == 0) {
            { KArgP A = kargs(); float* MOD = WSP(float, WS_MOD);
              norm_phase<true>(A->in[0], A->in[2], WSP(bf16_t, WS_HM), MOD, A->in[7], A->out, WSP(float, WS_XC), MOD + (size_t)9 * MODW, A->in[6] + DM, WSP(bf16_t, WS_WGT) + 16 * DM, WSP(bf16_t, WS_H), WSP(float, WS_GATES), (char*)lds); }
            GRID_BAR();
        } else { KArgP A = kargs(); post_phase_final(A->out, WSP(bf16_t, WS_HM), WSP(float, WS_MOD) + (size_t)9 * MODW, A->in[7] + DM, (char*)lds);
        }
    }
}

extern "C" void kernel_launch(void* const* d_in, const int* in_sizes, int n_in, void* d_out, int out_size, void* d_ws, size_t ws_size, hipStream_t stream) {
    (void)in_sizes; (void)n_in; (void)out_size; (void)ws_size;
    static int grid_blocks = 0;
    if (!grid_blocks) {
        int dev = 0, cus = 0, per_cu = 0;
        (void)hipGetDevice(&dev);
        (void)hipDeviceGetAttribute(&cus, hipDeviceAttributeMultiprocessorCount, dev);
        (void)hipFuncSetAttribute((const void*)mega_fwd, hipFuncAttributeMaxDynamicSharedMemorySize, MEGA_LDS);
        (void)hipOccupancyMaxActiveBlocksPerMultiprocessor(&per_cu, (const void*)mega_fwd, 512, MEGA_LDS);
        if (per_cu < 1) per_cu = 1;
        if (per_cu > 1) per_cu = 1;
        grid_blocks = cus * per_cu;
    }
    (void)hipMemsetAsync((char*)d_ws + WS_CTL, 0, WS_MOD + (size_t)2 * 9 * MODW * 4, stream);
    MegaArgs a{};
    for (int i = 0; i < 20; ++i) a.in[i] = (const float*)d_in[i];
    a.out = (float*)d_out; a.ws = (unsigned char*)d_ws;
    void* args[] = {&a};
    (void)hipLaunchCooperativeKernel((const void*)mega_fwd, dim3(grid_blocks), dim3(512), args, (size_t)MEGA_LDS, stream);
}
```

```cpp
#include <hip/hip_runtime.h>
#include <hip/hip_cooperative_groups.h>
#include <stdint.h>
#include <math.h>

#define DEVI __device__ __forceinline__
constexpr int LDS_PHASE_BYTES = 155648;
typedef unsigned short bf16_t;

constexpr int DM = 2048, NBATCH = 8, SEQ = 2048, CTXL = 256;
constexpr int NLAT = NBATCH * SEQ, NCTX = NBATCH * CTXL, NTOK = NLAT + NCTX;
constexpr int INC = 8208, NP = 8192, MODW = 6144;
constexpr int C_QA = 0, C_KA = 1024, C_VA = 2048, C_GA = 3072, C_QB = 4096, C_KB = 4608, C_VB = 5120, C_OB = 6144, C_GB = 7168;
constexpr float EPS = 1e-6f;

constexpr size_t MiB = (size_t)1 << 20;
constexpr size_t WS_CTL = 0, WS_MOD = 1 * MiB, WS_SC = WS_MOD + 512 * 1024, WS_ROPE = 2 * MiB, WS_WGT = 2 * MiB + 65536  , WS_GATES = 3 * MiB, WS_WOUT = 8 * MiB,
                 WS_WIN = 24 * MiB, WS_XC = 56 * MiB, WS_H = 72 * MiB, WS_HM = 144 * MiB, WS_P = 216 * MiB, WS_END = 504 * MiB;

DEVI int opaque_tid() {
    const unsigned hw = (unsigned)__builtin_amdgcn_s_getreg((5 << 11) | 4) & 63u;
    const unsigned w = *((const volatile __attribute__((address_space(3))) unsigned char*)(LDS_PHASE_BYTES + 128) + hw);
    int ln; asm volatile("v_mbcnt_lo_u32_b32 %0, -1, 0\n\tv_mbcnt_hi_u32_b32 %0, -1, %0" : "=v"(ln));
    return (int)(__builtin_amdgcn_readfirstlane(w) << 6) | ln;
}
DEVI float bf2f(bf16_t v) { return __uint_as_float(((unsigned)v) << 16); }
DEVI bf16_t f2bf(float f) { unsigned u = __float_as_uint(f); return (bf16_t)((u + 0x7fffu + ((u >> 16) & 1u)) >> 16); }
DEVI unsigned pk2(float lo, float hi) { typedef float f32x2_ __attribute__((ext_vector_type(2))); typedef __bf16 bf16x2_ __attribute__((ext_vector_type(2))); const f32x2_ v = {lo, hi}; return __builtin_bit_cast(unsigned, __builtin_convertvector(v, bf16x2_)); }
DEVI float row16_sum(float v) {
    v += __builtin_bit_cast(float, __builtin_amdgcn_update_dpp(0, __builtin_bit_cast(int, v), 0xB1, 0xF, 0xF, false));
    v += __builtin_bit_cast(float, __builtin_amdgcn_update_dpp(0, __builtin_bit_cast(int, v), 0x4E, 0xF, 0xF, false));
    v += __builtin_bit_cast(float, __builtin_amdgcn_update_dpp(0, __builtin_bit_cast(int, v), 0x141, 0xF, 0xF, false));
    v += __builtin_bit_cast(float, __builtin_amdgcn_update_dpp(0, __builtin_bit_cast(int, v), 0x140, 0xF, 0xF, false));
    return v;
}
DEVI float rl_f(float v, int l) { return __builtin_bit_cast(float, __builtin_amdgcn_readlane(__builtin_bit_cast(int, v), l)); }
DEVI float wave_sum(float v) { v = row16_sum(v); return (rl_f(v, 0) + rl_f(v, 16)) + (rl_f(v, 32) + rl_f(v, 48)); }
DEVI float half_sum(float v, int hi) { v = row16_sum(v); const float a = rl_f(v, 0) + rl_f(v, 16), b = rl_f(v, 32) + rl_f(v, 48); return hi ? b : a; }
DEVI float sigmoid_f(float x) { return __builtin_amdgcn_rcpf(1.f + __expf(-x)); }
DEVI float silu_f(float x) { return x * sigmoid_f(x); }


DEVI void transpose_item(const float* __restrict__ W, int ldw, int K, int N, bf16_t* __restrict__ WT, float* scr, int item, int lane) {
    const int nblk = N / 64, kb = item / nblk, nb = item % nblk, k0 = 64 * kb, n0 = 64 * nb;
    float tv[64];
#pragma unroll
    for (int i = 0; i < 64; ++i) tv[i] = W[(size_t)(k0 + i) * ldw + n0 + lane];
#pragma unroll
    for (int i = 0; i < 64; ++i) scr[i * 65 + lane] = tv[i];
    asm volatile("s_waitcnt lgkmcnt(0)" ::: "memory");
    const int c = lane & 7;
#pragma unroll
    for (int j = 0; j < 8; ++j) {
        const int n = (lane >> 3) + 8 * j; const float* sp = scr + (8 * c) * 65 + n;
        uint4 o; o.x = pk2(sp[0 * 65], sp[1 * 65]); o.y = pk2(sp[2 * 65], sp[3 * 65]); o.z = pk2(sp[4 * 65], sp[5 * 65]); o.w = pk2(sp[6 * 65], sp[7 * 65]);
        *(uint4*)(WT + (size_t)(n0 + n) * K + k0 + 8 * c) = o;
    }
    asm volatile("s_waitcnt lgkmcnt(0)" ::: "memory");
}

namespace pg8 {
#define PG8_LAS __attribute__((address_space(3)))
typedef unsigned short bf16_t;
typedef short bf16x8 __attribute__((ext_vector_type(8)));
typedef float f32x4 __attribute__((ext_vector_type(4)));
typedef unsigned u32x4 __attribute__((ext_vector_type(4)));
constexpr int BM = 256, BK = 64, HALF = 128, HTB = HALF * BK * 2  , STAGE_BYTES = 8 * HTB, NXCD = 8, WGM = 8;

__host__ __device__ __forceinline__ int lds_byte(int r, int c) { const int st = (r >> 4) * 2 + (c >> 5), rr = r & 15, cc = c & 31, ob = rr * 64 + cc * 2; return st * 1024 + (ob ^ (((ob >> 9) & 1) << 5)); }
__host__ __device__ __forceinline__ void stage_rc(int b, int& R, int& C) { const int st = b / 1024, sb = b % 1024, swz = sb ^ (((sb >> 9) & 1) << 5); R = (st >> 1) * 16 + swz / 64; C = (st & 1) * 32 + (swz % 64) / 2; }
__host__ __device__ __forceinline__ int perm32(int rho) { const int n = rho >> 4, i = rho & 15; return 8 * (i >> 2) + 4 * n + (i & 3); }

struct Unit { int pm, pn; };
struct Gemm { const bf16_t* A; const bf16_t* Bt; int M, N, K; };

struct StaticOrder {
    int nM, nN, nwg, G, c;
    __host__ __device__ void init(int M, int N, int G_, int c_) { nM = M / BM; nN = N / BM; nwg = nM * nN; G = G_; c = c_; }
    __host__ __device__ bool next(int i, Unit& u) const {
        const long L = (long)i * G + c; if (L >= nwg) return false;
        int wgid = (int)L; { const int q = nwg / NXCD, r = nwg % NXCD, xcd = wgid % NXCD, off = wgid / NXCD; wgid = (xcd < r ? xcd * (q + 1) : r * (q + 1) + (xcd - r) * q) + off; }
        const int nig = WGM * nN, gid = wgid / nig, fm = gid * WGM, gsz = (nM - fm) < WGM ? (nM - fm) : WGM;
        u.pm = fm + ((wgid % nig) % gsz); u.pn = (wgid % nig) / gsz; return true;
    }
    __device__ __forceinline__ void a_ready(const Unit&) const {}
    __device__ __forceinline__ void done(const Unit&) const {}
};

__device__ __forceinline__ unsigned cvt_pk_bf16(float lo, float hi) { unsigned r; asm volatile("v_cvt_pk_bf16_f32 %0, %1, %2" : "=v"(r) : "v"(lo), "v"(hi)); return r; }

struct EpiBf16 {
    static constexpr bool PERM = true, AFTER_DRAIN = false;
    bf16_t* O; int ldc;
    __device__ __forceinline__ void operator()(const f32x4 (&acc)[2][2][4][2], const Unit& u, int wr, int wc, int fr, int fq) const {
        const int row0 = u.pm * BM + wr * 64 + fr, col0 = u.pn * BM + wc * 32 + 8 * fq;
#pragma unroll
        for (int ai = 0; ai < 2; ++ai)
#pragma unroll
            for (int m = 0; m < 4; ++m) { bf16_t* rowp = O + (size_t)(row0 + ai * HALF + m * 16) * ldc + col0;
#pragma unroll
                for (int bj = 0; bj < 2; ++bj) { const f32x4 v0 = acc[ai][bj][m][0], v1 = acc[ai][bj][m][1];
                    u32x4 w; w.x = cvt_pk_bf16(v0[0], v0[1]); w.y = cvt_pk_bf16(v0[2], v0[3]); w.z = cvt_pk_bf16(v1[0], v1[1]); w.w = cvt_pk_bf16(v1[2], v1[3]);
                    *(u32x4*)(rowp + bj * HALF) = w; } }
    }
};
struct EpiInProj {
    static constexpr bool PERM = true, AFTER_DRAIN = false;
    bf16_t* O; int ldc; const float* rope;
    __device__ __forceinline__ void operator()(const f32x4 (&acc)[2][2][4][2], const Unit& u, int wr, int wc, int fr, int fq) const {
        const int row0 = u.pm * BM + wr * 64 + fr, col0 = u.pn * BM + wc * 32 + 8 * fq;
        const bool do_rope = (u.pn < 8) && (u.pm < 64);
        const float qsc = (u.pn < 4) ? 0.18033688011112042f : 1.f;
#pragma unroll
        for (int ai = 0; ai < 2; ++ai)
#pragma unroll
            for (int m = 0; m < 4; ++m) { const int row = row0 + ai * HALF + m * 16; bf16_t* rowp = O + (size_t)row * ldc + col0;
                f32x4 cs01 = {1.f, 0.f, 1.f, 0.f}, cs23 = {1.f, 0.f, 1.f, 0.f};
                if (do_rope) { const int pos = (wc & 1) ? (row & 63) : ((row >> 6) & 31); const f32x4* rp = (const f32x4*)(rope + (size_t)(pos * 16 + 4 * fq) * 2); cs01 = rp[0]; cs23 = rp[1]; }
#pragma unroll
                for (int bj = 0; bj < 2; ++bj) { f32x4 v0 = acc[ai][bj][m][0], v1 = acc[ai][bj][m][1];
                    if (do_rope) {
                        const float a0 = v0[0] * cs01[0] - v0[1] * cs01[1], a1 = v0[0] * cs01[1] + v0[1] * cs01[0];
                        const float a2 = v0[2] * cs01[2] - v0[3] * cs01[3], a3 = v0[2] * cs01[3] + v0[3] * cs01[2];
                        const float b0 = v1[0] * cs23[0] - v1[1] * cs23[1], b1 = v1[0] * cs23[1] + v1[1] * cs23[0];
                        const float b2 = v1[2] * cs23[2] - v1[3] * cs23[3], b3 = v1[2] * cs23[3] + v1[3] * cs23[2];
                        v0 = (f32x4){a0, a1, a2, a3}; v1 = (f32x4){b0, b1, b2, b3};
                    }
                    v0 = v0 * qsc; v1 = v1 * qsc;
                    u32x4 w; w.x = cvt_pk_bf16(v0[0], v0[1]); w.y = cvt_pk_bf16(v0[2], v0[3]); w.z = cvt_pk_bf16(v1[0], v1[1]); w.w = cvt_pk_bf16(v1[2], v1[3]);
                    *(u32x4*)(rowp + bj * HALF) = w; } }
    }
};

template <class Epi, class Sched, bool ALIGN_EPI = false, bool SP2 = false>
__device__ __forceinline__ void gemm_phase(PG8_LAS unsigned char* lds, const Gemm g, const Sched& S, const Epi& E) {
    const int tid = opaque_tid(), wid = __builtin_amdgcn_readfirstlane(tid >> 6), lane = tid & 63, wr = wid >> 2, wc = wid & 3, fr = lane & 15, fq = lane >> 4;
    const int K = g.K, nt = K / BK;
    unsigned voffA[2], voffB[2];
#pragma unroll
    for (int i = 0; i < 2; ++i) { int R, C; stage_rc(tid * 16 + i * 8192, R, C); const int Rb = Epi::PERM ? ((R & ~31) + perm32(R & 31)) : R;
        voffA[i] = (unsigned)(R * K + C) * 2u; voffB[i] = (unsigned)(Rb * K + C) * 2u; }
    const size_t kstep = (size_t)(BK * 2);
    const size_t hstep = (size_t)HALF * K * 2;
    const size_t tstep = 2 * hstep;
    const unsigned ldsw = (unsigned)wid * 1024u;
    const int aoff = lds_byte(wr * 64 + fr, fq * 8), boff = lds_byte(wc * 32 + fr, fq * 8);
#define PG8_SA(b, h) (((b) * 2 + (h)) * HTB)
#define PG8_SB(b, h) ((4 + (b) * 2 + (h)) * HTB)
#define PG8_STAGE(bufoff, gbase, voff) do { _Pragma("unroll") for (int _i = 0; _i < 2; ++_i) \
        __builtin_amdgcn_global_load_lds((const unsigned*)((const char*)(gbase) + (voff)[_i]), (PG8_LAS unsigned*)(lds + (bufoff) + ldsw + _i * 8192), 16, 0, 0); } while (0)
#define PG8_LDA(dst, b, h) do { _Pragma("unroll") for (int m = 0; m < 4; ++m) _Pragma("unroll") for (int k = 0; k < 2; ++k) dst[m][k] = *(const PG8_LAS bf16x8*)(lds + PG8_SA(b, h) + aoff + m * 2048 + k * 1024); } while (0)
#define PG8_LDB(dst, b, h) do { _Pragma("unroll") for (int n = 0; n < 2; ++n) _Pragma("unroll") for (int k = 0; k < 2; ++k) dst[n][k] = *(const PG8_LAS bf16x8*)(lds + PG8_SB(b, h) + boff + n * 2048 + k * 1024); } while (0)
#define PG8_MMA(ai, bj, At, Bt) do { __builtin_amdgcn_s_setprio(1); _Pragma("unroll") for (int m = 0; m < 4; ++m) _Pragma("unroll") for (int n = 0; n < 2; ++n) _Pragma("unroll") for (int k = 0; k < 2; ++k) \
        acc[ai][bj][m][n] = __builtin_amdgcn_mfma_f32_16x16x32_bf16(Bt[n][k], At[m][k], acc[ai][bj][m][n], 0, 0, 0); __builtin_amdgcn_s_setprio(0); } while (0)
#define PG8_WAIT_V(n) asm volatile("s_waitcnt vmcnt(" #n ")" ::: "memory")
#define PG8_WAIT_L(n) asm volatile("s_waitcnt lgkmcnt(" #n ")" ::: "memory")
#define PG8_BAR __builtin_amdgcn_s_barrier()
#define PG8_SCHED __builtin_amdgcn_sched_barrier(0)
    Unit cur, nxt; int ui = 0;
    if (!S.next(0, cur)) return;
    f32x4 acc[2][2][4][2];
#pragma unroll
    for (int a = 0; a < 2; ++a)
#pragma unroll
        for (int b = 0; b < 2; ++b)
#pragma unroll
            for (int m = 0; m < 4; ++m)
#pragma unroll
                for (int n = 0; n < 2; ++n) acc[a][b][m][n] = (f32x4){0.f, 0.f, 0.f, 0.f};
    bf16x8 At[4][2], B0[2][2], B1[2][2];
    const char* cA = (const char*)g.A + (size_t)cur.pm * tstep; const char* cB = (const char*)g.Bt + (size_t)cur.pn * tstep;
    S.a_ready(cur);
    if constexpr (SP2) {
        PG8_STAGE(PG8_SB(0, 0), cB, voffB); PG8_STAGE(PG8_SB(0, 1), cB + hstep, voffB); PG8_STAGE(PG8_SA(0, 0), cA, voffA); PG8_STAGE(PG8_SA(0, 1), cA + hstep, voffA);
        if (wr == 1) PG8_BAR;
        PG8_WAIT_V(2); PG8_BAR;
        PG8_STAGE(PG8_SB(1, 0), cB + kstep, voffB); PG8_STAGE(PG8_SA(1, 0), cA + kstep, voffA); PG8_STAGE(PG8_SB(1, 1), cB + hstep + kstep, voffB);
        PG8_WAIT_V(6); PG8_BAR;
    } else {
        PG8_STAGE(PG8_SB(0, 0), cB, voffB); PG8_STAGE(PG8_SA(0, 0), cA, voffA); PG8_STAGE(PG8_SB(0, 1), cB + hstep, voffB); PG8_STAGE(PG8_SA(0, 1), cA + hstep, voffA);
        if (wr == 1) PG8_BAR;
        PG8_WAIT_V(4); PG8_BAR;
        PG8_STAGE(PG8_SB(1, 0), cB + kstep, voffB); PG8_STAGE(PG8_SA(1, 0), cA + kstep, voffA); PG8_STAGE(PG8_SB(1, 1), cB + hstep + kstep, voffB);
        PG8_WAIT_V(6); PG8_BAR;
    }
    for (;;) {
        const bool has_next = S.next(ui + 1, nxt);
        const char* nA = has_next ? (const char*)g.A + (size_t)nxt.pm * tstep : cA; const char* nB = has_next ? (const char*)g.Bt + (size_t)nxt.pn * tstep : cB;
        for (int t = 0; t < nt; t += 2) {
            const bool last = (t == nt - 2);
            const char* a1 = cA + (size_t)(t + 1) * kstep;
            const char* a2 = last ? nA : cA + (size_t)(t + 2) * kstep; const char* b2 = last ? nB : cB + (size_t)(t + 2) * kstep;
            const char* a3 = a2 + kstep; const char* b3 = b2 + kstep;
            if (last && has_next) S.a_ready(nxt);
            if constexpr (SP2) {
            PG8_LDB(B0, 0, 0); PG8_LDB(B1, 0, 1); PG8_SCHED; PG8_LDA(At, 0, 0); PG8_STAGE(PG8_SA(1, 1), a1 + hstep, voffA);
            PG8_WAIT_V(8); PG8_WAIT_L(0); PG8_BAR; PG8_MMA(0, 0, At, B0); PG8_MMA(0, 1, At, B1); PG8_BAR; PG8_SCHED;
            PG8_LDA(At, 0, 1); PG8_STAGE(PG8_SB(0, 0), b2, voffB); PG8_STAGE(PG8_SB(0, 1), b2 + hstep, voffB); PG8_STAGE(PG8_SA(0, 0), a2, voffA);
            PG8_WAIT_V(8); PG8_WAIT_L(0); PG8_BAR; PG8_MMA(1, 0, At, B0); PG8_MMA(1, 1, At, B1); PG8_BAR; PG8_SCHED;
            PG8_LDB(B0, 1, 0); PG8_LDB(B1, 1, 1); PG8_SCHED; PG8_LDA(At, 1, 0); PG8_STAGE(PG8_SA(0, 1), a2 + hstep, voffA);
            PG8_WAIT_V(8); PG8_WAIT_L(0); PG8_BAR; PG8_MMA(0, 0, At, B0); PG8_MMA(0, 1, At, B1); PG8_BAR; PG8_SCHED;
            PG8_LDA(At, 1, 1); PG8_STAGE(PG8_SB(1, 0), b3, voffB); PG8_STAGE(PG8_SB(1, 1), b3 + hstep, voffB); PG8_STAGE(PG8_SA(1, 0), a3, voffA);
            PG8_WAIT_V(8); PG8_WAIT_L(0); PG8_BAR; PG8_MMA(1, 0, At, B0); PG8_MMA(1, 1, At, B1); PG8_BAR; PG8_SCHED;
            } else {
            PG8_LDB(B0, 0, 0); PG8_SCHED; PG8_LDA(At, 0, 0); PG8_STAGE(PG8_SA(1, 1), a1 + hstep, voffA);
            PG8_WAIT_L(8); PG8_BAR; PG8_WAIT_L(0); PG8_MMA(0, 0, At, B0); PG8_BAR; PG8_SCHED;
            PG8_LDB(B1, 0, 1); PG8_STAGE(PG8_SB(0, 0), b2, voffB);
            PG8_BAR; PG8_WAIT_L(0); PG8_MMA(0, 1, At, B1); PG8_BAR;
            PG8_LDA(At, 0, 1); PG8_STAGE(PG8_SA(0, 0), a2, voffA);
            PG8_BAR; PG8_WAIT_L(0); PG8_MMA(1, 0, At, B0); PG8_BAR; PG8_SCHED;
            PG8_STAGE(PG8_SB(0, 1), b2 + hstep, voffB);
            PG8_WAIT_V(6); PG8_BAR; PG8_MMA(1, 1, At, B1); PG8_BAR;
            PG8_LDB(B0, 1, 0); PG8_SCHED; PG8_LDA(At, 1, 0); PG8_STAGE(PG8_SA(0, 1), a2 + hstep, voffA);
            PG8_WAIT_L(8); PG8_BAR; PG8_WAIT_L(0); PG8_MMA(0, 0, At, B0); PG8_BAR; PG8_SCHED;
            PG8_LDB(B1, 1, 1); PG8_STAGE(PG8_SB(1, 0), b3, voffB);
            PG8_BAR; PG8_WAIT_L(0); PG8_MMA(0, 1, At, B1); PG8_BAR;
            PG8_LDA(At, 1, 1); PG8_STAGE(PG8_SA(1, 0), a3, voffA);
            PG8_BAR; PG8_WAIT_L(0); PG8_MMA(1, 0, At, B0); PG8_BAR; PG8_SCHED;
            PG8_STAGE(PG8_SB(1, 1), b3 + hstep, voffB);
            PG8_WAIT_V(6); PG8_BAR; PG8_MMA(1, 1, At, B1); PG8_BAR;
            }
        }
        if constexpr (ALIGN_EPI) { if (wr == 0) PG8_BAR; }
        if constexpr (!Epi::AFTER_DRAIN) { E(acc, cur, wr, wc, fr, fq); S.done(cur); }
        if (!has_next) break;
#pragma unroll
        for (int a = 0; a < 2; ++a)
#pragma unroll
            for (int b = 0; b < 2; ++b)
#pragma unroll
                for (int m = 0; m < 4; ++m)
#pragma unroll
                    for (int n = 0; n < 2; ++n) acc[a][b][m][n] = (f32x4){0.f, 0.f, 0.f, 0.f};
        cur = nxt; cA = nA; cB = nB; ++ui;
        if constexpr (ALIGN_EPI) { if (wr == 1) PG8_BAR; }
    }
    PG8_WAIT_V(0);
    if constexpr (!ALIGN_EPI) { if (wr == 0) PG8_BAR; }
    PG8_BAR;
    if constexpr (Epi::AFTER_DRAIN) { E.fused(acc, cur, wr, wc, fr, fq, lds, wid, lane); S.done(cur); }
#undef PG8_SA
#undef PG8_SB
#undef PG8_STAGE
#undef PG8_LDA
#undef PG8_LDB
#undef PG8_MMA
#undef PG8_WAIT_V
#undef PG8_WAIT_L
#undef PG8_BAR
#undef PG8_SCHED
}
}

namespace att {
using bf16x8 = __attribute__((ext_vector_type(8))) short;
using s16x4  = __attribute__((ext_vector_type(4))) short;
using f32x16 = __attribute__((ext_vector_type(16))) float;
using u32x4  = __attribute__((ext_vector_type(4))) unsigned;
constexpr int NW = 8, QBLK = 32, KVBLK = 64, QROWS = 128;
constexpr float SCALE = 0.125f, QPRESCALE = SCALE * 1.4426950408889634f, THRL = 24.f;
constexpr int SHM_V = KVBLK * 128 * 2, SHM_K = KVBLK * 128 * 2, SHM_ATTN = 2 * SHM_V + 2 * SHM_K + NW * 64 * 4;
#define KSWZ(row, colB) ((row) * 256 + ((colB) ^ (((row) & 7) << 4)))
#define SBAR() __builtin_amdgcn_sched_barrier(0)
__device__ __forceinline__ int crow(int r, int hi) { return (r & 3) + 8 * (r >> 2) + 4 * hi; }
__device__ __forceinline__ unsigned cvtpk(float lo, float hi) { unsigned r; asm volatile("v_cvt_pk_bf16_f32 %0, %1, %2" : "=v"(r) : "v"(lo), "v"(hi)); return r; }
__device__ __forceinline__ void qkt_lds(f32x16& p0, f32x16& p1, const char* Ks, const char* qrow  , float mh, int r32, int hi, int sub) {
#pragma unroll
  for (int r = 0; r < 16; ++r) { p0[r] = -mh; p1[r] = -mh; }
#pragma unroll
  for (int d0 = 0; d0 < 4; ++d0) { const int cb = (sub * 64 + d0 * 16 + hi * 8) * 2;
    const bf16x8 qf = *reinterpret_cast<const bf16x8*>(qrow + d0 * 32);
    const bf16x8 b0 = *reinterpret_cast<const bf16x8*>(Ks + KSWZ(r32, cb));
    const bf16x8 b1 = *reinterpret_cast<const bf16x8*>(Ks + KSWZ(32 + r32, cb));
    p0 = __builtin_amdgcn_mfma_f32_32x32x16_bf16(b0, qf, p0, 0, 0, 0);
    p1 = __builtin_amdgcn_mfma_f32_32x32x16_bf16(b1, qf, p1, 0, 0, 0); }
}
#define ATT_PK4(P, BASE, OUT) do { unsigned a0_ = cvtpk(P[BASE + 0], P[BASE + 1]), a1_ = cvtpk(P[BASE + 2], P[BASE + 3]);   \
    unsigned b0_ = cvtpk(P[BASE + 4], P[BASE + 5]), b1_ = cvtpk(P[BASE + 6], P[BASE + 7]);                              \
    auto r0_ = __builtin_amdgcn_permlane32_swap(a0_, b0_, false, false); auto r1_ = __builtin_amdgcn_permlane32_swap(a1_, b1_, false, false); \
    u32x4 w_ = {r0_[0], r1_[0], r0_[1], r1_[1]}; OUT = *reinterpret_cast<bf16x8*>(&w_); } while (0)
__device__ __forceinline__ void partialSM3(f32x16& p0, f32x16& p1, float& mhat, float& alpha, bf16x8& pa0, bf16x8& pa1, float& ps0) {
  float a = fmaxf(fmaxf(p0[0], p0[1]), p1[0]), b2 = fmaxf(fmaxf(p0[2], p0[3]), p1[1]); a = fmaxf(fmaxf(a, p1[2]), p1[3]);
#pragma unroll
  for (int r = 4; r < 16; r += 4) { a = fmaxf(fmaxf(a, p0[r]), p0[r + 1]); b2 = fmaxf(fmaxf(b2, p0[r + 2]), p0[r + 3]); a = fmaxf(fmaxf(a, p1[r]), p1[r + 1]); b2 = fmaxf(fmaxf(b2, p1[r + 2]), p1[r + 3]); }
  float rm = fmaxf(a, b2);
  { auto rr = __builtin_amdgcn_permlane32_swap(__float_as_uint(rm), __float_as_uint(rm), false, false);
    rm = fmaxf(__uint_as_float(rr[0]), __uint_as_float(rr[1])); }
  alpha = 1.f;
  if (__builtin_expect(__any(rm > THRL), 0)) {
    const float dl = fmaxf(rm, 0.f); mhat += dl;
#pragma unroll
    for (int r = 0; r < 16; ++r) { p0[r] -= dl; p1[r] -= dl; }
    alpha = __builtin_amdgcn_exp2f(-dl);
  }
  float s_ = 0.f;
#pragma unroll
  for (int r = 0; r < 16; ++r) { p0[r] = __builtin_amdgcn_exp2f(p0[r]); s_ += p0[r]; }
  ps0 = s_;
  ATT_PK4(p0, 0, pa0); ATT_PK4(p0, 8, pa1);
}
__device__ __forceinline__ void finishSM3(f32x16& p1, float alpha, float ps0, float& l_reg, bf16x8& pa2, bf16x8& pa3) {
#pragma unroll
  for (int r = 0; r < 16; ++r) p1[r] = __builtin_amdgcn_exp2f(p1[r]);
  float ps = ps0;
#pragma unroll
  for (int r = 0; r < 16; ++r) ps += p1[r];
  { auto rr = __builtin_amdgcn_permlane32_swap(__float_as_uint(ps), __float_as_uint(ps), false, false);
    ps = __uint_as_float(rr[0]) + __uint_as_float(rr[1]); }
  l_reg = l_reg * alpha + ps;
  ATT_PK4(p1, 0, pa2); ATT_PK4(p1, 8, pa3);
}
__device__ __forceinline__ int v_st(int k, int c) { const int kk = (k & ~0xC) | ((k & 4) << 1) | ((k & 8) >> 1); return ((kk >> 3) * 4 + (c >> 5)) * 512 + ((kk & 7) * 32 + (c & 31)) * 2; }
__device__ __forceinline__ int v_rd_base(int lane) { return ((lane & 3) << 3) | (((lane >> 2) & 3) << 6) | (((lane >> 4) & 1) << 5) | (((lane >> 5) & 1) << 8); }
constexpr int v_rd_off(int d0, int ks, int half) { return d0 * 512 + ks * 4096 + half * 2048; }
template <int OFF> __device__ __forceinline__ s16x4 tr_read(int vb) {
  s16x4 r; asm volatile("ds_read_b64_tr_b16 %0, %1 offset:%2" : "=&v"(r) : "v"(vb), "i"(OFF) : "memory"); return r;
}
template <int D0> __device__ __forceinline__ void pv_one(f32x16& od, int vb, bf16x8 pa0, bf16x8 pa1, bf16x8 pa2, bf16x8 pa3) {
  const s16x4 l0 = tr_read<v_rd_off(D0, 0, 0)>(vb), h0 = tr_read<v_rd_off(D0, 0, 1)>(vb), l1 = tr_read<v_rd_off(D0, 1, 0)>(vb), h1 = tr_read<v_rd_off(D0, 1, 1)>(vb);
  const s16x4 l2 = tr_read<v_rd_off(D0, 2, 0)>(vb), h2 = tr_read<v_rd_off(D0, 2, 1)>(vb), l3 = tr_read<v_rd_off(D0, 3, 0)>(vb), h3 = tr_read<v_rd_off(D0, 3, 1)>(vb);
  asm volatile("s_waitcnt lgkmcnt(0)" ::: "memory"); SBAR();
#define PK(L, H) (bf16x8){L[0], L[1], L[2], L[3], H[0], H[1], H[2], H[3]}
  od = __builtin_amdgcn_mfma_f32_32x32x16_bf16(pa0, PK(l0, h0), od, 0, 0, 0);
  od = __builtin_amdgcn_mfma_f32_32x32x16_bf16(pa1, PK(l1, h1), od, 0, 0, 0);
  od = __builtin_amdgcn_mfma_f32_32x32x16_bf16(pa2, PK(l2, h2), od, 0, 0, 0);
  od = __builtin_amdgcn_mfma_f32_32x32x16_bf16(pa3, PK(l3, h3), od, 0, 0, 0);
#undef PK
}
__device__ __forceinline__ void pv_d0(f32x16* o, int vb, bf16x8 pa0, bf16x8 pa1, bf16x8 pa2, bf16x8 pa3) {
  pv_one<0>(o[0], vb, pa0, pa1, pa2, pa3); pv_one<1>(o[1], vb, pa0, pa1, pa2, pa3); pv_one<2>(o[2], vb, pa0, pa1, pa2, pa3); pv_one<3>(o[3], vb, pa0, pa1, pa2, pa3);
}
__device__ __forceinline__ long ktile_row(int b, int t) { return t < 4 ? (long)(NLAT + b * CTXL + 64 * t) : (long)(b * SEQ + 64 * (t - 4)); }

constexpr int QROWS2 = 256, QT_ROWB = 272, QT_OFF = 2 * SHM_V + 2 * SHM_K + NW * 64 * 4, SHM_ATTN2 = QT_OFF + NW * 32 * QT_ROWB;
static_assert(SHM_ATTN2 <= LDS_PHASE_BYTES, "attention LDS map");
__device__ __forceinline__ void attn_unit2(const bf16_t* __restrict__ Pm, bf16_t* __restrict__ Y, long qrow0, int b, int hh, int NT, float lam, float lam_init,
                                           const float* __restrict__ subln, char* lds) {
  const int tid = opaque_tid(), wid = __builtin_amdgcn_readfirstlane(tid >> 6), lane = tid & 63, r32 = lane & 31, hi = lane >> 5;
  char* V_lds = lds; char* K_lds = lds + 2 * SHM_V;
  float* ws = (float*)(lds + 2 * SHM_V + 2 * SHM_K) + wid * 64; float* li_l = ws; float* al_l = ws + 32;
  char* qt = lds + QT_OFF + wid * (32 * QT_ROWB);
  const long wrow0 = qrow0 + wid * QBLK;
#pragma unroll
  for (int c8 = 0; c8 < 8; ++c8) { const int row = c8 * 4 + (lane >> 4), ch = lane & 15;
    *(uint4*)(qt + row * QT_ROWB + ch * 16) = *(const uint4*)(Pm + (wrow0 + row) * NP + C_QA + hh * 128 + ch * 8); }
  float mh0 = 0.f, mh1 = 0.f, l0 = 0.f, l1 = 0.f; f32x16 o0[4] = {}, o1[4] = {};
  const int vb0 = (int)(uintptr_t)V_lds + v_rd_base(lane);
  const unsigned ldsb = (unsigned)(uintptr_t)lds + (unsigned)(wid * 2048);
#define SDMA(t, bb) do { const char* tb_ = (const char*)(Pm + ktile_row(b, (t)) * NP + hh * 128); int ln_ = lane; asm volatile("" : "+v"(ln_)); \
    _Pragma("unroll") for (int i2 = 0; i2 < 2; ++i2) { const int sl = (wid * 2 + i2) * 64 + ln_; \
      const int krow = sl >> 4, kch = (sl & 15) ^ (krow & 7); const int kof = (krow * NP + C_KA + kch * 8) * 2; \
      const int kk = (sl >> 7) * 8 + ((sl & 31) >> 2), vc = ((sl >> 5) & 3) * 32 + (sl & 3) * 8, vk = (kk & ~0xC) | ((kk & 4) << 1) | ((kk & 8) >> 1); const int vof = (vk * NP + C_VA + vc) * 2; \
    __builtin_amdgcn_global_load_lds((const unsigned*)(tb_ + vof), (__attribute__((address_space(3))) unsigned*)(ldsb + (unsigned)((bb) * SHM_V + i2 * 1024)), 16, 0, 0); \
    __builtin_amdgcn_global_load_lds((const unsigned*)(tb_ + kof), (__attribute__((address_space(3))) unsigned*)(ldsb + (unsigned)(2 * SHM_V + (bb) * SHM_K + i2 * 1024)), 16, 0, 0); } } while (0)
#define RESC(o, a) do { if (__any((a) < 1.f)) { if (hi == 0) al_l[r32] = (a); asm volatile("s_waitcnt lgkmcnt(0)" ::: "memory"); \
    _Pragma("unroll") for (int r = 0; r < 16; ++r) { const float f_ = al_l[crow(r, hi)]; _Pragma("unroll") for (int d = 0; d < 4; ++d) o[d][r] *= f_; asm volatile("" ::: "memory"); } } } while (0)
  f32x16 pA1, pB1; float alA, alB, psA, psB; bf16x8 aA0, aA1, aB0, aB1, pa2, pa3;
  const char* qA = qt + r32 * QT_ROWB + (hi * 8) * 2;
#define qB (qA + 128)
  SDMA(0, 0); asm volatile("s_waitcnt vmcnt(0)" ::: "memory"); __syncthreads();
  { f32x16 t0; SBAR(); qkt_lds(t0, pA1, K_lds, qA, mh0, r32, hi, 0); partialSM3(t0, pA1, mh0, alA, aA0, aA1, psA); SBAR(); }
  if (1 < NT) SDMA(1, 1);
  { f32x16 t0; SBAR(); qkt_lds(t0, pB1, K_lds, qB, mh1, r32, hi, 1); finishSM3(pA1, alA, psA, l0, pa2, pa3); SBAR();
    pv_d0(o0, vb0, aA0, aA1, pa2, pa3); partialSM3(t0, pB1, mh1, alB, aB0, aB1, psB); SBAR(); }
  asm volatile("s_waitcnt vmcnt(0)" ::: "memory"); __syncthreads();
  for (int t = 1; t < NT; ++t) {
    const int cur = t & 1, prev = cur ^ 1;
    { f32x16 t0; SBAR(); qkt_lds(t0, pA1, K_lds + cur * SHM_K, qA, mh0, r32, hi, 0); RESC(o1, alB); finishSM3(pB1, alB, psB, l1, pa2, pa3); SBAR();
      pv_d0(o1, vb0 + prev * SHM_V, aB0, aB1, pa2, pa3); partialSM3(t0, pA1, mh0, alA, aA0, aA1, psA); SBAR(); }
    __syncthreads();
    if (t + 1 < NT) SDMA(t + 1, prev);
    RESC(o0, alA);
    { f32x16 t0; SBAR(); qkt_lds(t0, pB1, K_lds + cur * SHM_K, qB, mh1, r32, hi, 1); finishSM3(pA1, alA, psA, l0, pa2, pa3); SBAR();
      pv_d0(o0, vb0 + cur * SHM_V, aA0, aA1, pa2, pa3); partialSM3(t0, pB1, mh1, alB, aB0, aB1, psB); SBAR(); }
    asm volatile("s_waitcnt vmcnt(0)" ::: "memory"); __syncthreads();
  }
  RESC(o1, alB); finishSM3(pB1, alB, psB, l1, pa2, pa3); SBAR();
  pv_d0(o1, vb0 + ((NT - 1) & 1) * SHM_V, aB0, aB1, pa2, pa3);
  if (hi == 0) { li_l[r32] = l0; al_l[r32] = l1; } asm volatile("s_waitcnt lgkmcnt(0)" ::: "memory");
#pragma unroll
  for (int c8 = 0; c8 < 8; ++c8) { const int row = c8 * 4 + (lane >> 4), ch = lane & 15;
    *(uint4*)(qt + row * QT_ROWB + ch * 16) = *(const uint4*)(Pm + (wrow0 + row) * NP + C_GA + hh * 128 + ch * 8); }
  float ss[16];
#pragma unroll
  for (int r = 0; r < 16; ++r) { const float ra = __builtin_amdgcn_rcpf(li_l[crow(r, hi)]), rb = lam * __builtin_amdgcn_rcpf(al_l[crow(r, hi)]); float a = 0.f;
#pragma unroll
    for (int d0 = 0; d0 < 4; ++d0) { o0[d0][r] = o0[d0][r] * ra - o1[d0][r] * rb; a += o0[d0][r] * o0[d0][r]; }
    ss[r] = a; }
#pragma unroll
  for (int r = 0; r < 16; ++r) {
    ss[r] = rsqrtf(half_sum(ss[r], hi) * (1.f / 128.f) + EPS) * (1.f - lam_init);
  }
  float sw[4];
#pragma unroll
  for (int d0 = 0; d0 < 4; ++d0) sw[d0] = subln[d0 * 32 + r32];
  asm volatile("s_waitcnt vmcnt(0) lgkmcnt(0)" ::: "memory");
#pragma unroll
  for (int r = 0; r < 16; ++r) { bf16_t* tp = (bf16_t*)(qt + crow(r, hi) * QT_ROWB) + r32;
#pragma unroll
    for (int d0 = 0; d0 < 4; ++d0) { const float g = bf2f(tp[d0 * 32]); tp[d0 * 32] = f2bf(o0[d0][r] * ss[r] * sw[d0] * silu_f(g)); } }
  asm volatile("s_waitcnt lgkmcnt(0)" ::: "memory");
#pragma unroll
  for (int c8 = 0; c8 < 8; ++c8) { const int row = c8 * 4 + (lane >> 4), ch = lane & 15;
    *(uint4*)(Y + (wrow0 + row) * DM + hh * 128 + ch * 8) = *(const uint4*)(qt + row * QT_ROWB + ch * 16); }
  asm volatile("s_waitcnt lgkmcnt(0)" ::: "memory");
#undef SDMA
#undef RESC
#undef qB
}
#undef KSWZ
#undef SBAR
}

namespace mls {
using bf16x8 = __attribute__((ext_vector_type(8))) short;
using s16x4  = __attribute__((ext_vector_type(4))) short;
using f32x4  = __attribute__((ext_vector_type(4))) float;
constexpr int QSTRB = 272, SSTRB = 144;
constexpr int VSTRB = 528;
constexpr int L_Q = 0, L_K = L_Q + 64 * QSTRB, L_V = L_K + 64 * QSTRB, L_S = L_V + 64 * VSTRB, L_CT = L_S + 64 * SSTRB, L_SM = L_CT + 256 * QSTRB, L_END = L_SM + 8192;
static_assert(L_END <= LDS_PHASE_BYTES && (L_K % 16) == 0 && (L_V % 16) == 0 && (L_S % 16) == 0 && (L_CT % 16) == 0 && (L_SM % 16) == 0, "mlstm LDS map");
__device__ __forceinline__ f32x4 mfma16(bf16x8 a, bf16x8 b, f32x4 c) { return __builtin_amdgcn_mfma_f32_16x16x32_bf16(a, b, c, 0, 0, 0); }
struct TrPair { s16x4 lo, hi; };
__device__ __forceinline__ bf16x8 tr_pack(const TrPair& t) { return (bf16x8){t.lo[0], t.lo[1], t.lo[2], t.lo[3], t.hi[0], t.hi[1], t.hi[2], t.hi[3]}; }
__device__ __forceinline__ float wave_scan_incl(float v) {
  v += __builtin_bit_cast(float, __builtin_amdgcn_update_dpp(0, __builtin_bit_cast(int, v), 0x111, 0xF, 0xF, false));
  v += __builtin_bit_cast(float, __builtin_amdgcn_update_dpp(0, __builtin_bit_cast(int, v), 0x112, 0xF, 0xF, false));
  v += __builtin_bit_cast(float, __builtin_amdgcn_update_dpp(0, __builtin_bit_cast(int, v), 0x114, 0xF, 0xF, false));
  v += __builtin_bit_cast(float, __builtin_amdgcn_update_dpp(0, __builtin_bit_cast(int, v), 0x118, 0xF, 0xF, false));
  v += __builtin_bit_cast(float, __builtin_amdgcn_update_dpp(0, __builtin_bit_cast(int, v), 0x142, 0xA, 0xF, false));
  v += __builtin_bit_cast(float, __builtin_amdgcn_update_dpp(0, __builtin_bit_cast(int, v), 0x143, 0xC, 0xF, false));
  return v;
}
__device__ __forceinline__ float fast_tanh(float x) { return 1.f - 2.f * __builtin_amdgcn_rcpf(1.f + __expf(2.f * x)); }

__device__ __forceinline__ void tr_v4(unsigned base, TrPair& a0, TrPair& a1, TrPair& b0, TrPair& b1, TrPair& c0, TrPair& c1, TrPair& d0, TrPair& d1) {
  asm volatile(
    "ds_read_b64_tr_b16 %0, %16\n\tds_read_b64_tr_b16 %1, %16 offset:2112\n\tds_read_b64_tr_b16 %2, %16 offset:16896\n\tds_read_b64_tr_b16 %3, %16 offset:19008\n\t"
    "ds_read_b64_tr_b16 %4, %16 offset:32\n\tds_read_b64_tr_b16 %5, %16 offset:2144\n\tds_read_b64_tr_b16 %6, %16 offset:16928\n\tds_read_b64_tr_b16 %7, %16 offset:19040\n\t"
    "ds_read_b64_tr_b16 %8, %16 offset:64\n\tds_read_b64_tr_b16 %9, %16 offset:2176\n\tds_read_b64_tr_b16 %10, %16 offset:16960\n\tds_read_b64_tr_b16 %11, %16 offset:19072\n\t"
    "ds_read_b64_tr_b16 %12, %16 offset:96\n\tds_read_b64_tr_b16 %13, %16 offset:2208\n\tds_read_b64_tr_b16 %14, %16 offset:16992\n\tds_read_b64_tr_b16 %15, %16 offset:19104\n\t"
    "s_waitcnt lgkmcnt(0)"
    : "=&v"(a0.lo), "=&v"(a0.hi), "=&v"(a1.lo), "=&v"(a1.hi), "=&v"(b0.lo), "=&v"(b0.hi), "=&v"(b1.lo), "=&v"(b1.hi),
      "=&v"(c0.lo), "=&v"(c0.hi), "=&v"(c1.lo), "=&v"(c1.hi), "=&v"(d0.lo), "=&v"(d0.hi), "=&v"(d1.lo), "=&v"(d1.hi)
    : "v"(base) : "memory");
}
__device__ __forceinline__ bf16x8 scale_frag(const TrPair& t, const float4 wa, const float4 wb) {
  const float f0 = bf2f((bf16_t)t.lo[0]) * wa.x, f1 = bf2f((bf16_t)t.lo[1]) * wa.y, f2 = bf2f((bf16_t)t.lo[2]) * wa.z, f3 = bf2f((bf16_t)t.lo[3]) * wa.w;
  const float f4 = bf2f((bf16_t)t.hi[0]) * wb.x, f5 = bf2f((bf16_t)t.hi[1]) * wb.y, f6 = bf2f((bf16_t)t.hi[2]) * wb.z, f7 = bf2f((bf16_t)t.hi[3]) * wb.w;
  return __builtin_bit_cast(bf16x8, make_uint4(pk2(f0, f1), pk2(f2, f3), pk2(f4, f5), pk2(f6, f7)));
}

__device__ __forceinline__ void mlstm_unit(const bf16_t* __restrict__ Pm, const bf16_t* __restrict__ QKC  , const float* __restrict__ GATES,
                                           bf16_t* __restrict__ HM, const float* __restrict__ i_bias, const float* __restrict__ f_bias,
                                           int b, int head, int dir, bool ctx_out, unsigned* mdone, char* lds) {
  const int tid = opaque_tid(), wid = __builtin_amdgcn_readfirstlane(tid >> 6), lane = tid & 63, lr = lane & 15, kg = lane >> 4;
  char* q_lds = lds + L_Q; char* k_lds = lds + L_K; char* v_lds = lds + L_V; char* s_lds = lds + L_S; char* ct_lds = lds + L_CT;
  float* bl = (float*)(lds + L_SM); float* bsp = bl + 64; float* av = bsp + 64; float* wkl = av + 64; float* qn = wkl + 64; float* nvec = qn + 64; float* rs = nvec + 128; float* npart = rs + 1024;
  const unsigned lds0 = (unsigned)(uintptr_t)lds;
  const unsigned trq = (unsigned)((8 * kg + (lr >> 2)) * QSTRB + (4 * (lr & 3)) * 2), trv = (unsigned)((8 * kg + (lr >> 2)) * VSTRB + (4 * (lr & 3)) * 2);
  if (tid < 128) nvec[tid] = 0.f;
  const float ibias = i_bias[dir * 4 + head], fbias = f_bias[dir * 4 + head];
  const int chg = tid & 31, rg = tid >> 5; const bool isk = chg >= 16;
  const int qkcol = 1024 + (isk ? 512 : 0) + head * 128 + (chg & 15) * 8;
  const int vrow = tid >> 3, vch = tid & 7;
  uint4 pq0, pq1, pq2, pq3, pv0, pv1, pv2, pv3; float pgi, pgf;
#define MLS_LOAD(c_) do { const int c__ = (c_); const bool ic_ = c__ < 4; const int T_ = ic_ ? CTXL : SEQ, cc_ = ic_ ? c__ : c__ - 4; \
    const long rb_ = ic_ ? (long)(NLAT + b * CTXL) : (long)b * SEQ; const int t0_ = dir ? (T_ - 64 * (cc_ + 1)) : 64 * cc_; \
    { const bf16_t* qp_ = QKC + (rb_ + t0_ + rg) * DM + qkcol; pq0 = *(const uint4*)qp_; pq1 = *(const uint4*)(qp_ + 16 * DM); pq2 = *(const uint4*)(qp_ + 32 * DM); pq3 = *(const uint4*)(qp_ + 48 * DM); } \
    { const uint4* vp_ = (const uint4*)(Pm + (rb_ + t0_ + vrow) * NP + C_VB + head * 256 + vch * 32); pv0 = vp_[0]; pv1 = vp_[1]; pv2 = vp_[2]; pv3 = vp_[3]; } \
    const float* gr_ = GATES + (rb_ + t0_ + (dir ? 63 - lane : lane)) * 16; pgi = gr_[dir * 4 + head]; pgf = gr_[8 + dir * 4 + head]; } while (0)
  MLS_LOAD(0);
  f32x4 Cacc[16];
#pragma unroll
  for (int e = 0; e < 16; ++e) Cacc[e] = (f32x4){0.f, 0.f, 0.f, 0.f};
  float gprev = 0.f;
  __syncthreads();
  for (int c = 0; c < 36; ++c) {
    const bool isctx = c < 4; const int T = isctx ? CTXL : SEQ, cc = isctx ? c : c - 4;
    const long rowbase = isctx ? (long)(NLAT + b * CTXL) : (long)b * SEQ;
    const int t0 = dir ? (T - 64 * (cc + 1)) : 64 * cc;
    const bool need_h = ctx_out || !isctx;
    float gamma, wk_l;
    {
      const float igv = 15.f * fast_tanh((pgi + ibias) * (1.f / 15.f));
      const float fc = 15.f * fast_tanh((pgf + fbias) * (1.f / 15.f));
      const float lfv = fminf(fc, 0.f) - __logf(1.f + __expf(-fabsf(fc)));
      const float bcum = wave_scan_incl(lfv);
      const float b63 = __builtin_bit_cast(float, __builtin_amdgcn_readlane(__builtin_bit_cast(int, bcum), 63));
      gamma = __expf(b63); wk_l = __expf(b63 - bcum + igv);
      if (wid == 0) { bl[lane] = bcum; bsp[lane] = bcum - igv; av[lane] = __expf(bcum); wkl[lane] = wk_l; }
      if (c > 0 && tid < 128) nvec[tid] = gprev * nvec[tid] + (npart[tid] + npart[128 + tid]) + (npart[256 + tid] + npart[384 + tid]);
    }
#pragma unroll
    for (int eblk = 0; eblk < 16; ++eblk) { uint2 w_; w_.x = pk2(Cacc[eblk][0], Cacc[eblk][1]); w_.y = pk2(Cacc[eblk][2], Cacc[eblk][3]);
      *(uint2*)(ct_lds + (eblk * 16 + lr) * QSTRB + (wid * 16 + 4 * kg) * 2) = w_; }
    { char* dst = (isk ? k_lds : q_lds) + (chg & 15) * 16;
      *(uint4*)(dst + (dir ? 63 - rg : rg) * QSTRB) = pq0; *(uint4*)(dst + (dir ? 47 - rg : rg + 16) * QSTRB) = pq1;
      *(uint4*)(dst + (dir ? 31 - rg : rg + 32) * QSTRB) = pq2; *(uint4*)(dst + (dir ? 15 - rg : rg + 48) * QSTRB) = pq3; }
    { char* dst = v_lds + (dir ? 63 - vrow : vrow) * VSTRB + vch * 64;
      *(uint4*)dst = pv0; *(uint4*)(dst + 16) = pv1; *(uint4*)(dst + 32) = pv2; *(uint4*)(dst + 48) = pv3; }
    if (c + 1 < 36) MLS_LOAD(c + 1);
    __syncthreads();
    if (need_h) {
      const int lblk = wid >> 1;
#pragma unroll
      for (int u2 = 0; u2 < 2; ++u2) {
        const int sblk = 2 * (wid & 1) + u2;
        if (sblk <= lblk) {
          f32x4 acc = {0.f, 0.f, 0.f, 0.f};
#pragma unroll
          for (int ks = 0; ks < 4; ++ks) {
            const bf16x8 ka = *(const bf16x8*)(k_lds + (sblk * 16 + lr) * QSTRB + (ks * 32 + 8 * kg) * 2);
            const bf16x8 qb = *(const bf16x8*)(q_lds + (lblk * 16 + lr) * QSTRB + (ks * 32 + 8 * kg) * 2);
            acc = mfma16(ka, qb, acc);
          }
          const int l = lblk * 16 + lr; const float blv = bl[l];
          float v4[4]; float sum = 0.f;
#pragma unroll
          for (int r = 0; r < 4; ++r) { const int sidx = sblk * 16 + 4 * kg + r; const float w = (sidx <= l) ? __expf(blv - bsp[sidx]) : 0.f; v4[r] = acc[r] * w; sum += v4[r]; }
          uint2 w; w.x = pk2(v4[0], v4[1]); w.y = pk2(v4[2], v4[3]);
          *(uint2*)(s_lds + l * SSTRB + (sblk * 16 + 4 * kg) * 2) = w;
          rs[(sblk * 4 + kg) * 64 + l] = sum;
        } else if ((lblk == 0 && sblk == 1) || (lblk == 2 && sblk == 3)) {
          uint2 z_; z_.x = 0u; z_.y = 0u; asm volatile("" : "+v"(z_.x), "+v"(z_.y));
          *(uint2*)(s_lds + (lblk * 16 + lr) * SSTRB + (sblk * 16 + 4 * kg) * 2) = z_;
        }
      }
      { const int l = tid >> 3, part = tid & 7; float a = 0.f;
        const unsigned* qp = (const unsigned*)(q_lds + l * QSTRB + part * 32);
#pragma unroll
        for (int i = 0; i < 8; ++i) { const unsigned wd = qp[i]; a += __uint_as_float(wd << 16) * nvec[part * 16 + 2 * i] + __uint_as_float(wd & 0xffff0000u) * nvec[part * 16 + 2 * i + 1]; }
        a += __builtin_bit_cast(float, __builtin_amdgcn_update_dpp(0, __builtin_bit_cast(int, a), 0xB1, 0xF, 0xF, false));
        a += __builtin_bit_cast(float, __builtin_amdgcn_update_dpp(0, __builtin_bit_cast(int, a), 0x4E, 0xF, 0xF, false));
        a += __builtin_bit_cast(float, __builtin_amdgcn_update_dpp(0, __builtin_bit_cast(int, a), 0x141, 0xF, 0xF, false));
        if (part == 0) qn[l] = a; }
    }
    __syncthreads();
    if (need_h) {
      const int lblk = wid >> 1, l = lblk * 16 + lr, eh = wid & 1;
      float d = av[l] * qn[l];
      for (int sb = 0; sb <= lblk; ++sb) d += (rs[(sb * 4 + 0) * 64 + l] + rs[(sb * 4 + 1) * 64 + l]) + (rs[(sb * 4 + 2) * 64 + l] + rs[(sb * 4 + 3) * 64 + l]);
      const float a_l = av[l], dinv = 1.f / fmaxf(fabsf(d), 1.f);
      bf16x8 qb[4];
#pragma unroll
      for (int ks = 0; ks < 4; ++ks) qb[ks] = *(const bf16x8*)(q_lds + l * QSTRB + (ks * 32 + 8 * kg) * 2);
      const bf16x8 sb0 = *(const bf16x8*)(s_lds + l * SSTRB + (8 * kg) * 2);
      bf16x8 sb1 = sb0; if (lblk >= 2) sb1 = *(const bf16x8*)(s_lds + l * SSTRB + (32 + 8 * kg) * 2);
      const int t = dir ? (t0 + 63 - l) : (t0 + l);
      bf16_t* hp = HM + ((size_t)dir * NTOK + rowbase + t) * 1024 + head * 256 + eh * 128 + 4 * kg;
#pragma unroll
      for (int half = 0; half < 2; ++half) {
        TrPair a0, a1, b0, b1, c0, c1, d0, d1;
        tr_v4(lds0 + L_V + trv + (unsigned)((eh * 8 + half * 4) * 32), a0, a1, b0, b1, c0, c1, d0, d1);
        __builtin_amdgcn_sched_barrier(0);
#define MLS_HTILE(ti, VA0, VA1) do { const int eblk = eh * 8 + half * 4 + (ti); f32x4 acc1 = {0.f, 0.f, 0.f, 0.f}, acc2 = {0.f, 0.f, 0.f, 0.f}; \
          _Pragma("unroll") for (int ks = 0; ks < 4; ++ks) { const bf16x8 ca = *(const bf16x8*)(ct_lds + (eblk * 16 + lr) * QSTRB + (ks * 32 + 8 * kg) * 2); acc1 = mfma16(ca, qb[ks], acc1); } \
          acc2 = mfma16(tr_pack(VA0), sb0, acc2); if (lblk >= 2) acc2 = mfma16(tr_pack(VA1), sb1, acc2); \
          uint2 w_; w_.x = pk2((a_l * acc1[0] + acc2[0]) * dinv, (a_l * acc1[1] + acc2[1]) * dinv); w_.y = pk2((a_l * acc1[2] + acc2[2]) * dinv, (a_l * acc1[3] + acc2[3]) * dinv); \
          *(uint2*)(hp + (half * 4 + (ti)) * 16) = w_; } while (0)
        MLS_HTILE(0, a0, a1); MLS_HTILE(1, b0, b1); MLS_HTILE(2, c0, c1); MLS_HTILE(3, d0, d1);
#undef MLS_HTILE
      }
    }
    {
      bf16x8 kA0, kA1;
      { TrPair ka0, ka1; const unsigned ak = lds0 + L_K + trq + (unsigned)(wid * 32);
        asm volatile("ds_read_b64_tr_b16 %0, %4\n\tds_read_b64_tr_b16 %1, %4 offset:1088\n\tds_read_b64_tr_b16 %2, %4 offset:8704\n\tds_read_b64_tr_b16 %3, %4 offset:9792\n\ts_waitcnt lgkmcnt(0)"
                     : "=&v"(ka0.lo), "=&v"(ka0.hi), "=&v"(ka1.lo), "=&v"(ka1.hi) : "v"(ak) : "memory");
        const float4 w0 = *(const float4*)(wkl + 8 * kg), w1 = *(const float4*)(wkl + 8 * kg + 4), w2 = *(const float4*)(wkl + 32 + 8 * kg), w3 = *(const float4*)(wkl + 36 + 8 * kg);
        kA0 = scale_frag(ka0, w0, w1); kA1 = scale_frag(ka1, w2, w3); }
#pragma unroll
      for (int q4 = 0; q4 < 4; ++q4) {
        TrPair a0, a1, b0, b1, c0, c1, d0, d1;
        tr_v4(lds0 + L_V + trv + (unsigned)(q4 * 128), a0, a1, b0, b1, c0, c1, d0, d1);
        __builtin_amdgcn_sched_barrier(0);
#define MLS_CUPD(ti, V0, V1) do { f32x4 cc_ = Cacc[q4 * 4 + (ti)] * gamma; cc_ = mfma16(kA0, tr_pack(V0), cc_); cc_ = mfma16(kA1, tr_pack(V1), cc_); Cacc[q4 * 4 + (ti)] = cc_; } while (0)
        MLS_CUPD(0, a0, a1); MLS_CUPD(1, b0, b1); MLS_CUPD(2, c0, c1); MLS_CUPD(3, d0, d1);
#undef MLS_CUPD
      }
      { const int dd = tid & 127, sq = tid >> 7; float a = 0.f; const bf16_t* kp = (const bf16_t*)k_lds + (sq * 16) * (QSTRB / 2) + dd;
#pragma unroll
        for (int si = 0; si < 16; ++si) a += bf2f(kp[si * (QSTRB / 2)]) * wkl[sq * 16 + si];
        npart[sq * 128 + dd] = a; }
      gprev = gamma;
    }
    __syncthreads();
  }
#undef MLS_LOAD
  asm volatile("s_waitcnt vmcnt(0)" ::: "memory");
  __syncthreads();
  if (tid == 0) { __builtin_amdgcn_fence(__ATOMIC_RELEASE, "agent"); asm volatile("s_waitcnt vmcnt(0)" ::: "memory"); __hip_atomic_fetch_add(mdone + 64 * b, 1u, __ATOMIC_RELAXED, __HIP_MEMORY_SCOPE_AGENT); }
}
__device__ __forceinline__ void qkconv_phase(const bf16_t* __restrict__ Pm, bf16_t* __restrict__ QKC, const float* __restrict__ conv_w, const float* __restrict__ conv_b) {
  const int tid = opaque_tid(), lane = tid & 63, wave = tid >> 6;
  const int gw = blockIdx.x * 8 + wave, ngw = gridDim.x * 8;
  const int half = gw & 1, c0 = half * 512 + lane * 8;
  float cw0[8], cw1[8], cw2[8], cbv[8];
#pragma unroll
  for (int i = 0; i < 8; ++i) { cw0[i] = conv_w[c0 + i]; cw1[i] = conv_w[1024 + c0 + i]; cw2[i] = conv_w[2048 + c0 + i]; cbv[i] = conv_b[c0 + i]; }
  const float osc = half ? 0.08838834764831845f : 1.f;
  for (int it = gw >> 1; it < NTOK / 8; it += ngw >> 1) {
    const int r0 = it * 8; const bool isl = r0 < NLAT; const int seq0 = isl ? (r0 / SEQ) * SEQ : NLAT + ((r0 - NLAT) / CTXL) * CTXL, T = isl ? SEQ : CTXL;
    uint4 x[10];
#pragma unroll
    for (int r = 0; r < 10; ++r) { const int t = r0 - seq0 - 1 + r; x[r] = (t >= 0 && t < T) ? *(const uint4*)(Pm + (size_t)(seq0 + t) * NP + C_QB + c0) : make_uint4(0u, 0u, 0u, 0u); }
#pragma unroll
    for (int r = 0; r < 8; ++r) {
      const unsigned a0[4] = {x[r].x, x[r].y, x[r].z, x[r].w}, a1[4] = {x[r + 1].x, x[r + 1].y, x[r + 1].z, x[r + 1].w}, a2[4] = {x[r + 2].x, x[r + 2].y, x[r + 2].z, x[r + 2].w};
      float o[8];
#pragma unroll
      for (int i = 0; i < 8; ++i) {
        const float v0 = (i & 1) ? __uint_as_float(a0[i >> 1] & 0xffff0000u) : __uint_as_float(a0[i >> 1] << 16);
        const float v1 = (i & 1) ? __uint_as_float(a1[i >> 1] & 0xffff0000u) : __uint_as_float(a1[i >> 1] << 16);
        const float v2 = (i & 1) ? __uint_as_float(a2[i >> 1] & 0xffff0000u) : __uint_as_float(a2[i >> 1] << 16);
        const float z = cbv[i] + cw0[i] * v0 + cw1[i] * v1 + cw2[i] * v2;
        o[i] = osc * silu_f(z);
      }
      uint4 w; w.x = pk2(o[0], o[1]); w.y = pk2(o[2], o[3]); w.z = pk2(o[4], o[5]); w.w = pk2(o[6], o[7]);
      *(uint4*)(QKC + (size_t)(r0 + r) * DM + 1024 + c0) = w;
    }
  }
}
__device__ __forceinline__ void mlstm_phase(const bf16_t* __restrict__ Pm, const bf16_t* __restrict__ QKC, const float* __restrict__ GATES, bf16_t* __restrict__ HM,
                                            const float* __restrict__ i_bias, const float* __restrict__ f_bias, bool ctx_out, unsigned* mdone, char* lds) {
  const int G = gridDim.x, bx = blockIdx.x;
  if (G == 256) { const int vcu = (bx % 8) * 32 + bx / 8; if ((vcu & 31) < 8) { const int u = (vcu >> 5) * 8 + (vcu & 31); mlstm_unit(Pm, QKC, GATES, HM, i_bias, f_bias, u >> 3, (u >> 1) & 3, u & 1, ctx_out, mdone, lds); } }
  else for (int u = bx; u < 64; u += G) mlstm_unit(Pm, QKC, GATES, HM, i_bias, f_bias, u >> 3, (u >> 1) & 3, u & 1, ctx_out, mdone, lds);
}
}

DEVI void mod_unit(int unit, const float* __restrict__ c, const float* __restrict__ c_ctx, const float* __restrict__ w_ada, const float* __restrict__ b_ada, float* __restrict__ MOD, float* ldsf) {
    const int tid = opaque_tid(), lane = tid & 63, wv = tid >> 6;
    const int l = unit / 96, rem = unit % 96, cb = rem >> 2, kq = rem & 3;
    float* sc = ldsf; float* red = ldsf + 9 * 512;
    for (int i = tid; i < 9 * 512; i += 512) { const int r = i >> 9, k = kq * 512 + (i & 511); const float v = (r < 8) ? c[r * DM + k] : c_ctx[k]; sc[i] = silu_f(v); }
    __syncthreads();
    float4 acc[9];
#pragma unroll
    for (int r = 0; r < 9; ++r) acc[r] = make_float4(0.f, 0.f, 0.f, 0.f);
    const float4* w = (const float4*)(w_ada + (size_t)l * DM * MODW + (size_t)(kq * 512 + wv * 64) * MODW + cb * 256) + lane;
#pragma unroll 16
    for (int k = 0; k < 64; ++k) {
        const float4 wvv = w[(size_t)k * (MODW / 4)];
#pragma unroll
        for (int r = 0; r < 9; ++r) { const float s_ = sc[r * 512 + wv * 64 + k]; acc[r].x += s_ * wvv.x; acc[r].y += s_ * wvv.y; acc[r].z += s_ * wvv.z; acc[r].w += s_ * wvv.w; }
    }
#pragma unroll
    for (int r = 0; r < 9; ++r) ((float4*)red)[(wv * 9 + r) * 64 + lane] = acc[r];
    __syncthreads();
    for (int idx = tid; idx < 9 * 256; idx += 512) {
        const int r = idx >> 8, cc = idx & 255; float s_ = (kq == 0) ? b_ada[l * MODW + cb * 256 + cc] : 0.f;
#pragma unroll
        for (int g = 0; g < 8; ++g) s_ += red[(g * 9 + r) * 256 + cc];
        atomicAdd(MOD + (size_t)(l * 9 + r) * MODW + cb * 256 + cc, s_);
    }
    __syncthreads();
}
DEVI void transpose_items(const float* __restrict__ W, int ldw, int K, int N, bf16_t* __restrict__ WT, float* scr, int gw, int ngw, int lane) {
    const int nitems = (K / 64) * (N / 64);
    for (int it = gw; it < nitems; it += ngw) transpose_item(W, ldw, K, N, WT, scr, it, lane);
}
DEVI void finish_row(const bf16_t* __restrict__ P, const bf16_t* __restrict__ HM, const float* __restrict__ mnorm, bf16_t* __restrict__ Y, int row, int lane) {
#pragma unroll
    for (int head = 0; head < 4; ++head) {
        const int col = head * 256 + 4 * lane;
        const uint2 a = *(const uint2*)(HM + (size_t)row * 1024 + col), c = *(const uint2*)(HM + ((size_t)NTOK + row) * 1024 + col);
        float h[4];
        h[0] = __uint_as_float(a.x << 16) + __uint_as_float(c.x << 16); h[1] = __uint_as_float(a.x & 0xffff0000u) + __uint_as_float(c.x & 0xffff0000u);
        h[2] = __uint_as_float(a.y << 16) + __uint_as_float(c.y << 16); h[3] = __uint_as_float(a.y & 0xffff0000u) + __uint_as_float(c.y & 0xffff0000u);
        const float ss = wave_sum(h[0] * h[0] + h[1] * h[1] + h[2] * h[2] + h[3] * h[3]);
        const float r = rsqrtf(ss * (1.f / 256.f) + EPS);
        const uint2 ov = *(const uint2*)(P + (size_t)row * NP + C_OB + col), gv = *(const uint2*)(P + (size_t)row * NP + C_GB + col);
        const float o[4] = {__uint_as_float(ov.x << 16), __uint_as_float(ov.x & 0xffff0000u), __uint_as_float(ov.y << 16), __uint_as_float(ov.y & 0xffff0000u)};
        const float g[4] = {__uint_as_float(gv.x << 16), __uint_as_float(gv.x & 0xffff0000u), __uint_as_float(gv.y << 16), __uint_as_float(gv.y & 0xffff0000u)};
        const float4 w = *(const float4*)(mnorm + col);
        const float wv[4] = {w.x, w.y, w.z, w.w};
        float y[4];
#pragma unroll
        for (int e = 0; e < 4; ++e) y[e] = h[e] * r * wv[e] * sigmoid_f(o[e]) * silu_f(g[e]);
        uint2 out; out.x = pk2(y[0], y[1]); out.y = pk2(y[2], y[3]);
        *(uint2*)(Y + (size_t)row * DM + 1024 + col) = out;
    }
}
DEVI void load_row(const float* __restrict__ xr, float4 (&v)[8], int lane) {
#pragma unroll
    for (int j = 0; j < 8; ++j) v[j] = ((const float4*)xr)[lane + 64 * j];
}
DEVI void load_row_y(const bf16_t* __restrict__ yr, uint2 (&yv)[8], int lane) {
#pragma unroll
    for (int j = 0; j < 8; ++j) yv[j] = *(const uint2*)(yr + 4 * (lane + 64 * j));
}
DEVI void post_regs(float4 (&v)[8], const uint2 (&yv)[8], const float* gate, const float* npost, float* __restrict__ orow, int lane) {
    float ss = 0.f;
#pragma unroll
    for (int j = 0; j < 8; ++j) {
        const float y0 = __uint_as_float(yv[j].x << 16), y1 = __uint_as_float(yv[j].x & 0xffff0000u), y2 = __uint_as_float(yv[j].y << 16), y3 = __uint_as_float(yv[j].y & 0xffff0000u);
        ss += y0 * y0 + y1 * y1 + y2 * y2 + y3 * y3;
    }
    ss = wave_sum(ss);
    const float rstd = rsqrtf(ss * (1.f / DM) + EPS);
#pragma unroll
    for (int j = 0; j < 8; ++j) {
        const float4 gt = ((const float4*)gate)[lane + 64 * j], w = ((const float4*)npost)[lane + 64 * j];
        const float y0 = __uint_as_float(yv[j].x << 16), y1 = __uint_as_float(yv[j].x & 0xffff0000u), y2 = __uint_as_float(yv[j].y << 16), y3 = __uint_as_float(yv[j].y & 0xffff0000u);
        v[j].x += gt.x * (y0 * rstd * w.x); v[j].y += gt.y * (y1 * rstd * w.y); v[j].z += gt.z * (y2 * rstd * w.z); v[j].w += gt.w * (y3 * rstd * w.w);
        ((float4*)orow)[lane + 64 * j] = v[j];
        if (j == 3) asm volatile("" ::: "memory");
    }
}
DEVI void norm_regs(const float4 (&v)[8], const float* shift, const float* scale, const float* npre, bf16_t* __restrict__ hrow, char* trow, int lane) {
    float ss = 0.f;
#pragma unroll
    for (int j = 0; j < 8; ++j) ss += v[j].x * v[j].x + v[j].y * v[j].y + v[j].z * v[j].z + v[j].w * v[j].w;
    ss = wave_sum(ss);
    const float rstd = rsqrtf(ss * (1.f / DM) + EPS);
#pragma unroll
    for (int j = 0; j < 8; ++j) {
        const float4 w = ((const float4*)npre)[lane + 64 * j], sh = ((const float4*)shift)[lane + 64 * j], sc = ((const float4*)scale)[lane + 64 * j];
        uint2 o;
        o.x = pk2(v[j].x * rstd * w.x * (1.f + sc.x) + sh.x, v[j].y * rstd * w.y * (1.f + sc.y) + sh.y);
        o.y = pk2(v[j].z * rstd * w.z * (1.f + sc.z) + sh.z, v[j].w * rstd * w.w * (1.f + sc.w) + sh.w);
        *(uint2*)(hrow + 4 * (lane + 64 * j)) = o; *(uint2*)(trow + 8 * (lane + 64 * j)) = o;
        if (j == 3) asm volatile("" ::: "memory");
    }
}
constexpr int NT_ROWB = (DM + 8) * 2;
constexpr int NV_OFF = 0, NT_OFF = 5 * DM * 4, NR_OFF = NT_OFF + 16 * NT_ROWB, NPH_LDS = NR_OFF + 8 * 16 * 16 * 4;
static_assert(NPH_LDS <= LDS_PHASE_BYTES, "norm phase LDS map");
template <bool POST>
DEVI void norm_phase(const float* __restrict__ xlat, const float* __restrict__ xctx, const bf16_t* __restrict__ Y2, const float* __restrict__ mod_post, const float* __restrict__ npost,
                     float* olat, float* octx, const float* __restrict__ mod_n, const float* __restrict__ npre, const bf16_t* __restrict__ wgt, bf16_t* __restrict__ H,
                     float* __restrict__ GATES, char* lds) {
    typedef short bf16x8 __attribute__((ext_vector_type(8))); typedef float f32x4 __attribute__((ext_vector_type(4)));
    const int tid = opaque_tid(), lane = tid & 63, wave = __builtin_amdgcn_readfirstlane(tid >> 6), lr = lane & 15, kgp = lane >> 4;
    float* vec = (float*)(lds + NV_OFF); float* v_npre = vec; float* v_shift = vec + DM; float* v_scale = vec + 2 * DM; float* v_npost = vec + 3 * DM; float* v_gate = vec + 4 * DM;
    char* tile = lds + NT_OFF; float* red = (float*)(lds + NR_OFF);
    ((float4*)v_npre)[tid] = ((const float4*)npre)[tid];
    if (POST) ((float4*)v_npost)[tid] = ((const float4*)npost)[tid];
    int cur_b = -1;
#define NP_ENSURE(bb) do { if ((bb) != cur_b) { __syncthreads(); const float* mn_ = mod_n + (size_t)(bb) * MODW; ((float4*)v_shift)[tid] = ((const float4*)mn_)[tid]; ((float4*)v_scale)[tid] = ((const float4*)(mn_ + DM))[tid]; \
        if (POST) ((float4*)v_gate)[tid] = ((const float4*)(mod_post + (size_t)(bb) * MODW + 2 * DM))[tid]; cur_b = (bb); __syncthreads(); } } while (0)
    const int row0 = (int)blockIdx.x * (NTOK / 256);
    for (int g = 0; g < 5; ++g) {
        const int gr0 = row0 + 16 * g; const bool two = g < 4;
        const int rowA = gr0 + wave, rowB = gr0 + 8 + wave;
        const bool islA = rowA < NLAT, islB = rowB < NLAT; const int bA = gr0 < NLAT ? gr0 / SEQ : 8, bB = (gr0 + 8) < NLAT ? (gr0 + 8) / SEQ : 8;
        float4 vA[8], vB[8]; uint2 yA[8], yB[8];
        load_row(islA ? xlat + (size_t)rowA * DM : xctx + (size_t)(rowA - NLAT) * DM, vA, lane);
        if (POST) load_row_y(Y2 + (size_t)rowA * DM, yA, lane);
        if (two) { load_row(islB ? xlat + (size_t)rowB * DM : xctx + (size_t)(rowB - NLAT) * DM, vB, lane); if (POST) load_row_y(Y2 + (size_t)rowB * DM, yB, lane); }
        NP_ENSURE(bA);
        if (POST) post_regs(vA, yA, v_gate, v_npost, islA ? olat + (size_t)rowA * DM : octx + (size_t)(rowA - NLAT) * DM, lane);
        norm_regs(vA, v_shift, v_scale, v_npre, H + (size_t)rowA * DM, tile + wave * NT_ROWB, lane);
        if (two) {
            NP_ENSURE(bB);
            if (POST) post_regs(vB, yB, v_gate, v_npost, islB ? olat + (size_t)rowB * DM : octx + (size_t)(rowB - NLAT) * DM, lane);
            norm_regs(vB, v_shift, v_scale, v_npre, H + (size_t)rowB * DM, tile + (8 + wave) * NT_ROWB, lane);
        }
        __syncthreads();
        f32x4 acc = {0.f, 0.f, 0.f, 0.f};
#pragma unroll
        for (int ks = 0; ks < 8; ++ks) {
            const bf16x8 af = *(const bf16x8*)(tile + lr * NT_ROWB + (wave * 256 + ks * 32 + 8 * kgp) * 2);
            const bf16x8 bf = *(const bf16x8*)(wgt + lr * DM + wave * 256 + ks * 32 + 8 * kgp);
            acc = __builtin_amdgcn_mfma_f32_16x16x32_bf16(af, bf, acc, 0, 0, 0);
        }
#pragma unroll
        for (int r = 0; r < 4; ++r) red[(wave * 16 + 4 * kgp + r) * 16 + lr] = acc[r];
        __syncthreads();
        if (tid < 256) { const int rr = tid >> 4, cc = tid & 15;
            if (two || rr < 8) { float sum = 0.f;
#pragma unroll
                for (int w8 = 0; w8 < 8; ++w8) sum += red[(w8 * 16 + rr) * 16 + cc];
                GATES[(size_t)(gr0 + rr) * 16 + cc] = sum; } }
    }
#undef NP_ENSURE
    __syncthreads();
}
DEVI void post_phase_final(float* out, const bf16_t* __restrict__ Y2, const float* __restrict__ mod_l, const float* __restrict__ npost, char* lds) {
    const int tid = opaque_tid(), lane = tid & 63, wave = tid >> 6;
    float* v_gate = (float*)lds; float* v_npost = v_gate + DM;
    const int row0 = (int)blockIdx.x * (NLAT / 256), b = row0 / SEQ;
    ((float4*)v_gate)[tid] = ((const float4*)(mod_l + (size_t)b * MODW + 2 * DM))[tid];
    ((float4*)v_npost)[tid] = ((const float4*)npost)[tid];
    __syncthreads();
    float4 vA[8], vB[8]; uint2 yA[8], yB[8];
    const int r0 = row0 + wave * 8;
    load_row(out + (size_t)r0 * DM, vA, lane); load_row_y(Y2 + (size_t)r0 * DM, yA, lane);
    load_row(out + (size_t)(r0 + 1) * DM, vB, lane); load_row_y(Y2 + (size_t)(r0 + 1) * DM, yB, lane);
#pragma unroll 1
    for (int i = 0; i < 4; ++i) {
        const int ra = r0 + 2 * i, rb = ra + 1;
        post_regs(vA, yA, v_gate, v_npost, out + (size_t)ra * DM, lane);
        if (i < 3) { load_row(out + (size_t)(ra + 2) * DM, vA, lane); load_row_y(Y2 + (size_t)(ra + 2) * DM, yA, lane); }
        post_regs(vB, yB, v_gate, v_npost, out + (size_t)rb * DM, lane);
        if (i < 3) { load_row(out + (size_t)(rb + 2) * DM, vB, lane); load_row_y(Y2 + (size_t)(rb + 2) * DM, yB, lane); }
    }
    __syncthreads();
}

struct MegaArgs { const float* in[20]; float* out; unsigned char* ws; };
DEVI const float* karg_in(int i) { const char* kp = (const char*)__builtin_amdgcn_kernarg_segment_ptr(); asm volatile("" : "+s"(kp)); return *(const float* const*)(kp + 8 * i); }
DEVI unsigned char* karg_ws() { const char* kp = (const char*)__builtin_amdgcn_kernarg_segment_ptr(); asm volatile("" : "+s"(kp)); return *(unsigned char* const*)(kp + 168); }
DEVI float* karg_out() { const char* kp = (const char*)__builtin_amdgcn_kernarg_segment_ptr(); asm volatile("" : "+s"(kp)); return *(float* const*)(kp + 160); }
typedef const __attribute__((address_space(4))) MegaArgs* KArgP;
DEVI KArgP kargs() {
    const unsigned long long p = (unsigned long long)__builtin_amdgcn_kernarg_segment_ptr();
    unsigned lo = (unsigned)p, hi = (unsigned)(p >> 32);
    asm volatile("" : "+s"(lo), "+s"(hi));
    lo = __builtin_amdgcn_readfirstlane(lo); hi = __builtin_amdgcn_readfirstlane(hi);
    return (KArgP)(((unsigned long long)hi << 32) | lo);
}

DEVI void mixer_queue(const bf16_t* __restrict__ Pm, bf16_t* __restrict__ Y, const bf16_t* __restrict__ HM, const float* lq1, const float* lk1, const float* lq2, const float* lk2,
                      const float* __restrict__ subln, const float* __restrict__ mnorm, float lam_init, bool ctx_out, unsigned* qcnt  ,
                      unsigned* mdone  , volatile __attribute__((address_space(3))) unsigned* bcast, bool defer  , char* lds) {
  const int tid = opaque_tid(), lane = tid & 63;
  const float lam = rl_f(expf(wave_sum(lq1[lane] * lk1[lane])) - expf(wave_sum(lq2[lane] * lk2[lane])) + lam_init, 0);
  const int G = gridDim.x, bx = blockIdx.x; const int vcu = (G % 8 == 0) ? (bx % 8) * (G / 8) + bx / 8 : bx;
  const int g0 = (G == 256) ? (vcu >> 5) : (bx & 7);
  const int natt = 64 + (ctx_out ? 8 : 0), ndef = natt + (defer ? 44 : 0), nun = ndef + 32 + (ctx_out ? 4 : 0);
  for (int gi = 0; gi < 8; ++gi) {
    const int g = (g0 + gi) & 7;
    for (;;) {
      if (opaque_tid() == 0) bcast[0] = __hip_atomic_fetch_add(qcnt + 64 * g, 1u, __ATOMIC_RELAXED, __HIP_MEMORY_SCOPE_AGENT);
      __syncthreads();
      const int u = (int)bcast[0];
      __syncthreads();
      if (u >= nun) break;
      if (u < 64) { const int bh = g * 8 + (u >> 3), qb = u & 7, b = bh >> 3, hh = bh & 7; att::attn_unit2(Pm, Y, (long)b * SEQ + qb * att::QROWS2, b, hh, 36, lam, lam_init, subln, lds); }
      else if (u < natt) { const int bh = g * 8 + (u - 64), b = bh >> 3, hh = bh & 7; att::attn_unit2(Pm, Y, (long)NLAT + b * CTXL, b, hh, 4, lam, lam_init, subln, lds); }
      else if (u < ndef) {
        const int ge = g * 44 + (u - natt); KArgP A = kargs();
        if (ge < 96) mod_unit(96 + ge, A->in[1], A->in[3], A->in[4], A->in[5], (float*)(A->ws + WS_MOD), (float*)lds);
        else { const int t2 = opaque_tid(); const int it = (ge - 96) * 8 + (t2 >> 6); const float* w_out = A->in[9]; bf16_t* WOUT = (bf16_t*)(A->ws + WS_WOUT);
          transpose_item(w_out + (size_t)(it >> 10) * DM * DM, DM, DM, DM, WOUT + (size_t)(it >> 10) * DM * DM, (float*)lds + (t2 >> 6) * (64 * 65), it & 1023, t2 & 63); }
      }
      else {
        const int f = u - ndef; const int row0 = f < 32 ? g * SEQ + f * 64 : NLAT + g * CTXL + (f - 32) * 64;
        if (opaque_tid() == 0) {
          unsigned spins = 0;
          while (__hip_atomic_load(mdone + 64 * g, __ATOMIC_RELAXED, __HIP_MEMORY_SCOPE_AGENT) < 8u) { __builtin_amdgcn_s_sleep(8); if (++spins > (1u << 22)) break; }
          __builtin_amdgcn_fence(__ATOMIC_ACQUIRE, "agent");
          asm volatile("s_waitcnt vmcnt(0)" ::: "memory");
        }
        __syncthreads();
        const int tid2 = opaque_tid();
#pragma unroll 1
        for (int r = 0; r < 8; ++r) finish_row(Pm, HM, mnorm, Y, row0 + (tid2 >> 6) * 8 + r, tid2 & 63);
      }
    }
  }
}

#define XB_TMO      128
#define XB_XCNT(j)  (256  + 64 * (j))
#define XB_XSUB(j)  (1280 + 64 * (j))
#define XB_XGEN(j)  (2304 + 64 * (j))
#define XB_TOP      3328
#define XB_TOPGEN   3392
#define XCD_BAR_WORDS 3456
#define XB_SPIN_CAP (1u << 18)

__device__ __forceinline__ unsigned xb_ld(unsigned* p)              { return __hip_atomic_load(p, __ATOMIC_RELAXED, __HIP_MEMORY_SCOPE_AGENT); }
__device__ __forceinline__ unsigned xb_add(unsigned* p, unsigned v) { return __hip_atomic_fetch_add(p, v, __ATOMIC_RELAXED, __HIP_MEMORY_SCOPE_AGENT); }
__device__ __forceinline__ unsigned xb_xcc_id() { return (unsigned)__builtin_amdgcn_s_getreg((3 << 11) | 20) & 0xFu; }
#define XB_SPIN(cond, bar) do { unsigned _sp = 0; while (cond) { __builtin_amdgcn_s_sleep(1); \
    if ((++_sp & 255u) == 0u) { if (xb_ld(&(bar)[XB_TMO])) break; if (_sp > XB_SPIN_CAP) { atomicAdd(&(bar)[XB_TMO], 1u); break; } } } } while (0)

struct XcdBarrier {
    unsigned* bar; unsigned x;
    volatile __attribute__((address_space(3))) unsigned* st;
};

__device__ __forceinline__ XcdBarrier xcd_barrier_post(unsigned* bar, volatile __attribute__((address_space(3))) unsigned* st) {
    XcdBarrier b; b.bar = bar; b.x = xb_xcc_id(); b.st = st;
    if (threadIdx.x == 0) (void)xb_add(&bar[XB_XCNT(b.x)], 1u);
    return b;
}
__device__ __forceinline__ void xcd_barrier_complete(unsigned* bar, unsigned x, unsigned& nloc, unsigned& nx) {
    const unsigned G = gridDim.x * gridDim.y * gridDim.z;
    unsigned sum, cnt, mine, sp = 0u;
    for (;;) {
        sum = 0u; cnt = 0u; mine = 0u;
#pragma unroll
        for (unsigned j = 0; j < 16; ++j) { const unsigned c = xb_ld(&bar[XB_XCNT(j)]); sum += c; cnt += (c > 0u) ? 1u : 0u; mine = (j == x) ? c : mine; }
        if (sum == G) break;
        __builtin_amdgcn_s_sleep(1);
        if ((++sp & 255u) == 0u) { if (xb_ld(&bar[XB_TMO])) break; if (sp > XB_SPIN_CAP) { atomicAdd(&bar[XB_TMO], 1u); break; } }
    }
    nloc = mine > 0u ? mine : 1u; nx = cnt > 0u ? cnt : 1u;
}

__device__ __forceinline__ void xcd_barrier(const XcdBarrier& b) {
    asm volatile("s_waitcnt vmcnt(0)" ::: "memory");
    __syncthreads();
    if (threadIdx.x == 0) {
        unsigned* bar = b.bar;
        __builtin_amdgcn_s_waitcnt(0);
        unsigned nloc = b.st[0], nx = b.st[1];
        if (nloc == 0u) { xcd_barrier_complete(bar, b.x, nloc, nx); b.st[0] = nloc; b.st[1] = nx; }
        const unsigned old = xb_add(&bar[XB_XSUB(b.x)], 1u);
        const unsigned gen = old / nloc;
        if (old + 1u == (gen + 1u) * nloc) {
            __builtin_amdgcn_fence(__ATOMIC_RELEASE, "agent");
            asm volatile("s_waitcnt vmcnt(0)" ::: "memory");
            const unsigned og = xb_add(&bar[XB_TOP], 1u);
            const unsigned tg = og / nx;
            if (og + 1u == (tg + 1u) * nx) xb_add(&bar[XB_TOPGEN], 1u);
            else XB_SPIN(xb_ld(&bar[XB_TOPGEN]) == tg, bar);
            __builtin_amdgcn_fence(__ATOMIC_ACQUIRE, "agent");
            xb_add(&bar[XB_XGEN(b.x)], 1u);
            asm volatile("s_waitcnt vmcnt(0)" ::: "memory");
        } else {
            XB_SPIN(xb_ld(&bar[XB_XGEN(b.x)]) == gen, bar);
            __builtin_amdgcn_fence(__ATOMIC_ACQUIRE, "agent");
            asm volatile("s_waitcnt vmcnt(0)" ::: "memory");
        }
    }
    __syncthreads();
}

namespace cg = cooperative_groups;
constexpr int MEGA_LDS = LDS_PHASE_BYTES + 256;
#define LAS3 __attribute__((address_space(3)))
__global__ __launch_bounds__(512, 2) void mega_fwd(MegaArgs a_unused) {
    (void)a_unused;
    extern __shared__ __attribute__((aligned(16))) unsigned char lds[];
    cg::grid_group grid = cg::this_grid();
    { volatile LAS3 unsigned* MISC = (volatile LAS3 unsigned*)((LAS3 unsigned char*)lds + LDS_PHASE_BYTES);
      if (threadIdx.x < 64) MISC[threadIdx.x] = 0u;
      __syncthreads();
      if ((threadIdx.x & 63) == 0) ((volatile LAS3 unsigned char*)MISC)[128 + ((unsigned)__builtin_amdgcn_s_getreg((5 << 11) | 4) & 63u)] = (unsigned char)(threadIdx.x >> 6);
      __syncthreads();
      (void)xcd_barrier_post((unsigned*)(kargs()->ws + WS_CTL) + 4096, MISC + 8); }
#define GRID_BAR() do { XcdBarrier b_; b_.bar = (unsigned*)(kargs()->ws + WS_CTL) + 4096; b_.x = xb_xcc_id(); b_.st = (volatile LAS3 unsigned*)((LAS3 unsigned char*)lds + LDS_PHASE_BYTES) + 8; xcd_barrier(b_); } while (0)
#define PHASE_IDS const int G = gridDim.x; const int tid = opaque_tid(), lane = tid & 63, wave = tid >> 6, gw = blockIdx.x * 8 + wave, ngw = G * 8; (void)tid; (void)lane; (void)gw; (void)ngw; float* scr = (float*)lds + wave * (64 * 65); (void)scr
#define WSP(T, off) ((T*)(A->ws + (off)))

    { PHASE_IDS; KArgP A = kargs();
      const float* w_in = A->in[8]; const float* w_out = A->in[9]; bf16_t* WIN = WSP(bf16_t, WS_WIN); bf16_t* WOUT = WSP(bf16_t, WS_WOUT); float* ROPE = WSP(float, WS_ROPE);
      const bool dfr = (G == 256);
      for (int u = blockIdx.x; u < (dfr ? 96 : 192); u += G) mod_unit(u, A->in[1], A->in[3], A->in[4], A->in[5], WSP(float, WS_MOD), (float*)lds);
      { bf16_t* WGT = WSP(bf16_t, WS_WGT); for (int i = blockIdx.x * 512 + tid; i < 2 * 16 * DM; i += G * 512) { const int l_ = i >> 15, k_ = (i >> 4) & (DM - 1), c_ = i & 15; WGT[(l_ * 16 + c_) * DM + k_] = f2bf(w_in[(size_t)l_ * DM * INC + (size_t)k_ * INC + NP + c_]); } }
      for (int i = blockIdx.x * 512 + tid; i < 1024; i += G * 512) { const int pos = i >> 4, f = i & 15; const float inv = powf(10000.f, -(float)f / 16.f); const float ang = (float)pos * inv;
          ROPE[2 * i] = cosf(ang); ROPE[2 * i + 1] = sinf(ang); }
      if (dfr) {
          if ((int)blockIdx.x >= 96) for (int it = gw - 96 * 8; it < 4096; it += 160 * 8) transpose_item(w_in, INC, DM, NP, WIN, scr, it, lane);
      } else {
          for (int it = gw; it < 6144; it += ngw) {
              if (it < 4096) transpose_item(w_in, INC, DM, NP, WIN, scr, it, lane);
              else if (it < 5120) transpose_item(w_out, DM, DM, DM, WOUT, scr, it - 4096, lane);
              else transpose_item(w_out + (size_t)DM * DM, DM, DM, DM, WOUT + (size_t)DM * DM, scr, it - 5120, lane);
          }
      } }
    if (gridDim.x > 65536u) grid.sync();
    GRID_BAR();
    { KArgP A = kargs();
      norm_phase<false>(A->in[0], A->in[2], nullptr, nullptr, nullptr, nullptr, nullptr, WSP(float, WS_MOD), A->in[6], WSP(bf16_t, WS_WGT), WSP(bf16_t, WS_H), WSP(float, WS_GATES), (char*)lds); }
    GRID_BAR();
    for (int l = 0; l < 2; ++l) {
        { KArgP A = kargs();
          pg8::Gemm g{WSP(bf16_t, WS_H), WSP(bf16_t, WS_WIN), NTOK, NP, DM}; pg8::StaticOrder S; S.init(NTOK, NP, (int)gridDim.x, (int)blockIdx.x); pg8::EpiInProj E{WSP(bf16_t, WS_P), NP, WSP(float, WS_ROPE)};
          pg8::gemm_phase<pg8::EpiInProj, pg8::StaticOrder, true, true>((PG8_LAS unsigned char*)lds, g, S, E); }
        GRID_BAR();
        { KArgP A = kargs(); mls::qkconv_phase(WSP(bf16_t, WS_P), WSP(bf16_t, WS_H), A->in[15] + (size_t)l * 3 * 1024, A->in[16] + l * 1024); }
        GRID_BAR();
        { KArgP A = kargs(); mls::mlstm_phase(WSP(bf16_t, WS_P), WSP(bf16_t, WS_H), WSP(float, WS_GATES), WSP(bf16_t, WS_HM), A->in[17] + l * 8, A->in[18] + l * 8, l == 0, WSP(unsigned, WS_CTL) + 12288 + l * 512, (char*)lds); }
        { KArgP A = kargs(); const float lam_init = l == 0 ? 0.2f : 0.35550906759f;
          mixer_queue(WSP(bf16_t, WS_P), WSP(bf16_t, WS_H), WSP(bf16_t, WS_HM), A->in[10] + l * 64, A->in[11] + l * 64, A->in[12] + l * 64, A->in[13] + l * 64, A->in[14] + l * 128, A->in[19] + l * 1024, lam_init, l == 0,
                      WSP(unsigned, WS_CTL) + 8192 + l * 512, WSP(unsigned, WS_CTL) + 12288 + l * 512, (volatile LAS3 unsigned*)((LAS3 unsigned char*)lds + LDS_PHASE_BYTES) + 16, l == 0 && gridDim.x == 256u, (char*)lds); }
        GRID_BAR();
        { KArgP A = kargs(); const int M = l == 0 ? NTOK : NLAT;
          pg8::Gemm g{WSP(bf16_t, WS_H), WSP(bf16_t, WS_WOUT) + (size_t)l * DM * DM, M, DM, DM}; pg8::StaticOrder S; S.init(M, DM, (int)gridDim.x, (int)blockIdx.x); pg8::EpiBf16 E{WSP(bf16_t, WS_HM), DM};
          pg8::gemm_phase<pg8::EpiBf16, pg8::StaticOrder, true, true>((PG8_LAS unsigned char*)lds, g, S, E); }
        if (l == 0) { PHASE_IDS; KArgP A = kargs(); const float* w_in1 = A->in[8] + (size_t)DM * INC; bf16_t* WIN = WSP(bf16_t, WS_WIN);
            const int nbusy = (NTOK / 256) * (DM / 256) - 2 * G;
            if (nbusy >= 0 && nbusy < G) { if ((int)blockIdx.x >= nbusy) transpose_items(w_in1, INC, DM, NP, WIN, scr, ((int)blockIdx.x - nbusy) * 8 + wave, (G - nbusy) * 8, lane); }
            else transpose_items(w_in1, INC, DM, NP, WIN, scr, gw, ngw, lane);
        }
        GRID_BAR();
        if (l == 0) {
            { KArgP A = kargs(); float* MOD = WSP(float, WS_MOD);
              norm_phase<true>(A->in[0], A->in[2], WSP(bf16_t, WS_HM), MOD, A->in[7], A->out, WSP(float, WS_XC), MOD + (size_t)9 * MODW, A->in[6] + DM, WSP(bf16_t, WS_WGT) + 16 * DM, WSP(bf16_t, WS_H), WSP(float, WS_GATES), (char*)lds); }
            GRID_BAR();
        } else { KArgP A = kargs(); post_phase_final(A->out, WSP(bf16_t, WS_HM), WSP(float, WS_MOD) + (size_t)9 * MODW, A->in[7] + DM, (char*)lds);
        }
    }
}

extern "C" void kernel_launch(void* const* d_in, const int* in_sizes, int n_in, void* d_out, int out_size, void* d_ws, size_t ws_size, hipStream_t stream) {
    (void)in_sizes; (void)n_in; (void)out_size; (void)ws_size;
    static int grid_blocks = 0;
    if (!grid_blocks) {
        int dev = 0, cus = 0, per_cu = 0;
        (void)hipGetDevice(&dev);
        (void)hipDeviceGetAttribute(&cus, hipDeviceAttributeMultiprocessorCount, dev);
        (void)hipFuncSetAttribute((const void*)mega_fwd, hipFuncAttributeMaxDynamicSharedMemorySize, MEGA_LDS);
        (void)hipOccupancyMaxActiveBlocksPerMultiprocessor(&per_cu, (const void*)mega_fwd, 512, MEGA_LDS);
        if (per_cu < 1) per_cu = 1;
        if (per_cu > 1) per_cu = 1;
        grid_blocks = cus * per_cu;
    }
    (void)hipMemsetAsync((char*)d_ws + WS_CTL, 0, WS_MOD + (size_t)2 * 9 * MODW * 4, stream);
    MegaArgs a{};
    for (int i = 0; i < 20; ++i) a.in[i] = (const float*)d_in[i];
    a.out = (float*)d_out; a.ws = (unsigned char*)d_ws;
    void* args[] = {&a};
    (void)hipLaunchCooperativeKernel((const void*)mega_fwd, dim3(grid_blocks), dim3(512), args, (size_t)MEGA_LDS, stream);
}
```

```cpp
#include <hip/hip_runtime.h>
#include <hip/hip_cooperative_groups.h>
#include <stdint.h>
#include <math.h>

#define DEVI __device__ __forceinline__
constexpr int LDS_PHASE_BYTES = 155648;
typedef unsigned short bf16_t;

constexpr int DM = 2048, NBATCH = 8, SEQ = 2048, CTXL = 256;
constexpr int NLAT = NBATCH * SEQ, NCTX = NBATCH * CTXL, NTOK = NLAT + NCTX;
constexpr int INC = 8208, NP = 8192, MODW = 6144;
constexpr int C_QA = 0, C_KA = 1024, C_VA = 2048, C_GA = 3072, C_QB = 4096, C_KB = 4608, C_VB = 5120, C_OB = 6144, C_GB = 7168;
constexpr float EPS = 1e-6f;

constexpr size_t MiB = (size_t)1 << 20;
constexpr size_t WS_CTL = 0, WS_MOD = 1 * MiB, WS_SC = WS_MOD + 512 * 1024, WS_ROPE = 2 * MiB, WS_WGT = 2 * MiB + 65536  , WS_GATES = 3 * MiB, WS_WOUT = 8 * MiB,
                 WS_WIN = 24 * MiB, WS_XC = 56 * MiB, WS_H = 72 * MiB, WS_HM = 144 * MiB, WS_P = 216 * MiB, WS_END = 504 * MiB;

DEVI int opaque_tid() {
    const unsigned hw = (unsigned)__builtin_amdgcn_s_getreg((5 << 11) | 4) & 63u;
    const unsigned w = *((const volatile __attribute__((address_space(3))) unsigned char*)(LDS_PHASE_BYTES + 128) + hw);
    int ln; asm volatile("v_mbcnt_lo_u32_b32 %0, -1, 0\n\tv_mbcnt_hi_u32_b32 %0, -1, %0" : "=v"(ln));
    return (int)(__builtin_amdgcn_readfirstlane(w) << 6) | ln;
}
DEVI float bf2f(bf16_t v) { return __uint_as_float(((unsigned)v) << 16); }
DEVI bf16_t f2bf(float f) { unsigned u = __float_as_uint(f); return (bf16_t)((u + 0x7fffu + ((u >> 16) & 1u)) >> 16); }
DEVI unsigned pk2(float lo, float hi) { typedef float f32x2_ __attribute__((ext_vector_type(2))); typedef __bf16 bf16x2_ __attribute__((ext_vector_type(2))); const f32x2_ v = {lo, hi}; return __builtin_bit_cast(unsigned, __builtin_convertvector(v, bf16x2_)); }
DEVI float row16_sum(float v) {
    v += __builtin_bit_cast(float, __builtin_amdgcn_update_dpp(0, __builtin_bit_cast(int, v), 0xB1, 0xF, 0xF, false));
    v += __builtin_bit_cast(float, __builtin_amdgcn_update_dpp(0, __builtin_bit_cast(int, v), 0x4E, 0xF, 0xF, false));
    v += __builtin_bit_cast(float, __builtin_amdgcn_update_dpp(0, __builtin_bit_cast(int, v), 0x141, 0xF, 0xF, false));
    v += __builtin_bit_cast(float, __builtin_amdgcn_update_dpp(0, __builtin_bit_cast(int, v), 0x140, 0xF, 0xF, false));
    return v;
}
DEVI float rl_f(float v, int l) { return __builtin_bit_cast(float, __builtin_amdgcn_readlane(__builtin_bit_cast(int, v), l)); }
DEVI float wave_sum(float v) { v = row16_sum(v); return (rl_f(v, 0) + rl_f(v, 16)) + (rl_f(v, 32) + rl_f(v, 48)); }
DEVI float half_sum(float v, int hi) { v = row16_sum(v); const float a = rl_f(v, 0) + rl_f(v, 16), b = rl_f(v, 32) + rl_f(v, 48); return hi ? b : a; }
DEVI float sigmoid_f(float x) { return __builtin_amdgcn_rcpf(1.f + __expf(-x)); }
DEVI float silu_f(float x) { return x * sigmoid_f(x); }

typedef float f4v_t __attribute__((ext_vector_type(4)));
DEVI unsigned long long uniform_ptr(const void* p) { const unsigned long long pb = (unsigned long long)p;
    return ((unsigned long long)(unsigned)__builtin_amdgcn_readfirstlane((int)(pb >> 32)) << 32) | (unsigned)__builtin_amdgcn_readfirstlane((int)pb); }
#define LD8_ASM(TAIL) asm volatile("s_nop 4\n\tglobal_load_dwordx4 %0, %8, %16\n\tglobal_load_dwordx4 %1, %9, %16\n\tglobal_load_dwordx4 %2, %10, %16\n\tglobal_load_dwordx4 %3, %11, %16\n\t" \
        "global_load_dwordx4 %4, %12, %16\n\tglobal_load_dwordx4 %5, %13, %16\n\tglobal_load_dwordx4 %6, %14, %16\n\tglobal_load_dwordx4 %7, %15, %16" TAIL \
        : "=&v"(v[0]), "=&v"(v[1]), "=&v"(v[2]), "=&v"(v[3]), "=&v"(v[4]), "=&v"(v[5]), "=&v"(v[6]), "=&v"(v[7]) \
        : "v"(vo[0]), "v"(vo[1]), "v"(vo[2]), "v"(vo[3]), "v"(vo[4]), "v"(vo[5]), "v"(vo[6]), "v"(vo[7]), "s"(sb) : "memory")
DEVI void ld8_wait(f4v_t (&v)[8], const unsigned (&vo)[8], unsigned long long sb) { LD8_ASM("\n\ts_waitcnt vmcnt(0)"); }
DEVI void ld16_wait(f4v_t (&v)[16], const unsigned (&vo)[8], unsigned long long sb0, unsigned long long sb1) {
    asm volatile("s_nop 4\n\tglobal_load_dwordx4 %0, %16, %24\n\tglobal_load_dwordx4 %1, %17, %24\n\tglobal_load_dwordx4 %2, %18, %24\n\tglobal_load_dwordx4 %3, %19, %24\n\t"
                 "global_load_dwordx4 %4, %20, %24\n\tglobal_load_dwordx4 %5, %21, %24\n\tglobal_load_dwordx4 %6, %22, %24\n\tglobal_load_dwordx4 %7, %23, %24\n\t"
                 "global_load_dwordx4 %8, %16, %25\n\tglobal_load_dwordx4 %9, %17, %25\n\tglobal_load_dwordx4 %10, %18, %25\n\tglobal_load_dwordx4 %11, %19, %25\n\t"
                 "global_load_dwordx4 %12, %20, %25\n\tglobal_load_dwordx4 %13, %21, %25\n\tglobal_load_dwordx4 %14, %22, %25\n\tglobal_load_dwordx4 %15, %23, %25\n\ts_waitcnt vmcnt(0)"
                 : "=&v"(v[0]), "=&v"(v[1]), "=&v"(v[2]), "=&v"(v[3]), "=&v"(v[4]), "=&v"(v[5]), "=&v"(v[6]), "=&v"(v[7]),
                   "=&v"(v[8]), "=&v"(v[9]), "=&v"(v[10]), "=&v"(v[11]), "=&v"(v[12]), "=&v"(v[13]), "=&v"(v[14]), "=&v"(v[15])
                 : "v"(vo[0]), "v"(vo[1]), "v"(vo[2]), "v"(vo[3]), "v"(vo[4]), "v"(vo[5]), "v"(vo[6]), "v"(vo[7]), "s"(sb0), "s"(sb1) : "memory");
}


struct MegaArgs { const float* in[20]; float* out; unsigned char* ws; };
DEVI const float* karg_in(int i) { const char* kp = (const char*)__builtin_amdgcn_kernarg_segment_ptr(); asm volatile("" : "+s"(kp)); return *(const float* const*)(kp + 8 * i); }
DEVI unsigned char* karg_ws() { const char* kp = (const char*)__builtin_amdgcn_kernarg_segment_ptr(); asm volatile("" : "+s"(kp)); return *(unsigned char* const*)(kp + 168); }
DEVI float* karg_out() { const char* kp = (const char*)__builtin_amdgcn_kernarg_segment_ptr(); asm volatile("" : "+s"(kp)); return *(float* const*)(kp + 160); }
typedef const __attribute__((address_space(4))) MegaArgs* KArgP;
DEVI KArgP kargs() {
    const unsigned long long p = (unsigned long long)__builtin_amdgcn_kernarg_segment_ptr();
    unsigned lo = (unsigned)p, hi = (unsigned)(p >> 32);
    asm volatile("" : "+s"(lo), "+s"(hi));
    lo = __builtin_amdgcn_readfirstlane(lo); hi = __builtin_amdgcn_readfirstlane(hi);
    return (KArgP)(((unsigned long long)hi << 32) | lo);
}

DEVI void transpose_item(const float* __restrict__ W, int ldw, int K, int N, bf16_t* __restrict__ WT, float* scr, int item, int lane) {
    const int nblk = N / 64, kb = item / nblk, nb = item % nblk, k0 = 64 * kb, n0 = 64 * nb;
    float tv[64];
#pragma unroll
    for (int i = 0; i < 64; ++i) tv[i] = W[(size_t)(k0 + i) * ldw + n0 + lane];
#pragma unroll
    for (int i = 0; i < 64; ++i) scr[i * 65 + lane] = tv[i];
    asm volatile("s_waitcnt lgkmcnt(0)" ::: "memory");
    const int c = lane & 7;
#pragma unroll
    for (int j = 0; j < 8; ++j) {
        const int n = (lane >> 3) + 8 * j; const float* sp = scr + (8 * c) * 65 + n;
        uint4 o; o.x = pk2(sp[0 * 65], sp[1 * 65]); o.y = pk2(sp[2 * 65], sp[3 * 65]); o.z = pk2(sp[4 * 65], sp[5 * 65]); o.w = pk2(sp[6 * 65], sp[7 * 65]);
        *(uint4*)(WT + (size_t)(n0 + n) * K + k0 + 8 * c) = o;
    }
    asm volatile("s_waitcnt lgkmcnt(0)" ::: "memory");
}

namespace pg8 {
#define PG8_LAS __attribute__((address_space(3)))
typedef unsigned short bf16_t;
typedef short bf16x8 __attribute__((ext_vector_type(8)));
typedef float f32x4 __attribute__((ext_vector_type(4)));
typedef unsigned u32x4 __attribute__((ext_vector_type(4)));
constexpr int BM = 256, BK = 64, HALF = 128, HTB = HALF * BK * 2  , STAGE_BYTES = 8 * HTB, NXCD = 8, WGM = 8;

__host__ __device__ __forceinline__ int lds_byte(int r, int c) { const int st = (r >> 4) * 2 + (c >> 5), rr = r & 15, cc = c & 31, ob = rr * 64 + cc * 2; return st * 1024 + (ob ^ (((ob >> 9) & 1) << 5)); }
__host__ __device__ __forceinline__ void stage_rc(int b, int& R, int& C) { const int st = b / 1024, sb = b % 1024, swz = sb ^ (((sb >> 9) & 1) << 5); R = (st >> 1) * 16 + swz / 64; C = (st & 1) * 32 + (swz % 64) / 2; }
__host__ __device__ __forceinline__ int perm32(int rho) { const int n = rho >> 4, i = rho & 15; return 8 * (i >> 2) + 4 * n + (i & 3); }

struct Unit { int pm, pn; };
struct Gemm { const bf16_t* A; const bf16_t* Bt; int M, N, K; };

struct StaticOrder {
    int nM, nN, nwg, G, c;
    __host__ __device__ void init(int M, int N, int G_, int c_) { nM = M / BM; nN = N / BM; nwg = nM * nN; G = G_; c = c_; }
    __host__ __device__ bool next(int i, Unit& u) const {
        const long L = (long)i * G + c; if (L >= nwg) return false;
        int wgid = (int)L; { const int q = nwg / NXCD, r = nwg % NXCD, xcd = wgid % NXCD, off = wgid / NXCD; wgid = (xcd < r ? xcd * (q + 1) : r * (q + 1) + (xcd - r) * q) + off; }
        const int nig = WGM * nN, gid = wgid / nig, fm = gid * WGM, gsz = (nM - fm) < WGM ? (nM - fm) : WGM;
        u.pm = fm + ((wgid % nig) % gsz); u.pn = (wgid % nig) / gsz; return true;
    }
    __device__ __forceinline__ void a_ready(const Unit&) const {}
    __device__ __forceinline__ void done(const Unit&) const {}
};

__device__ __forceinline__ unsigned cvt_pk_bf16(float lo, float hi) { unsigned r; asm volatile("v_cvt_pk_bf16_f32 %0, %1, %2" : "=v"(r) : "v"(lo), "v"(hi)); return r; }

struct EpiBf16 {
    static constexpr bool PERM = true, AFTER_DRAIN = false;
    bf16_t* O; int ldc;
    __device__ __forceinline__ void operator()(const f32x4 (&acc)[2][2][4][2], const Unit& u, int wr, int wc, int fr, int fq) const {
        const int row0 = u.pm * BM + wr * 64 + fr, col0 = u.pn * BM + wc * 32 + 8 * fq;
#pragma unroll
        for (int ai = 0; ai < 2; ++ai)
#pragma unroll
            for (int m = 0; m < 4; ++m) { bf16_t* rowp = O + (size_t)(row0 + ai * HALF + m * 16) * ldc + col0;
#pragma unroll
                for (int bj = 0; bj < 2; ++bj) { const f32x4 v0 = acc[ai][bj][m][0], v1 = acc[ai][bj][m][1];
                    u32x4 w; w.x = cvt_pk_bf16(v0[0], v0[1]); w.y = cvt_pk_bf16(v0[2], v0[3]); w.z = cvt_pk_bf16(v1[0], v1[1]); w.w = cvt_pk_bf16(v1[2], v1[3]);
                    *(u32x4*)(rowp + bj * HALF) = w; } }
    }
};
struct EpiInProj {
    static constexpr bool PERM = true, AFTER_DRAIN = false;
    bf16_t* O; int ldc; const float* rope;
    __device__ __forceinline__ void operator()(const f32x4 (&acc)[2][2][4][2], const Unit& u, int wr, int wc, int fr, int fq) const {
        const int row0 = u.pm * BM + wr * 64 + fr, col0 = u.pn * BM + wc * 32 + 8 * fq;
        const bool do_rope = (u.pn < 8) && (u.pm < 64);
        const float qsc = (u.pn < 4) ? 0.18033688011112042f : 1.f;
        float ir0, ir1, ir2, ir3;
        { const float c = -0.8304820237218405f  , k2pi = 0.15915494309189535f;
          ir0 = __builtin_amdgcn_exp2f(c * (float)(4 * fq)) * k2pi; ir1 = __builtin_amdgcn_exp2f(c * (float)(4 * fq + 1)) * k2pi; ir2 = __builtin_amdgcn_exp2f(c * (float)(4 * fq + 2)) * k2pi; ir3 = __builtin_amdgcn_exp2f(c * (float)(4 * fq + 3)) * k2pi; }
#pragma unroll
        for (int ai = 0; ai < 2; ++ai)
#pragma unroll
            for (int m = 0; m < 4; ++m) { const int row = row0 + ai * HALF + m * 16; bf16_t* rowp = O + (size_t)row * ldc + col0;
                f32x4 cs01 = {1.f, 0.f, 1.f, 0.f}, cs23 = {1.f, 0.f, 1.f, 0.f};
                if (do_rope) { const float pos = (float)((wc & 1) ? (row & 63) : ((row >> 6) & 31));
                    cs01 = (f32x4){__builtin_amdgcn_cosf(pos * ir0), __builtin_amdgcn_sinf(pos * ir0), __builtin_amdgcn_cosf(pos * ir1), __builtin_amdgcn_sinf(pos * ir1)};
                    cs23 = (f32x4){__builtin_amdgcn_cosf(pos * ir2), __builtin_amdgcn_sinf(pos * ir2), __builtin_amdgcn_cosf(pos * ir3), __builtin_amdgcn_sinf(pos * ir3)}; }
#pragma unroll
                for (int bj = 0; bj < 2; ++bj) { f32x4 v0 = acc[ai][bj][m][0], v1 = acc[ai][bj][m][1];
                    if (do_rope) {
                        const float a0 = v0[0] * cs01[0] - v0[1] * cs01[1], a1 = v0[0] * cs01[1] + v0[1] * cs01[0];
                        const float a2 = v0[2] * cs01[2] - v0[3] * cs01[3], a3 = v0[2] * cs01[3] + v0[3] * cs01[2];
                        const float b0 = v1[0] * cs23[0] - v1[1] * cs23[1], b1 = v1[0] * cs23[1] + v1[1] * cs23[0];
                        const float b2 = v1[2] * cs23[2] - v1[3] * cs23[3], b3 = v1[2] * cs23[3] + v1[3] * cs23[2];
                        v0 = (f32x4){a0, a1, a2, a3}; v1 = (f32x4){b0, b1, b2, b3};
                    }
                    v0 = v0 * qsc; v1 = v1 * qsc;
                    u32x4 w; w.x = cvt_pk_bf16(v0[0], v0[1]); w.y = cvt_pk_bf16(v0[2], v0[3]); w.z = cvt_pk_bf16(v1[0], v1[1]); w.w = cvt_pk_bf16(v1[2], v1[3]);
                    *(u32x4*)(rowp + bj * HALF) = w; } }
    }
};

template <class Epi, class Sched, bool ALIGN_EPI = false, bool SP2 = false>
__device__ __forceinline__ void gemm_phase(PG8_LAS unsigned char* lds, const Gemm g, const Sched& S, const Epi& E) {
    const int tid = opaque_tid(), wid = __builtin_amdgcn_readfirstlane(tid >> 6), lane = tid & 63, wr = wid >> 2, wc = wid & 3, fr = lane & 15, fq = lane >> 4;
    const int K = g.K, nt = K / BK;
    unsigned voffA[2], voffB[2];
#pragma unroll
    for (int i = 0; i < 2; ++i) { int R, C; stage_rc(tid * 16 + i * 8192, R, C); const int Rb = Epi::PERM ? ((R & ~31) + perm32(R & 31)) : R;
        voffA[i] = (unsigned)(R * K + C) * 2u; voffB[i] = (unsigned)(Rb * K + C) * 2u; }
    const size_t kstep = (size_t)(BK * 2);
    const size_t hstep = (size_t)HALF * K * 2;
    const size_t tstep = 2 * hstep;
    const unsigned ldsw = (unsigned)wid * 1024u;
    const int aoff = lds_byte(wr * 64 + fr, fq * 8), boff = lds_byte(wc * 32 + fr, fq * 8);
#define PG8_SA(b, h) (((b) * 2 + (h)) * HTB)
#define PG8_SB(b, h) ((4 + (b) * 2 + (h)) * HTB)
#define PG8_STAGE(bufoff, gbase, voff) do { _Pragma("unroll") for (int _i = 0; _i < 2; ++_i) \
        __builtin_amdgcn_global_load_lds((const unsigned*)((const char*)(gbase) + (voff)[_i]), (PG8_LAS unsigned*)(lds + (bufoff) + ldsw + _i * 8192), 16, 0, 0); } while (0)
#define PG8_LDA(dst, b, h) do { _Pragma("unroll") for (int m = 0; m < 4; ++m) _Pragma("unroll") for (int k = 0; k < 2; ++k) dst[m][k] = *(const PG8_LAS bf16x8*)(lds + PG8_SA(b, h) + aoff + m * 2048 + k * 1024); } while (0)
#define PG8_LDB(dst, b, h) do { _Pragma("unroll") for (int n = 0; n < 2; ++n) _Pragma("unroll") for (int k = 0; k < 2; ++k) dst[n][k] = *(const PG8_LAS bf16x8*)(lds + PG8_SB(b, h) + boff + n * 2048 + k * 1024); } while (0)
#define PG8_MMA(ai, bj, At, Bt) do { __builtin_amdgcn_s_setprio(1); _Pragma("unroll") for (int m = 0; m < 4; ++m) _Pragma("unroll") for (int n = 0; n < 2; ++n) _Pragma("unroll") for (int k = 0; k < 2; ++k) \
        acc[ai][bj][m][n] = __builtin_amdgcn_mfma_f32_16x16x32_bf16(Bt[n][k], At[m][k], acc[ai][bj][m][n], 0, 0, 0); __builtin_amdgcn_s_setprio(0); } while (0)
#define PG8_WAIT_V(n) asm volatile("s_waitcnt vmcnt(" #n ")" ::: "memory")
#define PG8_WAIT_L(n) asm volatile("s_waitcnt lgkmcnt(" #n ")" ::: "memory")
#define PG8_BAR __builtin_amdgcn_s_barrier()
#define PG8_SCHED __builtin_amdgcn_sched_barrier(0)
    Unit cur, nxt; int ui = 0;
    if (!S.next(0, cur)) return;
    f32x4 acc[2][2][4][2];
#pragma unroll
    for (int a = 0; a < 2; ++a)
#pragma unroll
        for (int b = 0; b < 2; ++b)
#pragma unroll
            for (int m = 0; m < 4; ++m)
#pragma unroll
                for (int n = 0; n < 2; ++n) acc[a][b][m][n] = (f32x4){0.f, 0.f, 0.f, 0.f};
    bf16x8 At[4][2], B0[2][2], B1[2][2];
    const char* cA = (const char*)g.A + (size_t)cur.pm * tstep; const char* cB = (const char*)g.Bt + (size_t)cur.pn * tstep;
    S.a_ready(cur);
    if constexpr (SP2) {
        PG8_STAGE(PG8_SB(0, 0), cB, voffB); PG8_STAGE(PG8_SB(0, 1), cB + hstep, voffB); PG8_STAGE(PG8_SA(0, 0), cA, voffA); PG8_STAGE(PG8_SA(0, 1), cA + hstep, voffA);
        if (wr == 1) PG8_BAR;
        PG8_WAIT_V(2); PG8_BAR;
        PG8_STAGE(PG8_SB(1, 0), cB + kstep, voffB); PG8_STAGE(PG8_SA(1, 0), cA + kstep, voffA); PG8_STAGE(PG8_SB(1, 1), cB + hstep + kstep, voffB);
        PG8_WAIT_V(6); PG8_BAR;
    } else {
        PG8_STAGE(PG8_SB(0, 0), cB, voffB); PG8_STAGE(PG8_SA(0, 0), cA, voffA); PG8_STAGE(PG8_SB(0, 1), cB + hstep, voffB); PG8_STAGE(PG8_SA(0, 1), cA + hstep, voffA);
        if (wr == 1) PG8_BAR;
        PG8_WAIT_V(4); PG8_BAR;
        PG8_STAGE(PG8_SB(1, 0), cB + kstep, voffB); PG8_STAGE(PG8_SA(1, 0), cA + kstep, voffA); PG8_STAGE(PG8_SB(1, 1), cB + hstep + kstep, voffB);
        PG8_WAIT_V(6); PG8_BAR;
    }
    for (;;) {
        const bool has_next = S.next(ui + 1, nxt);
        const char* nA = has_next ? (const char*)g.A + (size_t)nxt.pm * tstep : cA; const char* nB = has_next ? (const char*)g.Bt + (size_t)nxt.pn * tstep : cB;
        for (int t = 0; t < nt; t += 2) {
            const bool last = (t == nt - 2);
            const char* a1 = cA + (size_t)(t + 1) * kstep;
            const char* a2 = last ? nA : cA + (size_t)(t + 2) * kstep; const char* b2 = last ? nB : cB + (size_t)(t + 2) * kstep;
            const char* a3 = a2 + kstep; const char* b3 = b2 + kstep;
            if (last && has_next) S.a_ready(nxt);
            if constexpr (SP2) {
            PG8_LDB(B0, 0, 0); PG8_LDB(B1, 0, 1); PG8_SCHED; PG8_LDA(At, 0, 0); PG8_STAGE(PG8_SA(1, 1), a1 + hstep, voffA);
            PG8_WAIT_V(8); PG8_WAIT_L(0); PG8_BAR; PG8_MMA(0, 0, At, B0); PG8_MMA(0, 1, At, B1); PG8_BAR; PG8_SCHED;
            PG8_LDA(At, 0, 1); PG8_STAGE(PG8_SB(0, 0), b2, voffB); PG8_STAGE(PG8_SB(0, 1), b2 + hstep, voffB); PG8_STAGE(PG8_SA(0, 0), a2, voffA);
            PG8_WAIT_V(8); PG8_WAIT_L(0); PG8_BAR; PG8_MMA(1, 0, At, B0); PG8_MMA(1, 1, At, B1); PG8_BAR; PG8_SCHED;
            PG8_LDB(B0, 1, 0); PG8_LDB(B1, 1, 1); PG8_SCHED; PG8_LDA(At, 1, 0); PG8_STAGE(PG8_SA(0, 1), a2 + hstep, voffA);
            PG8_WAIT_V(8); PG8_WAIT_L(0); PG8_BAR; PG8_MMA(0, 0, At, B0); PG8_MMA(0, 1, At, B1); PG8_BAR; PG8_SCHED;
            PG8_LDA(At, 1, 1); PG8_STAGE(PG8_SB(1, 0), b3, voffB); PG8_STAGE(PG8_SB(1, 1), b3 + hstep, voffB); PG8_STAGE(PG8_SA(1, 0), a3, voffA);
            PG8_WAIT_V(8); PG8_WAIT_L(0); PG8_BAR; PG8_MMA(1, 0, At, B0); PG8_MMA(1, 1, At, B1); PG8_BAR; PG8_SCHED;
            } else {
            PG8_LDB(B0, 0, 0); PG8_SCHED; PG8_LDA(At, 0, 0); PG8_STAGE(PG8_SA(1, 1), a1 + hstep, voffA);
            PG8_WAIT_L(8); PG8_BAR; PG8_WAIT_L(0); PG8_MMA(0, 0, At, B0); PG8_BAR; PG8_SCHED;
            PG8_LDB(B1, 0, 1); PG8_STAGE(PG8_SB(0, 0), b2, voffB);
            PG8_BAR; PG8_WAIT_L(0); PG8_MMA(0, 1, At, B1); PG8_BAR;
            PG8_LDA(At, 0, 1); PG8_STAGE(PG8_SA(0, 0), a2, voffA);
            PG8_BAR; PG8_WAIT_L(0); PG8_MMA(1, 0, At, B0); PG8_BAR; PG8_SCHED;
            PG8_STAGE(PG8_SB(0, 1), b2 + hstep, voffB);
            PG8_WAIT_V(6); PG8_BAR; PG8_MMA(1, 1, At, B1); PG8_BAR;
            PG8_LDB(B0, 1, 0); PG8_SCHED; PG8_LDA(At, 1, 0); PG8_STAGE(PG8_SA(0, 1), a2 + hstep, voffA);
            PG8_WAIT_L(8); PG8_BAR; PG8_WAIT_L(0); PG8_MMA(0, 0, At, B0); PG8_BAR; PG8_SCHED;
            PG8_LDB(B1, 1, 1); PG8_STAGE(PG8_SB(1, 0), b3, voffB);
            PG8_BAR; PG8_WAIT_L(0); PG8_MMA(0, 1, At, B1); PG8_BAR;
            PG8_LDA(At, 1, 1); PG8_STAGE(PG8_SA(1, 0), a3, voffA);
            PG8_BAR; PG8_WAIT_L(0); PG8_MMA(1, 0, At, B0); PG8_BAR; PG8_SCHED;
            PG8_STAGE(PG8_SB(1, 1), b3 + hstep, voffB);
            PG8_WAIT_V(6); PG8_BAR; PG8_MMA(1, 1, At, B1); PG8_BAR;
            }
        }
        if constexpr (ALIGN_EPI) { if (wr == 0) PG8_BAR; }
        if constexpr (!Epi::AFTER_DRAIN) { E(acc, cur, wr, wc, fr, fq); S.done(cur); }
        if (!has_next) break;
#pragma unroll
        for (int a = 0; a < 2; ++a)
#pragma unroll
            for (int b = 0; b < 2; ++b)
#pragma unroll
                for (int m = 0; m < 4; ++m)
#pragma unroll
                    for (int n = 0; n < 2; ++n) acc[a][b][m][n] = (f32x4){0.f, 0.f, 0.f, 0.f};
        cur = nxt; cA = nA; cB = nB; ++ui;
        if constexpr (ALIGN_EPI) { if (wr == 1) PG8_BAR; }
    }
    PG8_WAIT_V(0);
    if constexpr (!ALIGN_EPI) { if (wr == 0) PG8_BAR; }
    PG8_BAR;
    if constexpr (Epi::AFTER_DRAIN) { E.fused(acc, cur, wr, wc, fr, fq, lds, wid, lane); S.done(cur); }
#undef PG8_SA
#undef PG8_SB
#undef PG8_STAGE
#undef PG8_LDA
#undef PG8_LDB
#undef PG8_MMA
#undef PG8_WAIT_V
#undef PG8_WAIT_L
#undef PG8_BAR
#undef PG8_SCHED
}
}

namespace att {
using bf16x8 = __attribute__((ext_vector_type(8))) short;
using s16x4  = __attribute__((ext_vector_type(4))) short;
using f32x16 = __attribute__((ext_vector_type(16))) float;
using u32x4  = __attribute__((ext_vector_type(4))) unsigned;
constexpr int NW = 8, QBLK = 32, KVBLK = 64, QROWS = 128;
constexpr float SCALE = 0.125f, QPRESCALE = SCALE * 1.4426950408889634f, THRL = 24.f;
constexpr int SHM_V = KVBLK * 128 * 2, SHM_K = KVBLK * 128 * 2, SHM_ATTN = 2 * SHM_V + 2 * SHM_K + NW * 64 * 4;
#define KSWZ(row, colB) ((row) * 256 + ((colB) ^ (((row) & 7) << 4)))
#define SBAR() __builtin_amdgcn_sched_barrier(0)
__device__ __forceinline__ int crow(int r, int hi) { return (r & 3) + 8 * (r >> 2) + 4 * hi; }
__device__ __forceinline__ unsigned cvtpk(float lo, float hi) { unsigned r; asm volatile("v_cvt_pk_bf16_f32 %0, %1, %2" : "=v"(r) : "v"(lo), "v"(hi)); return r; }
__device__ __forceinline__ void qkt_lds(f32x16& p0, f32x16& p1, const char* Ks, const char* qrow  , float mh, int r32, int hi, int sub) {
#pragma unroll
  for (int r = 0; r < 16; ++r) { p0[r] = -mh; p1[r] = -mh; }
#pragma unroll
  for (int d0 = 0; d0 < 4; ++d0) { const int cb = (sub * 64 + d0 * 16 + hi * 8) * 2;
    const bf16x8 qf = *reinterpret_cast<const bf16x8*>(qrow + d0 * 32);
    const bf16x8 b0 = *reinterpret_cast<const bf16x8*>(Ks + KSWZ(r32, cb));
    const bf16x8 b1 = *reinterpret_cast<const bf16x8*>(Ks + KSWZ(32 + r32, cb));
    p0 = __builtin_amdgcn_mfma_f32_32x32x16_bf16(b0, qf, p0, 0, 0, 0);
    p1 = __builtin_amdgcn_mfma_f32_32x32x16_bf16(b1, qf, p1, 0, 0, 0); }
}
#define ATT_PK4(P, BASE, OUT) do { unsigned a0_ = cvtpk(P[BASE + 0], P[BASE + 1]), a1_ = cvtpk(P[BASE + 2], P[BASE + 3]);   \
    unsigned b0_ = cvtpk(P[BASE + 4], P[BASE + 5]), b1_ = cvtpk(P[BASE + 6], P[BASE + 7]);                              \
    auto r0_ = __builtin_amdgcn_permlane32_swap(a0_, b0_, false, false); auto r1_ = __builtin_amdgcn_permlane32_swap(a1_, b1_, false, false); \
    u32x4 w_ = {r0_[0], r1_[0], r0_[1], r1_[1]}; OUT = *reinterpret_cast<bf16x8*>(&w_); } while (0)
__device__ __forceinline__ void partialSM3(f32x16& p0, f32x16& p1, float& mhat, float& alpha, bf16x8& pa0, bf16x8& pa1, float& ps0) {
  float a = fmaxf(fmaxf(p0[0], p0[1]), p1[0]), b2 = fmaxf(fmaxf(p0[2], p0[3]), p1[1]); a = fmaxf(fmaxf(a, p1[2]), p1[3]);
#pragma unroll
  for (int r = 4; r < 16; r += 4) { a = fmaxf(fmaxf(a, p0[r]), p0[r + 1]); b2 = fmaxf(fmaxf(b2, p0[r + 2]), p0[r + 3]); a = fmaxf(fmaxf(a, p1[r]), p1[r + 1]); b2 = fmaxf(fmaxf(b2, p1[r + 2]), p1[r + 3]); }
  float rm = fmaxf(a, b2);
  { auto rr = __builtin_amdgcn_permlane32_swap(__float_as_uint(rm), __float_as_uint(rm), false, false);
    rm = fmaxf(__uint_as_float(rr[0]), __uint_as_float(rr[1])); }
  alpha = 1.f;
  if (__builtin_expect(__any(rm > THRL), 0)) {
    const float dl = fmaxf(rm, 0.f); mhat += dl;
#pragma unroll
    for (int r = 0; r < 16; ++r) { p0[r] -= dl; p1[r] -= dl; }
    alpha = __builtin_amdgcn_exp2f(-dl);
  }
  float s_ = 0.f;
#pragma unroll
  for (int r = 0; r < 16; ++r) { p0[r] = __builtin_amdgcn_exp2f(p0[r]); s_ += p0[r]; }
  ps0 = s_;
  ATT_PK4(p0, 0, pa0); ATT_PK4(p0, 8, pa1);
}
__device__ __forceinline__ void finishSM3(f32x16& p1, float alpha, float ps0, float& l_reg, bf16x8& pa2, bf16x8& pa3) {
#pragma unroll
  for (int r = 0; r < 16; ++r) p1[r] = __builtin_amdgcn_exp2f(p1[r]);
  float ps = ps0;
#pragma unroll
  for (int r = 0; r < 16; ++r) ps += p1[r];
  { auto rr = __builtin_amdgcn_permlane32_swap(__float_as_uint(ps), __float_as_uint(ps), false, false);
    ps = __uint_as_float(rr[0]) + __uint_as_float(rr[1]); }
  l_reg = l_reg * alpha + ps;
  ATT_PK4(p1, 0, pa2); ATT_PK4(p1, 8, pa3);
}
__device__ __forceinline__ int v_st(int k, int c) { const int kk = (k & ~0xC) | ((k & 4) << 1) | ((k & 8) >> 1); return ((kk >> 3) * 4 + (c >> 5)) * 512 + ((kk & 7) * 32 + (c & 31)) * 2; }
__device__ __forceinline__ int v_rd_base(int lane) { return ((lane & 3) << 3) | (((lane >> 2) & 3) << 6) | (((lane >> 4) & 1) << 5) | (((lane >> 5) & 1) << 8); }
constexpr int v_rd_off(int d0, int ks, int half) { return d0 * 512 + ks * 4096 + half * 2048; }
template <int OFF> __device__ __forceinline__ s16x4 tr_read(int vb) {
  s16x4 r; asm volatile("ds_read_b64_tr_b16 %0, %1 offset:%2" : "=&v"(r) : "v"(vb), "i"(OFF) : "memory"); return r;
}
template <int D0> __device__ __forceinline__ void pv_one(f32x16& od, int vb, bf16x8 pa0, bf16x8 pa1, bf16x8 pa2, bf16x8 pa3) {
  const s16x4 l0 = tr_read<v_rd_off(D0, 0, 0)>(vb), h0 = tr_read<v_rd_off(D0, 0, 1)>(vb), l1 = tr_read<v_rd_off(D0, 1, 0)>(vb), h1 = tr_read<v_rd_off(D0, 1, 1)>(vb);
  const s16x4 l2 = tr_read<v_rd_off(D0, 2, 0)>(vb), h2 = tr_read<v_rd_off(D0, 2, 1)>(vb), l3 = tr_read<v_rd_off(D0, 3, 0)>(vb), h3 = tr_read<v_rd_off(D0, 3, 1)>(vb);
  asm volatile("s_waitcnt lgkmcnt(0)" ::: "memory"); SBAR();
#define PK(L, H) (bf16x8){L[0], L[1], L[2], L[3], H[0], H[1], H[2], H[3]}
  od = __builtin_amdgcn_mfma_f32_32x32x16_bf16(pa0, PK(l0, h0), od, 0, 0, 0);
  od = __builtin_amdgcn_mfma_f32_32x32x16_bf16(pa1, PK(l1, h1), od, 0, 0, 0);
  od = __builtin_amdgcn_mfma_f32_32x32x16_bf16(pa2, PK(l2, h2), od, 0, 0, 0);
  od = __builtin_amdgcn_mfma_f32_32x32x16_bf16(pa3, PK(l3, h3), od, 0, 0, 0);
#undef PK
}
#define PV_RD(D0) const s16x4 l0_##D0 = tr_read<v_rd_off(D0, 0, 0)>(vb), h0_##D0 = tr_read<v_rd_off(D0, 0, 1)>(vb), l1_##D0 = tr_read<v_rd_off(D0, 1, 0)>(vb), h1_##D0 = tr_read<v_rd_off(D0, 1, 1)>(vb), \
                          l2_##D0 = tr_read<v_rd_off(D0, 2, 0)>(vb), h2_##D0 = tr_read<v_rd_off(D0, 2, 1)>(vb), l3_##D0 = tr_read<v_rd_off(D0, 3, 0)>(vb), h3_##D0 = tr_read<v_rd_off(D0, 3, 1)>(vb); SBAR()
#define PV_PK(L, H) (bf16x8){L[0], L[1], L[2], L[3], H[0], H[1], H[2], H[3]}
#define PV_MM(D0, CNT) do { asm volatile("s_waitcnt lgkmcnt(" #CNT ")" ::: "memory"); SBAR(); \
    o[D0] = __builtin_amdgcn_mfma_f32_32x32x16_bf16(pa0, PV_PK(l0_##D0, h0_##D0), o[D0], 0, 0, 0); o[D0] = __builtin_amdgcn_mfma_f32_32x32x16_bf16(pa1, PV_PK(l1_##D0, h1_##D0), o[D0], 0, 0, 0); \
    o[D0] = __builtin_amdgcn_mfma_f32_32x32x16_bf16(pa2, PV_PK(l2_##D0, h2_##D0), o[D0], 0, 0, 0); o[D0] = __builtin_amdgcn_mfma_f32_32x32x16_bf16(pa3, PV_PK(l3_##D0, h3_##D0), o[D0], 0, 0, 0); SBAR(); } while (0)
__device__ __forceinline__ void pv_d0(f32x16* o, int vb, bf16x8 pa0, bf16x8 pa1, bf16x8 pa2, bf16x8 pa3) {
  PV_RD(0); PV_RD(1); PV_MM(0, 8); PV_RD(2); PV_MM(1, 8); PV_RD(3); PV_MM(2, 8); PV_MM(3, 0);
}
#undef PV_RD
#undef PV_PK
#undef PV_MM
__device__ __forceinline__ long ktile_row(int b, int t) { return t < 4 ? (long)(NLAT + b * CTXL + 64 * t) : (long)(b * SEQ + 64 * (t - 4)); }

__device__ __forceinline__ void ld_tile8(u32x4 (&v)[8], const bf16_t* base  , int lane) {
  const unsigned long long sb = uniform_ptr(base);
  const int v0 = ((lane >> 4) * NP + (lane & 15) * 8) * 2, st = 4 * NP * 2;
  asm volatile("s_nop 4\n\tglobal_load_dwordx4 %0, %8, %16\n\tglobal_load_dwordx4 %1, %9, %16\n\tglobal_load_dwordx4 %2, %10, %16\n\tglobal_load_dwordx4 %3, %11, %16\n\t"
               "global_load_dwordx4 %4, %12, %16\n\tglobal_load_dwordx4 %5, %13, %16\n\tglobal_load_dwordx4 %6, %14, %16\n\tglobal_load_dwordx4 %7, %15, %16\n\ts_waitcnt vmcnt(0)"
               : "=&v"(v[0]), "=&v"(v[1]), "=&v"(v[2]), "=&v"(v[3]), "=&v"(v[4]), "=&v"(v[5]), "=&v"(v[6]), "=&v"(v[7])
               : "v"(v0), "v"(v0 + st), "v"(v0 + 2 * st), "v"(v0 + 3 * st), "v"(v0 + 4 * st), "v"(v0 + 5 * st), "v"(v0 + 6 * st), "v"(v0 + 7 * st), "s"(sb) : "memory");
}
constexpr int QROWS2 = 256, QT_ROWB = 272, QT_OFF = 2 * SHM_V + 2 * SHM_K + NW * 64 * 4, SHM_ATTN2 = QT_OFF + NW * 32 * QT_ROWB;
static_assert(SHM_ATTN2 <= LDS_PHASE_BYTES, "attention LDS map");
__device__ __forceinline__ void attn_unit2(const bf16_t* __restrict__ Pm, bf16_t* __restrict__ Y, long qrow0, int b, int hh, int NT, float lam, float lam_init,
                                           const float* __restrict__ subln, char* lds) {
  const int tid = opaque_tid(), wid = __builtin_amdgcn_readfirstlane(tid >> 6), lane = tid & 63, r32 = lane & 31, hi = lane >> 5;
  char* V_lds = lds; char* K_lds = lds + 2 * SHM_V;
  float* ws = (float*)(lds + 2 * SHM_V + 2 * SHM_K) + wid * 64; float* li_l = ws; float* al_l = ws + 32;
  char* qt = lds + QT_OFF + wid * (32 * QT_ROWB);
  const long wrow0 = qrow0 + wid * QBLK;
  float mh0 = 0.f, mh1 = 0.f, l0 = 0.f, l1 = 0.f; f32x16 o0[4] = {}, o1[4] = {};
  const int vb0 = (int)(uintptr_t)V_lds + v_rd_base(lane);
  const unsigned ldsb = (unsigned)(uintptr_t)lds + (unsigned)(wid * 2048);
  unsigned kof0, vof0;
  { const int sl = wid * 128 + lane, krow = sl >> 4, kch = (sl & 15) ^ (krow & 7);
    const int kk = (sl >> 7) * 8 + ((sl & 31) >> 2), vc = ((sl >> 5) & 3) * 32 + (sl & 3) * 8, vk = (kk & ~0xC) | ((kk & 4) << 1) | ((kk & 8) >> 1);
    kof0 = (unsigned)((krow * NP + C_KA + kch * 8) * 2); vof0 = (unsigned)((vk * NP + C_VA + vc) * 2); }
#define SDMA(t, bb) do { const char* tb_ = (const char*)(Pm + ktile_row(b, (t)) * NP + hh * 128); \
    __builtin_amdgcn_global_load_lds((const unsigned*)(tb_ + vof0), (__attribute__((address_space(3))) unsigned*)(ldsb + (unsigned)((bb) * SHM_V)), 16, 0, 0); \
    __builtin_amdgcn_global_load_lds((const unsigned*)(tb_ + kof0), (__attribute__((address_space(3))) unsigned*)(ldsb + (unsigned)(2 * SHM_V + (bb) * SHM_K)), 16, 0, 0); \
    __builtin_amdgcn_global_load_lds((const unsigned*)(tb_ + (vof0 + 128u)), (__attribute__((address_space(3))) unsigned*)(ldsb + (unsigned)((bb) * SHM_V + 1024)), 16, 0, 0); \
    __builtin_amdgcn_global_load_lds((const unsigned*)(tb_ + ((kof0 ^ 64u) + (unsigned)(4 * NP * 2))), (__attribute__((address_space(3))) unsigned*)(ldsb + (unsigned)(2 * SHM_V + (bb) * SHM_K + 1024)), 16, 0, 0); } while (0)
#define RESC(o, a) do { if (__any((a) < 1.f)) { if (hi == 0) al_l[r32] = (a); asm volatile("s_waitcnt lgkmcnt(0)" ::: "memory"); \
    _Pragma("unroll") for (int r = 0; r < 16; ++r) { const float f_ = al_l[crow(r, hi)]; _Pragma("unroll") for (int d = 0; d < 4; ++d) o[d][r] *= f_; asm volatile("" ::: "memory"); } } } while (0)
  f32x16 pA1, pB1; float alA, alB, psA, psB; bf16x8 aA0, aA1, aB0, aB1, pa2, pa3;
  const char* qA = qt + r32 * QT_ROWB + (hi * 8) * 2;
#define qB (qA + 128)
  SDMA(0, 0);
  { u32x4 qv[8]; ld_tile8(qv, Pm + wrow0 * NP + C_QA + hh * 128, lane);
#pragma unroll
    for (int c8 = 0; c8 < 8; ++c8) { const int row = c8 * 4 + (lane >> 4), ch = lane & 15; *(u32x4*)(qt + row * QT_ROWB + ch * 16) = qv[c8]; } }
  asm volatile("s_waitcnt vmcnt(0)" ::: "memory"); __syncthreads();
  { f32x16 t0; SBAR(); qkt_lds(t0, pA1, K_lds, qA, mh0, r32, hi, 0); partialSM3(t0, pA1, mh0, alA, aA0, aA1, psA); SBAR(); }
  if (1 < NT) SDMA(1, 1);
  { f32x16 t0; SBAR(); qkt_lds(t0, pB1, K_lds, qB, mh1, r32, hi, 1); finishSM3(pA1, alA, psA, l0, pa2, pa3); SBAR();
    pv_d0(o0, vb0, aA0, aA1, pa2, pa3); partialSM3(t0, pB1, mh1, alB, aB0, aB1, psB); SBAR(); }
  asm volatile("s_waitcnt vmcnt(0)" ::: "memory"); __syncthreads();
  for (int t = 1; t < NT; ++t) {
    const int cur = t & 1, prev = cur ^ 1;
    { f32x16 t0; SBAR(); qkt_lds(t0, pA1, K_lds + cur * SHM_K, qA, mh0, r32, hi, 0); RESC(o1, alB); finishSM3(pB1, alB, psB, l1, pa2, pa3); SBAR();
      pv_d0(o1, vb0 + prev * SHM_V, aB0, aB1, pa2, pa3); partialSM3(t0, pA1, mh0, alA, aA0, aA1, psA); SBAR(); }
    __syncthreads();
    if (t + 1 < NT) SDMA(t + 1, prev);
    RESC(o0, alA);
    { f32x16 t0; SBAR(); qkt_lds(t0, pB1, K_lds + cur * SHM_K, qB, mh1, r32, hi, 1); finishSM3(pA1, alA, psA, l0, pa2, pa3); SBAR();
      pv_d0(o0, vb0 + cur * SHM_V, aA0, aA1, pa2, pa3); partialSM3(t0, pB1, mh1, alB, aB0, aB1, psB); SBAR(); }
    asm volatile("s_waitcnt vmcnt(0)" ::: "memory"); __syncthreads();
  }
  { const char* gb_ = (const char*)(Pm + wrow0 * NP + C_GA + hh * 128); const unsigned qtb = (unsigned)(uintptr_t)qt; int lg = lane; asm volatile("" : "+v"(lg));
    const unsigned go = (unsigned)(((lg >> 4) * NP + (lg & 15) * 8) * 2);
#pragma unroll
    for (int c8 = 0; c8 < 8; ++c8)
      __builtin_amdgcn_global_load_lds((const unsigned*)(gb_ + (go + (unsigned)(c8 * 4 * NP * 2))), (__attribute__((address_space(3))) unsigned*)(qtb + (unsigned)(c8 * 1024)), 16, 0, 0); }
  RESC(o1, alB); finishSM3(pB1, alB, psB, l1, pa2, pa3); SBAR();
  pv_d0(o1, vb0 + ((NT - 1) & 1) * SHM_V, aB0, aB1, pa2, pa3);
  if (hi == 0) { li_l[r32] = l0; al_l[r32] = l1; } asm volatile("s_waitcnt lgkmcnt(0)" ::: "memory");
  float ss[16];
#pragma unroll
  for (int r = 0; r < 16; ++r) { const float ra = __builtin_amdgcn_rcpf(li_l[crow(r, hi)]), rb = lam * __builtin_amdgcn_rcpf(al_l[crow(r, hi)]); float a = 0.f;
#pragma unroll
    for (int d0 = 0; d0 < 4; ++d0) { o0[d0][r] = o0[d0][r] * ra - o1[d0][r] * rb; a += o0[d0][r] * o0[d0][r]; }
    ss[r] = a; }
#pragma unroll
  for (int r = 0; r < 16; ++r) {
    ss[r] = rsqrtf(half_sum(ss[r], hi) * (1.f / 128.f) + EPS) * (1.f - lam_init);
  }
  float sw[4];
#pragma unroll
  for (int d0 = 0; d0 < 4; ++d0) sw[d0] = subln[d0 * 32 + r32];
  asm volatile("s_waitcnt vmcnt(0) lgkmcnt(0)" ::: "memory");
#pragma unroll
  for (int r = 0; r < 16; ++r) { bf16_t* tp = (bf16_t*)(qt + crow(r, hi) * 256) + r32;
#pragma unroll
    for (int d0 = 0; d0 < 4; ++d0) { const float g = bf2f(tp[d0 * 32]); tp[d0 * 32] = f2bf(o0[d0][r] * ss[r] * sw[d0] * silu_f(g)); } }
  asm volatile("s_waitcnt lgkmcnt(0)" ::: "memory");
#pragma unroll
  for (int c8 = 0; c8 < 8; ++c8) { const int row = c8 * 4 + (lane >> 4), ch = lane & 15;
    *(uint4*)(Y + (wrow0 + row) * DM + hh * 128 + ch * 8) = *(const uint4*)(qt + row * 256 + ch * 16); }
  asm volatile("s_waitcnt lgkmcnt(0)" ::: "memory");
#undef SDMA
#undef RESC
#undef qB
}
#undef KSWZ
#undef SBAR
}

DEVI void mod_unit(int unit, const float* __restrict__ c, const float* __restrict__ c_ctx, const float* __restrict__ w_ada, const float* __restrict__ b_ada, float* __restrict__ MOD, float* ldsf);
namespace mls {
using bf16x8 = __attribute__((ext_vector_type(8))) short;
using s16x4  = __attribute__((ext_vector_type(4))) short;
using f32x4  = __attribute__((ext_vector_type(4))) float;
constexpr int QSTRB = 272, SSTRB = 144;
constexpr int VSTRB = 528;
constexpr int L_Q = 0, L_K = L_Q + 64 * QSTRB, L_V = L_K + 64 * QSTRB, L_S = L_V + 64 * VSTRB, L_CT = L_S + 64 * SSTRB, L_SM = L_CT + 256 * QSTRB, L_END = L_SM + 8192;
static_assert(L_END <= LDS_PHASE_BYTES && (L_K % 16) == 0 && (L_V % 16) == 0 && (L_S % 16) == 0 && (L_CT % 16) == 0 && (L_SM % 16) == 0, "mlstm LDS map");
__device__ __forceinline__ f32x4 mfma16(bf16x8 a, bf16x8 b, f32x4 c) { return __builtin_amdgcn_mfma_f32_16x16x32_bf16(a, b, c, 0, 0, 0); }
struct TrPair { s16x4 lo, hi; };
__device__ __forceinline__ bf16x8 tr_pack(const TrPair& t) { return (bf16x8){t.lo[0], t.lo[1], t.lo[2], t.lo[3], t.hi[0], t.hi[1], t.hi[2], t.hi[3]}; }
__device__ __forceinline__ float wave_scan_incl(float v) {
  v += __builtin_bit_cast(float, __builtin_amdgcn_update_dpp(0, __builtin_bit_cast(int, v), 0x111, 0xF, 0xF, false));
  v += __builtin_bit_cast(float, __builtin_amdgcn_update_dpp(0, __builtin_bit_cast(int, v), 0x112, 0xF, 0xF, false));
  v += __builtin_bit_cast(float, __builtin_amdgcn_update_dpp(0, __builtin_bit_cast(int, v), 0x114, 0xF, 0xF, false));
  v += __builtin_bit_cast(float, __builtin_amdgcn_update_dpp(0, __builtin_bit_cast(int, v), 0x118, 0xF, 0xF, false));
  v += __builtin_bit_cast(float, __builtin_amdgcn_update_dpp(0, __builtin_bit_cast(int, v), 0x142, 0xA, 0xF, false));
  v += __builtin_bit_cast(float, __builtin_amdgcn_update_dpp(0, __builtin_bit_cast(int, v), 0x143, 0xC, 0xF, false));
  return v;
}
__device__ __forceinline__ float fast_tanh(float x) { return 1.f - 2.f * __builtin_amdgcn_rcpf(1.f + __expf(2.f * x)); }

__device__ __forceinline__ void tr_v4(unsigned base, TrPair& a0, TrPair& a1, TrPair& b0, TrPair& b1, TrPair& c0, TrPair& c1, TrPair& d0, TrPair& d1) {
  asm volatile(
    "ds_read_b64_tr_b16 %0, %16\n\tds_read_b64_tr_b16 %1, %16 offset:2112\n\tds_read_b64_tr_b16 %2, %16 offset:16896\n\tds_read_b64_tr_b16 %3, %16 offset:19008\n\t"
    "ds_read_b64_tr_b16 %4, %16 offset:32\n\tds_read_b64_tr_b16 %5, %16 offset:2144\n\tds_read_b64_tr_b16 %6, %16 offset:16928\n\tds_read_b64_tr_b16 %7, %16 offset:19040\n\t"
    "ds_read_b64_tr_b16 %8, %16 offset:64\n\tds_read_b64_tr_b16 %9, %16 offset:2176\n\tds_read_b64_tr_b16 %10, %16 offset:16960\n\tds_read_b64_tr_b16 %11, %16 offset:19072\n\t"
    "ds_read_b64_tr_b16 %12, %16 offset:96\n\tds_read_b64_tr_b16 %13, %16 offset:2208\n\tds_read_b64_tr_b16 %14, %16 offset:16992\n\tds_read_b64_tr_b16 %15, %16 offset:19104\n\t"
    "s_waitcnt lgkmcnt(0)"
    : "=&v"(a0.lo), "=&v"(a0.hi), "=&v"(a1.lo), "=&v"(a1.hi), "=&v"(b0.lo), "=&v"(b0.hi), "=&v"(b1.lo), "=&v"(b1.hi),
      "=&v"(c0.lo), "=&v"(c0.hi), "=&v"(c1.lo), "=&v"(c1.hi), "=&v"(d0.lo), "=&v"(d0.hi), "=&v"(d1.lo), "=&v"(d1.hi)
    : "v"(base) : "memory");
}
__device__ __forceinline__ bf16x8 scale_frag(const TrPair& t, const float4 wa, const float4 wb) {
  const float f0 = bf2f((bf16_t)t.lo[0]) * wa.x, f1 = bf2f((bf16_t)t.lo[1]) * wa.y, f2 = bf2f((bf16_t)t.lo[2]) * wa.z, f3 = bf2f((bf16_t)t.lo[3]) * wa.w;
  const float f4 = bf2f((bf16_t)t.hi[0]) * wb.x, f5 = bf2f((bf16_t)t.hi[1]) * wb.y, f6 = bf2f((bf16_t)t.hi[2]) * wb.z, f7 = bf2f((bf16_t)t.hi[3]) * wb.w;
  return __builtin_bit_cast(bf16x8, make_uint4(pk2(f0, f1), pk2(f2, f3), pk2(f4, f5), pk2(f6, f7)));
}

__device__ __forceinline__ void mlstm_unit(const bf16_t* __restrict__ Pm, const bf16_t* __restrict__ QKC  , const float* __restrict__ GATES,
                                           bf16_t* __restrict__ HM, const float* __restrict__ i_bias, const float* __restrict__ f_bias,
                                           int b, int head, int dir, bool ctx_out, unsigned* mdone, char* lds) {
  const int tid = opaque_tid(), wid = __builtin_amdgcn_readfirstlane(tid >> 6), lane = tid & 63, lr = lane & 15, kg = lane >> 4;
  char* q_lds = lds + L_Q; char* k_lds = lds + L_K; char* v_lds = lds + L_V; char* s_lds = lds + L_S; char* ct_lds = lds + L_CT;
  float* bl = (float*)(lds + L_SM); float* bsp = bl + 64; float* av = bsp + 64; float* wkl = av + 64; float* qn = wkl + 64; float* nvec = qn + 64; float* rs = nvec + 128; float* npart = rs + 1024;
  const unsigned lds0 = (unsigned)(uintptr_t)lds;
  const unsigned trq = (unsigned)((8 * kg + (lr >> 2)) * QSTRB + (4 * (lr & 3)) * 2), trv = (unsigned)((8 * kg + (lr >> 2)) * VSTRB + (4 * (lr & 3)) * 2);
  if (tid < 128) nvec[tid] = 0.f;
  const float ibias = i_bias[dir * 4 + head], fbias = f_bias[dir * 4 + head];
  const int chg = tid & 31, rg = tid >> 5; const bool isk = chg >= 16;
  const int qkcol = 1024 + (isk ? 512 : 0) + head * 128 + (chg & 15) * 8;
  const int vrow = tid >> 3, vch = tid & 7;
  uint4 pq0, pq1, pq2, pq3, pv0, pv1, pv2, pv3; float pgi, pgf;
#define MLS_LOAD(c_) do { const int c__ = (c_); const bool ic_ = c__ < 4; const int T_ = ic_ ? CTXL : SEQ, cc_ = ic_ ? c__ : c__ - 4; \
    const long rb_ = ic_ ? (long)(NLAT + b * CTXL) : (long)b * SEQ; const int t0_ = dir ? (T_ - 64 * (cc_ + 1)) : 64 * cc_; \
    { const bf16_t* qp_ = QKC + (rb_ + t0_ + rg) * DM + qkcol; pq0 = *(const uint4*)qp_; pq1 = *(const uint4*)(qp_ + 16 * DM); pq2 = *(const uint4*)(qp_ + 32 * DM); pq3 = *(const uint4*)(qp_ + 48 * DM); } \
    { const uint4* vp_ = (const uint4*)(Pm + (rb_ + t0_ + vrow) * NP + C_VB + head * 256 + vch * 32); pv0 = vp_[0]; pv1 = vp_[1]; pv2 = vp_[2]; pv3 = vp_[3]; } \
    const float* gr_ = GATES + (rb_ + t0_ + (dir ? 63 - lane : lane)) * 16; pgi = gr_[dir * 4 + head]; pgf = gr_[8 + dir * 4 + head]; } while (0)
  MLS_LOAD(0);
  f32x4 Cacc[16];
#pragma unroll
  for (int e = 0; e < 16; ++e) Cacc[e] = (f32x4){0.f, 0.f, 0.f, 0.f};
  float gprev = 0.f;
  __syncthreads();
  for (int c = 0; c < 36; ++c) {
    const bool isctx = c < 4; const int T = isctx ? CTXL : SEQ, cc = isctx ? c : c - 4;
    const long rowbase = isctx ? (long)(NLAT + b * CTXL) : (long)b * SEQ;
    const int t0 = dir ? (T - 64 * (cc + 1)) : 64 * cc;
    const bool need_h = ctx_out || !isctx;
    float gamma, wk_l;
    {
      const float igv = 15.f * fast_tanh((pgi + ibias) * (1.f / 15.f));
      const float fc = 15.f * fast_tanh((pgf + fbias) * (1.f / 15.f));
      const float lfv = fminf(fc, 0.f) - __logf(1.f + __expf(-fabsf(fc)));
      const float bcum = wave_scan_incl(lfv);
      const float b63 = __builtin_bit_cast(float, __builtin_amdgcn_readlane(__builtin_bit_cast(int, bcum), 63));
      gamma = __expf(b63); wk_l = __expf(b63 - bcum + igv);
      if (wid == 0) { bl[lane] = bcum; bsp[lane] = bcum - igv; av[lane] = __expf(bcum); wkl[lane] = wk_l; }
      if (c > 0 && tid < 128) nvec[tid] = gprev * nvec[tid] + (npart[tid] + npart[128 + tid]) + (npart[256 + tid] + npart[384 + tid]);
    }
#pragma unroll
    for (int eblk = 0; eblk < 16; ++eblk) { uint2 w_; w_.x = pk2(Cacc[eblk][0], Cacc[eblk][1]); w_.y = pk2(Cacc[eblk][2], Cacc[eblk][3]);
      *(uint2*)(ct_lds + (eblk * 16 + lr) * QSTRB + (wid * 16 + 4 * kg) * 2) = w_; }
    { char* dst = (isk ? k_lds : q_lds) + (chg & 15) * 16;
      *(uint4*)(dst + (dir ? 63 - rg : rg) * QSTRB) = pq0; *(uint4*)(dst + (dir ? 47 - rg : rg + 16) * QSTRB) = pq1;
      *(uint4*)(dst + (dir ? 31 - rg : rg + 32) * QSTRB) = pq2; *(uint4*)(dst + (dir ? 15 - rg : rg + 48) * QSTRB) = pq3; }
    { char* dst = v_lds + (dir ? 63 - vrow : vrow) * VSTRB + vch * 64;
      *(uint4*)dst = pv0; *(uint4*)(dst + 16) = pv1; *(uint4*)(dst + 32) = pv2; *(uint4*)(dst + 48) = pv3; }
    if (c + 1 < 36) MLS_LOAD(c + 1);
    __syncthreads();
    if (need_h) {
      const int lblk = wid >> 1;
#pragma unroll
      for (int u2 = 0; u2 < 2; ++u2) {
        const int sblk = 2 * (wid & 1) + u2;
        if (sblk <= lblk) {
          f32x4 acc = {0.f, 0.f, 0.f, 0.f};
#pragma unroll
          for (int ks = 0; ks < 4; ++ks) {
            const bf16x8 ka = *(const bf16x8*)(k_lds + (sblk * 16 + lr) * QSTRB + (ks * 32 + 8 * kg) * 2);
            const bf16x8 qb = *(const bf16x8*)(q_lds + (lblk * 16 + lr) * QSTRB + (ks * 32 + 8 * kg) * 2);
            acc = mfma16(ka, qb, acc);
          }
          const int l = lblk * 16 + lr; const float blv = bl[l];
          float v4[4]; float sum = 0.f;
#pragma unroll
          for (int r = 0; r < 4; ++r) { const int sidx = sblk * 16 + 4 * kg + r; const float w = (sidx <= l) ? __expf(blv - bsp[sidx]) : 0.f; v4[r] = acc[r] * w; sum += v4[r]; }
          uint2 w; w.x = pk2(v4[0], v4[1]); w.y = pk2(v4[2], v4[3]);
          *(uint2*)(s_lds + l * SSTRB + (sblk * 16 + 4 * kg) * 2) = w;
          rs[(sblk * 4 + kg) * 64 + l] = sum;
        } else if ((lblk == 0 && sblk == 1) || (lblk == 2 && sblk == 3)) {
          uint2 z_; z_.x = 0u; z_.y = 0u; asm volatile("" : "+v"(z_.x), "+v"(z_.y));
          *(uint2*)(s_lds + (lblk * 16 + lr) * SSTRB + (sblk * 16 + 4 * kg) * 2) = z_;
        }
      }
      { const int l = tid >> 3, part = tid & 7; float a = 0.f;
        const unsigned* qp = (const unsigned*)(q_lds + l * QSTRB + part * 32);
#pragma unroll
        for (int i = 0; i < 8; ++i) { const unsigned wd = qp[i]; a += __uint_as_float(wd << 16) * nvec[part * 16 + 2 * i] + __uint_as_float(wd & 0xffff0000u) * nvec[part * 16 + 2 * i + 1]; }
        a += __builtin_bit_cast(float, __builtin_amdgcn_update_dpp(0, __builtin_bit_cast(int, a), 0xB1, 0xF, 0xF, false));
        a += __builtin_bit_cast(float, __builtin_amdgcn_update_dpp(0, __builtin_bit_cast(int, a), 0x4E, 0xF, 0xF, false));
        a += __builtin_bit_cast(float, __builtin_amdgcn_update_dpp(0, __builtin_bit_cast(int, a), 0x141, 0xF, 0xF, false));
        if (part == 0) qn[l] = a; }
    }
    __syncthreads();
    if (need_h) {
      const int lblk = wid >> 1, l = lblk * 16 + lr, eh = wid & 1;
      float d = av[l] * qn[l];
      for (int sb = 0; sb <= lblk; ++sb) d += (rs[(sb * 4 + 0) * 64 + l] + rs[(sb * 4 + 1) * 64 + l]) + (rs[(sb * 4 + 2) * 64 + l] + rs[(sb * 4 + 3) * 64 + l]);
      const float a_l = av[l], dinv = 1.f / fmaxf(fabsf(d), 1.f);
      bf16x8 qb[4];
#pragma unroll
      for (int ks = 0; ks < 4; ++ks) qb[ks] = *(const bf16x8*)(q_lds + l * QSTRB + (ks * 32 + 8 * kg) * 2);
      const bf16x8 sb0 = *(const bf16x8*)(s_lds + l * SSTRB + (8 * kg) * 2);
      bf16x8 sb1 = sb0; if (lblk >= 2) sb1 = *(const bf16x8*)(s_lds + l * SSTRB + (32 + 8 * kg) * 2);
      const int t = dir ? (t0 + 63 - l) : (t0 + l);
      bf16_t* hp = HM + ((size_t)dir * NTOK + rowbase + t) * 1024 + head * 256 + eh * 128 + 4 * kg;
#pragma unroll
      for (int half = 0; half < 2; ++half) {
        TrPair a0, a1, b0, b1, c0, c1, d0, d1;
        tr_v4(lds0 + L_V + trv + (unsigned)((eh * 8 + half * 4) * 32), a0, a1, b0, b1, c0, c1, d0, d1);
        __builtin_amdgcn_sched_barrier(0);
#define MLS_HTILE(ti, VA0, VA1) do { const int eblk = eh * 8 + half * 4 + (ti); f32x4 acc1 = {0.f, 0.f, 0.f, 0.f}, acc2 = {0.f, 0.f, 0.f, 0.f}; \
          _Pragma("unroll") for (int ks = 0; ks < 4; ++ks) { const bf16x8 ca = *(const bf16x8*)(ct_lds + (eblk * 16 + lr) * QSTRB + (ks * 32 + 8 * kg) * 2); acc1 = mfma16(ca, qb[ks], acc1); } \
          acc2 = mfma16(tr_pack(VA0), sb0, acc2); if (lblk >= 2) acc2 = mfma16(tr_pack(VA1), sb1, acc2); \
          uint2 w_; w_.x = pk2((a_l * acc1[0] + acc2[0]) * dinv, (a_l * acc1[1] + acc2[1]) * dinv); w_.y = pk2((a_l * acc1[2] + acc2[2]) * dinv, (a_l * acc1[3] + acc2[3]) * dinv); \
          *(uint2*)(hp + (half * 4 + (ti)) * 16) = w_; } while (0)
        MLS_HTILE(0, a0, a1); MLS_HTILE(1, b0, b1); MLS_HTILE(2, c0, c1); MLS_HTILE(3, d0, d1);
#undef MLS_HTILE
      }
    }
    {
      bf16x8 kA0, kA1;
      { TrPair ka0, ka1; const unsigned ak = lds0 + L_K + trq + (unsigned)(wid * 32);
        asm volatile("ds_read_b64_tr_b16 %0, %4\n\tds_read_b64_tr_b16 %1, %4 offset:1088\n\tds_read_b64_tr_b16 %2, %4 offset:8704\n\tds_read_b64_tr_b16 %3, %4 offset:9792\n\ts_waitcnt lgkmcnt(0)"
                     : "=&v"(ka0.lo), "=&v"(ka0.hi), "=&v"(ka1.lo), "=&v"(ka1.hi) : "v"(ak) : "memory");
        const float4 w0 = *(const float4*)(wkl + 8 * kg), w1 = *(const float4*)(wkl + 8 * kg + 4), w2 = *(const float4*)(wkl + 32 + 8 * kg), w3 = *(const float4*)(wkl + 36 + 8 * kg);
        kA0 = scale_frag(ka0, w0, w1); kA1 = scale_frag(ka1, w2, w3); }
#pragma unroll
      for (int q4 = 0; q4 < 4; ++q4) {
        TrPair a0, a1, b0, b1, c0, c1, d0, d1;
        tr_v4(lds0 + L_V + trv + (unsigned)(q4 * 128), a0, a1, b0, b1, c0, c1, d0, d1);
        __builtin_amdgcn_sched_barrier(0);
#define MLS_CUPD(ti, V0, V1) do { f32x4 cc_ = Cacc[q4 * 4 + (ti)] * gamma; cc_ = mfma16(kA0, tr_pack(V0), cc_); cc_ = mfma16(kA1, tr_pack(V1), cc_); Cacc[q4 * 4 + (ti)] = cc_; } while (0)
        MLS_CUPD(0, a0, a1); MLS_CUPD(1, b0, b1); MLS_CUPD(2, c0, c1); MLS_CUPD(3, d0, d1);
#undef MLS_CUPD
      }
      { const int dd = tid & 127, sq = tid >> 7; float a = 0.f; const bf16_t* kp = (const bf16_t*)k_lds + (sq * 16) * (QSTRB / 2) + dd;
#pragma unroll
        for (int si = 0; si < 16; ++si) a += bf2f(kp[si * (QSTRB / 2)]) * wkl[sq * 16 + si];
        npart[sq * 128 + dd] = a; }
      gprev = gamma;
    }
    __syncthreads();
  }
#undef MLS_LOAD
  asm volatile("s_waitcnt vmcnt(0)" ::: "memory");
  __syncthreads();
  if (tid == 0) { __builtin_amdgcn_fence(__ATOMIC_RELEASE, "agent"); asm volatile("s_waitcnt vmcnt(0)" ::: "memory"); __hip_atomic_fetch_add(mdone + 64 * b, 1u, __ATOMIC_RELAXED, __HIP_MEMORY_SCOPE_AGENT); }
}
__device__ __forceinline__ void qkconv_phase(const bf16_t* __restrict__ Pm, bf16_t* __restrict__ QKC, const float* __restrict__ conv_w, const float* __restrict__ conv_b) {
  const int tid = opaque_tid(), lane = tid & 63, wave = tid >> 6;
  const int gw = blockIdx.x * 8 + wave, ngw = gridDim.x * 8;
  const int half = gw & 1, c0 = half * 512 + lane * 8;
  float cw0[8], cw1[8], cw2[8], cbv[8];
#pragma unroll
  for (int i = 0; i < 8; ++i) { cw0[i] = conv_w[c0 + i]; cw1[i] = conv_w[1024 + c0 + i]; cw2[i] = conv_w[2048 + c0 + i]; cbv[i] = conv_b[c0 + i]; }
  const float osc = half ? 0.08838834764831845f : 1.f;
  for (int it = gw >> 1; it < NTOK / 8; it += ngw >> 1) {
    const int r0 = it * 8; const bool isl = r0 < NLAT; const int seq0 = isl ? (r0 / SEQ) * SEQ : NLAT + ((r0 - NLAT) / CTXL) * CTXL, T = isl ? SEQ : CTXL;
    uint4 x[10];
#pragma unroll
    for (int r = 0; r < 10; ++r) { const int t = r0 - seq0 - 1 + r; x[r] = (t >= 0 && t < T) ? *(const uint4*)(Pm + (size_t)(seq0 + t) * NP + C_QB + c0) : make_uint4(0u, 0u, 0u, 0u); }
#pragma unroll
    for (int r = 0; r < 8; ++r) {
      const unsigned a0[4] = {x[r].x, x[r].y, x[r].z, x[r].w}, a1[4] = {x[r + 1].x, x[r + 1].y, x[r + 1].z, x[r + 1].w}, a2[4] = {x[r + 2].x, x[r + 2].y, x[r + 2].z, x[r + 2].w};
      float o[8];
#pragma unroll
      for (int i = 0; i < 8; ++i) {
        const float v0 = (i & 1) ? __uint_as_float(a0[i >> 1] & 0xffff0000u) : __uint_as_float(a0[i >> 1] << 16);
        const float v1 = (i & 1) ? __uint_as_float(a1[i >> 1] & 0xffff0000u) : __uint_as_float(a1[i >> 1] << 16);
        const float v2 = (i & 1) ? __uint_as_float(a2[i >> 1] & 0xffff0000u) : __uint_as_float(a2[i >> 1] << 16);
        const float z = cbv[i] + cw0[i] * v0 + cw1[i] * v1 + cw2[i] * v2;
        o[i] = osc * silu_f(z);
      }
      uint4 w; w.x = pk2(o[0], o[1]); w.y = pk2(o[2], o[3]); w.z = pk2(o[4], o[5]); w.w = pk2(o[6], o[7]);
      *(uint4*)(QKC + (size_t)(r0 + r) * DM + 1024 + c0) = w;
    }
  }
}
__device__ __forceinline__ void mlstm_phase(const bf16_t* __restrict__ Pm, const bf16_t* __restrict__ QKC, const float* __restrict__ GATES, bf16_t* __restrict__ HM,
                                            const float* __restrict__ i_bias, const float* __restrict__ f_bias, bool ctx_out, unsigned* mdone, char* lds) {
  const int G = gridDim.x, bx = blockIdx.x;
  if (G == 256) { const int vcu = (bx % 8) * 32 + bx / 8; if ((vcu & 31) < 8) { const int u = (vcu >> 5) * 8 + (vcu & 31); mlstm_unit(Pm, QKC, GATES, HM, i_bias, f_bias, u >> 3, (u >> 1) & 3, u & 1, ctx_out, mdone, lds);
      {
        KArgP A = kargs(); const int lyr = ctx_out ? 0 : 1;
        const int t2 = opaque_tid(); const float* w_out = A->in[9] + (size_t)lyr * DM * DM; bf16_t* WOUT = (bf16_t*)(A->ws + WS_WOUT) + (size_t)lyr * DM * DM;
        for (int it = u * 8 + (t2 >> 6); it < 1024; it += 512) transpose_item(w_out, DM, DM, DM, WOUT, (float*)lds + (t2 >> 6) * (64 * 65), it, t2 & 63);
        __syncthreads();
      } } }
  else for (int u = bx; u < 64; u += G) mlstm_unit(Pm, QKC, GATES, HM, i_bias, f_bias, u >> 3, (u >> 1) & 3, u & 1, ctx_out, mdone, lds);
}
}

DEVI void mod_unit(int unit, const float* __restrict__ c, const float* __restrict__ c_ctx, const float* __restrict__ w_ada, const float* __restrict__ b_ada, float* __restrict__ MOD, float* ldsf) {
    const int tid = opaque_tid(), lane = tid & 63, wv = tid >> 6;
    const int l = unit / 96, rem = unit % 96, cb = rem >> 2, kq = rem & 3;
    float* sc = ldsf; float* red = ldsf + 9 * 512;
    for (int i = tid; i < 9 * 512; i += 512) { const int r = i >> 9, k = kq * 512 + (i & 511); const float v = (r < 8) ? c[r * DM + k] : c_ctx[k]; sc[i] = silu_f(v); }
    __syncthreads();
    float4 acc[9];
#pragma unroll
    for (int r = 0; r < 9; ++r) acc[r] = make_float4(0.f, 0.f, 0.f, 0.f);
    const float* wb = w_ada + (size_t)l * DM * MODW + (size_t)(kq * 512 + wv * 64) * MODW + cb * 256;
    unsigned vo[8];
#pragma unroll
    for (int j = 0; j < 8; ++j) vo[j] = (unsigned)(lane * 16 + j * (MODW * 4));
#pragma unroll 1
    for (int k0 = 0; k0 < 64; k0 += 16) {
        f4v_t wr[16];
        ld16_wait(wr, vo, uniform_ptr(wb + (size_t)k0 * MODW), uniform_ptr(wb + (size_t)(k0 + 8) * MODW));
#pragma unroll
        for (int j = 0; j < 16; ++j) { const f4v_t wvv = wr[j];
#pragma unroll
            for (int r = 0; r < 9; ++r) { const float s_ = sc[r * 512 + wv * 64 + k0 + j]; acc[r].x += s_ * wvv[0]; acc[r].y += s_ * wvv[1]; acc[r].z += s_ * wvv[2]; acc[r].w += s_ * wvv[3]; } }
    }
#pragma unroll
    for (int r = 0; r < 9; ++r) ((float4*)red)[(wv * 9 + r) * 64 + lane] = acc[r];
    __syncthreads();
    for (int idx = tid; idx < 9 * 256; idx += 512) {
        const int r = idx >> 8, cc = idx & 255; float s_ = (kq == 0) ? b_ada[l * MODW + cb * 256 + cc] : 0.f;
#pragma unroll
        for (int g = 0; g < 8; ++g) s_ += red[(g * 9 + r) * 256 + cc];
        atomicAdd(MOD + (size_t)(l * 9 + r) * MODW + cb * 256 + cc, s_);
    }
    __syncthreads();
}
DEVI void transpose_items(const float* __restrict__ W, int ldw, int K, int N, bf16_t* __restrict__ WT, float* scr, int gw, int ngw, int lane) {
    const int nitems = (K / 64) * (N / 64);
    for (int it = gw; it < nitems; it += ngw) transpose_item(W, ldw, K, N, WT, scr, it, lane);
}
DEVI void finish_row(const bf16_t* __restrict__ P, const bf16_t* __restrict__ HM, const float* __restrict__ mnorm, bf16_t* __restrict__ Y, int row, int lane) {
#pragma unroll
    for (int head = 0; head < 4; ++head) {
        const int col = head * 256 + 4 * lane;
        const uint2 a = *(const uint2*)(HM + (size_t)row * 1024 + col), c = *(const uint2*)(HM + ((size_t)NTOK + row) * 1024 + col);
        float h[4];
        h[0] = __uint_as_float(a.x << 16) + __uint_as_float(c.x << 16); h[1] = __uint_as_float(a.x & 0xffff0000u) + __uint_as_float(c.x & 0xffff0000u);
        h[2] = __uint_as_float(a.y << 16) + __uint_as_float(c.y << 16); h[3] = __uint_as_float(a.y & 0xffff0000u) + __uint_as_float(c.y & 0xffff0000u);
        const float ss = wave_sum(h[0] * h[0] + h[1] * h[1] + h[2] * h[2] + h[3] * h[3]);
        const float r = rsqrtf(ss * (1.f / 256.f) + EPS);
        const uint2 ov = *(const uint2*)(P + (size_t)row * NP + C_OB + col), gv = *(const uint2*)(P + (size_t)row * NP + C_GB + col);
        const float o[4] = {__uint_as_float(ov.x << 16), __uint_as_float(ov.x & 0xffff0000u), __uint_as_float(ov.y << 16), __uint_as_float(ov.y & 0xffff0000u)};
        const float g[4] = {__uint_as_float(gv.x << 16), __uint_as_float(gv.x & 0xffff0000u), __uint_as_float(gv.y << 16), __uint_as_float(gv.y & 0xffff0000u)};
        const float4 w = *(const float4*)(mnorm + col);
        const float wv[4] = {w.x, w.y, w.z, w.w};
        float y[4];
#pragma unroll
        for (int e = 0; e < 4; ++e) y[e] = h[e] * r * wv[e] * sigmoid_f(o[e]) * silu_f(g[e]);
        uint2 out; out.x = pk2(y[0], y[1]); out.y = pk2(y[2], y[3]);
        *(uint2*)(Y + (size_t)row * DM + 1024 + col) = out;
    }
}
DEVI void load_row(const float* __restrict__ xr, float4 (&v)[8], int lane) {
#pragma unroll
    for (int j = 0; j < 8; ++j) v[j] = ((const float4*)xr)[lane + 64 * j];
}
DEVI void load_row_y(const bf16_t* __restrict__ yr, uint2 (&yv)[8], int lane) {
#pragma unroll
    for (int j = 0; j < 8; ++j) yv[j] = *(const uint2*)(yr + 4 * (lane + 64 * j));
}
DEVI void post_regs(float4 (&v)[8], const uint2 (&yv)[8], const float* gate, const float* npost, float* __restrict__ orow, int lane) {
    float ss = 0.f;
#pragma unroll
    for (int j = 0; j < 8; ++j) {
        const float y0 = __uint_as_float(yv[j].x << 16), y1 = __uint_as_float(yv[j].x & 0xffff0000u), y2 = __uint_as_float(yv[j].y << 16), y3 = __uint_as_float(yv[j].y & 0xffff0000u);
        ss += y0 * y0 + y1 * y1 + y2 * y2 + y3 * y3;
    }
    ss = wave_sum(ss);
    const float rstd = rsqrtf(ss * (1.f / DM) + EPS);
#pragma unroll
    for (int j = 0; j < 8; ++j) {
        const float4 gt = ((const float4*)gate)[lane + 64 * j], w = ((const float4*)npost)[lane + 64 * j];
        const float y0 = __uint_as_float(yv[j].x << 16), y1 = __uint_as_float(yv[j].x & 0xffff0000u), y2 = __uint_as_float(yv[j].y << 16), y3 = __uint_as_float(yv[j].y & 0xffff0000u);
        v[j].x += gt.x * (y0 * rstd * w.x); v[j].y += gt.y * (y1 * rstd * w.y); v[j].z += gt.z * (y2 * rstd * w.z); v[j].w += gt.w * (y3 * rstd * w.w);
        ((float4*)orow)[lane + 64 * j] = v[j];
        if (j == 3) asm volatile("" ::: "memory");
    }
}
DEVI void norm_regs(const float4 (&v)[8], const float* shift, const float* scale, const float* npre, bf16_t* __restrict__ hrow, char* trow, int lane) {
    float ss = 0.f;
#pragma unroll
    for (int j = 0; j < 8; ++j) ss += v[j].x * v[j].x + v[j].y * v[j].y + v[j].z * v[j].z + v[j].w * v[j].w;
    ss = wave_sum(ss);
    const float rstd = rsqrtf(ss * (1.f / DM) + EPS);
#pragma unroll
    for (int j = 0; j < 8; ++j) {
        const float4 w = ((const float4*)npre)[lane + 64 * j], sh = ((const float4*)shift)[lane + 64 * j], sc = ((const float4*)scale)[lane + 64 * j];
        uint2 o;
        o.x = pk2(v[j].x * rstd * w.x * (1.f + sc.x) + sh.x, v[j].y * rstd * w.y * (1.f + sc.y) + sh.y);
        o.y = pk2(v[j].z * rstd * w.z * (1.f + sc.z) + sh.z, v[j].w * rstd * w.w * (1.f + sc.w) + sh.w);
        *(uint2*)(hrow + 4 * (lane + 64 * j)) = o; *(uint2*)(trow + 8 * (lane + 64 * j)) = o;
        if (j == 3) asm volatile("" ::: "memory");
    }
}
constexpr int NT_ROWB = (DM + 8) * 2;
constexpr int NV_OFF = 0, NT_OFF = 5 * DM * 4, NR_OFF = NT_OFF + 16 * NT_ROWB, NPH_LDS = NR_OFF + 8 * 16 * 16 * 4;
static_assert(NPH_LDS <= LDS_PHASE_BYTES, "norm phase LDS map");
template <bool POST>
DEVI void norm_phase(const float* __restrict__ xlat, const float* __restrict__ xctx, const bf16_t* __restrict__ Y2, const float* __restrict__ mod_post, const float* __restrict__ npost,
                     float* olat, float* octx, const float* __restrict__ mod_n, const float* __restrict__ npre, const bf16_t* __restrict__ wgt, bf16_t* __restrict__ H,
                     float* __restrict__ GATES, char* lds) {
    typedef short bf16x8 __attribute__((ext_vector_type(8))); typedef float f32x4 __attribute__((ext_vector_type(4)));
    const int tid = opaque_tid(), lane = tid & 63, wave = __builtin_amdgcn_readfirstlane(tid >> 6), lr = lane & 15, kgp = lane >> 4;
    float* vec = (float*)(lds + NV_OFF); float* v_npre = vec; float* v_shift = vec + DM; float* v_scale = vec + 2 * DM; float* v_npost = vec + 3 * DM; float* v_gate = vec + 4 * DM;
    char* tile = lds + NT_OFF; float* red = (float*)(lds + NR_OFF);
    ((float4*)v_npre)[tid] = ((const float4*)npre)[tid];
    if (POST) ((float4*)v_npost)[tid] = ((const float4*)npost)[tid];
    int cur_b = -1;
#define NP_ENSURE(bb) do { if ((bb) != cur_b) { __syncthreads(); const float* mn_ = mod_n + (size_t)(bb) * MODW; ((float4*)v_shift)[tid] = ((const float4*)mn_)[tid]; ((float4*)v_scale)[tid] = ((const float4*)(mn_ + DM))[tid]; \
        if (POST) ((float4*)v_gate)[tid] = ((const float4*)(mod_post + (size_t)(bb) * MODW + 2 * DM))[tid]; cur_b = (bb); __syncthreads(); } } while (0)
    const int row0 = (int)blockIdx.x * (NTOK / 256);
    for (int g = 0; g < 5; ++g) {
        const int gr0 = row0 + 16 * g; const bool two = g < 4;
        const int rowA = gr0 + wave, rowB = gr0 + 8 + wave;
        const bool islA = rowA < NLAT, islB = rowB < NLAT; const int bA = gr0 < NLAT ? gr0 / SEQ : 8, bB = (gr0 + 8) < NLAT ? (gr0 + 8) / SEQ : 8;
        float4 vA[8], vB[8]; uint2 yA[8], yB[8];
        load_row(islA ? xlat + (size_t)rowA * DM : xctx + (size_t)(rowA - NLAT) * DM, vA, lane);
        if (POST) load_row_y(Y2 + (size_t)rowA * DM, yA, lane);
        if (two) { load_row(islB ? xlat + (size_t)rowB * DM : xctx + (size_t)(rowB - NLAT) * DM, vB, lane); if (POST) load_row_y(Y2 + (size_t)rowB * DM, yB, lane); }
        NP_ENSURE(bA);
        if (POST) post_regs(vA, yA, v_gate, v_npost, islA ? olat + (size_t)rowA * DM : octx + (size_t)(rowA - NLAT) * DM, lane);
        norm_regs(vA, v_shift, v_scale, v_npre, H + (size_t)rowA * DM, tile + wave * NT_ROWB, lane);
        if (two) {
            NP_ENSURE(bB);
            if (POST) post_regs(vB, yB, v_gate, v_npost, islB ? olat + (size_t)rowB * DM : octx + (size_t)(rowB - NLAT) * DM, lane);
            norm_regs(vB, v_shift, v_scale, v_npre, H + (size_t)rowB * DM, tile + (8 + wave) * NT_ROWB, lane);
        }
        __syncthreads();
        f32x4 acc = {0.f, 0.f, 0.f, 0.f};
        {
            f4v_t bfr[8]; unsigned vo[8];
#pragma unroll
            for (int ks = 0; ks < 8; ++ks) vo[ks] = (unsigned)((lr * DM + wave * 256 + ks * 32 + 8 * kgp) * 2);
            ld8_wait(bfr, vo, uniform_ptr(wgt));
#pragma unroll
            for (int ks = 0; ks < 8; ++ks) {
                const bf16x8 af = *(const bf16x8*)(tile + lr * NT_ROWB + (wave * 256 + ks * 32 + 8 * kgp) * 2);
                acc = __builtin_amdgcn_mfma_f32_16x16x32_bf16(af, __builtin_bit_cast(bf16x8, bfr[ks]), acc, 0, 0, 0);
            }
        }
#pragma unroll
        for (int r = 0; r < 4; ++r) red[(wave * 16 + 4 * kgp + r) * 16 + lr] = acc[r];
        __syncthreads();
        if (tid < 256) { const int rr = tid >> 4, cc = tid & 15;
            if (two || rr < 8) { float sum = 0.f;
#pragma unroll
                for (int w8 = 0; w8 < 8; ++w8) sum += red[(w8 * 16 + rr) * 16 + cc];
                GATES[(size_t)(gr0 + rr) * 16 + cc] = sum; } }
    }
#undef NP_ENSURE
    __syncthreads();
}
DEVI void post_phase_final(float* out, const bf16_t* __restrict__ Y2, const float* __restrict__ mod_l, const float* __restrict__ npost, char* lds) {
    const int tid = opaque_tid(), lane = tid & 63, wave = tid >> 6;
    float* v_gate = (float*)lds; float* v_npost = v_gate + DM;
    const int row0 = (int)blockIdx.x * (NLAT / 256), b = row0 / SEQ;
    ((float4*)v_gate)[tid] = ((const float4*)(mod_l + (size_t)b * MODW + 2 * DM))[tid];
    ((float4*)v_npost)[tid] = ((const float4*)npost)[tid];
    __syncthreads();
    float4 vA[8], vB[8]; uint2 yA[8], yB[8];
    const int r0 = row0 + wave * 8;
    load_row(out + (size_t)r0 * DM, vA, lane); load_row_y(Y2 + (size_t)r0 * DM, yA, lane);
    load_row(out + (size_t)(r0 + 1) * DM, vB, lane); load_row_y(Y2 + (size_t)(r0 + 1) * DM, yB, lane);
#pragma unroll 1
    for (int i = 0; i < 4; ++i) {
        const int ra = r0 + 2 * i, rb = ra + 1;
        post_regs(vA, yA, v_gate, v_npost, out + (size_t)ra * DM, lane);
        if (i < 3) { load_row(out + (size_t)(ra + 2) * DM, vA, lane); load_row_y(Y2 + (size_t)(ra + 2) * DM, yA, lane); }
        post_regs(vB, yB, v_gate, v_npost, out + (size_t)rb * DM, lane);
        if (i < 3) { load_row(out + (size_t)(rb + 2) * DM, vB, lane); load_row_y(Y2 + (size_t)(rb + 2) * DM, yB, lane); }
    }
    __syncthreads();
}

DEVI void mixer_queue(const bf16_t* __restrict__ Pm, bf16_t* __restrict__ Y, const bf16_t* __restrict__ HM, const float* lq1, const float* lk1, const float* lq2, const float* lk2,
                      const float* __restrict__ subln, const float* __restrict__ mnorm, float lam_init, bool ctx_out, unsigned* qcnt  ,
                      unsigned* mdone  , volatile __attribute__((address_space(3))) unsigned* bcast, char* lds) {
  const int tid = opaque_tid(), lane = tid & 63;
  const float lam = rl_f(expf(wave_sum(lq1[lane] * lk1[lane])) - expf(wave_sum(lq2[lane] * lk2[lane])) + lam_init, 0);
  const int G = gridDim.x, bx = blockIdx.x; const int vcu = (G % 8 == 0) ? (bx % 8) * (G / 8) + bx / 8 : bx;
  const int g0 = (G == 256) ? (vcu >> 5) : (bx & 7);
  const int natt = 64 + (ctx_out ? 8 : 0), nun = natt + 32 + (ctx_out ? 4 : 0);
  for (int gi = 0; gi < 8; ++gi) {
    const int g = (g0 + gi) & 7;
    for (;;) {
      if (opaque_tid() == 0) bcast[0] = __hip_atomic_fetch_add(qcnt + 64 * g, 1u, __ATOMIC_RELAXED, __HIP_MEMORY_SCOPE_AGENT);
      __syncthreads();
      const int u = (int)bcast[0];
      __syncthreads();
      if (u >= nun) break;
      if (u < 64) { const int bh = g * 8 + (u >> 3), qb = u & 7, b = bh >> 3, hh = bh & 7; att::attn_unit2(Pm, Y, (long)b * SEQ + qb * att::QROWS2, b, hh, 36, lam, lam_init, subln, lds); }
      else if (u < natt) { const int bh = g * 8 + (u - 64), b = bh >> 3, hh = bh & 7; att::attn_unit2(Pm, Y, (long)NLAT + b * CTXL, b, hh, 4, lam, lam_init, subln, lds); }
      else {
        const int f = u - natt; const int row0 = f < 32 ? g * SEQ + f * 64 : NLAT + g * CTXL + (f - 32) * 64;
        if (opaque_tid() == 0) {
          unsigned spins = 0;
          while (__hip_atomic_load(mdone + 64 * g, __ATOMIC_RELAXED, __HIP_MEMORY_SCOPE_AGENT) < 8u) { __builtin_amdgcn_s_sleep(8); if (++spins > (1u << 22)) break; }
          __builtin_amdgcn_fence(__ATOMIC_ACQUIRE, "agent");
          asm volatile("s_waitcnt vmcnt(0)" ::: "memory");
        }
        __syncthreads();
        const int tid2 = opaque_tid();
#pragma unroll 1
        for (int r = 0; r < 8; ++r) finish_row(Pm, HM, mnorm, Y, row0 + (tid2 >> 6) * 8 + r, tid2 & 63);
      }
    }
  }
}

#define XB_TMO      128
#define XB_XCNT(j)  (256  + 64 * (j))
#define XB_XSUB(j)  (1280 + 64 * (j))
#define XB_XGEN(j)  (2304 + 64 * (j))
#define XB_TOP      3328
#define XB_TOPGEN   3392
#define XCD_BAR_WORDS 3456
#define XB_SPIN_CAP (1u << 18)

__device__ __forceinline__ unsigned xb_ld(unsigned* p)              { return __hip_atomic_load(p, __ATOMIC_RELAXED, __HIP_MEMORY_SCOPE_AGENT); }
__device__ __forceinline__ unsigned xb_add(unsigned* p, unsigned v) { return __hip_atomic_fetch_add(p, v, __ATOMIC_RELAXED, __HIP_MEMORY_SCOPE_AGENT); }
__device__ __forceinline__ unsigned xb_xcc_id() { return (unsigned)__builtin_amdgcn_s_getreg((3 << 11) | 20) & 0xFu; }
#define XB_SPIN(cond, bar) do { unsigned _sp = 0; while (cond) { __builtin_amdgcn_s_sleep(1); \
    if ((++_sp & 255u) == 0u) { if (xb_ld(&(bar)[XB_TMO])) break; if (_sp > XB_SPIN_CAP) { atomicAdd(&(bar)[XB_TMO], 1u); break; } } } } while (0)

struct XcdBarrier {
    unsigned* bar; unsigned x;
    volatile __attribute__((address_space(3))) unsigned* st;
};

__device__ __forceinline__ XcdBarrier xcd_barrier_post(unsigned* bar, volatile __attribute__((address_space(3))) unsigned* st) {
    XcdBarrier b; b.bar = bar; b.x = xb_xcc_id(); b.st = st;
    if (threadIdx.x == 0) (void)xb_add(&bar[XB_XCNT(b.x)], 1u);
    return b;
}
__device__ __forceinline__ void xcd_barrier_complete(unsigned* bar, unsigned x, unsigned& nloc, unsigned& nx) {
    const unsigned G = gridDim.x * gridDim.y * gridDim.z;
    unsigned sum, cnt, mine, sp = 0u;
    for (;;) {
        sum = 0u; cnt = 0u; mine = 0u;
#pragma unroll
        for (unsigned j = 0; j < 16; ++j) { const unsigned c = xb_ld(&bar[XB_XCNT(j)]); sum += c; cnt += (c > 0u) ? 1u : 0u; mine = (j == x) ? c : mine; }
        if (sum == G) break;
        __builtin_amdgcn_s_sleep(1);
        if ((++sp & 255u) == 0u) { if (xb_ld(&bar[XB_TMO])) break; if (sp > XB_SPIN_CAP) { atomicAdd(&bar[XB_TMO], 1u); break; } }
    }
    nloc = mine > 0u ? mine : 1u; nx = cnt > 0u ? cnt : 1u;
}

__device__ __forceinline__ void xcd_barrier(const XcdBarrier& b) {
    asm volatile("s_waitcnt vmcnt(0)" ::: "memory");
    __syncthreads();
    if (threadIdx.x == 0) {
        unsigned* bar = b.bar;
        __builtin_amdgcn_s_waitcnt(0);
        unsigned nloc = b.st[0], nx = b.st[1];
        if (nloc == 0u) { xcd_barrier_complete(bar, b.x, nloc, nx); b.st[0] = nloc; b.st[1] = nx; }
        const unsigned old = xb_add(&bar[XB_XSUB(b.x)], 1u);
        const unsigned gen = old / nloc;
        if (old + 1u == (gen + 1u) * nloc) {
            __builtin_amdgcn_fence(__ATOMIC_RELEASE, "agent");
            asm volatile("s_waitcnt vmcnt(0)" ::: "memory");
            const unsigned og = xb_add(&bar[XB_TOP], 1u);
            const unsigned tg = og / nx;
            if (og + 1u == (tg + 1u) * nx) xb_add(&bar[XB_TOPGEN], 1u);
            else XB_SPIN(xb_ld(&bar[XB_TOPGEN]) == tg, bar);
            __builtin_amdgcn_fence(__ATOMIC_ACQUIRE, "agent");
            xb_add(&bar[XB_XGEN(b.x)], 1u);
            asm volatile("s_waitcnt vmcnt(0)" ::: "memory");
        } else {
            XB_SPIN(xb_ld(&bar[XB_XGEN(b.x)]) == gen, bar);
            __builtin_amdgcn_fence(__ATOMIC_ACQUIRE, "agent");
            asm volatile("s_waitcnt vmcnt(0)" ::: "memory");
        }
    }
    __syncthreads();
}

namespace cg = cooperative_groups;
constexpr int MEGA_LDS = LDS_PHASE_BYTES + 256;
#define LAS3 __attribute__((address_space(3)))
__global__ __launch_bounds__(512, 2) void mega_fwd(MegaArgs a_unused) {
    (void)a_unused;
    extern __shared__ __attribute__((aligned(16))) unsigned char lds[];
    cg::grid_group grid = cg::this_grid();
    { volatile LAS3 unsigned* MISC = (volatile LAS3 unsigned*)((LAS3 unsigned char*)lds + LDS_PHASE_BYTES);
      if (threadIdx.x < 64) MISC[threadIdx.x] = 0u;
      __syncthreads();
      if ((threadIdx.x & 63) == 0) ((volatile LAS3 unsigned char*)MISC)[128 + ((unsigned)__builtin_amdgcn_s_getreg((5 << 11) | 4) & 63u)] = (unsigned char)(threadIdx.x >> 6);
      __syncthreads();
      (void)xcd_barrier_post((unsigned*)(kargs()->ws + WS_CTL) + 4096, MISC + 8); }
#define GRID_BAR() do { XcdBarrier b_; b_.bar = (unsigned*)(kargs()->ws + WS_CTL) + 4096; b_.x = xb_xcc_id(); b_.st = (volatile LAS3 unsigned*)((LAS3 unsigned char*)lds + LDS_PHASE_BYTES) + 8; xcd_barrier(b_); } while (0)
#define PHASE_IDS const int G = gridDim.x; const int tid = opaque_tid(), lane = tid & 63, wave = tid >> 6, gw = blockIdx.x * 8 + wave, ngw = G * 8; (void)tid; (void)lane; (void)gw; (void)ngw; float* scr = (float*)lds + wave * (64 * 65); (void)scr
#define WSP(T, off) ((T*)(A->ws + (off)))

    { PHASE_IDS; KArgP A = kargs();
      const float* w_in = A->in[8]; const float* w_out = A->in[9]; bf16_t* WIN = WSP(bf16_t, WS_WIN); bf16_t* WOUT = WSP(bf16_t, WS_WOUT); float* ROPE = WSP(float, WS_ROPE);
      const bool dfr = (G == 256);
      for (int u = blockIdx.x; u < (dfr ? 96 : 192); u += G) mod_unit(u, A->in[1], A->in[3], A->in[4], A->in[5], WSP(float, WS_MOD), (float*)lds);
      { bf16_t* WGT = WSP(bf16_t, WS_WGT); for (int i = blockIdx.x * 512 + tid; i < 2 * 16 * DM; i += G * 512) { const int l_ = i >> 15, k_ = (i >> 4) & (DM - 1), c_ = i & 15; WGT[(l_ * 16 + c_) * DM + k_] = f2bf(w_in[(size_t)l_ * DM * INC + (size_t)k_ * INC + NP + c_]); } }
      for (int i = blockIdx.x * 512 + tid; i < 1024; i += G * 512) { const int pos = i >> 4, f = i & 15; const float inv = powf(10000.f, -(float)f / 16.f); const float ang = (float)pos * inv;
          ROPE[2 * i] = cosf(ang); ROPE[2 * i + 1] = sinf(ang); }
      if (dfr) {
          if ((int)blockIdx.x >= 96) for (int it = gw - 96 * 8; it < 4096; it += 160 * 8) transpose_item(w_in, INC, DM, NP, WIN, scr, it, lane);
      } else {
          for (int it = gw; it < 6144; it += ngw) {
              if (it < 4096) transpose_item(w_in, INC, DM, NP, WIN, scr, it, lane);
              else if (it < 5120) transpose_item(w_out, DM, DM, DM, WOUT, scr, it - 4096, lane);
              else transpose_item(w_out + (size_t)DM * DM, DM, DM, DM, WOUT + (size_t)DM * DM, scr, it - 5120, lane);
          }
      } }
    if (gridDim.x > 65536u) grid.sync();
    GRID_BAR();
    { KArgP A = kargs();
      norm_phase<false>(A->in[0], A->in[2], nullptr, nullptr, nullptr, nullptr, nullptr, WSP(float, WS_MOD), A->in[6], WSP(bf16_t, WS_WGT), WSP(bf16_t, WS_H), WSP(float, WS_GATES), (char*)lds); }
    GRID_BAR();
    for (int l = 0; l < 2; ++l) {
        { KArgP A = kargs();
          pg8::Gemm g{WSP(bf16_t, WS_H), WSP(bf16_t, WS_WIN), NTOK, NP, DM}; pg8::StaticOrder S; S.init(NTOK, NP, (int)gridDim.x, (int)blockIdx.x); pg8::EpiInProj E{WSP(bf16_t, WS_P), NP, WSP(float, WS_ROPE)};
          pg8::gemm_phase<pg8::EpiInProj, pg8::StaticOrder, true, true>((PG8_LAS unsigned char*)lds, g, S, E); }
        GRID_BAR();
        { KArgP A = kargs(); mls::qkconv_phase(WSP(bf16_t, WS_P), WSP(bf16_t, WS_H), A->in[15] + (size_t)l * 3 * 1024, A->in[16] + l * 1024); }
        GRID_BAR();
        { KArgP A = kargs(); mls::mlstm_phase(WSP(bf16_t, WS_P), WSP(bf16_t, WS_H), WSP(float, WS_GATES), WSP(bf16_t, WS_HM), A->in[17] + l * 8, A->in[18] + l * 8, l == 0, WSP(unsigned, WS_CTL) + 12288 + l * 512, (char*)lds); }
        { KArgP A = kargs(); const float lam_init = l == 0 ? 0.2f : 0.35550906759f;
          mixer_queue(WSP(bf16_t, WS_P), WSP(bf16_t, WS_H), WSP(bf16_t, WS_HM), A->in[10] + l * 64, A->in[11] + l * 64, A->in[12] + l * 64, A->in[13] + l * 64, A->in[14] + l * 128, A->in[19] + l * 1024, lam_init, l == 0,
                      WSP(unsigned, WS_CTL) + 8192 + l * 512, WSP(unsigned, WS_CTL) + 12288 + l * 512, (volatile LAS3 unsigned*)((LAS3 unsigned char*)lds + LDS_PHASE_BYTES) + 16, (char*)lds); }
        GRID_BAR();
        { KArgP A = kargs(); const int M = l == 0 ? NTOK : NLAT;
          pg8::Gemm g{WSP(bf16_t, WS_H), WSP(bf16_t, WS_WOUT) + (size_t)l * DM * DM, M, DM, DM}; pg8::StaticOrder S; S.init(M, DM, (int)gridDim.x, (int)blockIdx.x); pg8::EpiBf16 E{WSP(bf16_t, WS_HM), DM};
          pg8::gemm_phase<pg8::EpiBf16, pg8::StaticOrder, true, true>((PG8_LAS unsigned char*)lds, g, S, E); }
        if (l == 0) { PHASE_IDS; KArgP A = kargs(); const float* w_in1 = A->in[8] + (size_t)DM * INC; bf16_t* WIN = WSP(bf16_t, WS_WIN);
            const int nbusy = (NTOK / 256) * (DM / 256) - 2 * G;
            if (nbusy >= 0 && nbusy < G) { if ((int)blockIdx.x >= nbusy) { const int ib = (int)blockIdx.x - nbusy, nidle = G - nbusy;
                    if (G == 256 && nidle == 192) { if (ib < 96) mod_unit(96 + ib, A->in[1], A->in[3], A->in[4], A->in[5], WSP(float, WS_MOD), (float*)lds);
                                                    else transpose_items(w_in1, INC, DM, NP, WIN, scr, (ib - 96) * 8 + wave, 96 * 8, lane); }
                    else transpose_items(w_in1, INC, DM, NP, WIN, scr, ib * 8 + wave, nidle * 8, lane); } }
            else transpose_items(w_in1, INC, DM, NP, WIN, scr, gw, ngw, lane);
        }
        GRID_BAR();
        if (l == 0) {
            { KArgP A = kargs(); float* MOD = WSP(float, WS_MOD);
              norm_phase<true>(A->in[0], A->in[2], WSP(bf16_t, WS_HM), MOD, A->in[7], A->out, WSP(float, WS_XC), MOD + (size_t)9 * MODW, A->in[6] + DM, WSP(bf16_t, WS_WGT) + 16 * DM, WSP(bf16_t, WS_H), WSP(float, WS_GATES), (char*)lds); }
            GRID_BAR();
        } else { KArgP A = kargs(); post_phase_final(A->out, WSP(bf16_t, WS_HM), WSP(float, WS_MOD) + (size_t)9 * MODW, A->in[7] + DM, (char*)lds);
        }
    }
}

extern "C" void kernel_launch(void* const* d_in, const int* in_sizes, int n_in, void* d_out, int out_size, void* d_ws, size_t ws_size, hipStream_t stream) {
    (void)in_sizes; (void)n_in; (void)out_size; (void)ws_size;
    static int grid_blocks = 0;
    if (!grid_blocks) {
        int dev = 0, cus = 0, per_cu = 0;
        (void)hipGetDevice(&dev);
        (void)hipDeviceGetAttribute(&cus, hipDeviceAttributeMultiprocessorCount, dev);
        (void)hipFuncSetAttribute((const void*)mega_fwd, hipFuncAttributeMaxDynamicSharedMemorySize, MEGA_LDS);
        (void)hipOccupancyMaxActiveBlocksPerMultiprocessor(&per_cu, (const void*)mega_fwd, 512, MEGA_LDS);
        if (per_cu < 1) per_cu = 1;
        if (per_cu > 1) per_cu = 1;
        grid_blocks = cus * per_cu;
    }
    (void)hipMemsetAsync((char*)d_ws + WS_CTL, 0, WS_MOD + (size_t)2 * 9 * MODW * 4, stream);
    MegaArgs a{};
    for (int i = 0; i < 20; ++i) a.in[i] = (const float*)d_in[i];
    a.out = (float*)d_out; a.ws = (unsigned char*)d_ws;
    void* args[] = {&a};
    (void)hipLaunchCooperativeKernel((const void*)mega_fwd, dim3(grid_blocks), dim3(512), args, (size_t)MEGA_LDS, stream);
}
```

```cpp
#include <hip/hip_runtime.h>
#include <hip/hip_cooperative_groups.h>
#include <stdint.h>
#include <math.h>

#define DEVI __device__ __forceinline__
constexpr int LDS_PHASE_BYTES = 155648;
typedef unsigned short bf16_t;

constexpr int DM = 2048, NBATCH = 8, SEQ = 2048, CTXL = 256;
constexpr int NLAT = NBATCH * SEQ, NCTX = NBATCH * CTXL, NTOK = NLAT + NCTX;
constexpr int INC = 8208, NP = 8192, MODW = 6144;
constexpr int C_QA = 0, C_KA = 1024, C_VA = 2048, C_GA = 3072, C_QB = 4096, C_KB = 4608, C_VB = 5120, C_OB = 6144, C_GB = 7168;
constexpr float EPS = 1e-6f;

constexpr size_t MiB = (size_t)1 << 20;
constexpr size_t WS_CTL = 0, WS_MOD = 1 * MiB, WS_SC = WS_MOD + 512 * 1024, WS_ROPE = 2 * MiB, WS_WGT = 2 * MiB + 65536  , WS_GATES = 3 * MiB, WS_WOUT = 8 * MiB,
                 WS_WIN = 24 * MiB, WS_XC = 56 * MiB, WS_H = 72 * MiB, WS_HM = 144 * MiB, WS_P = 216 * MiB, WS_END = 504 * MiB;

DEVI int opaque_tid() {
    const unsigned hw = (unsigned)__builtin_amdgcn_s_getreg((5 << 11) | 4) & 63u;
    const unsigned w = *((const volatile __attribute__((address_space(3))) unsigned char*)(LDS_PHASE_BYTES + 128) + hw);
    int ln; asm volatile("v_mbcnt_lo_u32_b32 %0, -1, 0\n\tv_mbcnt_hi_u32_b32 %0, -1, %0" : "=v"(ln));
    return (int)(__builtin_amdgcn_readfirstlane(w) << 6) | ln;
}
DEVI float bf2f(bf16_t v) { return __uint_as_float(((unsigned)v) << 16); }
DEVI bf16_t f2bf(float f) { unsigned u = __float_as_uint(f); return (bf16_t)((u + 0x7fffu + ((u >> 16) & 1u)) >> 16); }
DEVI unsigned pk2(float lo, float hi) { typedef float f32x2_ __attribute__((ext_vector_type(2))); typedef __bf16 bf16x2_ __attribute__((ext_vector_type(2))); const f32x2_ v = {lo, hi}; return __builtin_bit_cast(unsigned, __builtin_convertvector(v, bf16x2_)); }
DEVI float row16_sum(float v) {
    v += __builtin_bit_cast(float, __builtin_amdgcn_update_dpp(0, __builtin_bit_cast(int, v), 0xB1, 0xF, 0xF, false));
    v += __builtin_bit_cast(float, __builtin_amdgcn_update_dpp(0, __builtin_bit_cast(int, v), 0x4E, 0xF, 0xF, false));
    v += __builtin_bit_cast(float, __builtin_amdgcn_update_dpp(0, __builtin_bit_cast(int, v), 0x141, 0xF, 0xF, false));
    v += __builtin_bit_cast(float, __builtin_amdgcn_update_dpp(0, __builtin_bit_cast(int, v), 0x140, 0xF, 0xF, false));
    return v;
}
DEVI float rl_f(float v, int l) { return __builtin_bit_cast(float, __builtin_amdgcn_readlane(__builtin_bit_cast(int, v), l)); }
DEVI float wave_sum(float v) { v = row16_sum(v); return (rl_f(v, 0) + rl_f(v, 16)) + (rl_f(v, 32) + rl_f(v, 48)); }
DEVI float half_sum(float v, int hi) { v = row16_sum(v); const float a = rl_f(v, 0) + rl_f(v, 16), b = rl_f(v, 32) + rl_f(v, 48); return hi ? b : a; }
DEVI float sigmoid_f(float x) { return __builtin_amdgcn_rcpf(1.f + __expf(-x)); }
DEVI float silu_f(float x) { return x * sigmoid_f(x); }

typedef float f4v_t __attribute__((ext_vector_type(4)));
DEVI unsigned long long uniform_ptr(const void* p) { const unsigned long long pb = (unsigned long long)p;
    return ((unsigned long long)(unsigned)__builtin_amdgcn_readfirstlane((int)(pb >> 32)) << 32) | (unsigned)__builtin_amdgcn_readfirstlane((int)pb); }
#define LD8_ASM(TAIL) asm volatile("s_nop 4\n\tglobal_load_dwordx4 %0, %8, %16\n\tglobal_load_dwordx4 %1, %9, %16\n\tglobal_load_dwordx4 %2, %10, %16\n\tglobal_load_dwordx4 %3, %11, %16\n\t" \
        "global_load_dwordx4 %4, %12, %16\n\tglobal_load_dwordx4 %5, %13, %16\n\tglobal_load_dwordx4 %6, %14, %16\n\tglobal_load_dwordx4 %7, %15, %16" TAIL \
        : "=&v"(v[0]), "=&v"(v[1]), "=&v"(v[2]), "=&v"(v[3]), "=&v"(v[4]), "=&v"(v[5]), "=&v"(v[6]), "=&v"(v[7]) \
        : "v"(vo[0]), "v"(vo[1]), "v"(vo[2]), "v"(vo[3]), "v"(vo[4]), "v"(vo[5]), "v"(vo[6]), "v"(vo[7]), "s"(sb) : "memory")
DEVI void ld8_wait(f4v_t (&v)[8], const unsigned (&vo)[8], unsigned long long sb) { LD8_ASM("\n\ts_waitcnt vmcnt(0)"); }
DEVI void ld16_wait(f4v_t (&v)[16], const unsigned (&vo)[8], unsigned long long sb0, unsigned long long sb1) {
    asm volatile("s_nop 4\n\tglobal_load_dwordx4 %0, %16, %24\n\tglobal_load_dwordx4 %1, %17, %24\n\tglobal_load_dwordx4 %2, %18, %24\n\tglobal_load_dwordx4 %3, %19, %24\n\t"
                 "global_load_dwordx4 %4, %20, %24\n\tglobal_load_dwordx4 %5, %21, %24\n\tglobal_load_dwordx4 %6, %22, %24\n\tglobal_load_dwordx4 %7, %23, %24\n\t"
                 "global_load_dwordx4 %8, %16, %25\n\tglobal_load_dwordx4 %9, %17, %25\n\tglobal_load_dwordx4 %10, %18, %25\n\tglobal_load_dwordx4 %11, %19, %25\n\t"
                 "global_load_dwordx4 %12, %20, %25\n\tglobal_load_dwordx4 %13, %21, %25\n\tglobal_load_dwordx4 %14, %22, %25\n\tglobal_load_dwordx4 %15, %23, %25\n\ts_waitcnt vmcnt(0)"
                 : "=&v"(v[0]), "=&v"(v[1]), "=&v"(v[2]), "=&v"(v[3]), "=&v"(v[4]), "=&v"(v[5]), "=&v"(v[6]), "=&v"(v[7]),
                   "=&v"(v[8]), "=&v"(v[9]), "=&v"(v[10]), "=&v"(v[11]), "=&v"(v[12]), "=&v"(v[13]), "=&v"(v[14]), "=&v"(v[15])
                 : "v"(vo[0]), "v"(vo[1]), "v"(vo[2]), "v"(vo[3]), "v"(vo[4]), "v"(vo[5]), "v"(vo[6]), "v"(vo[7]), "s"(sb0), "s"(sb1) : "memory");
}


struct MegaArgs { const float* in[20]; float* out; unsigned char* ws; };
DEVI const float* karg_in(int i) { const char* kp = (const char*)__builtin_amdgcn_kernarg_segment_ptr(); asm volatile("" : "+s"(kp)); return *(const float* const*)(kp + 8 * i); }
DEVI unsigned char* karg_ws() { const char* kp = (const char*)__builtin_amdgcn_kernarg_segment_ptr(); asm volatile("" : "+s"(kp)); return *(unsigned char* const*)(kp + 168); }
DEVI float* karg_out() { const char* kp = (const char*)__builtin_amdgcn_kernarg_segment_ptr(); asm volatile("" : "+s"(kp)); return *(float* const*)(kp + 160); }
typedef const __attribute__((address_space(4))) MegaArgs* KArgP;
DEVI KArgP kargs() {
    const unsigned long long p = (unsigned long long)__builtin_amdgcn_kernarg_segment_ptr();
    unsigned lo = (unsigned)p, hi = (unsigned)(p >> 32);
    asm volatile("" : "+s"(lo), "+s"(hi));
    lo = __builtin_amdgcn_readfirstlane(lo); hi = __builtin_amdgcn_readfirstlane(hi);
    return (KArgP)(((unsigned long long)hi << 32) | lo);
}

DEVI void transpose_item(const float* __restrict__ W, int ldw, int K, int N, bf16_t* __restrict__ WT, float* scr, int item, int lane) {
    const int nblk = N / 64, kb = item / nblk, nb = item % nblk, k0 = 64 * kb, n0 = 64 * nb;
    float tv[64];
#pragma unroll
    for (int i = 0; i < 64; ++i) tv[i] = W[(size_t)(k0 + i) * ldw + n0 + lane];
#pragma unroll
    for (int i = 0; i < 64; ++i) scr[i * 65 + lane] = tv[i];
    asm volatile("s_waitcnt lgkmcnt(0)" ::: "memory");
    const int c = lane & 7;
#pragma unroll
    for (int j = 0; j < 8; ++j) {
        const int n = (lane >> 3) + 8 * j; const float* sp = scr + (8 * c) * 65 + n;
        uint4 o; o.x = pk2(sp[0 * 65], sp[1 * 65]); o.y = pk2(sp[2 * 65], sp[3 * 65]); o.z = pk2(sp[4 * 65], sp[5 * 65]); o.w = pk2(sp[6 * 65], sp[7 * 65]);
        *(uint4*)(WT + (size_t)(n0 + n) * K + k0 + 8 * c) = o;
    }
    asm volatile("s_waitcnt lgkmcnt(0)" ::: "memory");
}

namespace pg8 {
#define PG8_LAS __attribute__((address_space(3)))
typedef unsigned short bf16_t;
typedef short bf16x8 __attribute__((ext_vector_type(8)));
typedef float f32x4 __attribute__((ext_vector_type(4)));
typedef unsigned u32x4 __attribute__((ext_vector_type(4)));
constexpr int BM = 256, BK = 64, HALF = 128, HTB = HALF * BK * 2  , STAGE_BYTES = 8 * HTB, NXCD = 8, WGM = 8;

__host__ __device__ __forceinline__ int lds_byte(int r, int c) { const int st = (r >> 4) * 2 + (c >> 5), rr = r & 15, cc = c & 31, ob = rr * 64 + cc * 2; return st * 1024 + (ob ^ (((ob >> 9) & 1) << 5)); }
__host__ __device__ __forceinline__ void stage_rc(int b, int& R, int& C) { const int st = b / 1024, sb = b % 1024, swz = sb ^ (((sb >> 9) & 1) << 5); R = (st >> 1) * 16 + swz / 64; C = (st & 1) * 32 + (swz % 64) / 2; }
__host__ __device__ __forceinline__ int perm32(int rho) { const int n = rho >> 4, i = rho & 15; return 8 * (i >> 2) + 4 * n + (i & 3); }

struct Unit { int pm, pn; };
struct Gemm { const bf16_t* A; const bf16_t* Bt; int M, N, K; };

struct StaticOrder {
    int nM, nN, nwg, G, c;
    __host__ __device__ void init(int M, int N, int G_, int c_) { nM = M / BM; nN = N / BM; nwg = nM * nN; G = G_; c = c_; }
    __host__ __device__ bool next(int i, Unit& u) const {
        const long L = (long)i * G + c; if (L >= nwg) return false;
        int wgid = (int)L; { const int q = nwg / NXCD, r = nwg % NXCD, xcd = wgid % NXCD, off = wgid / NXCD; wgid = (xcd < r ? xcd * (q + 1) : r * (q + 1) + (xcd - r) * q) + off; }
        const int nig = WGM * nN, gid = wgid / nig, fm = gid * WGM, gsz = (nM - fm) < WGM ? (nM - fm) : WGM;
        u.pm = fm + ((wgid % nig) % gsz); u.pn = (wgid % nig) / gsz; return true;
    }
    __device__ __forceinline__ void a_ready(const Unit&) const {}
    __device__ __forceinline__ void done(const Unit&) const {}
};

__device__ __forceinline__ unsigned cvt_pk_bf16(float lo, float hi) { unsigned r; asm volatile("v_cvt_pk_bf16_f32 %0, %1, %2" : "=v"(r) : "v"(lo), "v"(hi)); return r; }

struct EpiBf16 {
    static constexpr bool PERM = true, AFTER_DRAIN = false;
    bf16_t* O; int ldc;
    __device__ __forceinline__ void operator()(const f32x4 (&acc)[2][2][4][2], const Unit& u, int wr, int wc, int fr, int fq) const {
        const int row0 = u.pm * BM + wr * 64 + fr, col0 = u.pn * BM + wc * 32 + 8 * fq;
#pragma unroll
        for (int ai = 0; ai < 2; ++ai)
#pragma unroll
            for (int m = 0; m < 4; ++m) { bf16_t* rowp = O + (size_t)(row0 + ai * HALF + m * 16) * ldc + col0;
#pragma unroll
                for (int bj = 0; bj < 2; ++bj) { const f32x4 v0 = acc[ai][bj][m][0], v1 = acc[ai][bj][m][1];
                    u32x4 w; w.x = cvt_pk_bf16(v0[0], v0[1]); w.y = cvt_pk_bf16(v0[2], v0[3]); w.z = cvt_pk_bf16(v1[0], v1[1]); w.w = cvt_pk_bf16(v1[2], v1[3]);
                    *(u32x4*)(rowp + bj * HALF) = w; } }
    }
};
struct EpiInProj {
    static constexpr bool PERM = true, AFTER_DRAIN = false;
    bf16_t* O; int ldc; const float* rope;
    __device__ __forceinline__ void operator()(const f32x4 (&acc)[2][2][4][2], const Unit& u, int wr, int wc, int fr, int fq) const {
        const int row0 = u.pm * BM + wr * 64 + fr, col0 = u.pn * BM + wc * 32 + 8 * fq;
        const bool do_rope = (u.pn < 8) && (u.pm < 64);
        const float qsc = (u.pn < 4) ? 0.18033688011112042f : 1.f;
        float ir0, ir1, ir2, ir3;
        { const float c = -0.8304820237218405f  , k2pi = 0.15915494309189535f;
          ir0 = __builtin_amdgcn_exp2f(c * (float)(4 * fq)) * k2pi; ir1 = __builtin_amdgcn_exp2f(c * (float)(4 * fq + 1)) * k2pi; ir2 = __builtin_amdgcn_exp2f(c * (float)(4 * fq + 2)) * k2pi; ir3 = __builtin_amdgcn_exp2f(c * (float)(4 * fq + 3)) * k2pi; }
#pragma unroll
        for (int ai = 0; ai < 2; ++ai)
#pragma unroll
            for (int m = 0; m < 4; ++m) { const int row = row0 + ai * HALF + m * 16; bf16_t* rowp = O + (size_t)row * ldc + col0;
                f32x4 cs01 = {1.f, 0.f, 1.f, 0.f}, cs23 = {1.f, 0.f, 1.f, 0.f};
                if (do_rope) { const float pos = (float)((wc & 1) ? (row & 63) : ((row >> 6) & 31));
                    cs01 = (f32x4){__builtin_amdgcn_cosf(pos * ir0), __builtin_amdgcn_sinf(pos * ir0), __builtin_amdgcn_cosf(pos * ir1), __builtin_amdgcn_sinf(pos * ir1)};
                    cs23 = (f32x4){__builtin_amdgcn_cosf(pos * ir2), __builtin_amdgcn_sinf(pos * ir2), __builtin_amdgcn_cosf(pos * ir3), __builtin_amdgcn_sinf(pos * ir3)}; }
#pragma unroll
                for (int bj = 0; bj < 2; ++bj) { f32x4 v0 = acc[ai][bj][m][0], v1 = acc[ai][bj][m][1];
                    if (do_rope) {
                        const float a0 = v0[0] * cs01[0] - v0[1] * cs01[1], a1 = v0[0] * cs01[1] + v0[1] * cs01[0];
                        const float a2 = v0[2] * cs01[2] - v0[3] * cs01[3], a3 = v0[2] * cs01[3] + v0[3] * cs01[2];
                        const float b0 = v1[0] * cs23[0] - v1[1] * cs23[1], b1 = v1[0] * cs23[1] + v1[1] * cs23[0];
                        const float b2 = v1[2] * cs23[2] - v1[3] * cs23[3], b3 = v1[2] * cs23[3] + v1[3] * cs23[2];
                        v0 = (f32x4){a0, a1, a2, a3}; v1 = (f32x4){b0, b1, b2, b3};
                    }
                    v0 = v0 * qsc; v1 = v1 * qsc;
                    u32x4 w; w.x = cvt_pk_bf16(v0[0], v0[1]); w.y = cvt_pk_bf16(v0[2], v0[3]); w.z = cvt_pk_bf16(v1[0], v1[1]); w.w = cvt_pk_bf16(v1[2], v1[3]);
                    *(u32x4*)(rowp + bj * HALF) = w; } }
    }
};

template <class Epi, class Sched, bool ALIGN_EPI = false, bool SP2 = false>
__device__ __forceinline__ void gemm_phase(PG8_LAS unsigned char* lds, const Gemm g, const Sched& S, const Epi& E) {
    const int tid = opaque_tid(), wid = __builtin_amdgcn_readfirstlane(tid >> 6), lane = tid & 63, wr = wid >> 2, wc = wid & 3, fr = lane & 15, fq = lane >> 4;
    const int K = g.K, nt = K / BK;
    unsigned voffA[2], voffB[2];
#pragma unroll
    for (int i = 0; i < 2; ++i) { int R, C; stage_rc(tid * 16 + i * 8192, R, C); const int Rb = Epi::PERM ? ((R & ~31) + perm32(R & 31)) : R;
        voffA[i] = (unsigned)(R * K + C) * 2u; voffB[i] = (unsigned)(Rb * K + C) * 2u; }
    const size_t kstep = (size_t)(BK * 2);
    const size_t hstep = (size_t)HALF * K * 2;
    const size_t tstep = 2 * hstep;
    const unsigned ldsw = (unsigned)wid * 1024u;
    const int aoff = lds_byte(wr * 64 + fr, fq * 8), boff = lds_byte(wc * 32 + fr, fq * 8);
#define PG8_SA(b, h) (((b) * 2 + (h)) * HTB)
#define PG8_SB(b, h) ((4 + (b) * 2 + (h)) * HTB)
#define PG8_STAGE(bufoff, gbase, voff) do { _Pragma("unroll") for (int _i = 0; _i < 2; ++_i) \
        __builtin_amdgcn_global_load_lds((const unsigned*)((const char*)(gbase) + (voff)[_i]), (PG8_LAS unsigned*)(lds + (bufoff) + ldsw + _i * 8192), 16, 0, 0); } while (0)
#define PG8_LDA(dst, b, h) do { _Pragma("unroll") for (int m = 0; m < 4; ++m) _Pragma("unroll") for (int k = 0; k < 2; ++k) dst[m][k] = *(const PG8_LAS bf16x8*)(lds + PG8_SA(b, h) + aoff + m * 2048 + k * 1024); } while (0)
#define PG8_LDB(dst, b, h) do { _Pragma("unroll") for (int n = 0; n < 2; ++n) _Pragma("unroll") for (int k = 0; k < 2; ++k) dst[n][k] = *(const PG8_LAS bf16x8*)(lds + PG8_SB(b, h) + boff + n * 2048 + k * 1024); } while (0)
#define PG8_MMA(ai, bj, At, Bt) do { __builtin_amdgcn_s_setprio(1); _Pragma("unroll") for (int m = 0; m < 4; ++m) _Pragma("unroll") for (int n = 0; n < 2; ++n) _Pragma("unroll") for (int k = 0; k < 2; ++k) \
        acc[ai][bj][m][n] = __builtin_amdgcn_mfma_f32_16x16x32_bf16(Bt[n][k], At[m][k], acc[ai][bj][m][n], 0, 0, 0); __builtin_amdgcn_s_setprio(0); } while (0)
#define PG8_WAIT_V(n) asm volatile("s_waitcnt vmcnt(" #n ")" ::: "memory")
#define PG8_WAIT_L(n) asm volatile("s_waitcnt lgkmcnt(" #n ")" ::: "memory")
#define PG8_BAR __builtin_amdgcn_s_barrier()
#define PG8_SCHED __builtin_amdgcn_sched_barrier(0)
    Unit cur, nxt; int ui = 0;
    if (!S.next(0, cur)) return;
    f32x4 acc[2][2][4][2];
#pragma unroll
    for (int a = 0; a < 2; ++a)
#pragma unroll
        for (int b = 0; b < 2; ++b)
#pragma unroll
            for (int m = 0; m < 4; ++m)
#pragma unroll
                for (int n = 0; n < 2; ++n) acc[a][b][m][n] = (f32x4){0.f, 0.f, 0.f, 0.f};
    bf16x8 At[4][2], B0[2][2], B1[2][2];
    const char* cA = (const char*)g.A + (size_t)cur.pm * tstep; const char* cB = (const char*)g.Bt + (size_t)cur.pn * tstep;
    S.a_ready(cur);
    if constexpr (SP2) {
        PG8_STAGE(PG8_SB(0, 0), cB, voffB); PG8_STAGE(PG8_SB(0, 1), cB + hstep, voffB); PG8_STAGE(PG8_SA(0, 0), cA, voffA); PG8_STAGE(PG8_SA(0, 1), cA + hstep, voffA);
        if (wr == 1) PG8_BAR;
        PG8_WAIT_V(2); PG8_BAR;
        PG8_STAGE(PG8_SB(1, 0), cB + kstep, voffB); PG8_STAGE(PG8_SA(1, 0), cA + kstep, voffA); PG8_STAGE(PG8_SB(1, 1), cB + hstep + kstep, voffB);
        PG8_WAIT_V(6); PG8_BAR;
    } else {
        PG8_STAGE(PG8_SB(0, 0), cB, voffB); PG8_STAGE(PG8_SA(0, 0), cA, voffA); PG8_STAGE(PG8_SB(0, 1), cB + hstep, voffB); PG8_STAGE(PG8_SA(0, 1), cA + hstep, voffA);
        if (wr == 1) PG8_BAR;
        PG8_WAIT_V(4); PG8_BAR;
        PG8_STAGE(PG8_SB(1, 0), cB + kstep, voffB); PG8_STAGE(PG8_SA(1, 0), cA + kstep, voffA); PG8_STAGE(PG8_SB(1, 1), cB + hstep + kstep, voffB);
        PG8_WAIT_V(6); PG8_BAR;
    }
    for (;;) {
        const bool has_next = S.next(ui + 1, nxt);
        const char* nA = has_next ? (const char*)g.A + (size_t)nxt.pm * tstep : cA; const char* nB = has_next ? (const char*)g.Bt + (size_t)nxt.pn * tstep : cB;
        for (int t = 0; t < nt; t += 2) {
            const bool last = (t == nt - 2);
            const char* a1 = cA + (size_t)(t + 1) * kstep;
            const char* a2 = last ? nA : cA + (size_t)(t + 2) * kstep; const char* b2 = last ? nB : cB + (size_t)(t + 2) * kstep;
            const char* a3 = a2 + kstep; const char* b3 = b2 + kstep;
            if (last && has_next) S.a_ready(nxt);
            if constexpr (SP2) {
            PG8_LDB(B0, 0, 0); PG8_LDB(B1, 0, 1); PG8_SCHED; PG8_LDA(At, 0, 0); PG8_STAGE(PG8_SA(1, 1), a1 + hstep, voffA);
            PG8_WAIT_V(8); PG8_WAIT_L(0); PG8_BAR; PG8_MMA(0, 0, At, B0); PG8_MMA(0, 1, At, B1); PG8_BAR; PG8_SCHED;
            PG8_LDA(At, 0, 1); PG8_STAGE(PG8_SB(0, 0), b2, voffB); PG8_STAGE(PG8_SB(0, 1), b2 + hstep, voffB); PG8_STAGE(PG8_SA(0, 0), a2, voffA);
            PG8_WAIT_V(8); PG8_WAIT_L(0); PG8_BAR; PG8_MMA(1, 0, At, B0); PG8_MMA(1, 1, At, B1); PG8_BAR; PG8_SCHED;
            PG8_LDB(B0, 1, 0); PG8_LDB(B1, 1, 1); PG8_SCHED; PG8_LDA(At, 1, 0); PG8_STAGE(PG8_SA(0, 1), a2 + hstep, voffA);
            PG8_WAIT_V(8); PG8_WAIT_L(0); PG8_BAR; PG8_MMA(0, 0, At, B0); PG8_MMA(0, 1, At, B1); PG8_BAR; PG8_SCHED;
            PG8_LDA(At, 1, 1); PG8_STAGE(PG8_SB(1, 0), b3, voffB); PG8_STAGE(PG8_SB(1, 1), b3 + hstep, voffB); PG8_STAGE(PG8_SA(1, 0), a3, voffA);
            PG8_WAIT_V(8); PG8_WAIT_L(0); PG8_BAR; PG8_MMA(1, 0, At, B0); PG8_MMA(1, 1, At, B1); PG8_BAR; PG8_SCHED;
            } else {
            PG8_LDB(B0, 0, 0); PG8_SCHED; PG8_LDA(At, 0, 0); PG8_STAGE(PG8_SA(1, 1), a1 + hstep, voffA);
            PG8_WAIT_L(8); PG8_BAR; PG8_WAIT_L(0); PG8_MMA(0, 0, At, B0); PG8_BAR; PG8_SCHED;
            PG8_LDB(B1, 0, 1); PG8_STAGE(PG8_SB(0, 0), b2, voffB);
            PG8_BAR; PG8_WAIT_L(0); PG8_MMA(0, 1, At, B1); PG8_BAR;
            PG8_LDA(At, 0, 1); PG8_STAGE(PG8_SA(0, 0), a2, voffA);
            PG8_BAR; PG8_WAIT_L(0); PG8_MMA(1, 0, At, B0); PG8_BAR; PG8_SCHED;
            PG8_STAGE(PG8_SB(0, 1), b2 + hstep, voffB);
            PG8_WAIT_V(6); PG8_BAR; PG8_MMA(1, 1, At, B1); PG8_BAR;
            PG8_LDB(B0, 1, 0); PG8_SCHED; PG8_LDA(At, 1, 0); PG8_STAGE(PG8_SA(0, 1), a2 + hstep, voffA);
            PG8_WAIT_L(8); PG8_BAR; PG8_WAIT_L(0); PG8_MMA(0, 0, At, B0); PG8_BAR; PG8_SCHED;
            PG8_LDB(B1, 1, 1); PG8_STAGE(PG8_SB(1, 0), b3, voffB);
            PG8_BAR; PG8_WAIT_L(0); PG8_MMA(0, 1, At, B1); PG8_BAR;
            PG8_LDA(At, 1, 1); PG8_STAGE(PG8_SA(1, 0), a3, voffA);
            PG8_BAR; PG8_WAIT_L(0); PG8_MMA(1, 0, At, B0); PG8_BAR; PG8_SCHED;
            PG8_STAGE(PG8_SB(1, 1), b3 + hstep, voffB);
            PG8_WAIT_V(6); PG8_BAR; PG8_MMA(1, 1, At, B1); PG8_BAR;
            }
        }
        if constexpr (ALIGN_EPI) { if (wr == 0) PG8_BAR; }
        if constexpr (!Epi::AFTER_DRAIN) { E(acc, cur, wr, wc, fr, fq); S.done(cur); }
        if (!has_next) break;
#pragma unroll
        for (int a = 0; a < 2; ++a)
#pragma unroll
            for (int b = 0; b < 2; ++b)
#pragma unroll
                for (int m = 0; m < 4; ++m)
#pragma unroll
                    for (int n = 0; n < 2; ++n) acc[a][b][m][n] = (f32x4){0.f, 0.f, 0.f, 0.f};
        cur = nxt; cA = nA; cB = nB; ++ui;
        if constexpr (ALIGN_EPI) { if (wr == 1) PG8_BAR; }
    }
    PG8_WAIT_V(0);
    if constexpr (!ALIGN_EPI) { if (wr == 0) PG8_BAR; }
    PG8_BAR;
    if constexpr (Epi::AFTER_DRAIN) { E.fused(acc, cur, wr, wc, fr, fq, lds, wid, lane); S.done(cur); }
#undef PG8_SA
#undef PG8_SB
#undef PG8_STAGE
#undef PG8_LDA
#undef PG8_LDB
#undef PG8_MMA
#undef PG8_WAIT_V
#undef PG8_WAIT_L
#undef PG8_BAR
#undef PG8_SCHED
}
}

namespace att {
using bf16x8 = __attribute__((ext_vector_type(8))) short;
using s16x4  = __attribute__((ext_vector_type(4))) short;
using f32x16 = __attribute__((ext_vector_type(16))) float;
using u32x4  = __attribute__((ext_vector_type(4))) unsigned;
constexpr int NW = 8, QBLK = 32, KVBLK = 64, QROWS = 128;
constexpr float SCALE = 0.125f, QPRESCALE = SCALE * 1.4426950408889634f, THRL = 24.f;
constexpr int SHM_V = KVBLK * 128 * 2, SHM_K = KVBLK * 128 * 2, SHM_ATTN = 2 * SHM_V + 2 * SHM_K + NW * 64 * 4;
#define KSWZ(row, colB) ((row) * 256 + ((colB) ^ (((row) & 7) << 4)))
#define SBAR() __builtin_amdgcn_sched_barrier(0)
__device__ __forceinline__ int crow(int r, int hi) { return (r & 3) + 8 * (r >> 2) + 4 * hi; }
__device__ __forceinline__ unsigned cvtpk(float lo, float hi) { unsigned r; asm volatile("v_cvt_pk_bf16_f32 %0, %1, %2" : "=v"(r) : "v"(lo), "v"(hi)); return r; }
__device__ __forceinline__ void qkt_lds(f32x16& p0, f32x16& p1, const char* Ks, const char* qrow  , float mh, int r32, int hi, int sub) {
#pragma unroll
  for (int r = 0; r < 16; ++r) { p0[r] = -mh; p1[r] = -mh; }
#pragma unroll
  for (int d0 = 0; d0 < 4; ++d0) { const int cb = (sub * 64 + d0 * 16 + hi * 8) * 2;
    const bf16x8 qf = *reinterpret_cast<const bf16x8*>(qrow + d0 * 32);
    const bf16x8 b0 = *reinterpret_cast<const bf16x8*>(Ks + KSWZ(r32, cb));
    const bf16x8 b1 = *reinterpret_cast<const bf16x8*>(Ks + KSWZ(32 + r32, cb));
    p0 = __builtin_amdgcn_mfma_f32_32x32x16_bf16(b0, qf, p0, 0, 0, 0);
    p1 = __builtin_amdgcn_mfma_f32_32x32x16_bf16(b1, qf, p1, 0, 0, 0); }
}
#define ATT_PK4(P, BASE, OUT) do { unsigned a0_ = cvtpk(P[BASE + 0], P[BASE + 1]), a1_ = cvtpk(P[BASE + 2], P[BASE + 3]);   \
    unsigned b0_ = cvtpk(P[BASE + 4], P[BASE + 5]), b1_ = cvtpk(P[BASE + 6], P[BASE + 7]);                              \
    auto r0_ = __builtin_amdgcn_permlane32_swap(a0_, b0_, false, false); auto r1_ = __builtin_amdgcn_permlane32_swap(a1_, b1_, false, false); \
    u32x4 w_ = {r0_[0], r1_[0], r0_[1], r1_[1]}; OUT = *reinterpret_cast<bf16x8*>(&w_); } while (0)
__device__ __forceinline__ void partialSM3(f32x16& p0, f32x16& p1, float& mhat, float& alpha, bf16x8& pa0, bf16x8& pa1, float& ps0) {
  float a = fmaxf(fmaxf(p0[0], p0[1]), p1[0]), b2 = fmaxf(fmaxf(p0[2], p0[3]), p1[1]); a = fmaxf(fmaxf(a, p1[2]), p1[3]);
#pragma unroll
  for (int r = 4; r < 16; r += 4) { a = fmaxf(fmaxf(a, p0[r]), p0[r + 1]); b2 = fmaxf(fmaxf(b2, p0[r + 2]), p0[r + 3]); a = fmaxf(fmaxf(a, p1[r]), p1[r + 1]); b2 = fmaxf(fmaxf(b2, p1[r + 2]), p1[r + 3]); }
  float rm = fmaxf(a, b2);
  { auto rr = __builtin_amdgcn_permlane32_swap(__float_as_uint(rm), __float_as_uint(rm), false, false);
    rm = fmaxf(__uint_as_float(rr[0]), __uint_as_float(rr[1])); }
  alpha = 1.f;
  if (__builtin_expect(__any(rm > THRL), 0)) {
    const float dl = fmaxf(rm, 0.f); mhat += dl;
#pragma unroll
    for (int r = 0; r < 16; ++r) { p0[r] -= dl; p1[r] -= dl; }
    alpha = __builtin_amdgcn_exp2f(-dl);
  }
  float s_ = 0.f;
#pragma unroll
  for (int r = 0; r < 16; ++r) { p0[r] = __builtin_amdgcn_exp2f(p0[r]); s_ += p0[r]; }
  ps0 = s_;
  ATT_PK4(p0, 0, pa0); ATT_PK4(p0, 8, pa1);
}
__device__ __forceinline__ void finishSM3(f32x16& p1, float alpha, float ps0, float& l_reg, bf16x8& pa2, bf16x8& pa3) {
#pragma unroll
  for (int r = 0; r < 16; ++r) p1[r] = __builtin_amdgcn_exp2f(p1[r]);
  float ps = ps0;
#pragma unroll
  for (int r = 0; r < 16; ++r) ps += p1[r];
  { auto rr = __builtin_amdgcn_permlane32_swap(__float_as_uint(ps), __float_as_uint(ps), false, false);
    ps = __uint_as_float(rr[0]) + __uint_as_float(rr[1]); }
  l_reg = l_reg * alpha + ps;
  ATT_PK4(p1, 0, pa2); ATT_PK4(p1, 8, pa3);
}
__device__ __forceinline__ int v_st(int k, int c) { const int kk = (k & ~0xC) | ((k & 4) << 1) | ((k & 8) >> 1); return ((kk >> 3) * 4 + (c >> 5)) * 512 + ((kk & 7) * 32 + (c & 31)) * 2; }
__device__ __forceinline__ int v_rd_base(int lane) { return ((lane & 3) << 3) | (((lane >> 2) & 3) << 6) | (((lane >> 4) & 1) << 5) | (((lane >> 5) & 1) << 8); }
constexpr int v_rd_off(int d0, int ks, int half) { return d0 * 512 + ks * 4096 + half * 2048; }
template <int OFF> __device__ __forceinline__ s16x4 tr_read(int vb) {
  s16x4 r; asm volatile("ds_read_b64_tr_b16 %0, %1 offset:%2" : "=&v"(r) : "v"(vb), "i"(OFF) : "memory"); return r;
}
template <int D0> __device__ __forceinline__ void pv_one(f32x16& od, int vb, bf16x8 pa0, bf16x8 pa1, bf16x8 pa2, bf16x8 pa3) {
  const s16x4 l0 = tr_read<v_rd_off(D0, 0, 0)>(vb), h0 = tr_read<v_rd_off(D0, 0, 1)>(vb), l1 = tr_read<v_rd_off(D0, 1, 0)>(vb), h1 = tr_read<v_rd_off(D0, 1, 1)>(vb);
  const s16x4 l2 = tr_read<v_rd_off(D0, 2, 0)>(vb), h2 = tr_read<v_rd_off(D0, 2, 1)>(vb), l3 = tr_read<v_rd_off(D0, 3, 0)>(vb), h3 = tr_read<v_rd_off(D0, 3, 1)>(vb);
  asm volatile("s_waitcnt lgkmcnt(0)" ::: "memory"); SBAR();
#define PK(L, H) (bf16x8){L[0], L[1], L[2], L[3], H[0], H[1], H[2], H[3]}
  od = __builtin_amdgcn_mfma_f32_32x32x16_bf16(pa0, PK(l0, h0), od, 0, 0, 0);
  od = __builtin_amdgcn_mfma_f32_32x32x16_bf16(pa1, PK(l1, h1), od, 0, 0, 0);
  od = __builtin_amdgcn_mfma_f32_32x32x16_bf16(pa2, PK(l2, h2), od, 0, 0, 0);
  od = __builtin_amdgcn_mfma_f32_32x32x16_bf16(pa3, PK(l3, h3), od, 0, 0, 0);
#undef PK
}
__device__ __forceinline__ void pv_d0(f32x16* o, int vb, bf16x8 pa0, bf16x8 pa1, bf16x8 pa2, bf16x8 pa3) {
  pv_one<0>(o[0], vb, pa0, pa1, pa2, pa3); pv_one<1>(o[1], vb, pa0, pa1, pa2, pa3); pv_one<2>(o[2], vb, pa0, pa1, pa2, pa3); pv_one<3>(o[3], vb, pa0, pa1, pa2, pa3);
}
__device__ __forceinline__ long ktile_row(int b, int t) { return t < 4 ? (long)(NLAT + b * CTXL + 64 * t) : (long)(b * SEQ + 64 * (t - 4)); }

__device__ __forceinline__ void ld_tile8(u32x4 (&v)[8], const bf16_t* base  , int lane) {
  const unsigned long long sb = uniform_ptr(base);
  const int v0 = ((lane >> 4) * NP + (lane & 15) * 8) * 2, st = 4 * NP * 2;
  asm volatile("s_nop 4\n\tglobal_load_dwordx4 %0, %8, %16\n\tglobal_load_dwordx4 %1, %9, %16\n\tglobal_load_dwordx4 %2, %10, %16\n\tglobal_load_dwordx4 %3, %11, %16\n\t"
               "global_load_dwordx4 %4, %12, %16\n\tglobal_load_dwordx4 %5, %13, %16\n\tglobal_load_dwordx4 %6, %14, %16\n\tglobal_load_dwordx4 %7, %15, %16\n\ts_waitcnt vmcnt(0)"
               : "=&v"(v[0]), "=&v"(v[1]), "=&v"(v[2]), "=&v"(v[3]), "=&v"(v[4]), "=&v"(v[5]), "=&v"(v[6]), "=&v"(v[7])
               : "v"(v0), "v"(v0 + st), "v"(v0 + 2 * st), "v"(v0 + 3 * st), "v"(v0 + 4 * st), "v"(v0 + 5 * st), "v"(v0 + 6 * st), "v"(v0 + 7 * st), "s"(sb) : "memory");
}
constexpr int QROWS2 = 256, QT_ROWB = 272, QT_OFF = 2 * SHM_V + 2 * SHM_K + NW * 64 * 4, SHM_ATTN2 = QT_OFF + NW * 32 * QT_ROWB;
static_assert(SHM_ATTN2 <= LDS_PHASE_BYTES, "attention LDS map");
__device__ __forceinline__ void attn_unit2(const bf16_t* __restrict__ Pm, bf16_t* __restrict__ Y, long qrow0, int b, int hh, int NT, float lam, float lam_init,
                                           const float* __restrict__ subln, char* lds) {
  const int tid = opaque_tid(), wid = __builtin_amdgcn_readfirstlane(tid >> 6), lane = tid & 63, r32 = lane & 31, hi = lane >> 5;
  char* V_lds = lds; char* K_lds = lds + 2 * SHM_V;
  float* ws = (float*)(lds + 2 * SHM_V + 2 * SHM_K) + wid * 64; float* li_l = ws; float* al_l = ws + 32;
  char* qt = lds + QT_OFF + wid * (32 * QT_ROWB);
  const long wrow0 = qrow0 + wid * QBLK;
  float mh0 = 0.f, mh1 = 0.f, l0 = 0.f, l1 = 0.f; f32x16 o0[4] = {}, o1[4] = {};
  const int vb0 = (int)(uintptr_t)V_lds + v_rd_base(lane);
  const bool late = wid >= 4;
  const unsigned ldsb = (unsigned)(uintptr_t)lds + (unsigned)(wid * 2048);
  unsigned kof0, vof0;
  { const int sl = wid * 128 + lane, krow = sl >> 4, kch = (sl & 15) ^ (krow & 7);
    const int kk = (sl >> 7) * 8 + ((sl & 31) >> 2), vc = ((sl >> 5) & 3) * 32 + (sl & 3) * 8, vk = (kk & ~0xC) | ((kk & 4) << 1) | ((kk & 8) >> 1);
    kof0 = (unsigned)((krow * NP + C_KA + kch * 8) * 2); vof0 = (unsigned)((vk * NP + C_VA + vc) * 2); }
#define SDMA(t, bb) do { const char* tb_ = (const char*)(Pm + ktile_row(b, (t)) * NP + hh * 128); \
    __builtin_amdgcn_global_load_lds((const unsigned*)(tb_ + vof0), (__attribute__((address_space(3))) unsigned*)(ldsb + (unsigned)((bb) * SHM_V)), 16, 0, 0); \
    __builtin_amdgcn_global_load_lds((const unsigned*)(tb_ + kof0), (__attribute__((address_space(3))) unsigned*)(ldsb + (unsigned)(2 * SHM_V + (bb) * SHM_K)), 16, 0, 0); \
    __builtin_amdgcn_global_load_lds((const unsigned*)(tb_ + (vof0 + 128u)), (__attribute__((address_space(3))) unsigned*)(ldsb + (unsigned)((bb) * SHM_V + 1024)), 16, 0, 0); \
    __builtin_amdgcn_global_load_lds((const unsigned*)(tb_ + ((kof0 ^ 64u) + (unsigned)(4 * NP * 2))), (__attribute__((address_space(3))) unsigned*)(ldsb + (unsigned)(2 * SHM_V + (bb) * SHM_K + 1024)), 16, 0, 0); } while (0)
#define RESC(o, a) do { if (__any((a) < 1.f)) { if (hi == 0) al_l[r32] = (a); asm volatile("s_waitcnt lgkmcnt(0)" ::: "memory"); \
    _Pragma("unroll") for (int r = 0; r < 16; ++r) { const float f_ = al_l[crow(r, hi)]; _Pragma("unroll") for (int d = 0; d < 4; ++d) o[d][r] *= f_; asm volatile("" ::: "memory"); } } } while (0)
  f32x16 pA1, pB1; float alA, alB, psA, psB; bf16x8 aA0, aA1, aB0, aB1, pa2, pa3;
  const char* qA = qt + r32 * QT_ROWB + (hi * 8) * 2;
#define qB (qA + 128)
  SDMA(0, 0);
  { u32x4 qv[8]; ld_tile8(qv, Pm + wrow0 * NP + C_QA + hh * 128, lane);
#pragma unroll
    for (int c8 = 0; c8 < 8; ++c8) { const int row = c8 * 4 + (lane >> 4), ch = lane & 15; *(u32x4*)(qt + row * QT_ROWB + ch * 16) = qv[c8]; } }
  asm volatile("s_waitcnt vmcnt(0)" ::: "memory"); __syncthreads();
  { f32x16 t0; SBAR(); qkt_lds(t0, pA1, K_lds, qA, mh0, r32, hi, 0); partialSM3(t0, pA1, mh0, alA, aA0, aA1, psA); SBAR(); }
  if (1 < NT) SDMA(1, 1);
  { f32x16 t0; SBAR(); qkt_lds(t0, pB1, K_lds, qB, mh1, r32, hi, 1); finishSM3(pA1, alA, psA, l0, pa2, pa3); SBAR();
    pv_d0(o0, vb0, aA0, aA1, pa2, pa3); partialSM3(t0, pB1, mh1, alB, aB0, aB1, psB); SBAR(); }
  asm volatile("s_waitcnt vmcnt(0)" ::: "memory"); __syncthreads();
  for (int t = 1; t < NT; ++t) {
    const int cur = t & 1, prev = cur ^ 1;
    { f32x16 t0; SBAR(); qkt_lds(t0, pA1, K_lds + cur * SHM_K, qA, mh0, r32, hi, 0); RESC(o1, alB); finishSM3(pB1, alB, psB, l1, pa2, pa3); SBAR();
      pv_d0(o1, vb0 + prev * SHM_V, aB0, aB1, pa2, pa3); partialSM3(t0, pA1, mh0, alA, aA0, aA1, psA); SBAR(); }
    __syncthreads();
    if (t + 1 < NT) SDMA(t + 1, prev);
    if (late) __builtin_amdgcn_s_sleep(4);
    RESC(o0, alA);
    { f32x16 t0; SBAR(); qkt_lds(t0, pB1, K_lds + cur * SHM_K, qB, mh1, r32, hi, 1); finishSM3(pA1, alA, psA, l0, pa2, pa3); SBAR();
      pv_d0(o0, vb0 + cur * SHM_V, aA0, aA1, pa2, pa3); partialSM3(t0, pB1, mh1, alB, aB0, aB1, psB); SBAR(); }
    asm volatile("s_waitcnt vmcnt(0)" ::: "memory"); __syncthreads();
    if (late) __builtin_amdgcn_s_sleep(4);
  }
  { const char* gb_ = (const char*)(Pm + wrow0 * NP + C_GA + hh * 128); const unsigned qtb = (unsigned)(uintptr_t)qt; int lg = lane; asm volatile("" : "+v"(lg));
    const unsigned go = (unsigned)(((lg >> 4) * NP + (lg & 15) * 8) * 2);
#pragma unroll
    for (int c8 = 0; c8 < 8; ++c8)
      __builtin_amdgcn_global_load_lds((const unsigned*)(gb_ + (go + (unsigned)(c8 * 4 * NP * 2))), (__attribute__((address_space(3))) unsigned*)(qtb + (unsigned)(c8 * 1024)), 16, 0, 0); }
  RESC(o1, alB); finishSM3(pB1, alB, psB, l1, pa2, pa3); SBAR();
  pv_d0(o1, vb0 + ((NT - 1) & 1) * SHM_V, aB0, aB1, pa2, pa3);
  if (hi == 0) { li_l[r32] = l0; al_l[r32] = l1; } asm volatile("s_waitcnt lgkmcnt(0)" ::: "memory");
  float ss[16];
#pragma unroll
  for (int r = 0; r < 16; ++r) { const float ra = __builtin_amdgcn_rcpf(li_l[crow(r, hi)]), rb = lam * __builtin_amdgcn_rcpf(al_l[crow(r, hi)]); float a = 0.f;
#pragma unroll
    for (int d0 = 0; d0 < 4; ++d0) { o0[d0][r] = o0[d0][r] * ra - o1[d0][r] * rb; a += o0[d0][r] * o0[d0][r]; }
    ss[r] = a; }
#pragma unroll
  for (int r = 0; r < 16; ++r) {
    ss[r] = rsqrtf(half_sum(ss[r], hi) * (1.f / 128.f) + EPS) * (1.f - lam_init);
  }
  float sw[4];
#pragma unroll
  for (int d0 = 0; d0 < 4; ++d0) sw[d0] = subln[d0 * 32 + r32];
  asm volatile("s_waitcnt vmcnt(0) lgkmcnt(0)" ::: "memory");
#pragma unroll
  for (int r = 0; r < 16; ++r) { bf16_t* tp = (bf16_t*)(qt + crow(r, hi) * 256) + r32;
#pragma unroll
    for (int d0 = 0; d0 < 4; ++d0) { const float g = bf2f(tp[d0 * 32]); tp[d0 * 32] = f2bf(o0[d0][r] * ss[r] * sw[d0] * silu_f(g)); } }
  asm volatile("s_waitcnt lgkmcnt(0)" ::: "memory");
#pragma unroll
  for (int c8 = 0; c8 < 8; ++c8) { const int row = c8 * 4 + (lane >> 4), ch = lane & 15;
    *(uint4*)(Y + (wrow0 + row) * DM + hh * 128 + ch * 8) = *(const uint4*)(qt + row * 256 + ch * 16); }
  asm volatile("s_waitcnt lgkmcnt(0)" ::: "memory");
#undef SDMA
#undef RESC
#undef qB
}
#undef KSWZ
#undef SBAR
}

DEVI void mod_unit(int unit, const float* __restrict__ c, const float* __restrict__ c_ctx, const float* __restrict__ w_ada, const float* __restrict__ b_ada, float* __restrict__ MOD, float* ldsf);
namespace mls {
using bf16x8 = __attribute__((ext_vector_type(8))) short;
using s16x4  = __attribute__((ext_vector_type(4))) short;
using f32x4  = __attribute__((ext_vector_type(4))) float;
constexpr int QSTRB = 272, SSTRB = 144;
constexpr int VSTRB = 528;
constexpr int L_Q = 0, L_K = L_Q + 64 * QSTRB, L_V = L_K + 64 * QSTRB, L_S = L_V + 64 * VSTRB, L_CT = L_S + 64 * SSTRB, L_SM = L_CT + 256 * QSTRB, L_END = L_SM + 8192;
static_assert(L_END <= LDS_PHASE_BYTES && (L_K % 16) == 0 && (L_V % 16) == 0 && (L_S % 16) == 0 && (L_CT % 16) == 0 && (L_SM % 16) == 0, "mlstm LDS map");
__device__ __forceinline__ f32x4 mfma16(bf16x8 a, bf16x8 b, f32x4 c) { return __builtin_amdgcn_mfma_f32_16x16x32_bf16(a, b, c, 0, 0, 0); }
struct TrPair { s16x4 lo, hi; };
__device__ __forceinline__ bf16x8 tr_pack(const TrPair& t) { return (bf16x8){t.lo[0], t.lo[1], t.lo[2], t.lo[3], t.hi[0], t.hi[1], t.hi[2], t.hi[3]}; }
__device__ __forceinline__ float wave_scan_incl(float v) {
  v += __builtin_bit_cast(float, __builtin_amdgcn_update_dpp(0, __builtin_bit_cast(int, v), 0x111, 0xF, 0xF, false));
  v += __builtin_bit_cast(float, __builtin_amdgcn_update_dpp(0, __builtin_bit_cast(int, v), 0x112, 0xF, 0xF, false));
  v += __builtin_bit_cast(float, __builtin_amdgcn_update_dpp(0, __builtin_bit_cast(int, v), 0x114, 0xF, 0xF, false));
  v += __builtin_bit_cast(float, __builtin_amdgcn_update_dpp(0, __builtin_bit_cast(int, v), 0x118, 0xF, 0xF, false));
  v += __builtin_bit_cast(float, __builtin_amdgcn_update_dpp(0, __builtin_bit_cast(int, v), 0x142, 0xA, 0xF, false));
  v += __builtin_bit_cast(float, __builtin_amdgcn_update_dpp(0, __builtin_bit_cast(int, v), 0x143, 0xC, 0xF, false));
  return v;
}
__device__ __forceinline__ float fast_tanh(float x) { return 1.f - 2.f * __builtin_amdgcn_rcpf(1.f + __expf(2.f * x)); }

__device__ __forceinline__ void tr_v4(unsigned base, TrPair& a0, TrPair& a1, TrPair& b0, TrPair& b1, TrPair& c0, TrPair& c1, TrPair& d0, TrPair& d1) {
  asm volatile(
    "ds_read_b64_tr_b16 %0, %16\n\tds_read_b64_tr_b16 %1, %16 offset:2112\n\tds_read_b64_tr_b16 %2, %16 offset:16896\n\tds_read_b64_tr_b16 %3, %16 offset:19008\n\t"
    "ds_read_b64_tr_b16 %4, %16 offset:32\n\tds_read_b64_tr_b16 %5, %16 offset:2144\n\tds_read_b64_tr_b16 %6, %16 offset:16928\n\tds_read_b64_tr_b16 %7, %16 offset:19040\n\t"
    "ds_read_b64_tr_b16 %8, %16 offset:64\n\tds_read_b64_tr_b16 %9, %16 offset:2176\n\tds_read_b64_tr_b16 %10, %16 offset:16960\n\tds_read_b64_tr_b16 %11, %16 offset:19072\n\t"
    "ds_read_b64_tr_b16 %12, %16 offset:96\n\tds_read_b64_tr_b16 %13, %16 offset:2208\n\tds_read_b64_tr_b16 %14, %16 offset:16992\n\tds_read_b64_tr_b16 %15, %16 offset:19104\n\t"
    "s_waitcnt lgkmcnt(0)"
    : "=&v"(a0.lo), "=&v"(a0.hi), "=&v"(a1.lo), "=&v"(a1.hi), "=&v"(b0.lo), "=&v"(b0.hi), "=&v"(b1.lo), "=&v"(b1.hi),
      "=&v"(c0.lo), "=&v"(c0.hi), "=&v"(c1.lo), "=&v"(c1.hi), "=&v"(d0.lo), "=&v"(d0.hi), "=&v"(d1.lo), "=&v"(d1.hi)
    : "v"(base) : "memory");
}
__device__ __forceinline__ bf16x8 scale_frag(const TrPair& t, const float4 wa, const float4 wb) {
  const float f0 = bf2f((bf16_t)t.lo[0]) * wa.x, f1 = bf2f((bf16_t)t.lo[1]) * wa.y, f2 = bf2f((bf16_t)t.lo[2]) * wa.z, f3 = bf2f((bf16_t)t.lo[3]) * wa.w;
  const float f4 = bf2f((bf16_t)t.hi[0]) * wb.x, f5 = bf2f((bf16_t)t.hi[1]) * wb.y, f6 = bf2f((bf16_t)t.hi[2]) * wb.z, f7 = bf2f((bf16_t)t.hi[3]) * wb.w;
  return __builtin_bit_cast(bf16x8, make_uint4(pk2(f0, f1), pk2(f2, f3), pk2(f4, f5), pk2(f6, f7)));
}

__device__ __forceinline__ void mlstm_unit(const bf16_t* __restrict__ Pm, const bf16_t* __restrict__ QKC  , const float* __restrict__ GATES,
                                           bf16_t* __restrict__ HM, const float* __restrict__ i_bias, const float* __restrict__ f_bias,
                                           int b, int head, int dir, bool ctx_out, unsigned* mdone, char* lds) {
  const int tid = opaque_tid(), wid = __builtin_amdgcn_readfirstlane(tid >> 6), lane = tid & 63, lr = lane & 15, kg = lane >> 4;
  char* q_lds = lds + L_Q; char* k_lds = lds + L_K; char* v_lds = lds + L_V; char* s_lds = lds + L_S; char* ct_lds = lds + L_CT;
  float* bl = (float*)(lds + L_SM); float* bsp = bl + 64; float* av = bsp + 64; float* wkl = av + 64; float* qn = wkl + 64; float* nvec = qn + 64; float* rs = nvec + 128; float* npart = rs + 1024;
  const unsigned lds0 = (unsigned)(uintptr_t)lds;
  const unsigned trq = (unsigned)((8 * kg + (lr >> 2)) * QSTRB + (4 * (lr & 3)) * 2), trv = (unsigned)((8 * kg + (lr >> 2)) * VSTRB + (4 * (lr & 3)) * 2);
  if (tid < 128) nvec[tid] = 0.f;
  const float ibias = i_bias[dir * 4 + head], fbias = f_bias[dir * 4 + head];
  const int chg = tid & 31, rg = tid >> 5; const bool isk = chg >= 16;
  const int qkcol = 1024 + (isk ? 512 : 0) + head * 128 + (chg & 15) * 8;
  const int vrow = tid >> 3, vch = tid & 7;
  uint4 pq0, pq1, pq2, pq3, pv0, pv1, pv2, pv3; float pgi, pgf;
#define MLS_LOAD(c_) do { const int c__ = (c_); const bool ic_ = c__ < 4; const int T_ = ic_ ? CTXL : SEQ, cc_ = ic_ ? c__ : c__ - 4; \
    const long rb_ = ic_ ? (long)(NLAT + b * CTXL) : (long)b * SEQ; const int t0_ = dir ? (T_ - 64 * (cc_ + 1)) : 64 * cc_; \
    { const bf16_t* qp_ = QKC + (rb_ + t0_ + rg) * DM + qkcol; pq0 = *(const uint4*)qp_; pq1 = *(const uint4*)(qp_ + 16 * DM); pq2 = *(const uint4*)(qp_ + 32 * DM); pq3 = *(const uint4*)(qp_ + 48 * DM); } \
    { const uint4* vp_ = (const uint4*)(Pm + (rb_ + t0_ + vrow) * NP + C_VB + head * 256 + vch * 32); pv0 = vp_[0]; pv1 = vp_[1]; pv2 = vp_[2]; pv3 = vp_[3]; } \
    const float* gr_ = GATES + (rb_ + t0_ + (dir ? 63 - lane : lane)) * 16; pgi = gr_[dir * 4 + head]; pgf = gr_[8 + dir * 4 + head]; } while (0)
  MLS_LOAD(0);
  f32x4 Cacc[16];
#pragma unroll
  for (int e = 0; e < 16; ++e) Cacc[e] = (f32x4){0.f, 0.f, 0.f, 0.f};
  float gprev = 0.f;
  __syncthreads();
  for (int c = 0; c < 36; ++c) {
    const bool isctx = c < 4; const int T = isctx ? CTXL : SEQ, cc = isctx ? c : c - 4;
    const long rowbase = isctx ? (long)(NLAT + b * CTXL) : (long)b * SEQ;
    const int t0 = dir ? (T - 64 * (cc + 1)) : 64 * cc;
    const bool need_h = ctx_out || !isctx;
    float gamma, wk_l;
    {
      const float igv = 15.f * fast_tanh((pgi + ibias) * (1.f / 15.f));
      const float fc = 15.f * fast_tanh((pgf + fbias) * (1.f / 15.f));
      const float lfv = fminf(fc, 0.f) - __logf(1.f + __expf(-fabsf(fc)));
      const float bcum = wave_scan_incl(lfv);
      const float b63 = __builtin_bit_cast(float, __builtin_amdgcn_readlane(__builtin_bit_cast(int, bcum), 63));
      gamma = __expf(b63); wk_l = __expf(b63 - bcum + igv);
      if (wid == 0) { bl[lane] = bcum; bsp[lane] = bcum - igv; av[lane] = __expf(bcum); wkl[lane] = wk_l; }
      if (c > 0 && tid < 128) nvec[tid] = gprev * nvec[tid] + (npart[tid] + npart[128 + tid]) + (npart[256 + tid] + npart[384 + tid]);
    }
#pragma unroll
    for (int eblk = 0; eblk < 16; ++eblk) { uint2 w_; w_.x = pk2(Cacc[eblk][0], Cacc[eblk][1]); w_.y = pk2(Cacc[eblk][2], Cacc[eblk][3]);
      *(uint2*)(ct_lds + (eblk * 16 + lr) * QSTRB + (wid * 16 + 4 * kg) * 2) = w_; }
    { char* dst = (isk ? k_lds : q_lds) + (chg & 15) * 16;
      *(uint4*)(dst + (dir ? 63 - rg : rg) * QSTRB) = pq0; *(uint4*)(dst + (dir ? 47 - rg : rg + 16) * QSTRB) = pq1;
      *(uint4*)(dst + (dir ? 31 - rg : rg + 32) * QSTRB) = pq2; *(uint4*)(dst + (dir ? 15 - rg : rg + 48) * QSTRB) = pq3; }
    { char* dst = v_lds + (dir ? 63 - vrow : vrow) * VSTRB + vch * 64;
      *(uint4*)dst = pv0; *(uint4*)(dst + 16) = pv1; *(uint4*)(dst + 32) = pv2; *(uint4*)(dst + 48) = pv3; }
    if (c + 1 < 36) MLS_LOAD(c + 1);
    __syncthreads();
    if (need_h) {
      const int lblk = wid >> 1;
#pragma unroll
      for (int u2 = 0; u2 < 2; ++u2) {
        const int sblk = 2 * (wid & 1) + u2;
        if (sblk <= lblk) {
          f32x4 acc = {0.f, 0.f, 0.f, 0.f};
#pragma unroll
          for (int ks = 0; ks < 4; ++ks) {
            const bf16x8 ka = *(const bf16x8*)(k_lds + (sblk * 16 + lr) * QSTRB + (ks * 32 + 8 * kg) * 2);
            const bf16x8 qb = *(const bf16x8*)(q_lds + (lblk * 16 + lr) * QSTRB + (ks * 32 + 8 * kg) * 2);
            acc = mfma16(ka, qb, acc);
          }
          const int l = lblk * 16 + lr; const float blv = bl[l];
          float v4[4]; float sum = 0.f;
#pragma unroll
          for (int r = 0; r < 4; ++r) { const int sidx = sblk * 16 + 4 * kg + r; const float w = (sidx <= l) ? __expf(blv - bsp[sidx]) : 0.f; v4[r] = acc[r] * w; sum += v4[r]; }
          uint2 w; w.x = pk2(v4[0], v4[1]); w.y = pk2(v4[2], v4[3]);
          *(uint2*)(s_lds + l * SSTRB + (sblk * 16 + 4 * kg) * 2) = w;
          rs[(sblk * 4 + kg) * 64 + l] = sum;
        } else if ((lblk == 0 && sblk == 1) || (lblk == 2 && sblk == 3)) {
          uint2 z_; z_.x = 0u; z_.y = 0u; asm volatile("" : "+v"(z_.x), "+v"(z_.y));
          *(uint2*)(s_lds + (lblk * 16 + lr) * SSTRB + (sblk * 16 + 4 * kg) * 2) = z_;
        }
      }
      { const int l = tid >> 3, part = tid & 7; float a = 0.f;
        const unsigned* qp = (const unsigned*)(q_lds + l * QSTRB + part * 32);
#pragma unroll
        for (int i = 0; i < 8; ++i) { const unsigned wd = qp[i]; a += __uint_as_float(wd << 16) * nvec[part * 16 + 2 * i] + __uint_as_float(wd & 0xffff0000u) * nvec[part * 16 + 2 * i + 1]; }
        a += __builtin_bit_cast(float, __builtin_amdgcn_update_dpp(0, __builtin_bit_cast(int, a), 0xB1, 0xF, 0xF, false));
        a += __builtin_bit_cast(float, __builtin_amdgcn_update_dpp(0, __builtin_bit_cast(int, a), 0x4E, 0xF, 0xF, false));
        a += __builtin_bit_cast(float, __builtin_amdgcn_update_dpp(0, __builtin_bit_cast(int, a), 0x141, 0xF, 0xF, false));
        if (part == 0) qn[l] = a; }
    }
    __syncthreads();
    if (need_h) {
      const int lblk = wid >> 1, l = lblk * 16 + lr, eh = wid & 1;
      float d = av[l] * qn[l];
      for (int sb = 0; sb <= lblk; ++sb) d += (rs[(sb * 4 + 0) * 64 + l] + rs[(sb * 4 + 1) * 64 + l]) + (rs[(sb * 4 + 2) * 64 + l] + rs[(sb * 4 + 3) * 64 + l]);
      const float a_l = av[l], dinv = 1.f / fmaxf(fabsf(d), 1.f);
      bf16x8 qb[4];
#pragma unroll
      for (int ks = 0; ks < 4; ++ks) qb[ks] = *(const bf16x8*)(q_lds + l * QSTRB + (ks * 32 + 8 * kg) * 2);
      const bf16x8 sb0 = *(const bf16x8*)(s_lds + l * SSTRB + (8 * kg) * 2);
      bf16x8 sb1 = sb0; if (lblk >= 2) sb1 = *(const bf16x8*)(s_lds + l * SSTRB + (32 + 8 * kg) * 2);
      const int t = dir ? (t0 + 63 - l) : (t0 + l);
      bf16_t* hp = HM + ((size_t)dir * NTOK + rowbase + t) * 1024 + head * 256 + eh * 128 + 4 * kg;
#pragma unroll
      for (int half = 0; half < 2; ++half) {
        TrPair a0, a1, b0, b1, c0, c1, d0, d1;
        tr_v4(lds0 + L_V + trv + (unsigned)((eh * 8 + half * 4) * 32), a0, a1, b0, b1, c0, c1, d0, d1);
        __builtin_amdgcn_sched_barrier(0);
#define MLS_HTILE(ti, VA0, VA1) do { const int eblk = eh * 8 + half * 4 + (ti); f32x4 acc1 = {0.f, 0.f, 0.f, 0.f}, acc2 = {0.f, 0.f, 0.f, 0.f}; \
          _Pragma("unroll") for (int ks = 0; ks < 4; ++ks) { const bf16x8 ca = *(const bf16x8*)(ct_lds + (eblk * 16 + lr) * QSTRB + (ks * 32 + 8 * kg) * 2); acc1 = mfma16(ca, qb[ks], acc1); } \
          acc2 = mfma16(tr_pack(VA0), sb0, acc2); if (lblk >= 2) acc2 = mfma16(tr_pack(VA1), sb1, acc2); \
          uint2 w_; w_.x = pk2((a_l * acc1[0] + acc2[0]) * dinv, (a_l * acc1[1] + acc2[1]) * dinv); w_.y = pk2((a_l * acc1[2] + acc2[2]) * dinv, (a_l * acc1[3] + acc2[3]) * dinv); \
          *(uint2*)(hp + (half * 4 + (ti)) * 16) = w_; } while (0)
        MLS_HTILE(0, a0, a1); MLS_HTILE(1, b0, b1); MLS_HTILE(2, c0, c1); MLS_HTILE(3, d0, d1);
#undef MLS_HTILE
      }
    }
    {
      bf16x8 kA0, kA1;
      { TrPair ka0, ka1; const unsigned ak = lds0 + L_K + trq + (unsigned)(wid * 32);
        asm volatile("ds_read_b64_tr_b16 %0, %4\n\tds_read_b64_tr_b16 %1, %4 offset:1088\n\tds_read_b64_tr_b16 %2, %4 offset:8704\n\tds_read_b64_tr_b16 %3, %4 offset:9792\n\ts_waitcnt lgkmcnt(0)"
                     : "=&v"(ka0.lo), "=&v"(ka0.hi), "=&v"(ka1.lo), "=&v"(ka1.hi) : "v"(ak) : "memory");
        const float4 w0 = *(const float4*)(wkl + 8 * kg), w1 = *(const float4*)(wkl + 8 * kg + 4), w2 = *(const float4*)(wkl + 32 + 8 * kg), w3 = *(const float4*)(wkl + 36 + 8 * kg);
        kA0 = scale_frag(ka0, w0, w1); kA1 = scale_frag(ka1, w2, w3); }
#pragma unroll
      for (int q4 = 0; q4 < 4; ++q4) {
        TrPair a0, a1, b0, b1, c0, c1, d0, d1;
        tr_v4(lds0 + L_V + trv + (unsigned)(q4 * 128), a0, a1, b0, b1, c0, c1, d0, d1);
        __builtin_amdgcn_sched_barrier(0);
#define MLS_CUPD(ti, V0, V1) do { f32x4 cc_ = Cacc[q4 * 4 + (ti)] * gamma; cc_ = mfma16(kA0, tr_pack(V0), cc_); cc_ = mfma16(kA1, tr_pack(V1), cc_); Cacc[q4 * 4 + (ti)] = cc_; } while (0)
        MLS_CUPD(0, a0, a1); MLS_CUPD(1, b0, b1); MLS_CUPD(2, c0, c1); MLS_CUPD(3, d0, d1);
#undef MLS_CUPD
      }
      { const int dd = tid & 127, sq = tid >> 7; float a = 0.f; const bf16_t* kp = (const bf16_t*)k_lds + (sq * 16) * (QSTRB / 2) + dd;
#pragma unroll
        for (int si = 0; si < 16; ++si) a += bf2f(kp[si * (QSTRB / 2)]) * wkl[sq * 16 + si];
        npart[sq * 128 + dd] = a; }
      gprev = gamma;
    }
    __syncthreads();
  }
#undef MLS_LOAD
  asm volatile("s_waitcnt vmcnt(0)" ::: "memory");
  __syncthreads();
  if (tid == 0) { __builtin_amdgcn_fence(__ATOMIC_RELEASE, "agent"); asm volatile("s_waitcnt vmcnt(0)" ::: "memory"); __hip_atomic_fetch_add(mdone + 64 * b, 1u, __ATOMIC_RELAXED, __HIP_MEMORY_SCOPE_AGENT); }
}
__device__ __forceinline__ void qkconv_phase(const bf16_t* __restrict__ Pm, bf16_t* __restrict__ QKC, const float* __restrict__ conv_w, const float* __restrict__ conv_b) {
  const int tid = opaque_tid(), lane = tid & 63, wave = tid >> 6;
  const int gw = blockIdx.x * 8 + wave, ngw = gridDim.x * 8;
  const int half = gw & 1, c0 = half * 512 + lane * 8;
  float cw0[8], cw1[8], cw2[8], cbv[8];
#pragma unroll
  for (int i = 0; i < 8; ++i) { cw0[i] = conv_w[c0 + i]; cw1[i] = conv_w[1024 + c0 + i]; cw2[i] = conv_w[2048 + c0 + i]; cbv[i] = conv_b[c0 + i]; }
  const float osc = half ? 0.08838834764831845f : 1.f;
  for (int it = gw >> 1; it < NTOK / 8; it += ngw >> 1) {
    const int r0 = it * 8; const bool isl = r0 < NLAT; const int seq0 = isl ? (r0 / SEQ) * SEQ : NLAT + ((r0 - NLAT) / CTXL) * CTXL, T = isl ? SEQ : CTXL;
    uint4 x[10];
#pragma unroll
    for (int r = 0; r < 10; ++r) { const int t = r0 - seq0 - 1 + r; x[r] = (t >= 0 && t < T) ? *(const uint4*)(Pm + (size_t)(seq0 + t) * NP + C_QB + c0) : make_uint4(0u, 0u, 0u, 0u); }
#pragma unroll
    for (int r = 0; r < 8; ++r) {
      const unsigned a0[4] = {x[r].x, x[r].y, x[r].z, x[r].w}, a1[4] = {x[r + 1].x, x[r + 1].y, x[r + 1].z, x[r + 1].w}, a2[4] = {x[r + 2].x, x[r + 2].y, x[r + 2].z, x[r + 2].w};
      float o[8];
#pragma unroll
      for (int i = 0; i < 8; ++i) {
        const float v0 = (i & 1) ? __uint_as_float(a0[i >> 1] & 0xffff0000u) : __uint_as_float(a0[i >> 1] << 16);
        const float v1 = (i & 1) ? __uint_as_float(a1[i >> 1] & 0xffff0000u) : __uint_as_float(a1[i >> 1] << 16);
        const float v2 = (i & 1) ? __uint_as_float(a2[i >> 1] & 0xffff0000u) : __uint_as_float(a2[i >> 1] << 16);
        const float z = cbv[i] + cw0[i] * v0 + cw1[i] * v1 + cw2[i] * v2;
        o[i] = osc * silu_f(z);
      }
      uint4 w; w.x = pk2(o[0], o[1]); w.y = pk2(o[2], o[3]); w.z = pk2(o[4], o[5]); w.w = pk2(o[6], o[7]);
      *(uint4*)(QKC + (size_t)(r0 + r) * DM + 1024 + c0) = w;
    }
  }
}
__device__ __forceinline__ void mlstm_phase(const bf16_t* __restrict__ Pm, const bf16_t* __restrict__ QKC, const float* __restrict__ GATES, bf16_t* __restrict__ HM,
                                            const float* __restrict__ i_bias, const float* __restrict__ f_bias, bool ctx_out, unsigned* mdone, char* lds) {
  const int G = gridDim.x, bx = blockIdx.x;
  if (G == 256) { const int vcu = (bx % 8) * 32 + bx / 8; if ((vcu & 31) < 8) { const int u = (vcu >> 5) * 8 + (vcu & 31); mlstm_unit(Pm, QKC, GATES, HM, i_bias, f_bias, u >> 3, (u >> 1) & 3, u & 1, ctx_out, mdone, lds);
      {
        KArgP A = kargs(); const int lyr = ctx_out ? 0 : 1;
        const int t2 = opaque_tid(); const float* w_out = A->in[9] + (size_t)lyr * DM * DM; bf16_t* WOUT = (bf16_t*)(A->ws + WS_WOUT) + (size_t)lyr * DM * DM;
        for (int it = u * 8 + (t2 >> 6); it < 1024; it += 512) transpose_item(w_out, DM, DM, DM, WOUT, (float*)lds + (t2 >> 6) * (64 * 65), it, t2 & 63);
        __syncthreads();
      } } }
  else for (int u = bx; u < 64; u += G) mlstm_unit(Pm, QKC, GATES, HM, i_bias, f_bias, u >> 3, (u >> 1) & 3, u & 1, ctx_out, mdone, lds);
}
}

DEVI void mod_unit(int unit, const float* __restrict__ c, const float* __restrict__ c_ctx, const float* __restrict__ w_ada, const float* __restrict__ b_ada, float* __restrict__ MOD, float* ldsf) {
    const int tid = opaque_tid(), lane = tid & 63, wv = tid >> 6;
    const int l = unit / 96, rem = unit % 96, cb = rem >> 2, kq = rem & 3;
    float* sc = ldsf; float* red = ldsf + 9 * 512;
    for (int i = tid; i < 9 * 512; i += 512) { const int r = i >> 9, k = kq * 512 + (i & 511); const float v = (r < 8) ? c[r * DM + k] : c_ctx[k]; sc[i] = silu_f(v); }
    __syncthreads();
    float4 acc[9];
#pragma unroll
    for (int r = 0; r < 9; ++r) acc[r] = make_float4(0.f, 0.f, 0.f, 0.f);
    const float* wb = w_ada + (size_t)l * DM * MODW + (size_t)(kq * 512 + wv * 64) * MODW + cb * 256;
    unsigned vo[8];
#pragma unroll
    for (int j = 0; j < 8; ++j) vo[j] = (unsigned)(lane * 16 + j * (MODW * 4));
#pragma unroll 1
    for (int k0 = 0; k0 < 64; k0 += 16) {
        f4v_t wr[16];
        ld16_wait(wr, vo, uniform_ptr(wb + (size_t)k0 * MODW), uniform_ptr(wb + (size_t)(k0 + 8) * MODW));
#pragma unroll
        for (int j = 0; j < 16; ++j) { const f4v_t wvv = wr[j];
#pragma unroll
            for (int r = 0; r < 9; ++r) { const float s_ = sc[r * 512 + wv * 64 + k0 + j]; acc[r].x += s_ * wvv[0]; acc[r].y += s_ * wvv[1]; acc[r].z += s_ * wvv[2]; acc[r].w += s_ * wvv[3]; } }
    }
#pragma unroll
    for (int r = 0; r < 9; ++r) ((float4*)red)[(wv * 9 + r) * 64 + lane] = acc[r];
    __syncthreads();
    for (int idx = tid; idx < 9 * 256; idx += 512) {
        const int r = idx >> 8, cc = idx & 255; float s_ = (kq == 0) ? b_ada[l * MODW + cb * 256 + cc] : 0.f;
#pragma unroll
        for (int g = 0; g < 8; ++g) s_ += red[(g * 9 + r) * 256 + cc];
        atomicAdd(MOD + (size_t)(l * 9 + r) * MODW + cb * 256 + cc, s_);
    }
    __syncthreads();
}
DEVI void transpose_items(const float* __restrict__ W, int ldw, int K, int N, bf16_t* __restrict__ WT, float* scr, int gw, int ngw, int lane) {
    const int nitems = (K / 64) * (N / 64);
    for (int it = gw; it < nitems; it += ngw) transpose_item(W, ldw, K, N, WT, scr, it, lane);
}
DEVI void finish_row(const bf16_t* __restrict__ P, const bf16_t* __restrict__ HM, const float* __restrict__ mnorm, bf16_t* __restrict__ Y, int row, int lane) {
#pragma unroll
    for (int head = 0; head < 4; ++head) {
        const int col = head * 256 + 4 * lane;
        const uint2 a = *(const uint2*)(HM + (size_t)row * 1024 + col), c = *(const uint2*)(HM + ((size_t)NTOK + row) * 1024 + col);
        float h[4];
        h[0] = __uint_as_float(a.x << 16) + __uint_as_float(c.x << 16); h[1] = __uint_as_float(a.x & 0xffff0000u) + __uint_as_float(c.x & 0xffff0000u);
        h[2] = __uint_as_float(a.y << 16) + __uint_as_float(c.y << 16); h[3] = __uint_as_float(a.y & 0xffff0000u) + __uint_as_float(c.y & 0xffff0000u);
        const float ss = wave_sum(h[0] * h[0] + h[1] * h[1] + h[2] * h[2] + h[3] * h[3]);
        const float r = rsqrtf(ss * (1.f / 256.f) + EPS);
        const uint2 ov = *(const uint2*)(P + (size_t)row * NP + C_OB + col), gv = *(const uint2*)(P + (size_t)row * NP + C_GB + col);
        const float o[4] = {__uint_as_float(ov.x << 16), __uint_as_float(ov.x & 0xffff0000u), __uint_as_float(ov.y << 16), __uint_as_float(ov.y & 0xffff0000u)};
        const float g[4] = {__uint_as_float(gv.x << 16), __uint_as_float(gv.x & 0xffff0000u), __uint_as_float(gv.y << 16), __uint_as_float(gv.y & 0xffff0000u)};
        const float4 w = *(const float4*)(mnorm + col);
        const float wv[4] = {w.x, w.y, w.z, w.w};
        float y[4];
#pragma unroll
        for (int e = 0; e < 4; ++e) y[e] = h[e] * r * wv[e] * sigmoid_f(o[e]) * silu_f(g[e]);
        uint2 out; out.x = pk2(y[0], y[1]); out.y = pk2(y[2], y[3]);
        *(uint2*)(Y + (size_t)row * DM + 1024 + col) = out;
    }
}
DEVI void load_row(const float* __restrict__ xr, float4 (&v)[8], int lane) {
#pragma unroll
    for (int j = 0; j < 8; ++j) v[j] = ((const float4*)xr)[lane + 64 * j];
}
DEVI void load_row_y(const bf16_t* __restrict__ yr, uint2 (&yv)[8], int lane) {
#pragma unroll
    for (int j = 0; j < 8; ++j) yv[j] = *(const uint2*)(yr + 4 * (lane + 64 * j));
}
DEVI void post_regs(float4 (&v)[8], const uint2 (&yv)[8], const float* gate, const float* npost, float* __restrict__ orow, int lane) {
    float ss = 0.f;
#pragma unroll
    for (int j = 0; j < 8; ++j) {
        const float y0 = __uint_as_float(yv[j].x << 16), y1 = __uint_as_float(yv[j].x & 0xffff0000u), y2 = __uint_as_float(yv[j].y << 16), y3 = __uint_as_float(yv[j].y & 0xffff0000u);
        ss += y0 * y0 + y1 * y1 + y2 * y2 + y3 * y3;
    }
    ss = wave_sum(ss);
    const float rstd = rsqrtf(ss * (1.f / DM) + EPS);
#pragma unroll
    for (int j = 0; j < 8; ++j) {
        const float4 gt = ((const float4*)gate)[lane + 64 * j], w = ((const float4*)npost)[lane + 64 * j];
        const float y0 = __uint_as_float(yv[j].x << 16), y1 = __uint_as_float(yv[j].x & 0xffff0000u), y2 = __uint_as_float(yv[j].y << 16), y3 = __uint_as_float(yv[j].y & 0xffff0000u);
        v[j].x += gt.x * (y0 * rstd * w.x); v[j].y += gt.y * (y1 * rstd * w.y); v[j].z += gt.z * (y2 * rstd * w.z); v[j].w += gt.w * (y3 * rstd * w.w);
        ((float4*)orow)[lane + 64 * j] = v[j];
        if (j == 3) asm volatile("" ::: "memory");
    }
}
DEVI void norm_regs(const float4 (&v)[8], const float* shift, const float* scale, const float* npre, bf16_t* __restrict__ hrow, char* trow, int lane) {
    float ss = 0.f;
#pragma unroll
    for (int j = 0; j < 8; ++j) ss += v[j].x * v[j].x + v[j].y * v[j].y + v[j].z * v[j].z + v[j].w * v[j].w;
    ss = wave_sum(ss);
    const float rstd = rsqrtf(ss * (1.f / DM) + EPS);
#pragma unroll
    for (int j = 0; j < 8; ++j) {
        const float4 w = ((const float4*)npre)[lane + 64 * j], sh = ((const float4*)shift)[lane + 64 * j], sc = ((const float4*)scale)[lane + 64 * j];
        uint2 o;
        o.x = pk2(v[j].x * rstd * w.x * (1.f + sc.x) + sh.x, v[j].y * rstd * w.y * (1.f + sc.y) + sh.y);
        o.y = pk2(v[j].z * rstd * w.z * (1.f + sc.z) + sh.z, v[j].w * rstd * w.w * (1.f + sc.w) + sh.w);
        *(uint2*)(hrow + 4 * (lane + 64 * j)) = o; *(uint2*)(trow + 8 * (lane + 64 * j)) = o;
        if (j == 3) asm volatile("" ::: "memory");
    }
}
constexpr int NT_ROWB = (DM + 8) * 2;
constexpr int NV_OFF = 0, NT_OFF = 5 * DM * 4, NR_OFF = NT_OFF + 16 * NT_ROWB, NPH_LDS = NR_OFF + 8 * 16 * 16 * 4;
static_assert(NPH_LDS <= LDS_PHASE_BYTES, "norm phase LDS map");
template <bool POST>
DEVI void norm_phase(const float* __restrict__ xlat, const float* __restrict__ xctx, const bf16_t* __restrict__ Y2, const float* __restrict__ mod_post, const float* __restrict__ npost,
                     float* olat, float* octx, const float* __restrict__ mod_n, const float* __restrict__ npre, const bf16_t* __restrict__ wgt, bf16_t* __restrict__ H,
                     float* __restrict__ GATES, char* lds) {
    typedef short bf16x8 __attribute__((ext_vector_type(8))); typedef float f32x4 __attribute__((ext_vector_type(4)));
    const int tid = opaque_tid(), lane = tid & 63, wave = __builtin_amdgcn_readfirstlane(tid >> 6), lr = lane & 15, kgp = lane >> 4;
    float* vec = (float*)(lds + NV_OFF); float* v_npre = vec; float* v_shift = vec + DM; float* v_scale = vec + 2 * DM; float* v_npost = vec + 3 * DM; float* v_gate = vec + 4 * DM;
    char* tile = lds + NT_OFF; float* red = (float*)(lds + NR_OFF);
    ((float4*)v_npre)[tid] = ((const float4*)npre)[tid];
    if (POST) ((float4*)v_npost)[tid] = ((const float4*)npost)[tid];
    int cur_b = -1;
#define NP_ENSURE(bb) do { if ((bb) != cur_b) { __syncthreads(); const float* mn_ = mod_n + (size_t)(bb) * MODW; ((float4*)v_shift)[tid] = ((const float4*)mn_)[tid]; ((float4*)v_scale)[tid] = ((const float4*)(mn_ + DM))[tid]; \
        if (POST) ((float4*)v_gate)[tid] = ((const float4*)(mod_post + (size_t)(bb) * MODW + 2 * DM))[tid]; cur_b = (bb); __syncthreads(); } } while (0)
    const int row0 = (int)blockIdx.x * (NTOK / 256);
    for (int g = 0; g < 5; ++g) {
        const int gr0 = row0 + 16 * g; const bool two = g < 4;
        const int rowA = gr0 + wave, rowB = gr0 + 8 + wave;
        const bool islA = rowA < NLAT, islB = rowB < NLAT; const int bA = gr0 < NLAT ? gr0 / SEQ : 8, bB = (gr0 + 8) < NLAT ? (gr0 + 8) / SEQ : 8;
        float4 vA[8], vB[8]; uint2 yA[8], yB[8];
        load_row(islA ? xlat + (size_t)rowA * DM : xctx + (size_t)(rowA - NLAT) * DM, vA, lane);
        if (POST) load_row_y(Y2 + (size_t)rowA * DM, yA, lane);
        if (two) { load_row(islB ? xlat + (size_t)rowB * DM : xctx + (size_t)(rowB - NLAT) * DM, vB, lane); if (POST) load_row_y(Y2 + (size_t)rowB * DM, yB, lane); }
        NP_ENSURE(bA);
        if (POST) post_regs(vA, yA, v_gate, v_npost, islA ? olat + (size_t)rowA * DM : octx + (size_t)(rowA - NLAT) * DM, lane);
        norm_regs(vA, v_shift, v_scale, v_npre, H + (size_t)rowA * DM, tile + wave * NT_ROWB, lane);
        if (two) {
            NP_ENSURE(bB);
            if (POST) post_regs(vB, yB, v_gate, v_npost, islB ? olat + (size_t)rowB * DM : octx + (size_t)(rowB - NLAT) * DM, lane);
            norm_regs(vB, v_shift, v_scale, v_npre, H + (size_t)rowB * DM, tile + (8 + wave) * NT_ROWB, lane);
        }
        __syncthreads();
        f32x4 acc = {0.f, 0.f, 0.f, 0.f};
        {
            f4v_t bfr[8]; unsigned vo[8];
#pragma unroll
            for (int ks = 0; ks < 8; ++ks) vo[ks] = (unsigned)((lr * DM + wave * 256 + ks * 32 + 8 * kgp) * 2);
            ld8_wait(bfr, vo, uniform_ptr(wgt));
#pragma unroll
            for (int ks = 0; ks < 8; ++ks) {
                const bf16x8 af = *(const bf16x8*)(tile + lr * NT_ROWB + (wave * 256 + ks * 32 + 8 * kgp) * 2);
                acc = __builtin_amdgcn_mfma_f32_16x16x32_bf16(af, __builtin_bit_cast(bf16x8, bfr[ks]), acc, 0, 0, 0);
            }
        }
#pragma unroll
        for (int r = 0; r < 4; ++r) red[(wave * 16 + 4 * kgp + r) * 16 + lr] = acc[r];
        __syncthreads();
        if (tid < 256) { const int rr = tid >> 4, cc = tid & 15;
            if (two || rr < 8) { float sum = 0.f;
#pragma unroll
                for (int w8 = 0; w8 < 8; ++w8) sum += red[(w8 * 16 + rr) * 16 + cc];
                GATES[(size_t)(gr0 + rr) * 16 + cc] = sum; } }
    }
#undef NP_ENSURE
    __syncthreads();
}
DEVI void post_phase_final(float* out, const bf16_t* __restrict__ Y2, const float* __restrict__ mod_l, const float* __restrict__ npost, char* lds) {
    const int tid = opaque_tid(), lane = tid & 63, wave = tid >> 6;
    float* v_gate = (float*)lds; float* v_npost = v_gate + DM;
    const int row0 = (int)blockIdx.x * (NLAT / 256), b = row0 / SEQ;
    ((float4*)v_gate)[tid] = ((const float4*)(mod_l + (size_t)b * MODW + 2 * DM))[tid];
    ((float4*)v_npost)[tid] = ((const float4*)npost)[tid];
    __syncthreads();
    float4 vA[8], vB[8]; uint2 yA[8], yB[8];
    const int r0 = row0 + wave * 8;
    load_row(out + (size_t)r0 * DM, vA, lane); load_row_y(Y2 + (size_t)r0 * DM, yA, lane);
    load_row(out + (size_t)(r0 + 1) * DM, vB, lane); load_row_y(Y2 + (size_t)(r0 + 1) * DM, yB, lane);
#pragma unroll 1
    for (int i = 0; i < 4; ++i) {
        const int ra = r0 + 2 * i, rb = ra + 1;
        post_regs(vA, yA, v_gate, v_npost, out + (size_t)ra * DM, lane);
        if (i < 3) { load_row(out + (size_t)(ra + 2) * DM, vA, lane); load_row_y(Y2 + (size_t)(ra + 2) * DM, yA, lane); }
        post_regs(vB, yB, v_gate, v_npost, out + (size_t)rb * DM, lane);
        if (i < 3) { load_row(out + (size_t)(rb + 2) * DM, vB, lane); load_row_y(Y2 + (size_t)(rb + 2) * DM, yB, lane); }
    }
    __syncthreads();
}

DEVI void mixer_queue(const bf16_t* __restrict__ Pm, bf16_t* __restrict__ Y, const bf16_t* __restrict__ HM, const float* lq1, const float* lk1, const float* lq2, const float* lk2,
                      const float* __restrict__ subln, const float* __restrict__ mnorm, float lam_init, bool ctx_out, unsigned* qcnt  ,
                      unsigned* mdone  , volatile __attribute__((address_space(3))) unsigned* bcast, char* lds) {
  const int tid = opaque_tid(), lane = tid & 63;
  const float lam = rl_f(expf(wave_sum(lq1[lane] * lk1[lane])) - expf(wave_sum(lq2[lane] * lk2[lane])) + lam_init, 0);
  const int G = gridDim.x, bx = blockIdx.x; const int vcu = (G % 8 == 0) ? (bx % 8) * (G / 8) + bx / 8 : bx;
  const int g0 = (G == 256) ? (vcu >> 5) : (bx & 7);
  const int natt = 64 + (ctx_out ? 8 : 0), nun = natt + 32 + (ctx_out ? 4 : 0);
  for (int gi = 0; gi < 8; ++gi) {
    const int g = (g0 + gi) & 7;
    for (;;) {
      if (opaque_tid() == 0) bcast[0] = __hip_atomic_fetch_add(qcnt + 64 * g, 1u, __ATOMIC_RELAXED, __HIP_MEMORY_SCOPE_AGENT);
      __syncthreads();
      const int u = (int)bcast[0];
      __syncthreads();
      if (u >= nun) break;
      if (u < 64) { const int bh = g * 8 + (u >> 3), qb = u & 7, b = bh >> 3, hh = bh & 7; att::attn_unit2(Pm, Y, (long)b * SEQ + qb * att::QROWS2, b, hh, 36, lam, lam_init, subln, lds); }
      else if (u < natt) { const int bh = g * 8 + (u - 64), b = bh >> 3, hh = bh & 7; att::attn_unit2(Pm, Y, (long)NLAT + b * CTXL, b, hh, 4, lam, lam_init, subln, lds); }
      else {
        const int f = u - natt; const int row0 = f < 32 ? g * SEQ + f * 64 : NLAT + g * CTXL + (f - 32) * 64;
        if (opaque_tid() == 0) {
          unsigned spins = 0;
          while (__hip_atomic_load(mdone + 64 * g, __ATOMIC_RELAXED, __HIP_MEMORY_SCOPE_AGENT) < 8u) { __builtin_amdgcn_s_sleep(8); if (++spins > (1u << 22)) break; }
          __builtin_amdgcn_fence(__ATOMIC_ACQUIRE, "agent");
          asm volatile("s_waitcnt vmcnt(0)" ::: "memory");
        }
        __syncthreads();
        const int tid2 = opaque_tid();
#pragma unroll 1
        for (int r = 0; r < 8; ++r) finish_row(Pm, HM, mnorm, Y, row0 + (tid2 >> 6) * 8 + r, tid2 & 63);
      }
    }
  }
}

#define XB_TMO      128
#define XB_XCNT(j)  (256  + 64 * (j))
#define XB_XSUB(j)  (1280 + 64 * (j))
#define XB_XGEN(j)  (2304 + 64 * (j))
#define XB_TOP      3328
#define XB_TOPGEN   3392
#define XCD_BAR_WORDS 3456
#define XB_SPIN_CAP (1u << 18)

__device__ __forceinline__ unsigned xb_ld(unsigned* p)              { return __hip_atomic_load(p, __ATOMIC_RELAXED, __HIP_MEMORY_SCOPE_AGENT); }
__device__ __forceinline__ unsigned xb_add(unsigned* p, unsigned v) { return __hip_atomic_fetch_add(p, v, __ATOMIC_RELAXED, __HIP_MEMORY_SCOPE_AGENT); }
__device__ __forceinline__ unsigned xb_xcc_id() { return (unsigned)__builtin_amdgcn_s_getreg((3 << 11) | 20) & 0xFu; }
#define XB_SPIN(cond, bar) do { unsigned _sp = 0; while (cond) { __builtin_amdgcn_s_sleep(1); \
    if ((++_sp & 255u) == 0u) { if (xb_ld(&(bar)[XB_TMO])) break; if (_sp > XB_SPIN_CAP) { atomicAdd(&(bar)[XB_TMO], 1u); break; } } } } while (0)

struct XcdBarrier {
    unsigned* bar; unsigned x;
    volatile __attribute__((address_space(3))) unsigned* st;
};

__device__ __forceinline__ XcdBarrier xcd_barrier_post(unsigned* bar, volatile __attribute__((address_space(3))) unsigned* st) {
    XcdBarrier b; b.bar = bar; b.x = xb_xcc_id(); b.st = st;
    if (threadIdx.x == 0) (void)xb_add(&bar[XB_XCNT(b.x)], 1u);
    return b;
}
__device__ __forceinline__ void xcd_barrier_complete(unsigned* bar, unsigned x, unsigned& nloc, unsigned& nx) {
    const unsigned G = gridDim.x * gridDim.y * gridDim.z;
    unsigned sum, cnt, mine, sp = 0u;
    for (;;) {
        sum = 0u; cnt = 0u; mine = 0u;
#pragma unroll
        for (unsigned j = 0; j < 16; ++j) { const unsigned c = xb_ld(&bar[XB_XCNT(j)]); sum += c; cnt += (c > 0u) ? 1u : 0u; mine = (j == x) ? c : mine; }
        if (sum == G) break;
        __builtin_amdgcn_s_sleep(1);
        if ((++sp & 255u) == 0u) { if (xb_ld(&bar[XB_TMO])) break; if (sp > XB_SPIN_CAP) { atomicAdd(&bar[XB_TMO], 1u); break; } }
    }
    nloc = mine > 0u ? mine : 1u; nx = cnt > 0u ? cnt : 1u;
}

__device__ __forceinline__ void xcd_barrier(const XcdBarrier& b) {
    asm volatile("s_waitcnt vmcnt(0)" ::: "memory");
    __syncthreads();
    if (threadIdx.x == 0) {
        unsigned* bar = b.bar;
        __builtin_amdgcn_s_waitcnt(0);
        unsigned nloc = b.st[0], nx = b.st[1];
        if (nloc == 0u) { xcd_barrier_complete(bar, b.x, nloc, nx); b.st[0] = nloc; b.st[1] = nx; }
        const unsigned old = xb_add(&bar[XB_XSUB(b.x)], 1u);
        const unsigned gen = old / nloc;
        if (old + 1u == (gen + 1u) * nloc) {
            __builtin_amdgcn_fence(__ATOMIC_RELEASE, "agent");
            asm volatile("s_waitcnt vmcnt(0)" ::: "memory");
            const unsigned og = xb_add(&bar[XB_TOP], 1u);
            const unsigned tg = og / nx;
            if (og + 1u == (tg + 1u) * nx) xb_add(&bar[XB_TOPGEN], 1u);
            else XB_SPIN(xb_ld(&bar[XB_TOPGEN]) == tg, bar);
            __builtin_amdgcn_fence(__ATOMIC_ACQUIRE, "agent");
            xb_add(&bar[XB_XGEN(b.x)], 1u);
            asm volatile("s_waitcnt vmcnt(0)" ::: "memory");
        } else {
            XB_SPIN(xb_ld(&bar[XB_XGEN(b.x)]) == gen, bar);
            __builtin_amdgcn_fence(__ATOMIC_ACQUIRE, "agent");
            asm volatile("s_waitcnt vmcnt(0)" ::: "memory");
        }
    }
    __syncthreads();
}

namespace cg = cooperative_groups;
constexpr int MEGA_LDS = LDS_PHASE_BYTES + 256;
#define LAS3 __attribute__((address_space(3)))
__global__ __launch_bounds__(512, 2) void mega_fwd(MegaArgs a_unused) {
    (void)a_unused;
    extern __shared__ __attribute__((aligned(16))) unsigned char lds[];
    cg::grid_group grid = cg::this_grid();
    { volatile LAS3 unsigned* MISC = (volatile LAS3 unsigned*)((LAS3 unsigned char*)lds + LDS_PHASE_BYTES);
      if (threadIdx.x < 64) MISC[threadIdx.x] = 0u;
      __syncthreads();
      if ((threadIdx.x & 63) == 0) ((volatile LAS3 unsigned char*)MISC)[128 + ((unsigned)__builtin_amdgcn_s_getreg((5 << 11) | 4) & 63u)] = (unsigned char)(threadIdx.x >> 6);
      __syncthreads();
      (void)xcd_barrier_post((unsigned*)(kargs()->ws + WS_CTL) + 4096, MISC + 8); }
#define GRID_BAR() do { XcdBarrier b_; b_.bar = (unsigned*)(kargs()->ws + WS_CTL) + 4096; b_.x = xb_xcc_id(); b_.st = (volatile LAS3 unsigned*)((LAS3 unsigned char*)lds + LDS_PHASE_BYTES) + 8; xcd_barrier(b_); } while (0)
#define PHASE_IDS const int G = gridDim.x; const int tid = opaque_tid(), lane = tid & 63, wave = tid >> 6, gw = blockIdx.x * 8 + wave, ngw = G * 8; (void)tid; (void)lane; (void)gw; (void)ngw; float* scr = (float*)lds + wave * (64 * 65); (void)scr
#define WSP(T, off) ((T*)(A->ws + (off)))

    { PHASE_IDS; KArgP A = kargs();
      const float* w_in = A->in[8]; const float* w_out = A->in[9]; bf16_t* WIN = WSP(bf16_t, WS_WIN); bf16_t* WOUT = WSP(bf16_t, WS_WOUT); float* ROPE = WSP(float, WS_ROPE);
      const bool dfr = (G == 256);
      for (int u = blockIdx.x; u < (dfr ? 96 : 192); u += G) mod_unit(u, A->in[1], A->in[3], A->in[4], A->in[5], WSP(float, WS_MOD), (float*)lds);
      { bf16_t* WGT = WSP(bf16_t, WS_WGT); for (int i = blockIdx.x * 512 + tid; i < 2 * 16 * DM; i += G * 512) { const int l_ = i >> 15, k_ = (i >> 4) & (DM - 1), c_ = i & 15; WGT[(l_ * 16 + c_) * DM + k_] = f2bf(w_in[(size_t)l_ * DM * INC + (size_t)k_ * INC + NP + c_]); } }
      for (int i = blockIdx.x * 512 + tid; i < 1024; i += G * 512) { const int pos = i >> 4, f = i & 15; const float inv = powf(10000.f, -(float)f / 16.f); const float ang = (float)pos * inv;
          ROPE[2 * i] = cosf(ang); ROPE[2 * i + 1] = sinf(ang); }
      if (dfr) {
          if ((int)blockIdx.x >= 96) for (int it = gw - 96 * 8; it < 4096; it += 160 * 8) transpose_item(w_in, INC, DM, NP, WIN, scr, it, lane);
      } else {
          for (int it = gw; it < 6144; it += ngw) {
              if (it < 4096) transpose_item(w_in, INC, DM, NP, WIN, scr, it, lane);
              else if (it < 5120) transpose_item(w_out, DM, DM, DM, WOUT, scr, it - 4096, lane);
              else transpose_item(w_out + (size_t)DM * DM, DM, DM, DM, WOUT + (size_t)DM * DM, scr, it - 5120, lane);
          }
      } }
    if (gridDim.x > 65536u) grid.sync();
    GRID_BAR();
    { KArgP A = kargs();
      norm_phase<false>(A->in[0], A->in[2], nullptr, nullptr, nullptr, nullptr, nullptr, WSP(float, WS_MOD), A->in[6], WSP(bf16_t, WS_WGT), WSP(bf16_t, WS_H), WSP(float, WS_GATES), (char*)lds); }
    GRID_BAR();
    for (int l = 0; l < 2; ++l) {
        { KArgP A = kargs();
          pg8::Gemm g{WSP(bf16_t, WS_H), WSP(bf16_t, WS_WIN), NTOK, NP, DM}; pg8::StaticOrder S; S.init(NTOK, NP, (int)gridDim.x, (int)blockIdx.x); pg8::EpiInProj E{WSP(bf16_t, WS_P), NP, WSP(float, WS_ROPE)};
          pg8::gemm_phase<pg8::EpiInProj, pg8::StaticOrder, true, true>((PG8_LAS unsigned char*)lds, g, S, E); }
        GRID_BAR();
        { KArgP A = kargs(); mls::qkconv_phase(WSP(bf16_t, WS_P), WSP(bf16_t, WS_H), A->in[15] + (size_t)l * 3 * 1024, A->in[16] + l * 1024); }
        GRID_BAR();
        { KArgP A = kargs(); mls::mlstm_phase(WSP(bf16_t, WS_P), WSP(bf16_t, WS_H), WSP(float, WS_GATES), WSP(bf16_t, WS_HM), A->in[17] + l * 8, A->in[18] + l * 8, l == 0, WSP(unsigned, WS_CTL) + 12288 + l * 512, (char*)lds); }
        { KArgP A = kargs(); const float lam_init = l == 0 ? 0.2f : 0.35550906759f;
          mixer_queue(WSP(bf16_t, WS_P), WSP(bf16_t, WS_H), WSP(bf16_t, WS_HM), A->in[10] + l * 64, A->in[11] + l * 64, A->in[12] + l * 64, A->in[13] + l * 64, A->in[14] + l * 128, A->in[19] + l * 1024, lam_init, l == 0,
                      WSP(unsigned, WS_CTL) + 8192 + l * 512, WSP(unsigned, WS_CTL) + 12288 + l * 512, (volatile LAS3 unsigned*)((LAS3 unsigned char*)lds + LDS_PHASE_BYTES) + 16, (char*)lds); }
        GRID_BAR();
        { KArgP A = kargs(); const int M = l == 0 ? NTOK : NLAT;
          pg8::Gemm g{WSP(bf16_t, WS_H), WSP(bf16_t, WS_WOUT) + (size_t)l * DM * DM, M, DM, DM}; pg8::StaticOrder S; S.init(M, DM, (int)gridDim.x, (int)blockIdx.x); pg8::EpiBf16 E{WSP(bf16_t, WS_HM), DM};
          pg8::gemm_phase<pg8::EpiBf16, pg8::StaticOrder, true, true>((PG8_LAS unsigned char*)lds, g, S, E); }
        if (l == 0) { PHASE_IDS; KArgP A = kargs(); const float* w_in1 = A->in[8] + (size_t)DM * INC; bf16_t* WIN = WSP(bf16_t, WS_WIN);
            const int nbusy = (NTOK / 256) * (DM / 256) - 2 * G;
            if (nbusy >= 0 && nbusy < G) { if ((int)blockIdx.x >= nbusy) { const int ib = (int)blockIdx.x - nbusy, nidle = G - nbusy;
                    if (G == 256 && nidle == 192) { if (ib < 96) mod_unit(96 + ib, A->in[1], A->in[3], A->in[4], A->in[5], WSP(float, WS_MOD), (float*)lds);
                                                    else transpose_items(w_in1, INC, DM, NP, WIN, scr, (ib - 96) * 8 + wave, 96 * 8, lane); }
                    else transpose_items(w_in1, INC, DM, NP, WIN, scr, ib * 8 + wave, nidle * 8, lane); } }
            else transpose_items(w_in1, INC, DM, NP, WIN, scr, gw, ngw, lane);
        }
        GRID_BAR();
        if (l == 0) {
            { KArgP A = kargs(); float* MOD = WSP(float, WS_MOD);
              norm_phase<true>(A->in[0], A->in[2], WSP(bf16_t, WS_HM), MOD, A->in[7], A->out, WSP(float, WS_XC), MOD + (size_t)9 * MODW, A->in[6] + DM, WSP(bf16_t, WS_WGT) + 16 * DM, WSP(bf16_t, WS_H), WSP(float, WS_GATES), (char*)lds); }
            GRID_BAR();
        } else { KArgP A = kargs(); post_phase_final(A->out, WSP(bf16_t, WS_HM), WSP(float, WS_MOD) + (size_t)9 * MODW, A->in[7] + DM, (char*)lds);
        }
    }
}

extern "C" void kernel_launch(void* const* d_in, const int* in_sizes, int n_in, void* d_out, int out_size, void* d_ws, size_t ws_size, hipStream_t stream) {
    (void)in_sizes; (void)n_in; (void)out_size; (void)ws_size;
    static int grid_blocks = 0;
    if (!grid_blocks) {
        int dev = 0, cus = 0, per_cu = 0;
        (void)hipGetDevice(&dev);
        (void)hipDeviceGetAttribute(&cus, hipDeviceAttributeMultiprocessorCount, dev);
        (void)hipFuncSetAttribute((const void*)mega_fwd, hipFuncAttributeMaxDynamicSharedMemorySize, MEGA_LDS);
        (void)hipOccupancyMaxActiveBlocksPerMultiprocessor(&per_cu, (const void*)mega_fwd, 512, MEGA_LDS);
        if (per_cu < 1) per_cu = 1;
        if (per_cu > 1) per_cu = 1;
        grid_blocks = cus * per_cu;
    }
    (void)hipMemsetAsync((char*)d_ws + WS_CTL, 0, WS_MOD + (size_t)2 * 9 * MODW * 4, stream);
    MegaArgs a{};
    for (int i = 0; i < 20; ++i) a.in[i] = (const float*)d_in[i];
    a.out = (float*)d_out; a.ws = (unsigned char*)d_ws;
    void* args[] = {&a};
    (void)hipLaunchCooperativeKernel((const void*)mega_fwd, dim3(grid_blocks), dim3(512), args, (size_t)MEGA_LDS, stream);
}
```

```cpp
#include <hip/hip_runtime.h>
#include <hip/hip_cooperative_groups.h>
#include <stdint.h>
#include <math.h>

#define DEVI __device__ __forceinline__
constexpr int LDS_PHASE_BYTES = 155648;
typedef unsigned short bf16_t;

constexpr int DM = 2048, NBATCH = 8, SEQ = 2048, CTXL = 256;
constexpr int NLAT = NBATCH * SEQ, NCTX = NBATCH * CTXL, NTOK = NLAT + NCTX;
constexpr int INC = 8208, NP = 8192, MODW = 6144;
constexpr int C_QA = 0, C_KA = 1024, C_VA = 2048, C_GA = 3072, C_QB = 4096, C_KB = 4608, C_VB = 5120, C_OB = 6144, C_GB = 7168;
constexpr float EPS = 1e-6f;

constexpr size_t MiB = (size_t)1 << 20;
constexpr size_t WS_CTL = 0, WS_MOD = 1 * MiB, WS_SC = WS_MOD + 512 * 1024, WS_ROPE = 2 * MiB, WS_WGT = 2 * MiB + 65536  , WS_GATES = 3 * MiB, WS_WOUT = 8 * MiB,
                 WS_WIN = 24 * MiB, WS_XC = 56 * MiB, WS_H = 72 * MiB, WS_HM = 144 * MiB, WS_P = 216 * MiB, WS_END = 504 * MiB;

DEVI int opaque_tid() {
    const unsigned hw = (unsigned)__builtin_amdgcn_s_getreg((5 << 11) | 4) & 63u;
    const unsigned w = *((const volatile __attribute__((address_space(3))) unsigned char*)(LDS_PHASE_BYTES + 128) + hw);
    int ln; asm volatile("v_mbcnt_lo_u32_b32 %0, -1, 0\n\tv_mbcnt_hi_u32_b32 %0, -1, %0" : "=v"(ln));
    return (int)(__builtin_amdgcn_readfirstlane(w) << 6) | ln;
}
DEVI float bf2f(bf16_t v) { return __uint_as_float(((unsigned)v) << 16); }
DEVI bf16_t f2bf(float f) { unsigned u = __float_as_uint(f); return (bf16_t)((u + 0x7fffu + ((u >> 16) & 1u)) >> 16); }
DEVI unsigned pk2(float lo, float hi) { typedef float f32x2_ __attribute__((ext_vector_type(2))); typedef __bf16 bf16x2_ __attribute__((ext_vector_type(2))); const f32x2_ v = {lo, hi}; return __builtin_bit_cast(unsigned, __builtin_convertvector(v, bf16x2_)); }
DEVI float row16_sum(float v) {
    v += __builtin_bit_cast(float, __builtin_amdgcn_update_dpp(0, __builtin_bit_cast(int, v), 0xB1, 0xF, 0xF, false));
    v += __builtin_bit_cast(float, __builtin_amdgcn_update_dpp(0, __builtin_bit_cast(int, v), 0x4E, 0xF, 0xF, false));
    v += __builtin_bit_cast(float, __builtin_amdgcn_update_dpp(0, __builtin_bit_cast(int, v), 0x141, 0xF, 0xF, false));
    v += __builtin_bit_cast(float, __builtin_amdgcn_update_dpp(0, __builtin_bit_cast(int, v), 0x140, 0xF, 0xF, false));
    return v;
}
DEVI float rl_f(float v, int l) { return __builtin_bit_cast(float, __builtin_amdgcn_readlane(__builtin_bit_cast(int, v), l)); }
DEVI float wave_sum(float v) { v = row16_sum(v); return (rl_f(v, 0) + rl_f(v, 16)) + (rl_f(v, 32) + rl_f(v, 48)); }
DEVI float half_sum(float v, int hi) { v = row16_sum(v); const float a = rl_f(v, 0) + rl_f(v, 16), b = rl_f(v, 32) + rl_f(v, 48); return hi ? b : a; }
DEVI float sigmoid_f(float x) { return __builtin_amdgcn_rcpf(1.f + __expf(-x)); }
DEVI float silu_f(float x) { return x * sigmoid_f(x); }

typedef float f4v_t __attribute__((ext_vector_type(4)));
DEVI unsigned long long uniform_ptr(const void* p) { const unsigned long long pb = (unsigned long long)p;
    return ((unsigned long long)(unsigned)__builtin_amdgcn_readfirstlane((int)(pb >> 32)) << 32) | (unsigned)__builtin_amdgcn_readfirstlane((int)pb); }
#define LD8_ASM(TAIL) asm volatile("s_nop 4\n\tglobal_load_dwordx4 %0, %8, %16\n\tglobal_load_dwordx4 %1, %9, %16\n\tglobal_load_dwordx4 %2, %10, %16\n\tglobal_load_dwordx4 %3, %11, %16\n\t" \
        "global_load_dwordx4 %4, %12, %16\n\tglobal_load_dwordx4 %5, %13, %16\n\tglobal_load_dwordx4 %6, %14, %16\n\tglobal_load_dwordx4 %7, %15, %16" TAIL \
        : "=&v"(v[0]), "=&v"(v[1]), "=&v"(v[2]), "=&v"(v[3]), "=&v"(v[4]), "=&v"(v[5]), "=&v"(v[6]), "=&v"(v[7]) \
        : "v"(vo[0]), "v"(vo[1]), "v"(vo[2]), "v"(vo[3]), "v"(vo[4]), "v"(vo[5]), "v"(vo[6]), "v"(vo[7]), "s"(sb) : "memory")
DEVI void ld8_wait(f4v_t (&v)[8], const unsigned (&vo)[8], unsigned long long sb) { LD8_ASM("\n\ts_waitcnt vmcnt(0)"); }
DEVI void ld16_wait(f4v_t (&v)[16], const unsigned (&vo)[8], unsigned long long sb0, unsigned long long sb1) {
    asm volatile("s_nop 4\n\tglobal_load_dwordx4 %0, %16, %24\n\tglobal_load_dwordx4 %1, %17, %24\n\tglobal_load_dwordx4 %2, %18, %24\n\tglobal_load_dwordx4 %3, %19, %24\n\t"
                 "global_load_dwordx4 %4, %20, %24\n\tglobal_load_dwordx4 %5, %21, %24\n\tglobal_load_dwordx4 %6, %22, %24\n\tglobal_load_dwordx4 %7, %23, %24\n\t"
                 "global_load_dwordx4 %8, %16, %25\n\tglobal_load_dwordx4 %9, %17, %25\n\tglobal_load_dwordx4 %10, %18, %25\n\tglobal_load_dwordx4 %11, %19, %25\n\t"
                 "global_load_dwordx4 %12, %20, %25\n\tglobal_load_dwordx4 %13, %21, %25\n\tglobal_load_dwordx4 %14, %22, %25\n\tglobal_load_dwordx4 %15, %23, %25\n\ts_waitcnt vmcnt(0)"
                 : "=&v"(v[0]), "=&v"(v[1]), "=&v"(v[2]), "=&v"(v[3]), "=&v"(v[4]), "=&v"(v[5]), "=&v"(v[6]), "=&v"(v[7]),
                   "=&v"(v[8]), "=&v"(v[9]), "=&v"(v[10]), "=&v"(v[11]), "=&v"(v[12]), "=&v"(v[13]), "=&v"(v[14]), "=&v"(v[15])
                 : "v"(vo[0]), "v"(vo[1]), "v"(vo[2]), "v"(vo[3]), "v"(vo[4]), "v"(vo[5]), "v"(vo[6]), "v"(vo[7]), "s"(sb0), "s"(sb1) : "memory");
}
DEVI void ld16_wait_nt(f4v_t (&v)[16], const unsigned (&vo)[8], unsigned long long sb0, unsigned long long sb1) {
    asm volatile("s_nop 4\n\tglobal_load_dwordx4 %0, %16, %24 nt\n\tglobal_load_dwordx4 %1, %17, %24 nt\n\tglobal_load_dwordx4 %2, %18, %24 nt\n\tglobal_load_dwordx4 %3, %19, %24 nt\n\t"
                 "global_load_dwordx4 %4, %20, %24 nt\n\tglobal_load_dwordx4 %5, %21, %24 nt\n\tglobal_load_dwordx4 %6, %22, %24 nt\n\tglobal_load_dwordx4 %7, %23, %24 nt\n\t"
                 "global_load_dwordx4 %8, %16, %25 nt\n\tglobal_load_dwordx4 %9, %17, %25 nt\n\tglobal_load_dwordx4 %10, %18, %25 nt\n\tglobal_load_dwordx4 %11, %19, %25 nt\n\t"
                 "global_load_dwordx4 %12, %20, %25 nt\n\tglobal_load_dwordx4 %13, %21, %25 nt\n\tglobal_load_dwordx4 %14, %22, %25 nt\n\tglobal_load_dwordx4 %15, %23, %25 nt\n\ts_waitcnt vmcnt(0)"
                 : "=&v"(v[0]), "=&v"(v[1]), "=&v"(v[2]), "=&v"(v[3]), "=&v"(v[4]), "=&v"(v[5]), "=&v"(v[6]), "=&v"(v[7]),
                   "=&v"(v[8]), "=&v"(v[9]), "=&v"(v[10]), "=&v"(v[11]), "=&v"(v[12]), "=&v"(v[13]), "=&v"(v[14]), "=&v"(v[15])
                 : "v"(vo[0]), "v"(vo[1]), "v"(vo[2]), "v"(vo[3]), "v"(vo[4]), "v"(vo[5]), "v"(vo[6]), "v"(vo[7]), "s"(sb0), "s"(sb1) : "memory");
}


struct MegaArgs { const float* in[20]; float* out; unsigned char* ws; };
DEVI const float* karg_in(int i) { const char* kp = (const char*)__builtin_amdgcn_kernarg_segment_ptr(); asm volatile("" : "+s"(kp)); return *(const float* const*)(kp + 8 * i); }
DEVI unsigned char* karg_ws() { const char* kp = (const char*)__builtin_amdgcn_kernarg_segment_ptr(); asm volatile("" : "+s"(kp)); return *(unsigned char* const*)(kp + 168); }
DEVI float* karg_out() { const char* kp = (const char*)__builtin_amdgcn_kernarg_segment_ptr(); asm volatile("" : "+s"(kp)); return *(float* const*)(kp + 160); }
typedef const __attribute__((address_space(4))) MegaArgs* KArgP;
DEVI KArgP kargs() {
    const unsigned long long p = (unsigned long long)__builtin_amdgcn_kernarg_segment_ptr();
    unsigned lo = (unsigned)p, hi = (unsigned)(p >> 32);
    asm volatile("" : "+s"(lo), "+s"(hi));
    lo = __builtin_amdgcn_readfirstlane(lo); hi = __builtin_amdgcn_readfirstlane(hi);
    return (KArgP)(((unsigned long long)hi << 32) | lo);
}

DEVI void transpose_item(const float* __restrict__ W, int ldw, int K, int N, bf16_t* __restrict__ WT, float* scr, int item, int lane) {
    const int nblk = N / 64, kb = item / nblk, nb = item % nblk, k0 = 64 * kb, n0 = 64 * nb;
    float tv[64];
#pragma unroll
    for (int i = 0; i < 64; ++i) tv[i] = __builtin_nontemporal_load(&W[(size_t)(k0 + i) * ldw + n0 + lane]);
#pragma unroll
    for (int i = 0; i < 64; ++i) scr[i * 65 + lane] = tv[i];
    asm volatile("s_waitcnt lgkmcnt(0)" ::: "memory");
    const int c = lane & 7;
#pragma unroll
    for (int j = 0; j < 8; ++j) {
        const int n = (lane >> 3) + 8 * j; const float* sp = scr + (8 * c) * 65 + n;
        uint4 o; o.x = pk2(sp[0 * 65], sp[1 * 65]); o.y = pk2(sp[2 * 65], sp[3 * 65]); o.z = pk2(sp[4 * 65], sp[5 * 65]); o.w = pk2(sp[6 * 65], sp[7 * 65]);
        *(uint4*)(WT + (size_t)(n0 + n) * K + k0 + 8 * c) = o;
    }
    asm volatile("s_waitcnt lgkmcnt(0)" ::: "memory");
}

namespace pg8 {
#define PG8_LAS __attribute__((address_space(3)))
typedef unsigned short bf16_t;
typedef short bf16x8 __attribute__((ext_vector_type(8)));
typedef float f32x4 __attribute__((ext_vector_type(4)));
typedef unsigned u32x4 __attribute__((ext_vector_type(4)));
constexpr int BM = 256, BK = 64, HALF = 128, HTB = HALF * BK * 2  , STAGE_BYTES = 8 * HTB, NXCD = 8, WGM = 8;

__host__ __device__ __forceinline__ int lds_byte(int r, int c) { const int st = (r >> 4) * 2 + (c >> 5), rr = r & 15, cc = c & 31, ob = rr * 64 + cc * 2; return st * 1024 + (ob ^ (((ob >> 9) & 1) << 5)); }
__host__ __device__ __forceinline__ void stage_rc(int b, int& R, int& C) { const int st = b / 1024, sb = b % 1024, swz = sb ^ (((sb >> 9) & 1) << 5); R = (st >> 1) * 16 + swz / 64; C = (st & 1) * 32 + (swz % 64) / 2; }
__host__ __device__ __forceinline__ int perm32(int rho) { const int n = rho >> 4, i = rho & 15; return 8 * (i >> 2) + 4 * n + (i & 3); }

struct Unit { int pm, pn; };
struct Gemm { const bf16_t* A; const bf16_t* Bt; int M, N, K; };

struct StaticOrder {
    int nM, nN, nwg, G, c;
    __host__ __device__ void init(int M, int N, int G_, int c_) { nM = M / BM; nN = N / BM; nwg = nM * nN; G = G_; c = c_; }
    __host__ __device__ bool next(int i, Unit& u) const {
        const long L = (long)i * G + c; if (L >= nwg) return false;
        int wgid = (int)L; { const int q = nwg / NXCD, r = nwg % NXCD, xcd = wgid % NXCD, off = wgid / NXCD; wgid = (xcd < r ? xcd * (q + 1) : r * (q + 1) + (xcd - r) * q) + off; }
        const int nig = WGM * nN, gid = wgid / nig, fm = gid * WGM, gsz = (nM - fm) < WGM ? (nM - fm) : WGM;
        u.pm = fm + ((wgid % nig) % gsz); u.pn = (wgid % nig) / gsz; return true;
    }
    __device__ __forceinline__ void a_ready(const Unit&) const {}
    __device__ __forceinline__ void done(const Unit&) const {}
};

__device__ __forceinline__ unsigned cvt_pk_bf16(float lo, float hi) { unsigned r; asm volatile("v_cvt_pk_bf16_f32 %0, %1, %2" : "=v"(r) : "v"(lo), "v"(hi)); return r; }

struct EpiBf16 {
    static constexpr bool PERM = true, AFTER_DRAIN = false;
    bf16_t* O; int ldc;
    __device__ __forceinline__ void operator()(const f32x4 (&acc)[2][2][4][2], const Unit& u, int wr, int wc, int fr, int fq) const {
        const int row0 = u.pm * BM + wr * 64 + fr, col0 = u.pn * BM + wc * 32 + 8 * fq;
#pragma unroll
        for (int ai = 0; ai < 2; ++ai)
#pragma unroll
            for (int m = 0; m < 4; ++m) { bf16_t* rowp = O + (size_t)(row0 + ai * HALF + m * 16) * ldc + col0;
#pragma unroll
                for (int bj = 0; bj < 2; ++bj) { const f32x4 v0 = acc[ai][bj][m][0], v1 = acc[ai][bj][m][1];
                    u32x4 w; w.x = cvt_pk_bf16(v0[0], v0[1]); w.y = cvt_pk_bf16(v0[2], v0[3]); w.z = cvt_pk_bf16(v1[0], v1[1]); w.w = cvt_pk_bf16(v1[2], v1[3]);
                    *(u32x4*)(rowp + bj * HALF) = w; } }
    }
};
struct EpiInProj {
    static constexpr bool PERM = true, AFTER_DRAIN = false;
    bf16_t* O; int ldc; const float* rope;
    __device__ __forceinline__ void operator()(const f32x4 (&acc)[2][2][4][2], const Unit& u, int wr, int wc, int fr, int fq) const {
        const int row0 = u.pm * BM + wr * 64 + fr, col0 = u.pn * BM + wc * 32 + 8 * fq;
        const bool do_rope = (u.pn < 8) && (u.pm < 64);
        const bool once = (u.pn < 4) || (u.pn >= 12 && u.pn < 16) || (u.pn >= 24);
        const float qsc = (u.pn < 4) ? 0.18033688011112042f : 1.f;
        float ir0, ir1, ir2, ir3;
        { const float c = -0.8304820237218405f  , k2pi = 0.15915494309189535f;
          ir0 = __builtin_amdgcn_exp2f(c * (float)(4 * fq)) * k2pi; ir1 = __builtin_amdgcn_exp2f(c * (float)(4 * fq + 1)) * k2pi; ir2 = __builtin_amdgcn_exp2f(c * (float)(4 * fq + 2)) * k2pi; ir3 = __builtin_amdgcn_exp2f(c * (float)(4 * fq + 3)) * k2pi; }
#pragma unroll
        for (int ai = 0; ai < 2; ++ai)
#pragma unroll
            for (int m = 0; m < 4; ++m) { const int row = row0 + ai * HALF + m * 16; bf16_t* rowp = O + (size_t)row * ldc + col0;
                f32x4 cs01 = {1.f, 0.f, 1.f, 0.f}, cs23 = {1.f, 0.f, 1.f, 0.f};
                if (do_rope) { const float pos = (float)((wc & 1) ? (row & 63) : ((row >> 6) & 31));
                    cs01 = (f32x4){__builtin_amdgcn_cosf(pos * ir0), __builtin_amdgcn_sinf(pos * ir0), __builtin_amdgcn_cosf(pos * ir1), __builtin_amdgcn_sinf(pos * ir1)};
                    cs23 = (f32x4){__builtin_amdgcn_cosf(pos * ir2), __builtin_amdgcn_sinf(pos * ir2), __builtin_amdgcn_cosf(pos * ir3), __builtin_amdgcn_sinf(pos * ir3)}; }
#pragma unroll
                for (int bj = 0; bj < 2; ++bj) { f32x4 v0 = acc[ai][bj][m][0], v1 = acc[ai][bj][m][1];
                    if (do_rope) {
                        const float a0 = v0[0] * cs01[0] - v0[1] * cs01[1], a1 = v0[0] * cs01[1] + v0[1] * cs01[0];
                        const float a2 = v0[2] * cs01[2] - v0[3] * cs01[3], a3 = v0[2] * cs01[3] + v0[3] * cs01[2];
                        const float b0 = v1[0] * cs23[0] - v1[1] * cs23[1], b1 = v1[0] * cs23[1] + v1[1] * cs23[0];
                        const float b2 = v1[2] * cs23[2] - v1[3] * cs23[3], b3 = v1[2] * cs23[3] + v1[3] * cs23[2];
                        v0 = (f32x4){a0, a1, a2, a3}; v1 = (f32x4){b0, b1, b2, b3};
                    }
                    v0 = v0 * qsc; v1 = v1 * qsc;
                    u32x4 w; w.x = cvt_pk_bf16(v0[0], v0[1]); w.y = cvt_pk_bf16(v0[2], v0[3]); w.z = cvt_pk_bf16(v1[0], v1[1]); w.w = cvt_pk_bf16(v1[2], v1[3]);
                    if (once) __builtin_nontemporal_store(w, (u32x4*)(rowp + bj * HALF)); else *(u32x4*)(rowp + bj * HALF) = w; } }
    }
};

template <class Epi, class Sched, bool ALIGN_EPI = false, bool SP2 = false>
__device__ __forceinline__ void gemm_phase(PG8_LAS unsigned char* lds, const Gemm g, const Sched& S, const Epi& E) {
    const int tid = opaque_tid(), wid = __builtin_amdgcn_readfirstlane(tid >> 6), lane = tid & 63, wr = wid >> 2, wc = wid & 3, fr = lane & 15, fq = lane >> 4;
    const int K = g.K, nt = K / BK;
    unsigned voffA[2], voffB[2];
#pragma unroll
    for (int i = 0; i < 2; ++i) { int R, C; stage_rc(tid * 16 + i * 8192, R, C); const int Rb = Epi::PERM ? ((R & ~31) + perm32(R & 31)) : R;
        voffA[i] = (unsigned)(R * K + C) * 2u; voffB[i] = (unsigned)(Rb * K + C) * 2u; }
    const size_t kstep = (size_t)(BK * 2);
    const size_t hstep = (size_t)HALF * K * 2;
    const size_t tstep = 2 * hstep;
    const unsigned ldsw = (unsigned)wid * 1024u;
    const int aoff = lds_byte(wr * 64 + fr, fq * 8), boff = lds_byte(wc * 32 + fr, fq * 8);
#define PG8_SA(b, h) (((b) * 2 + (h)) * HTB)
#define PG8_SB(b, h) ((4 + (b) * 2 + (h)) * HTB)
#define PG8_STAGE(bufoff, gbase, voff) do { _Pragma("unroll") for (int _i = 0; _i < 2; ++_i) \
        __builtin_amdgcn_global_load_lds((const unsigned*)((const char*)(gbase) + (voff)[_i]), (PG8_LAS unsigned*)(lds + (bufoff) + ldsw + _i * 8192), 16, 0, 0); } while (0)
#define PG8_LDA(dst, b, h) do { _Pragma("unroll") for (int m = 0; m < 4; ++m) _Pragma("unroll") for (int k = 0; k < 2; ++k) dst[m][k] = *(const PG8_LAS bf16x8*)(lds + PG8_SA(b, h) + aoff + m * 2048 + k * 1024); } while (0)
#define PG8_LDB(dst, b, h) do { _Pragma("unroll") for (int n = 0; n < 2; ++n) _Pragma("unroll") for (int k = 0; k < 2; ++k) dst[n][k] = *(const PG8_LAS bf16x8*)(lds + PG8_SB(b, h) + boff + n * 2048 + k * 1024); } while (0)
#define PG8_MMA(ai, bj, At, Bt) do { __builtin_amdgcn_s_setprio(1); _Pragma("unroll") for (int m = 0; m < 4; ++m) _Pragma("unroll") for (int n = 0; n < 2; ++n) _Pragma("unroll") for (int k = 0; k < 2; ++k) \
        acc[ai][bj][m][n] = __builtin_amdgcn_mfma_f32_16x16x32_bf16(Bt[n][k], At[m][k], acc[ai][bj][m][n], 0, 0, 0); __builtin_amdgcn_s_setprio(0); } while (0)
#define PG8_WAIT_V(n) asm volatile("s_waitcnt vmcnt(" #n ")" ::: "memory")
#define PG8_WAIT_L(n) asm volatile("s_waitcnt lgkmcnt(" #n ")" ::: "memory")
#define PG8_BAR __builtin_amdgcn_s_barrier()
#define PG8_SCHED __builtin_amdgcn_sched_barrier(0)
    Unit cur, nxt; int ui = 0;
    if (!S.next(0, cur)) return;
    f32x4 acc[2][2][4][2];
#pragma unroll
    for (int a = 0; a < 2; ++a)
#pragma unroll
        for (int b = 0; b < 2; ++b)
#pragma unroll
            for (int m = 0; m < 4; ++m)
#pragma unroll
                for (int n = 0; n < 2; ++n) acc[a][b][m][n] = (f32x4){0.f, 0.f, 0.f, 0.f};
    bf16x8 At[4][2], B0[2][2], B1[2][2];
    const char* cA = (const char*)g.A + (size_t)cur.pm * tstep; const char* cB = (const char*)g.Bt + (size_t)cur.pn * tstep;
    S.a_ready(cur);
    if constexpr (SP2) {
        PG8_STAGE(PG8_SB(0, 0), cB, voffB); PG8_STAGE(PG8_SB(0, 1), cB + hstep, voffB); PG8_STAGE(PG8_SA(0, 0), cA, voffA); PG8_STAGE(PG8_SA(0, 1), cA + hstep, voffA);
        if (wr == 1) PG8_BAR;
        PG8_WAIT_V(2); PG8_BAR;
        PG8_STAGE(PG8_SB(1, 0), cB + kstep, voffB); PG8_STAGE(PG8_SA(1, 0), cA + kstep, voffA); PG8_STAGE(PG8_SB(1, 1), cB + hstep + kstep, voffB);
        PG8_WAIT_V(6); PG8_BAR;
    } else {
        PG8_STAGE(PG8_SB(0, 0), cB, voffB); PG8_STAGE(PG8_SA(0, 0), cA, voffA); PG8_STAGE(PG8_SB(0, 1), cB + hstep, voffB); PG8_STAGE(PG8_SA(0, 1), cA + hstep, voffA);
        if (wr == 1) PG8_BAR;
        PG8_WAIT_V(4); PG8_BAR;
        PG8_STAGE(PG8_SB(1, 0), cB + kstep, voffB); PG8_STAGE(PG8_SA(1, 0), cA + kstep, voffA); PG8_STAGE(PG8_SB(1, 1), cB + hstep + kstep, voffB);
        PG8_WAIT_V(6); PG8_BAR;
    }
    for (;;) {
        const bool has_next = S.next(ui + 1, nxt);
        const char* nA = has_next ? (const char*)g.A + (size_t)nxt.pm * tstep : cA; const char* nB = has_next ? (const char*)g.Bt + (size_t)nxt.pn * tstep : cB;
        for (int t = 0; t < nt; t += 2) {
            const bool last = (t == nt - 2);
            const char* a1 = cA + (size_t)(t + 1) * kstep;
            const char* a2 = last ? nA : cA + (size_t)(t + 2) * kstep; const char* b2 = last ? nB : cB + (size_t)(t + 2) * kstep;
            const char* a3 = a2 + kstep; const char* b3 = b2 + kstep;
            if (last && has_next) S.a_ready(nxt);
            if constexpr (SP2) {
            PG8_LDB(B0, 0, 0); PG8_LDB(B1, 0, 1); PG8_SCHED; PG8_LDA(At, 0, 0); PG8_STAGE(PG8_SA(1, 1), a1 + hstep, voffA);
            PG8_WAIT_V(8); PG8_WAIT_L(0); PG8_BAR; PG8_MMA(0, 0, At, B0); PG8_MMA(0, 1, At, B1); PG8_BAR; PG8_SCHED;
            PG8_LDA(At, 0, 1); PG8_STAGE(PG8_SB(0, 0), b2, voffB); PG8_STAGE(PG8_SB(0, 1), b2 + hstep, voffB); PG8_STAGE(PG8_SA(0, 0), a2, voffA);
            PG8_WAIT_V(8); PG8_WAIT_L(0); PG8_BAR; PG8_MMA(1, 0, At, B0); PG8_MMA(1, 1, At, B1); PG8_BAR; PG8_SCHED;
            PG8_LDB(B0, 1, 0); PG8_LDB(B1, 1, 1); PG8_SCHED; PG8_LDA(At, 1, 0); PG8_STAGE(PG8_SA(0, 1), a2 + hstep, voffA);
            PG8_WAIT_V(8); PG8_WAIT_L(0); PG8_BAR; PG8_MMA(0, 0, At, B0); PG8_MMA(0, 1, At, B1); PG8_BAR; PG8_SCHED;
            PG8_LDA(At, 1, 1); PG8_STAGE(PG8_SB(1, 0), b3, voffB); PG8_STAGE(PG8_SB(1, 1), b3 + hstep, voffB); PG8_STAGE(PG8_SA(1, 0), a3, voffA);
            PG8_WAIT_V(8); PG8_WAIT_L(0); PG8_BAR; PG8_MMA(1, 0, At, B0); PG8_MMA(1, 1, At, B1); PG8_BAR; PG8_SCHED;
            } else {
            PG8_LDB(B0, 0, 0); PG8_SCHED; PG8_LDA(At, 0, 0); PG8_STAGE(PG8_SA(1, 1), a1 + hstep, voffA);
            PG8_WAIT_L(8); PG8_BAR; PG8_WAIT_L(0); PG8_MMA(0, 0, At, B0); PG8_BAR; PG8_SCHED;
            PG8_LDB(B1, 0, 1); PG8_STAGE(PG8_SB(0, 0), b2, voffB);
            PG8_BAR; PG8_WAIT_L(0); PG8_MMA(0, 1, At, B1); PG8_BAR;
            PG8_LDA(At, 0, 1); PG8_STAGE(PG8_SA(0, 0), a2, voffA);
            PG8_BAR; PG8_WAIT_L(0); PG8_MMA(1, 0, At, B0); PG8_BAR; PG8_SCHED;
            PG8_STAGE(PG8_SB(0, 1), b2 + hstep, voffB);
            PG8_WAIT_V(6); PG8_BAR; PG8_MMA(1, 1, At, B1); PG8_BAR;
            PG8_LDB(B0, 1, 0); PG8_SCHED; PG8_LDA(At, 1, 0); PG8_STAGE(PG8_SA(0, 1), a2 + hstep, voffA);
            PG8_WAIT_L(8); PG8_BAR; PG8_WAIT_L(0); PG8_MMA(0, 0, At, B0); PG8_BAR; PG8_SCHED;
            PG8_LDB(B1, 1, 1); PG8_STAGE(PG8_SB(1, 0), b3, voffB);
            PG8_BAR; PG8_WAIT_L(0); PG8_MMA(0, 1, At, B1); PG8_BAR;
            PG8_LDA(At, 1, 1); PG8_STAGE(PG8_SA(1, 0), a3, voffA);
            PG8_BAR; PG8_WAIT_L(0); PG8_MMA(1, 0, At, B0); PG8_BAR; PG8_SCHED;
            PG8_STAGE(PG8_SB(1, 1), b3 + hstep, voffB);
            PG8_WAIT_V(6); PG8_BAR; PG8_MMA(1, 1, At, B1); PG8_BAR;
            }
        }
        if constexpr (ALIGN_EPI) { if (wr == 0) PG8_BAR; }
        if constexpr (!Epi::AFTER_DRAIN) { E(acc, cur, wr, wc, fr, fq); S.done(cur); }
        if (!has_next) break;
#pragma unroll
        for (int a = 0; a < 2; ++a)
#pragma unroll
            for (int b = 0; b < 2; ++b)
#pragma unroll
                for (int m = 0; m < 4; ++m)
#pragma unroll
                    for (int n = 0; n < 2; ++n) acc[a][b][m][n] = (f32x4){0.f, 0.f, 0.f, 0.f};
        cur = nxt; cA = nA; cB = nB; ++ui;
        if constexpr (ALIGN_EPI) { if (wr == 1) PG8_BAR; }
    }
    PG8_WAIT_V(0);
    if constexpr (!ALIGN_EPI) { if (wr == 0) PG8_BAR; }
    PG8_BAR;
    if constexpr (Epi::AFTER_DRAIN) { E.fused(acc, cur, wr, wc, fr, fq, lds, wid, lane); S.done(cur); }
#undef PG8_SA
#undef PG8_SB
#undef PG8_STAGE
#undef PG8_LDA
#undef PG8_LDB
#undef PG8_MMA
#undef PG8_WAIT_V
#undef PG8_WAIT_L
#undef PG8_BAR
#undef PG8_SCHED
}
}

namespace att {
using bf16x8 = __attribute__((ext_vector_type(8))) short;
using s16x4  = __attribute__((ext_vector_type(4))) short;
using f32x16 = __attribute__((ext_vector_type(16))) float;
using u32x4  = __attribute__((ext_vector_type(4))) unsigned;
constexpr int NW = 8, QBLK = 32, KVBLK = 64, QROWS = 128;
constexpr float SCALE = 0.125f, QPRESCALE = SCALE * 1.4426950408889634f, THRL = 24.f;
constexpr int SHM_V = KVBLK * 128 * 2, SHM_K = KVBLK * 128 * 2, SHM_ATTN = 2 * SHM_V + 2 * SHM_K + NW * 64 * 4;
#define KSWZ(row, colB) ((row) * 256 + ((colB) ^ (((row) & 7) << 4)))
#define SBAR() __builtin_amdgcn_sched_barrier(0)
__device__ __forceinline__ int crow(int r, int hi) { return (r & 3) + 8 * (r >> 2) + 4 * hi; }
__device__ __forceinline__ unsigned cvtpk(float lo, float hi) { unsigned r; asm volatile("v_cvt_pk_bf16_f32 %0, %1, %2" : "=v"(r) : "v"(lo), "v"(hi)); return r; }
__device__ __forceinline__ void qkt_lds(f32x16& p0, f32x16& p1, const char* Ks, const char* qrow  , float mh, int r32, int hi, int sub) {
#pragma unroll
  for (int r = 0; r < 16; ++r) { p0[r] = -mh; p1[r] = -mh; }
#pragma unroll
  for (int d0 = 0; d0 < 4; ++d0) { const int cb = (sub * 64 + d0 * 16 + hi * 8) * 2;
    const bf16x8 qf = *reinterpret_cast<const bf16x8*>(qrow + d0 * 32);
    const bf16x8 b0 = *reinterpret_cast<const bf16x8*>(Ks + KSWZ(r32, cb));
    const bf16x8 b1 = *reinterpret_cast<const bf16x8*>(Ks + KSWZ(32 + r32, cb));
    p0 = __builtin_amdgcn_mfma_f32_32x32x16_bf16(b0, qf, p0, 0, 0, 0);
    p1 = __builtin_amdgcn_mfma_f32_32x32x16_bf16(b1, qf, p1, 0, 0, 0); }
}
#define ATT_PK4(P, BASE, OUT) do { unsigned a0_ = cvtpk(P[BASE + 0], P[BASE + 1]), a1_ = cvtpk(P[BASE + 2], P[BASE + 3]);   \
    unsigned b0_ = cvtpk(P[BASE + 4], P[BASE + 5]), b1_ = cvtpk(P[BASE + 6], P[BASE + 7]);                              \
    auto r0_ = __builtin_amdgcn_permlane32_swap(a0_, b0_, false, false); auto r1_ = __builtin_amdgcn_permlane32_swap(a1_, b1_, false, false); \
    u32x4 w_ = {r0_[0], r1_[0], r0_[1], r1_[1]}; OUT = *reinterpret_cast<bf16x8*>(&w_); } while (0)
__device__ __forceinline__ void partialSM3(f32x16& p0, f32x16& p1, float& mhat, float& alpha, bf16x8& pa0, bf16x8& pa1, float& ps0) {
  float a = fmaxf(fmaxf(p0[0], p0[1]), p1[0]), b2 = fmaxf(fmaxf(p0[2], p0[3]), p1[1]); a = fmaxf(fmaxf(a, p1[2]), p1[3]);
#pragma unroll
  for (int r = 4; r < 16; r += 4) { a = fmaxf(fmaxf(a, p0[r]), p0[r + 1]); b2 = fmaxf(fmaxf(b2, p0[r + 2]), p0[r + 3]); a = fmaxf(fmaxf(a, p1[r]), p1[r + 1]); b2 = fmaxf(fmaxf(b2, p1[r + 2]), p1[r + 3]); }
  float rm = fmaxf(a, b2);
  { auto rr = __builtin_amdgcn_permlane32_swap(__float_as_uint(rm), __float_as_uint(rm), false, false);
    rm = fmaxf(__uint_as_float(rr[0]), __uint_as_float(rr[1])); }
  alpha = 1.f;
  if (__builtin_expect(__any(rm > THRL), 0)) {
    const float dl = fmaxf(rm, 0.f); mhat += dl;
#pragma unroll
    for (int r = 0; r < 16; ++r) { p0[r] -= dl; p1[r] -= dl; }
    alpha = __builtin_amdgcn_exp2f(-dl);
  }
  float s_ = 0.f;
#pragma unroll
  for (int r = 0; r < 16; ++r) { p0[r] = __builtin_amdgcn_exp2f(p0[r]); s_ += p0[r]; }
  ps0 = s_;
  ATT_PK4(p0, 0, pa0); ATT_PK4(p0, 8, pa1);
}
__device__ __forceinline__ void finishSM3(f32x16& p1, float alpha, float ps0, float& l_reg, bf16x8& pa2, bf16x8& pa3) {
#pragma unroll
  for (int r = 0; r < 16; ++r) p1[r] = __builtin_amdgcn_exp2f(p1[r]);
  float ps = ps0;
#pragma unroll
  for (int r = 0; r < 16; ++r) ps += p1[r];
  { auto rr = __builtin_amdgcn_permlane32_swap(__float_as_uint(ps), __float_as_uint(ps), false, false);
    ps = __uint_as_float(rr[0]) + __uint_as_float(rr[1]); }
  l_reg = l_reg * alpha + ps;
  ATT_PK4(p1, 0, pa2); ATT_PK4(p1, 8, pa3);
}
__device__ __forceinline__ int v_st(int k, int c) { const int kk = (k & ~0xC) | ((k & 4) << 1) | ((k & 8) >> 1); return ((kk >> 3) * 4 + (c >> 5)) * 512 + ((kk & 7) * 32 + (c & 31)) * 2; }
__device__ __forceinline__ int v_rd_base(int lane) { return ((lane & 3) << 3) | (((lane >> 2) & 3) << 6) | (((lane >> 4) & 1) << 5) | (((lane >> 5) & 1) << 8); }
constexpr int v_rd_off(int d0, int ks, int half) { return d0 * 512 + ks * 4096 + half * 2048; }
template <int OFF> __device__ __forceinline__ s16x4 tr_read(int vb) {
  s16x4 r; asm volatile("ds_read_b64_tr_b16 %0, %1 offset:%2" : "=&v"(r) : "v"(vb), "i"(OFF) : "memory"); return r;
}
template <int D0> __device__ __forceinline__ void pv_one(f32x16& od, int vb, bf16x8 pa0, bf16x8 pa1, bf16x8 pa2, bf16x8 pa3) {
  const s16x4 l0 = tr_read<v_rd_off(D0, 0, 0)>(vb), h0 = tr_read<v_rd_off(D0, 0, 1)>(vb), l1 = tr_read<v_rd_off(D0, 1, 0)>(vb), h1 = tr_read<v_rd_off(D0, 1, 1)>(vb);
  const s16x4 l2 = tr_read<v_rd_off(D0, 2, 0)>(vb), h2 = tr_read<v_rd_off(D0, 2, 1)>(vb), l3 = tr_read<v_rd_off(D0, 3, 0)>(vb), h3 = tr_read<v_rd_off(D0, 3, 1)>(vb);
  asm volatile("s_waitcnt lgkmcnt(0)" ::: "memory"); SBAR();
#define PK(L, H) (bf16x8){L[0], L[1], L[2], L[3], H[0], H[1], H[2], H[3]}
  od = __builtin_amdgcn_mfma_f32_32x32x16_bf16(pa0, PK(l0, h0), od, 0, 0, 0);
  od = __builtin_amdgcn_mfma_f32_32x32x16_bf16(pa1, PK(l1, h1), od, 0, 0, 0);
  od = __builtin_amdgcn_mfma_f32_32x32x16_bf16(pa2, PK(l2, h2), od, 0, 0, 0);
  od = __builtin_amdgcn_mfma_f32_32x32x16_bf16(pa3, PK(l3, h3), od, 0, 0, 0);
#undef PK
}
__device__ __forceinline__ void pv_d0(f32x16* o, int vb, bf16x8 pa0, bf16x8 pa1, bf16x8 pa2, bf16x8 pa3) {
  pv_one<0>(o[0], vb, pa0, pa1, pa2, pa3); pv_one<1>(o[1], vb, pa0, pa1, pa2, pa3); pv_one<2>(o[2], vb, pa0, pa1, pa2, pa3); pv_one<3>(o[3], vb, pa0, pa1, pa2, pa3);
}
__device__ __forceinline__ long ktile_row(int b, int t) { return t < 4 ? (long)(NLAT + b * CTXL + 64 * t) : (long)(b * SEQ + 64 * (t - 4)); }

__device__ __forceinline__ void ld_tile8(u32x4 (&v)[8], const bf16_t* base  , int lane) {
  const unsigned long long sb = uniform_ptr(base);
  const int v0 = ((lane >> 4) * NP + (lane & 15) * 8) * 2, st = 4 * NP * 2;
  asm volatile("s_nop 4\n\tglobal_load_dwordx4 %0, %8, %16\n\tglobal_load_dwordx4 %1, %9, %16\n\tglobal_load_dwordx4 %2, %10, %16\n\tglobal_load_dwordx4 %3, %11, %16\n\t"
               "global_load_dwordx4 %4, %12, %16\n\tglobal_load_dwordx4 %5, %13, %16\n\tglobal_load_dwordx4 %6, %14, %16\n\tglobal_load_dwordx4 %7, %15, %16\n\ts_waitcnt vmcnt(0)"
               : "=&v"(v[0]), "=&v"(v[1]), "=&v"(v[2]), "=&v"(v[3]), "=&v"(v[4]), "=&v"(v[5]), "=&v"(v[6]), "=&v"(v[7])
               : "v"(v0), "v"(v0 + st), "v"(v0 + 2 * st), "v"(v0 + 3 * st), "v"(v0 + 4 * st), "v"(v0 + 5 * st), "v"(v0 + 6 * st), "v"(v0 + 7 * st), "s"(sb) : "memory");
}
constexpr int QROWS2 = 256, QT_ROWB = 272, QT_OFF = 2 * SHM_V + 2 * SHM_K + NW * 64 * 4, SHM_ATTN2 = QT_OFF + NW * 32 * QT_ROWB;
static_assert(SHM_ATTN2 <= LDS_PHASE_BYTES, "attention LDS map");
__device__ __forceinline__ void attn_unit2(const bf16_t* __restrict__ Pm, bf16_t* __restrict__ Y, long qrow0, int b, int hh, int NT, float lam, float lam_init,
                                           const float* __restrict__ subln, char* lds) {
  const int tid = opaque_tid(), wid = __builtin_amdgcn_readfirstlane(tid >> 6), lane = tid & 63, r32 = lane & 31, hi = lane >> 5;
  char* V_lds = lds; char* K_lds = lds + 2 * SHM_V;
  float* ws = (float*)(lds + 2 * SHM_V + 2 * SHM_K) + wid * 64; float* li_l = ws; float* al_l = ws + 32;
  char* qt = lds + QT_OFF + wid * (32 * QT_ROWB);
  const long wrow0 = qrow0 + wid * QBLK;
  float mh0 = 0.f, mh1 = 0.f, l0 = 0.f, l1 = 0.f; f32x16 o0[4] = {}, o1[4] = {};
  const int vb0 = (int)(uintptr_t)V_lds + v_rd_base(lane);
  const unsigned ldsb = (unsigned)(uintptr_t)lds + (unsigned)(wid * 2048);
  unsigned kof0, vof0;
  { const int sl = wid * 128 + lane, krow = sl >> 4, kch = (sl & 15) ^ (krow & 7);
    const int kk = (sl >> 7) * 8 + ((sl & 31) >> 2), vc = ((sl >> 5) & 3) * 32 + (sl & 3) * 8, vk = (kk & ~0xC) | ((kk & 4) << 1) | ((kk & 8) >> 1);
    kof0 = (unsigned)((krow * NP + C_KA + kch * 8) * 2); vof0 = (unsigned)((vk * NP + C_VA + vc) * 2); }
#define SDMA(t, bb) do { const char* tb_ = (const char*)(Pm + ktile_row(b, (t)) * NP + hh * 128); \
    __builtin_amdgcn_global_load_lds((const unsigned*)(tb_ + vof0), (__attribute__((address_space(3))) unsigned*)(ldsb + (unsigned)((bb) * SHM_V)), 16, 0, 0); \
    __builtin_amdgcn_global_load_lds((const unsigned*)(tb_ + kof0), (__attribute__((address_space(3))) unsigned*)(ldsb + (unsigned)(2 * SHM_V + (bb) * SHM_K)), 16, 0, 0); \
    __builtin_amdgcn_global_load_lds((const unsigned*)(tb_ + (vof0 + 128u)), (__attribute__((address_space(3))) unsigned*)(ldsb + (unsigned)((bb) * SHM_V + 1024)), 16, 0, 0); \
    __builtin_amdgcn_global_load_lds((const unsigned*)(tb_ + ((kof0 ^ 64u) + (unsigned)(4 * NP * 2))), (__attribute__((address_space(3))) unsigned*)(ldsb + (unsigned)(2 * SHM_V + (bb) * SHM_K + 1024)), 16, 0, 0); } while (0)
#define RESC(o, a) do { if (__any((a) < 1.f)) { if (hi == 0) al_l[r32] = (a); asm volatile("s_waitcnt lgkmcnt(0)" ::: "memory"); \
    _Pragma("unroll") for (int r = 0; r < 16; ++r) { const float f_ = al_l[crow(r, hi)]; _Pragma("unroll") for (int d = 0; d < 4; ++d) o[d][r] *= f_; asm volatile("" ::: "memory"); } } } while (0)
  f32x16 pA1, pB1; float alA, alB, psA, psB; bf16x8 aA0, aA1, aB0, aB1, pa2, pa3;
  const char* qA = qt + r32 * QT_ROWB + (hi * 8) * 2;
#define qB (qA + 128)
  SDMA(0, 0);
  { u32x4 qv[8]; ld_tile8(qv, Pm + wrow0 * NP + C_QA + hh * 128, lane);
#pragma unroll
    for (int c8 = 0; c8 < 8; ++c8) { const int row = c8 * 4 + (lane >> 4), ch = lane & 15; *(u32x4*)(qt + row * QT_ROWB + ch * 16) = qv[c8]; } }
  asm volatile("s_waitcnt vmcnt(0)" ::: "memory"); __syncthreads();
  { f32x16 t0; SBAR(); qkt_lds(t0, pA1, K_lds, qA, mh0, r32, hi, 0); partialSM3(t0, pA1, mh0, alA, aA0, aA1, psA); SBAR(); }
  if (1 < NT) SDMA(1, 1);
  { f32x16 t0; SBAR(); qkt_lds(t0, pB1, K_lds, qB, mh1, r32, hi, 1); finishSM3(pA1, alA, psA, l0, pa2, pa3); SBAR();
    pv_d0(o0, vb0, aA0, aA1, pa2, pa3); partialSM3(t0, pB1, mh1, alB, aB0, aB1, psB); SBAR(); }
  asm volatile("s_waitcnt vmcnt(0)" ::: "memory"); __syncthreads();
  for (int t = 1; t < NT; ++t) {
    const int cur = t & 1, prev = cur ^ 1;
    { f32x16 t0; SBAR(); qkt_lds(t0, pA1, K_lds + cur * SHM_K, qA, mh0, r32, hi, 0); RESC(o1, alB); finishSM3(pB1, alB, psB, l1, pa2, pa3); SBAR();
      pv_d0(o1, vb0 + prev * SHM_V, aB0, aB1, pa2, pa3); partialSM3(t0, pA1, mh0, alA, aA0, aA1, psA); SBAR(); }
    __syncthreads();
    if (t + 1 < NT) SDMA(t + 1, prev);
    RESC(o0, alA);
    { f32x16 t0; SBAR(); qkt_lds(t0, pB1, K_lds + cur * SHM_K, qB, mh1, r32, hi, 1); finishSM3(pA1, alA, psA, l0, pa2, pa3); SBAR();
      pv_d0(o0, vb0 + cur * SHM_V, aA0, aA1, pa2, pa3); partialSM3(t0, pB1, mh1, alB, aB0, aB1, psB); SBAR(); }
    asm volatile("s_waitcnt vmcnt(0)" ::: "memory"); __syncthreads();
  }
  { const char* gb_ = (const char*)(Pm + wrow0 * NP + C_GA + hh * 128); const unsigned qtb = (unsigned)(uintptr_t)qt; int lg = lane; asm volatile("" : "+v"(lg));
    const unsigned go = (unsigned)(((lg >> 4) * NP + (lg & 15) * 8) * 2);
#pragma unroll
    for (int c8 = 0; c8 < 8; ++c8)
      __builtin_amdgcn_global_load_lds((const unsigned*)(gb_ + (go + (unsigned)(c8 * 4 * NP * 2))), (__attribute__((address_space(3))) unsigned*)(qtb + (unsigned)(c8 * 1024)), 16, 0, 0); }
  RESC(o1, alB); finishSM3(pB1, alB, psB, l1, pa2, pa3); SBAR();
  pv_d0(o1, vb0 + ((NT - 1) & 1) * SHM_V, aB0, aB1, pa2, pa3);
  if (hi == 0) { li_l[r32] = l0; al_l[r32] = l1; } asm volatile("s_waitcnt lgkmcnt(0)" ::: "memory");
  float ss[16];
#pragma unroll
  for (int r = 0; r < 16; ++r) { const float ra = __builtin_amdgcn_rcpf(li_l[crow(r, hi)]), rb = lam * __builtin_amdgcn_rcpf(al_l[crow(r, hi)]); float a = 0.f;
#pragma unroll
    for (int d0 = 0; d0 < 4; ++d0) { o0[d0][r] = o0[d0][r] * ra - o1[d0][r] * rb; a += o0[d0][r] * o0[d0][r]; }
    ss[r] = a; }
#pragma unroll
  for (int r = 0; r < 16; ++r) {
    ss[r] = rsqrtf(half_sum(ss[r], hi) * (1.f / 128.f) + EPS) * (1.f - lam_init);
  }
  float sw[4];
#pragma unroll
  for (int d0 = 0; d0 < 4; ++d0) sw[d0] = subln[d0 * 32 + r32];
  asm volatile("s_waitcnt vmcnt(0) lgkmcnt(0)" ::: "memory");
#pragma unroll
  for (int r = 0; r < 16; ++r) { bf16_t* tp = (bf16_t*)(qt + crow(r, hi) * 256) + r32;
#pragma unroll
    for (int d0 = 0; d0 < 4; ++d0) { const float g = bf2f(tp[d0 * 32]); tp[d0 * 32] = f2bf(o0[d0][r] * ss[r] * sw[d0] * silu_f(g)); } }
  asm volatile("s_waitcnt lgkmcnt(0)" ::: "memory");
#pragma unroll
  for (int c8 = 0; c8 < 8; ++c8) { const int row = c8 * 4 + (lane >> 4), ch = lane & 15;
    *(uint4*)(Y + (wrow0 + row) * DM + hh * 128 + ch * 8) = *(const uint4*)(qt + row * 256 + ch * 16); }
  asm volatile("s_waitcnt lgkmcnt(0)" ::: "memory");
#undef SDMA
#undef RESC
#undef qB
}
#undef KSWZ
#undef SBAR
}

DEVI void mod_unit(int unit, const float* __restrict__ c, const float* __restrict__ c_ctx, const float* __restrict__ w_ada, const float* __restrict__ b_ada, float* __restrict__ MOD, float* ldsf);
namespace mls {
using bf16x8 = __attribute__((ext_vector_type(8))) short;
using s16x4  = __attribute__((ext_vector_type(4))) short;
using f32x4  = __attribute__((ext_vector_type(4))) float;
constexpr int QSTRB = 272, SSTRB = 144;
constexpr int VSTRB = 528;
constexpr int L_Q = 0, L_K = L_Q + 64 * QSTRB, L_V = L_K + 64 * QSTRB, L_S = L_V + 64 * VSTRB, L_CT = L_S + 64 * SSTRB, L_SM = L_CT + 256 * QSTRB, L_END = L_SM + 8192;
static_assert(L_END <= LDS_PHASE_BYTES && (L_K % 16) == 0 && (L_V % 16) == 0 && (L_S % 16) == 0 && (L_CT % 16) == 0 && (L_SM % 16) == 0, "mlstm LDS map");
__device__ __forceinline__ f32x4 mfma16(bf16x8 a, bf16x8 b, f32x4 c) { return __builtin_amdgcn_mfma_f32_16x16x32_bf16(a, b, c, 0, 0, 0); }
struct TrPair { s16x4 lo, hi; };
__device__ __forceinline__ bf16x8 tr_pack(const TrPair& t) { return (bf16x8){t.lo[0], t.lo[1], t.lo[2], t.lo[3], t.hi[0], t.hi[1], t.hi[2], t.hi[3]}; }
__device__ __forceinline__ float wave_scan_incl(float v) {
  v += __builtin_bit_cast(float, __builtin_amdgcn_update_dpp(0, __builtin_bit_cast(int, v), 0x111, 0xF, 0xF, false));
  v += __builtin_bit_cast(float, __builtin_amdgcn_update_dpp(0, __builtin_bit_cast(int, v), 0x112, 0xF, 0xF, false));
  v += __builtin_bit_cast(float, __builtin_amdgcn_update_dpp(0, __builtin_bit_cast(int, v), 0x114, 0xF, 0xF, false));
  v += __builtin_bit_cast(float, __builtin_amdgcn_update_dpp(0, __builtin_bit_cast(int, v), 0x118, 0xF, 0xF, false));
  v += __builtin_bit_cast(float, __builtin_amdgcn_update_dpp(0, __builtin_bit_cast(int, v), 0x142, 0xA, 0xF, false));
  v += __builtin_bit_cast(float, __builtin_amdgcn_update_dpp(0, __builtin_bit_cast(int, v), 0x143, 0xC, 0xF, false));
  return v;
}
__device__ __forceinline__ float fast_tanh(float x) { return 1.f - 2.f * __builtin_amdgcn_rcpf(1.f + __expf(2.f * x)); }

__device__ __forceinline__ void tr_v4(unsigned base, TrPair& a0, TrPair& a1, TrPair& b0, TrPair& b1, TrPair& c0, TrPair& c1, TrPair& d0, TrPair& d1) {
  asm volatile(
    "ds_read_b64_tr_b16 %0, %16\n\tds_read_b64_tr_b16 %1, %16 offset:2112\n\tds_read_b64_tr_b16 %2, %16 offset:16896\n\tds_read_b64_tr_b16 %3, %16 offset:19008\n\t"
    "ds_read_b64_tr_b16 %4, %16 offset:32\n\tds_read_b64_tr_b16 %5, %16 offset:2144\n\tds_read_b64_tr_b16 %6, %16 offset:16928\n\tds_read_b64_tr_b16 %7, %16 offset:19040\n\t"
    "ds_read_b64_tr_b16 %8, %16 offset:64\n\tds_read_b64_tr_b16 %9, %16 offset:2176\n\tds_read_b64_tr_b16 %10, %16 offset:16960\n\tds_read_b64_tr_b16 %11, %16 offset:19072\n\t"
    "ds_read_b64_tr_b16 %12, %16 offset:96\n\tds_read_b64_tr_b16 %13, %16 offset:2208\n\tds_read_b64_tr_b16 %14, %16 offset:16992\n\tds_read_b64_tr_b16 %15, %16 offset:19104\n\t"
    "s_waitcnt lgkmcnt(0)"
    : "=&v"(a0.lo), "=&v"(a0.hi), "=&v"(a1.lo), "=&v"(a1.hi), "=&v"(b0.lo), "=&v"(b0.hi), "=&v"(b1.lo), "=&v"(b1.hi),
      "=&v"(c0.lo), "=&v"(c0.hi), "=&v"(c1.lo), "=&v"(c1.hi), "=&v"(d0.lo), "=&v"(d0.hi), "=&v"(d1.lo), "=&v"(d1.hi)
    : "v"(base) : "memory");
}
__device__ __forceinline__ bf16x8 scale_frag(const TrPair& t, const float4 wa, const float4 wb) {
  const float f0 = bf2f((bf16_t)t.lo[0]) * wa.x, f1 = bf2f((bf16_t)t.lo[1]) * wa.y, f2 = bf2f((bf16_t)t.lo[2]) * wa.z, f3 = bf2f((bf16_t)t.lo[3]) * wa.w;
  const float f4 = bf2f((bf16_t)t.hi[0]) * wb.x, f5 = bf2f((bf16_t)t.hi[1]) * wb.y, f6 = bf2f((bf16_t)t.hi[2]) * wb.z, f7 = bf2f((bf16_t)t.hi[3]) * wb.w;
  return __builtin_bit_cast(bf16x8, make_uint4(pk2(f0, f1), pk2(f2, f3), pk2(f4, f5), pk2(f6, f7)));
}

__device__ __forceinline__ void mlstm_unit(const bf16_t* __restrict__ Pm, const bf16_t* __restrict__ QKC  , const float* __restrict__ GATES,
                                           bf16_t* __restrict__ HM, const float* __restrict__ i_bias, const float* __restrict__ f_bias,
                                           int b, int head, int dir, bool ctx_out, unsigned* mdone, char* lds) {
  const int tid = opaque_tid(), wid = __builtin_amdgcn_readfirstlane(tid >> 6), lane = tid & 63, lr = lane & 15, kg = lane >> 4;
  char* q_lds = lds + L_Q; char* k_lds = lds + L_K; char* v_lds = lds + L_V; char* s_lds = lds + L_S; char* ct_lds = lds + L_CT;
  float* bl = (float*)(lds + L_SM); float* bsp = bl + 64; float* av = bsp + 64; float* wkl = av + 64; float* qn = wkl + 64; float* nvec = qn + 64; float* rs = nvec + 128; float* npart = rs + 1024;
  const unsigned lds0 = (unsigned)(uintptr_t)lds;
  const unsigned trq = (unsigned)((8 * kg + (lr >> 2)) * QSTRB + (4 * (lr & 3)) * 2), trv = (unsigned)((8 * kg + (lr >> 2)) * VSTRB + (4 * (lr & 3)) * 2);
  if (tid < 128) nvec[tid] = 0.f;
  const float ibias = i_bias[dir * 4 + head], fbias = f_bias[dir * 4 + head];
  const int chg = tid & 31, rg = tid >> 5; const bool isk = chg >= 16;
  const int qkcol = 1024 + (isk ? 512 : 0) + head * 128 + (chg & 15) * 8;
  const int vrow = tid >> 3, vch = tid & 7;
  uint4 pq0, pq1, pq2, pq3, pv0, pv1, pv2, pv3; float pgi, pgf;
#define MLS_LOAD(c_) do { const int c__ = (c_); const bool ic_ = c__ < 4; const int T_ = ic_ ? CTXL : SEQ, cc_ = ic_ ? c__ : c__ - 4; \
    const long rb_ = ic_ ? (long)(NLAT + b * CTXL) : (long)b * SEQ; const int t0_ = dir ? (T_ - 64 * (cc_ + 1)) : 64 * cc_; \
    { const bf16_t* qp_ = QKC + (rb_ + t0_ + rg) * DM + qkcol; pq0 = *(const uint4*)qp_; pq1 = *(const uint4*)(qp_ + 16 * DM); pq2 = *(const uint4*)(qp_ + 32 * DM); pq3 = *(const uint4*)(qp_ + 48 * DM); } \
    { const uint4* vp_ = (const uint4*)(Pm + (rb_ + t0_ + vrow) * NP + C_VB + head * 256 + vch * 32); pv0 = vp_[0]; pv1 = vp_[1]; pv2 = vp_[2]; pv3 = vp_[3]; } \
    const float* gr_ = GATES + (rb_ + t0_ + (dir ? 63 - lane : lane)) * 16; pgi = gr_[dir * 4 + head]; pgf = gr_[8 + dir * 4 + head]; } while (0)
  MLS_LOAD(0);
  f32x4 Cacc[16];
#pragma unroll
  for (int e = 0; e < 16; ++e) Cacc[e] = (f32x4){0.f, 0.f, 0.f, 0.f};
  float gprev = 0.f;
  __syncthreads();
  for (int c = 0; c < 36; ++c) {
    const bool isctx = c < 4; const int T = isctx ? CTXL : SEQ, cc = isctx ? c : c - 4;
    const long rowbase = isctx ? (long)(NLAT + b * CTXL) : (long)b * SEQ;
    const int t0 = dir ? (T - 64 * (cc + 1)) : 64 * cc;
    const bool need_h = ctx_out || !isctx;
    float gamma, wk_l;
    {
      const float igv = 15.f * fast_tanh((pgi + ibias) * (1.f / 15.f));
      const float fc = 15.f * fast_tanh((pgf + fbias) * (1.f / 15.f));
      const float lfv = fminf(fc, 0.f) - __logf(1.f + __expf(-fabsf(fc)));
      const float bcum = wave_scan_incl(lfv);
      const float b63 = __builtin_bit_cast(float, __builtin_amdgcn_readlane(__builtin_bit_cast(int, bcum), 63));
      gamma = __expf(b63); wk_l = __expf(b63 - bcum + igv);
      if (wid == 0) { bl[lane] = bcum; bsp[lane] = bcum - igv; av[lane] = __expf(bcum); wkl[lane] = wk_l; }
      if (c > 0 && tid < 128) nvec[tid] = gprev * nvec[tid] + (npart[tid] + npart[128 + tid]) + (npart[256 + tid] + npart[384 + tid]);
    }
#pragma unroll
    for (int eblk = 0; eblk < 16; ++eblk) { uint2 w_; w_.x = pk2(Cacc[eblk][0], Cacc[eblk][1]); w_.y = pk2(Cacc[eblk][2], Cacc[eblk][3]);
      *(uint2*)(ct_lds + (eblk * 16 + lr) * QSTRB + (wid * 16 + 4 * kg) * 2) = w_; }
    { char* dst = (isk ? k_lds : q_lds) + (chg & 15) * 16;
      *(uint4*)(dst + (dir ? 63 - rg : rg) * QSTRB) = pq0; *(uint4*)(dst + (dir ? 47 - rg : rg + 16) * QSTRB) = pq1;
      *(uint4*)(dst + (dir ? 31 - rg : rg + 32) * QSTRB) = pq2; *(uint4*)(dst + (dir ? 15 - rg : rg + 48) * QSTRB) = pq3; }
    { char* dst = v_lds + (dir ? 63 - vrow : vrow) * VSTRB + vch * 64;
      *(uint4*)dst = pv0; *(uint4*)(dst + 16) = pv1; *(uint4*)(dst + 32) = pv2; *(uint4*)(dst + 48) = pv3; }
    if (c + 1 < 36) MLS_LOAD(c + 1);
    __syncthreads();
    if (need_h) {
      const int lblk = wid >> 1;
#pragma unroll
      for (int u2 = 0; u2 < 2; ++u2) {
        const int sblk = 2 * (wid & 1) + u2;
        if (sblk <= lblk) {
          f32x4 acc = {0.f, 0.f, 0.f, 0.f};
#pragma unroll
          for (int ks = 0; ks < 4; ++ks) {
            const bf16x8 ka = *(const bf16x8*)(k_lds + (sblk * 16 + lr) * QSTRB + (ks * 32 + 8 * kg) * 2);
            const bf16x8 qb = *(const bf16x8*)(q_lds + (lblk * 16 + lr) * QSTRB + (ks * 32 + 8 * kg) * 2);
            acc = mfma16(ka, qb, acc);
          }
          const int l = lblk * 16 + lr; const float blv = bl[l];
          float v4[4]; float sum = 0.f;
#pragma unroll
          for (int r = 0; r < 4; ++r) { const int sidx = sblk * 16 + 4 * kg + r; const float w = (sidx <= l) ? __expf(blv - bsp[sidx]) : 0.f; v4[r] = acc[r] * w; sum += v4[r]; }
          uint2 w; w.x = pk2(v4[0], v4[1]); w.y = pk2(v4[2], v4[3]);
          *(uint2*)(s_lds + l * SSTRB + (sblk * 16 + 4 * kg) * 2) = w;
          rs[(sblk * 4 + kg) * 64 + l] = sum;
        } else if ((lblk == 0 && sblk == 1) || (lblk == 2 && sblk == 3)) {
          uint2 z_; z_.x = 0u; z_.y = 0u; asm volatile("" : "+v"(z_.x), "+v"(z_.y));
          *(uint2*)(s_lds + (lblk * 16 + lr) * SSTRB + (sblk * 16 + 4 * kg) * 2) = z_;
        }
      }
      { const int l = tid >> 3, part = tid & 7; float a = 0.f;
        const unsigned* qp = (const unsigned*)(q_lds + l * QSTRB + part * 32);
#pragma unroll
        for (int i = 0; i < 8; ++i) { const unsigned wd = qp[i]; a += __uint_as_float(wd << 16) * nvec[part * 16 + 2 * i] + __uint_as_float(wd & 0xffff0000u) * nvec[part * 16 + 2 * i + 1]; }
        a += __builtin_bit_cast(float, __builtin_amdgcn_update_dpp(0, __builtin_bit_cast(int, a), 0xB1, 0xF, 0xF, false));
        a += __builtin_bit_cast(float, __builtin_amdgcn_update_dpp(0, __builtin_bit_cast(int, a), 0x4E, 0xF, 0xF, false));
        a += __builtin_bit_cast(float, __builtin_amdgcn_update_dpp(0, __builtin_bit_cast(int, a), 0x141, 0xF, 0xF, false));
        if (part == 0) qn[l] = a; }
    }
    __syncthreads();
    if (need_h) {
      const int lblk = wid >> 1, l = lblk * 16 + lr, eh = wid & 1;
      float d = av[l] * qn[l];
      for (int sb = 0; sb <= lblk; ++sb) d += (rs[(sb * 4 + 0) * 64 + l] + rs[(sb * 4 + 1) * 64 + l]) + (rs[(sb * 4 + 2) * 64 + l] + rs[(sb * 4 + 3) * 64 + l]);
      const float a_l = av[l], dinv = 1.f / fmaxf(fabsf(d), 1.f);
      bf16x8 qb[4];
#pragma unroll
      for (int ks = 0; ks < 4; ++ks) qb[ks] = *(const bf16x8*)(q_lds + l * QSTRB + (ks * 32 + 8 * kg) * 2);
      const bf16x8 sb0 = *(const bf16x8*)(s_lds + l * SSTRB + (8 * kg) * 2);
      bf16x8 sb1 = sb0; if (lblk >= 2) sb1 = *(const bf16x8*)(s_lds + l * SSTRB + (32 + 8 * kg) * 2);
      const int t = dir ? (t0 + 63 - l) : (t0 + l);
      bf16_t* hp = HM + ((size_t)dir * NTOK + rowbase + t) * 1024 + head * 256 + eh * 128 + 4 * kg;
#pragma unroll
      for (int half = 0; half < 2; ++half) {
        TrPair a0, a1, b0, b1, c0, c1, d0, d1;
        tr_v4(lds0 + L_V + trv + (unsigned)((eh * 8 + half * 4) * 32), a0, a1, b0, b1, c0, c1, d0, d1);
        __builtin_amdgcn_sched_barrier(0);
#define MLS_HTILE(ti, VA0, VA1) do { const int eblk = eh * 8 + half * 4 + (ti); f32x4 acc1 = {0.f, 0.f, 0.f, 0.f}, acc2 = {0.f, 0.f, 0.f, 0.f}; \
          _Pragma("unroll") for (int ks = 0; ks < 4; ++ks) { const bf16x8 ca = *(const bf16x8*)(ct_lds + (eblk * 16 + lr) * QSTRB + (ks * 32 + 8 * kg) * 2); acc1 = mfma16(ca, qb[ks], acc1); } \
          acc2 = mfma16(tr_pack(VA0), sb0, acc2); if (lblk >= 2) acc2 = mfma16(tr_pack(VA1), sb1, acc2); \
          uint2 w_; w_.x = pk2((a_l * acc1[0] + acc2[0]) * dinv, (a_l * acc1[1] + acc2[1]) * dinv); w_.y = pk2((a_l * acc1[2] + acc2[2]) * dinv, (a_l * acc1[3] + acc2[3]) * dinv); \
          *(uint2*)(hp + (half * 4 + (ti)) * 16) = w_; } while (0)
        MLS_HTILE(0, a0, a1); MLS_HTILE(1, b0, b1); MLS_HTILE(2, c0, c1); MLS_HTILE(3, d0, d1);
#undef MLS_HTILE
      }
    }
    {
      bf16x8 kA0, kA1;
      { TrPair ka0, ka1; const unsigned ak = lds0 + L_K + trq + (unsigned)(wid * 32);
        asm volatile("ds_read_b64_tr_b16 %0, %4\n\tds_read_b64_tr_b16 %1, %4 offset:1088\n\tds_read_b64_tr_b16 %2, %4 offset:8704\n\tds_read_b64_tr_b16 %3, %4 offset:9792\n\ts_waitcnt lgkmcnt(0)"
                     : "=&v"(ka0.lo), "=&v"(ka0.hi), "=&v"(ka1.lo), "=&v"(ka1.hi) : "v"(ak) : "memory");
        const float4 w0 = *(const float4*)(wkl + 8 * kg), w1 = *(const float4*)(wkl + 8 * kg + 4), w2 = *(const float4*)(wkl + 32 + 8 * kg), w3 = *(const float4*)(wkl + 36 + 8 * kg);
        kA0 = scale_frag(ka0, w0, w1); kA1 = scale_frag(ka1, w2, w3); }
#pragma unroll
      for (int q4 = 0; q4 < 4; ++q4) {
        TrPair a0, a1, b0, b1, c0, c1, d0, d1;
        tr_v4(lds0 + L_V + trv + (unsigned)(q4 * 128), a0, a1, b0, b1, c0, c1, d0, d1);
        __builtin_amdgcn_sched_barrier(0);
#define MLS_CUPD(ti, V0, V1) do { f32x4 cc_ = Cacc[q4 * 4 + (ti)] * gamma; cc_ = mfma16(kA0, tr_pack(V0), cc_); cc_ = mfma16(kA1, tr_pack(V1), cc_); Cacc[q4 * 4 + (ti)] = cc_; } while (0)
        MLS_CUPD(0, a0, a1); MLS_CUPD(1, b0, b1); MLS_CUPD(2, c0, c1); MLS_CUPD(3, d0, d1);
#undef MLS_CUPD
      }
      { const int dd = tid & 127, sq = tid >> 7; float a = 0.f; const bf16_t* kp = (const bf16_t*)k_lds + (sq * 16) * (QSTRB / 2) + dd;
#pragma unroll
        for (int si = 0; si < 16; ++si) a += bf2f(kp[si * (QSTRB / 2)]) * wkl[sq * 16 + si];
        npart[sq * 128 + dd] = a; }
      gprev = gamma;
    }
    __syncthreads();
  }
#undef MLS_LOAD
  asm volatile("s_waitcnt vmcnt(0)" ::: "memory");
  __syncthreads();
  if (tid == 0) { __builtin_amdgcn_fence(__ATOMIC_RELEASE, "agent"); asm volatile("s_waitcnt vmcnt(0)" ::: "memory"); __hip_atomic_fetch_add(mdone + 64 * b, 1u, __ATOMIC_RELAXED, __HIP_MEMORY_SCOPE_AGENT); }
}
__device__ __forceinline__ void qkconv_phase(const bf16_t* __restrict__ Pm, bf16_t* __restrict__ QKC, const float* __restrict__ conv_w, const float* __restrict__ conv_b) {
  const int tid = opaque_tid(), lane = tid & 63, wave = tid >> 6;
  const int gw = blockIdx.x * 8 + wave, ngw = gridDim.x * 8;
  const int half = gw & 1, c0 = half * 512 + lane * 8;
  float cw0[8], cw1[8], cw2[8], cbv[8];
#pragma unroll
  for (int i = 0; i < 8; ++i) { cw0[i] = conv_w[c0 + i]; cw1[i] = conv_w[1024 + c0 + i]; cw2[i] = conv_w[2048 + c0 + i]; cbv[i] = conv_b[c0 + i]; }
  const float osc = half ? 0.08838834764831845f : 1.f;
  for (int it = gw >> 1; it < NTOK / 8; it += ngw >> 1) {
    const int r0 = it * 8; const bool isl = r0 < NLAT; const int seq0 = isl ? (r0 / SEQ) * SEQ : NLAT + ((r0 - NLAT) / CTXL) * CTXL, T = isl ? SEQ : CTXL;
    uint4 x[10];
#pragma unroll
    for (int r = 0; r < 10; ++r) { const int t = r0 - seq0 - 1 + r; x[r] = (t >= 0 && t < T) ? *(const uint4*)(Pm + (size_t)(seq0 + t) * NP + C_QB + c0) : make_uint4(0u, 0u, 0u, 0u); }
#pragma unroll
    for (int r = 0; r < 8; ++r) {
      const unsigned a0[4] = {x[r].x, x[r].y, x[r].z, x[r].w}, a1[4] = {x[r + 1].x, x[r + 1].y, x[r + 1].z, x[r + 1].w}, a2[4] = {x[r + 2].x, x[r + 2].y, x[r + 2].z, x[r + 2].w};
      float o[8];
#pragma unroll
      for (int i = 0; i < 8; ++i) {
        const float v0 = (i & 1) ? __uint_as_float(a0[i >> 1] & 0xffff0000u) : __uint_as_float(a0[i >> 1] << 16);
        const float v1 = (i & 1) ? __uint_as_float(a1[i >> 1] & 0xffff0000u) : __uint_as_float(a1[i >> 1] << 16);
        const float v2 = (i & 1) ? __uint_as_float(a2[i >> 1] & 0xffff0000u) : __uint_as_float(a2[i >> 1] << 16);
        const float z = cbv[i] + cw0[i] * v0 + cw1[i] * v1 + cw2[i] * v2;
        o[i] = osc * silu_f(z);
      }
      uint4 w; w.x = pk2(o[0], o[1]); w.y = pk2(o[2], o[3]); w.z = pk2(o[4], o[5]); w.w = pk2(o[6], o[7]);
      *(uint4*)(QKC + (size_t)(r0 + r) * DM + 1024 + c0) = w;
    }
  }
}
__device__ __forceinline__ void mlstm_phase(const bf16_t* __restrict__ Pm, const bf16_t* __restrict__ QKC, const float* __restrict__ GATES, bf16_t* __restrict__ HM,
                                            const float* __restrict__ i_bias, const float* __restrict__ f_bias, bool ctx_out, unsigned* mdone, char* lds) {
  const int G = gridDim.x, bx = blockIdx.x;
  if (G == 256) { const int vcu = (bx % 8) * 32 + bx / 8; if ((vcu & 31) < 8) { const int u = (vcu >> 5) * 8 + (vcu & 31); mlstm_unit(Pm, QKC, GATES, HM, i_bias, f_bias, u >> 3, (u >> 1) & 3, u & 1, ctx_out, mdone, lds);
      {
        KArgP A = kargs(); const int lyr = ctx_out ? 0 : 1;
        const int t2 = opaque_tid(); const float* w_out = A->in[9] + (size_t)lyr * DM * DM; bf16_t* WOUT = (bf16_t*)(A->ws + WS_WOUT) + (size_t)lyr * DM * DM;
        for (int it = u * 8 + (t2 >> 6); it < 1024; it += 512) transpose_item(w_out, DM, DM, DM, WOUT, (float*)lds + (t2 >> 6) * (64 * 65), it, t2 & 63);
        __syncthreads();
      } } }
  else for (int u = bx; u < 64; u += G) mlstm_unit(Pm, QKC, GATES, HM, i_bias, f_bias, u >> 3, (u >> 1) & 3, u & 1, ctx_out, mdone, lds);
}
}

DEVI void mod_unit_g(int l, int cb, int kq, int rows, const float* __restrict__ c, const float* __restrict__ c_ctx, const float* __restrict__ w_ada, const float* __restrict__ b_ada, float* __restrict__ MOD, float* ldsf) {
    const int tid = opaque_tid(), lane = tid & 63, wv = tid >> 6;
    const int rw = rows >> 3;
    float* sc = ldsf; float* red = ldsf + 9 * 512;
    for (int i = tid; i < 9 * rows; i += 512) { const int r = i / rows, k = kq * rows + (i & (rows - 1)); const float v = (r < 8) ? c[r * DM + k] : c_ctx[k]; sc[i] = silu_f(v); }
    __syncthreads();
    float4 acc[9];
#pragma unroll
    for (int r = 0; r < 9; ++r) acc[r] = make_float4(0.f, 0.f, 0.f, 0.f);
    const float* wb = w_ada + (size_t)l * DM * MODW + (size_t)(kq * rows + wv * rw) * MODW + cb * 256;
    unsigned vo[8];
#pragma unroll
    for (int j = 0; j < 8; ++j) vo[j] = (unsigned)(lane * 16 + j * (MODW * 4));
#pragma unroll 1
    for (int k0 = 0; k0 < rw; k0 += 16) {
        f4v_t wr[16];
        ld16_wait_nt(wr, vo, uniform_ptr(wb + (size_t)k0 * MODW), uniform_ptr(wb + (size_t)(k0 + 8) * MODW));
#pragma unroll
        for (int j = 0; j < 16; ++j) { const f4v_t wvv = wr[j];
#pragma unroll
            for (int r = 0; r < 9; ++r) { const float s_ = sc[r * rows + wv * rw + k0 + j]; acc[r].x += s_ * wvv[0]; acc[r].y += s_ * wvv[1]; acc[r].z += s_ * wvv[2]; acc[r].w += s_ * wvv[3]; } }
    }
#pragma unroll
    for (int r = 0; r < 9; ++r) ((float4*)red)[(wv * 9 + r) * 64 + lane] = acc[r];
    __syncthreads();
    for (int idx = tid; idx < 9 * 256; idx += 512) {
        const int r = idx >> 8, cc = idx & 255; float s_ = (kq == 0) ? b_ada[l * MODW + cb * 256 + cc] : 0.f;
#pragma unroll
        for (int g = 0; g < 8; ++g) s_ += red[(g * 9 + r) * 256 + cc];
        atomicAdd(MOD + (size_t)(l * 9 + r) * MODW + cb * 256 + cc, s_);
    }
    __syncthreads();
}
DEVI void mod_unit(int unit, const float* __restrict__ c, const float* __restrict__ c_ctx, const float* __restrict__ w_ada, const float* __restrict__ b_ada, float* __restrict__ MOD, float* ldsf) {
    const int l = unit / 96, rem = unit % 96; mod_unit_g(l, rem >> 2, rem & 3, 512, c, c_ctx, w_ada, b_ada, MOD, ldsf);
}
DEVI void transpose_items(const float* __restrict__ W, int ldw, int K, int N, bf16_t* __restrict__ WT, float* scr, int gw, int ngw, int lane) {
    const int nitems = (K / 64) * (N / 64);
    for (int it = gw; it < nitems; it += ngw) transpose_item(W, ldw, K, N, WT, scr, it, lane);
}
DEVI void finish_row(const bf16_t* __restrict__ P, const bf16_t* __restrict__ HM, const float* __restrict__ mnorm, bf16_t* __restrict__ Y, int row, int lane) {
#pragma unroll
    for (int head = 0; head < 4; ++head) {
        const int col = head * 256 + 4 * lane;
        const uint2 a = *(const uint2*)(HM + (size_t)row * 1024 + col), c = *(const uint2*)(HM + ((size_t)NTOK + row) * 1024 + col);
        float h[4];
        h[0] = __uint_as_float(a.x << 16) + __uint_as_float(c.x << 16); h[1] = __uint_as_float(a.x & 0xffff0000u) + __uint_as_float(c.x & 0xffff0000u);
        h[2] = __uint_as_float(a.y << 16) + __uint_as_float(c.y << 16); h[3] = __uint_as_float(a.y & 0xffff0000u) + __uint_as_float(c.y & 0xffff0000u);
        const float ss = wave_sum(h[0] * h[0] + h[1] * h[1] + h[2] * h[2] + h[3] * h[3]);
        const float r = rsqrtf(ss * (1.f / 256.f) + EPS);
        const uint2 ov = *(const uint2*)(P + (size_t)row * NP + C_OB + col), gv = *(const uint2*)(P + (size_t)row * NP + C_GB + col);
        const float o[4] = {__uint_as_float(ov.x << 16), __uint_as_float(ov.x & 0xffff0000u), __uint_as_float(ov.y << 16), __uint_as_float(ov.y & 0xffff0000u)};
        const float g[4] = {__uint_as_float(gv.x << 16), __uint_as_float(gv.x & 0xffff0000u), __uint_as_float(gv.y << 16), __uint_as_float(gv.y & 0xffff0000u)};
        const float4 w = *(const float4*)(mnorm + col);
        const float wv[4] = {w.x, w.y, w.z, w.w};
        float y[4];
#pragma unroll
        for (int e = 0; e < 4; ++e) y[e] = h[e] * r * wv[e] * sigmoid_f(o[e]) * silu_f(g[e]);
        uint2 out; out.x = pk2(y[0], y[1]); out.y = pk2(y[2], y[3]);
        *(uint2*)(Y + (size_t)row * DM + 1024 + col) = out;
    }
}
DEVI void load_row(const float* __restrict__ xr, float4 (&v)[8], int lane) {
#pragma unroll
    for (int j = 0; j < 8; ++j) { const f4v_t t = __builtin_nontemporal_load((const f4v_t*)xr + lane + 64 * j); v[j] = make_float4(t[0], t[1], t[2], t[3]); }
}
DEVI void load_row_h(const float* __restrict__ slot, float4 (&v)[8], int lane) {
    typedef unsigned u2v_t __attribute__((ext_vector_type(2)));
#pragma unroll
    for (int j = 0; j < 8; ++j) { const u2v_t t = __builtin_nontemporal_load((const u2v_t*)(slot + DM / 2) + lane + 64 * j);
        v[j] = make_float4(__uint_as_float(t[0] << 16), __uint_as_float(t[0] & 0xffff0000u), __uint_as_float(t[1] << 16), __uint_as_float(t[1] & 0xffff0000u)); }
}
DEVI void load_row_y(const bf16_t* __restrict__ yr, uint2 (&yv)[8], int lane) {
    typedef unsigned u2v_t __attribute__((ext_vector_type(2)));
#pragma unroll
    for (int j = 0; j < 8; ++j) { const u2v_t t = __builtin_nontemporal_load((const u2v_t*)(yr + 4 * (lane + 64 * j))); yv[j].x = t[0]; yv[j].y = t[1]; }
}
DEVI void post_regs(float4 (&v)[8], const uint2 (&yv)[8], const float* gate, const float* npost, float* __restrict__ orow, int lane, bool half = false  ) {
    float ss = 0.f;
#pragma unroll
    for (int j = 0; j < 8; ++j) {
        const float y0 = __uint_as_float(yv[j].x << 16), y1 = __uint_as_float(yv[j].x & 0xffff0000u), y2 = __uint_as_float(yv[j].y << 16), y3 = __uint_as_float(yv[j].y & 0xffff0000u);
        ss += y0 * y0 + y1 * y1 + y2 * y2 + y3 * y3;
    }
    ss = wave_sum(ss);
    const float rstd = rsqrtf(ss * (1.f / DM) + EPS);
#pragma unroll
    for (int j = 0; j < 8; ++j) {
        const float4 gt = ((const float4*)gate)[lane + 64 * j], w = ((const float4*)npost)[lane + 64 * j];
        const float y0 = __uint_as_float(yv[j].x << 16), y1 = __uint_as_float(yv[j].x & 0xffff0000u), y2 = __uint_as_float(yv[j].y << 16), y3 = __uint_as_float(yv[j].y & 0xffff0000u);
        v[j].x += gt.x * (y0 * rstd * w.x); v[j].y += gt.y * (y1 * rstd * w.y); v[j].z += gt.z * (y2 * rstd * w.z); v[j].w += gt.w * (y3 * rstd * w.w);
        if (orow) { if (half) { typedef unsigned u2v_t __attribute__((ext_vector_type(2))); const u2v_t t = {pk2(v[j].x, v[j].y), pk2(v[j].z, v[j].w)}; __builtin_nontemporal_store(t, (u2v_t*)(orow + DM / 2) + lane + 64 * j); }
                    else { const f4v_t t = {v[j].x, v[j].y, v[j].z, v[j].w}; __builtin_nontemporal_store(t, (f4v_t*)orow + lane + 64 * j); } }
        if (j == 3) asm volatile("" ::: "memory");
    }
}
DEVI void norm_regs(const float4 (&v)[8], const float* shift, const float* scale, const float* npre, bf16_t* __restrict__ hrow, char* trow, int lane) {
    float ss = 0.f;
#pragma unroll
    for (int j = 0; j < 8; ++j) ss += v[j].x * v[j].x + v[j].y * v[j].y + v[j].z * v[j].z + v[j].w * v[j].w;
    ss = wave_sum(ss);
    const float rstd = rsqrtf(ss * (1.f / DM) + EPS);
#pragma unroll
    for (int j = 0; j < 8; ++j) {
        const float4 w = ((const float4*)npre)[lane + 64 * j], sh = ((const float4*)shift)[lane + 64 * j], sc = ((const float4*)scale)[lane + 64 * j];
        uint2 o;
        o.x = pk2(v[j].x * rstd * w.x * (1.f + sc.x) + sh.x, v[j].y * rstd * w.y * (1.f + sc.y) + sh.y);
        o.y = pk2(v[j].z * rstd * w.z * (1.f + sc.z) + sh.z, v[j].w * rstd * w.w * (1.f + sc.w) + sh.w);
        *(uint2*)(hrow + 4 * (lane + 64 * j)) = o; *(uint2*)(trow + 8 * (lane + 64 * j)) = o;
        if (j == 3) asm volatile("" ::: "memory");
    }
}
constexpr int NT_ROWB = (DM + 8) * 2;
constexpr int NV_OFF = 0, NT_OFF = 5 * DM * 4, NR_OFF = NT_OFF + 16 * NT_ROWB, NPH_LDS = NR_OFF + 8 * 16 * 16 * 4;
static_assert(NPH_LDS <= LDS_PHASE_BYTES, "norm phase LDS map");
template <bool POST>
DEVI void norm_phase(const float* __restrict__ xlat, const float* __restrict__ xctx, const bf16_t* __restrict__ Y2, const float* __restrict__ mod_post, const float* __restrict__ npost,
                     float* olat, float* octx, const float* __restrict__ mod_n, const float* __restrict__ npre, const bf16_t* __restrict__ wgt, bf16_t* __restrict__ H,
                     float* __restrict__ GATES, char* lds) {
    typedef short bf16x8 __attribute__((ext_vector_type(8))); typedef float f32x4 __attribute__((ext_vector_type(4)));
    const int tid = opaque_tid(), lane = tid & 63, wave = __builtin_amdgcn_readfirstlane(tid >> 6), lr = lane & 15, kgp = lane >> 4;
    float* vec = (float*)(lds + NV_OFF); float* v_npre = vec; float* v_shift = vec + DM; float* v_scale = vec + 2 * DM; float* v_npost = vec + 3 * DM; float* v_gate = vec + 4 * DM;
    char* tile = lds + NT_OFF; float* red = (float*)(lds + NR_OFF);
    ((float4*)v_npre)[tid] = ((const float4*)npre)[tid];
    if (POST) ((float4*)v_npost)[tid] = ((const float4*)npost)[tid];
    int cur_b = -1;
#define NP_ENSURE(bb) do { if ((bb) != cur_b) { __syncthreads(); const float* mn_ = mod_n + (size_t)(bb) * MODW; ((float4*)v_shift)[tid] = ((const float4*)mn_)[tid]; ((float4*)v_scale)[tid] = ((const float4*)(mn_ + DM))[tid]; \
        if (POST) ((float4*)v_gate)[tid] = ((const float4*)(mod_post + (size_t)(bb) * MODW + 2 * DM))[tid]; cur_b = (bb); __syncthreads(); } } while (0)
    const int row0 = (int)blockIdx.x * (NTOK / 256);
    for (int g = 0; g < 5; ++g) {
        const int gr0 = row0 + 16 * g; const bool two = g < 4;
        const int rowA = gr0 + wave, rowB = gr0 + 8 + wave;
        const bool islA = rowA < NLAT, islB = rowB < NLAT; const int bA = gr0 < NLAT ? gr0 / SEQ : 8, bB = (gr0 + 8) < NLAT ? (gr0 + 8) / SEQ : 8;
        float4 vA[8], vB[8]; uint2 yA[8], yB[8];
        load_row(islA ? xlat + (size_t)rowA * DM : xctx + (size_t)(rowA - NLAT) * DM, vA, lane);
        if (POST) load_row_y(Y2 + (size_t)rowA * DM, yA, lane);
        if (two) { load_row(islB ? xlat + (size_t)rowB * DM : xctx + (size_t)(rowB - NLAT) * DM, vB, lane); if (POST) load_row_y(Y2 + (size_t)rowB * DM, yB, lane); }
        NP_ENSURE(bA);
        if (POST) post_regs(vA, yA, v_gate, v_npost, islA ? olat + (size_t)rowA * DM : (float*)nullptr  , lane, true);
        norm_regs(vA, v_shift, v_scale, v_npre, H + (size_t)rowA * DM, tile + wave * NT_ROWB, lane);
        if (two) {
            NP_ENSURE(bB);
            if (POST) post_regs(vB, yB, v_gate, v_npost, islB ? olat + (size_t)rowB * DM : (float*)nullptr, lane, true);
            norm_regs(vB, v_shift, v_scale, v_npre, H + (size_t)rowB * DM, tile + (8 + wave) * NT_ROWB, lane);
        }
        __syncthreads();
        f32x4 acc = {0.f, 0.f, 0.f, 0.f};
        {
            f4v_t bfr[8]; unsigned vo[8];
#pragma unroll
            for (int ks = 0; ks < 8; ++ks) vo[ks] = (unsigned)((lr * DM + wave * 256 + ks * 32 + 8 * kgp) * 2);
            ld8_wait(bfr, vo, uniform_ptr(wgt));
#pragma unroll
            for (int ks = 0; ks < 8; ++ks) {
                const bf16x8 af = *(const bf16x8*)(tile + lr * NT_ROWB + (wave * 256 + ks * 32 + 8 * kgp) * 2);
                acc = __builtin_amdgcn_mfma_f32_16x16x32_bf16(af, __builtin_bit_cast(bf16x8, bfr[ks]), acc, 0, 0, 0);
            }
        }
#pragma unroll
        for (int r = 0; r < 4; ++r) red[(wave * 16 + 4 * kgp + r) * 16 + lr] = acc[r];
        __syncthreads();
        if (tid < 256) { const int rr = tid >> 4, cc = tid & 15;
            if (two || rr < 8) { float sum = 0.f;
#pragma unroll
                for (int w8 = 0; w8 < 8; ++w8) sum += red[(w8 * 16 + rr) * 16 + cc];
                GATES[(size_t)(gr0 + rr) * 16 + cc] = sum; } }
    }
#undef NP_ENSURE
    __syncthreads();
}
DEVI void post_phase_final(float* out, const bf16_t* __restrict__ Y2, const float* __restrict__ mod_l, const float* __restrict__ npost, char* lds) {
    const int tid = opaque_tid(), lane = tid & 63, wave = tid >> 6;
    float* v_gate = (float*)lds; float* v_npost = v_gate + DM;
    const int row0 = (int)blockIdx.x * (NLAT / 256), b = row0 / SEQ;
    ((float4*)v_gate)[tid] = ((const float4*)(mod_l + (size_t)b * MODW + 2 * DM))[tid];
    ((float4*)v_npost)[tid] = ((const float4*)npost)[tid];
    __syncthreads();
    float4 vA[8], vB[8]; uint2 yA[8], yB[8];
    const int r0 = row0 + wave * 8;
    load_row_h(out + (size_t)r0 * DM, vA, lane); load_row_y(Y2 + (size_t)r0 * DM, yA, lane);
    load_row_h(out + (size_t)(r0 + 1) * DM, vB, lane); load_row_y(Y2 + (size_t)(r0 + 1) * DM, yB, lane);
#pragma unroll 1
    for (int i = 0; i < 4; ++i) {
        const int ra = r0 + 2 * i, rb = ra + 1;
        post_regs(vA, yA, v_gate, v_npost, out + (size_t)ra * DM, lane);
        if (i < 3) { load_row_h(out + (size_t)(ra + 2) * DM, vA, lane); load_row_y(Y2 + (size_t)(ra + 2) * DM, yA, lane); }
        post_regs(vB, yB, v_gate, v_npost, out + (size_t)rb * DM, lane);
        if (i < 3) { load_row_h(out + (size_t)(rb + 2) * DM, vB, lane); load_row_y(Y2 + (size_t)(rb + 2) * DM, yB, lane); }
    }
    __syncthreads();
}

DEVI void mixer_queue(const bf16_t* __restrict__ Pm, bf16_t* __restrict__ Y, const bf16_t* __restrict__ HM, const float* lq1, const float* lk1, const float* lq2, const float* lk2,
                      const float* __restrict__ subln, const float* __restrict__ mnorm, float lam_init, bool ctx_out, unsigned* qcnt  ,
                      unsigned* mdone  , volatile __attribute__((address_space(3))) unsigned* bcast, char* lds) {
  const int tid = opaque_tid(), lane = tid & 63;
  const float lam = rl_f(expf(wave_sum(lq1[lane] * lk1[lane])) - expf(wave_sum(lq2[lane] * lk2[lane])) + lam_init, 0);
  const int G = gridDim.x, bx = blockIdx.x; const int vcu = (G % 8 == 0) ? (bx % 8) * (G / 8) + bx / 8 : bx;
  const int g0 = (G == 256) ? (vcu >> 5) : (bx & 7);
  const int natt = 64 + (ctx_out ? 8 : 0), nun = natt + 32 + (ctx_out ? 4 : 0);
  for (int gi = 0; gi < 8; ++gi) {
    const int g = (g0 + gi) & 7;
    for (;;) {
      if (opaque_tid() == 0) bcast[0] = __hip_atomic_fetch_add(qcnt + 64 * g, 1u, __ATOMIC_RELAXED, __HIP_MEMORY_SCOPE_AGENT);
      __syncthreads();
      const int u = (int)bcast[0];
      __syncthreads();
      if (u >= nun) break;
      if (u < 64) { const int bh = g * 8 + (u >> 3), qb = u & 7, b = bh >> 3, hh = bh & 7; att::attn_unit2(Pm, Y, (long)b * SEQ + qb * att::QROWS2, b, hh, 36, lam, lam_init, subln, lds); }
      else if (u < natt) { const int bh = g * 8 + (u - 64), b = bh >> 3, hh = bh & 7; att::attn_unit2(Pm, Y, (long)NLAT + b * CTXL, b, hh, 4, lam, lam_init, subln, lds); }
      else {
        const int f = u - natt; const int row0 = f < 32 ? g * SEQ + f * 64 : NLAT + g * CTXL + (f - 32) * 64;
        if (opaque_tid() == 0) {
          unsigned spins = 0;
          while (__hip_atomic_load(mdone + 64 * g, __ATOMIC_RELAXED, __HIP_MEMORY_SCOPE_AGENT) < 8u) { __builtin_amdgcn_s_sleep(8); if (++spins > (1u << 22)) break; }
          __builtin_amdgcn_fence(__ATOMIC_ACQUIRE, "agent");
          asm volatile("s_waitcnt vmcnt(0)" ::: "memory");
        }
        __syncthreads();
        const int tid2 = opaque_tid();
#pragma unroll 1
        for (int r = 0; r < 8; ++r) finish_row(Pm, HM, mnorm, Y, row0 + (tid2 >> 6) * 8 + r, tid2 & 63);
      }
    }
  }
}

#define XB_TMO      128
#define XB_XCNT(j)  (256  + 64 * (j))
#define XB_XSUB(j)  (1280 + 64 * (j))
#define XB_XGEN(j)  (2304 + 64 * (j))
#define XB_TOP      3328
#define XB_TOPGEN   3392
#define XCD_BAR_WORDS 3456
#define XB_SPIN_CAP (1u << 18)

__device__ __forceinline__ unsigned xb_ld(unsigned* p)              { return __hip_atomic_load(p, __ATOMIC_RELAXED, __HIP_MEMORY_SCOPE_AGENT); }
__device__ __forceinline__ unsigned xb_add(unsigned* p, unsigned v) { return __hip_atomic_fetch_add(p, v, __ATOMIC_RELAXED, __HIP_MEMORY_SCOPE_AGENT); }
__device__ __forceinline__ unsigned xb_xcc_id() { return (unsigned)__builtin_amdgcn_s_getreg((3 << 11) | 20) & 0xFu; }
#define XB_SPIN(cond, bar) do { unsigned _sp = 0; while (cond) { __builtin_amdgcn_s_sleep(1); \
    if ((++_sp & 255u) == 0u) { if (xb_ld(&(bar)[XB_TMO])) break; if (_sp > XB_SPIN_CAP) { atomicAdd(&(bar)[XB_TMO], 1u); break; } } } } while (0)

struct XcdBarrier {
    unsigned* bar; unsigned x;
    volatile __attribute__((address_space(3))) unsigned* st;
};

__device__ __forceinline__ XcdBarrier xcd_barrier_post(unsigned* bar, volatile __attribute__((address_space(3))) unsigned* st) {
    XcdBarrier b; b.bar = bar; b.x = xb_xcc_id(); b.st = st;
    if (threadIdx.x == 0) (void)xb_add(&bar[XB_XCNT(b.x)], 1u);
    return b;
}
__device__ __forceinline__ void xcd_barrier_complete(unsigned* bar, unsigned x, unsigned& nloc, unsigned& nx) {
    const unsigned G = gridDim.x * gridDim.y * gridDim.z;
    unsigned sum, cnt, mine, sp = 0u;
    for (;;) {
        sum = 0u; cnt = 0u; mine = 0u;
#pragma unroll
        for (unsigned j = 0; j < 16; ++j) { const unsigned c = xb_ld(&bar[XB_XCNT(j)]); sum += c; cnt += (c > 0u) ? 1u : 0u; mine = (j == x) ? c : mine; }
        if (sum == G) break;
        __builtin_amdgcn_s_sleep(1);
        if ((++sp & 255u) == 0u) { if (xb_ld(&bar[XB_TMO])) break; if (sp > XB_SPIN_CAP) { atomicAdd(&bar[XB_TMO], 1u); break; } }
    }
    nloc = mine > 0u ? mine : 1u; nx = cnt > 0u ? cnt : 1u;
}

__device__ __forceinline__ void xcd_barrier(const XcdBarrier& b, bool nowait = false  ) {
    asm volatile("s_waitcnt vmcnt(0)" ::: "memory");
    __syncthreads();
    if (threadIdx.x == 0) {
        unsigned* bar = b.bar;
        __builtin_amdgcn_s_waitcnt(0);
        unsigned nloc = b.st[0], nx = b.st[1];
        if (nloc == 0u) { xcd_barrier_complete(bar, b.x, nloc, nx); b.st[0] = nloc; b.st[1] = nx; }
        const unsigned old = xb_add(&bar[XB_XSUB(b.x)], 1u);
        const unsigned gen = old / nloc;
        if (old + 1u == (gen + 1u) * nloc) {
            __builtin_amdgcn_fence(__ATOMIC_RELEASE, "agent");
            asm volatile("s_waitcnt vmcnt(0)" ::: "memory");
            const unsigned og = xb_add(&bar[XB_TOP], 1u);
            const unsigned tg = og / nx;
            if (og + 1u == (tg + 1u) * nx) xb_add(&bar[XB_TOPGEN], 1u);
            else XB_SPIN(xb_ld(&bar[XB_TOPGEN]) == tg, bar);
            __builtin_amdgcn_fence(__ATOMIC_ACQUIRE, "agent");
            xb_add(&bar[XB_XGEN(b.x)], 1u);
            asm volatile("s_waitcnt vmcnt(0)" ::: "memory");
        } else if (!nowait) {
            XB_SPIN(xb_ld(&bar[XB_XGEN(b.x)]) == gen, bar);
            __builtin_amdgcn_fence(__ATOMIC_ACQUIRE, "agent");
            asm volatile("s_waitcnt vmcnt(0)" ::: "memory");
        }
    }
    __syncthreads();
}

namespace cg = cooperative_groups;
constexpr int MEGA_LDS = LDS_PHASE_BYTES + 256;
#define LAS3 __attribute__((address_space(3)))
__global__ __launch_bounds__(512, 2) void mega_fwd(MegaArgs a_unused) {
    (void)a_unused;
    extern __shared__ __attribute__((aligned(16))) unsigned char lds[];
    cg::grid_group grid = cg::this_grid();
    { volatile LAS3 unsigned* MISC = (volatile LAS3 unsigned*)((LAS3 unsigned char*)lds + LDS_PHASE_BYTES);
      if (threadIdx.x < 64) MISC[threadIdx.x] = 0u;
      __syncthreads();
      if ((threadIdx.x & 63) == 0) ((volatile LAS3 unsigned char*)MISC)[128 + ((unsigned)__builtin_amdgcn_s_getreg((5 << 11) | 4) & 63u)] = (unsigned char)(threadIdx.x >> 6);
      __syncthreads();
      (void)xcd_barrier_post((unsigned*)(kargs()->ws + WS_CTL) + 4096, MISC + 8); }
#define GRID_BAR() do { XcdBarrier b_; b_.bar = (unsigned*)(kargs()->ws + WS_CTL) + 4096; b_.x = xb_xcc_id(); b_.st = (volatile LAS3 unsigned*)((LAS3 unsigned char*)lds + LDS_PHASE_BYTES) + 8; xcd_barrier(b_); } while (0)
#define GRID_BAR_NW(nw) do { XcdBarrier b_; b_.bar = (unsigned*)(kargs()->ws + WS_CTL) + 4096; b_.x = xb_xcc_id(); b_.st = (volatile LAS3 unsigned*)((LAS3 unsigned char*)lds + LDS_PHASE_BYTES) + 8; xcd_barrier(b_, (nw)); } while (0)
#define PHASE_IDS const int G = gridDim.x; const int tid = opaque_tid(), lane = tid & 63, wave = tid >> 6, gw = blockIdx.x * 8 + wave, ngw = G * 8; (void)tid; (void)lane; (void)gw; (void)ngw; float* scr = (float*)lds + wave * (64 * 65); (void)scr
#define WSP(T, off) ((T*)(A->ws + (off)))

    { PHASE_IDS; KArgP A = kargs();
      const float* w_in = A->in[8]; const float* w_out = A->in[9]; bf16_t* WIN = WSP(bf16_t, WS_WIN); bf16_t* WOUT = WSP(bf16_t, WS_WOUT); float* ROPE = WSP(float, WS_ROPE);
      const bool dfr = (G == 256);
      if (dfr) { if ((int)blockIdx.x < 192) mod_unit_g(0, (int)blockIdx.x >> 3, (int)blockIdx.x & 7, 256, A->in[1], A->in[3], A->in[4], A->in[5], WSP(float, WS_MOD), (float*)lds); }
      else for (int u = blockIdx.x; u < 192; u += G) mod_unit(u, A->in[1], A->in[3], A->in[4], A->in[5], WSP(float, WS_MOD), (float*)lds);
      { bf16_t* WGT = WSP(bf16_t, WS_WGT); for (int i = blockIdx.x * 512 + tid; i < 2 * 16 * DM; i += G * 512) { const int l_ = i >> 15, k_ = (i >> 4) & (DM - 1), c_ = i & 15; WGT[(l_ * 16 + c_) * DM + k_] = f2bf(w_in[(size_t)l_ * DM * INC + (size_t)k_ * INC + NP + c_]); } }
      for (int i = blockIdx.x * 512 + tid; i < 1024; i += G * 512) { const int pos = i >> 4, f = i & 15; const float inv = powf(10000.f, -(float)f / 16.f); const float ang = (float)pos * inv;
          ROPE[2 * i] = cosf(ang); ROPE[2 * i + 1] = sinf(ang); }
      if (dfr) {
          if ((int)blockIdx.x < 192) { for (int it = gw; it < 2304; it += 192 * 8) transpose_item(w_in, INC, DM, NP, WIN, scr, it, lane); }
          else for (int it = 2304 + gw - 192 * 8; it < 4096; it += 64 * 8) transpose_item(w_in, INC, DM, NP, WIN, scr, it, lane);
      } else {
          for (int it = gw; it < 6144; it += ngw) {
              if (it < 4096) transpose_item(w_in, INC, DM, NP, WIN, scr, it, lane);
              else if (it < 5120) transpose_item(w_out, DM, DM, DM, WOUT, scr, it - 4096, lane);
              else transpose_item(w_out + (size_t)DM * DM, DM, DM, DM, WOUT + (size_t)DM * DM, scr, it - 5120, lane);
          }
      } }
    if (gridDim.x > 65536u) grid.sync();
    GRID_BAR();
    { KArgP A = kargs();
      norm_phase<false>(A->in[0], A->in[2], nullptr, nullptr, nullptr, nullptr, nullptr, WSP(float, WS_MOD), A->in[6], WSP(bf16_t, WS_WGT), WSP(bf16_t, WS_H), WSP(float, WS_GATES), (char*)lds); }
    GRID_BAR();
    for (int l = 0; l < 2; ++l) {
        { KArgP A = kargs();
          pg8::Gemm g{WSP(bf16_t, WS_H), WSP(bf16_t, WS_WIN), NTOK, NP, DM}; pg8::StaticOrder S; S.init(NTOK, NP, (int)gridDim.x, (int)blockIdx.x); pg8::EpiInProj E{WSP(bf16_t, WS_P), NP, WSP(float, WS_ROPE)};
          pg8::gemm_phase<pg8::EpiInProj, pg8::StaticOrder, true, true>((PG8_LAS unsigned char*)lds, g, S, E); }
        GRID_BAR();
        { KArgP A = kargs(); mls::qkconv_phase(WSP(bf16_t, WS_P), WSP(bf16_t, WS_H), A->in[15] + (size_t)l * 3 * 1024, A->in[16] + l * 1024); }
        { const int G_ = gridDim.x, bx_ = blockIdx.x;
          GRID_BAR_NW(G_ == 256 && ((((bx_ % 8) * 32 + bx_ / 8) & 31) >= 8)); }
        { KArgP A = kargs(); mls::mlstm_phase(WSP(bf16_t, WS_P), WSP(bf16_t, WS_H), WSP(float, WS_GATES), WSP(bf16_t, WS_HM), A->in[17] + l * 8, A->in[18] + l * 8, l == 0, WSP(unsigned, WS_CTL) + 12288 + l * 512, (char*)lds); }
        { KArgP A = kargs(); const float lam_init = l == 0 ? 0.2f : 0.35550906759f;
          mixer_queue(WSP(bf16_t, WS_P), WSP(bf16_t, WS_H), WSP(bf16_t, WS_HM), A->in[10] + l * 64, A->in[11] + l * 64, A->in[12] + l * 64, A->in[13] + l * 64, A->in[14] + l * 128, A->in[19] + l * 1024, lam_init, l == 0,
                      WSP(unsigned, WS_CTL) + 8192 + l * 512, WSP(unsigned, WS_CTL) + 12288 + l * 512, (volatile LAS3 unsigned*)((LAS3 unsigned char*)lds + LDS_PHASE_BYTES) + 16, (char*)lds); }
        GRID_BAR();
        { KArgP A = kargs(); const int M = l == 0 ? NTOK : NLAT;
          pg8::Gemm g{WSP(bf16_t, WS_H), WSP(bf16_t, WS_WOUT) + (size_t)l * DM * DM, M, DM, DM}; pg8::StaticOrder S; S.init(M, DM, (int)gridDim.x, (int)blockIdx.x); pg8::EpiBf16 E{WSP(bf16_t, WS_HM), DM};
          pg8::gemm_phase<pg8::EpiBf16, pg8::StaticOrder, true, true>((PG8_LAS unsigned char*)lds, g, S, E); }
        if (l == 0) { PHASE_IDS; KArgP A = kargs(); const float* w_in1 = A->in[8] + (size_t)DM * INC; bf16_t* WIN = WSP(bf16_t, WS_WIN);
            const int nbusy = (NTOK / 256) * (DM / 256) - 2 * G;
            if (nbusy >= 0 && nbusy < G) { if ((int)blockIdx.x >= nbusy) { const int ib = (int)blockIdx.x - nbusy, nidle = G - nbusy;
                    if (G == 256 && nidle == 192) { if (ib < 96) mod_unit(96 + ib, A->in[1], A->in[3], A->in[4], A->in[5], WSP(float, WS_MOD), (float*)lds);
                                                    else transpose_items(w_in1, INC, DM, NP, WIN, scr, (ib - 96) * 8 + wave, 96 * 8, lane); }
                    else transpose_items(w_in1, INC, DM, NP, WIN, scr, ib * 8 + wave, nidle * 8, lane); } }
            else transpose_items(w_in1, INC, DM, NP, WIN, scr, gw, ngw, lane);
        }
        GRID_BAR();
        if (l == 0) {
            { KArgP A = kargs(); float* MOD = WSP(float, WS_MOD);
              norm_phase<true>(A->in[0], A->in[2], WSP(bf16_t, WS_HM), MOD, A->in[7], A->out, WSP(float, WS_XC), MOD + (size_t)9 * MODW, A->in[6] + DM, WSP(bf16_t, WS_WGT) + 16 * DM, WSP(bf16_t, WS_H), WSP(float, WS_GATES), (char*)lds); }
            GRID_BAR();
        } else { KArgP A = kargs(); post_phase_final(A->out, WSP(bf16_t, WS_HM), WSP(float, WS_MOD) + (size_t)9 * MODW, A->in[7] + DM, (char*)lds);
        }
    }
}

extern "C" void kernel_launch(void* const* d_in, const int* in_sizes, int n_in, void* d_out, int out_size, void* d_ws, size_t ws_size, hipStream_t stream) {
    (void)in_sizes; (void)n_in; (void)out_size; (void)ws_size;
    static int grid_blocks = 0;
    if (!grid_blocks) {
        int dev = 0, cus = 0, per_cu = 0;
        (void)hipGetDevice(&dev);
        (void)hipDeviceGetAttribute(&cus, hipDeviceAttributeMultiprocessorCount, dev);
        (void)hipFuncSetAttribute((const void*)mega_fwd, hipFuncAttributeMaxDynamicSharedMemorySize, MEGA_LDS);
        (void)hipOccupancyMaxActiveBlocksPerMultiprocessor(&per_cu, (const void*)mega_fwd, 512, MEGA_LDS);
        if (per_cu < 1) per_cu = 1;
        if (per_cu > 1) per_cu = 1;
        grid_blocks = cus * per_cu;
    }
    (void)hipMemsetAsync((char*)d_ws + WS_CTL, 0, WS_MOD + (size_t)2 * 9 * MODW * 4, stream);
    MegaArgs a{};
    for (int i = 0; i < 20; ++i) a.in[i] = (const float*)d_in[i];
    a.out = (float*)d_out; a.ws = (unsigned char*)d_ws;
    void* args[] = {&a};
    (void)hipLaunchCooperativeKernel((const void*)mega_fwd, dim3(grid_blocks), dim3(512), args, (size_t)MEGA_LDS, stream);
}
```
